# Optimizing an MI355X kernel written in HIP

```python
import math
import jax, jax.numpy as jnp
from jax import lax
import numpy as np

D_MODEL = 2048
BATCH = 32
SEQ = 256
DEPTH = 2
DEC_BATCH = 2
DEC_SEQ = 2048
PAST_LEN = 256

GRID_W = 64
D_MIX = D_MODEL
ATT_HEADS = 8
ATT_KV_HEADS = 2
GQA_GROUP = ATT_HEADS // ATT_KV_HEADS
HEAD_DIM = 128
ATT_WIDTH = ATT_HEADS * HEAD_DIM
KV_WIDTH = ATT_KV_HEADS * HEAD_DIM
WINDOW = 128
ATT_BLOCK = 128
ROPE_BASE = 10000.0
HG_HEADS = 4
HG_DK = 128
HG_DV = 128
HG_KW = HG_HEADS * HG_DK
HG_WIDTH = HG_HEADS * HG_DV
HG_CHUNK = 32
GATE_EPS = 1e-6
CV_WIDTH = D_MIX - ATT_WIDTH - HG_WIDTH
CONV_TAPS = 31
SPLITS = (ATT_WIDTH, KV_WIDTH, KV_WIDTH, ATT_WIDTH,
          HG_KW, HG_WIDTH, HG_KW, HG_KW, HG_WIDTH,
          CV_WIDTH, CV_WIDTH, CV_WIDTH)
SPLIT_POINTS = tuple(int(s) for s in np.cumsum(SPLITS)[:-1])
D_IN = int(sum(SPLITS))
ALPHA = float((2 * DEPTH) ** 0.25)
BETA = float((8 * DEPTH) ** -0.25)
NEG = -1e30

kernel_name = "hymba_hgrn2_swa_conformer_dit_step"

F32 = jnp.float32


def layer_norm(x, w, b, eps=1e-5):
    xf = x.astype(F32)
    mu = jnp.mean(xf, axis=-1, keepdims=True)
    var = jnp.mean(jnp.square(xf - mu), axis=-1, keepdims=True)
    return ((xf - mu) * lax.rsqrt(var + eps) * w.astype(F32) + b.astype(F32)).astype(x.dtype)


def rms_norm(x, w, eps=1e-6):
    xf = x.astype(F32)
    return xf * lax.rsqrt(jnp.mean(xf * xf, axis=-1, keepdims=True) + eps) * w.astype(F32)


def axial_rope(x):
    seq_len = x.shape[1]
    rows = seq_len // GRID_W
    row = jnp.broadcast_to(jnp.arange(rows)[:, None], (rows, GRID_W)).reshape(-1)
    col = jnp.broadcast_to(jnp.arange(GRID_W)[None, :], (rows, GRID_W)).reshape(-1)
    half = HEAD_DIM // 2
    nf = half // 2
    inv = ROPE_BASE ** (-jnp.arange(nf, dtype=F32) / nf)

    def rot(xp, pos):
        ang = pos.astype(F32)[:, None] * inv[None, :]
        cos = jnp.cos(ang)[None, :, None, :]
        sin = jnp.sin(ang)[None, :, None, :]
        x1 = xp[..., :nf].astype(F32)
        x2 = xp[..., nf:].astype(F32)
        return jnp.concatenate([x1 * cos - x2 * sin, x2 * cos + x1 * sin], axis=-1)

    return jnp.concatenate([rot(x[..., :half], row), rot(x[..., half:], col)], axis=-1).astype(x.dtype)


def sink_softmax(logits, sink):
    s = jnp.broadcast_to(sink[:, :, None, None], logits.shape[:-1] + (1,))
    p = jax.nn.softmax(jnp.concatenate([logits, s], axis=-1), axis=-1)
    return p[..., :-1]


def context_attention(q, k, v, sink):
    B, L, H, D = q.shape
    nq = L // ATT_BLOCK
    scale = D ** -0.5
    qb = q.reshape(B, nq, ATT_BLOCK, ATT_KV_HEADS, GQA_GROUP, D).transpose(1, 0, 2, 3, 4, 5)

    def one_block(qblk):
        s = jnp.einsum('bqkgd,bckd->bkgqc', qblk, k).astype(F32) * scale
        p = sink_softmax(s, sink).astype(v.dtype)
        return jnp.einsum('bkgqc,bckd->bqkgd', p, v)

    o = lax.map(one_block, qb)
    return o.transpose(1, 0, 2, 3, 4, 5).reshape(B, L, H * D)


def latent_attention(q, k, v, ck, cv, sink):
    B, S, H, D = q.shape
    nb = S // ATT_BLOCK
    scale = D ** -0.5
    qb = q.reshape(B, nb, ATT_BLOCK, ATT_KV_HEADS, GQA_GROUP, D)
    pad = ((0, 0), (ATT_BLOCK, ATT_BLOCK), (0, 0), (0, 0))
    kb = jnp.pad(k, pad).reshape(B, nb + 2, ATT_BLOCK, ATT_KV_HEADS, D)
    vb = jnp.pad(v, pad).reshape(B, nb + 2, ATT_BLOCK, ATT_KV_HEADS, D)
    kl = jnp.concatenate([kb[:, :nb], kb[:, 1:nb + 1], kb[:, 2:]], axis=2)
    vl = jnp.concatenate([vb[:, :nb], vb[:, 1:nb + 1], vb[:, 2:]], axis=2)
    qpos = jnp.arange(S).reshape(nb, ATT_BLOCK)
    kpos = jnp.arange(nb)[:, None] * ATT_BLOCK - ATT_BLOCK + jnp.arange(3 * ATT_BLOCK)[None, :]
    mask = ((jnp.abs(qpos[:, :, None] - kpos[:, None, :]) <= WINDOW)
            & (kpos[:, None, :] >= 0) & (kpos[:, None, :] < S))
    s_loc = jnp.einsum('bnqkgd,bnrkd->bnkgqr', qb, kl).astype(F32) * scale
    s_loc = jnp.where(mask[None, :, None, None, :, :], s_loc, NEG)
    s_ctx = jnp.einsum('bnqkgd,bckd->bnkgqc', qb, ck.astype(q.dtype)).astype(F32) * scale
    p = sink_softmax(jnp.concatenate([s_loc, s_ctx], axis=-1), sink).astype(v.dtype)
    r = 3 * ATT_BLOCK
    o = (jnp.einsum('bnkgqr,bnrkd->bnqkgd', p[..., :r], vl)
         + jnp.einsum('bnkgqc,bckd->bnqkgd', p[..., r:], cv.astype(v.dtype)))
    return o.reshape(B, S, H * D)


def hgrn2_chunk_scan(q, k, v, logf, s0):
    B, L, H, DK = q.shape
    DV = v.shape[-1]
    n = L // HG_CHUNK

    def chunks(t):
        return t.reshape(B, n, HG_CHUNK, H, t.shape[-1]).transpose(1, 0, 3, 2, 4)

    causal = jnp.tril(jnp.ones((HG_CHUNK, HG_CHUNK), dtype=bool))

    def step(S, inp):
        qc, kc, vc, gc = inp
        G = jnp.cumsum(gc, axis=2)
        inter = jnp.einsum('bhtd,bhde->bhte', qc * jnp.exp(G), S)
        diff = jnp.where(causal[None, None, :, :, None],
                         G[:, :, :, None, :] - G[:, :, None, :, :], NEG)
        A = jnp.einsum('bhtd,bhtsd,bhsd->bhts', qc, jnp.exp(diff), kc)
        intra = jnp.einsum('bhts,bhse->bhte', A, vc)
        g_last = G[:, :, -1:, :]
        S_new = (jnp.exp(g_last[:, :, 0, :])[..., None] * S
                 + jnp.einsum('bhsd,bhse->bhde', kc * jnp.exp(g_last - G), vc))
        return S_new, inter + intra

    s_fin, o = lax.scan(step, s0.astype(F32), (chunks(q), chunks(k), chunks(v), chunks(logf)))
    o = o.transpose(1, 0, 3, 2, 4).reshape(B, L, H, DV)
    return o, s_fin


def hgrn2_branch(hq, hi, hf_f, hf_b, lb_f, lb_b, norm_w, s0_f, s0_b):
    B, L, _ = hq.shape
    q = jax.nn.silu(hq.astype(F32)).reshape(B, L, HG_HEADS, HG_DK) * (HG_DK ** -0.5)
    v = hi.astype(F32).reshape(B, L, HG_HEADS, HG_DV)

    def gates(hf, lb):
        lb = lb.astype(F32).reshape(HG_HEADS, HG_DK)
        one_minus_f = (1.0 - lb) * jax.nn.sigmoid(-hf.astype(F32).reshape(B, L, HG_HEADS, HG_DK))
        logf = jnp.log1p(-jnp.minimum(one_minus_f, 1.0 - GATE_EPS))
        return one_minus_f, logf

    k_f, g_f = gates(hf_f, lb_f)
    k_b, g_b = gates(hf_b, lb_b)
    o_f, s_f = hgrn2_chunk_scan(q, k_f, v, g_f, s0_f)
    o_b, s_b = hgrn2_chunk_scan(q[:, ::-1], k_b[:, ::-1], v[:, ::-1], g_b[:, ::-1], s0_b)
    o = o_f + o_b[:, ::-1]
    o = rms_norm(o, norm_w.reshape(HG_HEADS, HG_DV))
    return o.reshape(B, L, HG_WIDTH).astype(hq.dtype), jnp.stack([s_f, s_b], axis=1)


def conv_branch(ha, hb, w, b, ln_w, ln_b):
    u = ha * jax.nn.sigmoid(hb)
    y = lax.conv_general_dilated(u, w[:, None, :].astype(u.dtype), window_strides=(1,),
                                 padding=[(CONV_TAPS // 2, CONV_TAPS // 2)],
                                 dimension_numbers=('NWC', 'WIO', 'NWC'),
                                 feature_group_count=CV_WIDTH) + b.astype(u.dtype)
    return jax.nn.silu(layer_norm(y, ln_w, ln_b))


def modulation(cond, ada_w_l, ada_b_l):
    m = jax.nn.silu(cond) @ ada_w_l + ada_b_l
    return jnp.split(m, 3, axis=-1)


def trunk_layer(x, shift, scale, gate, w_in_l, w_out_l, ln_w_l, ln_b_l, sink_l, lb_l, hg_norm_l,
                conv_w_l, conv_b_l, conv_ln_w_l, conv_ln_b_l, ctx):
    B, L, _ = x.shape
    h = x * (1 + scale) + shift
    z = h @ w_in_l
    aq, ak, av, ag, hq, hi, hff, hfb, hgate, ca, cb, cgate = jnp.split(z, SPLIT_POINTS, axis=-1)
    q = aq.reshape(B, L, ATT_HEADS, HEAD_DIM)
    k = ak.reshape(B, L, ATT_KV_HEADS, HEAD_DIM)
    v = av.reshape(B, L, ATT_KV_HEADS, HEAD_DIM)
    sink = sink_l.astype(F32).reshape(ATT_KV_HEADS, GQA_GROUP)
    if ctx is None:
        att = context_attention(q, k, v, sink)
        s0 = jnp.zeros((B, 2, HG_HEADS, HG_DK, HG_DV), F32)
    else:
        ctx_k, ctx_v, s0 = ctx
        att = latent_attention(axial_rope(q), axial_rope(k), v, ctx_k, ctx_v, sink)
    hg_out, s_fin = hgrn2_branch(hq, hi, hff, hfb, lb_l[0], lb_l[1], hg_norm_l, s0[:, 0], s0[:, 1])
    cv_out = conv_branch(ca, cb, conv_w_l, conv_b_l, conv_ln_w_l, conv_ln_b_l)
    mix = jnp.concatenate([att * jax.nn.silu(ag), hg_out * jax.nn.silu(hgate),
                           cv_out * jax.nn.silu(cgate)], axis=-1)
    out = mix @ w_out_l
    x_new = layer_norm(ALPHA * x + gate * out, ln_w_l, ln_b_l)
    return x_new, k, v, s_fin.astype(x.dtype)


def setup_inputs(seed: int = 0) -> dict:
    key = jax.random.key(seed)
    ks = jax.random.split(key, 20)

    def nrm(k, shape, s):
        return s * jax.random.normal(k, shape, F32)

    col_scales = (1.0, 1.0, BETA, 1.0, 1.0, BETA, 1.0, 1.0, 1.0, BETA, 1.0, 1.0)
    col_scale = jnp.concatenate([jnp.full((n,), s, F32) for n, s in zip(SPLITS, col_scales)])
    return {
        "x_prompt": nrm(ks[0], (BATCH, SEQ, D_MODEL), 1.0),
        "x_sample": nrm(ks[1], (DEC_BATCH, DEC_SEQ, D_MODEL), 1.0),
        "cache_k": nrm(ks[2], (DEC_BATCH, DEPTH, PAST_LEN, ATT_KV_HEADS, HEAD_DIM), 1.0),
        "cache_v": nrm(ks[3], (DEC_BATCH, DEPTH, PAST_LEN, ATT_KV_HEADS, HEAD_DIM), 1.0),
        "state_hgrn": nrm(ks[4], (DEC_BATCH, DEPTH, 2, HG_HEADS, HG_DK, HG_DV), 0.5),
        "c": nrm(ks[5], (DEC_BATCH, D_MODEL), 1.0),
        "c_ctx": nrm(ks[6], (D_MODEL,), 1.0),
        "ada_w": nrm(ks[7], (DEPTH, D_MODEL, 3 * D_MODEL), 0.5 * D_MODEL ** -0.5),
        "ada_b": nrm(ks[8], (DEPTH, 3 * D_MODEL), 0.02),
        "w_in": nrm(ks[9], (DEPTH, D_MODEL, D_IN), D_MODEL ** -0.5) * col_scale,
        "w_out": nrm(ks[10], (DEPTH, D_MIX, D_MODEL), BETA * D_MIX ** -0.5),
        "attn_sink": nrm(ks[11], (DEPTH, ATT_HEADS), 0.5),
        "hg_lower_bounds": nrm(ks[12], (2, DEPTH, HG_KW), 0.5),
        "hg_norm_w": 1.0 + nrm(ks[13], (DEPTH, HG_WIDTH), 0.02),
        "conv_w": nrm(ks[14], (DEPTH, CONV_TAPS, CV_WIDTH), CONV_TAPS ** -0.5),
        "conv_b": nrm(ks[15], (DEPTH, CV_WIDTH), 0.02),
        "conv_ln_w": 1.0 + nrm(ks[16], (DEPTH, CV_WIDTH), 0.02),
        "conv_ln_b": nrm(ks[17], (DEPTH, CV_WIDTH), 0.02),
        "ln_w": 1.0 + nrm(ks[18], (DEPTH, D_MODEL), 0.02),
        "ln_b": nrm(ks[19], (DEPTH, D_MODEL), 0.02),
    }


def reference(x_prompt, x_sample, cache_k, cache_v, state_hgrn, c, c_ctx, ada_w, ada_b, w_in, w_out,
              attn_sink, hg_lower_bounds, hg_norm_w, conv_w, conv_b, conv_ln_w, conv_ln_b, ln_w, ln_b):
    lbs = jax.nn.softmax(hg_lower_bounds.astype(F32), axis=1)
    lbs = jnp.cumsum(lbs, axis=1) - lbs[:, :1]

    y_prompt = x_prompt
    ks_, vs_, ss_ = [], [], []
    for l in range(DEPTH):
        shift, scale, gate = modulation(c_ctx, ada_w[l], ada_b[l])
        y_prompt, k_l, v_l, s_l = trunk_layer(
            y_prompt, shift, scale, gate, w_in[l], w_out[l], ln_w[l], ln_b[l], attn_sink[l], lbs[:, l],
            hg_norm_w[l], conv_w[l], conv_b[l], conv_ln_w[l], conv_ln_b[l], None)
        ks_.append(k_l)
        vs_.append(v_l)
        ss_.append(s_l)
    new_cache_k = jnp.stack(ks_, axis=1)
    new_cache_v = jnp.stack(vs_, axis=1)
    new_state_hgrn = jnp.stack(ss_, axis=1)

    y_sample = x_sample
    for l in range(DEPTH):
        shift, scale, gate = modulation(c, ada_w[l], ada_b[l])
        y_sample, _, _, _ = trunk_layer(
            y_sample, shift[:, None, :], scale[:, None, :], gate[:, None, :], w_in[l], w_out[l],
            ln_w[l], ln_b[l], attn_sink[l], lbs[:, l], hg_norm_w[l], conv_w[l], conv_b[l],
            conv_ln_w[l], conv_ln_b[l], (cache_k[:, l], cache_v[:, l], state_hgrn[:, l]))

    return (y_prompt, y_sample, new_cache_k, new_cache_v, new_state_hgrn)
```

```cpp
#include <hip/hip_runtime.h>
#include <hip/hip_cooperative_groups.h>
#include <cstdio>
#include <cstdint>
namespace cg = cooperative_groups;

constexpr int D_MODEL = 2048, DIN = 6656, NCTX = 8192, NLAT = 4096, MTOK = 12288, DEPTH = 2;
constexpr int C_AQ = 0, C_AK = 1024, C_AV = 1280, C_AG = 1536, C_HQ = 2560, C_HI = 3072, C_HFF = 3584, C_HFB = 4096, C_HG = 4608, C_CA = 5120, C_CB = 5632, C_CG = 6144;
constexpr float ALPHA_DN = 1.4142135623730951f;
constexpr size_t OUT_YP = 0, OUT_YS = 16777216, OUT_CK = 25165824, OUT_CV = 29360128, OUT_ST = 33554432, OUT_TOTAL = 41943040;
namespace pg8 {
#define PG8_LAS __attribute__((address_space(3)))
typedef unsigned short bf16_t;
typedef short bf16x8 __attribute__((ext_vector_type(8)));
typedef float f32x4 __attribute__((ext_vector_type(4)));
typedef unsigned u32x4 __attribute__((ext_vector_type(4)));
constexpr int BM = 256, BK = 64, HALF = 128, HTB = HALF * BK * 2  , STAGE_BYTES = 8 * HTB, NXCD = 8, WGM = 8;

__host__ __device__ __forceinline__ int lds_byte(int r, int c) { const int st = (r >> 4) * 2 + (c >> 5), rr = r & 15, cc = c & 31, ob = rr * 64 + cc * 2; return st * 1024 + (ob ^ (((ob >> 9) & 1) << 5)); }
__host__ __device__ __forceinline__ void stage_rc(int b, int& R, int& C) { const int st = b / 1024, sb = b % 1024, swz = sb ^ (((sb >> 9) & 1) << 5); R = (st >> 1) * 16 + swz / 64; C = (st & 1) * 32 + (swz % 64) / 2; }
__host__ __device__ __forceinline__ int perm32(int rho) { const int n = rho >> 4, i = rho & 15; return 8 * (i >> 2) + 4 * n + (i & 3); }

struct Unit { int pm, pn; };
struct Gemm { const bf16_t* A; const bf16_t* Bt; int M, N, K; };

struct StaticOrder {
    int nM, nN, nwg, G, c;
    __host__ __device__ void init(int M, int N, int G_, int c_) { nM = M / BM; nN = N / BM; nwg = nM * nN; G = G_; c = c_; }
    __host__ __device__ bool next(int i, Unit& u) const {
        const long L = (long)i * G + c; if (L >= nwg) return false;
        int wgid = (int)L; { const int q = nwg / NXCD, r = nwg % NXCD, xcd = wgid % NXCD, off = wgid / NXCD; wgid = (xcd < r ? xcd * (q + 1) : r * (q + 1) + (xcd - r) * q) + off; }
        const int nig = WGM * nN, gid = wgid / nig, fm = gid * WGM, gsz = (nM - fm) < WGM ? (nM - fm) : WGM;
        u.pm = fm + ((wgid % nig) % gsz); u.pn = (wgid % nig) / gsz; return true;
    }
    __device__ __forceinline__ void a_ready(const Unit&) const {}
    __device__ __forceinline__ void done(const Unit&) const {}
};

__device__ __forceinline__ unsigned cvt_pk_bf16(float lo, float hi) { unsigned r; asm volatile("v_cvt_pk_bf16_f32 %0, %1, %2" : "=v"(r) : "v"(lo), "v"(hi)); return r; }
typedef float f32x2 __attribute__((ext_vector_type(2)));

struct EpiZ {
    static constexpr bool PERM = true, AFTER_DRAIN = false;
    bf16_t* Z; float* ck; float* cv; int layer;
    __device__ __forceinline__ void operator()(const f32x4 (&acc)[2][2][4][2], const Unit& u, int wr, int wc, int fr, int fq) const {
        const int row0 = u.pm * BM + wr * 64 + fr; const int col0 = u.pn * BM + wc * 32 + 8 * fq;
#pragma unroll
        for (int ai = 0; ai < 2; ++ai)
#pragma unroll
            for (int m = 0; m < 4; ++m) { bf16_t* rowp = Z + (size_t)(row0 + ai * HALF + m * 16) * DIN + col0;
#pragma unroll
                for (int bj = 0; bj < 2; ++bj) { const f32x4 v0 = acc[ai][bj][m][0], v1 = acc[ai][bj][m][1];
                    u32x4 w; w.x = cvt_pk_bf16(v0[0], v0[1]); w.y = cvt_pk_bf16(v0[2], v0[3]); w.z = cvt_pk_bf16(v1[0], v1[1]); w.w = cvt_pk_bf16(v1[2], v1[3]);
                    *(u32x4*)(rowp + bj * HALF) = w; } }
        if ((u.pn == 4 || u.pn == 5) && u.pm < 32) {
            float* base = (u.pn == 4) ? ck : cv;
#pragma unroll
            for (int ai = 0; ai < 2; ++ai)
#pragma unroll
                for (int m = 0; m < 4; ++m) { const int row = row0 + ai * HALF + m * 16; const int b = row >> 8, s = row & 255;
                    float* p = base + ((size_t)((b * 2 + layer) * 256 + s)) * 256 + (wc * 32 + 8 * fq);
#pragma unroll
                    for (int bj = 0; bj < 2; ++bj) { *(f32x4*)(p + bj * HALF) = acc[ai][bj][m][0]; *(f32x4*)(p + bj * HALF + 4) = acc[ai][bj][m][1]; } }
        }
    }
};
struct EpiV {
    static constexpr bool PERM = false, AFTER_DRAIN = false;
    const float* xp; const float* xs; float* V; const float* gate;
    __device__ __forceinline__ void operator()(const f32x4 (&acc)[2][2][4][2], const Unit& u, int wr, int wc, int fr, int fq) const {
        const int row0 = u.pm * BM + wr * 64 + fr; const int col0 = u.pn * BM + wc * 32 + 4 * fq;
        const int cond = (u.pm < 32) ? 0 : 1 + ((u.pm - 32) >> 3);
        const float* g = gate + cond * 6144 + col0;
        f32x4 gv[2][2];
#pragma unroll
        for (int bj = 0; bj < 2; ++bj)
#pragma unroll
            for (int n = 0; n < 2; ++n) gv[bj][n] = *(const f32x4*)(g + bj * HALF + n * 16);
#pragma unroll
        for (int ai = 0; ai < 2; ++ai)
#pragma unroll
            for (int m = 0; m < 4; ++m) { const int row = row0 + ai * HALF + m * 16;
                const float* xr = ((row < NCTX) ? xp + (size_t)row * D_MODEL : xs + (size_t)(row - NCTX) * D_MODEL) + col0;
                float* vr = V + (size_t)row * D_MODEL + col0;
#pragma unroll
                for (int bj = 0; bj < 2; ++bj)
#pragma unroll
                    for (int n = 0; n < 2; ++n) { const f32x4 xv = *(const f32x4*)(xr + bj * HALF + n * 16);
                        *(f32x4*)(vr + bj * HALF + n * 16) = xv * ALPHA_DN + gv[bj][n] * acc[ai][bj][m][n]; }
                asm volatile("" ::: "memory"); }
    }
};
template <class Epi, class Sched, bool ALIGN_EPI = false, bool SP2 = false>
__device__ __forceinline__ void gemm_phase(PG8_LAS unsigned char* lds, const Gemm g, const Sched& S, const Epi& E) {
    int tid_l = threadIdx.x; asm volatile("" : "+v"(tid_l));
    const int tid = tid_l, wid = __builtin_amdgcn_readfirstlane(tid >> 6), lane = tid & 63, wr = wid >> 2, wc = wid & 3, fr = lane & 15, fq = lane >> 4;
    const int K = g.K, nt = K / BK;
    unsigned voffA[2], voffB[2];
#pragma unroll
    for (int i = 0; i < 2; ++i) { int R, C; stage_rc(tid * 16 + i * 8192, R, C); const int Rb = Epi::PERM ? ((R & ~31) + perm32(R & 31)) : R;
        voffA[i] = (unsigned)(R * K + C) * 2u; voffB[i] = (unsigned)(Rb * K + C) * 2u; }
    const size_t kstep = (size_t)(BK * 2);
    const size_t hstep = (size_t)HALF * K * 2;
    const size_t tstep = 2 * hstep;
    const unsigned ldsw = (unsigned)wid * 1024u;
    const int aoff = lds_byte(wr * 64 + fr, fq * 8), boff = lds_byte(wc * 32 + fr, fq * 8);
#define PG8_SA(b, h) (((b) * 2 + (h)) * HTB)
#define PG8_SB(b, h) ((4 + (b) * 2 + (h)) * HTB)
#define PG8_STAGE(bufoff, gbase, voff) do { _Pragma("unroll") for (int _i = 0; _i < 2; ++_i) \
        __builtin_amdgcn_global_load_lds((const unsigned*)((const char*)(gbase) + (voff)[_i]), (PG8_LAS unsigned*)(lds + (bufoff) + ldsw + _i * 8192), 16, 0, 0); } while (0)
#define PG8_LDA(dst, b, h) do { _Pragma("unroll") for (int m = 0; m < 4; ++m) _Pragma("unroll") for (int k = 0; k < 2; ++k) dst[m][k] = *(const PG8_LAS bf16x8*)(lds + PG8_SA(b, h) + aoff + m * 2048 + k * 1024); } while (0)
#define PG8_LDB(dst, b, h) do { _Pragma("unroll") for (int n = 0; n < 2; ++n) _Pragma("unroll") for (int k = 0; k < 2; ++k) dst[n][k] = *(const PG8_LAS bf16x8*)(lds + PG8_SB(b, h) + boff + n * 2048 + k * 1024); } while (0)
#define PG8_MMA(ai, bj, At, Bt) do { __builtin_amdgcn_s_setprio(1); _Pragma("unroll") for (int m = 0; m < 4; ++m) _Pragma("unroll") for (int n = 0; n < 2; ++n) _Pragma("unroll") for (int k = 0; k < 2; ++k) \
        acc[ai][bj][m][n] = __builtin_amdgcn_mfma_f32_16x16x32_bf16(Bt[n][k], At[m][k], acc[ai][bj][m][n], 0, 0, 0); __builtin_amdgcn_s_setprio(0); } while (0)
#define PG8_WAIT_V(n) asm volatile("s_waitcnt vmcnt(" #n ")" ::: "memory")
#define PG8_WAIT_L(n) asm volatile("s_waitcnt lgkmcnt(" #n ")" ::: "memory")
#define PG8_BAR __builtin_amdgcn_s_barrier()
#define PG8_SCHED __builtin_amdgcn_sched_barrier(0)
    Unit cur, nxt; int ui = 0;
    if (!S.next(0, cur)) return;
    f32x4 acc[2][2][4][2];
#pragma unroll
    for (int a = 0; a < 2; ++a)
#pragma unroll
        for (int b = 0; b < 2; ++b)
#pragma unroll
            for (int m = 0; m < 4; ++m)
#pragma unroll
                for (int n = 0; n < 2; ++n) acc[a][b][m][n] = (f32x4){0.f, 0.f, 0.f, 0.f};
    bf16x8 At[4][2], B0[2][2], B1[2][2];
    const char* cA = (const char*)g.A + (size_t)cur.pm * tstep; const char* cB = (const char*)g.Bt + (size_t)cur.pn * tstep;
    S.a_ready(cur);
    if constexpr (SP2) {
        PG8_STAGE(PG8_SB(0, 0), cB, voffB); PG8_STAGE(PG8_SB(0, 1), cB + hstep, voffB); PG8_STAGE(PG8_SA(0, 0), cA, voffA); PG8_STAGE(PG8_SA(0, 1), cA + hstep, voffA);
        if (wr == 1) PG8_BAR;
        PG8_WAIT_V(2); PG8_BAR;
        PG8_STAGE(PG8_SB(1, 0), cB + kstep, voffB); PG8_STAGE(PG8_SA(1, 0), cA + kstep, voffA); PG8_STAGE(PG8_SB(1, 1), cB + hstep + kstep, voffB);
        PG8_WAIT_V(6); PG8_BAR;
    } else {
        PG8_STAGE(PG8_SB(0, 0), cB, voffB); PG8_STAGE(PG8_SA(0, 0), cA, voffA); PG8_STAGE(PG8_SB(0, 1), cB + hstep, voffB); PG8_STAGE(PG8_SA(0, 1), cA + hstep, voffA);
        if (wr == 1) PG8_BAR;
        PG8_WAIT_V(4); PG8_BAR;
        PG8_STAGE(PG8_SB(1, 0), cB + kstep, voffB); PG8_STAGE(PG8_SA(1, 0), cA + kstep, voffA); PG8_STAGE(PG8_SB(1, 1), cB + hstep + kstep, voffB);
        PG8_WAIT_V(6); PG8_BAR;
    }
    for (;;) {
        const bool has_next = S.next(ui + 1, nxt);
        const char* nA = has_next ? (const char*)g.A + (size_t)nxt.pm * tstep : cA; const char* nB = has_next ? (const char*)g.Bt + (size_t)nxt.pn * tstep : cB;
        for (int t = 0; t < nt; t += 2) {
            const bool last = (t == nt - 2);
            const char* a1 = cA + (size_t)(t + 1) * kstep;
            const char* a2 = last ? nA : cA + (size_t)(t + 2) * kstep; const char* b2 = last ? nB : cB + (size_t)(t + 2) * kstep;
            const char* a3 = a2 + kstep; const char* b3 = b2 + kstep;
            if (last && has_next) S.a_ready(nxt);
            if constexpr (SP2) {
            PG8_LDB(B0, 0, 0); PG8_LDB(B1, 0, 1); PG8_SCHED; PG8_LDA(At, 0, 0); PG8_STAGE(PG8_SA(1, 1), a1 + hstep, voffA);
            PG8_WAIT_V(8); PG8_WAIT_L(0); PG8_BAR; PG8_MMA(0, 0, At, B0); PG8_MMA(0, 1, At, B1); PG8_BAR; PG8_SCHED;
            PG8_LDA(At, 0, 1); PG8_STAGE(PG8_SB(0, 0), b2, voffB); PG8_STAGE(PG8_SB(0, 1), b2 + hstep, voffB); PG8_STAGE(PG8_SA(0, 0), a2, voffA);
            PG8_WAIT_V(8); PG8_WAIT_L(0); PG8_BAR; PG8_MMA(1, 0, At, B0); PG8_MMA(1, 1, At, B1); PG8_BAR; PG8_SCHED;
            PG8_LDB(B0, 1, 0); PG8_LDB(B1, 1, 1); PG8_SCHED; PG8_LDA(At, 1, 0); PG8_STAGE(PG8_SA(0, 1), a2 + hstep, voffA);
            PG8_WAIT_V(8); PG8_WAIT_L(0); PG8_BAR; PG8_MMA(0, 0, At, B0); PG8_MMA(0, 1, At, B1); PG8_BAR; PG8_SCHED;
            PG8_LDA(At, 1, 1); PG8_STAGE(PG8_SB(1, 0), b3, voffB); PG8_STAGE(PG8_SB(1, 1), b3 + hstep, voffB); PG8_STAGE(PG8_SA(1, 0), a3, voffA);
            PG8_WAIT_V(8); PG8_WAIT_L(0); PG8_BAR; PG8_MMA(1, 0, At, B0); PG8_MMA(1, 1, At, B1); PG8_BAR; PG8_SCHED;
            } else {
            PG8_LDB(B0, 0, 0); PG8_SCHED; PG8_LDA(At, 0, 0); PG8_STAGE(PG8_SA(1, 1), a1 + hstep, voffA);
            PG8_WAIT_L(8); PG8_BAR; PG8_WAIT_L(0); PG8_MMA(0, 0, At, B0); PG8_BAR; PG8_SCHED;
            PG8_LDB(B1, 0, 1); PG8_STAGE(PG8_SB(0, 0), b2, voffB);
            PG8_BAR; PG8_WAIT_L(0); PG8_MMA(0, 1, At, B1); PG8_BAR;
            PG8_LDA(At, 0, 1); PG8_STAGE(PG8_SA(0, 0), a2, voffA);
            PG8_BAR; PG8_WAIT_L(0); PG8_MMA(1, 0, At, B0); PG8_BAR; PG8_SCHED;
            PG8_STAGE(PG8_SB(0, 1), b2 + hstep, voffB);
            PG8_WAIT_V(6); PG8_BAR; PG8_MMA(1, 1, At, B1); PG8_BAR;
            PG8_LDB(B0, 1, 0); PG8_SCHED; PG8_LDA(At, 1, 0); PG8_STAGE(PG8_SA(0, 1), a2 + hstep, voffA);
            PG8_WAIT_L(8); PG8_BAR; PG8_WAIT_L(0); PG8_MMA(0, 0, At, B0); PG8_BAR; PG8_SCHED;
            PG8_LDB(B1, 1, 1); PG8_STAGE(PG8_SB(1, 0), b3, voffB);
            PG8_BAR; PG8_WAIT_L(0); PG8_MMA(0, 1, At, B1); PG8_BAR;
            PG8_LDA(At, 1, 1); PG8_STAGE(PG8_SA(1, 0), a3, voffA);
            PG8_BAR; PG8_WAIT_L(0); PG8_MMA(1, 0, At, B0); PG8_BAR; PG8_SCHED;
            PG8_STAGE(PG8_SB(1, 1), b3 + hstep, voffB);
            PG8_WAIT_V(6); PG8_BAR; PG8_MMA(1, 1, At, B1); PG8_BAR;
            }
        }
        if constexpr (ALIGN_EPI) { if (wr == 0) PG8_BAR; }
        if constexpr (!Epi::AFTER_DRAIN) { E(acc, cur, wr, wc, fr, fq); S.done(cur); }
        if (!has_next) break;
#pragma unroll
        for (int a = 0; a < 2; ++a)
#pragma unroll
            for (int b = 0; b < 2; ++b)
#pragma unroll
                for (int m = 0; m < 4; ++m)
#pragma unroll
                    for (int n = 0; n < 2; ++n) acc[a][b][m][n] = (f32x4){0.f, 0.f, 0.f, 0.f};
        cur = nxt; cA = nA; cB = nB; ++ui;
        if constexpr (ALIGN_EPI) { if (wr == 1) PG8_BAR; }
    }
    PG8_WAIT_V(0);
    if constexpr (!ALIGN_EPI) { if (wr == 0) PG8_BAR; }
    PG8_BAR;
    if constexpr (Epi::AFTER_DRAIN) { E.fused(acc, cur, wr, wc, fr, fq, lds, wid, lane); S.done(cur); }
#undef PG8_SA
#undef PG8_SB
#undef PG8_STAGE
#undef PG8_LDA
#undef PG8_LDB
#undef PG8_MMA
#undef PG8_WAIT_V
#undef PG8_WAIT_L
#undef PG8_BAR
#undef PG8_SCHED
}
}

constexpr size_t MiB = 1u << 20;
constexpr size_t WS_CTL = 0, CTL_ZERO_BYTES = 4096;
constexpr size_t WS_MOD = 1 * MiB;
constexpr size_t WS_CS = 1 * MiB + 192 * 1024;
constexpr size_t WS_DLOG = 1 * MiB + 256 * 1024;
constexpr size_t WS_WTOUT = 2 * MiB;
constexpr size_t WS_WTIN = 18 * MiB;
constexpr size_t WS_H = 44 * MiB;
constexpr size_t WS_Z = 92 * MiB;
constexpr size_t WS_U = 248 * MiB;
constexpr size_t WS_OL = 264 * MiB;
constexpr size_t WS_END = 312 * MiB;
constexpr int LDS_BYTES = 147456;
constexpr int NWAVES = 8, NTHREADS = 512;

#define LAS __attribute__((address_space(3)))
typedef unsigned short bf16;
typedef float f32x4 __attribute__((ext_vector_type(4)));
typedef float f32x16 __attribute__((ext_vector_type(16)));
typedef unsigned u32x4 __attribute__((ext_vector_type(4)));
typedef unsigned u32x2 __attribute__((ext_vector_type(2)));
typedef short bf16x8 __attribute__((ext_vector_type(8)));

__device__ __forceinline__ float bf2f(unsigned short u) { return __builtin_bit_cast(float, (unsigned)u << 16); }
__device__ __forceinline__ float bflo(unsigned u) { return __builtin_bit_cast(float, u << 16); }
__device__ __forceinline__ float bfhi(unsigned u) { return __builtin_bit_cast(float, u & 0xffff0000u); }
__device__ __forceinline__ unsigned f2bf(float f) { unsigned u = __builtin_bit_cast(unsigned, f); return (u + 0x7fffu + ((u >> 16) & 1u)) >> 16; }
__device__ __forceinline__ unsigned pk2(float lo, float hi) { return f2bf(lo) | (f2bf(hi) << 16); }
__device__ __forceinline__ float sigmoidf_(float x) { return 1.0f / (1.0f + __expf(-x)); }
__device__ __forceinline__ float siluf_(float x) { return x / (1.0f + __expf(-x)); }
__device__ __forceinline__ float wave_sum(float v) {
#pragma unroll
    for (int o = 1; o < 64; o <<= 1) v += __shfl_xor(v, o);
    return v;
}

struct Params {
    const float* in[20];
    float* out; unsigned char* ws;
};

__device__ __forceinline__ int next_unit(unsigned* ctr, volatile LAS unsigned* slot, int tid) {
    __syncthreads();
    if (tid == 0) *slot = __hip_atomic_fetch_add(ctr, 1u, __ATOMIC_RELAXED, __HIP_MEMORY_SCOPE_AGENT);
    __syncthreads();
    return (int)*slot;
}

__device__ __forceinline__ void transpose_item(const float* W, int K, int N, bf16* WT, LAS float* scr, int item, int lane) {
    const int nblk = N / 32, kb = item / nblk, nb = item % nblk, k0 = 64 * kb, n0 = 32 * nb;
#pragma unroll 8
    for (int i = 0; i < 32; ++i) { const int kk = 2 * i + (lane >> 5); scr[kk * 33 + (lane & 31)] = W[(size_t)(k0 + kk) * N + n0 + (lane & 31)]; }
    asm volatile("s_waitcnt lgkmcnt(0)" ::: "memory");
    const int c = lane & 7;
#pragma unroll
    for (int j = 0; j < 4; ++j) { const int n = (lane >> 3) + 8 * j; const LAS float* s = scr + (8 * c) * 33 + n;
        u32x4 o; o.x = pk2(s[0 * 33], s[1 * 33]); o.y = pk2(s[2 * 33], s[3 * 33]); o.z = pk2(s[4 * 33], s[5 * 33]); o.w = pk2(s[6 * 33], s[7 * 33]);
        *(u32x4*)(WT + (size_t)(n0 + n) * K + k0 + 8 * c) = o; }
    asm volatile("s_waitcnt lgkmcnt(0)" ::: "memory");
}

__device__ __forceinline__ void mod_unit(const Params& P, LAS float* lds, int l, int nc, int tid) {
    const float* c = P.in[5]; const float* cctx = P.in[6]; const float* aw = P.in[7] + (size_t)l * 2048 * 6144; const float* ab = P.in[8] + l * 6144;
    LAS float* sc = lds;
    LAS float* red = lds + 3 * 2048;
    for (int i = tid; i < 3 * 2048; i += NTHREADS) { const int j = i >> 11, k = i & 2047; const float v = (j == 0) ? cctx[k] : c[(j - 1) * 2048 + k]; sc[i] = siluf_(v); }
    __syncthreads();
    const int tn = tid & 7, tk = tid >> 3, n0 = nc * 32 + 4 * tn;
    float a[3][4] = {};
    for (int kk = 0; kk < 32; ++kk) { const int k = tk * 32 + kk; const f32x4 w = *(const f32x4*)(aw + (size_t)k * 6144 + n0);
#pragma unroll
        for (int j = 0; j < 3; ++j) { const float s = sc[j * 2048 + k]; a[j][0] += s * w[0]; a[j][1] += s * w[1]; a[j][2] += s * w[2]; a[j][3] += s * w[3]; } }
#pragma unroll
    for (int j = 0; j < 3; ++j)
#pragma unroll
        for (int e = 0; e < 4; ++e) red[(tk * 8 + tn) * 12 + j * 4 + e] = a[j][e];
    __syncthreads();
    if (tid < 96) { const int tn2 = tid / 12, je = tid % 12; float s = 0.f; for (int t = 0; t < 64; ++t) s += red[(t * 8 + tn2) * 12 + je];
        const int j = je >> 2, e = je & 3, n = nc * 32 + 4 * tn2 + e;
        ((float*)(P.ws + WS_MOD))[(l * 3 + j) * 6144 + n] = s + ab[n]; }
    __syncthreads();
}

__device__ __forceinline__ void hprep_row(const float* xrow, const float* mod  , bf16* hrow, int lane) {
#pragma unroll
    for (int j = 0; j < 8; ++j) { const int c = 4 * lane + 256 * j; const f32x4 x = *(const f32x4*)(xrow + c), sh = *(const f32x4*)(mod + c), sc = *(const f32x4*)(mod + 2048 + c);
        const f32x4 h = x * (sc + 1.0f) + sh; u32x2 o; o.x = pk2(h[0], h[1]); o.y = pk2(h[2], h[3]); *(u32x2*)(hrow + c) = o; }
}
__device__ __forceinline__ void ln_row(float* vrow, const float* w, const float* b, const float* modn, bf16* hrow, int lane) {
    f32x4 v[8]; float s = 0.f;
#pragma unroll
    for (int j = 0; j < 8; ++j) { v[j] = *(const f32x4*)(vrow + 4 * lane + 256 * j); s += (v[j][0] + v[j][1]) + (v[j][2] + v[j][3]); }
    const float mean = wave_sum(s) * (1.0f / 2048.0f); float q = 0.f;
#pragma unroll
    for (int j = 0; j < 8; ++j) { v[j] = v[j] - mean; q += (v[j][0] * v[j][0] + v[j][1] * v[j][1]) + (v[j][2] * v[j][2] + v[j][3] * v[j][3]); }
    const float rstd = 1.0f / sqrtf(wave_sum(q) * (1.0f / 2048.0f) + 1e-5f);
#pragma unroll
    for (int j = 0; j < 8; ++j) { const int c = 4 * lane + 256 * j; const f32x4 y = v[j] * rstd * *(const f32x4*)(w + c) + *(const f32x4*)(b + c);
        *(f32x4*)(vrow + c) = y;
        if (hrow) { const f32x4 sh = *(const f32x4*)(modn + c), sc = *(const f32x4*)(modn + 2048 + c); const f32x4 h = y * (sc + 1.0f) + sh;
            u32x2 o; o.x = pk2(h[0], h[1]); o.y = pk2(h[2], h[3]); *(u32x2*)(hrow + c) = o; } }
}

__device__ __forceinline__ void conv_unit(const Params& P, LAS float* lds, int l, int unit, int tid) {
    const int lane = tid & 63, wave = tid >> 6;
    const bf16* Z = (const bf16*)(P.ws + WS_Z); bf16* MIX = (bf16*)(P.ws + WS_H);
    const int t0 = unit * 16;
    int s0, s1; if (t0 < NCTX) { s0 = t0 & ~255; s1 = s0 + 256; } else { s0 = NCTX + ((t0 - NCTX) & ~2047); s1 = s0 + 2048; }
    const int c = tid;
    float u[46];
#pragma unroll
    for (int r = 0; r < 46; ++r) { const int row = t0 - 15 + r; float val = 0.f;
        if (row >= s0 && row < s1) { const float a = bf2f(Z[(size_t)row * DIN + C_CA + c]), b = bf2f(Z[(size_t)row * DIN + C_CB + c]); val = a * sigmoidf_(b); }
        u[r] = val; }
    float acc[16]; const float bias = P.in[15][l * 512 + c];
#pragma unroll
    for (int i = 0; i < 16; ++i) acc[i] = bias;
    const float* cw = P.in[14] + (size_t)l * 31 * 512 + c;
#pragma unroll
    for (int j = 0; j < 31; ++j) { const float w = cw[j * 512];
#pragma unroll
        for (int i = 0; i < 16; ++i) acc[i] += u[i + j] * w; }
    LAS float* yb = lds;
#pragma unroll
    for (int i = 0; i < 16; ++i) yb[i * 512 + c] = acc[i];
    __syncthreads();
    const float* lw = P.in[16] + l * 512; const float* lb = P.in[17] + l * 512;
#pragma unroll
    for (int tt = 0; tt < 2; ++tt) { const int ti = wave * 2 + tt, row = t0 + ti;
        f32x4 a = *(const LAS f32x4*)(yb + ti * 512 + 8 * lane), b = *(const LAS f32x4*)(yb + ti * 512 + 8 * lane + 4);
        float s = (a[0] + a[1]) + (a[2] + a[3]) + (b[0] + b[1]) + (b[2] + b[3]);
        const float mean = wave_sum(s) * (1.0f / 512.0f); a = a - mean; b = b - mean;
        float q = (a[0] * a[0] + a[1] * a[1]) + (a[2] * a[2] + a[3] * a[3]) + (b[0] * b[0] + b[1] * b[1]) + (b[2] * b[2] + b[3] * b[3]);
        const float rstd = 1.0f / sqrtf(wave_sum(q) * (1.0f / 512.0f) + 1e-5f);
        const f32x4 w0 = *(const f32x4*)(lw + 8 * lane), w1 = *(const f32x4*)(lw + 8 * lane + 4), b0 = *(const f32x4*)(lb + 8 * lane), b1 = *(const f32x4*)(lb + 8 * lane + 4);
        a = a * rstd * w0 + b0; b = b * rstd * w1 + b1;
        const u32x4 g = *(const u32x4*)(Z + (size_t)row * DIN + C_CG + 8 * lane);
        float o[8];
        o[0] = siluf_(a[0]) * siluf_(bflo(g.x)); o[1] = siluf_(a[1]) * siluf_(bfhi(g.x)); o[2] = siluf_(a[2]) * siluf_(bflo(g.y)); o[3] = siluf_(a[3]) * siluf_(bfhi(g.y));
        o[4] = siluf_(b[0]) * siluf_(bflo(g.z)); o[5] = siluf_(b[1]) * siluf_(bfhi(g.z)); o[6] = siluf_(b[2]) * siluf_(bflo(g.w)); o[7] = siluf_(b[3]) * siluf_(bfhi(g.w));
        u32x4 w; w.x = pk2(o[0], o[1]); w.y = pk2(o[2], o[3]); w.z = pk2(o[4], o[5]); w.w = pk2(o[6], o[7]);
        *(u32x4*)(MIX + (size_t)row * D_MODEL + 1536 + 8 * lane) = w; }
}

typedef short v4i16_t __attribute__((ext_vector_type(4)));
#define SBAR __builtin_amdgcn_sched_barrier(0);
#define R0(i) (((i) & 3) + 8 * ((i) >> 2))
constexpr float ATT_C2 = 0.08838834764831845f * 1.4426950408889634f;
constexpr float LOG2E = 1.4426950408889634f;
constexpr int KROW = 272, VROW = 320, ATT_V_OFF = 64 * KROW;

__device__ __forceinline__ void rope8(bf16x8& a, bf16x8& b, const float* cs) {
#pragma unroll
    for (int j = 0; j < 8; ++j) { const float x1 = bf2f((unsigned short)a[j]), x2 = bf2f((unsigned short)b[j]), c = cs[2 * j], s = cs[2 * j + 1];
        a[j] = (short)f2bf(x1 * c - x2 * s); b[j] = (short)f2bf(x2 * c + x1 * s); }
}
__device__ __forceinline__ bf16x8 cvt8(const float* p) {
    const f32x4 a = *(const f32x4*)p, b = *(const f32x4*)(p + 4); bf16x8 r;
    r[0] = (short)f2bf(a[0]); r[1] = (short)f2bf(a[1]); r[2] = (short)f2bf(a[2]); r[3] = (short)f2bf(a[3]);
    r[4] = (short)f2bf(b[0]); r[5] = (short)f2bf(b[1]); r[6] = (short)f2bf(b[2]); r[7] = (short)f2bf(b[3]); return r;
}

__device__ __forceinline__ void attn_unit(const Params& P, LAS unsigned char* lds, int l, int kind, int idx, int tid) {
    const int lane = tid & 63, wave = __builtin_amdgcn_readfirstlane(tid >> 6), r32 = lane & 31, hh = lane >> 5;
    const bf16* Z = (const bf16*)(P.ws + WS_Z); bf16* MIX = (bf16*)(P.ws + WS_H); const float* CS = (const float*)(P.ws + WS_CS);
    int b, h, qpos0, grow0, kpos0, klrow0, nloc, ncache;
    if (kind == 0) { b = idx >> 3; h = idx & 7; qpos0 = 0; grow0 = b * 256; kpos0 = 0; klrow0 = b * 256; nloc = 4; ncache = 0; }
    else { const int qb = idx & 7; h = (idx >> 3) & 7; b = idx >> 6; qpos0 = qb * 256; grow0 = NCTX + b * 2048 + qpos0;
        kpos0 = qpos0 - 128 < 0 ? 0 : qpos0 - 128; const int kend = qpos0 + 384 > 2048 ? 2048 : qpos0 + 384; nloc = (kend - kpos0) >> 6; klrow0 = NCTX + b * 2048 + kpos0; ncache = 4; }
    const bool lat = (kind == 1);
    const int kv = h >> 2;
    const int qrow = grow0 + 32 * wave + r32, qpos = qpos0 + 32 * wave + r32, qw0 = qpos0 + 32 * wave;
    bf16x8 qf[8];
    { const bf16* qp = Z + (size_t)qrow * DIN + C_AQ + h * 128 + 8 * hh;
#pragma unroll
      for (int s = 0; s < 8; ++s) qf[s] = *(const bf16x8*)(qp + 16 * s);
      if (lat) { const float* c0 = CS + ((qpos >> 6) * 32 + 8 * hh) * 2; const float* c1 = CS + ((qpos & 63) * 32 + 8 * hh) * 2;
          rope8(qf[0], qf[2], c0); rope8(qf[1], qf[3], c0 + 32); rope8(qf[4], qf[6], c1); rope8(qf[5], qf[7], c1 + 32); } }
    f32x16 O[4];
#pragma unroll
    for (int d = 0; d < 4; ++d)
#pragma unroll
        for (int i = 0; i < 16; ++i) O[d][i] = 0.f;
    float m = P.in[11][l * 8 + h] * LOG2E, lsum = (hh == 0) ? 1.0f : 0.0f;
    const int skey = tid >> 3, cp = tid & 7, c1 = (cp >> 2) * 8 + (cp & 3), sd0 = 8 * c1;
    const int ntiles = nloc + ncache;
    for (int ti = 0; ti < ntiles; ++ti) {
        __syncthreads();
        {
            bf16x8 k1, k2, v1, v2;
            if (ti < nloc) {
                const int krow = klrow0 + 64 * ti + skey; const bf16* kp = Z + (size_t)krow * DIN + C_AK + kv * 128 + sd0; const bf16* vp = Z + (size_t)krow * DIN + C_AV + kv * 128 + sd0;
                k1 = *(const bf16x8*)kp; k2 = *(const bf16x8*)(kp + 32); v1 = *(const bf16x8*)vp; v2 = *(const bf16x8*)(vp + 32);
                if (lat) { const int kpos = kpos0 + 64 * ti + skey; const int pos = (cp < 4) ? (kpos >> 6) : (kpos & 63); rope8(k1, k2, CS + (pos * 32 + 8 * (cp & 3)) * 2); }
            } else {
                const int key = 64 * (ti - nloc) + skey; const size_t off = ((size_t)((b * 2 + l) * 256 + key) * 2 + kv) * 128 + sd0;
                k1 = cvt8(P.in[2] + off); k2 = cvt8(P.in[2] + off + 32); v1 = cvt8(P.in[3] + off); v2 = cvt8(P.in[3] + off + 32);
            }
            *(LAS bf16x8*)(lds + skey * KROW + sd0 * 2) = k1; *(LAS bf16x8*)(lds + skey * KROW + sd0 * 2 + 64) = k2;
            *(LAS bf16x8*)(lds + ATT_V_OFF + skey * VROW + sd0 * 2) = v1; *(LAS bf16x8*)(lds + ATT_V_OFF + skey * VROW + sd0 * 2 + 64) = v2;
        }
        __syncthreads();
        const bool local = lat && (ti < nloc);
        const int tk0 = kpos0 + 64 * ti;
        bool skip = false;
        if (local) skip = (tk0 > qw0 + 31 + 128) || (tk0 + 63 < qw0 - 128);
        if (!skip) {
            f32x16 p0, p1;
#pragma unroll
            for (int i = 0; i < 16; ++i) { p0[i] = 0.f; p1[i] = 0.f; }
            const LAS unsigned char* kb = lds + r32 * KROW + 16 * hh;
#pragma unroll
            for (int s = 0; s < 8; ++s) { const bf16x8 kf0 = *(const LAS bf16x8*)(kb + 32 * s), kf1 = *(const LAS bf16x8*)(kb + 32 * KROW + 32 * s);
                p0 = __builtin_amdgcn_mfma_f32_32x32x16_bf16(kf0, qf[s], p0, 0, 0, 0); p1 = __builtin_amdgcn_mfma_f32_32x32x16_bf16(kf1, qf[s], p1, 0, 0, 0); }
            float mx = -1e30f;
#pragma unroll
            for (int i = 0; i < 16; ++i) { float a = p0[i] * ATT_C2, c = p1[i] * ATT_C2;
                if (local) { const int kp = tk0 + R0(i) + 4 * hh; const int d0 = qpos - kp, d1 = qpos - kp - 32;
                    if (d0 > 128 || d0 < -128) a = -1e30f; if (d1 > 128 || d1 < -128) c = -1e30f; }
                p0[i] = a; p1[i] = c; mx = fmaxf(mx, fmaxf(a, c)); }
            mx = fmaxf(mx, __shfl_xor(mx, 32));
            const float mn = fmaxf(m, mx), alpha = __builtin_amdgcn_exp2f(m - mn); m = mn;
            float ps = 0.f;
#pragma unroll
            for (int i = 0; i < 16; ++i) { p0[i] = __builtin_amdgcn_exp2f(p0[i] - mn); p1[i] = __builtin_amdgcn_exp2f(p1[i] - mn); ps += p0[i] + p1[i]; }
            lsum = lsum * alpha + ps;
#pragma unroll
            for (int d = 0; d < 4; ++d)
#pragma unroll
                for (int i = 0; i < 16; ++i) O[d][i] *= alpha;
            bf16x8 pb[4];
#pragma unroll
            for (int s = 0; s < 2; ++s)
#pragma unroll
                for (int j = 0; j < 8; ++j) { pb[s][j] = (short)f2bf(p0[8 * s + j]); pb[2 + s][j] = (short)f2bf(p1[8 * s + j]); }
            const int i16 = lane & 15;
            const LAS unsigned char* vb = lds + ATT_V_OFF + (4 * hh + (i16 >> 2)) * VROW + (16 * ((lane >> 4) & 1) + 4 * (i16 & 3)) * 2;
#pragma unroll
            for (int dt = 0; dt < 4; ++dt)
#pragma unroll
                for (int ks = 0; ks < 4; ++ks) {
                    const LAS unsigned char* vp = vb + (16 * ks) * VROW + 64 * dt;
                    const v4i16_t lo = __builtin_amdgcn_ds_read_tr16_b64_v4i16((LAS v4i16_t*)vp), hi = __builtin_amdgcn_ds_read_tr16_b64_v4i16((LAS v4i16_t*)(vp + 8 * VROW));
                    const bf16x8 vf = (bf16x8){lo[0], lo[1], lo[2], lo[3], hi[0], hi[1], hi[2], hi[3]};
                    O[dt] = __builtin_amdgcn_mfma_f32_32x32x16_bf16(vf, pb[ks], O[dt], 0, 0, 0);
                }
        }
    }
    const float ltot = lsum + __shfl_xor(lsum, 32), inv = 1.0f / ltot;
    const bf16* gp = Z + (size_t)qrow * DIN + C_AG + h * 128 + 4 * hh; bf16* op = MIX + (size_t)qrow * D_MODEL + h * 128 + 4 * hh;
#pragma unroll
    for (int dt = 0; dt < 4; ++dt)
#pragma unroll
        for (int i4 = 0; i4 < 4; ++i4) { const int d0 = 32 * dt + 8 * i4; const u32x2 g = *(const u32x2*)(gp + d0);
            const float o0 = O[dt][4 * i4 + 0] * inv * siluf_(bflo(g.x)), o1 = O[dt][4 * i4 + 1] * inv * siluf_(bfhi(g.x));
            const float o2 = O[dt][4 * i4 + 2] * inv * siluf_(bflo(g.y)), o3 = O[dt][4 * i4 + 3] * inv * siluf_(bfhi(g.y));
            u32x2 w; w.x = pk2(o0, o1); w.y = pk2(o2, o3); *(u32x2*)(op + d0) = w; }
}

constexpr int HT_Q = 0, HT_K = 4224, HT_G = 8448, HT_V = 12672, HT_KG = 16896, HT_QGT = 21120, HT_AT = 25344, HT_DK = 26400;
__device__ __forceinline__ float hg_lb(const Params& P, int l, int dir, int hd) {
    if (l == 0) return 0.0f;
    const float* hb = P.in[12] + dir * 1024; return sigmoidf_(hb[512 + hd] - hb[hd]);
}
__device__ __forceinline__ void hgrn_local_unit(const Params& P, LAS float* lds, int l, int kind, int idx, int tid) {
    const int lane = tid & 63, wave = __builtin_amdgcn_readfirstlane(tid >> 6), r32 = lane & 31, hh = lane >> 5;
    const bf16* Z = (const bf16*)(P.ws + WS_Z); float* OL = (float*)(P.ws + WS_OL);
    int h, dir, row0, seglen, nch; float* Sdst;
    if (kind == 0) { const int b = idx >> 3; h = (idx >> 1) & 3; dir = idx & 1; row0 = b * 256; seglen = 256; nch = 8;
        Sdst = P.out + OUT_ST + (size_t)((((b * 2 + l) * 2 + dir) * 4 + h)) * 16384; }
    else { const int blk = idx & 15; dir = (idx >> 4) & 1; h = (idx >> 5) & 3; const int b = idx >> 7; row0 = NCTX + b * 2048 + blk * 128; seglen = 128; nch = 4;
        Sdst = (float*)(P.ws + WS_U) + (size_t)idx * 16384; }
    const int ti = tid >> 4, d0 = 8 * (tid & 15);
    float oml[8];
#pragma unroll
    for (int j = 0; j < 8; ++j) oml[j] = 1.0f - hg_lb(P, l, dir, h * 128 + d0 + j);
    f32x16 S[4];
#pragma unroll
    for (int k = 0; k < 4; ++k)
#pragma unroll
        for (int i = 0; i < 16; ++i) S[k][i] = 0.f;
    float gtot = 0.f;
    const int cf = dir ? C_HFB : C_HFF;
    for (int c = 0; c < nch; ++c) {
        const int tl = 32 * c + ti; const int row = dir ? row0 + seglen - 1 - tl : row0 + tl;
        const bf16* zr = Z + (size_t)row * DIN + h * 128 + d0;
        const u32x4 uq = *(const u32x4*)(zr + C_HQ), uv = *(const u32x4*)(zr + C_HI), uf = *(const u32x4*)(zr + cf);
        float q[8], kk[8], g2[8], vv[8];
#pragma unroll
        for (int j = 0; j < 4; ++j) { const unsigned wq = uq[j], wv = uv[j], wf = uf[j];
            q[2 * j] = siluf_(bflo(wq)) * 0.08838834764831845f; q[2 * j + 1] = siluf_(bfhi(wq)) * 0.08838834764831845f;
            vv[2 * j] = bflo(wv); vv[2 * j + 1] = bfhi(wv);
            kk[2 * j] = oml[2 * j] * sigmoidf_(-bflo(wf)); kk[2 * j + 1] = oml[2 * j + 1] * sigmoidf_(-bfhi(wf)); }
#pragma unroll
        for (int j = 0; j < 8; ++j) g2[j] = log1pf(-fminf(kk[j], 1.0f - 1e-6f)) * LOG2E;
        { LAS float* p = lds + ti * 132 + d0;
          *(LAS f32x4*)(p + HT_Q) = (f32x4){q[0], q[1], q[2], q[3]}; *(LAS f32x4*)(p + HT_Q + 4) = (f32x4){q[4], q[5], q[6], q[7]};
          *(LAS f32x4*)(p + HT_K) = (f32x4){kk[0], kk[1], kk[2], kk[3]}; *(LAS f32x4*)(p + HT_K + 4) = (f32x4){kk[4], kk[5], kk[6], kk[7]};
          *(LAS f32x4*)(p + HT_G) = (f32x4){g2[0], g2[1], g2[2], g2[3]}; *(LAS f32x4*)(p + HT_G + 4) = (f32x4){g2[4], g2[5], g2[6], g2[7]};
          *(LAS f32x4*)(p + HT_V) = (f32x4){vv[0], vv[1], vv[2], vv[3]}; *(LAS f32x4*)(p + HT_V + 4) = (f32x4){vv[4], vv[5], vv[6], vv[7]}; }
        __syncthreads();
        if (tid < 128) {
            LAS float* gc = lds + HT_G + tid; float run = 0.f;
#pragma unroll
            for (int i = 0; i < 32; ++i) { run += gc[i * 132]; gc[i * 132] = run; }
            lds[HT_DK + tid] = __builtin_amdgcn_exp2f(run); gtot += run;
        }
        __syncthreads();
        {
            const LAS float* gr = lds + HT_G + ti * 132 + d0; const LAS float* gl = lds + HT_G + 31 * 132 + d0;
            float kg[8];
#pragma unroll
            for (int j = 0; j < 8; ++j) { const float G = gr[j]; lds[HT_QGT + (d0 + j) * 33 + ti] = q[j] * __builtin_amdgcn_exp2f(G); kg[j] = kk[j] * __builtin_amdgcn_exp2f(gl[j] - G); }
            LAS float* p = lds + HT_KG + ti * 132 + d0;
            *(LAS f32x4*)p = (f32x4){kg[0], kg[1], kg[2], kg[3]}; *(LAS f32x4*)(p + 4) = (f32x4){kg[4], kg[5], kg[6], kg[7]};
        }
        {
            const int t = tid >> 4, s0 = 2 * (tid & 15); float a0 = 0.f, a1 = 0.f;
            if (s0 <= t) {
                const LAS float* qt = lds + HT_Q + t * 132; const LAS float* gt = lds + HT_G + t * 132;
                const LAS float* k0 = lds + HT_K + s0 * 132; const LAS float* g0 = lds + HT_G + s0 * 132;
#pragma unroll 2
                for (int d = 0; d < 128; d += 4) {
                    const f32x4 Q = *(const LAS f32x4*)(qt + d), Gt = *(const LAS f32x4*)(gt + d), K0 = *(const LAS f32x4*)(k0 + d), G0 = *(const LAS f32x4*)(g0 + d), K1 = *(const LAS f32x4*)(k0 + 132 + d), G1 = *(const LAS f32x4*)(g0 + 132 + d);
#pragma unroll
                    for (int e = 0; e < 4; ++e) { a0 += Q[e] * K0[e] * __builtin_amdgcn_exp2f(Gt[e] - G0[e]); a1 += Q[e] * K1[e] * __builtin_amdgcn_exp2f(fminf(Gt[e] - G1[e], 0.f)); }
                }
                if (s0 + 1 > t) a1 = 0.f;
            }
            lds[HT_AT + s0 * 33 + t] = a0; lds[HT_AT + (s0 + 1) * 33 + t] = a1;
        }
        __syncthreads();
        if (wave < 4) {
            const int nt = wave;
            f32x16 o;
#pragma unroll
            for (int i = 0; i < 16; ++i) o[i] = 0.f;
#pragma unroll
            for (int kt = 0; kt < 4; ++kt) {
                const LAS float* ap = lds + HT_QGT + (32 * kt + 4 * hh) * 33 + r32;
#pragma unroll
                for (int i = 0; i < 16; ++i) { const float a = ap[R0(i) * 33]; o = __builtin_amdgcn_mfma_f32_32x32x2f32(a, S[kt][i], o, 0, 0, 0); }
                SBAR
            }
            float bv[16];
            { const LAS float* vp = lds + HT_V + hh * 132 + 32 * nt + r32; const LAS float* ap = lds + HT_AT + hh * 33 + r32;
#pragma unroll
              for (int st = 0; st < 16; ++st) bv[st] = vp[2 * st * 132];
#pragma unroll
              for (int st = 0; st < 16; ++st) { const float a = ap[2 * st * 33]; o = __builtin_amdgcn_mfma_f32_32x32x2f32(a, bv[st], o, 0, 0, 0); } }
            SBAR
            { const int t2 = 32 * c + 4 * hh; const int rowb = dir ? row0 + seglen - 1 - t2 : row0 + t2; const int rs = dir ? -512 : 512;
              float* ob = OL + ((size_t)dir * MTOK + rowb) * 512 + h * 128 + 32 * nt + r32;
#pragma unroll
              for (int i = 0; i < 16; ++i) ob[R0(i) * rs] = o[i]; }
            SBAR
#pragma unroll
            for (int kt = 0; kt < 4; ++kt) {
                const LAS float* dp = lds + HT_DK + 32 * kt + 4 * hh; const LAS float* ap = lds + HT_KG + hh * 132 + 32 * kt + r32;
#pragma unroll
                for (int i = 0; i < 16; ++i) S[kt][i] *= dp[R0(i)];
#pragma unroll
                for (int st = 0; st < 16; ++st) { const float a = ap[2 * st * 132]; S[kt] = __builtin_amdgcn_mfma_f32_32x32x2f32(a, bv[st], S[kt], 0, 0, 0); }
                SBAR
            }
        }
        __syncthreads();
    }
    if (wave < 4) {
#pragma unroll
        for (int kt = 0; kt < 4; ++kt)
#pragma unroll
            for (int i = 0; i < 16; ++i) Sdst[(32 * kt + R0(i) + 4 * hh) * 128 + 32 * wave + r32] = S[kt][i];
    }
    if (kind == 1 && tid < 128) ((float*)(P.ws + WS_DLOG))[idx * 128 + tid] = gtot;
}

constexpr int HF_O = 0, HF_QGT = 16896, HF_G = 21120;
__device__ __forceinline__ void hgrn_final_unit(const Params& P, LAS float* lds, int l, int gb, int h, int tid) {
    const int lane = tid & 63, wave = __builtin_amdgcn_readfirstlane(tid >> 6), r32 = lane & 31, hh = lane >> 5;
    const bf16* Z = (const bf16*)(P.ws + WS_Z); bf16* MIX = (bf16*)(P.ws + WS_H); const float* OL = (const float*)(P.ws + WS_OL);
    const int row0 = gb * 128;
#pragma unroll
    for (int k = 0; k < 8; ++k) { const int e = tid + 512 * k, r = e >> 5, c4 = (e & 31) * 4;
        const f32x4 a = *(const f32x4*)(OL + (size_t)(row0 + r) * 512 + h * 128 + c4), b = *(const f32x4*)(OL + ((size_t)MTOK + row0 + r) * 512 + h * 128 + c4);
        *(LAS f32x4*)(lds + HF_O + r * 132 + c4) = a + b; }
    __syncthreads();
    if (gb >= 64) {
        const int lbat = (gb - 64) >> 4, blk = (gb - 64) & 15;
        const int ti = tid >> 4, d0 = 8 * (tid & 15);
        for (int dir = 0; dir < 2; ++dir) {
            f32x16 S[4];
            if (wave < 4) {
                const float* s0 = P.in[4] + (size_t)((((lbat * 2 + l) * 2 + dir) * 4 + h)) * 16384 + (4 * hh) * 128 + 32 * wave + r32;
#pragma unroll
                for (int kt = 0; kt < 4; ++kt) {
#pragma unroll
                    for (int i = 0; i < 16; ++i) S[kt][i] = s0[(32 * kt + R0(i)) * 128];
                    SBAR
                }
                const int p = dir ? 15 - blk : blk;
                for (int pp = 0; pp < p; ++pp) { const int blk2 = dir ? 15 - pp : pp; const int uidx = ((lbat * 4 + h) * 2 + dir) * 16 + blk2;
                    const float* U = (const float*)(P.ws + WS_U) + (size_t)uidx * 16384 + (4 * hh) * 128 + 32 * wave + r32; const float* DL = (const float*)(P.ws + WS_DLOG) + uidx * 128 + 4 * hh;
#pragma unroll
                    for (int kt = 0; kt < 4; ++kt) {
#pragma unroll
                        for (int i = 0; i < 16; ++i) { const int dk = 32 * kt + R0(i); S[kt][i] = __builtin_amdgcn_exp2f(DL[dk]) * S[kt][i] + U[dk * 128]; }
                        SBAR
                    } }
            }
            float oml[8];
#pragma unroll
            for (int j = 0; j < 8; ++j) oml[j] = 1.0f - hg_lb(P, l, dir, h * 128 + d0 + j);
            const int cf = dir ? C_HFB : C_HFF;
            float carry = 0.f;
            for (int cc = 0; cc < 4; ++cc) {
                const int tl = 32 * cc + ti; const int row = dir ? row0 + 127 - tl : row0 + tl;
                const bf16* zr = Z + (size_t)row * DIN + h * 128 + d0;
                const u32x4 uq = *(const u32x4*)(zr + C_HQ), uf = *(const u32x4*)(zr + cf);
                float q[8], g2[8];
#pragma unroll
                for (int j = 0; j < 4; ++j) { const unsigned wq = uq[j], wf = uf[j];
                    q[2 * j] = siluf_(bflo(wq)) * 0.08838834764831845f; q[2 * j + 1] = siluf_(bfhi(wq)) * 0.08838834764831845f;
                    const float k0 = oml[2 * j] * sigmoidf_(-bflo(wf)), k1 = oml[2 * j + 1] * sigmoidf_(-bfhi(wf));
                    g2[2 * j] = log1pf(-fminf(k0, 1.0f - 1e-6f)) * LOG2E; g2[2 * j + 1] = log1pf(-fminf(k1, 1.0f - 1e-6f)) * LOG2E; }
                { LAS float* p = lds + HF_G + ti * 132 + d0; *(LAS f32x4*)p = (f32x4){g2[0], g2[1], g2[2], g2[3]}; *(LAS f32x4*)(p + 4) = (f32x4){g2[4], g2[5], g2[6], g2[7]}; }
                __syncthreads();
                if (tid < 128) { LAS float* gc = lds + HF_G + tid; float run = carry;
#pragma unroll
                    for (int i = 0; i < 32; ++i) { run += gc[i * 132]; gc[i * 132] = run; }
                    carry = run; }
                __syncthreads();
                { const LAS float* gr = lds + HF_G + ti * 132 + d0;
#pragma unroll
                  for (int j = 0; j < 8; ++j) lds[HF_QGT + (d0 + j) * 33 + ti] = q[j] * __builtin_amdgcn_exp2f(gr[j]); }
                __syncthreads();
                if (wave < 4) {
                    f32x16 o;
#pragma unroll
                    for (int i = 0; i < 16; ++i) o[i] = 0.f;
#pragma unroll
                    for (int kt = 0; kt < 4; ++kt) {
                        const LAS float* ap = lds + HF_QGT + (32 * kt + 4 * hh) * 33 + r32;
#pragma unroll
                        for (int i = 0; i < 16; ++i) { const float a = ap[R0(i) * 33]; o = __builtin_amdgcn_mfma_f32_32x32x2f32(a, S[kt][i], o, 0, 0, 0); }
                        SBAR
                    }
#pragma unroll
                    for (int i = 0; i < 16; ++i) { const int t2 = 32 * cc + R0(i) + 4 * hh; const int tn = dir ? 127 - t2 : t2; lds[HF_O + tn * 132 + 32 * wave + r32] += o[i]; }
                }
                __syncthreads();
            }
        }
    }
    const float w0 = P.in[13][l * 512 + h * 128 + 2 * lane], w1 = P.in[13][l * 512 + h * 128 + 2 * lane + 1];
    for (int k = 0; k < 16; ++k) { const int tn = wave * 16 + k, row = row0 + tn;
        const float a = lds[HF_O + tn * 132 + 2 * lane], b = lds[HF_O + tn * 132 + 2 * lane + 1];
        const float ss = wave_sum(a * a + b * b); const float r = 1.0f / sqrtf(ss * (1.0f / 128.0f) + 1e-6f);
        const unsigned g = *(const unsigned*)(Z + (size_t)row * DIN + C_HG + h * 128 + 2 * lane);
        *(unsigned*)(MIX + (size_t)row * D_MODEL + 1024 + h * 128 + 2 * lane) = pk2(a * r * w0 * siluf_(bflo(g)), b * r * w1 * siluf_(bfhi(g))); }
}

__global__ void __launch_bounds__(NTHREADS, 2) fwd_kernel(Params P) {
    extern __shared__ __attribute__((aligned(16))) unsigned char lds_raw[];
    cg::grid_group grid = cg::this_grid();
    LAS unsigned char* lds = (LAS unsigned char*)lds_raw;
    LAS float* ldsf = (LAS float*)lds;
    volatile LAS unsigned* qslot = (volatile LAS unsigned*)(lds + 131072 + 1024);
#define PHASE_IDS int tid = threadIdx.x; asm volatile("" : "+v"(tid)); const int lane = tid & 63, wave = __builtin_amdgcn_readfirstlane(tid >> 6), gw = blockIdx.x * NWAVES + wave; (void)lane; (void)gw;
    const int G = gridDim.x, NGW = G * NWAVES;
    unsigned char* ws = P.ws;
    unsigned* ctl = (unsigned*)(ws + WS_CTL);
    float* MOD = (float*)(ws + WS_MOD);
    bf16* H = (bf16*)(ws + WS_H); bf16* Z = (bf16*)(ws + WS_Z);
    bf16* WTIN = (bf16*)(ws + WS_WTIN); bf16* WTOUT = (bf16*)(ws + WS_WTOUT);
    const float* xp = P.in[0]; const float* xs = P.in[1];

    {
        PHASE_IDS
        for (int u = blockIdx.x; u < 384; u += G) mod_unit(P, ldsf, u / 192, u % 192, tid);
        LAS float* scr = ldsf + wave * 4096;
        for (int it = gw; it < 6656 + 2048 + 2048; it += NGW) {
            if (it < 6656) transpose_item(P.in[9], 2048, DIN, WTIN, scr, it, lane);
            else if (it < 6656 + 2048) transpose_item(P.in[10], 2048, 2048, WTOUT, scr, it - 6656, lane);
            else transpose_item(P.in[10] + (size_t)2048 * 2048, 2048, 2048, WTOUT + (size_t)2048 * 2048, scr, it - 6656 - 2048, lane);
        }
        const int gt = blockIdx.x * NTHREADS + tid;
        if (gt < 2048) { const int pos = gt >> 5, i = gt & 31; const float inv = powf(10000.0f, -(float)i / 32.0f); const float ang = (float)pos * inv;
            float sn, cs; sincosf(ang, &sn, &cs); float* CS = (float*)(ws + WS_CS); CS[gt * 2] = cs; CS[gt * 2 + 1] = sn; }
    }
    grid.sync();
    { PHASE_IDS
    for (int row = gw; row < MTOK; row += NGW) {
        const int cond = (row < NCTX) ? 0 : 1 + ((row - NCTX) >> 11);
        const float* xrow = (row < NCTX) ? xp + (size_t)row * D_MODEL : xs + (size_t)(row - NCTX) * D_MODEL;
        hprep_row(xrow, MOD + (0 * 3 + cond) * 6144, H + (size_t)row * D_MODEL, lane);
    } }
    grid.sync();

    for (int l = 0; l < DEPTH; ++l) {
        {
            pg8::Gemm g{H, WTIN, MTOK, DIN, D_MODEL}; pg8::StaticOrder S; S.init(MTOK, DIN, G, (int)blockIdx.x);
            pg8::EpiZ E{Z, P.out + OUT_CK, P.out + OUT_CV, l};
            pg8::gemm_phase<pg8::EpiZ, pg8::StaticOrder, true, true>(lds, g, S, E);
        }
        grid.sync();
        {
            PHASE_IDS
            unsigned* ctr = ctl + 64 * (l * 2 + 0);
            const int n_cvt = (l == 0) ? 832 : 0;
            for (;;) {
                asm volatile("" : "+v"(tid));
                const int lane = tid & 63;
                int u = next_unit(ctr, qslot, tid);
                if (u >= 1664 + n_cvt) break;
                if (u < 256) { hgrn_local_unit(P, ldsf, l, 0, u, tid); continue; } u -= 256;
                if (u < 128) { attn_unit(P, lds, l, 1, u, tid); continue; } u -= 128;
                if (u < 256) { hgrn_local_unit(P, ldsf, l, 1, u, tid); continue; } u -= 256;
                if (u < 256) { attn_unit(P, lds, l, 0, u, tid); continue; } u -= 256;
                if (u < 768) { conv_unit(P, ldsf, l, u, tid); continue; } u -= 768;
                { LAS float* scr = ldsf + wave * 4096; transpose_item(P.in[9] + (size_t)2048 * DIN, 2048, DIN, WTIN, scr, u * 8 + wave, lane); }
            }
        }
        grid.sync();
        {
            PHASE_IDS
            unsigned* ctr = ctl + 64 * (l * 2 + 1);
            for (;;) {
                asm volatile("" : "+v"(tid));
                const int u = next_unit(ctr, qslot, tid);
                if (u >= 384) break;
                hgrn_final_unit(P, ldsf, l, 95 - (u >> 2), u & 3, tid);
            }
        }
        grid.sync();
        {
            pg8::Gemm g{H, WTOUT + (size_t)l * 2048 * 2048, MTOK, D_MODEL, D_MODEL}; pg8::StaticOrder S; S.init(MTOK, D_MODEL, G, (int)blockIdx.x);
            pg8::EpiV E{(l == 0) ? xp : P.out, (l == 0) ? xs : P.out + OUT_YS, P.out, MOD + l * 3 * 6144 + 4096};
            pg8::gemm_phase<pg8::EpiV, pg8::StaticOrder, true, true>(lds, g, S, E);
        }
        grid.sync();
        { PHASE_IDS
        for (int row = gw; row < MTOK; row += NGW) {
            const int cond = (row < NCTX) ? 0 : 1 + ((row - NCTX) >> 11);
            ln_row(P.out + (size_t)row * D_MODEL, P.in[18] + l * D_MODEL, P.in[19] + l * D_MODEL, MOD + (3 + cond) * 6144, (l == 0) ? H + (size_t)row * D_MODEL : (bf16*)nullptr, lane);
        } }
        if (l + 1 < DEPTH) grid.sync();
    }
}

extern "C" void kernel_launch(void* const* d_in, const int* in_sizes, int n_in, void* d_out, int out_size, void* d_ws, size_t ws_size, hipStream_t stream) {
    static int grid = 0;
    if (grid == 0) {
        if (n_in != 20 || out_size != (int)OUT_TOTAL || ws_size < WS_END) { fprintf(stderr, "kernel_launch: unexpected shapes (n_in %d, out %d, ws %zu)\n", n_in, out_size, ws_size); grid = -1; return; }
        int dev = 0, cus = 0, per_cu = 0;
        hipGetDevice(&dev); hipDeviceGetAttribute(&cus, hipDeviceAttributeMultiprocessorCount, dev);
        hipFuncSetAttribute((const void*)fwd_kernel, hipFuncAttributeMaxDynamicSharedMemorySize, LDS_BYTES);
        hipOccupancyMaxActiveBlocksPerMultiprocessor(&per_cu, (const void*)fwd_kernel, NTHREADS, LDS_BYTES);
        if (per_cu < 1) { fprintf(stderr, "kernel_launch: occupancy query says %d blocks per CU\n", per_cu); grid = -1; return; }
        grid = cus;
    }
    if (grid < 0) return;
    hipMemsetAsync((char*)d_ws + WS_CTL, 0, CTL_ZERO_BYTES, stream);
    Params p{};
    for (int i = 0; i < 20; ++i) p.in[i] = (const float*)d_in[i];
    p.out = (float*)d_out; p.ws = (unsigned char*)d_ws;
    void* args[] = {&p};
    hipError_t e = hipLaunchCooperativeKernel((const void*)fwd_kernel, dim3(grid), dim3(NTHREADS), args, LDS_BYTES, stream);
    if (e != hipSuccess) fprintf(stderr, "cooperative launch failed: %s (grid %d)\n", hipGetErrorString(e), grid);
}
```

```cpp
#include <hip/hip_runtime.h>
#include <hip/hip_cooperative_groups.h>
#include <cstdio>
#include <cstdint>
namespace cg = cooperative_groups;

constexpr int D_MODEL = 2048, DIN = 6656, NCTX = 8192, NLAT = 4096, MTOK = 12288, DEPTH = 2;
constexpr int C_AQ = 0, C_AK = 1024, C_AV = 1280, C_AG = 1536, C_HQ = 2560, C_HI = 3072, C_HFF = 3584, C_HFB = 4096, C_HG = 4608, C_CA = 5120, C_CB = 5632, C_CG = 6144;
constexpr float ALPHA_DN = 1.4142135623730951f;
constexpr size_t OUT_YP = 0, OUT_YS = 16777216, OUT_CK = 25165824, OUT_CV = 29360128, OUT_ST = 33554432, OUT_TOTAL = 41943040;
namespace pg8 {
#define PG8_LAS __attribute__((address_space(3)))
typedef unsigned short bf16_t;
typedef short bf16x8 __attribute__((ext_vector_type(8)));
typedef float f32x4 __attribute__((ext_vector_type(4)));
typedef unsigned u32x4 __attribute__((ext_vector_type(4)));
constexpr int BM = 256, BK = 64, HALF = 128, HTB = HALF * BK * 2  , STAGE_BYTES = 8 * HTB, NXCD = 8, WGM = 8;

__host__ __device__ __forceinline__ int lds_byte(int r, int c) { const int st = (r >> 4) * 2 + (c >> 5), rr = r & 15, cc = c & 31, ob = rr * 64 + cc * 2; return st * 1024 + (ob ^ (((ob >> 9) & 1) << 5)); }
__host__ __device__ __forceinline__ void stage_rc(int b, int& R, int& C) { const int st = b / 1024, sb = b % 1024, swz = sb ^ (((sb >> 9) & 1) << 5); R = (st >> 1) * 16 + swz / 64; C = (st & 1) * 32 + (swz % 64) / 2; }
__host__ __device__ __forceinline__ int perm32(int rho) { const int n = rho >> 4, i = rho & 15; return 8 * (i >> 2) + 4 * n + (i & 3); }

struct Unit { int pm, pn; };
struct Gemm { const bf16_t* A; const bf16_t* Bt; int M, N, K; };

struct StaticOrder {
    int nM, nN, nwg, G, c;
    __host__ __device__ void init(int M, int N, int G_, int c_) { nM = M / BM; nN = N / BM; nwg = nM * nN; G = G_; c = c_; }
    __host__ __device__ bool next(int i, Unit& u) const {
        const long L = (long)i * G + c; if (L >= nwg) return false;
        int wgid = (int)L; { const int q = nwg / NXCD, r = nwg % NXCD, xcd = wgid % NXCD, off = wgid / NXCD; wgid = (xcd < r ? xcd * (q + 1) : r * (q + 1) + (xcd - r) * q) + off; }
        const int nig = WGM * nN, gid = wgid / nig, fm = gid * WGM, gsz = (nM - fm) < WGM ? (nM - fm) : WGM;
        u.pm = fm + ((wgid % nig) % gsz); u.pn = (wgid % nig) / gsz; return true;
    }
    __device__ __forceinline__ void a_ready(const Unit&) const {}
    __device__ __forceinline__ void done(const Unit&) const {}
};

__device__ __forceinline__ unsigned cvt_pk_bf16(float lo, float hi) { unsigned r; asm volatile("v_cvt_pk_bf16_f32 %0, %1, %2" : "=v"(r) : "v"(lo), "v"(hi)); return r; }
typedef float f32x2 __attribute__((ext_vector_type(2)));

struct EpiZ {
    static constexpr bool PERM = true, AFTER_DRAIN = false;
    bf16_t* Z; float* ck; float* cv; int layer;
    __device__ __forceinline__ void operator()(const f32x4 (&acc)[2][2][4][2], const Unit& u, int wr, int wc, int fr, int fq) const {
        const int row0 = u.pm * BM + wr * 64 + fr; const int col0 = u.pn * BM + wc * 32 + 8 * fq;
#pragma unroll
        for (int ai = 0; ai < 2; ++ai)
#pragma unroll
            for (int m = 0; m < 4; ++m) { bf16_t* rowp = Z + (size_t)(row0 + ai * HALF + m * 16) * DIN + col0;
#pragma unroll
                for (int bj = 0; bj < 2; ++bj) { const f32x4 v0 = acc[ai][bj][m][0], v1 = acc[ai][bj][m][1];
                    u32x4 w; w.x = cvt_pk_bf16(v0[0], v0[1]); w.y = cvt_pk_bf16(v0[2], v0[3]); w.z = cvt_pk_bf16(v1[0], v1[1]); w.w = cvt_pk_bf16(v1[2], v1[3]);
                    *(u32x4*)(rowp + bj * HALF) = w; } }
        if ((u.pn == 4 || u.pn == 5) && u.pm < 32) {
            float* base = (u.pn == 4) ? ck : cv;
#pragma unroll
            for (int ai = 0; ai < 2; ++ai)
#pragma unroll
                for (int m = 0; m < 4; ++m) { const int row = row0 + ai * HALF + m * 16; const int b = row >> 8, s = row & 255;
                    float* p = base + ((size_t)((b * 2 + layer) * 256 + s)) * 256 + (wc * 32 + 8 * fq);
#pragma unroll
                    for (int bj = 0; bj < 2; ++bj) { *(f32x4*)(p + bj * HALF) = acc[ai][bj][m][0]; *(f32x4*)(p + bj * HALF + 4) = acc[ai][bj][m][1]; } }
        }
    }
};
struct EpiV {
    static constexpr bool PERM = false, AFTER_DRAIN = false;
    const float* xp; const float* xs; float* V; const float* gate;
    __device__ __forceinline__ void operator()(const f32x4 (&acc)[2][2][4][2], const Unit& u, int wr, int wc, int fr, int fq) const {
        const int row0 = u.pm * BM + wr * 64 + fr; const int col0 = u.pn * BM + wc * 32 + 4 * fq;
        const int cond = (u.pm < 32) ? 0 : 1 + ((u.pm - 32) >> 3);
        const float* g = gate + cond * 6144 + col0;
        f32x4 gv[2][2];
#pragma unroll
        for (int bj = 0; bj < 2; ++bj)
#pragma unroll
            for (int n = 0; n < 2; ++n) gv[bj][n] = *(const f32x4*)(g + bj * HALF + n * 16);
#pragma unroll
        for (int ai = 0; ai < 2; ++ai)
#pragma unroll
            for (int m = 0; m < 4; ++m) { const int row = row0 + ai * HALF + m * 16;
                const float* xr = ((row < NCTX) ? xp + (size_t)row * D_MODEL : xs + (size_t)(row - NCTX) * D_MODEL) + col0;
                float* vr = V + (size_t)row * D_MODEL + col0;
#pragma unroll
                for (int bj = 0; bj < 2; ++bj)
#pragma unroll
                    for (int n = 0; n < 2; ++n) { const f32x4 xv = *(const f32x4*)(xr + bj * HALF + n * 16);
                        *(f32x4*)(vr + bj * HALF + n * 16) = xv * ALPHA_DN + gv[bj][n] * acc[ai][bj][m][n]; }
                asm volatile("" ::: "memory"); }
    }
};
template <class Epi, class Sched, bool ALIGN_EPI = false, bool SP2 = false>
__device__ __forceinline__ void gemm_phase(PG8_LAS unsigned char* lds, const Gemm g, const Sched& S, const Epi& E) {
    int tid_l = threadIdx.x; asm volatile("" : "+v"(tid_l));
    const int tid = tid_l, wid = __builtin_amdgcn_readfirstlane(tid >> 6), lane = tid & 63, wr = wid >> 2, wc = wid & 3, fr = lane & 15, fq = lane >> 4;
    const int K = g.K, nt = K / BK;
    unsigned voffA[2], voffB[2];
#pragma unroll
    for (int i = 0; i < 2; ++i) { int R, C; stage_rc(tid * 16 + i * 8192, R, C); const int Rb = Epi::PERM ? ((R & ~31) + perm32(R & 31)) : R;
        voffA[i] = (unsigned)(R * K + C) * 2u; voffB[i] = (unsigned)(Rb * K + C) * 2u; }
    const size_t kstep = (size_t)(BK * 2);
    const size_t hstep = (size_t)HALF * K * 2;
    const size_t tstep = 2 * hstep;
    const unsigned ldsw = (unsigned)wid * 1024u;
    const int aoff = lds_byte(wr * 64 + fr, fq * 8), boff = lds_byte(wc * 32 + fr, fq * 8);
#define PG8_SA(b, h) (((b) * 2 + (h)) * HTB)
#define PG8_SB(b, h) ((4 + (b) * 2 + (h)) * HTB)
#define PG8_STAGE(bufoff, gbase, voff) do { _Pragma("unroll") for (int _i = 0; _i < 2; ++_i) \
        __builtin_amdgcn_global_load_lds((const unsigned*)((const char*)(gbase) + (voff)[_i]), (PG8_LAS unsigned*)(lds + (bufoff) + ldsw + _i * 8192), 16, 0, 0); } while (0)
#define PG8_LDA(dst, b, h) do { _Pragma("unroll") for (int m = 0; m < 4; ++m) _Pragma("unroll") for (int k = 0; k < 2; ++k) dst[m][k] = *(const PG8_LAS bf16x8*)(lds + PG8_SA(b, h) + aoff + m * 2048 + k * 1024); } while (0)
#define PG8_LDB(dst, b, h) do { _Pragma("unroll") for (int n = 0; n < 2; ++n) _Pragma("unroll") for (int k = 0; k < 2; ++k) dst[n][k] = *(const PG8_LAS bf16x8*)(lds + PG8_SB(b, h) + boff + n * 2048 + k * 1024); } while (0)
#define PG8_MMA(ai, bj, At, Bt) do { __builtin_amdgcn_s_setprio(1); _Pragma("unroll") for (int m = 0; m < 4; ++m) _Pragma("unroll") for (int n = 0; n < 2; ++n) _Pragma("unroll") for (int k = 0; k < 2; ++k) \
        acc[ai][bj][m][n] = __builtin_amdgcn_mfma_f32_16x16x32_bf16(Bt[n][k], At[m][k], acc[ai][bj][m][n], 0, 0, 0); __builtin_amdgcn_s_setprio(0); } while (0)
#define PG8_WAIT_V(n) asm volatile("s_waitcnt vmcnt(" #n ")" ::: "memory")
#define PG8_WAIT_L(n) asm volatile("s_waitcnt lgkmcnt(" #n ")" ::: "memory")
#define PG8_BAR __builtin_amdgcn_s_barrier()
#define PG8_SCHED __builtin_amdgcn_sched_barrier(0)
    Unit cur, nxt; int ui = 0;
    if (!S.next(0, cur)) return;
    f32x4 acc[2][2][4][2];
#pragma unroll
    for (int a = 0; a < 2; ++a)
#pragma unroll
        for (int b = 0; b < 2; ++b)
#pragma unroll
            for (int m = 0; m < 4; ++m)
#pragma unroll
                for (int n = 0; n < 2; ++n) acc[a][b][m][n] = (f32x4){0.f, 0.f, 0.f, 0.f};
    bf16x8 At[4][2], B0[2][2], B1[2][2];
    const char* cA = (const char*)g.A + (size_t)cur.pm * tstep; const char* cB = (const char*)g.Bt + (size_t)cur.pn * tstep;
    S.a_ready(cur);
    if constexpr (SP2) {
        PG8_STAGE(PG8_SB(0, 0), cB, voffB); PG8_STAGE(PG8_SB(0, 1), cB + hstep, voffB); PG8_STAGE(PG8_SA(0, 0), cA, voffA); PG8_STAGE(PG8_SA(0, 1), cA + hstep, voffA);
        if (wr == 1) PG8_BAR;
        PG8_WAIT_V(2); PG8_BAR;
        PG8_STAGE(PG8_SB(1, 0), cB + kstep, voffB); PG8_STAGE(PG8_SA(1, 0), cA + kstep, voffA); PG8_STAGE(PG8_SB(1, 1), cB + hstep + kstep, voffB);
        PG8_WAIT_V(6); PG8_BAR;
    } else {
        PG8_STAGE(PG8_SB(0, 0), cB, voffB); PG8_STAGE(PG8_SA(0, 0), cA, voffA); PG8_STAGE(PG8_SB(0, 1), cB + hstep, voffB); PG8_STAGE(PG8_SA(0, 1), cA + hstep, voffA);
        if (wr == 1) PG8_BAR;
        PG8_WAIT_V(4); PG8_BAR;
        PG8_STAGE(PG8_SB(1, 0), cB + kstep, voffB); PG8_STAGE(PG8_SA(1, 0), cA + kstep, voffA); PG8_STAGE(PG8_SB(1, 1), cB + hstep + kstep, voffB);
        PG8_WAIT_V(6); PG8_BAR;
    }
    for (;;) {
        const bool has_next = S.next(ui + 1, nxt);
        const char* nA = has_next ? (const char*)g.A + (size_t)nxt.pm * tstep : cA; const char* nB = has_next ? (const char*)g.Bt + (size_t)nxt.pn * tstep : cB;
        for (int t = 0; t < nt; t += 2) {
            const bool last = (t == nt - 2);
            const char* a1 = cA + (size_t)(t + 1) * kstep;
            const char* a2 = last ? nA : cA + (size_t)(t + 2) * kstep; const char* b2 = last ? nB : cB + (size_t)(t + 2) * kstep;
            const char* a3 = a2 + kstep; const char* b3 = b2 + kstep;
            if (last && has_next) S.a_ready(nxt);
            if constexpr (SP2) {
            PG8_LDB(B0, 0, 0); PG8_LDB(B1, 0, 1); PG8_SCHED; PG8_LDA(At, 0, 0); PG8_STAGE(PG8_SA(1, 1), a1 + hstep, voffA);
            PG8_WAIT_V(8); PG8_WAIT_L(0); PG8_BAR; PG8_MMA(0, 0, At, B0); PG8_MMA(0, 1, At, B1); PG8_BAR; PG8_SCHED;
            PG8_LDA(At, 0, 1); PG8_STAGE(PG8_SB(0, 0), b2, voffB); PG8_STAGE(PG8_SB(0, 1), b2 + hstep, voffB); PG8_STAGE(PG8_SA(0, 0), a2, voffA);
            PG8_WAIT_V(8); PG8_WAIT_L(0); PG8_BAR; PG8_MMA(1, 0, At, B0); PG8_MMA(1, 1, At, B1); PG8_BAR; PG8_SCHED;
            PG8_LDB(B0, 1, 0); PG8_LDB(B1, 1, 1); PG8_SCHED; PG8_LDA(At, 1, 0); PG8_STAGE(PG8_SA(0, 1), a2 + hstep, voffA);
            PG8_WAIT_V(8); PG8_WAIT_L(0); PG8_BAR; PG8_MMA(0, 0, At, B0); PG8_MMA(0, 1, At, B1); PG8_BAR; PG8_SCHED;
            PG8_LDA(At, 1, 1); PG8_STAGE(PG8_SB(1, 0), b3, voffB); PG8_STAGE(PG8_SB(1, 1), b3 + hstep, voffB); PG8_STAGE(PG8_SA(1, 0), a3, voffA);
            PG8_WAIT_V(8); PG8_WAIT_L(0); PG8_BAR; PG8_MMA(1, 0, At, B0); PG8_MMA(1, 1, At, B1); PG8_BAR; PG8_SCHED;
            } else {
            PG8_LDB(B0, 0, 0); PG8_SCHED; PG8_LDA(At, 0, 0); PG8_STAGE(PG8_SA(1, 1), a1 + hstep, voffA);
            PG8_WAIT_L(8); PG8_BAR; PG8_WAIT_L(0); PG8_MMA(0, 0, At, B0); PG8_BAR; PG8_SCHED;
            PG8_LDB(B1, 0, 1); PG8_STAGE(PG8_SB(0, 0), b2, voffB);
            PG8_BAR; PG8_WAIT_L(0); PG8_MMA(0, 1, At, B1); PG8_BAR;
            PG8_LDA(At, 0, 1); PG8_STAGE(PG8_SA(0, 0), a2, voffA);
            PG8_BAR; PG8_WAIT_L(0); PG8_MMA(1, 0, At, B0); PG8_BAR; PG8_SCHED;
            PG8_STAGE(PG8_SB(0, 1), b2 + hstep, voffB);
            PG8_WAIT_V(6); PG8_BAR; PG8_MMA(1, 1, At, B1); PG8_BAR;
            PG8_LDB(B0, 1, 0); PG8_SCHED; PG8_LDA(At, 1, 0); PG8_STAGE(PG8_SA(0, 1), a2 + hstep, voffA);
            PG8_WAIT_L(8); PG8_BAR; PG8_WAIT_L(0); PG8_MMA(0, 0, At, B0); PG8_BAR; PG8_SCHED;
            PG8_LDB(B1, 1, 1); PG8_STAGE(PG8_SB(1, 0), b3, voffB);
            PG8_BAR; PG8_WAIT_L(0); PG8_MMA(0, 1, At, B1); PG8_BAR;
            PG8_LDA(At, 1, 1); PG8_STAGE(PG8_SA(1, 0), a3, voffA);
            PG8_BAR; PG8_WAIT_L(0); PG8_MMA(1, 0, At, B0); PG8_BAR; PG8_SCHED;
            PG8_STAGE(PG8_SB(1, 1), b3 + hstep, voffB);
            PG8_WAIT_V(6); PG8_BAR; PG8_MMA(1, 1, At, B1); PG8_BAR;
            }
        }
        if constexpr (ALIGN_EPI) { if (wr == 0) PG8_BAR; }
        if constexpr (!Epi::AFTER_DRAIN) { E(acc, cur, wr, wc, fr, fq); S.done(cur); }
        if (!has_next) break;
#pragma unroll
        for (int a = 0; a < 2; ++a)
#pragma unroll
            for (int b = 0; b < 2; ++b)
#pragma unroll
                for (int m = 0; m < 4; ++m)
#pragma unroll
                    for (int n = 0; n < 2; ++n) acc[a][b][m][n] = (f32x4){0.f, 0.f, 0.f, 0.f};
        cur = nxt; cA = nA; cB = nB; ++ui;
        if constexpr (ALIGN_EPI) { if (wr == 1) PG8_BAR; }
    }
    PG8_WAIT_V(0);
    if constexpr (!ALIGN_EPI) { if (wr == 0) PG8_BAR; }
    PG8_BAR;
    if constexpr (Epi::AFTER_DRAIN) { E.fused(acc, cur, wr, wc, fr, fq, lds, wid, lane); S.done(cur); }
#undef PG8_SA
#undef PG8_SB
#undef PG8_STAGE
#undef PG8_LDA
#undef PG8_LDB
#undef PG8_MMA
#undef PG8_WAIT_V
#undef PG8_WAIT_L
#undef PG8_BAR
#undef PG8_SCHED
}
}

constexpr size_t MiB = 1u << 20;
constexpr size_t WS_CTL = 0, CTL_ZERO_BYTES = 4096;
constexpr size_t WS_MOD = 1 * MiB;
constexpr size_t WS_CS = 1 * MiB + 192 * 1024;
constexpr size_t WS_DLOG = 1 * MiB + 256 * 1024;
constexpr size_t WS_WTOUT = 2 * MiB;
constexpr size_t WS_WTIN = 18 * MiB;
constexpr size_t WS_H = 44 * MiB;
constexpr size_t WS_Z = 92 * MiB;
constexpr size_t WS_U = 248 * MiB;
constexpr size_t WS_OL = 264 * MiB;
constexpr size_t WS_END = 312 * MiB;
constexpr int LDS_BYTES = 147456;
constexpr int NWAVES = 8, NTHREADS = 512;

#define LAS __attribute__((address_space(3)))
typedef unsigned short bf16;
typedef float f32x4 __attribute__((ext_vector_type(4)));
typedef float f32x16 __attribute__((ext_vector_type(16)));
typedef unsigned u32x4 __attribute__((ext_vector_type(4)));
typedef unsigned u32x2 __attribute__((ext_vector_type(2)));
typedef short bf16x8 __attribute__((ext_vector_type(8)));

__device__ __forceinline__ float bf2f(unsigned short u) { return __builtin_bit_cast(float, (unsigned)u << 16); }
__device__ __forceinline__ float bflo(unsigned u) { return __builtin_bit_cast(float, u << 16); }
__device__ __forceinline__ float bfhi(unsigned u) { return __builtin_bit_cast(float, u & 0xffff0000u); }
__device__ __forceinline__ unsigned f2bf(float f) { unsigned u = __builtin_bit_cast(unsigned, f); return (u + 0x7fffu + ((u >> 16) & 1u)) >> 16; }
__device__ __forceinline__ unsigned pk2(float lo, float hi) { return f2bf(lo) | (f2bf(hi) << 16); }
__device__ __forceinline__ float sigmoidf_(float x) { return 1.0f / (1.0f + __expf(-x)); }
__device__ __forceinline__ float siluf_(float x) { return x / (1.0f + __expf(-x)); }
__device__ __forceinline__ float wave_sum(float v) {
#pragma unroll
    for (int o = 1; o < 64; o <<= 1) v += __shfl_xor(v, o);
    return v;
}

struct Params {
    const float* in[20];
    float* out; unsigned char* ws;
};
typedef const __attribute__((address_space(4))) Params* PP;

__device__ __forceinline__ int next_unit(unsigned* ctr, volatile LAS unsigned* slot, int tid) {
    __syncthreads();
    if (tid == 0) *slot = __hip_atomic_fetch_add(ctr, 1u, __ATOMIC_RELAXED, __HIP_MEMORY_SCOPE_AGENT);
    __syncthreads();
    return (int)*slot;
}

__device__ __forceinline__ void transpose_item(const float* W, int K, int N, bf16* WT, LAS float* scr, int item, int lane) {
    const int nblk = N / 32, kb = item / nblk, nb = item % nblk, k0 = 64 * kb, n0 = 32 * nb;
#pragma unroll 8
    for (int i = 0; i < 32; ++i) { const int kk = 2 * i + (lane >> 5); scr[kk * 33 + (lane & 31)] = W[(size_t)(k0 + kk) * N + n0 + (lane & 31)]; }
    asm volatile("s_waitcnt lgkmcnt(0)" ::: "memory");
    const int c = lane & 7;
#pragma unroll
    for (int j = 0; j < 4; ++j) { const int n = (lane >> 3) + 8 * j; const LAS float* s = scr + (8 * c) * 33 + n;
        u32x4 o; o.x = pk2(s[0 * 33], s[1 * 33]); o.y = pk2(s[2 * 33], s[3 * 33]); o.z = pk2(s[4 * 33], s[5 * 33]); o.w = pk2(s[6 * 33], s[7 * 33]);
        *(u32x4*)(WT + (size_t)(n0 + n) * K + k0 + 8 * c) = o; }
    asm volatile("s_waitcnt lgkmcnt(0)" ::: "memory");
}

__device__ __forceinline__ void mod_unit(PP P, LAS float* lds, int l, int nc, int tid) {
    const float* c = P->in[5]; const float* cctx = P->in[6]; const float* aw = P->in[7] + (size_t)l * 2048 * 6144; const float* ab = P->in[8] + l * 6144;
    LAS float* sc = lds;
    LAS float* red = lds + 3 * 2048;
    for (int i = tid; i < 3 * 2048; i += NTHREADS) { const int j = i >> 11, k = i & 2047; const float v = (j == 0) ? cctx[k] : c[(j - 1) * 2048 + k]; sc[i] = siluf_(v); }
    __syncthreads();
    const int tn = tid & 7, tk = tid >> 3, n0 = nc * 32 + 4 * tn;
    float a[3][4] = {};
    for (int kk = 0; kk < 32; ++kk) { const int k = tk * 32 + kk; const f32x4 w = *(const f32x4*)(aw + (size_t)k * 6144 + n0);
#pragma unroll
        for (int j = 0; j < 3; ++j) { const float s = sc[j * 2048 + k]; a[j][0] += s * w[0]; a[j][1] += s * w[1]; a[j][2] += s * w[2]; a[j][3] += s * w[3]; } }
#pragma unroll
    for (int j = 0; j < 3; ++j)
#pragma unroll
        for (int e = 0; e < 4; ++e) red[(tk * 8 + tn) * 12 + j * 4 + e] = a[j][e];
    __syncthreads();
    if (tid < 96) { const int tn2 = tid / 12, je = tid % 12; float s = 0.f; for (int t = 0; t < 64; ++t) s += red[(t * 8 + tn2) * 12 + je];
        const int j = je >> 2, e = je & 3, n = nc * 32 + 4 * tn2 + e;
        ((float*)(P->ws + WS_MOD))[(l * 3 + j) * 6144 + n] = s + ab[n]; }
    __syncthreads();
}

__device__ __forceinline__ void hprep_row(const float* xrow, const float* mod  , bf16* hrow, int lane) {
#pragma unroll
    for (int j = 0; j < 8; ++j) { const int c = 4 * lane + 256 * j; const f32x4 x = *(const f32x4*)(xrow + c), sh = *(const f32x4*)(mod + c), sc = *(const f32x4*)(mod + 2048 + c);
        const f32x4 h = x * (sc + 1.0f) + sh; u32x2 o; o.x = pk2(h[0], h[1]); o.y = pk2(h[2], h[3]); *(u32x2*)(hrow + c) = o; }
}
__device__ __forceinline__ void ln_row(float* vrow, const float* w, const float* b, const float* modn, bf16* hrow, int lane) {
    f32x4 v[8]; float s = 0.f;
#pragma unroll
    for (int j = 0; j < 8; ++j) { v[j] = *(const f32x4*)(vrow + 4 * lane + 256 * j); s += (v[j][0] + v[j][1]) + (v[j][2] + v[j][3]); }
    const float mean = wave_sum(s) * (1.0f / 2048.0f); float q = 0.f;
#pragma unroll
    for (int j = 0; j < 8; ++j) { v[j] = v[j] - mean; q += (v[j][0] * v[j][0] + v[j][1] * v[j][1]) + (v[j][2] * v[j][2] + v[j][3] * v[j][3]); }
    const float rstd = 1.0f / sqrtf(wave_sum(q) * (1.0f / 2048.0f) + 1e-5f);
#pragma unroll
    for (int j = 0; j < 8; ++j) { const int c = 4 * lane + 256 * j; const f32x4 y = v[j] * rstd * *(const f32x4*)(w + c) + *(const f32x4*)(b + c);
        *(f32x4*)(vrow + c) = y;
        if (hrow) { const f32x4 sh = *(const f32x4*)(modn + c), sc = *(const f32x4*)(modn + 2048 + c); const f32x4 h = y * (sc + 1.0f) + sh;
            u32x2 o; o.x = pk2(h[0], h[1]); o.y = pk2(h[2], h[3]); *(u32x2*)(hrow + c) = o; } }
}

__device__ __forceinline__ void conv_unit(PP P, LAS float* lds, int l, int unit, int tid) {
    const int lane = tid & 63, wave = tid >> 6;
    const bf16* Z = (const bf16*)(P->ws + WS_Z); bf16* MIX = (bf16*)(P->ws + WS_H);
    const int t0 = unit * 16;
    int s0, s1; if (t0 < NCTX) { s0 = t0 & ~255; s1 = s0 + 256; } else { s0 = NCTX + ((t0 - NCTX) & ~2047); s1 = s0 + 2048; }
    const int c = tid;
    float u[46];
    unsigned short ra[46], rb[46];
#pragma unroll
    for (int r = 0; r < 46; ++r) { const int row = t0 - 15 + r; const int rc = row < s0 ? s0 : (row >= s1 ? s1 - 1 : row);
        ra[r] = Z[(size_t)rc * DIN + C_CA + c]; rb[r] = Z[(size_t)rc * DIN + C_CB + c]; }
    __builtin_amdgcn_sched_barrier(0);
#pragma unroll
    for (int r = 0; r < 46; ++r) { const int row = t0 - 15 + r; const float val = bf2f(ra[r]) * sigmoidf_(bf2f(rb[r])); u[r] = (row >= s0 && row < s1) ? val : 0.f; }
    float acc[16]; const float bias = P->in[15][l * 512 + c];
#pragma unroll
    for (int i = 0; i < 16; ++i) acc[i] = bias;
    const float* cw = P->in[14] + (size_t)l * 31 * 512 + c;
#pragma unroll
    for (int j = 0; j < 31; ++j) { const float w = cw[j * 512];
#pragma unroll
        for (int i = 0; i < 16; ++i) acc[i] += u[i + j] * w; }
    LAS float* yb = lds;
#pragma unroll
    for (int i = 0; i < 16; ++i) yb[i * 512 + c] = acc[i];
    __syncthreads();
    const float* lw = P->in[16] + l * 512; const float* lb = P->in[17] + l * 512;
#pragma unroll
    for (int tt = 0; tt < 2; ++tt) { const int ti = wave * 2 + tt, row = t0 + ti;
        f32x4 a = *(const LAS f32x4*)(yb + ti * 512 + 8 * lane), b = *(const LAS f32x4*)(yb + ti * 512 + 8 * lane + 4);
        float s = (a[0] + a[1]) + (a[2] + a[3]) + (b[0] + b[1]) + (b[2] + b[3]);
        const float mean = wave_sum(s) * (1.0f / 512.0f); a = a - mean; b = b - mean;
        float q = (a[0] * a[0] + a[1] * a[1]) + (a[2] * a[2] + a[3] * a[3]) + (b[0] * b[0] + b[1] * b[1]) + (b[2] * b[2] + b[3] * b[3]);
        const float rstd = 1.0f / sqrtf(wave_sum(q) * (1.0f / 512.0f) + 1e-5f);
        const f32x4 w0 = *(const f32x4*)(lw + 8 * lane), w1 = *(const f32x4*)(lw + 8 * lane + 4), b0 = *(const f32x4*)(lb + 8 * lane), b1 = *(const f32x4*)(lb + 8 * lane + 4);
        a = a * rstd * w0 + b0; b = b * rstd * w1 + b1;
        const u32x4 g = *(const u32x4*)(Z + (size_t)row * DIN + C_CG + 8 * lane);
        float o[8];
        o[0] = siluf_(a[0]) * siluf_(bflo(g.x)); o[1] = siluf_(a[1]) * siluf_(bfhi(g.x)); o[2] = siluf_(a[2]) * siluf_(bflo(g.y)); o[3] = siluf_(a[3]) * siluf_(bfhi(g.y));
        o[4] = siluf_(b[0]) * siluf_(bflo(g.z)); o[5] = siluf_(b[1]) * siluf_(bfhi(g.z)); o[6] = siluf_(b[2]) * siluf_(bflo(g.w)); o[7] = siluf_(b[3]) * siluf_(bfhi(g.w));
        u32x4 w; w.x = pk2(o[0], o[1]); w.y = pk2(o[2], o[3]); w.z = pk2(o[4], o[5]); w.w = pk2(o[6], o[7]);
        *(u32x4*)(MIX + (size_t)row * D_MODEL + 1536 + 8 * lane) = w; }
}

typedef short v4i16_t __attribute__((ext_vector_type(4)));
#define SBAR __builtin_amdgcn_sched_barrier(0);
#define R0(i) (((i) & 3) + 8 * ((i) >> 2))
constexpr float ATT_C2 = 0.08838834764831845f * 1.4426950408889634f;
constexpr float LOG2E = 1.4426950408889634f;
constexpr int KROW = 272, VROW = 320, ATT_V_OFF = 64 * KROW;

__device__ __forceinline__ void rope8(bf16x8& a, bf16x8& b, const float* cs) {
#pragma unroll
    for (int j = 0; j < 8; ++j) { const float x1 = bf2f((unsigned short)a[j]), x2 = bf2f((unsigned short)b[j]), c = cs[2 * j], s = cs[2 * j + 1];
        a[j] = (short)f2bf(x1 * c - x2 * s); b[j] = (short)f2bf(x2 * c + x1 * s); }
}
__device__ __forceinline__ bf16x8 cvt8(const float* p) {
    const f32x4 a = *(const f32x4*)p, b = *(const f32x4*)(p + 4); bf16x8 r;
    r[0] = (short)f2bf(a[0]); r[1] = (short)f2bf(a[1]); r[2] = (short)f2bf(a[2]); r[3] = (short)f2bf(a[3]);
    r[4] = (short)f2bf(b[0]); r[5] = (short)f2bf(b[1]); r[6] = (short)f2bf(b[2]); r[7] = (short)f2bf(b[3]); return r;
}

__device__ __forceinline__ void attn_unit(PP P, LAS unsigned char* lds, int l, int kind, int idx, int tid) {
    const int lane = tid & 63, wave = __builtin_amdgcn_readfirstlane(tid >> 6), r32 = lane & 31, hh = lane >> 5;
    const bf16* Z = (const bf16*)(P->ws + WS_Z); bf16* MIX = (bf16*)(P->ws + WS_H); const float* CS = (const float*)(P->ws + WS_CS);
    int b, h, qpos0, grow0, kpos0, klrow0, nloc, ncache;
    if (kind == 0) { b = idx >> 3; h = idx & 7; qpos0 = 0; grow0 = b * 256; kpos0 = 0; klrow0 = b * 256; nloc = 4; ncache = 0; }
    else { const int qb = idx & 7; h = (idx >> 3) & 7; b = idx >> 6; qpos0 = qb * 256; grow0 = NCTX + b * 2048 + qpos0;
        kpos0 = qpos0 - 128 < 0 ? 0 : qpos0 - 128; const int kend = qpos0 + 384 > 2048 ? 2048 : qpos0 + 384; nloc = (kend - kpos0) >> 6; klrow0 = NCTX + b * 2048 + kpos0; ncache = 4; }
    const bool lat = (kind == 1);
    const int kv = h >> 2;
    const int qrow = grow0 + 32 * wave + r32, qpos = qpos0 + 32 * wave + r32, qw0 = qpos0 + 32 * wave;
    bf16x8 qf[8];
    { const bf16* qp = Z + (size_t)qrow * DIN + C_AQ + h * 128 + 8 * hh;
#pragma unroll
      for (int s = 0; s < 8; ++s) qf[s] = *(const bf16x8*)(qp + 16 * s);
      if (lat) { const float* c0 = CS + ((qpos >> 6) * 32 + 8 * hh) * 2; const float* c1 = CS + ((qpos & 63) * 32 + 8 * hh) * 2;
          rope8(qf[0], qf[2], c0); rope8(qf[1], qf[3], c0 + 32); rope8(qf[4], qf[6], c1); rope8(qf[5], qf[7], c1 + 32); } }
    f32x16 O[4];
#pragma unroll
    for (int d = 0; d < 4; ++d)
#pragma unroll
        for (int i = 0; i < 16; ++i) O[d][i] = 0.f;
    float m = P->in[11][l * 8 + h] * LOG2E, lsum = (hh == 0) ? 1.0f : 0.0f;
    const int skey = tid >> 3, cp = tid & 7, c1 = (cp >> 2) * 8 + (cp & 3), sd0 = 8 * c1;
    const int ntiles = nloc + ncache;
    for (int ti = 0; ti < ntiles; ++ti) {
        __syncthreads();
        {
            bf16x8 k1, k2, v1, v2;
            if (ti < nloc) {
                const int krow = klrow0 + 64 * ti + skey; const bf16* kp = Z + (size_t)krow * DIN + C_AK + kv * 128 + sd0; const bf16* vp = Z + (size_t)krow * DIN + C_AV + kv * 128 + sd0;
                k1 = *(const bf16x8*)kp; k2 = *(const bf16x8*)(kp + 32); v1 = *(const bf16x8*)vp; v2 = *(const bf16x8*)(vp + 32);
                if (lat) { const int kpos = kpos0 + 64 * ti + skey; const int pos = (cp < 4) ? (kpos >> 6) : (kpos & 63); rope8(k1, k2, CS + (pos * 32 + 8 * (cp & 3)) * 2); }
            } else {
                const int key = 64 * (ti - nloc) + skey; const size_t off = ((size_t)((b * 2 + l) * 256 + key) * 2 + kv) * 128 + sd0;
                k1 = cvt8(P->in[2] + off); k2 = cvt8(P->in[2] + off + 32); v1 = cvt8(P->in[3] + off); v2 = cvt8(P->in[3] + off + 32);
            }
            *(LAS bf16x8*)(lds + skey * KROW + sd0 * 2) = k1; *(LAS bf16x8*)(lds + skey * KROW + sd0 * 2 + 64) = k2;
            *(LAS bf16x8*)(lds + ATT_V_OFF + skey * VROW + sd0 * 2) = v1; *(LAS bf16x8*)(lds + ATT_V_OFF + skey * VROW + sd0 * 2 + 64) = v2;
        }
        __syncthreads();
        const bool local = lat && (ti < nloc);
        const int tk0 = kpos0 + 64 * ti;
        bool skip = false;
        if (local) skip = (tk0 > qw0 + 31 + 128) || (tk0 + 63 < qw0 - 128);
        if (!skip) {
            f32x16 p0, p1;
#pragma unroll
            for (int i = 0; i < 16; ++i) { p0[i] = 0.f; p1[i] = 0.f; }
            const LAS unsigned char* kb = lds + r32 * KROW + 16 * hh;
#pragma unroll
            for (int s = 0; s < 8; ++s) { const bf16x8 kf0 = *(const LAS bf16x8*)(kb + 32 * s), kf1 = *(const LAS bf16x8*)(kb + 32 * KROW + 32 * s);
                p0 = __builtin_amdgcn_mfma_f32_32x32x16_bf16(kf0, qf[s], p0, 0, 0, 0); p1 = __builtin_amdgcn_mfma_f32_32x32x16_bf16(kf1, qf[s], p1, 0, 0, 0); }
            float mx = -1e30f;
#pragma unroll
            for (int i = 0; i < 16; ++i) { float a = p0[i] * ATT_C2, c = p1[i] * ATT_C2;
                if (local) { const int kp = tk0 + R0(i) + 4 * hh; const int d0 = qpos - kp, d1 = qpos - kp - 32;
                    if (d0 > 128 || d0 < -128) a = -1e30f; if (d1 > 128 || d1 < -128) c = -1e30f; }
                p0[i] = a; p1[i] = c; mx = fmaxf(mx, fmaxf(a, c)); }
            mx = fmaxf(mx, __shfl_xor(mx, 32));
            const float mn = fmaxf(m, mx), alpha = __builtin_amdgcn_exp2f(m - mn); m = mn;
            float ps = 0.f;
#pragma unroll
            for (int i = 0; i < 16; ++i) { p0[i] = __builtin_amdgcn_exp2f(p0[i] - mn); p1[i] = __builtin_amdgcn_exp2f(p1[i] - mn); ps += p0[i] + p1[i]; }
            lsum = lsum * alpha + ps;
#pragma unroll
            for (int d = 0; d < 4; ++d)
#pragma unroll
                for (int i = 0; i < 16; ++i) O[d][i] *= alpha;
            bf16x8 pb[4];
#pragma unroll
            for (int s = 0; s < 2; ++s)
#pragma unroll
                for (int j = 0; j < 8; ++j) { pb[s][j] = (short)f2bf(p0[8 * s + j]); pb[2 + s][j] = (short)f2bf(p1[8 * s + j]); }
            const int i16 = lane & 15;
            const LAS unsigned char* vb = lds + ATT_V_OFF + (4 * hh + (i16 >> 2)) * VROW + (16 * ((lane >> 4) & 1) + 4 * (i16 & 3)) * 2;
#pragma unroll
            for (int dt = 0; dt < 4; ++dt)
#pragma unroll
                for (int ks = 0; ks < 4; ++ks) {
                    const LAS unsigned char* vp = vb + (16 * ks) * VROW + 64 * dt;
                    const v4i16_t lo = __builtin_amdgcn_ds_read_tr16_b64_v4i16((LAS v4i16_t*)vp), hi = __builtin_amdgcn_ds_read_tr16_b64_v4i16((LAS v4i16_t*)(vp + 8 * VROW));
                    const bf16x8 vf = (bf16x8){lo[0], lo[1], lo[2], lo[3], hi[0], hi[1], hi[2], hi[3]};
                    O[dt] = __builtin_amdgcn_mfma_f32_32x32x16_bf16(vf, pb[ks], O[dt], 0, 0, 0);
                }
        }
    }
    const float ltot = lsum + __shfl_xor(lsum, 32), inv = 1.0f / ltot;
    const bf16* gp = Z + (size_t)qrow * DIN + C_AG + h * 128 + 4 * hh; bf16* op = MIX + (size_t)qrow * D_MODEL + h * 128 + 4 * hh;
#pragma unroll
    for (int dt = 0; dt < 4; ++dt)
#pragma unroll
        for (int i4 = 0; i4 < 4; ++i4) { const int d0 = 32 * dt + 8 * i4; const u32x2 g = *(const u32x2*)(gp + d0);
            const float o0 = O[dt][4 * i4 + 0] * inv * siluf_(bflo(g.x)), o1 = O[dt][4 * i4 + 1] * inv * siluf_(bfhi(g.x));
            const float o2 = O[dt][4 * i4 + 2] * inv * siluf_(bflo(g.y)), o3 = O[dt][4 * i4 + 3] * inv * siluf_(bfhi(g.y));
            u32x2 w; w.x = pk2(o0, o1); w.y = pk2(o2, o3); *(u32x2*)(op + d0) = w; }
}

__device__ __forceinline__ float hg_lb(PP P, int l, int dir, int hd) {
    if (l == 0) return 0.0f;
    const float* hb = P->in[12] + dir * 1024; return sigmoidf_(hb[512 + hd] - hb[hd]);
}
constexpr int H2_TG = 0, H2_QE = 16896, H2_KE = 25600, H2_QG = 34304, H2_KG = 42752, H2_V = 52992, H2_OBA = 63232, H2_OBB = 80128, H2_DK = 97024;
constexpr size_t WS_DLC_OFF = 0;
__device__ __forceinline__ bf16x8 trpair(const LAS unsigned char* p, int second_off) {
    const v4i16_t lo = __builtin_amdgcn_ds_read_tr16_b64_v4i16((LAS v4i16_t*)p), hi = __builtin_amdgcn_ds_read_tr16_b64_v4i16((LAS v4i16_t*)(p + second_off));
    return (bf16x8){lo[0], lo[1], lo[2], lo[3], hi[0], hi[1], hi[2], hi[3]};
}
__device__ __forceinline__ bf16x8 pack8(float a, float b, float c, float d, float e, float f, float g, float h) {
    bf16x8 r; r[0] = (short)f2bf(a); r[1] = (short)f2bf(b); r[2] = (short)f2bf(c); r[3] = (short)f2bf(d); r[4] = (short)f2bf(e); r[5] = (short)f2bf(f); r[6] = (short)f2bf(g); r[7] = (short)f2bf(h); return r;
}
__device__ __forceinline__ void hgrn2_unit(PP P, LAS unsigned char* lds, int l, int kind, int idx, int tid) {
    const int lane = tid & 63, wave = __builtin_amdgcn_readfirstlane(tid >> 6), r32 = lane & 31, hh = lane >> 5, i16 = lane & 15, cg = (lane >> 4) & 1;
    const bf16* Z = (const bf16*)(P->ws + WS_Z); bf16* MIX = (bf16*)(P->ws + WS_H); float* OL = (float*)(P->ws + WS_OL);
    LAS float* ldsf = (LAS float*)lds;
    int h, row0, seglen, nch, b = 0;
    if (kind == 0) { b = idx >> 2; h = idx & 3; row0 = b * 256; seglen = 256; nch = 8; }
    else { const int blk = idx & 15; h = (idx >> 4) & 3; const int lb = idx >> 6; row0 = NCTX + lb * 2048 + blk * 128; seglen = 128; nch = 4; }
    const int ti = tid >> 4, d0 = 8 * (tid & 15), nt = wave & 3, kp = wave >> 2;
    for (int dir = 0; dir < 2; ++dir) {
        float oml[8];
#pragma unroll
        for (int j = 0; j < 8; ++j) oml[j] = 1.0f - hg_lb(P, l, dir, h * 128 + d0 + j);
        const int cf = dir ? C_HFB : C_HFF;
        f32x16 S0, S1;
#pragma unroll
        for (int i = 0; i < 16; ++i) { S0[i] = 0.f; S1[i] = 0.f; }
        const int uidx = (kind == 1) ? ((idx >> 4) * 2 + dir) * 16 + (idx & 15) : 0;
        u32x4 uq, uv, uf;
        { const int row = dir ? row0 + seglen - 1 - ti : row0 + ti; const bf16* zr = Z + (size_t)row * DIN + h * 128 + d0;
          uq = *(const u32x4*)(zr + C_HQ); uv = *(const u32x4*)(zr + C_HI); uf = *(const u32x4*)(zr + cf); }
        for (int c = 0; c < nch; ++c) {
            const int nc = dir ? nch - 1 - c : c; const int rown = row0 + 32 * nc + ti;
            f32x4 olp0 = {0.f, 0.f, 0.f, 0.f}, olp1 = {0.f, 0.f, 0.f, 0.f}; u32x4 ug = {0u, 0u, 0u, 0u};
            float* olr = OL + (size_t)rown * 512 + h * 128 + d0;
            if (dir == 1) { olp0 = *(const f32x4*)olr; olp1 = *(const f32x4*)(olr + 4); if (kind == 0) ug = *(const u32x4*)(Z + (size_t)rown * DIN + C_HG + h * 128 + d0); }
            float q[8], kk[8];
            {
                float g2[8], vv[8];
#pragma unroll
                for (int j = 0; j < 4; ++j) { const unsigned wq = uq[j], wv = uv[j], wf = uf[j];
                    q[2 * j] = siluf_(bflo(wq)) * 0.08838834764831845f; q[2 * j + 1] = siluf_(bfhi(wq)) * 0.08838834764831845f;
                    vv[2 * j] = bflo(wv); vv[2 * j + 1] = bfhi(wv);
                    kk[2 * j] = oml[2 * j] * sigmoidf_(-bflo(wf)); kk[2 * j + 1] = oml[2 * j + 1] * sigmoidf_(-bfhi(wf)); }
#pragma unroll
                for (int j = 0; j < 8; ++j) g2[j] = __builtin_amdgcn_logf(1.0f - fminf(kk[j], 1.0f - 1e-6f));
                LAS float* pg = ldsf + (H2_TG >> 2) + ti * 132 + d0;
                *(LAS f32x4*)pg = (f32x4){g2[0], g2[1], g2[2], g2[3]}; *(LAS f32x4*)(pg + 4) = (f32x4){g2[4], g2[5], g2[6], g2[7]};
                *(LAS u32x4*)(lds + H2_V + ti * 320 + d0 * 2) = uv;
            }
            if (c + 1 < nch) { const int tl = 32 * (c + 1) + ti; const int row = dir ? row0 + seglen - 1 - tl : row0 + tl; const bf16* zr = Z + (size_t)row * DIN + h * 128 + d0;
                uq = *(const u32x4*)(zr + C_HQ); uv = *(const u32x4*)(zr + C_HI); uf = *(const u32x4*)(zr + cf); }
            __syncthreads();
            if (tid < 128) {
                LAS float* gc = ldsf + (H2_TG >> 2) + tid; float run = 0.f;
#pragma unroll
                for (int i = 0; i < 32; ++i) { run += gc[i * 132]; gc[i * 132] = run; }
                ldsf[(H2_DK >> 2) + tid] = __builtin_amdgcn_exp2f(run);
                if (kind == 1) ((float*)(P->ws + WS_DLOG))[(uidx * 4 + c) * 128 + tid] = run;
            }
            __syncthreads();
            {
                const LAS float* gr = ldsf + (H2_TG >> 2) + ti * 132 + d0; const LAS float* gm = ldsf + (H2_TG >> 2) + 15 * 132 + d0; const LAS float* gl = ldsf + (H2_TG >> 2) + 31 * 132 + d0;
                float qe[8], ke[8], qg[8], kg[8];
#pragma unroll
                for (int j = 0; j < 8; ++j) { const float G = gr[j], Gm = gm[j], Gl = gl[j];
                    qe[j] = q[j] * __builtin_amdgcn_exp2f(fminf(G - Gm, 100.f)); ke[j] = kk[j] * __builtin_amdgcn_exp2f(fminf(Gm - G, 100.f));
                    qg[j] = q[j] * __builtin_amdgcn_exp2f(G); kg[j] = kk[j] * __builtin_amdgcn_exp2f(Gl - G); }
                *(LAS bf16x8*)(lds + H2_QE + ti * 272 + d0 * 2) = pack8(qe[0], qe[1], qe[2], qe[3], qe[4], qe[5], qe[6], qe[7]);
                *(LAS bf16x8*)(lds + H2_KE + ti * 272 + d0 * 2) = pack8(ke[0], ke[1], ke[2], ke[3], ke[4], ke[5], ke[6], ke[7]);
                *(LAS bf16x8*)(lds + H2_KG + ti * 320 + d0 * 2) = pack8(kg[0], kg[1], kg[2], kg[3], kg[4], kg[5], kg[6], kg[7]);
                u32x2 w0, w1; w0.x = pk2(qg[0], qg[1]); w0.y = pk2(qg[2], qg[3]); w1.x = pk2(qg[4], qg[5]); w1.y = pk2(qg[6], qg[7]);
                *(LAS u32x2*)(lds + H2_QG + ti * 264 + d0 * 2) = w0; *(LAS u32x2*)(lds + H2_QG + ti * 264 + d0 * 2 + 8) = w1;
            }
            __syncthreads();
            {
                f32x16 at;
#pragma unroll
                for (int i = 0; i < 16; ++i) at[i] = 0.f;
                const LAS unsigned char* kep = lds + H2_KE + r32 * 272 + 16 * hh; const LAS unsigned char* qep = lds + H2_QE + r32 * 272 + 16 * hh;
#pragma unroll
                for (int k = 0; k < 8; ++k) at = __builtin_amdgcn_mfma_f32_32x32x16_bf16(*(const LAS bf16x8*)(kep + 32 * k), *(const LAS bf16x8*)(qep + 32 * k), at, 0, 0, 0);
                float am[8];
#pragma unroll
                for (int j = 0; j < 8; ++j) { const float lo = at[j], hi = at[8 + j]; const float v = kp ? hi : lo; const int s = 16 * kp + 8 * (j >> 2) + 4 * hh + (j & 3); am[j] = (s <= r32) ? v : 0.f; }
                const bf16x8 afrag = pack8(am[0], am[1], am[2], am[3], am[4], am[5], am[6], am[7]);
                f32x16 ot;
#pragma unroll
                for (int i = 0; i < 16; ++i) ot[i] = 0.f;
                { const bf16x8 vfrag = trpair(lds + H2_V + (16 * kp + 4 * hh + (i16 >> 2)) * 320 + (32 * nt + 16 * cg + 4 * (i16 & 3)) * 2, 8 * 320);
                  ot = __builtin_amdgcn_mfma_f32_32x32x16_bf16(vfrag, afrag, ot, 0, 0, 0); }
                const LAS unsigned char* qgp = lds + H2_QG + r32 * 264 + (64 * kp + 4 * hh) * 2;
#pragma unroll
                for (int kl = 0; kl < 2; ++kl)
#pragma unroll
                    for (int sp = 0; sp < 2; ++sp) {
                        const u32x2 qlo = *(const LAS u32x2*)(qgp + (32 * kl + 16 * sp) * 2), qhi = *(const LAS u32x2*)(qgp + (32 * kl + 16 * sp) * 2 + 16);
                        const u32x4 qq = {qlo.x, qlo.y, qhi.x, qhi.y};
                        bf16x8 sfrag;
                        if (kl == 0) sfrag = pack8(S0[8 * sp], S0[8 * sp + 1], S0[8 * sp + 2], S0[8 * sp + 3], S0[8 * sp + 4], S0[8 * sp + 5], S0[8 * sp + 6], S0[8 * sp + 7]);
                        else sfrag = pack8(S1[8 * sp], S1[8 * sp + 1], S1[8 * sp + 2], S1[8 * sp + 3], S1[8 * sp + 4], S1[8 * sp + 5], S1[8 * sp + 6], S1[8 * sp + 7]);
                        ot = __builtin_amdgcn_mfma_f32_32x32x16_bf16(sfrag, __builtin_bit_cast(bf16x8, qq), ot, 0, 0, 0);
                    }
                { LAS float* ob = ldsf + ((kp ? H2_OBB : H2_OBA) >> 2) + (32 * nt + 4 * hh) * 33 + r32;
#pragma unroll
                  for (int i = 0; i < 16; ++i) ob[R0(i) * 33] = ot[i]; }
                const LAS float* dkp = ldsf + (H2_DK >> 2) + 64 * kp + 4 * hh;
#pragma unroll
                for (int i = 0; i < 16; ++i) { S0[i] *= dkp[R0(i)]; S1[i] *= dkp[32 + R0(i)]; }
#pragma unroll
                for (int ks = 0; ks < 2; ++ks) {
                    const int roff = (16 * ks + 8 * hh + (i16 >> 2)) * 320, coff = (16 * cg + 4 * (i16 & 3)) * 2;
                    const bf16x8 vf = trpair(lds + H2_V + roff + 64 * nt + coff, 4 * 320);
                    const bf16x8 k0 = trpair(lds + H2_KG + roff + 64 * (2 * kp) + coff, 4 * 320), k1 = trpair(lds + H2_KG + roff + 64 * (2 * kp + 1) + coff, 4 * 320);
                    S0 = __builtin_amdgcn_mfma_f32_32x32x16_bf16(k0, vf, S0, 0, 0, 0); S1 = __builtin_amdgcn_mfma_f32_32x32x16_bf16(k1, vf, S1, 0, 0, 0);
                }
            }
            __syncthreads();
            {
                const int t = dir ? 31 - ti : ti;
                const LAS float* oa = ldsf + (H2_OBA >> 2) + d0 * 33 + t; const LAS float* obb = ldsf + (H2_OBB >> 2) + d0 * 33 + t;
                float o[8];
#pragma unroll
                for (int j = 0; j < 8; ++j) o[j] = oa[j * 33] + obb[j * 33];
                if (dir == 1) { o[0] += olp0[0]; o[1] += olp0[1]; o[2] += olp0[2]; o[3] += olp0[3]; o[4] += olp1[0]; o[5] += olp1[1]; o[6] += olp1[2]; o[7] += olp1[3]; }
                if (dir == 0 || kind == 1) { *(f32x4*)olr = (f32x4){o[0], o[1], o[2], o[3]}; *(f32x4*)(olr + 4) = (f32x4){o[4], o[5], o[6], o[7]}; }
                else {
                    float ss = 0.f;
#pragma unroll
                    for (int j = 0; j < 8; ++j) ss += o[j] * o[j];
                    ss += __shfl_xor(ss, 1); ss += __shfl_xor(ss, 2); ss += __shfl_xor(ss, 4); ss += __shfl_xor(ss, 8);
                    const float r = 1.0f / sqrtf(ss * (1.0f / 128.0f) + 1e-6f);
                    const float* nw = P->in[13] + l * 512 + h * 128 + d0; const f32x4 n0 = *(const f32x4*)nw, n1 = *(const f32x4*)(nw + 4);
                    u32x4 w;
                    w.x = pk2(o[0] * r * n0[0] * siluf_(bflo(ug.x)), o[1] * r * n0[1] * siluf_(bfhi(ug.x))); w.y = pk2(o[2] * r * n0[2] * siluf_(bflo(ug.y)), o[3] * r * n0[3] * siluf_(bfhi(ug.y)));
                    w.z = pk2(o[4] * r * n1[0] * siluf_(bflo(ug.z)), o[5] * r * n1[1] * siluf_(bfhi(ug.z))); w.w = pk2(o[6] * r * n1[2] * siluf_(bflo(ug.w)), o[7] * r * n1[3] * siluf_(bfhi(ug.w)));
                    *(u32x4*)(MIX + (size_t)rown * D_MODEL + 1024 + h * 128 + d0) = w;
                }
            }
        }
        {
            float* Sd = (kind == 0) ? P->out + OUT_ST + (size_t)((((b * 2 + l) * 2 + dir) * 4 + h)) * 16384 : (float*)(P->ws + WS_U) + (size_t)uidx * 16384;
            float* sp = Sd + (64 * kp + 4 * hh) * 128 + 32 * nt + r32;
#pragma unroll
            for (int i = 0; i < 16; ++i) { sp[R0(i) * 128] = S0[i]; sp[(32 + R0(i)) * 128] = S1[i]; }
        }
    }
}

__device__ __forceinline__ void hgrn_scan(PP P, int l, int tid) {
    float* U = (float*)(P->ws + WS_U); const float* DLC = (const float*)(P->ws + WS_DLOG);
    for (int e = blockIdx.x * NTHREADS + tid; e < 16 * 16384; e += gridDim.x * NTHREADS) {
        const int sq = e >> 14, el = e & 16383, dk = el >> 7, lb = sq >> 3, h = (sq >> 1) & 3, dir = sq & 1;
        float S = P->in[4][(size_t)((((lb * 2 + l) * 2 + dir) * 4 + h)) * 16384 + el];
        float u[16], dl[16];
#pragma unroll
        for (int p = 0; p < 16; ++p) { const int blk = dir ? 15 - p : p; const int uidx = sq * 16 + blk; u[p] = U[(size_t)uidx * 16384 + el];
            const float* d = DLC + (uidx * 4) * 128 + dk; dl[p] = (d[0] + d[128]) + (d[256] + d[384]); }
#pragma unroll
        for (int p = 0; p < 16; ++p) { const int blk = dir ? 15 - p : p; const int uidx = sq * 16 + blk; U[(size_t)uidx * 16384 + el] = S; S = __builtin_amdgcn_exp2f(dl[p]) * S + u[p]; }
    }
}

constexpr int HF_S0 = 0, HF_S1 = 40960, HF_TG0 = 81920, HF_TG1 = 98816, HF_QG0 = 115712, HF_QG1 = 124416;
__device__ __forceinline__ void hgrn_final_unit(PP P, LAS unsigned char* lds, int l, int idx, int tid) {
    const int lane = tid & 63, wave = __builtin_amdgcn_readfirstlane(tid >> 6), r32 = lane & 31, hh = lane >> 5, i16 = lane & 15, cg = (lane >> 4) & 1;
    const bf16* Z = (const bf16*)(P->ws + WS_Z); bf16* MIX = (bf16*)(P->ws + WS_H); const float* OL = (const float*)(P->ws + WS_OL); const float* DLC = (const float*)(P->ws + WS_DLOG);
    LAS float* ldsf = (LAS float*)lds;
    const int blk = idx & 15, h = (idx >> 4) & 3, lb = idx >> 6, row0 = NCTX + lb * 2048 + blk * 128;
    const int ti = tid >> 4, d0 = 8 * (tid & 15), nt = wave & 3, ds = wave >> 2;
    const int uidx0 = ((idx >> 4) * 2 + 0) * 16 + blk, uidx1 = ((idx >> 4) * 2 + 1) * 16 + blk;
#pragma unroll
    for (int half = 0; half < 2; ++half) {
        f32x4 sv[8];
#pragma unroll
        for (int k = 0; k < 8; ++k) { const int id = tid + 512 * (k + 8 * half), dsel = id >> 12, dk = (id >> 5) & 127, c4 = id & 31;
            sv[k] = *(const f32x4*)((const float*)(P->ws + WS_U) + (size_t)(dsel ? uidx1 : uidx0) * 16384 + dk * 128 + c4 * 4); }
#pragma unroll
        for (int k = 0; k < 8; ++k) { const int id = tid + 512 * (k + 8 * half), dsel = id >> 12, dk = (id >> 5) & 127, c4 = id & 31;
            u32x2 w; w.x = pk2(sv[k][0], sv[k][1]); w.y = pk2(sv[k][2], sv[k][3]); *(LAS u32x2*)(lds + (dsel ? HF_S1 : HF_S0) + dk * 320 + c4 * 8) = w; }
    }
    float oml0[8], oml1[8];
#pragma unroll
    for (int j = 0; j < 8; ++j) { oml0[j] = 1.0f - hg_lb(P, l, 0, h * 128 + d0 + j); oml1[j] = 1.0f - hg_lb(P, l, 1, h * 128 + d0 + j); }
    float carry = 0.f;
    for (int nc = 0; nc < 4; ++nc) {
        const int rown = row0 + 32 * nc + ti; const bf16* zr = Z + (size_t)rown * DIN + h * 128 + d0;
        const u32x4 uq = *(const u32x4*)(zr + C_HQ), uf0 = *(const u32x4*)(zr + C_HFF), uf1 = *(const u32x4*)(zr + C_HFB), ug = *(const u32x4*)(zr + C_HG);
        const float* olr = OL + (size_t)rown * 512 + h * 128 + d0; const f32x4 olp0 = *(const f32x4*)olr, olp1 = *(const f32x4*)(olr + 4);
        float off1 = 0.f;
        if (tid >= 128 && tid < 256) { for (int c = 0; c < 3 - nc; ++c) off1 += DLC[(uidx1 * 4 + c) * 128 + (tid - 128)]; }
        float q[8];
        {
            float ga[8], gb[8];
#pragma unroll
            for (int j = 0; j < 4; ++j) { const unsigned wq = uq[j], wa = uf0[j], wb = uf1[j];
                q[2 * j] = siluf_(bflo(wq)) * 0.08838834764831845f; q[2 * j + 1] = siluf_(bfhi(wq)) * 0.08838834764831845f;
                ga[2 * j] = oml0[2 * j] * sigmoidf_(-bflo(wa)); ga[2 * j + 1] = oml0[2 * j + 1] * sigmoidf_(-bfhi(wa));
                gb[2 * j] = oml1[2 * j] * sigmoidf_(-bflo(wb)); gb[2 * j + 1] = oml1[2 * j + 1] * sigmoidf_(-bfhi(wb)); }
#pragma unroll
            for (int j = 0; j < 8; ++j) { ga[j] = __builtin_amdgcn_logf(1.0f - fminf(ga[j], 1.0f - 1e-6f)); gb[j] = __builtin_amdgcn_logf(1.0f - fminf(gb[j], 1.0f - 1e-6f)); }
            LAS float* p0 = ldsf + (HF_TG0 >> 2) + ti * 132 + d0; LAS float* p1 = ldsf + (HF_TG1 >> 2) + ti * 132 + d0;
            *(LAS f32x4*)p0 = (f32x4){ga[0], ga[1], ga[2], ga[3]}; *(LAS f32x4*)(p0 + 4) = (f32x4){ga[4], ga[5], ga[6], ga[7]};
            *(LAS f32x4*)p1 = (f32x4){gb[0], gb[1], gb[2], gb[3]}; *(LAS f32x4*)(p1 + 4) = (f32x4){gb[4], gb[5], gb[6], gb[7]};
        }
        __syncthreads();
        if (tid < 128) { LAS float* gc = ldsf + (HF_TG0 >> 2) + tid; float run = carry;
#pragma unroll
            for (int i = 0; i < 32; ++i) { run += gc[i * 132]; gc[i * 132] = run; }
            carry = run; }
        else if (tid < 256) { LAS float* gc = ldsf + (HF_TG1 >> 2) + (tid - 128); float run = off1;
#pragma unroll
            for (int i = 31; i >= 0; --i) { run += gc[i * 132]; gc[i * 132] = run; } }
        __syncthreads();
        {
            const LAS float* g0 = ldsf + (HF_TG0 >> 2) + ti * 132 + d0; const LAS float* g1 = ldsf + (HF_TG1 >> 2) + ti * 132 + d0;
            float a[8], c[8];
#pragma unroll
            for (int j = 0; j < 8; ++j) { a[j] = q[j] * __builtin_amdgcn_exp2f(g0[j]); c[j] = q[j] * __builtin_amdgcn_exp2f(g1[j]); }
            *(LAS bf16x8*)(lds + HF_QG0 + ti * 272 + d0 * 2) = pack8(a[0], a[1], a[2], a[3], a[4], a[5], a[6], a[7]);
            *(LAS bf16x8*)(lds + HF_QG1 + ti * 272 + d0 * 2) = pack8(c[0], c[1], c[2], c[3], c[4], c[5], c[6], c[7]);
        }
        __syncthreads();
        {
            f32x16 acc;
#pragma unroll
            for (int i = 0; i < 16; ++i) acc[i] = 0.f;
            const LAS unsigned char* qp = lds + (ds ? HF_QG1 : HF_QG0) + r32 * 272 + 16 * hh;
            const LAS unsigned char* sp = lds + (ds ? HF_S1 : HF_S0) + (8 * hh + (i16 >> 2)) * 320 + (32 * nt + 16 * cg + 4 * (i16 & 3)) * 2;
#pragma unroll
            for (int k = 0; k < 8; ++k) { const bf16x8 sf = trpair(sp + 16 * k * 320, 4 * 320); acc = __builtin_amdgcn_mfma_f32_32x32x16_bf16(*(const LAS bf16x8*)(qp + 32 * k), sf, acc, 0, 0, 0); }
            LAS float* ob = ldsf + ((ds ? HF_TG1 : HF_TG0) >> 2) + (4 * hh) * 132 + 32 * nt + r32;
#pragma unroll
            for (int i = 0; i < 16; ++i) ob[R0(i) * 132] = acc[i];
        }
        __syncthreads();
        {
            const LAS float* oa = ldsf + (HF_TG0 >> 2) + ti * 132 + d0; const LAS float* obb = ldsf + (HF_TG1 >> 2) + ti * 132 + d0;
            const f32x4 a0 = *(const LAS f32x4*)oa, a1 = *(const LAS f32x4*)(oa + 4), b0 = *(const LAS f32x4*)obb, b1 = *(const LAS f32x4*)(obb + 4);
            const f32x4 o0 = a0 + b0 + olp0, o1 = a1 + b1 + olp1;
            float ss = (o0[0] * o0[0] + o0[1] * o0[1]) + (o0[2] * o0[2] + o0[3] * o0[3]) + (o1[0] * o1[0] + o1[1] * o1[1]) + (o1[2] * o1[2] + o1[3] * o1[3]);
            ss += __shfl_xor(ss, 1); ss += __shfl_xor(ss, 2); ss += __shfl_xor(ss, 4); ss += __shfl_xor(ss, 8);
            const float r = 1.0f / sqrtf(ss * (1.0f / 128.0f) + 1e-6f);
            const float* nw = P->in[13] + l * 512 + h * 128 + d0; const f32x4 n0 = *(const f32x4*)nw, n1 = *(const f32x4*)(nw + 4);
            u32x4 w;
            w.x = pk2(o0[0] * r * n0[0] * siluf_(bflo(ug.x)), o0[1] * r * n0[1] * siluf_(bfhi(ug.x))); w.y = pk2(o0[2] * r * n0[2] * siluf_(bflo(ug.y)), o0[3] * r * n0[3] * siluf_(bfhi(ug.y)));
            w.z = pk2(o1[0] * r * n1[0] * siluf_(bflo(ug.z)), o1[1] * r * n1[1] * siluf_(bfhi(ug.z))); w.w = pk2(o1[2] * r * n1[2] * siluf_(bflo(ug.w)), o1[3] * r * n1[3] * siluf_(bfhi(ug.w)));
            *(u32x4*)(MIX + (size_t)rown * D_MODEL + 1024 + h * 128 + d0) = w;
        }
        __syncthreads();
    }
}

#ifndef REP_P0
#define REP_P0 1
#endif
#ifndef REP_P1
#define REP_P1 1
#endif
#ifndef REP_P2
#define REP_P2 1
#endif
#ifndef P2_MASK
#define P2_MASK 31
#endif
#ifndef REP_P3
#define REP_P3 1
#endif
#ifndef REP_P4
#define REP_P4 1
#endif
__global__ void __launch_bounds__(NTHREADS, 2) fwd_kernel(Params Pkarg) {
    extern __shared__ __attribute__((aligned(16))) unsigned char lds_raw[];
    cg::grid_group grid = cg::this_grid();
    LAS unsigned char* lds = (LAS unsigned char*)lds_raw;
    LAS float* ldsf = (LAS float*)lds;
    volatile LAS unsigned* qslot = (volatile LAS unsigned*)(lds + 131072 + 1024);
#define PHASE_IDS int tid = threadIdx.x; asm volatile("" : "+v"(tid)); const int lane = tid & 63, wave = __builtin_amdgcn_readfirstlane(tid >> 6), gw = blockIdx.x * NWAVES + wave; (void)lane; (void)gw; \
    PP P = (PP)__builtin_amdgcn_kernarg_segment_ptr(); asm volatile("" : "+s"(P)); unsigned char* ws = P->ws; unsigned* ctl = (unsigned*)(ws + WS_CTL); float* MOD = (float*)(ws + WS_MOD); \
    bf16* H = (bf16*)(ws + WS_H); bf16* Z = (bf16*)(ws + WS_Z); bf16* WTIN = (bf16*)(ws + WS_WTIN); bf16* WTOUT = (bf16*)(ws + WS_WTOUT); const float* xp = P->in[0]; const float* xs = P->in[1]; \
    (void)ctl; (void)MOD; (void)H; (void)Z; (void)WTIN; (void)WTOUT; (void)xp; (void)xs;
    const int G = gridDim.x, NGW = G * NWAVES;

    for (int rep = 0; rep < REP_P0; ++rep) {
        PHASE_IDS
        for (int u = blockIdx.x; u < 384; u += G) mod_unit(P, ldsf, u / 192, u % 192, tid);
        LAS float* scr = ldsf + wave * 4096;
        for (int it = gw; it < 6656 + 2048 + 2048; it += NGW) {
            if (it < 6656) transpose_item(P->in[9], 2048, DIN, WTIN, scr, it, lane);
            else if (it < 6656 + 2048) transpose_item(P->in[10], 2048, 2048, WTOUT, scr, it - 6656, lane);
            else transpose_item(P->in[10] + (size_t)2048 * 2048, 2048, 2048, WTOUT + (size_t)2048 * 2048, scr, it - 6656 - 2048, lane);
        }
        const int gt = blockIdx.x * NTHREADS + tid;
        if (gt < 2048) { const int pos = gt >> 5, i = gt & 31; const float inv = powf(10000.0f, -(float)i / 32.0f); const float ang = (float)pos * inv;
            float sn, cs; sincosf(ang, &sn, &cs); float* CS = (float*)(ws + WS_CS); CS[gt * 2] = cs; CS[gt * 2 + 1] = sn; }
        grid.sync();
    }
    { PHASE_IDS
    for (int row = gw; row < MTOK; row += NGW) {
        const int cond = (row < NCTX) ? 0 : 1 + ((row - NCTX) >> 11);
        const float* xrow = (row < NCTX) ? xp + (size_t)row * D_MODEL : xs + (size_t)(row - NCTX) * D_MODEL;
        hprep_row(xrow, MOD + (0 * 3 + cond) * 6144, H + (size_t)row * D_MODEL, lane);
    } }
    grid.sync();

    for (int l = 0; l < DEPTH; ++l) {
        for (int rep = 0; rep < REP_P1; ++rep) {
            PHASE_IDS
            pg8::Gemm g{H, WTIN, MTOK, DIN, D_MODEL}; pg8::StaticOrder S; S.init(MTOK, DIN, G, (int)blockIdx.x);
            pg8::EpiZ E{Z, P->out + OUT_CK, P->out + OUT_CV, l};
            pg8::gemm_phase<pg8::EpiZ, pg8::StaticOrder, true, true>(lds, g, S, E);
            grid.sync();
        }
        for (int rep = 0; rep < REP_P2; ++rep) {
            PHASE_IDS
            unsigned* ctr = ctl + 64 * (l * 2 + 0 + 4 * rep);
            const int n_cvt = (l == 0) ? 832 : 0;
            const int msk = (rep == 0) ? 31 : P2_MASK;
            for (;;) {
                asm volatile("" : "+v"(tid));
                int u = next_unit(ctr, qslot, tid);
                if (u >= 1408 + n_cvt) break;
                if (u < 128) { if (msk & 2) attn_unit(P, lds, l, 1, u, tid); continue; } u -= 128;
                if (u < 128) { if (msk & 1) hgrn2_unit(P, lds, l, 0, u, tid); continue; } u -= 128;
                if (u < 256) { if (msk & 4) attn_unit(P, lds, l, 0, u, tid); continue; } u -= 256;
                if (u < 128) { if (msk & 1) hgrn2_unit(P, lds, l, 1, u, tid); continue; } u -= 128;
                if (u < 768) { if (msk & 8) conv_unit(P, ldsf, l, u, tid); continue; } u -= 768;
                if (msk & 16) { const int lane2 = tid & 63; LAS float* scr = ldsf + wave * 4096; transpose_item(P->in[9] + (size_t)2048 * DIN, 2048, DIN, WTIN, scr, u * 8 + wave, lane2); }
            }
            grid.sync();
        }
        { PHASE_IDS hgrn_scan(P, l, tid); }
        grid.sync();
        for (int rep = 0; rep < REP_P3; ++rep) {
            PHASE_IDS
            unsigned* ctr = ctl + 64 * (l * 2 + 1 + 4 * rep);
            for (;;) {
                asm volatile("" : "+v"(tid));
                const int u = next_unit(ctr, qslot, tid);
                if (u >= 128) break;
                hgrn_final_unit(P, lds, l, u, tid);
            }
            grid.sync();
        }
        for (int rep = 0; rep < ((l == 0) ? REP_P4 : 1); ++rep) {
            PHASE_IDS
            pg8::Gemm g{H, WTOUT + (size_t)l * 2048 * 2048, MTOK, D_MODEL, D_MODEL}; pg8::StaticOrder S; S.init(MTOK, D_MODEL, G, (int)blockIdx.x);
            pg8::EpiV E{(l == 0) ? xp : P->out, (l == 0) ? xs : P->out + OUT_YS, P->out, MOD + l * 3 * 6144 + 4096};
            pg8::gemm_phase<pg8::EpiV, pg8::StaticOrder, true, true>(lds, g, S, E);
            grid.sync();
        }
        { PHASE_IDS
        for (int row = gw; row < MTOK; row += NGW) {
            const int cond = (row < NCTX) ? 0 : 1 + ((row - NCTX) >> 11);
            ln_row(P->out + (size_t)row * D_MODEL, P->in[18] + l * D_MODEL, P->in[19] + l * D_MODEL, MOD + (3 + cond) * 6144, (l == 0) ? H + (size_t)row * D_MODEL : (bf16*)nullptr, lane);
        } }
        if (l + 1 < DEPTH) grid.sync();
    }
}

extern "C" void kernel_launch(void* const* d_in, const int* in_sizes, int n_in, void* d_out, int out_size, void* d_ws, size_t ws_size, hipStream_t stream) {
    static int grid = 0;
    if (grid == 0) {
        if (n_in != 20 || out_size != (int)OUT_TOTAL || ws_size < WS_END) { fprintf(stderr, "kernel_launch: unexpected shapes (n_in %d, out %d, ws %zu)\n", n_in, out_size, ws_size); grid = -1; return; }
        int dev = 0, cus = 0, per_cu = 0;
        hipGetDevice(&dev); hipDeviceGetAttribute(&cus, hipDeviceAttributeMultiprocessorCount, dev);
        hipFuncSetAttribute((const void*)fwd_kernel, hipFuncAttributeMaxDynamicSharedMemorySize, LDS_BYTES);
        hipOccupancyMaxActiveBlocksPerMultiprocessor(&per_cu, (const void*)fwd_kernel, NTHREADS, LDS_BYTES);
        if (per_cu < 1) { fprintf(stderr, "kernel_launch: occupancy query says %d blocks per CU\n", per_cu); grid = -1; return; }
        grid = cus;
    }
    if (grid < 0) return;
    hipMemsetAsync((char*)d_ws + WS_CTL, 0, CTL_ZERO_BYTES, stream);
    Params p{};
    for (int i = 0; i < 20; ++i) p.in[i] = (const float*)d_in[i];
    p.out = (float*)d_out; p.ws = (unsigned char*)d_ws;
    void* args[] = {&p};
    hipError_t e = hipLaunchCooperativeKernel((const void*)fwd_kernel, dim3(grid), dim3(NTHREADS), args, LDS_BYTES, stream);
    if (e != hipSuccess) fprintf(stderr, "cooperative launch failed: %s (grid %d)\n", hipGetErrorString(e), grid);
}
```

```cpp
#include <hip/hip_runtime.h>
#include <hip/hip_cooperative_groups.h>
#include <cstdio>
#include <cstdint>
namespace cg = cooperative_groups;

constexpr int D_MODEL = 2048, DIN = 6656, NCTX = 8192, NLAT = 4096, MTOK = 12288, DEPTH = 2;
constexpr int C_AQ = 0, C_AK = 1024, C_AV = 1280, C_AG = 1536, C_HQ = 2560, C_HI = 3072, C_HFF = 3584, C_HFB = 4096, C_HG = 4608, C_CA = 5120, C_CB = 5632, C_CG = 6144;
constexpr float ALPHA_DN = 1.4142135623730951f;
constexpr size_t OUT_YP = 0, OUT_YS = 16777216, OUT_CK = 25165824, OUT_CV = 29360128, OUT_ST = 33554432, OUT_TOTAL = 41943040;
namespace pg8 {
#define PG8_LAS __attribute__((address_space(3)))
typedef unsigned short bf16_t;
typedef short bf16x8 __attribute__((ext_vector_type(8)));
typedef float f32x4 __attribute__((ext_vector_type(4)));
typedef unsigned u32x4 __attribute__((ext_vector_type(4)));
constexpr int BM = 256, BK = 64, HALF = 128, HTB = HALF * BK * 2  , STAGE_BYTES = 8 * HTB, NXCD = 8, WGM = 8;

__host__ __device__ __forceinline__ int lds_byte(int r, int c) { const int st = (r >> 4) * 2 + (c >> 5), rr = r & 15, cc = c & 31, ob = rr * 64 + cc * 2; return st * 1024 + (ob ^ (((ob >> 9) & 1) << 5)); }
__host__ __device__ __forceinline__ void stage_rc(int b, int& R, int& C) { const int st = b / 1024, sb = b % 1024, swz = sb ^ (((sb >> 9) & 1) << 5); R = (st >> 1) * 16 + swz / 64; C = (st & 1) * 32 + (swz % 64) / 2; }
__host__ __device__ __forceinline__ int perm32(int rho) { const int n = rho >> 4, i = rho & 15; return 8 * (i >> 2) + 4 * n + (i & 3); }

struct Unit { int pm, pn; };
struct Gemm { const bf16_t* A; const bf16_t* Bt; int M, N, K; };

struct StaticOrder {
    int nM, nN, nwg, G, c;
    __host__ __device__ void init(int M, int N, int G_, int c_) { nM = M / BM; nN = N / BM; nwg = nM * nN; G = G_; c = c_; }
    __host__ __device__ bool next(int i, Unit& u) const {
        const long L = (long)i * G + c; if (L >= nwg) return false;
        int wgid = (int)L; { const int q = nwg / NXCD, r = nwg % NXCD, xcd = wgid % NXCD, off = wgid / NXCD; wgid = (xcd < r ? xcd * (q + 1) : r * (q + 1) + (xcd - r) * q) + off; }
        const int nig = WGM * nN, gid = wgid / nig, fm = gid * WGM, gsz = (nM - fm) < WGM ? (nM - fm) : WGM;
        u.pm = fm + ((wgid % nig) % gsz); u.pn = (wgid % nig) / gsz; return true;
    }
    __device__ __forceinline__ void a_ready(const Unit&) const {}
    __device__ __forceinline__ void done(const Unit&) const {}
};

__device__ __forceinline__ unsigned cvt_pk_bf16(float lo, float hi) { unsigned r; asm volatile("v_cvt_pk_bf16_f32 %0, %1, %2" : "=v"(r) : "v"(lo), "v"(hi)); return r; }
typedef float f32x2 __attribute__((ext_vector_type(2)));

struct EpiZ {
    static constexpr bool PERM = true, AFTER_DRAIN = false;
    bf16_t* Z; float* ck; float* cv; int layer;
    __device__ __forceinline__ void operator()(const f32x4 (&acc)[2][2][4][2], const Unit& u, int wr, int wc, int fr, int fq) const {
        const int row0 = u.pm * BM + wr * 64 + fr; const int col0 = u.pn * BM + wc * 32 + 8 * fq;
#pragma unroll
        for (int ai = 0; ai < 2; ++ai)
#pragma unroll
            for (int m = 0; m < 4; ++m) { bf16_t* rowp = Z + (size_t)(row0 + ai * HALF + m * 16) * DIN + col0;
#pragma unroll
                for (int bj = 0; bj < 2; ++bj) { const f32x4 v0 = acc[ai][bj][m][0], v1 = acc[ai][bj][m][1];
                    u32x4 w; w.x = cvt_pk_bf16(v0[0], v0[1]); w.y = cvt_pk_bf16(v0[2], v0[3]); w.z = cvt_pk_bf16(v1[0], v1[1]); w.w = cvt_pk_bf16(v1[2], v1[3]);
                    *(u32x4*)(rowp + bj * HALF) = w; } }
        if ((u.pn == 4 || u.pn == 5) && u.pm < 32) {
            float* base = (u.pn == 4) ? ck : cv;
#pragma unroll
            for (int ai = 0; ai < 2; ++ai)
#pragma unroll
                for (int m = 0; m < 4; ++m) { const int row = row0 + ai * HALF + m * 16; const int b = row >> 8, s = row & 255;
                    float* p = base + ((size_t)((b * 2 + layer) * 256 + s)) * 256 + (wc * 32 + 8 * fq);
#pragma unroll
                    for (int bj = 0; bj < 2; ++bj) { *(f32x4*)(p + bj * HALF) = acc[ai][bj][m][0]; *(f32x4*)(p + bj * HALF + 4) = acc[ai][bj][m][1]; } }
        }
    }
};
struct EpiV {
    static constexpr bool PERM = false, AFTER_DRAIN = false;
    const float* xp; const float* xs; float* V; const float* gate;
    __device__ __forceinline__ void operator()(const f32x4 (&acc)[2][2][4][2], const Unit& u, int wr, int wc, int fr, int fq) const {
        const int row0 = u.pm * BM + wr * 64 + fr; const int col0 = u.pn * BM + wc * 32 + 4 * fq;
        const int cond = (u.pm < 32) ? 0 : 1 + ((u.pm - 32) >> 3);
        const float* g = gate + cond * 6144 + col0;
        f32x4 gv[2][2];
#pragma unroll
        for (int bj = 0; bj < 2; ++bj)
#pragma unroll
            for (int n = 0; n < 2; ++n) gv[bj][n] = *(const f32x4*)(g + bj * HALF + n * 16);
#pragma unroll
        for (int ai = 0; ai < 2; ++ai)
#pragma unroll
            for (int m = 0; m < 4; ++m) { const int row = row0 + ai * HALF + m * 16;
                const float* xr = ((row < NCTX) ? xp + (size_t)row * D_MODEL : xs + (size_t)(row - NCTX) * D_MODEL) + col0;
                float* vr = V + (size_t)row * D_MODEL + col0;
#pragma unroll
                for (int bj = 0; bj < 2; ++bj)
#pragma unroll
                    for (int n = 0; n < 2; ++n) { const f32x4 xv = *(const f32x4*)(xr + bj * HALF + n * 16);
                        *(f32x4*)(vr + bj * HALF + n * 16) = xv * ALPHA_DN + gv[bj][n] * acc[ai][bj][m][n]; }
                asm volatile("" ::: "memory"); }
    }
};
template <class Epi, class Sched, bool ALIGN_EPI = false, bool SP2 = false>
__device__ __forceinline__ void gemm_phase(PG8_LAS unsigned char* lds, const Gemm g, const Sched& S, const Epi& E) {
    int tid_l = threadIdx.x; asm volatile("" : "+v"(tid_l));
    const int tid = tid_l, wid = __builtin_amdgcn_readfirstlane(tid >> 6), lane = tid & 63, wr = wid >> 2, wc = wid & 3, fr = lane & 15, fq = lane >> 4;
    const int K = g.K, nt = K / BK;
    unsigned voffA[2], voffB[2];
#pragma unroll
    for (int i = 0; i < 2; ++i) { int R, C; stage_rc(tid * 16 + i * 8192, R, C); const int Rb = Epi::PERM ? ((R & ~31) + perm32(R & 31)) : R;
        voffA[i] = (unsigned)(R * K + C) * 2u; voffB[i] = (unsigned)(Rb * K + C) * 2u; }
    const size_t kstep = (size_t)(BK * 2);
    const size_t hstep = (size_t)HALF * K * 2;
    const size_t tstep = 2 * hstep;
    const unsigned ldsw = (unsigned)wid * 1024u;
    const int aoff = lds_byte(wr * 64 + fr, fq * 8), boff = lds_byte(wc * 32 + fr, fq * 8);
#define PG8_SA(b, h) (((b) * 2 + (h)) * HTB)
#define PG8_SB(b, h) ((4 + (b) * 2 + (h)) * HTB)
#define PG8_STAGE(bufoff, gbase, voff) do { _Pragma("unroll") for (int _i = 0; _i < 2; ++_i) \
        __builtin_amdgcn_global_load_lds((const unsigned*)((const char*)(gbase) + (voff)[_i]), (PG8_LAS unsigned*)(lds + (bufoff) + ldsw + _i * 8192), 16, 0, 0); } while (0)
#define PG8_LDA(dst, b, h) do { _Pragma("unroll") for (int m = 0; m < 4; ++m) _Pragma("unroll") for (int k = 0; k < 2; ++k) dst[m][k] = *(const PG8_LAS bf16x8*)(lds + PG8_SA(b, h) + aoff + m * 2048 + k * 1024); } while (0)
#define PG8_LDB(dst, b, h) do { _Pragma("unroll") for (int n = 0; n < 2; ++n) _Pragma("unroll") for (int k = 0; k < 2; ++k) dst[n][k] = *(const PG8_LAS bf16x8*)(lds + PG8_SB(b, h) + boff + n * 2048 + k * 1024); } while (0)
#define PG8_MMA(ai, bj, At, Bt) do { __builtin_amdgcn_s_setprio(1); _Pragma("unroll") for (int m = 0; m < 4; ++m) _Pragma("unroll") for (int n = 0; n < 2; ++n) _Pragma("unroll") for (int k = 0; k < 2; ++k) \
        acc[ai][bj][m][n] = __builtin_amdgcn_mfma_f32_16x16x32_bf16(Bt[n][k], At[m][k], acc[ai][bj][m][n], 0, 0, 0); __builtin_amdgcn_s_setprio(0); } while (0)
#define PG8_WAIT_V(n) asm volatile("s_waitcnt vmcnt(" #n ")" ::: "memory")
#define PG8_WAIT_L(n) asm volatile("s_waitcnt lgkmcnt(" #n ")" ::: "memory")
#define PG8_BAR __builtin_amdgcn_s_barrier()
#define PG8_SCHED __builtin_amdgcn_sched_barrier(0)
    Unit cur, nxt; int ui = 0;
    if (!S.next(0, cur)) return;
    f32x4 acc[2][2][4][2];
#pragma unroll
    for (int a = 0; a < 2; ++a)
#pragma unroll
        for (int b = 0; b < 2; ++b)
#pragma unroll
            for (int m = 0; m < 4; ++m)
#pragma unroll
                for (int n = 0; n < 2; ++n) acc[a][b][m][n] = (f32x4){0.f, 0.f, 0.f, 0.f};
    bf16x8 At[4][2], B0[2][2], B1[2][2];
    const char* cA = (const char*)g.A + (size_t)cur.pm * tstep; const char* cB = (const char*)g.Bt + (size_t)cur.pn * tstep;
    S.a_ready(cur);
    if constexpr (SP2) {
        PG8_STAGE(PG8_SB(0, 0), cB, voffB); PG8_STAGE(PG8_SB(0, 1), cB + hstep, voffB); PG8_STAGE(PG8_SA(0, 0), cA, voffA); PG8_STAGE(PG8_SA(0, 1), cA + hstep, voffA);
        if (wr == 1) PG8_BAR;
        PG8_WAIT_V(2); PG8_BAR;
        PG8_STAGE(PG8_SB(1, 0), cB + kstep, voffB); PG8_STAGE(PG8_SA(1, 0), cA + kstep, voffA); PG8_STAGE(PG8_SB(1, 1), cB + hstep + kstep, voffB);
        PG8_WAIT_V(6); PG8_BAR;
    } else {
        PG8_STAGE(PG8_SB(0, 0), cB, voffB); PG8_STAGE(PG8_SA(0, 0), cA, voffA); PG8_STAGE(PG8_SB(0, 1), cB + hstep, voffB); PG8_STAGE(PG8_SA(0, 1), cA + hstep, voffA);
        if (wr == 1) PG8_BAR;
        PG8_WAIT_V(4); PG8_BAR;
        PG8_STAGE(PG8_SB(1, 0), cB + kstep, voffB); PG8_STAGE(PG8_SA(1, 0), cA + kstep, voffA); PG8_STAGE(PG8_SB(1, 1), cB + hstep + kstep, voffB);
        PG8_WAIT_V(6); PG8_BAR;
    }
    for (;;) {
        const bool has_next = S.next(ui + 1, nxt);
        const char* nA = has_next ? (const char*)g.A + (size_t)nxt.pm * tstep : cA; const char* nB = has_next ? (const char*)g.Bt + (size_t)nxt.pn * tstep : cB;
        for (int t = 0; t < nt; t += 2) {
            const bool last = (t == nt - 2);
            const char* a1 = cA + (size_t)(t + 1) * kstep;
            const char* a2 = last ? nA : cA + (size_t)(t + 2) * kstep; const char* b2 = last ? nB : cB + (size_t)(t + 2) * kstep;
            const char* a3 = a2 + kstep; const char* b3 = b2 + kstep;
            if (last && has_next) S.a_ready(nxt);
            if constexpr (SP2) {
            PG8_LDB(B0, 0, 0); PG8_LDB(B1, 0, 1); PG8_SCHED; PG8_LDA(At, 0, 0); PG8_STAGE(PG8_SA(1, 1), a1 + hstep, voffA);
            PG8_WAIT_V(8); PG8_WAIT_L(0); PG8_BAR; PG8_MMA(0, 0, At, B0); PG8_MMA(0, 1, At, B1); PG8_BAR; PG8_SCHED;
            PG8_LDA(At, 0, 1); PG8_STAGE(PG8_SB(0, 0), b2, voffB); PG8_STAGE(PG8_SB(0, 1), b2 + hstep, voffB); PG8_STAGE(PG8_SA(0, 0), a2, voffA);
            PG8_WAIT_V(8); PG8_WAIT_L(0); PG8_BAR; PG8_MMA(1, 0, At, B0); PG8_MMA(1, 1, At, B1); PG8_BAR; PG8_SCHED;
            PG8_LDB(B0, 1, 0); PG8_LDB(B1, 1, 1); PG8_SCHED; PG8_LDA(At, 1, 0); PG8_STAGE(PG8_SA(0, 1), a2 + hstep, voffA);
            PG8_WAIT_V(8); PG8_WAIT_L(0); PG8_BAR; PG8_MMA(0, 0, At, B0); PG8_MMA(0, 1, At, B1); PG8_BAR; PG8_SCHED;
            PG8_LDA(At, 1, 1); PG8_STAGE(PG8_SB(1, 0), b3, voffB); PG8_STAGE(PG8_SB(1, 1), b3 + hstep, voffB); PG8_STAGE(PG8_SA(1, 0), a3, voffA);
            PG8_WAIT_V(8); PG8_WAIT_L(0); PG8_BAR; PG8_MMA(1, 0, At, B0); PG8_MMA(1, 1, At, B1); PG8_BAR; PG8_SCHED;
            } else {
            PG8_LDB(B0, 0, 0); PG8_SCHED; PG8_LDA(At, 0, 0); PG8_STAGE(PG8_SA(1, 1), a1 + hstep, voffA);
            PG8_WAIT_L(8); PG8_BAR; PG8_WAIT_L(0); PG8_MMA(0, 0, At, B0); PG8_BAR; PG8_SCHED;
            PG8_LDB(B1, 0, 1); PG8_STAGE(PG8_SB(0, 0), b2, voffB);
            PG8_BAR; PG8_WAIT_L(0); PG8_MMA(0, 1, At, B1); PG8_BAR;
            PG8_LDA(At, 0, 1); PG8_STAGE(PG8_SA(0, 0), a2, voffA);
            PG8_BAR; PG8_WAIT_L(0); PG8_MMA(1, 0, At, B0); PG8_BAR; PG8_SCHED;
            PG8_STAGE(PG8_SB(0, 1), b2 + hstep, voffB);
            PG8_WAIT_V(6); PG8_BAR; PG8_MMA(1, 1, At, B1); PG8_BAR;
            PG8_LDB(B0, 1, 0); PG8_SCHED; PG8_LDA(At, 1, 0); PG8_STAGE(PG8_SA(0, 1), a2 + hstep, voffA);
            PG8_WAIT_L(8); PG8_BAR; PG8_WAIT_L(0); PG8_MMA(0, 0, At, B0); PG8_BAR; PG8_SCHED;
            PG8_LDB(B1, 1, 1); PG8_STAGE(PG8_SB(1, 0), b3, voffB);
            PG8_BAR; PG8_WAIT_L(0); PG8_MMA(0, 1, At, B1); PG8_BAR;
            PG8_LDA(At, 1, 1); PG8_STAGE(PG8_SA(1, 0), a3, voffA);
            PG8_BAR; PG8_WAIT_L(0); PG8_MMA(1, 0, At, B0); PG8_BAR; PG8_SCHED;
            PG8_STAGE(PG8_SB(1, 1), b3 + hstep, voffB);
            PG8_WAIT_V(6); PG8_BAR; PG8_MMA(1, 1, At, B1); PG8_BAR;
            }
        }
        if constexpr (ALIGN_EPI) { if (wr == 0) PG8_BAR; }
        if constexpr (!Epi::AFTER_DRAIN) { E(acc, cur, wr, wc, fr, fq); S.done(cur); }
        if (!has_next) break;
#pragma unroll
        for (int a = 0; a < 2; ++a)
#pragma unroll
            for (int b = 0; b < 2; ++b)
#pragma unroll
                for (int m = 0; m < 4; ++m)
#pragma unroll
                    for (int n = 0; n < 2; ++n) acc[a][b][m][n] = (f32x4){0.f, 0.f, 0.f, 0.f};
        cur = nxt; cA = nA; cB = nB; ++ui;
        if constexpr (ALIGN_EPI) { if (wr == 1) PG8_BAR; }
    }
    PG8_WAIT_V(0);
    if constexpr (!ALIGN_EPI) { if (wr == 0) PG8_BAR; }
    PG8_BAR;
    if constexpr (Epi::AFTER_DRAIN) { E.fused(acc, cur, wr, wc, fr, fq, lds, wid, lane); S.done(cur); }
#undef PG8_SA
#undef PG8_SB
#undef PG8_STAGE
#undef PG8_LDA
#undef PG8_LDB
#undef PG8_MMA
#undef PG8_WAIT_V
#undef PG8_WAIT_L
#undef PG8_BAR
#undef PG8_SCHED
}
}

constexpr size_t MiB = 1u << 20;
constexpr size_t WS_CTL = 0, CTL_ZERO_BYTES = 32768;
constexpr size_t WS_MOD = 1 * MiB;
constexpr size_t WS_CS = 1 * MiB + 192 * 1024;
constexpr size_t WS_DLOG = 1 * MiB + 256 * 1024;
constexpr size_t WS_WTOUT = 2 * MiB;
constexpr size_t WS_WTIN = 18 * MiB;
constexpr size_t WS_H = 44 * MiB;
constexpr size_t WS_Z = 92 * MiB;
constexpr size_t WS_U = 248 * MiB;
constexpr size_t WS_OL = 264 * MiB;
constexpr size_t WS_END = 312 * MiB;
constexpr int LDS_BYTES = 147456;
constexpr int NWAVES = 8, NTHREADS = 512;

#define LAS __attribute__((address_space(3)))
typedef unsigned short bf16;
typedef float f32x4 __attribute__((ext_vector_type(4)));
typedef float f32x16 __attribute__((ext_vector_type(16)));
typedef unsigned u32x4 __attribute__((ext_vector_type(4)));
typedef unsigned u32x2 __attribute__((ext_vector_type(2)));
typedef short bf16x8 __attribute__((ext_vector_type(8)));

__device__ __forceinline__ float bf2f(unsigned short u) { return __builtin_bit_cast(float, (unsigned)u << 16); }
__device__ __forceinline__ float bflo(unsigned u) { return __builtin_bit_cast(float, u << 16); }
__device__ __forceinline__ float bfhi(unsigned u) { return __builtin_bit_cast(float, u & 0xffff0000u); }
__device__ __forceinline__ unsigned f2bf(float f) { unsigned u = __builtin_bit_cast(unsigned, f); return (u + 0x7fffu + ((u >> 16) & 1u)) >> 16; }
__device__ __forceinline__ unsigned pk2(float lo, float hi) { return f2bf(lo) | (f2bf(hi) << 16); }
__device__ __forceinline__ float sigmoidf_(float x) { return 1.0f / (1.0f + __expf(-x)); }
__device__ __forceinline__ float siluf_(float x) { return x / (1.0f + __expf(-x)); }
__device__ __forceinline__ float wave_sum(float v) {
#pragma unroll
    for (int o = 1; o < 64; o <<= 1) v += __shfl_xor(v, o);
    return v;
}

struct Params {
    const float* in[20];
    float* out; unsigned char* ws;
};
typedef const __attribute__((address_space(4))) Params* PP;

__device__ __forceinline__ int next_unit(unsigned* ctr, volatile LAS unsigned* slot, int tid) {
    __syncthreads();
    if (tid == 0) *slot = __hip_atomic_fetch_add(ctr, 1u, __ATOMIC_RELAXED, __HIP_MEMORY_SCOPE_AGENT);
    __syncthreads();
    return (int)*slot;
}
__device__ __forceinline__ int q_first(unsigned* ctr, volatile LAS unsigned* slot, int tid, unsigned& pend) {
    unsigned cur = 0u;
    if (tid == 0) { cur = __hip_atomic_fetch_add(ctr, 1u, __ATOMIC_RELAXED, __HIP_MEMORY_SCOPE_AGENT); *slot = cur; pend = __hip_atomic_fetch_add(ctr, 1u, __ATOMIC_RELAXED, __HIP_MEMORY_SCOPE_AGENT); }
    __syncthreads();
    return (int)*slot;
}
__device__ __forceinline__ int q_next(unsigned* ctr, volatile LAS unsigned* slot, int tid, unsigned& pend) {
    __syncthreads();
    if (tid == 0) { *slot = pend; pend = __hip_atomic_fetch_add(ctr, 1u, __ATOMIC_RELAXED, __HIP_MEMORY_SCOPE_AGENT); }
    __syncthreads();
    return (int)*slot;
}

__device__ __forceinline__ void transpose_item(const float* W, int K, int N, bf16* WT, LAS float* scr, int item, int lane) {
    const int nblk = N / 32, kb = item / nblk, nb = item % nblk, k0 = 64 * kb, n0 = 32 * nb;
    float wv[32];
    const float* wp = W + (size_t)(k0 + (lane >> 5)) * N + n0 + (lane & 31);
#pragma unroll
    for (int i = 0; i < 32; ++i) wv[i] = wp[(size_t)(2 * i) * N];
    __builtin_amdgcn_sched_barrier(0);
#pragma unroll
    for (int i = 0; i < 32; ++i) { const int kk = 2 * i + (lane >> 5); scr[kk * 33 + (lane & 31)] = wv[i]; }
    asm volatile("s_waitcnt lgkmcnt(0)" ::: "memory");
    const int c = lane & 7;
#pragma unroll
    for (int j = 0; j < 4; ++j) { const int n = (lane >> 3) + 8 * j; const LAS float* s = scr + (8 * c) * 33 + n;
        u32x4 o; o.x = pk2(s[0 * 33], s[1 * 33]); o.y = pk2(s[2 * 33], s[3 * 33]); o.z = pk2(s[4 * 33], s[5 * 33]); o.w = pk2(s[6 * 33], s[7 * 33]);
        *(u32x4*)(WT + (size_t)(n0 + n) * K + k0 + 8 * c) = o; }
    asm volatile("s_waitcnt lgkmcnt(0)" ::: "memory");
}

__device__ __forceinline__ void mod_unit(PP P, LAS float* lds, int l, int nc, int tid) {
    const float* c = P->in[5]; const float* cctx = P->in[6]; const float* aw = P->in[7] + (size_t)l * 2048 * 6144; const float* ab = P->in[8] + l * 6144;
    LAS float* sc = lds;
    LAS float* red = lds + 3 * 2048;
    for (int i = tid; i < 3 * 2048; i += NTHREADS) { const int j = i >> 11, k = i & 2047; const float v = (j == 0) ? cctx[k] : c[(j - 1) * 2048 + k]; sc[i] = siluf_(v); }
    __syncthreads();
    const int tn = tid & 7, tk = tid >> 3, n0 = nc * 32 + 4 * tn;
    float a[3][4] = {};
    for (int k8 = 0; k8 < 32; k8 += 16) {
        f32x4 w[16];
#pragma unroll
        for (int kk = 0; kk < 16; ++kk) w[kk] = *(const f32x4*)(aw + (size_t)(tk * 32 + k8 + kk) * 6144 + n0);
        __builtin_amdgcn_sched_barrier(0);
#pragma unroll
        for (int kk = 0; kk < 16; ++kk) { const int k = tk * 32 + k8 + kk;
#pragma unroll
            for (int j = 0; j < 3; ++j) { const float s = sc[j * 2048 + k]; a[j][0] += s * w[kk][0]; a[j][1] += s * w[kk][1]; a[j][2] += s * w[kk][2]; a[j][3] += s * w[kk][3]; } }
    }
#pragma unroll
    for (int j = 0; j < 3; ++j)
#pragma unroll
        for (int e = 0; e < 4; ++e) red[(tk * 8 + tn) * 12 + j * 4 + e] = a[j][e];
    __syncthreads();
    if (tid < 96) { const int tn2 = tid / 12, je = tid % 12; float s = 0.f; for (int t = 0; t < 64; ++t) s += red[(t * 8 + tn2) * 12 + je];
        const int j = je >> 2, e = je & 3, n = nc * 32 + 4 * tn2 + e;
        ((float*)(P->ws + WS_MOD))[(l * 3 + j) * 6144 + n] = s + ab[n]; }
    __syncthreads();
}

__device__ __forceinline__ void hprep_row(const float* xrow, const float* mod  , bf16* hrow, int lane) {
#pragma unroll
    for (int j = 0; j < 8; ++j) { const int c = 4 * lane + 256 * j; const f32x4 x = *(const f32x4*)(xrow + c), sh = *(const f32x4*)(mod + c), sc = *(const f32x4*)(mod + 2048 + c);
        const f32x4 h = x * (sc + 1.0f) + sh; u32x2 o; o.x = pk2(h[0], h[1]); o.y = pk2(h[2], h[3]); *(u32x2*)(hrow + c) = o; }
}
__device__ __forceinline__ void ln_row(float* vrow, const float* w, const float* b, const float* modn, bf16* hrow, int lane) {
    f32x4 v[8]; float s = 0.f;
#pragma unroll
    for (int j = 0; j < 8; ++j) { v[j] = *(const f32x4*)(vrow + 4 * lane + 256 * j); s += (v[j][0] + v[j][1]) + (v[j][2] + v[j][3]); }
    const float mean = wave_sum(s) * (1.0f / 2048.0f); float q = 0.f;
#pragma unroll
    for (int j = 0; j < 8; ++j) { v[j] = v[j] - mean; q += (v[j][0] * v[j][0] + v[j][1] * v[j][1]) + (v[j][2] * v[j][2] + v[j][3] * v[j][3]); }
    const float rstd = 1.0f / sqrtf(wave_sum(q) * (1.0f / 2048.0f) + 1e-5f);
#pragma unroll
    for (int j = 0; j < 8; ++j) { const int c = 4 * lane + 256 * j; const f32x4 y = v[j] * rstd * *(const f32x4*)(w + c) + *(const f32x4*)(b + c);
        *(f32x4*)(vrow + c) = y;
        if (hrow) { const f32x4 sh = *(const f32x4*)(modn + c), sc = *(const f32x4*)(modn + 2048 + c); const f32x4 h = y * (sc + 1.0f) + sh;
            u32x2 o; o.x = pk2(h[0], h[1]); o.y = pk2(h[2], h[3]); *(u32x2*)(hrow + c) = o; } }
}

__device__ __forceinline__ void conv_unit(PP P, LAS float* lds, int l, int unit, int tid) {
    const int lane = tid & 63, wave = tid >> 6;
    const bf16* Z = (const bf16*)(P->ws + WS_Z); bf16* MIX = (bf16*)(P->ws + WS_H);
    const int t0 = unit * 16;
    int s0, s1; if (t0 < NCTX) { s0 = t0 & ~255; s1 = s0 + 256; } else { s0 = NCTX + ((t0 - NCTX) & ~2047); s1 = s0 + 2048; }
    const int c = tid;
    float u[46];
    unsigned short ra[46], rb[46];
#pragma unroll
    for (int r = 0; r < 46; ++r) { const int row = t0 - 15 + r; const int rc = row < s0 ? s0 : (row >= s1 ? s1 - 1 : row);
        ra[r] = Z[(size_t)rc * DIN + C_CA + c]; rb[r] = Z[(size_t)rc * DIN + C_CB + c]; }
    __builtin_amdgcn_sched_barrier(0);
#pragma unroll
    for (int r = 0; r < 46; ++r) { const int row = t0 - 15 + r; const float val = bf2f(ra[r]) * sigmoidf_(bf2f(rb[r])); u[r] = (row >= s0 && row < s1) ? val : 0.f; }
    float acc[16]; const float bias = P->in[15][l * 512 + c];
#pragma unroll
    for (int i = 0; i < 16; ++i) acc[i] = bias;
    const float* cw = P->in[14] + (size_t)l * 31 * 512 + c;
#pragma unroll
    for (int j = 0; j < 31; ++j) { const float w = cw[j * 512];
#pragma unroll
        for (int i = 0; i < 16; ++i) acc[i] += u[i + j] * w; }
    LAS float* yb = lds;
#pragma unroll
    for (int i = 0; i < 16; ++i) yb[i * 512 + c] = acc[i];
    __syncthreads();
    const float* lw = P->in[16] + l * 512; const float* lb = P->in[17] + l * 512;
#pragma unroll
    for (int tt = 0; tt < 2; ++tt) { const int ti = wave * 2 + tt, row = t0 + ti;
        f32x4 a = *(const LAS f32x4*)(yb + ti * 512 + 8 * lane), b = *(const LAS f32x4*)(yb + ti * 512 + 8 * lane + 4);
        float s = (a[0] + a[1]) + (a[2] + a[3]) + (b[0] + b[1]) + (b[2] + b[3]);
        const float mean = wave_sum(s) * (1.0f / 512.0f); a = a - mean; b = b - mean;
        float q = (a[0] * a[0] + a[1] * a[1]) + (a[2] * a[2] + a[3] * a[3]) + (b[0] * b[0] + b[1] * b[1]) + (b[2] * b[2] + b[3] * b[3]);
        const float rstd = 1.0f / sqrtf(wave_sum(q) * (1.0f / 512.0f) + 1e-5f);
        const f32x4 w0 = *(const f32x4*)(lw + 8 * lane), w1 = *(const f32x4*)(lw + 8 * lane + 4), b0 = *(const f32x4*)(lb + 8 * lane), b1 = *(const f32x4*)(lb + 8 * lane + 4);
        a = a * rstd * w0 + b0; b = b * rstd * w1 + b1;
        const u32x4 g = *(const u32x4*)(Z + (size_t)row * DIN + C_CG + 8 * lane);
        float o[8];
        o[0] = siluf_(a[0]) * siluf_(bflo(g.x)); o[1] = siluf_(a[1]) * siluf_(bfhi(g.x)); o[2] = siluf_(a[2]) * siluf_(bflo(g.y)); o[3] = siluf_(a[3]) * siluf_(bfhi(g.y));
        o[4] = siluf_(b[0]) * siluf_(bflo(g.z)); o[5] = siluf_(b[1]) * siluf_(bfhi(g.z)); o[6] = siluf_(b[2]) * siluf_(bflo(g.w)); o[7] = siluf_(b[3]) * siluf_(bfhi(g.w));
        u32x4 w; w.x = pk2(o[0], o[1]); w.y = pk2(o[2], o[3]); w.z = pk2(o[4], o[5]); w.w = pk2(o[6], o[7]);
        *(u32x4*)(MIX + (size_t)row * D_MODEL + 1536 + 8 * lane) = w; }
}

typedef short v4i16_t __attribute__((ext_vector_type(4)));
#define SBAR __builtin_amdgcn_sched_barrier(0);
#define R0(i) (((i) & 3) + 8 * ((i) >> 2))
constexpr float ATT_C2 = 0.08838834764831845f * 1.4426950408889634f;
constexpr float LOG2E = 1.4426950408889634f;
constexpr int KROW = 272, VROW = 320, ATT_V_OFF = 64 * KROW;

__device__ __forceinline__ void rope8(bf16x8& a, bf16x8& b, const float* cs) {
#pragma unroll
    for (int j = 0; j < 8; ++j) { const float x1 = bf2f((unsigned short)a[j]), x2 = bf2f((unsigned short)b[j]), c = cs[2 * j], s = cs[2 * j + 1];
        a[j] = (short)f2bf(x1 * c - x2 * s); b[j] = (short)f2bf(x2 * c + x1 * s); }
}
__device__ __forceinline__ bf16x8 cvt8(const float* p) {
    const f32x4 a = *(const f32x4*)p, b = *(const f32x4*)(p + 4); bf16x8 r;
    r[0] = (short)f2bf(a[0]); r[1] = (short)f2bf(a[1]); r[2] = (short)f2bf(a[2]); r[3] = (short)f2bf(a[3]);
    r[4] = (short)f2bf(b[0]); r[5] = (short)f2bf(b[1]); r[6] = (short)f2bf(b[2]); r[7] = (short)f2bf(b[3]); return r;
}

__device__ __forceinline__ void attn_unit(PP P, LAS unsigned char* lds, int l, int kind, int idx, int tid) {
    const int lane = tid & 63, wave = __builtin_amdgcn_readfirstlane(tid >> 6), r32 = lane & 31, hh = lane >> 5;
    const bf16* Z = (const bf16*)(P->ws + WS_Z); bf16* MIX = (bf16*)(P->ws + WS_H); const float* CS = (const float*)(P->ws + WS_CS);
    int b, h, qpos0, grow0, kpos0, klrow0, nloc, ncache;
    if (kind == 0) { b = idx >> 3; h = idx & 7; qpos0 = 0; grow0 = b * 256; kpos0 = 0; klrow0 = b * 256; nloc = 4; ncache = 0; }
    else { const int qb = idx & 7; h = (idx >> 3) & 7; b = idx >> 6; qpos0 = qb * 256; grow0 = NCTX + b * 2048 + qpos0;
        kpos0 = qpos0 - 128 < 0 ? 0 : qpos0 - 128; const int kend = qpos0 + 384 > 2048 ? 2048 : qpos0 + 384; nloc = (kend - kpos0) >> 6; klrow0 = NCTX + b * 2048 + kpos0; ncache = 4; }
    const bool lat = (kind == 1);
    const int kv = h >> 2;
    const int qrow = grow0 + 32 * wave + r32, qpos = qpos0 + 32 * wave + r32, qw0 = qpos0 + 32 * wave;
    bf16x8 qf[8];
    { const bf16* qp = Z + (size_t)qrow * DIN + C_AQ + h * 128 + 8 * hh;
#pragma unroll
      for (int s = 0; s < 8; ++s) qf[s] = *(const bf16x8*)(qp + 16 * s);
      if (lat) { const float* c0 = CS + ((qpos >> 6) * 32 + 8 * hh) * 2; const float* c1 = CS + ((qpos & 63) * 32 + 8 * hh) * 2;
          rope8(qf[0], qf[2], c0); rope8(qf[1], qf[3], c0 + 32); rope8(qf[4], qf[6], c1); rope8(qf[5], qf[7], c1 + 32); } }
    f32x16 O[4];
#pragma unroll
    for (int d = 0; d < 4; ++d)
#pragma unroll
        for (int i = 0; i < 16; ++i) O[d][i] = 0.f;
    float m = P->in[11][l * 8 + h] * LOG2E, lsum = (hh == 0) ? 1.0f : 0.0f;
    const int skey = tid >> 3, cp = tid & 7, c1 = (cp >> 2) * 8 + (cp & 3), sd0 = 8 * c1;
    const int ntiles = nloc + ncache;
    for (int ti = 0; ti < ntiles; ++ti) {
        __syncthreads();
        {
            bf16x8 k1, k2, v1, v2;
            if (ti < nloc) {
                const int krow = klrow0 + 64 * ti + skey; const bf16* kp = Z + (size_t)krow * DIN + C_AK + kv * 128 + sd0; const bf16* vp = Z + (size_t)krow * DIN + C_AV + kv * 128 + sd0;
                k1 = *(const bf16x8*)kp; k2 = *(const bf16x8*)(kp + 32); v1 = *(const bf16x8*)vp; v2 = *(const bf16x8*)(vp + 32);
                if (lat) { const int kpos = kpos0 + 64 * ti + skey; const int pos = (cp < 4) ? (kpos >> 6) : (kpos & 63); rope8(k1, k2, CS + (pos * 32 + 8 * (cp & 3)) * 2); }
            } else {
                const int key = 64 * (ti - nloc) + skey; const size_t off = ((size_t)((b * 2 + l) * 256 + key) * 2 + kv) * 128 + sd0;
                k1 = cvt8(P->in[2] + off); k2 = cvt8(P->in[2] + off + 32); v1 = cvt8(P->in[3] + off); v2 = cvt8(P->in[3] + off + 32);
            }
            *(LAS bf16x8*)(lds + skey * KROW + sd0 * 2) = k1; *(LAS bf16x8*)(lds + skey * KROW + sd0 * 2 + 64) = k2;
            *(LAS bf16x8*)(lds + ATT_V_OFF + skey * VROW + sd0 * 2) = v1; *(LAS bf16x8*)(lds + ATT_V_OFF + skey * VROW + sd0 * 2 + 64) = v2;
        }
        __syncthreads();
        const bool local = lat && (ti < nloc);
        const int tk0 = kpos0 + 64 * ti;
        bool skip = false;
        if (local) skip = (tk0 > qw0 + 31 + 128) || (tk0 + 63 < qw0 - 128);
        if (!skip) {
            f32x16 p0, p1;
#pragma unroll
            for (int i = 0; i < 16; ++i) { p0[i] = 0.f; p1[i] = 0.f; }
            const LAS unsigned char* kb = lds + r32 * KROW + 16 * hh;
#pragma unroll
            for (int s = 0; s < 8; ++s) { const bf16x8 kf0 = *(const LAS bf16x8*)(kb + 32 * s), kf1 = *(const LAS bf16x8*)(kb + 32 * KROW + 32 * s);
                p0 = __builtin_amdgcn_mfma_f32_32x32x16_bf16(kf0, qf[s], p0, 0, 0, 0); p1 = __builtin_amdgcn_mfma_f32_32x32x16_bf16(kf1, qf[s], p1, 0, 0, 0); }
            float mx = -1e30f;
#pragma unroll
            for (int i = 0; i < 16; ++i) { float a = p0[i] * ATT_C2, c = p1[i] * ATT_C2;
                if (local) { const int kp = tk0 + R0(i) + 4 * hh; const int d0 = qpos - kp, d1 = qpos - kp - 32;
                    if (d0 > 128 || d0 < -128) a = -1e30f; if (d1 > 128 || d1 < -128) c = -1e30f; }
                p0[i] = a; p1[i] = c; mx = fmaxf(mx, fmaxf(a, c)); }
            mx = fmaxf(mx, __shfl_xor(mx, 32));
            const float mn = fmaxf(m, mx), alpha = __builtin_amdgcn_exp2f(m - mn); m = mn;
            float ps = 0.f;
#pragma unroll
            for (int i = 0; i < 16; ++i) { p0[i] = __builtin_amdgcn_exp2f(p0[i] - mn); p1[i] = __builtin_amdgcn_exp2f(p1[i] - mn); ps += p0[i] + p1[i]; }
            lsum = lsum * alpha + ps;
#pragma unroll
            for (int d = 0; d < 4; ++d)
#pragma unroll
                for (int i = 0; i < 16; ++i) O[d][i] *= alpha;
            bf16x8 pb[4];
#pragma unroll
            for (int s = 0; s < 2; ++s)
#pragma unroll
                for (int j = 0; j < 8; ++j) { pb[s][j] = (short)f2bf(p0[8 * s + j]); pb[2 + s][j] = (short)f2bf(p1[8 * s + j]); }
            const int i16 = lane & 15;
            const LAS unsigned char* vb = lds + ATT_V_OFF + (4 * hh + (i16 >> 2)) * VROW + (16 * ((lane >> 4) & 1) + 4 * (i16 & 3)) * 2;
#pragma unroll
            for (int dt = 0; dt < 4; ++dt)
#pragma unroll
                for (int ks = 0; ks < 4; ++ks) {
                    const LAS unsigned char* vp = vb + (16 * ks) * VROW + 64 * dt;
                    const v4i16_t lo = __builtin_amdgcn_ds_read_tr16_b64_v4i16((LAS v4i16_t*)vp), hi = __builtin_amdgcn_ds_read_tr16_b64_v4i16((LAS v4i16_t*)(vp + 8 * VROW));
                    const bf16x8 vf = (bf16x8){lo[0], lo[1], lo[2], lo[3], hi[0], hi[1], hi[2], hi[3]};
                    O[dt] = __builtin_amdgcn_mfma_f32_32x32x16_bf16(vf, pb[ks], O[dt], 0, 0, 0);
                }
        }
    }
    const float ltot = lsum + __shfl_xor(lsum, 32), inv = 1.0f / ltot;
    const bf16* gp = Z + (size_t)qrow * DIN + C_AG + h * 128 + 4 * hh; bf16* op = MIX + (size_t)qrow * D_MODEL + h * 128 + 4 * hh;
#pragma unroll
    for (int dt = 0; dt < 4; ++dt)
#pragma unroll
        for (int i4 = 0; i4 < 4; ++i4) { const int d0 = 32 * dt + 8 * i4; const u32x2 g = *(const u32x2*)(gp + d0);
            const float o0 = O[dt][4 * i4 + 0] * inv * siluf_(bflo(g.x)), o1 = O[dt][4 * i4 + 1] * inv * siluf_(bfhi(g.x));
            const float o2 = O[dt][4 * i4 + 2] * inv * siluf_(bflo(g.y)), o3 = O[dt][4 * i4 + 3] * inv * siluf_(bfhi(g.y));
            u32x2 w; w.x = pk2(o0, o1); w.y = pk2(o2, o3); *(u32x2*)(op + d0) = w; }
}

__device__ __forceinline__ float hg_lb(PP P, int l, int dir, int hd) {
    if (l == 0) return 0.0f;
    const float* hb = P->in[12] + dir * 1024; return sigmoidf_(hb[512 + hd] - hb[hd]);
}
constexpr int H2_TG = 0, H2_QE = 16896, H2_KE = 25600, H2_QG = 34304, H2_KG = 42752, H2_V = 52992, H2_OBA = 63232, H2_OBB = 80128, H2_DK = 97024;
constexpr size_t WS_DLC_OFF = 0;
__device__ __forceinline__ bf16x8 trpair(const LAS unsigned char* p, int second_off) {
    const v4i16_t lo = __builtin_amdgcn_ds_read_tr16_b64_v4i16((LAS v4i16_t*)p), hi = __builtin_amdgcn_ds_read_tr16_b64_v4i16((LAS v4i16_t*)(p + second_off));
    return (bf16x8){lo[0], lo[1], lo[2], lo[3], hi[0], hi[1], hi[2], hi[3]};
}
__device__ __forceinline__ bf16x8 pack8(float a, float b, float c, float d, float e, float f, float g, float h) {
    bf16x8 r; r[0] = (short)f2bf(a); r[1] = (short)f2bf(b); r[2] = (short)f2bf(c); r[3] = (short)f2bf(d); r[4] = (short)f2bf(e); r[5] = (short)f2bf(f); r[6] = (short)f2bf(g); r[7] = (short)f2bf(h); return r;
}
__device__ __forceinline__ void hgrn2_unit(PP P, LAS unsigned char* lds, int l, int kind, int idx, int tid) {
    const int lane = tid & 63, wave = __builtin_amdgcn_readfirstlane(tid >> 6), r32 = lane & 31, hh = lane >> 5, i16 = lane & 15, cg = (lane >> 4) & 1;
    const bf16* Z = (const bf16*)(P->ws + WS_Z); bf16* MIX = (bf16*)(P->ws + WS_H); float* OL = (float*)(P->ws + WS_OL);
    LAS float* ldsf = (LAS float*)lds;
    int h, row0, seglen, nch, b = 0;
    if (kind == 0) { b = idx >> 2; h = idx & 3; row0 = b * 256; seglen = 256; nch = 8; }
    else { const int blk = idx & 15; h = (idx >> 4) & 3; const int lb = idx >> 6; row0 = NCTX + lb * 2048 + blk * 128; seglen = 128; nch = 4; }
    const int ti = tid >> 4, d0 = 8 * (tid & 15), nt = wave & 3, kp = wave >> 2;
    for (int dir = 0; dir < 2; ++dir) {
        float oml[8];
#pragma unroll
        for (int j = 0; j < 8; ++j) oml[j] = 1.0f - hg_lb(P, l, dir, h * 128 + d0 + j);
        const int cf = dir ? C_HFB : C_HFF;
        f32x16 S0, S1;
#pragma unroll
        for (int i = 0; i < 16; ++i) { S0[i] = 0.f; S1[i] = 0.f; }
        const int uidx = (kind == 1) ? ((idx >> 4) * 2 + dir) * 16 + (idx & 15) : 0;
        u32x4 uq, uv, uf;
        { const int row = dir ? row0 + seglen - 1 - ti : row0 + ti; const bf16* zr = Z + (size_t)row * DIN + h * 128 + d0;
          uq = *(const u32x4*)(zr + C_HQ); uv = *(const u32x4*)(zr + C_HI); uf = *(const u32x4*)(zr + cf); }
        for (int c = 0; c < nch; ++c) {
            const int nc = dir ? nch - 1 - c : c; const int rown = row0 + 32 * nc + ti;
            f32x4 olp0 = {0.f, 0.f, 0.f, 0.f}, olp1 = {0.f, 0.f, 0.f, 0.f}; u32x4 ug = {0u, 0u, 0u, 0u};
            float* olr = OL + (size_t)rown * 512 + h * 128 + d0;
            if (dir == 1) { olp0 = *(const f32x4*)olr; olp1 = *(const f32x4*)(olr + 4); if (kind == 0) ug = *(const u32x4*)(Z + (size_t)rown * DIN + C_HG + h * 128 + d0); }
            float q[8], kk[8];
            {
                float g2[8], vv[8];
#pragma unroll
                for (int j = 0; j < 4; ++j) { const unsigned wq = uq[j], wv = uv[j], wf = uf[j];
                    q[2 * j] = siluf_(bflo(wq)) * 0.08838834764831845f; q[2 * j + 1] = siluf_(bfhi(wq)) * 0.08838834764831845f;
                    vv[2 * j] = bflo(wv); vv[2 * j + 1] = bfhi(wv);
                    kk[2 * j] = oml[2 * j] * sigmoidf_(-bflo(wf)); kk[2 * j + 1] = oml[2 * j + 1] * sigmoidf_(-bfhi(wf)); }
#pragma unroll
                for (int j = 0; j < 8; ++j) g2[j] = __builtin_amdgcn_logf(1.0f - fminf(kk[j], 1.0f - 1e-6f));
                LAS float* pg = ldsf + (H2_TG >> 2) + ti * 132 + d0;
                *(LAS f32x4*)pg = (f32x4){g2[0], g2[1], g2[2], g2[3]}; *(LAS f32x4*)(pg + 4) = (f32x4){g2[4], g2[5], g2[6], g2[7]};
                *(LAS u32x4*)(lds + H2_V + ti * 320 + d0 * 2) = uv;
            }
            if (c + 1 < nch) { const int tl = 32 * (c + 1) + ti; const int row = dir ? row0 + seglen - 1 - tl : row0 + tl; const bf16* zr = Z + (size_t)row * DIN + h * 128 + d0;
                uq = *(const u32x4*)(zr + C_HQ); uv = *(const u32x4*)(zr + C_HI); uf = *(const u32x4*)(zr + cf); }
            __syncthreads();
            if (tid < 128) {
                LAS float* gc = ldsf + (H2_TG >> 2) + tid; float run = 0.f;
#pragma unroll
                for (int i = 0; i < 32; ++i) { run += gc[i * 132]; gc[i * 132] = run; }
                ldsf[(H2_DK >> 2) + tid] = __builtin_amdgcn_exp2f(run);
                if (kind == 1) ((float*)(P->ws + WS_DLOG))[(uidx * 4 + c) * 128 + tid] = run;
            }
            __syncthreads();
            {
                const LAS float* gr = ldsf + (H2_TG >> 2) + ti * 132 + d0; const LAS float* gm = ldsf + (H2_TG >> 2) + 15 * 132 + d0; const LAS float* gl = ldsf + (H2_TG >> 2) + 31 * 132 + d0;
                float qe[8], ke[8], qg[8], kg[8];
#pragma unroll
                for (int j = 0; j < 8; ++j) { const float G = gr[j], Gm = gm[j], Gl = gl[j];
                    qe[j] = q[j] * __builtin_amdgcn_exp2f(fminf(G - Gm, 100.f)); ke[j] = kk[j] * __builtin_amdgcn_exp2f(fminf(Gm - G, 100.f));
                    qg[j] = q[j] * __builtin_amdgcn_exp2f(G); kg[j] = kk[j] * __builtin_amdgcn_exp2f(Gl - G); }
                *(LAS bf16x8*)(lds + H2_QE + ti * 272 + d0 * 2) = pack8(qe[0], qe[1], qe[2], qe[3], qe[4], qe[5], qe[6], qe[7]);
                *(LAS bf16x8*)(lds + H2_KE + ti * 272 + d0 * 2) = pack8(ke[0], ke[1], ke[2], ke[3], ke[4], ke[5], ke[6], ke[7]);
                *(LAS bf16x8*)(lds + H2_KG + ti * 320 + d0 * 2) = pack8(kg[0], kg[1], kg[2], kg[3], kg[4], kg[5], kg[6], kg[7]);
                u32x2 w0, w1; w0.x = pk2(qg[0], qg[1]); w0.y = pk2(qg[2], qg[3]); w1.x = pk2(qg[4], qg[5]); w1.y = pk2(qg[6], qg[7]);
                *(LAS u32x2*)(lds + H2_QG + ti * 264 + d0 * 2) = w0; *(LAS u32x2*)(lds + H2_QG + ti * 264 + d0 * 2 + 8) = w1;
            }
            __syncthreads();
            {
                f32x16 at;
#pragma unroll
                for (int i = 0; i < 16; ++i) at[i] = 0.f;
                const LAS unsigned char* kep = lds + H2_KE + r32 * 272 + 16 * hh; const LAS unsigned char* qep = lds + H2_QE + r32 * 272 + 16 * hh;
#pragma unroll
                for (int k = 0; k < 8; ++k) at = __builtin_amdgcn_mfma_f32_32x32x16_bf16(*(const LAS bf16x8*)(kep + 32 * k), *(const LAS bf16x8*)(qep + 32 * k), at, 0, 0, 0);
                float am[8];
#pragma unroll
                for (int j = 0; j < 8; ++j) { const float lo = at[j], hi = at[8 + j]; const float v = kp ? hi : lo; const int s = 16 * kp + 8 * (j >> 2) + 4 * hh + (j & 3); am[j] = (s <= r32) ? v : 0.f; }
                const bf16x8 afrag = pack8(am[0], am[1], am[2], am[3], am[4], am[5], am[6], am[7]);
                f32x16 ot;
#pragma unroll
                for (int i = 0; i < 16; ++i) ot[i] = 0.f;
                { const bf16x8 vfrag = trpair(lds + H2_V + (16 * kp + 4 * hh + (i16 >> 2)) * 320 + (32 * nt + 16 * cg + 4 * (i16 & 3)) * 2, 8 * 320);
                  ot = __builtin_amdgcn_mfma_f32_32x32x16_bf16(vfrag, afrag, ot, 0, 0, 0); }
                const LAS unsigned char* qgp = lds + H2_QG + r32 * 264 + (64 * kp + 4 * hh) * 2;
#pragma unroll
                for (int kl = 0; kl < 2; ++kl)
#pragma unroll
                    for (int sp = 0; sp < 2; ++sp) {
                        const u32x2 qlo = *(const LAS u32x2*)(qgp + (32 * kl + 16 * sp) * 2), qhi = *(const LAS u32x2*)(qgp + (32 * kl + 16 * sp) * 2 + 16);
                        const u32x4 qq = {qlo.x, qlo.y, qhi.x, qhi.y};
                        bf16x8 sfrag;
                        if (kl == 0) sfrag = pack8(S0[8 * sp], S0[8 * sp + 1], S0[8 * sp + 2], S0[8 * sp + 3], S0[8 * sp + 4], S0[8 * sp + 5], S0[8 * sp + 6], S0[8 * sp + 7]);
                        else sfrag = pack8(S1[8 * sp], S1[8 * sp + 1], S1[8 * sp + 2], S1[8 * sp + 3], S1[8 * sp + 4], S1[8 * sp + 5], S1[8 * sp + 6], S1[8 * sp + 7]);
                        ot = __builtin_amdgcn_mfma_f32_32x32x16_bf16(sfrag, __builtin_bit_cast(bf16x8, qq), ot, 0, 0, 0);
                    }
                { LAS float* ob = ldsf + ((kp ? H2_OBB : H2_OBA) >> 2) + (32 * nt + 4 * hh) * 33 + r32;
#pragma unroll
                  for (int i = 0; i < 16; ++i) ob[R0(i) * 33] = ot[i]; }
                const LAS float* dkp = ldsf + (H2_DK >> 2) + 64 * kp + 4 * hh;
#pragma unroll
                for (int i = 0; i < 16; ++i) { S0[i] *= dkp[R0(i)]; S1[i] *= dkp[32 + R0(i)]; }
#pragma unroll
                for (int ks = 0; ks < 2; ++ks) {
                    const int roff = (16 * ks + 8 * hh + (i16 >> 2)) * 320, coff = (16 * cg + 4 * (i16 & 3)) * 2;
                    const bf16x8 vf = trpair(lds + H2_V + roff + 64 * nt + coff, 4 * 320);
                    const bf16x8 k0 = trpair(lds + H2_KG + roff + 64 * (2 * kp) + coff, 4 * 320), k1 = trpair(lds + H2_KG + roff + 64 * (2 * kp + 1) + coff, 4 * 320);
                    S0 = __builtin_amdgcn_mfma_f32_32x32x16_bf16(k0, vf, S0, 0, 0, 0); S1 = __builtin_amdgcn_mfma_f32_32x32x16_bf16(k1, vf, S1, 0, 0, 0);
                }
            }
            __syncthreads();
            {
                const int t = dir ? 31 - ti : ti;
                const LAS float* oa = ldsf + (H2_OBA >> 2) + d0 * 33 + t; const LAS float* obb = ldsf + (H2_OBB >> 2) + d0 * 33 + t;
                float o[8];
#pragma unroll
                for (int j = 0; j < 8; ++j) o[j] = oa[j * 33] + obb[j * 33];
                if (dir == 1) { o[0] += olp0[0]; o[1] += olp0[1]; o[2] += olp0[2]; o[3] += olp0[3]; o[4] += olp1[0]; o[5] += olp1[1]; o[6] += olp1[2]; o[7] += olp1[3]; }
                if (dir == 0 || kind == 1) { *(f32x4*)olr = (f32x4){o[0], o[1], o[2], o[3]}; *(f32x4*)(olr + 4) = (f32x4){o[4], o[5], o[6], o[7]}; }
                else {
                    float ss = 0.f;
#pragma unroll
                    for (int j = 0; j < 8; ++j) ss += o[j] * o[j];
                    ss += __shfl_xor(ss, 1); ss += __shfl_xor(ss, 2); ss += __shfl_xor(ss, 4); ss += __shfl_xor(ss, 8);
                    const float r = 1.0f / sqrtf(ss * (1.0f / 128.0f) + 1e-6f);
                    const float* nw = P->in[13] + l * 512 + h * 128 + d0; const f32x4 n0 = *(const f32x4*)nw, n1 = *(const f32x4*)(nw + 4);
                    u32x4 w;
                    w.x = pk2(o[0] * r * n0[0] * siluf_(bflo(ug.x)), o[1] * r * n0[1] * siluf_(bfhi(ug.x))); w.y = pk2(o[2] * r * n0[2] * siluf_(bflo(ug.y)), o[3] * r * n0[3] * siluf_(bfhi(ug.y)));
                    w.z = pk2(o[4] * r * n1[0] * siluf_(bflo(ug.z)), o[5] * r * n1[1] * siluf_(bfhi(ug.z))); w.w = pk2(o[6] * r * n1[2] * siluf_(bflo(ug.w)), o[7] * r * n1[3] * siluf_(bfhi(ug.w)));
                    *(u32x4*)(MIX + (size_t)rown * D_MODEL + 1024 + h * 128 + d0) = w;
                }
            }
        }
        {
            float* Sd = (kind == 0) ? P->out + OUT_ST + (size_t)((((b * 2 + l) * 2 + dir) * 4 + h)) * 16384 : (float*)(P->ws + WS_U) + (size_t)uidx * 16384;
            float* sp = Sd + (64 * kp + 4 * hh) * 128 + 32 * nt + r32;
#pragma unroll
            for (int i = 0; i < 16; ++i) { sp[R0(i) * 128] = S0[i]; sp[(32 + R0(i)) * 128] = S1[i]; }
        }
    }
}

__device__ __forceinline__ void hgrn_scan(PP P, int l, int tid) {
    float* U = (float*)(P->ws + WS_U); const float* DLC = (const float*)(P->ws + WS_DLOG);
    for (int e = blockIdx.x * NTHREADS + tid; e < 16 * 16384; e += gridDim.x * NTHREADS) {
        const int sq = e >> 14, el = e & 16383, dk = el >> 7, lb = sq >> 3, h = (sq >> 1) & 3, dir = sq & 1;
        float S = P->in[4][(size_t)((((lb * 2 + l) * 2 + dir) * 4 + h)) * 16384 + el];
        float u[16], dl[16];
#pragma unroll
        for (int p = 0; p < 16; ++p) { const int blk = dir ? 15 - p : p; const int uidx = sq * 16 + blk; u[p] = U[(size_t)uidx * 16384 + el];
            const float* d = DLC + (uidx * 4) * 128 + dk; dl[p] = (d[0] + d[128]) + (d[256] + d[384]); }
#pragma unroll
        for (int p = 0; p < 16; ++p) { const int blk = dir ? 15 - p : p; const int uidx = sq * 16 + blk; U[(size_t)uidx * 16384 + el] = S; S = __builtin_amdgcn_exp2f(dl[p]) * S + u[p]; }
    }
}

constexpr int HF_S0 = 0, HF_S1 = 40960, HF_TG0 = 81920, HF_TG1 = 98816, HF_QG0 = 115712, HF_QG1 = 124416;
__device__ __forceinline__ void hgrn_final_unit(PP P, LAS unsigned char* lds, int l, int idx, int tid) {
    const int lane = tid & 63, wave = __builtin_amdgcn_readfirstlane(tid >> 6), r32 = lane & 31, hh = lane >> 5, i16 = lane & 15, cg = (lane >> 4) & 1;
    const bf16* Z = (const bf16*)(P->ws + WS_Z); bf16* MIX = (bf16*)(P->ws + WS_H); const float* OL = (const float*)(P->ws + WS_OL); const float* DLC = (const float*)(P->ws + WS_DLOG);
    LAS float* ldsf = (LAS float*)lds;
    const int blk = idx & 15, h = (idx >> 4) & 3, lb = idx >> 6, row0 = NCTX + lb * 2048 + blk * 128;
    const int ti = tid >> 4, d0 = 8 * (tid & 15), nt = wave & 3, ds = wave >> 2;
    const int uidx0 = ((idx >> 4) * 2 + 0) * 16 + blk, uidx1 = ((idx >> 4) * 2 + 1) * 16 + blk;
#pragma unroll
    for (int half = 0; half < 2; ++half) {
        f32x4 sv[8];
#pragma unroll
        for (int k = 0; k < 8; ++k) { const int id = tid + 512 * (k + 8 * half), dsel = id >> 12, dk = (id >> 5) & 127, c4 = id & 31;
            sv[k] = *(const f32x4*)((const float*)(P->ws + WS_U) + (size_t)(dsel ? uidx1 : uidx0) * 16384 + dk * 128 + c4 * 4); }
#pragma unroll
        for (int k = 0; k < 8; ++k) { const int id = tid + 512 * (k + 8 * half), dsel = id >> 12, dk = (id >> 5) & 127, c4 = id & 31;
            u32x2 w; w.x = pk2(sv[k][0], sv[k][1]); w.y = pk2(sv[k][2], sv[k][3]); *(LAS u32x2*)(lds + (dsel ? HF_S1 : HF_S0) + dk * 320 + c4 * 8) = w; }
    }
    float oml0[8], oml1[8];
#pragma unroll
    for (int j = 0; j < 8; ++j) { oml0[j] = 1.0f - hg_lb(P, l, 0, h * 128 + d0 + j); oml1[j] = 1.0f - hg_lb(P, l, 1, h * 128 + d0 + j); }
    float carry = 0.f;
    for (int nc = 0; nc < 4; ++nc) {
        const int rown = row0 + 32 * nc + ti; const bf16* zr = Z + (size_t)rown * DIN + h * 128 + d0;
        const u32x4 uq = *(const u32x4*)(zr + C_HQ), uf0 = *(const u32x4*)(zr + C_HFF), uf1 = *(const u32x4*)(zr + C_HFB), ug = *(const u32x4*)(zr + C_HG);
        const float* olr = OL + (size_t)rown * 512 + h * 128 + d0; const f32x4 olp0 = *(const f32x4*)olr, olp1 = *(const f32x4*)(olr + 4);
        float off1 = 0.f;
        if (tid >= 128 && tid < 256) { for (int c = 0; c < 3 - nc; ++c) off1 += DLC[(uidx1 * 4 + c) * 128 + (tid - 128)]; }
        float q[8];
        {
            float ga[8], gb[8];
#pragma unroll
            for (int j = 0; j < 4; ++j) { const unsigned wq = uq[j], wa = uf0[j], wb = uf1[j];
                q[2 * j] = siluf_(bflo(wq)) * 0.08838834764831845f; q[2 * j + 1] = siluf_(bfhi(wq)) * 0.08838834764831845f;
                ga[2 * j] = oml0[2 * j] * sigmoidf_(-bflo(wa)); ga[2 * j + 1] = oml0[2 * j + 1] * sigmoidf_(-bfhi(wa));
                gb[2 * j] = oml1[2 * j] * sigmoidf_(-bflo(wb)); gb[2 * j + 1] = oml1[2 * j + 1] * sigmoidf_(-bfhi(wb)); }
#pragma unroll
            for (int j = 0; j < 8; ++j) { ga[j] = __builtin_amdgcn_logf(1.0f - fminf(ga[j], 1.0f - 1e-6f)); gb[j] = __builtin_amdgcn_logf(1.0f - fminf(gb[j], 1.0f - 1e-6f)); }
            LAS float* p0 = ldsf + (HF_TG0 >> 2) + ti * 132 + d0; LAS float* p1 = ldsf + (HF_TG1 >> 2) + ti * 132 + d0;
            *(LAS f32x4*)p0 = (f32x4){ga[0], ga[1], ga[2], ga[3]}; *(LAS f32x4*)(p0 + 4) = (f32x4){ga[4], ga[5], ga[6], ga[7]};
            *(LAS f32x4*)p1 = (f32x4){gb[0], gb[1], gb[2], gb[3]}; *(LAS f32x4*)(p1 + 4) = (f32x4){gb[4], gb[5], gb[6], gb[7]};
        }
        __syncthreads();
        if (tid < 128) { LAS float* gc = ldsf + (HF_TG0 >> 2) + tid; float run = carry;
#pragma unroll
            for (int i = 0; i < 32; ++i) { run += gc[i * 132]; gc[i * 132] = run; }
            carry = run; }
        else if (tid < 256) { LAS float* gc = ldsf + (HF_TG1 >> 2) + (tid - 128); float run = off1;
#pragma unroll
            for (int i = 31; i >= 0; --i) { run += gc[i * 132]; gc[i * 132] = run; } }
        __syncthreads();
        {
            const LAS float* g0 = ldsf + (HF_TG0 >> 2) + ti * 132 + d0; const LAS float* g1 = ldsf + (HF_TG1 >> 2) + ti * 132 + d0;
            float a[8], c[8];
#pragma unroll
            for (int j = 0; j < 8; ++j) { a[j] = q[j] * __builtin_amdgcn_exp2f(g0[j]); c[j] = q[j] * __builtin_amdgcn_exp2f(g1[j]); }
            *(LAS bf16x8*)(lds + HF_QG0 + ti * 272 + d0 * 2) = pack8(a[0], a[1], a[2], a[3], a[4], a[5], a[6], a[7]);
            *(LAS bf16x8*)(lds + HF_QG1 + ti * 272 + d0 * 2) = pack8(c[0], c[1], c[2], c[3], c[4], c[5], c[6], c[7]);
        }
        __syncthreads();
        {
            f32x16 acc;
#pragma unroll
            for (int i = 0; i < 16; ++i) acc[i] = 0.f;
            const LAS unsigned char* qp = lds + (ds ? HF_QG1 : HF_QG0) + r32 * 272 + 16 * hh;
            const LAS unsigned char* sp = lds + (ds ? HF_S1 : HF_S0) + (8 * hh + (i16 >> 2)) * 320 + (32 * nt + 16 * cg + 4 * (i16 & 3)) * 2;
#pragma unroll
            for (int k = 0; k < 8; ++k) { const bf16x8 sf = trpair(sp + 16 * k * 320, 4 * 320); acc = __builtin_amdgcn_mfma_f32_32x32x16_bf16(*(const LAS bf16x8*)(qp + 32 * k), sf, acc, 0, 0, 0); }
            LAS float* ob = ldsf + ((ds ? HF_TG1 : HF_TG0) >> 2) + (4 * hh) * 132 + 32 * nt + r32;
#pragma unroll
            for (int i = 0; i < 16; ++i) ob[R0(i) * 132] = acc[i];
        }
        __syncthreads();
        {
            const LAS float* oa = ldsf + (HF_TG0 >> 2) + ti * 132 + d0; const LAS float* obb = ldsf + (HF_TG1 >> 2) + ti * 132 + d0;
            const f32x4 a0 = *(const LAS f32x4*)oa, a1 = *(const LAS f32x4*)(oa + 4), b0 = *(const LAS f32x4*)obb, b1 = *(const LAS f32x4*)(obb + 4);
            const f32x4 o0 = a0 + b0 + olp0, o1 = a1 + b1 + olp1;
            float ss = (o0[0] * o0[0] + o0[1] * o0[1]) + (o0[2] * o0[2] + o0[3] * o0[3]) + (o1[0] * o1[0] + o1[1] * o1[1]) + (o1[2] * o1[2] + o1[3] * o1[3]);
            ss += __shfl_xor(ss, 1); ss += __shfl_xor(ss, 2); ss += __shfl_xor(ss, 4); ss += __shfl_xor(ss, 8);
            const float r = 1.0f / sqrtf(ss * (1.0f / 128.0f) + 1e-6f);
            const float* nw = P->in[13] + l * 512 + h * 128 + d0; const f32x4 n0 = *(const f32x4*)nw, n1 = *(const f32x4*)(nw + 4);
            u32x4 w;
            w.x = pk2(o0[0] * r * n0[0] * siluf_(bflo(ug.x)), o0[1] * r * n0[1] * siluf_(bfhi(ug.x))); w.y = pk2(o0[2] * r * n0[2] * siluf_(bflo(ug.y)), o0[3] * r * n0[3] * siluf_(bfhi(ug.y)));
            w.z = pk2(o1[0] * r * n1[0] * siluf_(bflo(ug.z)), o1[1] * r * n1[1] * siluf_(bfhi(ug.z))); w.w = pk2(o1[2] * r * n1[2] * siluf_(bflo(ug.w)), o1[3] * r * n1[3] * siluf_(bfhi(ug.w)));
            *(u32x4*)(MIX + (size_t)rown * D_MODEL + 1024 + h * 128 + d0) = w;
        }
        __syncthreads();
    }
}

#define RLX_AGENT __ATOMIC_RELAXED, __HIP_MEMORY_SCOPE_AGENT
#define XB_TMO      128
#define XB_XCNT(j)  (256  + 64 * (j))
#define XB_XSUB(j)  (1280 + 64 * (j))
#define XB_XGEN(j)  (2304 + 64 * (j))
#define XB_TOP      3328
#define XB_TOPGEN   3392
#define XCD_BAR_WORDS 3456
#define XB_SPIN_CAP (1u << 18)

__device__ __forceinline__ unsigned xb_ld(unsigned* p)              { return __hip_atomic_load(p, __ATOMIC_RELAXED, __HIP_MEMORY_SCOPE_AGENT); }
__device__ __forceinline__ unsigned xb_add(unsigned* p, unsigned v) { return __hip_atomic_fetch_add(p, v, __ATOMIC_RELAXED, __HIP_MEMORY_SCOPE_AGENT); }
__device__ __forceinline__ unsigned xb_xcc_id() { return (unsigned)__builtin_amdgcn_s_getreg((3 << 11) | 20) & 0xFu; }
#define XB_SPIN(cond, bar) do { unsigned _sp = 0; while (cond) { __builtin_amdgcn_s_sleep(1); \
    if ((++_sp & 255u) == 0u) { if (xb_ld(&(bar)[XB_TMO])) break; if (_sp > XB_SPIN_CAP) { atomicAdd(&(bar)[XB_TMO], 1u); break; } } } } while (0)

struct XcdBarrier {
    unsigned* bar; unsigned x;
    volatile LAS unsigned* st;
};

__device__ __forceinline__ XcdBarrier xcd_barrier_post(unsigned* bar, volatile LAS unsigned* st) {
    XcdBarrier b; b.bar = bar; b.x = xb_xcc_id(); b.st = st;
    if (threadIdx.x == 0) (void)xb_add(&bar[XB_XCNT(b.x)], 1u);
    return b;
}
__device__ __forceinline__ void xcd_barrier_complete(unsigned* bar, unsigned x, unsigned& nloc, unsigned& nx) {
    const unsigned G = gridDim.x * gridDim.y * gridDim.z;
    unsigned sum, cnt, mine, sp = 0u;
    for (;;) {
        sum = 0u; cnt = 0u; mine = 0u;
#pragma unroll
        for (unsigned j = 0; j < 16; ++j) { const unsigned c = xb_ld(&bar[XB_XCNT(j)]); sum += c; cnt += (c > 0u) ? 1u : 0u; mine = (j == x) ? c : mine; }
        if (sum == G) break;
        __builtin_amdgcn_s_sleep(1);
        if ((++sp & 255u) == 0u) { if (xb_ld(&bar[XB_TMO])) break; if (sp > XB_SPIN_CAP) { atomicAdd(&bar[XB_TMO], 1u); break; } }
    }
    nloc = mine > 0u ? mine : 1u; nx = cnt > 0u ? cnt : 1u;
}

__device__ __forceinline__ void xcd_barrier(const XcdBarrier& b) {
    asm volatile("s_waitcnt vmcnt(0)" ::: "memory");
    __syncthreads();
    if (threadIdx.x == 0) {
        unsigned* bar = b.bar;
        __builtin_amdgcn_s_waitcnt(0);
        unsigned nloc = b.st[0], nx = b.st[1];
        if (nloc == 0u) { xcd_barrier_complete(bar, b.x, nloc, nx); b.st[0] = nloc; b.st[1] = nx; }
        const unsigned old = xb_add(&bar[XB_XSUB(b.x)], 1u);
        const unsigned gen = old / nloc;
        if (old + 1u == (gen + 1u) * nloc) {
            __builtin_amdgcn_fence(__ATOMIC_RELEASE, "agent");
            asm volatile("s_waitcnt vmcnt(0)" ::: "memory");
            const unsigned og = xb_add(&bar[XB_TOP], 1u);
            const unsigned tg = og / nx;
            if (og + 1u == (tg + 1u) * nx) xb_add(&bar[XB_TOPGEN], 1u);
            else XB_SPIN(xb_ld(&bar[XB_TOPGEN]) == tg, bar);
            __builtin_amdgcn_fence(__ATOMIC_ACQUIRE, "agent");
            xb_add(&bar[XB_XGEN(b.x)], 1u);
            asm volatile("s_waitcnt vmcnt(0)" ::: "memory");
        } else {
            XB_SPIN(xb_ld(&bar[XB_XGEN(b.x)]) == gen, bar);
            __builtin_amdgcn_fence(__ATOMIC_ACQUIRE, "agent");
            asm volatile("s_waitcnt vmcnt(0)" ::: "memory");
        }
    }
    __syncthreads();
}

#ifndef REP_P0
#define REP_P0 1
#endif
#ifndef REP_P1
#define REP_P1 1
#endif
#ifndef REP_P2
#define REP_P2 1
#endif
#ifndef P2_MASK
#define P2_MASK 31
#endif
#ifndef REP_P3
#define REP_P3 1
#endif
#ifndef REP_P4
#define REP_P4 1
#endif
__global__ void __launch_bounds__(NTHREADS, 2) fwd_kernel(Params Pkarg) {
    extern __shared__ __attribute__((aligned(16))) unsigned char lds_raw[];
    cg::grid_group grid = cg::this_grid();
    LAS unsigned char* lds = (LAS unsigned char*)lds_raw;
    LAS float* ldsf = (LAS float*)lds;
    volatile LAS unsigned* qslot = (volatile LAS unsigned*)(lds + 131072 + 1024);
    volatile LAS unsigned* xbst = (volatile LAS unsigned*)(lds + 131072 + 2048);
    if (threadIdx.x < 2) xbst[threadIdx.x] = 0u;
    __syncthreads();
    const XcdBarrier xb = xcd_barrier_post((unsigned*)(Pkarg.ws + WS_CTL) + 1024, xbst);
#define GSYNC() xcd_barrier(xb)
#define PHASE_IDS int tid = threadIdx.x; asm volatile("" : "+v"(tid)); const int lane = tid & 63, wave = __builtin_amdgcn_readfirstlane(tid >> 6), gw = blockIdx.x * NWAVES + wave; (void)lane; (void)gw; \
    PP P = (PP)__builtin_amdgcn_kernarg_segment_ptr(); asm volatile("" : "+s"(P)); unsigned char* ws = P->ws; unsigned* ctl = (unsigned*)(ws + WS_CTL); float* MOD = (float*)(ws + WS_MOD); \
    bf16* H = (bf16*)(ws + WS_H); bf16* Z = (bf16*)(ws + WS_Z); bf16* WTIN = (bf16*)(ws + WS_WTIN); bf16* WTOUT = (bf16*)(ws + WS_WTOUT); const float* xp = P->in[0]; const float* xs = P->in[1]; \
    (void)ctl; (void)MOD; (void)H; (void)Z; (void)WTIN; (void)WTOUT; (void)xp; (void)xs;
    const int G = gridDim.x, NGW = G * NWAVES;

    for (int rep = 0; rep < REP_P0; ++rep) {
        PHASE_IDS
        for (int u = blockIdx.x; u < 384; u += G) mod_unit(P, ldsf, u / 192, u % 192, tid);
        LAS float* scr = ldsf + wave * 4096;
        for (int it = gw; it < 6656 + 2048 + 2048; it += NGW) {
            if (it < 6656) transpose_item(P->in[9], 2048, DIN, WTIN, scr, it, lane);
            else if (it < 6656 + 2048) transpose_item(P->in[10], 2048, 2048, WTOUT, scr, it - 6656, lane);
            else transpose_item(P->in[10] + (size_t)2048 * 2048, 2048, 2048, WTOUT + (size_t)2048 * 2048, scr, it - 6656 - 2048, lane);
        }
        const int gt = blockIdx.x * NTHREADS + tid;
        if (gt < 2048) { const int pos = gt >> 5, i = gt & 31; const float inv = powf(10000.0f, -(float)i / 32.0f); const float ang = (float)pos * inv;
            float sn, cs; sincosf(ang, &sn, &cs); float* CS = (float*)(ws + WS_CS); CS[gt * 2] = cs; CS[gt * 2 + 1] = sn; }
        grid.sync();
    }
    { PHASE_IDS
    for (int row = gw; row < MTOK; row += NGW) {
        const int cond = (row < NCTX) ? 0 : 1 + ((row - NCTX) >> 11);
        const float* xrow = (row < NCTX) ? xp + (size_t)row * D_MODEL : xs + (size_t)(row - NCTX) * D_MODEL;
        hprep_row(xrow, MOD + (0 * 3 + cond) * 6144, H + (size_t)row * D_MODEL, lane);
    } }
    GSYNC();

    for (int l = 0; l < DEPTH; ++l) {
        for (int rep = 0; rep < REP_P1; ++rep) {
            PHASE_IDS
            pg8::Gemm g{H, WTIN, MTOK, DIN, D_MODEL}; pg8::StaticOrder S; S.init(MTOK, DIN, G, (int)blockIdx.x);
            pg8::EpiZ E{Z, P->out + OUT_CK, P->out + OUT_CV, l};
            pg8::gemm_phase<pg8::EpiZ, pg8::StaticOrder, true, true>(lds, g, S, E);
            GSYNC();
        }
        for (int rep = 0; rep < REP_P2; ++rep) {
            PHASE_IDS
            unsigned* ctr = ctl + 64 * (l * 2 + 0 + 4 * rep);
            const int n_cvt = (l == 0) ? 832 : 0;
            const int msk = (rep == 0) ? 31 : P2_MASK;
            unsigned pend = 0u;
            for (int u = q_first(ctr, qslot, tid, pend); u < 1408 + n_cvt; u = q_next(ctr, qslot, tid, pend)) {
                asm volatile("" : "+v"(tid));
                if (u < 128) { if (msk & 2) attn_unit(P, lds, l, 1, u, tid); continue; } u -= 128;
                if (u < 128) { if (msk & 1) hgrn2_unit(P, lds, l, 0, u, tid); continue; } u -= 128;
                if (u < 256) { if (msk & 4) attn_unit(P, lds, l, 0, u, tid); continue; } u -= 256;
                if (u < 128) { if (msk & 1) hgrn2_unit(P, lds, l, 1, u, tid); continue; } u -= 128;
                if (u < 768) { if (msk & 8) conv_unit(P, ldsf, l, u, tid); continue; } u -= 768;
                if (msk & 16) { const int lane2 = tid & 63; LAS float* scr = ldsf + wave * 4096; transpose_item(P->in[9] + (size_t)2048 * DIN, 2048, DIN, WTIN, scr, u * 8 + wave, lane2); }
            }
            GSYNC();
        }
        { PHASE_IDS hgrn_scan(P, l, tid); }
        GSYNC();
        for (int rep = 0; rep < REP_P3; ++rep) {
            PHASE_IDS
            unsigned* ctr = ctl + 64 * (l * 2 + 1 + 4 * rep);
            unsigned pend = 0u;
            for (int u = q_first(ctr, qslot, tid, pend); u < 128; u = q_next(ctr, qslot, tid, pend)) {
                asm volatile("" : "+v"(tid));
                hgrn_final_unit(P, lds, l, u, tid);
            }
            GSYNC();
        }
        for (int rep = 0; rep < ((l == 0) ? REP_P4 : 1); ++rep) {
            PHASE_IDS
            pg8::Gemm g{H, WTOUT + (size_t)l * 2048 * 2048, MTOK, D_MODEL, D_MODEL}; pg8::StaticOrder S; S.init(MTOK, D_MODEL, G, (int)blockIdx.x);
            pg8::EpiV E{(l == 0) ? xp : P->out, (l == 0) ? xs : P->out + OUT_YS, P->out, MOD + l * 3 * 6144 + 4096};
            pg8::gemm_phase<pg8::EpiV, pg8::StaticOrder, true, true>(lds, g, S, E);
            GSYNC();
        }
        { PHASE_IDS
        for (int row = gw; row < MTOK; row += NGW) {
            const int cond = (row < NCTX) ? 0 : 1 + ((row - NCTX) >> 11);
            ln_row(P->out + (size_t)row * D_MODEL, P->in[18] + l * D_MODEL, P->in[19] + l * D_MODEL, MOD + (3 + cond) * 6144, (l == 0) ? H + (size_t)row * D_MODEL : (bf16*)nullptr, lane);
        } }
        if (l + 1 < DEPTH) GSYNC();
    }
}

extern "C" void kernel_launch(void* const* d_in, const int* in_sizes, int n_in, void* d_out, int out_size, void* d_ws, size_t ws_size, hipStream_t stream) {
    static int grid = 0;
    if (grid == 0) {
        if (n_in != 20 || out_size != (int)OUT_TOTAL || ws_size < WS_END) { fprintf(stderr, "kernel_launch: unexpected shapes (n_in %d, out %d, ws %zu)\n", n_in, out_size, ws_size); grid = -1; return; }
        int dev = 0, cus = 0, per_cu = 0;
        hipGetDevice(&dev); hipDeviceGetAttribute(&cus, hipDeviceAttributeMultiprocessorCount, dev);
        hipFuncSetAttribute((const void*)fwd_kernel, hipFuncAttributeMaxDynamicSharedMemorySize, LDS_BYTES);
        hipOccupancyMaxActiveBlocksPerMultiprocessor(&per_cu, (const void*)fwd_kernel, NTHREADS, LDS_BYTES);
        if (per_cu < 1) { fprintf(stderr, "kernel_launch: occupancy query says %d blocks per CU\n", per_cu); grid = -1; return; }
        grid = cus;
    }
    if (grid < 0) return;
    hipMemsetAsync((char*)d_ws + WS_CTL, 0, CTL_ZERO_BYTES, stream);
    Params p{};
    for (int i = 0; i < 20; ++i) p.in[i] = (const float*)d_in[i];
    p.out = (float*)d_out; p.ws = (unsigned char*)d_ws;
    void* args[] = {&p};
    hipError_t e = hipLaunchCooperativeKernel((const void*)fwd_kernel, dim3(grid), dim3(NTHREADS), args, LDS_BYTES, stream);
    if (e != hipSuccess) fprintf(stderr, "cooperative launch failed: %s (grid %d)\n", hipGetErrorString(e), grid);
}
```

```cpp
#include <hip/hip_runtime.h>
#include <hip/hip_cooperative_groups.h>
#include <cstdio>
#include <cstdint>
namespace cg = cooperative_groups;

constexpr int D_MODEL = 2048, DIN = 6656, NCTX = 8192, NLAT = 4096, MTOK = 12288, DEPTH = 2;
constexpr int C_AQ = 0, C_AK = 1024, C_AV = 1280, C_AG = 1536, C_HQ = 2560, C_HI = 3072, C_HFF = 3584, C_HFB = 4096, C_HG = 4608, C_CA = 5120, C_CB = 5632, C_CG = 6144;
constexpr float ALPHA_DN = 1.4142135623730951f;
constexpr size_t OUT_YP = 0, OUT_YS = 16777216, OUT_CK = 25165824, OUT_CV = 29360128, OUT_ST = 33554432, OUT_TOTAL = 41943040;
namespace pg8 {
#define PG8_LAS __attribute__((address_space(3)))
typedef unsigned short bf16_t;
typedef short bf16x8 __attribute__((ext_vector_type(8)));
typedef float f32x4 __attribute__((ext_vector_type(4)));
typedef unsigned u32x4 __attribute__((ext_vector_type(4)));
constexpr int BM = 256, BK = 64, HALF = 128, HTB = HALF * BK * 2  , STAGE_BYTES = 8 * HTB, NXCD = 8, WGM = 8;

__host__ __device__ __forceinline__ int lds_byte(int r, int c) { const int st = (r >> 4) * 2 + (c >> 5), rr = r & 15, cc = c & 31, ob = rr * 64 + cc * 2; return st * 1024 + (ob ^ (((ob >> 9) & 1) << 5)); }
__host__ __device__ __forceinline__ void stage_rc(int b, int& R, int& C) { const int st = b / 1024, sb = b % 1024, swz = sb ^ (((sb >> 9) & 1) << 5); R = (st >> 1) * 16 + swz / 64; C = (st & 1) * 32 + (swz % 64) / 2; }
__host__ __device__ __forceinline__ int perm32(int rho) { const int n = rho >> 4, i = rho & 15; return 8 * (i >> 2) + 4 * n + (i & 3); }

struct Unit { int pm, pn; };
struct Gemm { const bf16_t* A; const bf16_t* Bt; int M, N, K; };

struct StaticOrder {
    int nM, nN, nwg, G, c;
    __host__ __device__ void init(int M, int N, int G_, int c_) { nM = M / BM; nN = N / BM; nwg = nM * nN; G = G_; c = c_; }
    __host__ __device__ bool next(int i, Unit& u) const {
        const long L = (long)i * G + c; if (L >= nwg) return false;
        int wgid = (int)L; { const int q = nwg / NXCD, r = nwg % NXCD, xcd = wgid % NXCD, off = wgid / NXCD; wgid = (xcd < r ? xcd * (q + 1) : r * (q + 1) + (xcd - r) * q) + off; }
        const int nig = WGM * nN, gid = wgid / nig, fm = gid * WGM, gsz = (nM - fm) < WGM ? (nM - fm) : WGM;
        u.pm = fm + ((wgid % nig) % gsz); u.pn = (wgid % nig) / gsz; return true;
    }
    __device__ __forceinline__ void a_ready(const Unit&) const {}
    __device__ __forceinline__ void done(const Unit&) const {}
};

__device__ __forceinline__ unsigned cvt_pk_bf16(float lo, float hi) { unsigned r; asm volatile("v_cvt_pk_bf16_f32 %0, %1, %2" : "=v"(r) : "v"(lo), "v"(hi)); return r; }
typedef float f32x2 __attribute__((ext_vector_type(2)));

struct EpiZ {
    static constexpr bool PERM = true, AFTER_DRAIN = false;
    bf16_t* Z; float* ck; float* cv; int layer;
    __device__ __forceinline__ void operator()(const f32x4 (&acc)[2][2][4][2], const Unit& u, int wr, int wc, int fr, int fq) const {
        const int row0 = u.pm * BM + wr * 64 + fr; const int col0 = u.pn * BM + wc * 32 + 8 * fq;
#pragma unroll
        for (int ai = 0; ai < 2; ++ai)
#pragma unroll
            for (int m = 0; m < 4; ++m) { bf16_t* rowp = Z + (size_t)(row0 + ai * HALF + m * 16) * DIN + col0;
#pragma unroll
                for (int bj = 0; bj < 2; ++bj) { const f32x4 v0 = acc[ai][bj][m][0], v1 = acc[ai][bj][m][1];
                    u32x4 w; w.x = cvt_pk_bf16(v0[0], v0[1]); w.y = cvt_pk_bf16(v0[2], v0[3]); w.z = cvt_pk_bf16(v1[0], v1[1]); w.w = cvt_pk_bf16(v1[2], v1[3]);
                    *(u32x4*)(rowp + bj * HALF) = w; } }
        if ((u.pn == 4 || u.pn == 5) && u.pm < 32) {
            float* base = (u.pn == 4) ? ck : cv;
#pragma unroll
            for (int ai = 0; ai < 2; ++ai)
#pragma unroll
                for (int m = 0; m < 4; ++m) { const int row = row0 + ai * HALF + m * 16; const int b = row >> 8, s = row & 255;
                    float* p = base + ((size_t)((b * 2 + layer) * 256 + s)) * 256 + (wc * 32 + 8 * fq);
#pragma unroll
                    for (int bj = 0; bj < 2; ++bj) { *(f32x4*)(p + bj * HALF) = acc[ai][bj][m][0]; *(f32x4*)(p + bj * HALF + 4) = acc[ai][bj][m][1]; } }
        }
    }
};
struct EpiV {
    static constexpr bool PERM = false, AFTER_DRAIN = false;
    const float* xp; const float* xs; float* V; const float* gate;
    __device__ __forceinline__ void operator()(const f32x4 (&acc)[2][2][4][2], const Unit& u, int wr, int wc, int fr, int fq) const {
        const int row0 = u.pm * BM + wr * 64 + fr; const int col0 = u.pn * BM + wc * 32 + 4 * fq;
        const int cond = (u.pm < 32) ? 0 : 1 + ((u.pm - 32) >> 3);
        const float* g = gate + cond * 6144 + col0;
        f32x4 gv[2][2];
#pragma unroll
        for (int bj = 0; bj < 2; ++bj)
#pragma unroll
            for (int n = 0; n < 2; ++n) gv[bj][n] = *(const f32x4*)(g + bj * HALF + n * 16);
#pragma unroll
        for (int ai = 0; ai < 2; ++ai)
#pragma unroll
            for (int m = 0; m < 4; ++m) { const int row = row0 + ai * HALF + m * 16;
                const float* xr = ((row < NCTX) ? xp + (size_t)row * D_MODEL : xs + (size_t)(row - NCTX) * D_MODEL) + col0;
                float* vr = V + (size_t)row * D_MODEL + col0;
#pragma unroll
                for (int bj = 0; bj < 2; ++bj)
#pragma unroll
                    for (int n = 0; n < 2; ++n) { const f32x4 xv = *(const f32x4*)(xr + bj * HALF + n * 16);
                        *(f32x4*)(vr + bj * HALF + n * 16) = xv * ALPHA_DN + gv[bj][n] * acc[ai][bj][m][n]; }
                asm volatile("" ::: "memory"); }
    }
};
template <class Epi, class Sched, bool ALIGN_EPI = false, bool SP2 = false>
__device__ __forceinline__ void gemm_phase(PG8_LAS unsigned char* lds, const Gemm g, const Sched& S, const Epi& E, int tid_in) {
    int tid_l = tid_in; asm volatile("" : "+v"(tid_l));
    const int tid = tid_l, wid = __builtin_amdgcn_readfirstlane(tid >> 6), lane = tid & 63, wr = wid >> 2, wc = wid & 3, fr = lane & 15, fq = lane >> 4;
    const int K = g.K, nt = K / BK;
    unsigned voffA[2], voffB[2];
#pragma unroll
    for (int i = 0; i < 2; ++i) { int R, C; stage_rc(tid * 16 + i * 8192, R, C); const int Rb = Epi::PERM ? ((R & ~31) + perm32(R & 31)) : R;
        voffA[i] = (unsigned)(R * K + C) * 2u; voffB[i] = (unsigned)(Rb * K + C) * 2u; }
    const size_t kstep = (size_t)(BK * 2);
    const size_t hstep = (size_t)HALF * K * 2;
    const size_t tstep = 2 * hstep;
    const unsigned ldsw = (unsigned)wid * 1024u;
    const int aoff = lds_byte(wr * 64 + fr, fq * 8), boff = lds_byte(wc * 32 + fr, fq * 8);
#define PG8_SA(b, h) (((b) * 2 + (h)) * HTB)
#define PG8_SB(b, h) ((4 + (b) * 2 + (h)) * HTB)
#define PG8_STAGE(bufoff, gbase, voff) do { _Pragma("unroll") for (int _i = 0; _i < 2; ++_i) \
        __builtin_amdgcn_global_load_lds((const unsigned*)((const char*)(gbase) + (voff)[_i]), (PG8_LAS unsigned*)(lds + (bufoff) + ldsw + _i * 8192), 16, 0, 0); } while (0)
#define PG8_LDA(dst, b, h) do { _Pragma("unroll") for (int m = 0; m < 4; ++m) _Pragma("unroll") for (int k = 0; k < 2; ++k) dst[m][k] = *(const PG8_LAS bf16x8*)(lds + PG8_SA(b, h) + aoff + m * 2048 + k * 1024); } while (0)
#define PG8_LDB(dst, b, h) do { _Pragma("unroll") for (int n = 0; n < 2; ++n) _Pragma("unroll") for (int k = 0; k < 2; ++k) dst[n][k] = *(const PG8_LAS bf16x8*)(lds + PG8_SB(b, h) + boff + n * 2048 + k * 1024); } while (0)
#define PG8_MMA(ai, bj, At, Bt) do { __builtin_amdgcn_s_setprio(1); _Pragma("unroll") for (int m = 0; m < 4; ++m) _Pragma("unroll") for (int n = 0; n < 2; ++n) _Pragma("unroll") for (int k = 0; k < 2; ++k) \
        acc[ai][bj][m][n] = __builtin_amdgcn_mfma_f32_16x16x32_bf16(Bt[n][k], At[m][k], acc[ai][bj][m][n], 0, 0, 0); __builtin_amdgcn_s_setprio(0); } while (0)
#define PG8_WAIT_V(n) asm volatile("s_waitcnt vmcnt(" #n ")" ::: "memory")
#define PG8_WAIT_L(n) asm volatile("s_waitcnt lgkmcnt(" #n ")" ::: "memory")
#define PG8_BAR __builtin_amdgcn_s_barrier()
#define PG8_SCHED __builtin_amdgcn_sched_barrier(0)
    Unit cur, nxt; int ui = 0;
    if (!S.next(0, cur)) return;
    f32x4 acc[2][2][4][2];
#pragma unroll
    for (int a = 0; a < 2; ++a)
#pragma unroll
        for (int b = 0; b < 2; ++b)
#pragma unroll
            for (int m = 0; m < 4; ++m)
#pragma unroll
                for (int n = 0; n < 2; ++n) acc[a][b][m][n] = (f32x4){0.f, 0.f, 0.f, 0.f};
    bf16x8 At[4][2], B0[2][2], B1[2][2];
    const char* cA = (const char*)g.A + (size_t)cur.pm * tstep; const char* cB = (const char*)g.Bt + (size_t)cur.pn * tstep;
    S.a_ready(cur);
    if constexpr (SP2) {
        PG8_STAGE(PG8_SB(0, 0), cB, voffB); PG8_STAGE(PG8_SB(0, 1), cB + hstep, voffB); PG8_STAGE(PG8_SA(0, 0), cA, voffA); PG8_STAGE(PG8_SA(0, 1), cA + hstep, voffA);
        if (wr == 1) PG8_BAR;
        PG8_WAIT_V(2); PG8_BAR;
        PG8_STAGE(PG8_SB(1, 0), cB + kstep, voffB); PG8_STAGE(PG8_SA(1, 0), cA + kstep, voffA); PG8_STAGE(PG8_SB(1, 1), cB + hstep + kstep, voffB);
        PG8_WAIT_V(6); PG8_BAR;
    } else {
        PG8_STAGE(PG8_SB(0, 0), cB, voffB); PG8_STAGE(PG8_SA(0, 0), cA, voffA); PG8_STAGE(PG8_SB(0, 1), cB + hstep, voffB); PG8_STAGE(PG8_SA(0, 1), cA + hstep, voffA);
        if (wr == 1) PG8_BAR;
        PG8_WAIT_V(4); PG8_BAR;
        PG8_STAGE(PG8_SB(1, 0), cB + kstep, voffB); PG8_STAGE(PG8_SA(1, 0), cA + kstep, voffA); PG8_STAGE(PG8_SB(1, 1), cB + hstep + kstep, voffB);
        PG8_WAIT_V(6); PG8_BAR;
    }
    for (;;) {
        const bool has_next = S.next(ui + 1, nxt);
        const char* nA = has_next ? (const char*)g.A + (size_t)nxt.pm * tstep : cA; const char* nB = has_next ? (const char*)g.Bt + (size_t)nxt.pn * tstep : cB;
        for (int t = 0; t < nt; t += 2) {
            const bool last = (t == nt - 2);
            const char* a1 = cA + (size_t)(t + 1) * kstep;
            const char* a2 = last ? nA : cA + (size_t)(t + 2) * kstep; const char* b2 = last ? nB : cB + (size_t)(t + 2) * kstep;
            const char* a3 = a2 + kstep; const char* b3 = b2 + kstep;
            if (last && has_next) S.a_ready(nxt);
            if constexpr (SP2) {
            PG8_LDB(B0, 0, 0); PG8_LDB(B1, 0, 1); PG8_SCHED; PG8_LDA(At, 0, 0); PG8_STAGE(PG8_SA(1, 1), a1 + hstep, voffA);
            PG8_WAIT_V(8); PG8_WAIT_L(0); PG8_BAR; PG8_MMA(0, 0, At, B0); PG8_MMA(0, 1, At, B1); PG8_BAR; PG8_SCHED;
            PG8_LDA(At, 0, 1); PG8_STAGE(PG8_SB(0, 0), b2, voffB); PG8_STAGE(PG8_SB(0, 1), b2 + hstep, voffB); PG8_STAGE(PG8_SA(0, 0), a2, voffA);
            PG8_WAIT_V(8); PG8_WAIT_L(0); PG8_BAR; PG8_MMA(1, 0, At, B0); PG8_MMA(1, 1, At, B1); PG8_BAR; PG8_SCHED;
            PG8_LDB(B0, 1, 0); PG8_LDB(B1, 1, 1); PG8_SCHED; PG8_LDA(At, 1, 0); PG8_STAGE(PG8_SA(0, 1), a2 + hstep, voffA);
            PG8_WAIT_V(8); PG8_WAIT_L(0); PG8_BAR; PG8_MMA(0, 0, At, B0); PG8_MMA(0, 1, At, B1); PG8_BAR; PG8_SCHED;
            PG8_LDA(At, 1, 1); PG8_STAGE(PG8_SB(1, 0), b3, voffB); PG8_STAGE(PG8_SB(1, 1), b3 + hstep, voffB); PG8_STAGE(PG8_SA(1, 0), a3, voffA);
            PG8_WAIT_V(8); PG8_WAIT_L(0); PG8_BAR; PG8_MMA(1, 0, At, B0); PG8_MMA(1, 1, At, B1); PG8_BAR; PG8_SCHED;
            } else {
            PG8_LDB(B0, 0, 0); PG8_SCHED; PG8_LDA(At, 0, 0); PG8_STAGE(PG8_SA(1, 1), a1 + hstep, voffA);
            PG8_WAIT_L(8); PG8_BAR; PG8_WAIT_L(0); PG8_MMA(0, 0, At, B0); PG8_BAR; PG8_SCHED;
            PG8_LDB(B1, 0, 1); PG8_STAGE(PG8_SB(0, 0), b2, voffB);
            PG8_BAR; PG8_WAIT_L(0); PG8_MMA(0, 1, At, B1); PG8_BAR;
            PG8_LDA(At, 0, 1); PG8_STAGE(PG8_SA(0, 0), a2, voffA);
            PG8_BAR; PG8_WAIT_L(0); PG8_MMA(1, 0, At, B0); PG8_BAR; PG8_SCHED;
            PG8_STAGE(PG8_SB(0, 1), b2 + hstep, voffB);
            PG8_WAIT_V(6); PG8_BAR; PG8_MMA(1, 1, At, B1); PG8_BAR;
            PG8_LDB(B0, 1, 0); PG8_SCHED; PG8_LDA(At, 1, 0); PG8_STAGE(PG8_SA(0, 1), a2 + hstep, voffA);
            PG8_WAIT_L(8); PG8_BAR; PG8_WAIT_L(0); PG8_MMA(0, 0, At, B0); PG8_BAR; PG8_SCHED;
            PG8_LDB(B1, 1, 1); PG8_STAGE(PG8_SB(1, 0), b3, voffB);
            PG8_BAR; PG8_WAIT_L(0); PG8_MMA(0, 1, At, B1); PG8_BAR;
            PG8_LDA(At, 1, 1); PG8_STAGE(PG8_SA(1, 0), a3, voffA);
            PG8_BAR; PG8_WAIT_L(0); PG8_MMA(1, 0, At, B0); PG8_BAR; PG8_SCHED;
            PG8_STAGE(PG8_SB(1, 1), b3 + hstep, voffB);
            PG8_WAIT_V(6); PG8_BAR; PG8_MMA(1, 1, At, B1); PG8_BAR;
            }
        }
        if constexpr (ALIGN_EPI) { if (wr == 0) PG8_BAR; }
        if constexpr (!Epi::AFTER_DRAIN) { E(acc, cur, wr, wc, fr, fq); S.done(cur); }
        if (!has_next) break;
#pragma unroll
        for (int a = 0; a < 2; ++a)
#pragma unroll
            for (int b = 0; b < 2; ++b)
#pragma unroll
                for (int m = 0; m < 4; ++m)
#pragma unroll
                    for (int n = 0; n < 2; ++n) acc[a][b][m][n] = (f32x4){0.f, 0.f, 0.f, 0.f};
        cur = nxt; cA = nA; cB = nB; ++ui;
        if constexpr (ALIGN_EPI) { if (wr == 1) PG8_BAR; }
    }
    PG8_WAIT_V(0);
    if constexpr (!ALIGN_EPI) { if (wr == 0) PG8_BAR; }
    PG8_BAR;
    if constexpr (Epi::AFTER_DRAIN) { E.fused(acc, cur, wr, wc, fr, fq, lds, wid, lane); S.done(cur); }
#undef PG8_SA
#undef PG8_SB
#undef PG8_STAGE
#undef PG8_LDA
#undef PG8_LDB
#undef PG8_MMA
#undef PG8_WAIT_V
#undef PG8_WAIT_L
#undef PG8_BAR
#undef PG8_SCHED
}
}

constexpr size_t MiB = 1u << 20;
constexpr size_t WS_CTL = 0, CTL_ZERO_BYTES = 32768;
constexpr size_t WS_MOD = 1 * MiB;
constexpr size_t WS_CS = 1 * MiB + 192 * 1024;
constexpr size_t WS_DLOG = 1 * MiB + 256 * 1024;
constexpr size_t WS_WTOUT = 2 * MiB;
constexpr size_t WS_WTIN = 18 * MiB;
constexpr size_t WS_H = 44 * MiB;
constexpr size_t WS_Z = 92 * MiB;
constexpr size_t WS_U = 248 * MiB;
constexpr size_t WS_OL = 264 * MiB;
constexpr size_t WS_END = 312 * MiB;
constexpr int LDS_BYTES = 147456;
constexpr int NWAVES = 8, NTHREADS = 512;

#define LAS __attribute__((address_space(3)))
typedef unsigned short bf16;
typedef float f32x4 __attribute__((ext_vector_type(4)));
typedef float f32x16 __attribute__((ext_vector_type(16)));
typedef unsigned u32x4 __attribute__((ext_vector_type(4)));
typedef unsigned u32x2 __attribute__((ext_vector_type(2)));
typedef short bf16x8 __attribute__((ext_vector_type(8)));

__device__ __forceinline__ float bf2f(unsigned short u) { return __builtin_bit_cast(float, (unsigned)u << 16); }
__device__ __forceinline__ float bflo(unsigned u) { return __builtin_bit_cast(float, u << 16); }
__device__ __forceinline__ float bfhi(unsigned u) { return __builtin_bit_cast(float, u & 0xffff0000u); }
typedef float f32x2_t_ __attribute__((ext_vector_type(2))); typedef __bf16 bf16x2_t_ __attribute__((ext_vector_type(2)));
__device__ __forceinline__ unsigned pk2(float lo, float hi) { const f32x2_t_ v = {lo, hi}; return __builtin_bit_cast(unsigned, __builtin_convertvector(v, bf16x2_t_)); }
__device__ __forceinline__ unsigned f2bf(float f) { return pk2(f, f) & 0xffffu; }
__device__ __forceinline__ float sigmoidf_(float x) { return __builtin_amdgcn_rcpf(1.0f + __builtin_amdgcn_exp2f(-1.4426950408889634f * x)); }
__device__ __forceinline__ float siluf_(float x) { return x * __builtin_amdgcn_rcpf(1.0f + __builtin_amdgcn_exp2f(-1.4426950408889634f * x)); }
__device__ __forceinline__ float wave_sum(float v) {
#pragma unroll
    for (int o = 1; o < 64; o <<= 1) v += __shfl_xor(v, o);
    return v;
}

struct Params {
    const float* in[20];
    float* out; unsigned char* ws;
};
typedef const __attribute__((address_space(4))) Params* PP;

__device__ __forceinline__ int next_unit(unsigned* ctr, volatile LAS unsigned* slot, int tid) {
    __syncthreads();
    if (tid == 0) *slot = __hip_atomic_fetch_add(ctr, 1u, __ATOMIC_RELAXED, __HIP_MEMORY_SCOPE_AGENT);
    __syncthreads();
    return (int)*slot;
}
__device__ __forceinline__ int q_first(unsigned* ctr, volatile LAS unsigned* slot, int tid, unsigned& pend) {
    unsigned cur = 0u;
    if (tid == 0) { cur = __hip_atomic_fetch_add(ctr, 1u, __ATOMIC_RELAXED, __HIP_MEMORY_SCOPE_AGENT); *slot = cur; pend = __hip_atomic_fetch_add(ctr, 1u, __ATOMIC_RELAXED, __HIP_MEMORY_SCOPE_AGENT); }
    __syncthreads();
    return (int)*slot;
}
__device__ __forceinline__ int q_next(unsigned* ctr, volatile LAS unsigned* slot, int tid, unsigned& pend) {
    __syncthreads();
    if (tid == 0) { *slot = pend; pend = __hip_atomic_fetch_add(ctr, 1u, __ATOMIC_RELAXED, __HIP_MEMORY_SCOPE_AGENT); }
    __syncthreads();
    return (int)*slot;
}

__device__ __forceinline__ void transpose_item(const float* W, int K, int N, bf16* WT, LAS float* scr, int item, int lane) {
    const int nblk = N / 32, kb = item / nblk, nb = item % nblk, k0 = 64 * kb, n0 = 32 * nb;
    float wv[32];
    const float* wp = W + (size_t)(k0 + (lane >> 5)) * N + n0 + (lane & 31);
#pragma unroll
    for (int i = 0; i < 32; ++i) wv[i] = wp[(size_t)(2 * i) * N];
    __builtin_amdgcn_sched_barrier(0);
#pragma unroll
    for (int i = 0; i < 32; ++i) { const int kk = 2 * i + (lane >> 5); scr[kk * 33 + (lane & 31)] = wv[i]; }
    asm volatile("s_waitcnt lgkmcnt(0)" ::: "memory");
    const int c = lane & 7;
#pragma unroll
    for (int j = 0; j < 4; ++j) { const int n = (lane >> 3) + 8 * j; const LAS float* s = scr + (8 * c) * 33 + n;
        u32x4 o; o.x = pk2(s[0 * 33], s[1 * 33]); o.y = pk2(s[2 * 33], s[3 * 33]); o.z = pk2(s[4 * 33], s[5 * 33]); o.w = pk2(s[6 * 33], s[7 * 33]);
        *(u32x4*)(WT + (size_t)(n0 + n) * K + k0 + 8 * c) = o; }
    asm volatile("s_waitcnt lgkmcnt(0)" ::: "memory");
}

__device__ __forceinline__ void mod_unit(PP P, LAS float* lds, int l, int nc, int tid) {
    const float* c = P->in[5]; const float* cctx = P->in[6]; const float* aw = P->in[7] + (size_t)l * 2048 * 6144; const float* ab = P->in[8] + l * 6144;
    LAS float* sc = lds;
    LAS float* red = lds + 3 * 2048;
    for (int i = tid; i < 3 * 2048; i += NTHREADS) { const int j = i >> 11, k = i & 2047; const float v = (j == 0) ? cctx[k] : c[(j - 1) * 2048 + k]; sc[i] = siluf_(v); }
    __syncthreads();
    const int tn = tid & 7, tk = tid >> 3, n0 = nc * 32 + 4 * tn;
    float a[3][4] = {};
    for (int k8 = 0; k8 < 32; k8 += 16) {
        f32x4 w[16];
#pragma unroll
        for (int kk = 0; kk < 16; ++kk) w[kk] = *(const f32x4*)(aw + (size_t)(tk * 32 + k8 + kk) * 6144 + n0);
        __builtin_amdgcn_sched_barrier(0);
#pragma unroll
        for (int kk = 0; kk < 16; ++kk) { const int k = tk * 32 + k8 + kk;
#pragma unroll
            for (int j = 0; j < 3; ++j) { const float s = sc[j * 2048 + k]; a[j][0] += s * w[kk][0]; a[j][1] += s * w[kk][1]; a[j][2] += s * w[kk][2]; a[j][3] += s * w[kk][3]; } }
    }
#pragma unroll
    for (int j = 0; j < 3; ++j)
#pragma unroll
        for (int e = 0; e < 4; ++e) red[(tk * 8 + tn) * 12 + j * 4 + e] = a[j][e];
    __syncthreads();
    if (tid < 96) { const int tn2 = tid / 12, je = tid % 12; float s = 0.f; for (int t = 0; t < 64; ++t) s += red[(t * 8 + tn2) * 12 + je];
        const int j = je >> 2, e = je & 3, n = nc * 32 + 4 * tn2 + e;
        ((float*)(P->ws + WS_MOD))[(l * 3 + j) * 6144 + n] = s + ab[n]; }
    __syncthreads();
}

__device__ __forceinline__ void hprep_row(const float* xrow, const float* mod  , bf16* hrow, int lane) {
#pragma unroll
    for (int j = 0; j < 8; ++j) { const int c = 4 * lane + 256 * j; const f32x4 x = *(const f32x4*)(xrow + c), sh = *(const f32x4*)(mod + c), sc = *(const f32x4*)(mod + 2048 + c);
        const f32x4 h = x * (sc + 1.0f) + sh; u32x2 o; o.x = pk2(h[0], h[1]); o.y = pk2(h[2], h[3]); *(u32x2*)(hrow + c) = o; }
}
__device__ __forceinline__ void ln_row(float* vrow, const float* w, const float* b, const float* modn, bf16* hrow, int lane) {
    f32x4 v[8]; float s = 0.f;
#pragma unroll
    for (int j = 0; j < 8; ++j) { v[j] = *(const f32x4*)(vrow + 4 * lane + 256 * j); s += (v[j][0] + v[j][1]) + (v[j][2] + v[j][3]); }
    const float mean = wave_sum(s) * (1.0f / 2048.0f); float q = 0.f;
#pragma unroll
    for (int j = 0; j < 8; ++j) { v[j] = v[j] - mean; q += (v[j][0] * v[j][0] + v[j][1] * v[j][1]) + (v[j][2] * v[j][2] + v[j][3] * v[j][3]); }
    const float rstd = __builtin_amdgcn_rsqf(wave_sum(q) * (1.0f / 2048.0f) + 1e-5f);
#pragma unroll
    for (int j = 0; j < 8; ++j) { const int c = 4 * lane + 256 * j; const f32x4 y = v[j] * rstd * *(const f32x4*)(w + c) + *(const f32x4*)(b + c);
        *(f32x4*)(vrow + c) = y;
        if (hrow) { const f32x4 sh = *(const f32x4*)(modn + c), sc = *(const f32x4*)(modn + 2048 + c); const f32x4 h = y * (sc + 1.0f) + sh;
            u32x2 o; o.x = pk2(h[0], h[1]); o.y = pk2(h[2], h[3]); *(u32x2*)(hrow + c) = o; } }
}

__device__ __forceinline__ void conv_unit(PP P, LAS float* lds, int l, int unit, int tid) {
    const int lane = tid & 63, wave = tid >> 6;
    const bf16* Z = (const bf16*)(P->ws + WS_Z); bf16* MIX = (bf16*)(P->ws + WS_H);
    const int t0 = unit * 16;
    int s0, s1; if (t0 < NCTX) { s0 = t0 & ~255; s1 = s0 + 256; } else { s0 = NCTX + ((t0 - NCTX) & ~2047); s1 = s0 + 2048; }
    const int c = tid;
    float u[46];
    unsigned short ra[46], rb[46];
#pragma unroll
    for (int r = 0; r < 46; ++r) { const int row = t0 - 15 + r; const int rc = row < s0 ? s0 : (row >= s1 ? s1 - 1 : row);
        ra[r] = Z[(size_t)rc * DIN + C_CA + c]; rb[r] = Z[(size_t)rc * DIN + C_CB + c]; }
    __builtin_amdgcn_sched_barrier(0);
#pragma unroll
    for (int r = 0; r < 46; ++r) { const int row = t0 - 15 + r; const float val = bf2f(ra[r]) * sigmoidf_(bf2f(rb[r])); u[r] = (row >= s0 && row < s1) ? val : 0.f; }
    float acc[16]; const float bias = P->in[15][l * 512 + c];
#pragma unroll
    for (int i = 0; i < 16; ++i) acc[i] = bias;
    const float* cw = P->in[14] + (size_t)l * 31 * 512 + c;
#pragma unroll
    for (int j = 0; j < 31; ++j) { const float w = cw[j * 512];
#pragma unroll
        for (int i = 0; i < 16; ++i) acc[i] += u[i + j] * w; }
    LAS float* yb = lds;
#pragma unroll
    for (int i = 0; i < 16; ++i) yb[i * 512 + c] = acc[i];
    __syncthreads();
    const float* lw = P->in[16] + l * 512; const float* lb = P->in[17] + l * 512;
#pragma unroll
    for (int tt = 0; tt < 2; ++tt) { const int ti = wave * 2 + tt, row = t0 + ti;
        f32x4 a = *(const LAS f32x4*)(yb + ti * 512 + 8 * lane), b = *(const LAS f32x4*)(yb + ti * 512 + 8 * lane + 4);
        float s = (a[0] + a[1]) + (a[2] + a[3]) + (b[0] + b[1]) + (b[2] + b[3]);
        const float mean = wave_sum(s) * (1.0f / 512.0f); a = a - mean; b = b - mean;
        float q = (a[0] * a[0] + a[1] * a[1]) + (a[2] * a[2] + a[3] * a[3]) + (b[0] * b[0] + b[1] * b[1]) + (b[2] * b[2] + b[3] * b[3]);
        const float rstd = __builtin_amdgcn_rsqf(wave_sum(q) * (1.0f / 512.0f) + 1e-5f);
        const f32x4 w0 = *(const f32x4*)(lw + 8 * lane), w1 = *(const f32x4*)(lw + 8 * lane + 4), b0 = *(const f32x4*)(lb + 8 * lane), b1 = *(const f32x4*)(lb + 8 * lane + 4);
        a = a * rstd * w0 + b0; b = b * rstd * w1 + b1;
        const u32x4 g = *(const u32x4*)(Z + (size_t)row * DIN + C_CG + 8 * lane);
        float o[8];
        o[0] = siluf_(a[0]) * siluf_(bflo(g.x)); o[1] = siluf_(a[1]) * siluf_(bfhi(g.x)); o[2] = siluf_(a[2]) * siluf_(bflo(g.y)); o[3] = siluf_(a[3]) * siluf_(bfhi(g.y));
        o[4] = siluf_(b[0]) * siluf_(bflo(g.z)); o[5] = siluf_(b[1]) * siluf_(bfhi(g.z)); o[6] = siluf_(b[2]) * siluf_(bflo(g.w)); o[7] = siluf_(b[3]) * siluf_(bfhi(g.w));
        u32x4 w; w.x = pk2(o[0], o[1]); w.y = pk2(o[2], o[3]); w.z = pk2(o[4], o[5]); w.w = pk2(o[6], o[7]);
        *(u32x4*)(MIX + (size_t)row * D_MODEL + 1536 + 8 * lane) = w; }
}

typedef short v4i16_t __attribute__((ext_vector_type(4)));
#define SBAR __builtin_amdgcn_sched_barrier(0);
#define R0(i) (((i) & 3) + 8 * ((i) >> 2))
constexpr float ATT_C2 = 0.08838834764831845f * 1.4426950408889634f;
constexpr float LOG2E = 1.4426950408889634f;
constexpr int KROW = 272, VROW = 320, ATT_V_OFF = 64 * KROW;

__device__ __forceinline__ bf16x8 trpair(const LAS unsigned char* p, int second_off) {
    const v4i16_t lo = __builtin_amdgcn_ds_read_tr16_b64_v4i16((LAS v4i16_t*)p), hi = __builtin_amdgcn_ds_read_tr16_b64_v4i16((LAS v4i16_t*)(p + second_off));
    return (bf16x8){lo[0], lo[1], lo[2], lo[3], hi[0], hi[1], hi[2], hi[3]};
}
__device__ __forceinline__ bf16x8 pack8(float a, float b, float c, float d, float e, float f, float g, float h) {
    const u32x4 w = {pk2(a, b), pk2(c, d), pk2(e, f), pk2(g, h)}; return __builtin_bit_cast(bf16x8, w);
}
__device__ __forceinline__ void rope8(bf16x8& a, bf16x8& b, const float* cs) {
    float ra[8], rb[8];
#pragma unroll
    for (int j = 0; j < 8; ++j) { const float x1 = bf2f((unsigned short)a[j]), x2 = bf2f((unsigned short)b[j]), c = cs[2 * j], s = cs[2 * j + 1]; ra[j] = x1 * c - x2 * s; rb[j] = x2 * c + x1 * s; }
    a = pack8(ra[0], ra[1], ra[2], ra[3], ra[4], ra[5], ra[6], ra[7]); b = pack8(rb[0], rb[1], rb[2], rb[3], rb[4], rb[5], rb[6], rb[7]);
}
__device__ __forceinline__ void rope8l(bf16x8& a, bf16x8& b, const LAS float* cs) {
    const f32x4 c0 = *(const LAS f32x4*)cs, c1 = *(const LAS f32x4*)(cs + 4), c2 = *(const LAS f32x4*)(cs + 8), c3 = *(const LAS f32x4*)(cs + 12);
    const float cc[8] = {c0[0], c0[2], c1[0], c1[2], c2[0], c2[2], c3[0], c3[2]}, sn[8] = {c0[1], c0[3], c1[1], c1[3], c2[1], c2[3], c3[1], c3[3]};
    float ra[8], rb[8];
#pragma unroll
    for (int j = 0; j < 8; ++j) { const float x1 = bf2f((unsigned short)a[j]), x2 = bf2f((unsigned short)b[j]); ra[j] = x1 * cc[j] - x2 * sn[j]; rb[j] = x2 * cc[j] + x1 * sn[j]; }
    a = pack8(ra[0], ra[1], ra[2], ra[3], ra[4], ra[5], ra[6], ra[7]); b = pack8(rb[0], rb[1], rb[2], rb[3], rb[4], rb[5], rb[6], rb[7]);
}
__device__ __forceinline__ bf16x8 cvt8(const float* p) {
    const f32x4 a = *(const f32x4*)p, b = *(const f32x4*)(p + 4);
    return pack8(a[0], a[1], a[2], a[3], b[0], b[1], b[2], b[3]);
}

__device__ __forceinline__ void attn_unit(PP P, LAS unsigned char* lds, int l, int kind, int idx, int tid) {
    const int lane = tid & 63, wave = __builtin_amdgcn_readfirstlane(tid >> 6), r32 = lane & 31, hh = lane >> 5;
    const bf16* Z = (const bf16*)(P->ws + WS_Z); bf16* MIX = (bf16*)(P->ws + WS_H); const float* CS = (const float*)(P->ws + WS_CS);
    int b, h, qpos0, grow0, kpos0, klrow0, nloc, ncache;
    if (kind == 0) { b = idx >> 3; h = idx & 7; qpos0 = 0; grow0 = b * 256; kpos0 = 0; klrow0 = b * 256; nloc = 4; ncache = 0; }
    else { const int qb = idx & 7; h = (idx >> 3) & 7; b = idx >> 6; qpos0 = qb * 256; grow0 = NCTX + b * 2048 + qpos0;
        kpos0 = qpos0 - 128 < 0 ? 0 : qpos0 - 128; const int kend = qpos0 + 384 > 2048 ? 2048 : qpos0 + 384; nloc = (kend - kpos0) >> 6; klrow0 = NCTX + b * 2048 + kpos0; ncache = 4; }
    const bool lat = (kind == 1);
    const int kv = h >> 2;
    LAS float* CSL = (LAS float*)(lds + 65536);
    if (lat) {
#pragma unroll
        for (int k = 0; k < 2; ++k) *(LAS f32x4*)(CSL + 4 * (tid + 512 * k)) = *(const f32x4*)(CS + 4 * (tid + 512 * k));
        __syncthreads();
    }
    const int qrow = grow0 + 32 * wave + r32, qpos = qpos0 + 32 * wave + r32, qw0 = qpos0 + 32 * wave;
    bf16x8 qf[8];
    { const bf16* qp = Z + (size_t)qrow * DIN + C_AQ + h * 128 + 8 * hh;
#pragma unroll
      for (int s = 0; s < 8; ++s) qf[s] = *(const bf16x8*)(qp + 16 * s);
      if (lat) { const float* c0 = CS + ((qpos >> 6) * 32 + 8 * hh) * 2; const float* c1 = CS + ((qpos & 63) * 32 + 8 * hh) * 2;
          rope8(qf[0], qf[2], c0); rope8(qf[1], qf[3], c0 + 32); rope8(qf[4], qf[6], c1); rope8(qf[5], qf[7], c1 + 32); } }
    f32x16 O[4];
#pragma unroll
    for (int d = 0; d < 4; ++d)
#pragma unroll
        for (int i = 0; i < 16; ++i) O[d][i] = 0.f;
    float m = P->in[11][l * 8 + h] * LOG2E, lsum = (hh == 0) ? 1.0f : 0.0f;
    const int skey = tid >> 3, cp = tid & 7, c1 = (cp >> 2) * 8 + (cp & 3), sd0 = 8 * c1;
    const int ntiles = nloc + ncache;
    u32x4 rr[8];
#define ATT_ISSUE(TI) do { const int ti_ = (TI); \
        if (ti_ < nloc) { const int krow = klrow0 + 64 * ti_ + skey; const bf16* kp_ = Z + (size_t)krow * DIN + C_AK + kv * 128 + sd0; const bf16* vp_ = Z + (size_t)krow * DIN + C_AV + kv * 128 + sd0; \
            rr[0] = *(const u32x4*)kp_; rr[1] = *(const u32x4*)(kp_ + 32); rr[2] = *(const u32x4*)vp_; rr[3] = *(const u32x4*)(vp_ + 32); } \
        else { const int key = 64 * (ti_ - nloc) + skey; const size_t off = ((size_t)((b * 2 + l) * 256 + key) * 2 + kv) * 128 + sd0; const float* ck_ = P->in[2] + off; const float* cv_ = P->in[3] + off; \
            rr[0] = *(const u32x4*)ck_; rr[1] = *(const u32x4*)(ck_ + 4); rr[2] = *(const u32x4*)(ck_ + 32); rr[3] = *(const u32x4*)(ck_ + 36); \
            rr[4] = *(const u32x4*)cv_; rr[5] = *(const u32x4*)(cv_ + 4); rr[6] = *(const u32x4*)(cv_ + 32); rr[7] = *(const u32x4*)(cv_ + 36); } } while (0)
#define F4(x) __builtin_bit_cast(f32x4, x)
#define CV8(a, b) pack8(F4(a)[0], F4(a)[1], F4(a)[2], F4(a)[3], F4(b)[0], F4(b)[1], F4(b)[2], F4(b)[3])
    ATT_ISSUE(0);
    for (int ti = 0; ti < ntiles; ++ti) {
        {
            bf16x8 k1, k2, v1, v2;
            if (ti < nloc) { k1 = __builtin_bit_cast(bf16x8, rr[0]); k2 = __builtin_bit_cast(bf16x8, rr[1]); v1 = __builtin_bit_cast(bf16x8, rr[2]); v2 = __builtin_bit_cast(bf16x8, rr[3]);
                if (lat) { const int kpos = kpos0 + 64 * ti + skey; const int pos = (cp < 4) ? (kpos >> 6) : (kpos & 63); rope8l(k1, k2, CSL + (pos * 32 + 8 * (cp & 3)) * 2); } }
            else { k1 = CV8(rr[0], rr[1]); k2 = CV8(rr[2], rr[3]); v1 = CV8(rr[4], rr[5]); v2 = CV8(rr[6], rr[7]); }
            *(LAS bf16x8*)(lds + skey * KROW + sd0 * 2) = k1; *(LAS bf16x8*)(lds + skey * KROW + sd0 * 2 + 64) = k2;
            *(LAS bf16x8*)(lds + ATT_V_OFF + skey * VROW + sd0 * 2) = v1; *(LAS bf16x8*)(lds + ATT_V_OFF + skey * VROW + sd0 * 2 + 64) = v2;
        }
        __syncthreads();
        if (ti + 1 < ntiles) ATT_ISSUE(ti + 1);
        const bool local = lat && (ti < nloc);
        const int tk0 = kpos0 + 64 * ti;
        bool skip = false;
        if (local) skip = (tk0 > qw0 + 31 + 128) || (tk0 + 63 < qw0 - 128);
        if (!skip) {
            f32x16 p0, p1;
#pragma unroll
            for (int i = 0; i < 16; ++i) { p0[i] = 0.f; p1[i] = 0.f; }
            const LAS unsigned char* kb = lds + r32 * KROW + 16 * hh;
#pragma unroll
            for (int s = 0; s < 8; ++s) { const bf16x8 kf0 = *(const LAS bf16x8*)(kb + 32 * s), kf1 = *(const LAS bf16x8*)(kb + 32 * KROW + 32 * s);
                p0 = __builtin_amdgcn_mfma_f32_32x32x16_bf16(kf0, qf[s], p0, 0, 0, 0); p1 = __builtin_amdgcn_mfma_f32_32x32x16_bf16(kf1, qf[s], p1, 0, 0, 0); }
            const int i16 = lane & 15;
            const LAS unsigned char* vb = lds + ATT_V_OFF + (4 * hh + (i16 >> 2)) * VROW + (16 * ((lane >> 4) & 1) + 4 * (i16 & 3)) * 2;
            bf16x8 vfa[4], vfb[4];
#pragma unroll
            for (int ks = 0; ks < 4; ++ks) vfa[ks] = trpair(vb + (16 * ks) * VROW, 8 * VROW);
            float mx = -1e30f;
#pragma unroll
            for (int i = 0; i < 16; ++i) { float a = p0[i] * ATT_C2, c = p1[i] * ATT_C2;
                if (local) { const int kp = tk0 + R0(i) + 4 * hh; const int d0 = qpos - kp, d1 = qpos - kp - 32;
                    if (d0 > 128 || d0 < -128) a = -1e30f; if (d1 > 128 || d1 < -128) c = -1e30f; }
                p0[i] = a; p1[i] = c; mx = fmaxf(mx, fmaxf(a, c)); }
            mx = fmaxf(mx, __shfl_xor(mx, 32));
            const float mn = fmaxf(m, mx), alpha = __builtin_amdgcn_exp2f(m - mn); m = mn;
            float ps = 0.f;
#pragma unroll
            for (int i = 0; i < 16; ++i) { p0[i] = __builtin_amdgcn_exp2f(p0[i] - mn); p1[i] = __builtin_amdgcn_exp2f(p1[i] - mn); ps += p0[i] + p1[i]; }
            lsum = lsum * alpha + ps;
#pragma unroll
            for (int d = 0; d < 4; ++d)
#pragma unroll
                for (int i = 0; i < 16; ++i) O[d][i] *= alpha;
            bf16x8 pb[4];
#pragma unroll
            for (int s = 0; s < 2; ++s) { pb[s] = pack8(p0[8 * s], p0[8 * s + 1], p0[8 * s + 2], p0[8 * s + 3], p0[8 * s + 4], p0[8 * s + 5], p0[8 * s + 6], p0[8 * s + 7]);
                pb[2 + s] = pack8(p1[8 * s], p1[8 * s + 1], p1[8 * s + 2], p1[8 * s + 3], p1[8 * s + 4], p1[8 * s + 5], p1[8 * s + 6], p1[8 * s + 7]); }
#pragma unroll
            for (int dt = 0; dt < 4; ++dt) {
                if (dt + 1 < 4) {
#pragma unroll
                    for (int ks = 0; ks < 4; ++ks) { const bf16x8 t_ = trpair(vb + (16 * ks) * VROW + 64 * (dt + 1), 8 * VROW); if (dt & 1) vfa[ks] = t_; else vfb[ks] = t_; }
                }
#pragma unroll
                for (int ks = 0; ks < 4; ++ks) O[dt] = __builtin_amdgcn_mfma_f32_32x32x16_bf16((dt & 1) ? vfb[ks] : vfa[ks], pb[ks], O[dt], 0, 0, 0);
            }
        }
        __syncthreads();
    }
    const float ltot = lsum + __shfl_xor(lsum, 32), inv = __builtin_amdgcn_rcpf(ltot);
    const bf16* gp = Z + (size_t)qrow * DIN + C_AG + h * 128 + 4 * hh; bf16* op = MIX + (size_t)qrow * D_MODEL + h * 128 + 4 * hh;
    u32x2 gg[16];
#pragma unroll
    for (int e = 0; e < 16; ++e) gg[e] = *(const u32x2*)(gp + 32 * (e >> 2) + 8 * (e & 3));
    __builtin_amdgcn_sched_barrier(0);
#pragma unroll
    for (int dt = 0; dt < 4; ++dt)
#pragma unroll
        for (int i4 = 0; i4 < 4; ++i4) { const int d0 = 32 * dt + 8 * i4; const u32x2 g = gg[dt * 4 + i4];
            const float o0 = O[dt][4 * i4 + 0] * inv * siluf_(bflo(g.x)), o1 = O[dt][4 * i4 + 1] * inv * siluf_(bfhi(g.x));
            const float o2 = O[dt][4 * i4 + 2] * inv * siluf_(bflo(g.y)), o3 = O[dt][4 * i4 + 3] * inv * siluf_(bfhi(g.y));
            u32x2 w; w.x = pk2(o0, o1); w.y = pk2(o2, o3); *(u32x2*)(op + d0) = w; }
#undef ATT_ISSUE
#undef F4
#undef CV8
}

__device__ __forceinline__ void hg_oml8(PP P, int l, int dir, int hd0, float (&oml)[8]) {
    const float* hb = P->in[12] + dir * 1024 + hd0;
    const f32x4 a0 = *(const f32x4*)hb, a1 = *(const f32x4*)(hb + 4), b0 = *(const f32x4*)(hb + 512), b1 = *(const f32x4*)(hb + 516);
#pragma unroll
    for (int j = 0; j < 4; ++j) { const float s0 = sigmoidf_(b0[j] - a0[j]), s1 = sigmoidf_(b1[j] - a1[j]); oml[j] = l ? 1.0f - s0 : 1.0f; oml[4 + j] = l ? 1.0f - s1 : 1.0f; }
}
constexpr int H2_TG = 0, H2_QE = 16896, H2_KE = 25600, H2_QG = 34304, H2_KG = 42752, H2_V = 52992, H2_OBA = 63232, H2_OBB = 80128, H2_DK = 97024;
constexpr size_t WS_DLC_OFF = 0;
__device__ __forceinline__ void hgrn2_unit(PP P, LAS unsigned char* lds, int l, int kind, int idx, int tid) {
    const int lane = tid & 63, wave = __builtin_amdgcn_readfirstlane(tid >> 6), r32 = lane & 31, hh = lane >> 5, i16 = lane & 15, cg = (lane >> 4) & 1;
    const bf16* Z = (const bf16*)(P->ws + WS_Z); bf16* MIX = (bf16*)(P->ws + WS_H); float* OL = (float*)(P->ws + WS_OL);
    LAS float* ldsf = (LAS float*)lds;
    int h, row0, seglen, nch, b = 0;
    if (kind == 0) { b = idx >> 2; h = idx & 3; row0 = b * 256; seglen = 256; nch = 8; }
    else { const int blk = idx & 15; h = (idx >> 4) & 3; const int lb = idx >> 6; row0 = NCTX + lb * 2048 + blk * 128; seglen = 128; nch = 4; }
    const int ti = tid >> 4, d0 = 8 * (tid & 15), nt = wave & 3, kp = wave >> 2;
    const f32x4 n0 = *(const f32x4*)(P->in[13] + l * 512 + h * 128 + d0), n1 = *(const f32x4*)(P->in[13] + l * 512 + h * 128 + d0 + 4);
    for (int dir = 0; dir < 2; ++dir) {
        float oml[8]; hg_oml8(P, l, dir, h * 128 + d0, oml);
        const int cf = dir ? C_HFB : C_HFF;
        f32x16 S0, S1;
#pragma unroll
        for (int i = 0; i < 16; ++i) { S0[i] = 0.f; S1[i] = 0.f; }
        const int uidx = (kind == 1) ? ((idx >> 4) * 2 + dir) * 16 + (idx & 15) : 0;
        u32x4 uq, uv, uf;
        { const int row = dir ? row0 + seglen - 1 - ti : row0 + ti; const bf16* zr = Z + (size_t)row * DIN + h * 128 + d0;
          uq = *(const u32x4*)(zr + C_HQ); uv = *(const u32x4*)(zr + C_HI); uf = *(const u32x4*)(zr + cf); }
        for (int c = 0; c < nch; ++c) {
            const int nc = dir ? nch - 1 - c : c; const int rown = row0 + 32 * nc + ti;
            f32x4 olp0 = {0.f, 0.f, 0.f, 0.f}, olp1 = {0.f, 0.f, 0.f, 0.f}; u32x4 ug = {0u, 0u, 0u, 0u};
            float* olr = OL + (size_t)rown * 512 + h * 128 + d0;
            if (dir == 1) { olp0 = *(const f32x4*)olr; olp1 = *(const f32x4*)(olr + 4); if (kind == 0) ug = *(const u32x4*)(Z + (size_t)rown * DIN + C_HG + h * 128 + d0); }
            float q[8], kk[8];
            {
                float g2[8], vv[8];
#pragma unroll
                for (int j = 0; j < 4; ++j) { const unsigned wq = uq[j], wv = uv[j], wf = uf[j];
                    q[2 * j] = siluf_(bflo(wq)) * 0.08838834764831845f; q[2 * j + 1] = siluf_(bfhi(wq)) * 0.08838834764831845f;
                    vv[2 * j] = bflo(wv); vv[2 * j + 1] = bfhi(wv);
                    kk[2 * j] = oml[2 * j] * sigmoidf_(-bflo(wf)); kk[2 * j + 1] = oml[2 * j + 1] * sigmoidf_(-bfhi(wf)); }
#pragma unroll
                for (int j = 0; j < 8; ++j) g2[j] = __builtin_amdgcn_logf(1.0f - fminf(kk[j], 1.0f - 1e-6f));
                LAS float* pg = ldsf + (H2_TG >> 2) + ti * 132 + d0;
                *(LAS f32x4*)pg = (f32x4){g2[0], g2[1], g2[2], g2[3]}; *(LAS f32x4*)(pg + 4) = (f32x4){g2[4], g2[5], g2[6], g2[7]};
                *(LAS u32x4*)(lds + H2_V + ti * 320 + d0 * 2) = uv;
            }
            if (c + 1 < nch) { const int tl = 32 * (c + 1) + ti; const int row = dir ? row0 + seglen - 1 - tl : row0 + tl; const bf16* zr = Z + (size_t)row * DIN + h * 128 + d0;
                uq = *(const u32x4*)(zr + C_HQ); uv = *(const u32x4*)(zr + C_HI); uf = *(const u32x4*)(zr + cf); }
            __syncthreads();
            if (tid < 128) {
                LAS float* gc = ldsf + (H2_TG >> 2) + tid; float run = 0.f; float gv[32];
#pragma unroll
                for (int i = 0; i < 32; ++i) gv[i] = gc[i * 132];
                SBAR
#pragma unroll
                for (int i = 0; i < 32; ++i) { run += gv[i]; gc[i * 132] = run; }
                ldsf[(H2_DK >> 2) + tid] = __builtin_amdgcn_exp2f(run);
                if (kind == 1) ((float*)(P->ws + WS_DLOG))[(uidx * 4 + c) * 128 + tid] = run;
            }
            __syncthreads();
            {
                const LAS float* gr = ldsf + (H2_TG >> 2) + ti * 132 + d0; const LAS float* gm = ldsf + (H2_TG >> 2) + 15 * 132 + d0; const LAS float* gl = ldsf + (H2_TG >> 2) + 31 * 132 + d0;
                float qe[8], ke[8], qg[8], kg[8];
#pragma unroll
                for (int j = 0; j < 8; ++j) { const float G = gr[j], Gm = gm[j], Gl = gl[j];
                    qe[j] = q[j] * __builtin_amdgcn_exp2f(fminf(G - Gm, 100.f)); ke[j] = kk[j] * __builtin_amdgcn_exp2f(fminf(Gm - G, 100.f));
                    qg[j] = q[j] * __builtin_amdgcn_exp2f(G); kg[j] = kk[j] * __builtin_amdgcn_exp2f(Gl - G); }
                *(LAS bf16x8*)(lds + H2_QE + ti * 272 + d0 * 2) = pack8(qe[0], qe[1], qe[2], qe[3], qe[4], qe[5], qe[6], qe[7]);
                *(LAS bf16x8*)(lds + H2_KE + ti * 272 + d0 * 2) = pack8(ke[0], ke[1], ke[2], ke[3], ke[4], ke[5], ke[6], ke[7]);
                *(LAS bf16x8*)(lds + H2_KG + ti * 320 + d0 * 2) = pack8(kg[0], kg[1], kg[2], kg[3], kg[4], kg[5], kg[6], kg[7]);
                u32x2 w0, w1; w0.x = pk2(qg[0], qg[1]); w0.y = pk2(qg[2], qg[3]); w1.x = pk2(qg[4], qg[5]); w1.y = pk2(qg[6], qg[7]);
                *(LAS u32x2*)(lds + H2_QG + ti * 264 + d0 * 2) = w0; *(LAS u32x2*)(lds + H2_QG + ti * 264 + d0 * 2 + 8) = w1;
            }
            __syncthreads();
            {
                f32x16 at;
#pragma unroll
                for (int i = 0; i < 16; ++i) at[i] = 0.f;
                const LAS unsigned char* kep = lds + H2_KE + r32 * 272 + 16 * hh; const LAS unsigned char* qep = lds + H2_QE + r32 * 272 + 16 * hh;
#pragma unroll
                for (int k = 0; k < 8; ++k) at = __builtin_amdgcn_mfma_f32_32x32x16_bf16(*(const LAS bf16x8*)(kep + 32 * k), *(const LAS bf16x8*)(qep + 32 * k), at, 0, 0, 0);
                float am[8];
#pragma unroll
                for (int j = 0; j < 8; ++j) { const float lo = at[j], hi = at[8 + j]; const float v = kp ? hi : lo; const int s = 16 * kp + 8 * (j >> 2) + 4 * hh + (j & 3); am[j] = (s <= r32) ? v : 0.f; }
                const bf16x8 afrag = pack8(am[0], am[1], am[2], am[3], am[4], am[5], am[6], am[7]);
                f32x16 ot;
#pragma unroll
                for (int i = 0; i < 16; ++i) ot[i] = 0.f;
                { const bf16x8 vfrag = trpair(lds + H2_V + (16 * kp + 4 * hh + (i16 >> 2)) * 320 + (32 * nt + 16 * cg + 4 * (i16 & 3)) * 2, 8 * 320);
                  ot = __builtin_amdgcn_mfma_f32_32x32x16_bf16(vfrag, afrag, ot, 0, 0, 0); }
                const LAS unsigned char* qgp = lds + H2_QG + r32 * 264 + (64 * kp + 4 * hh) * 2;
#pragma unroll
                for (int kl = 0; kl < 2; ++kl)
#pragma unroll
                    for (int sp = 0; sp < 2; ++sp) {
                        const u32x2 qlo = *(const LAS u32x2*)(qgp + (32 * kl + 16 * sp) * 2), qhi = *(const LAS u32x2*)(qgp + (32 * kl + 16 * sp) * 2 + 16);
                        const u32x4 qq = {qlo.x, qlo.y, qhi.x, qhi.y};
                        bf16x8 sfrag;
                        if (kl == 0) sfrag = pack8(S0[8 * sp], S0[8 * sp + 1], S0[8 * sp + 2], S0[8 * sp + 3], S0[8 * sp + 4], S0[8 * sp + 5], S0[8 * sp + 6], S0[8 * sp + 7]);
                        else sfrag = pack8(S1[8 * sp], S1[8 * sp + 1], S1[8 * sp + 2], S1[8 * sp + 3], S1[8 * sp + 4], S1[8 * sp + 5], S1[8 * sp + 6], S1[8 * sp + 7]);
                        ot = __builtin_amdgcn_mfma_f32_32x32x16_bf16(sfrag, __builtin_bit_cast(bf16x8, qq), ot, 0, 0, 0);
                    }
                { LAS float* ob = ldsf + ((kp ? H2_OBB : H2_OBA) >> 2) + (32 * nt + 4 * hh) * 33 + r32;
#pragma unroll
                  for (int i = 0; i < 16; ++i) ob[R0(i) * 33] = ot[i]; }
                const LAS float* dkp = ldsf + (H2_DK >> 2) + 64 * kp + 4 * hh;
#pragma unroll
                for (int i = 0; i < 16; ++i) { S0[i] *= dkp[R0(i)]; S1[i] *= dkp[32 + R0(i)]; }
#pragma unroll
                for (int ks = 0; ks < 2; ++ks) {
                    const int roff = (16 * ks + 8 * hh + (i16 >> 2)) * 320, coff = (16 * cg + 4 * (i16 & 3)) * 2;
                    const bf16x8 vf = trpair(lds + H2_V + roff + 64 * nt + coff, 4 * 320);
                    const bf16x8 k0 = trpair(lds + H2_KG + roff + 64 * (2 * kp) + coff, 4 * 320), k1 = trpair(lds + H2_KG + roff + 64 * (2 * kp + 1) + coff, 4 * 320);
                    S0 = __builtin_amdgcn_mfma_f32_32x32x16_bf16(k0, vf, S0, 0, 0, 0); S1 = __builtin_amdgcn_mfma_f32_32x32x16_bf16(k1, vf, S1, 0, 0, 0);
                }
            }
            __syncthreads();
            {
                const int t = dir ? 31 - ti : ti;
                const LAS float* oa = ldsf + (H2_OBA >> 2) + d0 * 33 + t; const LAS float* obb = ldsf + (H2_OBB >> 2) + d0 * 33 + t;
                float o[8];
#pragma unroll
                for (int j = 0; j < 8; ++j) o[j] = oa[j * 33] + obb[j * 33];
                if (dir == 1) { o[0] += olp0[0]; o[1] += olp0[1]; o[2] += olp0[2]; o[3] += olp0[3]; o[4] += olp1[0]; o[5] += olp1[1]; o[6] += olp1[2]; o[7] += olp1[3]; }
                if (dir == 0 || kind == 1) { *(f32x4*)olr = (f32x4){o[0], o[1], o[2], o[3]}; *(f32x4*)(olr + 4) = (f32x4){o[4], o[5], o[6], o[7]}; }
                else {
                    float ss = 0.f;
#pragma unroll
                    for (int j = 0; j < 8; ++j) ss += o[j] * o[j];
                    ss += __shfl_xor(ss, 1); ss += __shfl_xor(ss, 2); ss += __shfl_xor(ss, 4); ss += __shfl_xor(ss, 8);
                    const float r = __builtin_amdgcn_rsqf(ss * (1.0f / 128.0f) + 1e-6f);
                    u32x4 w;
                    w.x = pk2(o[0] * r * n0[0] * siluf_(bflo(ug.x)), o[1] * r * n0[1] * siluf_(bfhi(ug.x))); w.y = pk2(o[2] * r * n0[2] * siluf_(bflo(ug.y)), o[3] * r * n0[3] * siluf_(bfhi(ug.y)));
                    w.z = pk2(o[4] * r * n1[0] * siluf_(bflo(ug.z)), o[5] * r * n1[1] * siluf_(bfhi(ug.z))); w.w = pk2(o[6] * r * n1[2] * siluf_(bflo(ug.w)), o[7] * r * n1[3] * siluf_(bfhi(ug.w)));
                    *(u32x4*)(MIX + (size_t)rown * D_MODEL + 1024 + h * 128 + d0) = w;
                }
            }
        }
        {
            float* Sd = (kind == 0) ? P->out + OUT_ST + (size_t)((((b * 2 + l) * 2 + dir) * 4 + h)) * 16384 : (float*)(P->ws + WS_U) + (size_t)uidx * 16384;
            float* sp = Sd + (64 * kp + 4 * hh) * 128 + 32 * nt + r32;
#pragma unroll
            for (int i = 0; i < 16; ++i) { sp[R0(i) * 128] = S0[i]; sp[(32 + R0(i)) * 128] = S1[i]; }
        }
    }
}

__device__ __forceinline__ void hgrn_scan(PP P, int l, int tid) {
    float* U = (float*)(P->ws + WS_U); const float* DLC = (const float*)(P->ws + WS_DLOG);
    for (int e = blockIdx.x * NTHREADS + tid; e < 16 * 16384; e += gridDim.x * NTHREADS) {
        const int sq = e >> 14, el = e & 16383, dk = el >> 7, lb = sq >> 3, h = (sq >> 1) & 3, dir = sq & 1;
        float S = P->in[4][(size_t)((((lb * 2 + l) * 2 + dir) * 4 + h)) * 16384 + el];
        float u[16], dl[16];
#pragma unroll
        for (int p = 0; p < 16; ++p) { const int blk = dir ? 15 - p : p; const int uidx = sq * 16 + blk; u[p] = U[(size_t)uidx * 16384 + el];
            const float* d = DLC + (uidx * 4) * 128 + dk; dl[p] = (d[0] + d[128]) + (d[256] + d[384]); }
#pragma unroll
        for (int p = 0; p < 16; ++p) { const int blk = dir ? 15 - p : p; const int uidx = sq * 16 + blk; U[(size_t)uidx * 16384 + el] = S; S = __builtin_amdgcn_exp2f(dl[p]) * S + u[p]; }
    }
}

constexpr int HF_S0 = 0, HF_S1 = 40960, HF_TG0 = 81920, HF_TG1 = 98816, HF_QG0 = 115712, HF_QG1 = 124416;
__device__ __forceinline__ void hgrn_final_unit(PP P, LAS unsigned char* lds, int l, int idx, int tid) {
    const int lane = tid & 63, wave = __builtin_amdgcn_readfirstlane(tid >> 6), r32 = lane & 31, hh = lane >> 5, i16 = lane & 15, cg = (lane >> 4) & 1;
    const bf16* Z = (const bf16*)(P->ws + WS_Z); bf16* MIX = (bf16*)(P->ws + WS_H); const float* OL = (const float*)(P->ws + WS_OL); const float* DLC = (const float*)(P->ws + WS_DLOG);
    LAS float* ldsf = (LAS float*)lds;
    const int blk = idx & 15, h = (idx >> 4) & 3, lb = idx >> 6, row0 = NCTX + lb * 2048 + blk * 128;
    const int ti = tid >> 4, d0 = 8 * (tid & 15), nt = wave & 3, ds = wave >> 2;
    const int uidx0 = ((idx >> 4) * 2 + 0) * 16 + blk, uidx1 = ((idx >> 4) * 2 + 1) * 16 + blk;
#pragma unroll
    for (int half = 0; half < 2; ++half) {
        f32x4 sv[8];
#pragma unroll
        for (int k = 0; k < 8; ++k) { const int id = tid + 512 * (k + 8 * half), dsel = id >> 12, dk = (id >> 5) & 127, c4 = id & 31;
            sv[k] = *(const f32x4*)((const float*)(P->ws + WS_U) + (size_t)(dsel ? uidx1 : uidx0) * 16384 + dk * 128 + c4 * 4); }
#pragma unroll
        for (int k = 0; k < 8; ++k) { const int id = tid + 512 * (k + 8 * half), dsel = id >> 12, dk = (id >> 5) & 127, c4 = id & 31;
            u32x2 w; w.x = pk2(sv[k][0], sv[k][1]); w.y = pk2(sv[k][2], sv[k][3]); *(LAS u32x2*)(lds + (dsel ? HF_S1 : HF_S0) + dk * 320 + c4 * 8) = w; }
    }
    float oml0[8], oml1[8]; hg_oml8(P, l, 0, h * 128 + d0, oml0); hg_oml8(P, l, 1, h * 128 + d0, oml1);
    const f32x4 n0 = *(const f32x4*)(P->in[13] + l * 512 + h * 128 + d0), n1 = *(const f32x4*)(P->in[13] + l * 512 + h * 128 + d0 + 4);
    float carry = 0.f;
    for (int nc = 0; nc < 4; ++nc) {
        const int rown = row0 + 32 * nc + ti; const bf16* zr = Z + (size_t)rown * DIN + h * 128 + d0;
        const u32x4 uq = *(const u32x4*)(zr + C_HQ), uf0 = *(const u32x4*)(zr + C_HFF), uf1 = *(const u32x4*)(zr + C_HFB), ug = *(const u32x4*)(zr + C_HG);
        const float* olr = OL + (size_t)rown * 512 + h * 128 + d0; const f32x4 olp0 = *(const f32x4*)olr, olp1 = *(const f32x4*)(olr + 4);
        float off1 = 0.f;
        if (tid >= 128 && tid < 256) { for (int c = 0; c < 3 - nc; ++c) off1 += DLC[(uidx1 * 4 + c) * 128 + (tid - 128)]; }
        float q[8];
        {
            float ga[8], gb[8];
#pragma unroll
            for (int j = 0; j < 4; ++j) { const unsigned wq = uq[j], wa = uf0[j], wb = uf1[j];
                q[2 * j] = siluf_(bflo(wq)) * 0.08838834764831845f; q[2 * j + 1] = siluf_(bfhi(wq)) * 0.08838834764831845f;
                ga[2 * j] = oml0[2 * j] * sigmoidf_(-bflo(wa)); ga[2 * j + 1] = oml0[2 * j + 1] * sigmoidf_(-bfhi(wa));
                gb[2 * j] = oml1[2 * j] * sigmoidf_(-bflo(wb)); gb[2 * j + 1] = oml1[2 * j + 1] * sigmoidf_(-bfhi(wb)); }
#pragma unroll
            for (int j = 0; j < 8; ++j) { ga[j] = __builtin_amdgcn_logf(1.0f - fminf(ga[j], 1.0f - 1e-6f)); gb[j] = __builtin_amdgcn_logf(1.0f - fminf(gb[j], 1.0f - 1e-6f)); }
            LAS float* p0 = ldsf + (HF_TG0 >> 2) + ti * 132 + d0; LAS float* p1 = ldsf + (HF_TG1 >> 2) + ti * 132 + d0;
            *(LAS f32x4*)p0 = (f32x4){ga[0], ga[1], ga[2], ga[3]}; *(LAS f32x4*)(p0 + 4) = (f32x4){ga[4], ga[5], ga[6], ga[7]};
            *(LAS f32x4*)p1 = (f32x4){gb[0], gb[1], gb[2], gb[3]}; *(LAS f32x4*)(p1 + 4) = (f32x4){gb[4], gb[5], gb[6], gb[7]};
        }
        __syncthreads();
        if (tid < 256) { const bool rev = tid >= 128; LAS float* gc = ldsf + ((rev ? HF_TG1 : HF_TG0) >> 2) + (tid & 127); float run = rev ? off1 : carry; float gv[32];
#pragma unroll
            for (int i = 0; i < 32; ++i) gv[i] = gc[(rev ? 31 - i : i) * 132];
            SBAR
#pragma unroll
            for (int i = 0; i < 32; ++i) { run += gv[i]; gc[(rev ? 31 - i : i) * 132] = run; }
            if (!rev) carry = run; }
        __syncthreads();
        {
            const LAS float* g0 = ldsf + (HF_TG0 >> 2) + ti * 132 + d0; const LAS float* g1 = ldsf + (HF_TG1 >> 2) + ti * 132 + d0;
            float a[8], c[8];
#pragma unroll
            for (int j = 0; j < 8; ++j) { a[j] = q[j] * __builtin_amdgcn_exp2f(g0[j]); c[j] = q[j] * __builtin_amdgcn_exp2f(g1[j]); }
            *(LAS bf16x8*)(lds + HF_QG0 + ti * 272 + d0 * 2) = pack8(a[0], a[1], a[2], a[3], a[4], a[5], a[6], a[7]);
            *(LAS bf16x8*)(lds + HF_QG1 + ti * 272 + d0 * 2) = pack8(c[0], c[1], c[2], c[3], c[4], c[5], c[6], c[7]);
        }
        __syncthreads();
        {
            f32x16 acc;
#pragma unroll
            for (int i = 0; i < 16; ++i) acc[i] = 0.f;
            const LAS unsigned char* qp = lds + (ds ? HF_QG1 : HF_QG0) + r32 * 272 + 16 * hh;
            const LAS unsigned char* sp = lds + (ds ? HF_S1 : HF_S0) + (8 * hh + (i16 >> 2)) * 320 + (32 * nt + 16 * cg + 4 * (i16 & 3)) * 2;
#pragma unroll
            for (int k = 0; k < 8; ++k) { const bf16x8 sf = trpair(sp + 16 * k * 320, 4 * 320); acc = __builtin_amdgcn_mfma_f32_32x32x16_bf16(*(const LAS bf16x8*)(qp + 32 * k), sf, acc, 0, 0, 0); }
            LAS float* ob = ldsf + ((ds ? HF_TG1 : HF_TG0) >> 2) + (4 * hh) * 132 + 32 * nt + r32;
#pragma unroll
            for (int i = 0; i < 16; ++i) ob[R0(i) * 132] = acc[i];
        }
        __syncthreads();
        {
            const LAS float* oa = ldsf + (HF_TG0 >> 2) + ti * 132 + d0; const LAS float* obb = ldsf + (HF_TG1 >> 2) + ti * 132 + d0;
            const f32x4 a0 = *(const LAS f32x4*)oa, a1 = *(const LAS f32x4*)(oa + 4), b0 = *(const LAS f32x4*)obb, b1 = *(const LAS f32x4*)(obb + 4);
            const f32x4 o0 = a0 + b0 + olp0, o1 = a1 + b1 + olp1;
            float ss = (o0[0] * o0[0] + o0[1] * o0[1]) + (o0[2] * o0[2] + o0[3] * o0[3]) + (o1[0] * o1[0] + o1[1] * o1[1]) + (o1[2] * o1[2] + o1[3] * o1[3]);
            ss += __shfl_xor(ss, 1); ss += __shfl_xor(ss, 2); ss += __shfl_xor(ss, 4); ss += __shfl_xor(ss, 8);
            const float r = __builtin_amdgcn_rsqf(ss * (1.0f / 128.0f) + 1e-6f);
            u32x4 w;
            w.x = pk2(o0[0] * r * n0[0] * siluf_(bflo(ug.x)), o0[1] * r * n0[1] * siluf_(bfhi(ug.x))); w.y = pk2(o0[2] * r * n0[2] * siluf_(bflo(ug.y)), o0[3] * r * n0[3] * siluf_(bfhi(ug.y)));
            w.z = pk2(o1[0] * r * n1[0] * siluf_(bflo(ug.z)), o1[1] * r * n1[1] * siluf_(bfhi(ug.z))); w.w = pk2(o1[2] * r * n1[2] * siluf_(bflo(ug.w)), o1[3] * r * n1[3] * siluf_(bfhi(ug.w)));
            *(u32x4*)(MIX + (size_t)rown * D_MODEL + 1024 + h * 128 + d0) = w;
        }
        __syncthreads();
    }
}

#define RLX_AGENT __ATOMIC_RELAXED, __HIP_MEMORY_SCOPE_AGENT
#define XB_TMO      128
#define XB_XCNT(j)  (256  + 64 * (j))
#define XB_XSUB(j)  (1280 + 64 * (j))
#define XB_XGEN(j)  (2304 + 64 * (j))
#define XB_TOP      3328
#define XB_TOPGEN   3392
#define XCD_BAR_WORDS 3456
#define XB_SPIN_CAP (1u << 18)

__device__ __forceinline__ unsigned xb_ld(unsigned* p)              { return __hip_atomic_load(p, __ATOMIC_RELAXED, __HIP_MEMORY_SCOPE_AGENT); }
__device__ __forceinline__ unsigned xb_add(unsigned* p, unsigned v) { return __hip_atomic_fetch_add(p, v, __ATOMIC_RELAXED, __HIP_MEMORY_SCOPE_AGENT); }
__device__ __forceinline__ unsigned xb_xcc_id() { return (unsigned)__builtin_amdgcn_s_getreg((3 << 11) | 20) & 0xFu; }
#define XB_SPIN(cond, bar) do { unsigned _sp = 0; while (cond) { __builtin_amdgcn_s_sleep(1); \
    if ((++_sp & 255u) == 0u) { if (xb_ld(&(bar)[XB_TMO])) break; if (_sp > XB_SPIN_CAP) { atomicAdd(&(bar)[XB_TMO], 1u); break; } } } } while (0)

struct XcdBarrier {
    unsigned* bar; unsigned x; bool t0;
    volatile LAS unsigned* st;
};

__device__ __forceinline__ XcdBarrier xcd_barrier_post(unsigned* bar, volatile LAS unsigned* st) {
    XcdBarrier b; b.bar = bar; b.x = xb_xcc_id(); b.st = st; b.t0 = (threadIdx.x == 0);
    if (threadIdx.x == 0) (void)xb_add(&bar[XB_XCNT(b.x)], 1u);
    return b;
}
__device__ __forceinline__ void xcd_barrier_complete(unsigned* bar, unsigned x, unsigned& nloc, unsigned& nx) {
    const unsigned G = gridDim.x * gridDim.y * gridDim.z;
    unsigned sum, cnt, mine, sp = 0u;
    for (;;) {
        sum = 0u; cnt = 0u; mine = 0u;
#pragma unroll
        for (unsigned j = 0; j < 16; ++j) { const unsigned c = xb_ld(&bar[XB_XCNT(j)]); sum += c; cnt += (c > 0u) ? 1u : 0u; mine = (j == x) ? c : mine; }
        if (sum == G) break;
        __builtin_amdgcn_s_sleep(1);
        if ((++sp & 255u) == 0u) { if (xb_ld(&bar[XB_TMO])) break; if (sp > XB_SPIN_CAP) { atomicAdd(&bar[XB_TMO], 1u); break; } }
    }
    nloc = mine > 0u ? mine : 1u; nx = cnt > 0u ? cnt : 1u;
}

__device__ __forceinline__ void xcd_barrier(const XcdBarrier& b) {
    asm volatile("s_waitcnt vmcnt(0)" ::: "memory");
    __syncthreads();
    if (b.t0) {
        unsigned* bar = b.bar;
        __builtin_amdgcn_s_waitcnt(0);
        unsigned nloc = b.st[0], nx = b.st[1];
        if (nloc == 0u) { xcd_barrier_complete(bar, b.x, nloc, nx); b.st[0] = nloc; b.st[1] = nx; }
        const unsigned old = xb_add(&bar[XB_XSUB(b.x)], 1u);
        const unsigned gen = old / nloc;
        if (old + 1u == (gen + 1u) * nloc) {
            __builtin_amdgcn_fence(__ATOMIC_RELEASE, "agent");
            asm volatile("s_waitcnt vmcnt(0)" ::: "memory");
            const unsigned og = xb_add(&bar[XB_TOP], 1u);
            const unsigned tg = og / nx;
            if (og + 1u == (tg + 1u) * nx) xb_add(&bar[XB_TOPGEN], 1u);
            else XB_SPIN(xb_ld(&bar[XB_TOPGEN]) == tg, bar);
            __builtin_amdgcn_fence(__ATOMIC_ACQUIRE, "agent");
            xb_add(&bar[XB_XGEN(b.x)], 1u);
            asm volatile("s_waitcnt vmcnt(0)" ::: "memory");
        } else {
            XB_SPIN(xb_ld(&bar[XB_XGEN(b.x)]) == gen, bar);
            __builtin_amdgcn_fence(__ATOMIC_ACQUIRE, "agent");
            asm volatile("s_waitcnt vmcnt(0)" ::: "memory");
        }
    }
    __syncthreads();
}

#ifndef REP_P0
#define REP_P0 1
#endif
#ifndef REP_P1
#define REP_P1 1
#endif
#ifndef REP_P2
#define REP_P2 1
#endif
#ifndef P0_MASK
#define P0_MASK 3
#endif
#ifndef P2_MASK
#define P2_MASK 31
#endif
#ifndef REP_P3
#define REP_P3 1
#endif
#ifndef REP_P4
#define REP_P4 1
#endif
__global__ void __launch_bounds__(NTHREADS, 2) fwd_kernel(Params Pkarg) {
    extern __shared__ __attribute__((aligned(16))) unsigned char lds_raw[];
    cg::grid_group grid = cg::this_grid();
    LAS unsigned char* lds = (LAS unsigned char*)lds_raw;
    LAS float* ldsf = (LAS float*)lds;
    volatile LAS unsigned* qslot = (volatile LAS unsigned*)(lds + 131072 + 1024);
    volatile LAS unsigned* xbst = (volatile LAS unsigned*)(lds + 131072 + 2048);
    if (threadIdx.x < 2) xbst[threadIdx.x] = 0u;
    __syncthreads();
    (void)xcd_barrier_post((unsigned*)(Pkarg.ws + WS_CTL) + 1024, xbst);
#define GSYNC() do { PP Pb_ = (PP)__builtin_amdgcn_kernarg_segment_ptr(); asm volatile("" : "+s"(Pb_)); XcdBarrier xb_; xb_.bar = (unsigned*)(Pb_->ws + WS_CTL) + 1024; xb_.x = xb_xcc_id(); xb_.st = xbst; int ln_; asm volatile("v_mbcnt_lo_u32_b32 %0, -1, 0\n\tv_mbcnt_hi_u32_b32 %0, -1, %0" : "=v"(ln_)); xb_.t0 = (wave_s == 0) && (ln_ == 0); xcd_barrier(xb_); } while (0)
    const int wave_s = __builtin_amdgcn_readfirstlane(threadIdx.x >> 6);
#define PHASE_IDS int tid; asm volatile("v_mbcnt_lo_u32_b32 %0, -1, 0\n\tv_mbcnt_hi_u32_b32 %0, -1, %0" : "=v"(tid)); tid += wave_s * 64; const int lane = tid & 63, wave = wave_s, gw = blockIdx.x * NWAVES + wave; (void)lane; (void)gw; \
    PP P = (PP)__builtin_amdgcn_kernarg_segment_ptr(); asm volatile("" : "+s"(P)); unsigned char* ws = P->ws; unsigned* ctl = (unsigned*)(ws + WS_CTL); float* MOD = (float*)(ws + WS_MOD); \
    bf16* H = (bf16*)(ws + WS_H); bf16* Z = (bf16*)(ws + WS_Z); bf16* WTIN = (bf16*)(ws + WS_WTIN); bf16* WTOUT = (bf16*)(ws + WS_WTOUT); const float* xp = P->in[0]; const float* xs = P->in[1]; \
    (void)ctl; (void)MOD; (void)H; (void)Z; (void)WTIN; (void)WTOUT; (void)xp; (void)xs;
    const int G = gridDim.x, NGW = G * NWAVES;

    for (int rep = 0; rep < REP_P0; ++rep) {
        PHASE_IDS
        const int m0 = (rep == 0) ? 3 : P0_MASK;
        if (m0 & 1) for (int u = blockIdx.x; u < 384; u += G) mod_unit(P, ldsf, u / 192, u % 192, tid);
        LAS float* scr = ldsf + wave * 4096;
        if (m0 & 2) for (int it = gw; it < 6656 + 2048 + 2048; it += NGW) {
            if (it < 6656) transpose_item(P->in[9], 2048, DIN, WTIN, scr, it, lane);
            else if (it < 6656 + 2048) transpose_item(P->in[10], 2048, 2048, WTOUT, scr, it - 6656, lane);
            else transpose_item(P->in[10] + (size_t)2048 * 2048, 2048, 2048, WTOUT + (size_t)2048 * 2048, scr, it - 6656 - 2048, lane);
        }
        const int gt = blockIdx.x * NTHREADS + tid;
        if (gt < 2048) { const int pos = gt >> 5, i = gt & 31; const float inv = powf(10000.0f, -(float)i / 32.0f); const float ang = (float)pos * inv;
            float sn, cs; sincosf(ang, &sn, &cs); float* CS = (float*)(ws + WS_CS); CS[gt * 2] = cs; CS[gt * 2 + 1] = sn; }
        grid.sync();
    }
    { PHASE_IDS
    for (int row = gw; row < MTOK; row += NGW) {
        const int cond = (row < NCTX) ? 0 : 1 + ((row - NCTX) >> 11);
        const float* xrow = (row < NCTX) ? xp + (size_t)row * D_MODEL : xs + (size_t)(row - NCTX) * D_MODEL;
        hprep_row(xrow, MOD + (0 * 3 + cond) * 6144, H + (size_t)row * D_MODEL, lane);
    } }
    GSYNC();

    for (int l = 0; l < DEPTH; ++l) {
        for (int rep = 0; rep < REP_P1; ++rep) {
            PHASE_IDS
            pg8::Gemm g{H, WTIN, MTOK, DIN, D_MODEL}; pg8::StaticOrder S; S.init(MTOK, DIN, G, (int)blockIdx.x);
            pg8::EpiZ E{Z, P->out + OUT_CK, P->out + OUT_CV, l};
            pg8::gemm_phase<pg8::EpiZ, pg8::StaticOrder, true, true>(lds, g, S, E, tid);
            GSYNC();
        }
        for (int rep = 0; rep < REP_P2; ++rep) {
            PHASE_IDS
            unsigned* ctr = ctl + 64 * (l * 2 + 0 + 4 * rep);
            const int n_cvt = (l == 0) ? 832 : 0;
            const int msk = (rep == 0) ? 31 : P2_MASK;
            unsigned pend = 0u;
            for (int u = q_first(ctr, qslot, tid, pend); u < 1408 + n_cvt; u = q_next(ctr, qslot, tid, pend)) {
                asm volatile("" : "+v"(tid));
                if (u < 128) { if (msk & 2) attn_unit(P, lds, l, 1, u, tid); continue; } u -= 128;
                if (u < 128) { if (msk & 1) hgrn2_unit(P, lds, l, 0, u, tid); continue; } u -= 128;
                if (u < 256) { if (msk & 4) attn_unit(P, lds, l, 0, u, tid); continue; } u -= 256;
                if (u < 128) { if (msk & 1) hgrn2_unit(P, lds, l, 1, u, tid); continue; } u -= 128;
                if (u < 768) { if (msk & 8) conv_unit(P, ldsf, l, u, tid); continue; } u -= 768;
                if (msk & 16) { const int lane2 = tid & 63; LAS float* scr = ldsf + wave * 4096; transpose_item(P->in[9] + (size_t)2048 * DIN, 2048, DIN, WTIN, scr, u * 8 + wave, lane2); }
            }
            GSYNC();
        }
        { PHASE_IDS hgrn_scan(P, l, tid); }
        GSYNC();
        for (int rep = 0; rep < REP_P3; ++rep) {
            PHASE_IDS
            unsigned* ctr = ctl + 64 * (l * 2 + 1 + 4 * rep);
            unsigned pend = 0u;
            for (int u = q_first(ctr, qslot, tid, pend); u < 128; u = q_next(ctr, qslot, tid, pend)) {
                asm volatile("" : "+v"(tid));
                hgrn_final_unit(P, lds, l, u, tid);
            }
            GSYNC();
        }
        for (int rep = 0; rep < ((l == 0) ? REP_P4 : 1); ++rep) {
            PHASE_IDS
            pg8::Gemm g{H, WTOUT + (size_t)l * 2048 * 2048, MTOK, D_MODEL, D_MODEL}; pg8::StaticOrder S; S.init(MTOK, D_MODEL, G, (int)blockIdx.x);
            pg8::EpiV E{(l == 0) ? xp : P->out, (l == 0) ? xs : P->out + OUT_YS, P->out, MOD + l * 3 * 6144 + 4096};
            pg8::gemm_phase<pg8::EpiV, pg8::StaticOrder, true, true>(lds, g, S, E, tid);
            GSYNC();
        }
        { PHASE_IDS
        for (int row = gw; row < MTOK; row += NGW) {
            const int cond = (row < NCTX) ? 0 : 1 + ((row - NCTX) >> 11);
            ln_row(P->out + (size_t)row * D_MODEL, P->in[18] + l * D_MODEL, P->in[19] + l * D_MODEL, MOD + (3 + cond) * 6144, (l == 0) ? H + (size_t)row * D_MODEL : (bf16*)nullptr, lane);
        } }
        if (l + 1 < DEPTH) GSYNC();
    }
}

extern "C" void kernel_launch(void* const* d_in, const int* in_sizes, int n_in, void* d_out, int out_size, void* d_ws, size_t ws_size, hipStream_t stream) {
    static int grid = 0;
    if (grid == 0) {
        if (n_in != 20 || out_size != (int)OUT_TOTAL || ws_size < WS_END) { fprintf(stderr, "kernel_launch: unexpected shapes (n_in %d, out %d, ws %zu)\n", n_in, out_size, ws_size); grid = -1; return; }
        int dev = 0, cus = 0, per_cu = 0;
        hipGetDevice(&dev); hipDeviceGetAttribute(&cus, hipDeviceAttributeMultiprocessorCount, dev);
        hipFuncSetAttribute((const void*)fwd_kernel, hipFuncAttributeMaxDynamicSharedMemorySize, LDS_BYTES);
        hipOccupancyMaxActiveBlocksPerMultiprocessor(&per_cu, (const void*)fwd_kernel, NTHREADS, LDS_BYTES);
        if (per_cu < 1) { fprintf(stderr, "kernel_launch: occupancy query says %d blocks per CU\n", per_cu); grid = -1; return; }
        grid = cus;
    }
    if (grid < 0) return;
    hipMemsetAsync((char*)d_ws + WS_CTL, 0, CTL_ZERO_BYTES, stream);
    Params p{};
    for (int i = 0; i < 20; ++i) p.in[i] = (const float*)d_in[i];
    p.out = (float*)d_out; p.ws = (unsigned char*)d_ws;
    void* args[] = {&p};
    hipError_t e = hipLaunchCooperativeKernel((const void*)fwd_kernel, dim3(grid), dim3(NTHREADS), args, LDS_BYTES, stream);
    if (e != hipSuccess) fprintf(stderr, "cooperative launch failed: %s (grid %d)\n", hipGetErrorString(e), grid);
}
```

```cpp
#include <hip/hip_runtime.h>
#include <hip/hip_cooperative_groups.h>
#include <cstdio>
#include <cstdint>
namespace cg = cooperative_groups;

constexpr int D_MODEL = 2048, DIN = 6656, NCTX = 8192, NLAT = 4096, MTOK = 12288, DEPTH = 2;
constexpr int C_AQ = 0, C_AK = 1024, C_AV = 1280, C_AG = 1536, C_HQ = 2560, C_HI = 3072, C_HFF = 3584, C_HFB = 4096, C_HG = 4608, C_CA = 5120, C_CB = 5632, C_CG = 6144;
constexpr float ALPHA_DN = 1.4142135623730951f;
constexpr size_t OUT_YP = 0, OUT_YS = 16777216, OUT_CK = 25165824, OUT_CV = 29360128, OUT_ST = 33554432, OUT_TOTAL = 41943040;
namespace pg8 {
#define PG8_LAS __attribute__((address_space(3)))
typedef unsigned short bf16_t;
typedef short bf16x8 __attribute__((ext_vector_type(8)));
typedef float f32x4 __attribute__((ext_vector_type(4)));
typedef unsigned u32x4 __attribute__((ext_vector_type(4)));
constexpr int BM = 256, BK = 64, HALF = 128, HTB = HALF * BK * 2  , STAGE_BYTES = 8 * HTB, NXCD = 8, WGM = 8;

__host__ __device__ __forceinline__ int lds_byte(int r, int c) { const int st = (r >> 4) * 2 + (c >> 5), rr = r & 15, cc = c & 31, ob = rr * 64 + cc * 2; return st * 1024 + (ob ^ (((ob >> 9) & 1) << 5)); }
__host__ __device__ __forceinline__ void stage_rc(int b, int& R, int& C) { const int st = b / 1024, sb = b % 1024, swz = sb ^ (((sb >> 9) & 1) << 5); R = (st >> 1) * 16 + swz / 64; C = (st & 1) * 32 + (swz % 64) / 2; }
__host__ __device__ __forceinline__ int perm32(int rho) { const int n = rho >> 4, i = rho & 15; return 8 * (i >> 2) + 4 * n + (i & 3); }

struct Unit { int pm, pn, k0, nk, role, pair; };
struct Gemm { const bf16_t* A; const bf16_t* Bt; int M, N, K; };

struct StaticOrder {
    int nM, nN, nwg, G, c, nkt, split;
    __host__ __device__ void init(int M, int N, int K, int G_, int c_, int split_ = 0) { nM = M / BM; nN = N / BM; nwg = nM * nN; G = G_; c = c_; nkt = K / BK; split = split_ && (G_ % 16 == 0) && (2 * nwg == 3 * G_) && (nkt % 4 == 0); }
    __host__ __device__ void map(long L, Unit& u) const {
        int wgid = (int)L; { const int q = nwg / NXCD, r = nwg % NXCD, xcd = wgid % NXCD, off = wgid / NXCD; wgid = (xcd < r ? xcd * (q + 1) : r * (q + 1) + (xcd - r) * q) + off; }
        const int nig = WGM * nN, gid = wgid / nig, fm = gid * WGM, gsz = (nM - fm) < WGM ? (nM - fm) : WGM;
        u.pm = fm + ((wgid % nig) % gsz); u.pn = (wgid % nig) / gsz; u.k0 = 0; u.nk = nkt; u.role = 0; u.pair = 0;
    }
    __host__ __device__ bool next(int i, Unit& u) const {
        if (split) {
            if (i == 0) { map(c, u); return true; }
            if (i == 1) { const int j = (c >> 4) * 8 + (c & 7), half = (c >> 3) & 1; map(G + j, u); u.k0 = half * (nkt / 2); u.nk = nkt / 2; u.role = 1 + half; u.pair = j; return true; }
            return false;
        }
        const long L = (long)i * G + c; if (L >= nwg) return false;
        map(L, u); return true;
    }
    __device__ __forceinline__ void a_ready(const Unit&) const {}
    __device__ __forceinline__ void done(const Unit&) const {}
};

__device__ __forceinline__ unsigned cvt_pk_bf16(float lo, float hi) { unsigned r; asm volatile("v_cvt_pk_bf16_f32 %0, %1, %2" : "=v"(r) : "v"(lo), "v"(hi)); return r; }
typedef float f32x2 __attribute__((ext_vector_type(2)));

struct EpiZ {
    static constexpr bool PERM = true, AFTER_DRAIN = false;
    bf16_t* Z; float* ck; float* cv; int layer;
    __device__ __forceinline__ void operator()(f32x4 (&acc)[2][2][4][2], const Unit& u, int wr, int wc, int fr_in, int fq_in) const {
        int fr = fr_in, fq = fq_in; asm volatile("" : "+v"(fr), "+v"(fq));
        const int row0 = u.pm * BM + wr * 64 + fr; const int col0 = u.pn * BM + wc * 32 + 8 * fq;
#pragma unroll
        for (int ai = 0; ai < 2; ++ai)
#pragma unroll
            for (int m = 0; m < 4; ++m) { bf16_t* rowp = Z + (size_t)(row0 + ai * HALF + m * 16) * DIN + col0;
#pragma unroll
                for (int bj = 0; bj < 2; ++bj) { const f32x4 v0 = acc[ai][bj][m][0], v1 = acc[ai][bj][m][1];
                    u32x4 w; w.x = cvt_pk_bf16(v0[0], v0[1]); w.y = cvt_pk_bf16(v0[2], v0[3]); w.z = cvt_pk_bf16(v1[0], v1[1]); w.w = cvt_pk_bf16(v1[2], v1[3]);
                    *(u32x4*)(rowp + bj * HALF) = w; } }
        if ((u.pn == 4 || u.pn == 5) && u.pm < 32) {
            float* base = (u.pn == 4) ? ck : cv;
#pragma unroll
            for (int ai = 0; ai < 2; ++ai)
#pragma unroll
                for (int m = 0; m < 4; ++m) { const int row = row0 + ai * HALF + m * 16; const int b = row >> 8, s = row & 255;
                    float* p = base + ((size_t)((b * 2 + layer) * 256 + s)) * 256 + (wc * 32 + 8 * fq);
#pragma unroll
                    for (int bj = 0; bj < 2; ++bj) { *(f32x4*)(p + bj * HALF) = acc[ai][bj][m][0]; *(f32x4*)(p + bj * HALF + 4) = acc[ai][bj][m][1]; } }
        }
    }
};
struct EpiV {
    static constexpr bool PERM = false, AFTER_DRAIN = false;
    const float* xp; const float* xs; float* V; const float* gate;
    float* slab; unsigned* flags;
    __device__ __forceinline__ void operator()(f32x4 (&acc)[2][2][4][2], const Unit& u, int wr, int wc, int fr_in, int fq_in) const {
        int fr = fr_in, fq = fq_in; asm volatile("" : "+v"(fr), "+v"(fq));
        const int lane = fq * 16 + fr, tid = (wr * 4 + wc) * 64 + lane;
        float* sp = slab + (size_t)u.pair * 65536 + tid * 4; unsigned* fl = flags + 64 * u.pair;
        if (u.role == 1) {
            { float* q = sp;
#pragma unroll
              for (int ai = 0; ai < 2; ++ai)
#pragma unroll
                for (int m = 0; m < 4; ++m)
#pragma unroll
                    for (int bj = 0; bj < 2; ++bj)
#pragma unroll
                        for (int n = 0; n < 2; ++n) {
                            asm volatile("global_store_dwordx4 %0, %1, off sc1\n\ts_nop 1" :: "v"(q), "v"(acc[ai][bj][m][n]) : "memory");
                            q += 2048; asm volatile("" : "+v"(q)); } }
            asm volatile("s_waitcnt vmcnt(0)" ::: "memory");
            if (lane == 0) __hip_atomic_fetch_add(fl, 1u, __ATOMIC_RELAXED, __HIP_MEMORY_SCOPE_AGENT);
            return;
        }
        const bool red = (u.role == 2);
        if (red) {
            unsigned sp_ = 0;
            while ((unsigned)__builtin_amdgcn_readfirstlane(__hip_atomic_load(fl, __ATOMIC_RELAXED, __HIP_MEMORY_SCOPE_AGENT)) < 8u) { __builtin_amdgcn_s_sleep(2); if (++sp_ > (1u << 20)) break; }
            asm volatile("" ::: "memory");
        }
        const int row0 = u.pm * BM + wr * 64 + fr; const int col0 = u.pn * BM + wc * 32 + 4 * fq;
        const int cond = (u.pm < 32) ? 0 : 1 + ((u.pm - 32) >> 3);
        const float* g = gate + cond * 6144 + col0;
        f32x4 gv[2][2];
#pragma unroll
        for (int bj = 0; bj < 2; ++bj)
#pragma unroll
            for (int n = 0; n < 2; ++n) gv[bj][n] = *(const f32x4*)(g + bj * HALF + n * 16);
        if (!red) {
            f32x4 xq[2][4];
            { const int row = row0; const float* xr = ((row < NCTX) ? xp + (size_t)row * D_MODEL : xs + (size_t)(row - NCTX) * D_MODEL) + col0;
#pragma unroll
              for (int e = 0; e < 4; ++e) xq[0][e] = *(const f32x4*)(xr + (e >> 1) * HALF + (e & 1) * 16); }
#pragma unroll
            for (int g8 = 0; g8 < 8; ++g8) { const int ai = g8 >> 2, m = g8 & 3; const int row = row0 + ai * HALF + m * 16;
                if (g8 + 1 < 8) { const int rown = row0 + ((g8 + 1) >> 2) * HALF + ((g8 + 1) & 3) * 16;
                    const float* xr = ((rown < NCTX) ? xp + (size_t)rown * D_MODEL : xs + (size_t)(rown - NCTX) * D_MODEL) + col0;
#pragma unroll
                    for (int e = 0; e < 4; ++e) xq[(g8 + 1) & 1][e] = *(const f32x4*)(xr + (e >> 1) * HALF + (e & 1) * 16); }
                float* vr = V + (size_t)row * D_MODEL + col0;
#pragma unroll
                for (int e = 0; e < 4; ++e) *(f32x4*)(vr + (e >> 1) * HALF + (e & 1) * 16) = xq[g8 & 1][e] * ALPHA_DN + gv[e >> 1][e & 1] * acc[ai][e >> 1][m][e & 1];
                asm volatile("" ::: "memory"); }
        } else {
            const float* rq = sp;
#pragma unroll
            for (int ai = 0; ai < 2; ++ai)
#pragma unroll
                for (int m = 0; m < 4; ++m) { const int row = row0 + ai * HALF + m * 16;
                    const float* xr = ((row < NCTX) ? xp + (size_t)row * D_MODEL : xs + (size_t)(row - NCTX) * D_MODEL) + col0;
                    float* vr = V + (size_t)row * D_MODEL + col0;
                    f32x4 t[2][2];
#pragma unroll
                    for (int bj = 0; bj < 2; ++bj)
#pragma unroll
                        for (int n = 0; n < 2; ++n) { const unsigned long long* q8 = (const unsigned long long*)rq;
                            const unsigned long long a8 = __hip_atomic_load(q8, __ATOMIC_RELAXED, __HIP_MEMORY_SCOPE_AGENT), b8 = __hip_atomic_load(q8 + 1, __ATOMIC_RELAXED, __HIP_MEMORY_SCOPE_AGENT);
                            t[bj][n] = (f32x4){__builtin_bit_cast(float, (unsigned)a8), __builtin_bit_cast(float, (unsigned)(a8 >> 32)), __builtin_bit_cast(float, (unsigned)b8), __builtin_bit_cast(float, (unsigned)(b8 >> 32))};
                            rq += 2048; asm volatile("" : "+v"(rq)); }
#pragma unroll
                    for (int bj = 0; bj < 2; ++bj)
#pragma unroll
                        for (int n = 0; n < 2; ++n) { const f32x4 xv = *(const f32x4*)(xr + bj * HALF + n * 16);
                            *(f32x4*)(vr + bj * HALF + n * 16) = xv * ALPHA_DN + gv[bj][n] * (acc[ai][bj][m][n] + t[bj][n]); }
                    asm volatile("" ::: "memory"); }
        }
    }
};
template <class Epi, class Sched, bool ALIGN_EPI = false, bool SP2 = false>
__device__ __forceinline__ void gemm_phase(PG8_LAS unsigned char* lds, const Gemm g, const Sched& S, const Epi& E, int tid_in) {
    int tid_l = tid_in; asm volatile("" : "+v"(tid_l));
    const int tid = tid_l, wid = __builtin_amdgcn_readfirstlane(tid >> 6), lane = tid & 63, wr = wid >> 2, wc = wid & 3, fr = lane & 15, fq = lane >> 4;
    const int K = g.K;
    unsigned voffA[2], voffB[2];
#pragma unroll
    for (int i = 0; i < 2; ++i) { int R, C; stage_rc(tid * 16 + i * 8192, R, C); const int Rb = Epi::PERM ? ((R & ~31) + perm32(R & 31)) : R;
        voffA[i] = (unsigned)(R * K + C) * 2u; voffB[i] = (unsigned)(Rb * K + C) * 2u; }
    const size_t kstep = (size_t)(BK * 2);
    const size_t hstep = (size_t)HALF * K * 2;
    const size_t tstep = 2 * hstep;
    const unsigned ldsw = (unsigned)wid * 1024u;
    const int aoff = lds_byte(wr * 64 + fr, fq * 8), boff = lds_byte(wc * 32 + fr, fq * 8);
#define PG8_SA(b, h) (((b) * 2 + (h)) * HTB)
#define PG8_SB(b, h) ((4 + (b) * 2 + (h)) * HTB)
#define PG8_STAGE(bufoff, gbase, voff) do { _Pragma("unroll") for (int _i = 0; _i < 2; ++_i) \
        __builtin_amdgcn_global_load_lds((const unsigned*)((const char*)(gbase) + (voff)[_i]), (PG8_LAS unsigned*)(lds + (bufoff) + ldsw + _i * 8192), 16, 0, 0); } while (0)
#define PG8_LDA(dst, b, h) do { _Pragma("unroll") for (int m = 0; m < 4; ++m) _Pragma("unroll") for (int k = 0; k < 2; ++k) dst[m][k] = *(const PG8_LAS bf16x8*)(lds + PG8_SA(b, h) + aoff + m * 2048 + k * 1024); } while (0)
#define PG8_LDB(dst, b, h) do { _Pragma("unroll") for (int n = 0; n < 2; ++n) _Pragma("unroll") for (int k = 0; k < 2; ++k) dst[n][k] = *(const PG8_LAS bf16x8*)(lds + PG8_SB(b, h) + boff + n * 2048 + k * 1024); } while (0)
#define PG8_MMA(ai, bj, At, Bt) do { __builtin_amdgcn_s_setprio(1); _Pragma("unroll") for (int m = 0; m < 4; ++m) _Pragma("unroll") for (int n = 0; n < 2; ++n) _Pragma("unroll") for (int k = 0; k < 2; ++k) \
        acc[ai][bj][m][n] = __builtin_amdgcn_mfma_f32_16x16x32_bf16(Bt[n][k], At[m][k], acc[ai][bj][m][n], 0, 0, 0); __builtin_amdgcn_s_setprio(0); } while (0)
#define PG8_WAIT_V(n) asm volatile("s_waitcnt vmcnt(" #n ")" ::: "memory")
#define PG8_WAIT_L(n) asm volatile("s_waitcnt lgkmcnt(" #n ")" ::: "memory")
#define PG8_BAR __builtin_amdgcn_s_barrier()
#define PG8_SCHED __builtin_amdgcn_sched_barrier(0)
    Unit cur, nxt; int ui = 0;
    if (!S.next(0, cur)) return;
    f32x4 acc[2][2][4][2];
#pragma unroll
    for (int a = 0; a < 2; ++a)
#pragma unroll
        for (int b = 0; b < 2; ++b)
#pragma unroll
            for (int m = 0; m < 4; ++m)
#pragma unroll
                for (int n = 0; n < 2; ++n) acc[a][b][m][n] = (f32x4){0.f, 0.f, 0.f, 0.f};
    bf16x8 At[4][2], B0[2][2], B1[2][2];
    const char* cA = (const char*)g.A + (size_t)cur.pm * tstep + (size_t)cur.k0 * kstep; const char* cB = (const char*)g.Bt + (size_t)cur.pn * tstep + (size_t)cur.k0 * kstep;
    S.a_ready(cur);
    if constexpr (SP2) {
        PG8_STAGE(PG8_SB(0, 0), cB, voffB); PG8_STAGE(PG8_SB(0, 1), cB + hstep, voffB); PG8_STAGE(PG8_SA(0, 0), cA, voffA); PG8_STAGE(PG8_SA(0, 1), cA + hstep, voffA);
        if (wr == 1) PG8_BAR;
        PG8_WAIT_V(2); PG8_BAR;
        PG8_STAGE(PG8_SB(1, 0), cB + kstep, voffB); PG8_STAGE(PG8_SA(1, 0), cA + kstep, voffA); PG8_STAGE(PG8_SB(1, 1), cB + hstep + kstep, voffB);
        PG8_WAIT_V(6); PG8_BAR;
    } else {
        PG8_STAGE(PG8_SB(0, 0), cB, voffB); PG8_STAGE(PG8_SA(0, 0), cA, voffA); PG8_STAGE(PG8_SB(0, 1), cB + hstep, voffB); PG8_STAGE(PG8_SA(0, 1), cA + hstep, voffA);
        if (wr == 1) PG8_BAR;
        PG8_WAIT_V(4); PG8_BAR;
        PG8_STAGE(PG8_SB(1, 0), cB + kstep, voffB); PG8_STAGE(PG8_SA(1, 0), cA + kstep, voffA); PG8_STAGE(PG8_SB(1, 1), cB + hstep + kstep, voffB);
        PG8_WAIT_V(6); PG8_BAR;
    }
    for (;;) {
        const bool has_next = S.next(ui + 1, nxt);
        const char* nA = has_next ? (const char*)g.A + (size_t)nxt.pm * tstep + (size_t)nxt.k0 * kstep : cA; const char* nB = has_next ? (const char*)g.Bt + (size_t)nxt.pn * tstep + (size_t)nxt.k0 * kstep : cB;
        const int nt = cur.nk;
        for (int t = 0; t < nt; t += 2) {
            const bool last = (t == nt - 2);
            const char* a1 = cA + (size_t)(t + 1) * kstep;
            const char* a2 = last ? nA : cA + (size_t)(t + 2) * kstep; const char* b2 = last ? nB : cB + (size_t)(t + 2) * kstep;
            const char* a3 = a2 + kstep; const char* b3 = b2 + kstep;
            if (last && has_next) S.a_ready(nxt);
            if constexpr (SP2) {
            PG8_LDB(B0, 0, 0); PG8_LDB(B1, 0, 1); PG8_SCHED; PG8_LDA(At, 0, 0); PG8_STAGE(PG8_SA(1, 1), a1 + hstep, voffA);
            PG8_WAIT_V(8); PG8_WAIT_L(0); PG8_BAR; PG8_MMA(0, 0, At, B0); PG8_MMA(0, 1, At, B1); PG8_BAR; PG8_SCHED;
            PG8_LDA(At, 0, 1); PG8_STAGE(PG8_SB(0, 0), b2, voffB); PG8_STAGE(PG8_SB(0, 1), b2 + hstep, voffB); PG8_STAGE(PG8_SA(0, 0), a2, voffA);
            PG8_WAIT_V(8); PG8_WAIT_L(0); PG8_BAR; PG8_MMA(1, 0, At, B0); PG8_MMA(1, 1, At, B1); PG8_BAR; PG8_SCHED;
            PG8_LDB(B0, 1, 0); PG8_LDB(B1, 1, 1); PG8_SCHED; PG8_LDA(At, 1, 0); PG8_STAGE(PG8_SA(0, 1), a2 + hstep, voffA);
            PG8_WAIT_V(8); PG8_WAIT_L(0); PG8_BAR; PG8_MMA(0, 0, At, B0); PG8_MMA(0, 1, At, B1); PG8_BAR; PG8_SCHED;
            PG8_LDA(At, 1, 1); PG8_STAGE(PG8_SB(1, 0), b3, voffB); PG8_STAGE(PG8_SB(1, 1), b3 + hstep, voffB); PG8_STAGE(PG8_SA(1, 0), a3, voffA);
            PG8_WAIT_V(8); PG8_WAIT_L(0); PG8_BAR; PG8_MMA(1, 0, At, B0); PG8_MMA(1, 1, At, B1); PG8_BAR; PG8_SCHED;
            } else {
            PG8_LDB(B0, 0, 0); PG8_SCHED; PG8_LDA(At, 0, 0); PG8_STAGE(PG8_SA(1, 1), a1 + hstep, voffA);
            PG8_WAIT_L(8); PG8_BAR; PG8_WAIT_L(0); PG8_MMA(0, 0, At, B0); PG8_BAR; PG8_SCHED;
            PG8_LDB(B1, 0, 1); PG8_STAGE(PG8_SB(0, 0), b2, voffB);
            PG8_BAR; PG8_WAIT_L(0); PG8_MMA(0, 1, At, B1); PG8_BAR;
            PG8_LDA(At, 0, 1); PG8_STAGE(PG8_SA(0, 0), a2, voffA);
            PG8_BAR; PG8_WAIT_L(0); PG8_MMA(1, 0, At, B0); PG8_BAR; PG8_SCHED;
            PG8_STAGE(PG8_SB(0, 1), b2 + hstep, voffB);
            PG8_WAIT_V(6); PG8_BAR; PG8_MMA(1, 1, At, B1); PG8_BAR;
            PG8_LDB(B0, 1, 0); PG8_SCHED; PG8_LDA(At, 1, 0); PG8_STAGE(PG8_SA(0, 1), a2 + hstep, voffA);
            PG8_WAIT_L(8); PG8_BAR; PG8_WAIT_L(0); PG8_MMA(0, 0, At, B0); PG8_BAR; PG8_SCHED;
            PG8_LDB(B1, 1, 1); PG8_STAGE(PG8_SB(1, 0), b3, voffB);
            PG8_BAR; PG8_WAIT_L(0); PG8_MMA(0, 1, At, B1); PG8_BAR;
            PG8_LDA(At, 1, 1); PG8_STAGE(PG8_SA(1, 0), a3, voffA);
            PG8_BAR; PG8_WAIT_L(0); PG8_MMA(1, 0, At, B0); PG8_BAR; PG8_SCHED;
            PG8_STAGE(PG8_SB(1, 1), b3 + hstep, voffB);
            PG8_WAIT_V(6); PG8_BAR; PG8_MMA(1, 1, At, B1); PG8_BAR;
            }
        }
        if constexpr (ALIGN_EPI) { if (wr == 0) PG8_BAR; }
        if constexpr (!Epi::AFTER_DRAIN) { E(acc, cur, wr, wc, fr, fq); S.done(cur); }
        if (!has_next) break;
#pragma unroll
        for (int a = 0; a < 2; ++a)
#pragma unroll
            for (int b = 0; b < 2; ++b)
#pragma unroll
                for (int m = 0; m < 4; ++m)
#pragma unroll
                    for (int n = 0; n < 2; ++n) acc[a][b][m][n] = (f32x4){0.f, 0.f, 0.f, 0.f};
        cur = nxt; cA = nA; cB = nB; ++ui;
        if constexpr (ALIGN_EPI) { if (wr == 1) PG8_BAR; }
    }
    PG8_WAIT_V(0);
    if constexpr (!ALIGN_EPI) { if (wr == 0) PG8_BAR; }
    PG8_BAR;
    if constexpr (Epi::AFTER_DRAIN) { E.fused(acc, cur, wr, wc, fr, fq, lds, wid, lane); S.done(cur); }
#undef PG8_SA
#undef PG8_SB
#undef PG8_STAGE
#undef PG8_LDA
#undef PG8_LDB
#undef PG8_MMA
#undef PG8_WAIT_V
#undef PG8_WAIT_L
#undef PG8_BAR
#undef PG8_SCHED
}
}

constexpr size_t MiB = 1u << 20;
constexpr size_t WS_CTL = 0, CTL_ZERO_BYTES = 262144;
constexpr size_t WS_MOD = 1 * MiB;
constexpr size_t WS_CS = 1 * MiB + 192 * 1024;
constexpr size_t WS_DLOG = 1 * MiB + 256 * 1024;
constexpr size_t WS_WTOUT = 2 * MiB;
constexpr size_t WS_WTIN = 18 * MiB;
constexpr size_t WS_H = 44 * MiB;
constexpr size_t WS_Z = 92 * MiB;
constexpr size_t WS_U = 248 * MiB;
constexpr size_t WS_OL = 264 * MiB;
constexpr size_t WS_END = 312 * MiB;
constexpr int LDS_BYTES = 147456;
constexpr int NWAVES = 8, NTHREADS = 512;

#define LAS __attribute__((address_space(3)))
typedef unsigned short bf16;
typedef float f32x4 __attribute__((ext_vector_type(4)));
typedef float f32x16 __attribute__((ext_vector_type(16)));
typedef unsigned u32x4 __attribute__((ext_vector_type(4)));
typedef unsigned u32x2 __attribute__((ext_vector_type(2)));
typedef short bf16x8 __attribute__((ext_vector_type(8)));

__device__ __forceinline__ float bf2f(unsigned short u) { return __builtin_bit_cast(float, (unsigned)u << 16); }
__device__ __forceinline__ float bflo(unsigned u) { return __builtin_bit_cast(float, u << 16); }
__device__ __forceinline__ float bfhi(unsigned u) { return __builtin_bit_cast(float, u & 0xffff0000u); }
typedef float f32x2_t_ __attribute__((ext_vector_type(2))); typedef __bf16 bf16x2_t_ __attribute__((ext_vector_type(2)));
__device__ __forceinline__ unsigned pk2(float lo, float hi) { const f32x2_t_ v = {lo, hi}; return __builtin_bit_cast(unsigned, __builtin_convertvector(v, bf16x2_t_)); }
__device__ __forceinline__ unsigned f2bf(float f) { return pk2(f, f) & 0xffffu; }
__device__ __forceinline__ float sigmoidf_(float x) { return __builtin_amdgcn_rcpf(1.0f + __builtin_amdgcn_exp2f(-1.4426950408889634f * x)); }
__device__ __forceinline__ float siluf_(float x) { return x * __builtin_amdgcn_rcpf(1.0f + __builtin_amdgcn_exp2f(-1.4426950408889634f * x)); }
__device__ __forceinline__ float wave_sum(float v) {
#pragma unroll
    for (int o = 1; o < 64; o <<= 1) v += __shfl_xor(v, o);
    return v;
}

struct Params {
    const float* in[20];
    float* out; unsigned char* ws;
};
typedef const __attribute__((address_space(4))) Params* PP;

__device__ __forceinline__ int next_unit(unsigned* ctr, volatile LAS unsigned* slot, int tid) {
    __syncthreads();
    if (tid == 0) *slot = __hip_atomic_fetch_add(ctr, 1u, __ATOMIC_RELAXED, __HIP_MEMORY_SCOPE_AGENT);
    __syncthreads();
    return (int)*slot;
}
__device__ __forceinline__ int q_first(unsigned* ctr, volatile LAS unsigned* slot, int tid, unsigned& pend) {
    unsigned cur = 0u;
    if (tid == 0) { cur = __hip_atomic_fetch_add(ctr, 1u, __ATOMIC_RELAXED, __HIP_MEMORY_SCOPE_AGENT); *slot = cur; pend = __hip_atomic_fetch_add(ctr, 1u, __ATOMIC_RELAXED, __HIP_MEMORY_SCOPE_AGENT); }
    __syncthreads();
    return (int)*slot;
}
__device__ __forceinline__ int q_next(unsigned* ctr, volatile LAS unsigned* slot, int tid, unsigned& pend) {
    __syncthreads();
    if (tid == 0) { *slot = pend; pend = __hip_atomic_fetch_add(ctr, 1u, __ATOMIC_RELAXED, __HIP_MEMORY_SCOPE_AGENT); }
    __syncthreads();
    return (int)*slot;
}

__device__ __forceinline__ void transpose_item(const float* W, int K, int N, bf16* WT, LAS float* scr, int item, int lane) {
    const int nblk = N / 32, kb = item / nblk, nb = item % nblk, k0 = 64 * kb, n0 = 32 * nb;
    float wv[32];
    const float* wp = W + (size_t)(k0 + (lane >> 5)) * N + n0 + (lane & 31);
#pragma unroll
    for (int i = 0; i < 32; ++i) wv[i] = wp[(size_t)(2 * i) * N];
    __builtin_amdgcn_sched_barrier(0);
#pragma unroll
    for (int i = 0; i < 32; ++i) { const int kk = 2 * i + (lane >> 5); scr[kk * 33 + (lane & 31)] = wv[i]; }
    asm volatile("s_waitcnt lgkmcnt(0)" ::: "memory");
    const int c = lane & 7;
#pragma unroll
    for (int j = 0; j < 4; ++j) { const int n = (lane >> 3) + 8 * j; const LAS float* s = scr + (8 * c) * 33 + n;
        u32x4 o; o.x = pk2(s[0 * 33], s[1 * 33]); o.y = pk2(s[2 * 33], s[3 * 33]); o.z = pk2(s[4 * 33], s[5 * 33]); o.w = pk2(s[6 * 33], s[7 * 33]);
        *(u32x4*)(WT + (size_t)(n0 + n) * K + k0 + 8 * c) = o; }
    asm volatile("s_waitcnt lgkmcnt(0)" ::: "memory");
}

__device__ __forceinline__ void mod_unit(PP P, LAS float* lds, int l, int nc, int tid) {
    const float* c = P->in[5]; const float* cctx = P->in[6]; const float* aw = P->in[7] + (size_t)l * 2048 * 6144; const float* ab = P->in[8] + l * 6144;
    LAS float* sc = lds;
    LAS float* red = lds + 3 * 2048;
    for (int i = tid; i < 3 * 2048; i += NTHREADS) { const int j = i >> 11, k = i & 2047; const float v = (j == 0) ? cctx[k] : c[(j - 1) * 2048 + k]; sc[i] = siluf_(v); }
    __syncthreads();
    const int tn = tid & 7, tk = tid >> 3, n0 = nc * 32 + 4 * tn;
    float a[3][4] = {};
    for (int k8 = 0; k8 < 32; k8 += 16) {
        f32x4 w[16];
#pragma unroll
        for (int kk = 0; kk < 16; ++kk) w[kk] = *(const f32x4*)(aw + (size_t)(tk * 32 + k8 + kk) * 6144 + n0);
        __builtin_amdgcn_sched_barrier(0);
#pragma unroll
        for (int kk = 0; kk < 16; ++kk) { const int k = tk * 32 + k8 + kk;
#pragma unroll
            for (int j = 0; j < 3; ++j) { const float s = sc[j * 2048 + k]; a[j][0] += s * w[kk][0]; a[j][1] += s * w[kk][1]; a[j][2] += s * w[kk][2]; a[j][3] += s * w[kk][3]; } }
    }
#pragma unroll
    for (int j = 0; j < 3; ++j)
#pragma unroll
        for (int e = 0; e < 4; ++e) red[(tk * 8 + tn) * 12 + j * 4 + e] = a[j][e];
    __syncthreads();
    if (tid < 96) { const int tn2 = tid / 12, je = tid % 12; float s = 0.f; for (int t = 0; t < 64; ++t) s += red[(t * 8 + tn2) * 12 + je];
        const int j = je >> 2, e = je & 3, n = nc * 32 + 4 * tn2 + e;
        ((float*)(P->ws + WS_MOD))[(l * 3 + j) * 6144 + n] = s + ab[n]; }
    __syncthreads();
}

__device__ __forceinline__ void hprep_row(const float* xrow, const float* mod  , bf16* hrow, int lane) {
#pragma unroll
    for (int j = 0; j < 8; ++j) { const int c = 4 * lane + 256 * j; const f32x4 x = *(const f32x4*)(xrow + c), sh = *(const f32x4*)(mod + c), sc = *(const f32x4*)(mod + 2048 + c);
        const f32x4 h = x * (sc + 1.0f) + sh; u32x2 o; o.x = pk2(h[0], h[1]); o.y = pk2(h[2], h[3]); *(u32x2*)(hrow + c) = o; }
}
__device__ __forceinline__ void ln_row(float* vrow, const float* w, const float* b, const float* modn, bf16* hrow, int lane) {
    f32x4 v[8]; float s = 0.f;
#pragma unroll
    for (int j = 0; j < 8; ++j) { v[j] = *(const f32x4*)(vrow + 4 * lane + 256 * j); s += (v[j][0] + v[j][1]) + (v[j][2] + v[j][3]); }
    const float mean = wave_sum(s) * (1.0f / 2048.0f); float q = 0.f;
#pragma unroll
    for (int j = 0; j < 8; ++j) { v[j] = v[j] - mean; q += (v[j][0] * v[j][0] + v[j][1] * v[j][1]) + (v[j][2] * v[j][2] + v[j][3] * v[j][3]); }
    const float rstd = __builtin_amdgcn_rsqf(wave_sum(q) * (1.0f / 2048.0f) + 1e-5f);
#pragma unroll
    for (int j = 0; j < 8; ++j) { const int c = 4 * lane + 256 * j; const f32x4 y = v[j] * rstd * *(const f32x4*)(w + c) + *(const f32x4*)(b + c);
        *(f32x4*)(vrow + c) = y;
        if (hrow) { const f32x4 sh = *(const f32x4*)(modn + c), sc = *(const f32x4*)(modn + 2048 + c); const f32x4 h = y * (sc + 1.0f) + sh;
            u32x2 o; o.x = pk2(h[0], h[1]); o.y = pk2(h[2], h[3]); *(u32x2*)(hrow + c) = o; } }
}

__device__ __forceinline__ void conv_unit(PP P, LAS float* lds, int l, int unit, int tid) {
    const int lane = tid & 63, wave = tid >> 6;
    const bf16* Z = (const bf16*)(P->ws + WS_Z); bf16* MIX = (bf16*)(P->ws + WS_H);
    const int t0 = unit * 16;
    int s0, s1; if (t0 < NCTX) { s0 = t0 & ~255; s1 = s0 + 256; } else { s0 = NCTX + ((t0 - NCTX) & ~2047); s1 = s0 + 2048; }
    const int c = tid;
    float u[46];
    unsigned short ra[46], rb[46];
#pragma unroll
    for (int r = 0; r < 46; ++r) { const int row = t0 - 15 + r; const int rc = row < s0 ? s0 : (row >= s1 ? s1 - 1 : row);
        ra[r] = Z[(size_t)rc * DIN + C_CA + c]; rb[r] = Z[(size_t)rc * DIN + C_CB + c]; }
    __builtin_amdgcn_sched_barrier(0);
#pragma unroll
    for (int r = 0; r < 46; ++r) { const int row = t0 - 15 + r; const float val = bf2f(ra[r]) * sigmoidf_(bf2f(rb[r])); u[r] = (row >= s0 && row < s1) ? val : 0.f; }
    float acc[16]; const float bias = P->in[15][l * 512 + c];
#pragma unroll
    for (int i = 0; i < 16; ++i) acc[i] = bias;
    const float* cw = P->in[14] + (size_t)l * 31 * 512 + c;
#pragma unroll
    for (int j = 0; j < 31; ++j) { const float w = cw[j * 512];
#pragma unroll
        for (int i = 0; i < 16; ++i) acc[i] += u[i + j] * w; }
    LAS float* yb = lds;
#pragma unroll
    for (int i = 0; i < 16; ++i) yb[i * 512 + c] = acc[i];
    __syncthreads();
    const float* lw = P->in[16] + l * 512; const float* lb = P->in[17] + l * 512;
#pragma unroll
    for (int tt = 0; tt < 2; ++tt) { const int ti = wave * 2 + tt, row = t0 + ti;
        f32x4 a = *(const LAS f32x4*)(yb + ti * 512 + 8 * lane), b = *(const LAS f32x4*)(yb + ti * 512 + 8 * lane + 4);
        float s = (a[0] + a[1]) + (a[2] + a[3]) + (b[0] + b[1]) + (b[2] + b[3]);
        const float mean = wave_sum(s) * (1.0f / 512.0f); a = a - mean; b = b - mean;
        float q = (a[0] * a[0] + a[1] * a[1]) + (a[2] * a[2] + a[3] * a[3]) + (b[0] * b[0] + b[1] * b[1]) + (b[2] * b[2] + b[3] * b[3]);
        const float rstd = __builtin_amdgcn_rsqf(wave_sum(q) * (1.0f / 512.0f) + 1e-5f);
        const f32x4 w0 = *(const f32x4*)(lw + 8 * lane), w1 = *(const f32x4*)(lw + 8 * lane + 4), b0 = *(const f32x4*)(lb + 8 * lane), b1 = *(const f32x4*)(lb + 8 * lane + 4);
        a = a * rstd * w0 + b0; b = b * rstd * w1 + b1;
        const u32x4 g = *(const u32x4*)(Z + (size_t)row * DIN + C_CG + 8 * lane);
        float o[8];
        o[0] = siluf_(a[0]) * siluf_(bflo(g.x)); o[1] = siluf_(a[1]) * siluf_(bfhi(g.x)); o[2] = siluf_(a[2]) * siluf_(bflo(g.y)); o[3] = siluf_(a[3]) * siluf_(bfhi(g.y));
        o[4] = siluf_(b[0]) * siluf_(bflo(g.z)); o[5] = siluf_(b[1]) * siluf_(bfhi(g.z)); o[6] = siluf_(b[2]) * siluf_(bflo(g.w)); o[7] = siluf_(b[3]) * siluf_(bfhi(g.w));
        u32x4 w; w.x = pk2(o[0], o[1]); w.y = pk2(o[2], o[3]); w.z = pk2(o[4], o[5]); w.w = pk2(o[6], o[7]);
        *(u32x4*)(MIX + (size_t)row * D_MODEL + 1536 + 8 * lane) = w; }
}

typedef short v4i16_t __attribute__((ext_vector_type(4)));
#define SBAR __builtin_amdgcn_sched_barrier(0);
#define R0(i) (((i) & 3) + 8 * ((i) >> 2))
constexpr float ATT_C2 = 0.08838834764831845f * 1.4426950408889634f;
constexpr float LOG2E = 1.4426950408889634f;
constexpr int KROW = 272, VROW = 320, ATT_V_OFF = 64 * KROW;

__device__ __forceinline__ bf16x8 trpair(const LAS unsigned char* p, int second_off) {
    const v4i16_t lo = __builtin_amdgcn_ds_read_tr16_b64_v4i16((LAS v4i16_t*)p), hi = __builtin_amdgcn_ds_read_tr16_b64_v4i16((LAS v4i16_t*)(p + second_off));
    return (bf16x8){lo[0], lo[1], lo[2], lo[3], hi[0], hi[1], hi[2], hi[3]};
}
__device__ __forceinline__ bf16x8 pack8(float a, float b, float c, float d, float e, float f, float g, float h) {
    const u32x4 w = {pk2(a, b), pk2(c, d), pk2(e, f), pk2(g, h)}; return __builtin_bit_cast(bf16x8, w);
}
__device__ __forceinline__ void rope8(bf16x8& a, bf16x8& b, const float* cs) {
    float ra[8], rb[8];
#pragma unroll
    for (int j = 0; j < 8; ++j) { const float x1 = bf2f((unsigned short)a[j]), x2 = bf2f((unsigned short)b[j]), c = cs[2 * j], s = cs[2 * j + 1]; ra[j] = x1 * c - x2 * s; rb[j] = x2 * c + x1 * s; }
    a = pack8(ra[0], ra[1], ra[2], ra[3], ra[4], ra[5], ra[6], ra[7]); b = pack8(rb[0], rb[1], rb[2], rb[3], rb[4], rb[5], rb[6], rb[7]);
}
__device__ __forceinline__ void rope8l(bf16x8& a, bf16x8& b, const LAS float* cs) {
    const f32x4 c0 = *(const LAS f32x4*)cs, c1 = *(const LAS f32x4*)(cs + 4), c2 = *(const LAS f32x4*)(cs + 8), c3 = *(const LAS f32x4*)(cs + 12);
    const float cc[8] = {c0[0], c0[2], c1[0], c1[2], c2[0], c2[2], c3[0], c3[2]}, sn[8] = {c0[1], c0[3], c1[1], c1[3], c2[1], c2[3], c3[1], c3[3]};
    float ra[8], rb[8];
#pragma unroll
    for (int j = 0; j < 8; ++j) { const float x1 = bf2f((unsigned short)a[j]), x2 = bf2f((unsigned short)b[j]); ra[j] = x1 * cc[j] - x2 * sn[j]; rb[j] = x2 * cc[j] + x1 * sn[j]; }
    a = pack8(ra[0], ra[1], ra[2], ra[3], ra[4], ra[5], ra[6], ra[7]); b = pack8(rb[0], rb[1], rb[2], rb[3], rb[4], rb[5], rb[6], rb[7]);
}
__device__ __forceinline__ bf16x8 cvt8(const float* p) {
    const f32x4 a = *(const f32x4*)p, b = *(const f32x4*)(p + 4);
    return pack8(a[0], a[1], a[2], a[3], b[0], b[1], b[2], b[3]);
}

__device__ __forceinline__ void attn_unit(PP P, LAS unsigned char* lds, int l, int kind, int idx, int tid) {
    const int lane = tid & 63, wave = __builtin_amdgcn_readfirstlane(tid >> 6), r32 = lane & 31, hh = lane >> 5;
    const bf16* Z = (const bf16*)(P->ws + WS_Z); bf16* MIX = (bf16*)(P->ws + WS_H); const float* CS = (const float*)(P->ws + WS_CS);
    int b, h, qpos0, grow0, kpos0, klrow0, nloc, ncache;
    if (kind == 0) { b = idx >> 3; h = idx & 7; qpos0 = 0; grow0 = b * 256; kpos0 = 0; klrow0 = b * 256; nloc = 4; ncache = 0; }
    else { const int qb = idx & 7; h = (idx >> 3) & 7; b = idx >> 6; qpos0 = qb * 256; grow0 = NCTX + b * 2048 + qpos0;
        kpos0 = qpos0 - 128 < 0 ? 0 : qpos0 - 128; const int kend = qpos0 + 384 > 2048 ? 2048 : qpos0 + 384; nloc = (kend - kpos0) >> 6; klrow0 = NCTX + b * 2048 + kpos0; ncache = 4; }
    const bool lat = (kind == 1);
    const int kv = h >> 2;
    LAS float* CSL = (LAS float*)(lds + 65536);
    if (lat) {
#pragma unroll
        for (int k = 0; k < 2; ++k) *(LAS f32x4*)(CSL + 4 * (tid + 512 * k)) = *(const f32x4*)(CS + 4 * (tid + 512 * k));
        __syncthreads();
    }
    const int qrow = grow0 + 32 * wave + r32, qpos = qpos0 + 32 * wave + r32, qw0 = qpos0 + 32 * wave;
    bf16x8 qf[8];
    { const bf16* qp = Z + (size_t)qrow * DIN + C_AQ + h * 128 + 8 * hh;
#pragma unroll
      for (int s = 0; s < 8; ++s) qf[s] = *(const bf16x8*)(qp + 16 * s);
      if (lat) { const float* c0 = CS + ((qpos >> 6) * 32 + 8 * hh) * 2; const float* c1 = CS + ((qpos & 63) * 32 + 8 * hh) * 2;
          rope8(qf[0], qf[2], c0); rope8(qf[1], qf[3], c0 + 32); rope8(qf[4], qf[6], c1); rope8(qf[5], qf[7], c1 + 32); } }
    f32x16 O[4];
#pragma unroll
    for (int d = 0; d < 4; ++d)
#pragma unroll
        for (int i = 0; i < 16; ++i) O[d][i] = 0.f;
    float m = P->in[11][l * 8 + h] * LOG2E, lsum = (hh == 0) ? 1.0f : 0.0f;
    const int skey = tid >> 3, cp = tid & 7, c1 = (cp >> 2) * 8 + (cp & 3), sd0 = 8 * c1;
    const int ntiles = nloc + ncache;
    u32x4 rr[8];
#define ATT_ISSUE(TI) do { const int ti_ = (TI); \
        if (ti_ < nloc) { const int krow = klrow0 + 64 * ti_ + skey; const bf16* kp_ = Z + (size_t)krow * DIN + C_AK + kv * 128 + sd0; const bf16* vp_ = Z + (size_t)krow * DIN + C_AV + kv * 128 + sd0; \
            rr[0] = *(const u32x4*)kp_; rr[1] = *(const u32x4*)(kp_ + 32); rr[2] = *(const u32x4*)vp_; rr[3] = *(const u32x4*)(vp_ + 32); } \
        else { const int key = 64 * (ti_ - nloc) + skey; const size_t off = ((size_t)((b * 2 + l) * 256 + key) * 2 + kv) * 128 + sd0; const float* ck_ = P->in[2] + off; const float* cv_ = P->in[3] + off; \
            rr[0] = *(const u32x4*)ck_; rr[1] = *(const u32x4*)(ck_ + 4); rr[2] = *(const u32x4*)(ck_ + 32); rr[3] = *(const u32x4*)(ck_ + 36); \
            rr[4] = *(const u32x4*)cv_; rr[5] = *(const u32x4*)(cv_ + 4); rr[6] = *(const u32x4*)(cv_ + 32); rr[7] = *(const u32x4*)(cv_ + 36); } } while (0)
#define F4(x) __builtin_bit_cast(f32x4, x)
#define CV8(a, b) pack8(F4(a)[0], F4(a)[1], F4(a)[2], F4(a)[3], F4(b)[0], F4(b)[1], F4(b)[2], F4(b)[3])
    ATT_ISSUE(0);
    for (int ti = 0; ti < ntiles; ++ti) {
        {
            bf16x8 k1, k2, v1, v2;
            if (ti < nloc) { k1 = __builtin_bit_cast(bf16x8, rr[0]); k2 = __builtin_bit_cast(bf16x8, rr[1]); v1 = __builtin_bit_cast(bf16x8, rr[2]); v2 = __builtin_bit_cast(bf16x8, rr[3]);
                if (lat) { const int kpos = kpos0 + 64 * ti + skey; const int pos = (cp < 4) ? (kpos >> 6) : (kpos & 63); rope8l(k1, k2, CSL + (pos * 32 + 8 * (cp & 3)) * 2); } }
            else { k1 = CV8(rr[0], rr[1]); k2 = CV8(rr[2], rr[3]); v1 = CV8(rr[4], rr[5]); v2 = CV8(rr[6], rr[7]); }
            *(LAS bf16x8*)(lds + skey * KROW + sd0 * 2) = k1; *(LAS bf16x8*)(lds + skey * KROW + sd0 * 2 + 64) = k2;
            *(LAS bf16x8*)(lds + ATT_V_OFF + skey * VROW + sd0 * 2) = v1; *(LAS bf16x8*)(lds + ATT_V_OFF + skey * VROW + sd0 * 2 + 64) = v2;
        }
        __syncthreads();
        if (ti + 1 < ntiles) ATT_ISSUE(ti + 1);
        const bool local = lat && (ti < nloc);
        const int tk0 = kpos0 + 64 * ti;
        bool skip = false;
        if (local) skip = (tk0 > qw0 + 31 + 128) || (tk0 + 63 < qw0 - 128);
        if (!skip) {
            f32x16 p0, p1;
#pragma unroll
            for (int i = 0; i < 16; ++i) { p0[i] = 0.f; p1[i] = 0.f; }
            const LAS unsigned char* kb = lds + r32 * KROW + 16 * hh;
#pragma unroll
            for (int s = 0; s < 8; ++s) { const bf16x8 kf0 = *(const LAS bf16x8*)(kb + 32 * s), kf1 = *(const LAS bf16x8*)(kb + 32 * KROW + 32 * s);
                p0 = __builtin_amdgcn_mfma_f32_32x32x16_bf16(kf0, qf[s], p0, 0, 0, 0); p1 = __builtin_amdgcn_mfma_f32_32x32x16_bf16(kf1, qf[s], p1, 0, 0, 0); }
            const int i16 = lane & 15;
            const LAS unsigned char* vb = lds + ATT_V_OFF + (4 * hh + (i16 >> 2)) * VROW + (16 * ((lane >> 4) & 1) + 4 * (i16 & 3)) * 2;
            bf16x8 vfa[4], vfb[4];
#pragma unroll
            for (int ks = 0; ks < 4; ++ks) vfa[ks] = trpair(vb + (16 * ks) * VROW, 8 * VROW);
            float mx = -3e38f;
            if (local) { const unsigned mb = (unsigned)(qpos - tk0 - 4 * hh + 128);
#pragma unroll
                for (int i = 0; i < 16; ++i) { const unsigned d0 = mb - (unsigned)R0(i), d1 = d0 - 32u;
                    p0[i] = (d0 <= 256u) ? p0[i] : -1e30f; p1[i] = (d1 <= 256u) ? p1[i] : -1e30f; } }
#pragma unroll
            for (int i = 0; i < 16; ++i) mx = fmaxf(mx, fmaxf(p0[i], p1[i]));
            mx = fmaxf(mx, __shfl_xor(mx, 32)) * ATT_C2;
            const float mn = fmaxf(m, mx), alpha = __builtin_amdgcn_exp2f(m - mn); m = mn;
            float ps = 0.f;
#pragma unroll
            for (int i = 0; i < 16; ++i) { p0[i] = __builtin_amdgcn_exp2f(__builtin_fmaf(p0[i], ATT_C2, -mn)); p1[i] = __builtin_amdgcn_exp2f(__builtin_fmaf(p1[i], ATT_C2, -mn)); ps += p0[i] + p1[i]; }
            lsum = lsum * alpha + ps;
            if (__builtin_amdgcn_ballot_w64(alpha != 1.0f) != 0ull) {
#pragma unroll
                for (int d = 0; d < 4; ++d)
#pragma unroll
                    for (int i = 0; i < 16; ++i) O[d][i] *= alpha;
            }
            bf16x8 pb[4];
#pragma unroll
            for (int s = 0; s < 2; ++s) { pb[s] = pack8(p0[8 * s], p0[8 * s + 1], p0[8 * s + 2], p0[8 * s + 3], p0[8 * s + 4], p0[8 * s + 5], p0[8 * s + 6], p0[8 * s + 7]);
                pb[2 + s] = pack8(p1[8 * s], p1[8 * s + 1], p1[8 * s + 2], p1[8 * s + 3], p1[8 * s + 4], p1[8 * s + 5], p1[8 * s + 6], p1[8 * s + 7]); }
#pragma unroll
            for (int dt = 0; dt < 4; ++dt) {
                if (dt + 1 < 4) {
#pragma unroll
                    for (int ks = 0; ks < 4; ++ks) { const bf16x8 t_ = trpair(vb + (16 * ks) * VROW + 64 * (dt + 1), 8 * VROW); if (dt & 1) vfa[ks] = t_; else vfb[ks] = t_; }
                }
#pragma unroll
                for (int ks = 0; ks < 4; ++ks) O[dt] = __builtin_amdgcn_mfma_f32_32x32x16_bf16((dt & 1) ? vfb[ks] : vfa[ks], pb[ks], O[dt], 0, 0, 0);
            }
        }
        __syncthreads();
    }
    const float ltot = lsum + __shfl_xor(lsum, 32), inv = __builtin_amdgcn_rcpf(ltot);
    const bf16* gp = Z + (size_t)qrow * DIN + C_AG + h * 128 + 4 * hh; bf16* op = MIX + (size_t)qrow * D_MODEL + h * 128 + 4 * hh;
    u32x2 gg[16];
#pragma unroll
    for (int e = 0; e < 16; ++e) gg[e] = *(const u32x2*)(gp + 32 * (e >> 2) + 8 * (e & 3));
    __builtin_amdgcn_sched_barrier(0);
#pragma unroll
    for (int dt = 0; dt < 4; ++dt)
#pragma unroll
        for (int i4 = 0; i4 < 4; ++i4) { const int d0 = 32 * dt + 8 * i4; const u32x2 g = gg[dt * 4 + i4];
            const float o0 = O[dt][4 * i4 + 0] * inv * siluf_(bflo(g.x)), o1 = O[dt][4 * i4 + 1] * inv * siluf_(bfhi(g.x));
            const float o2 = O[dt][4 * i4 + 2] * inv * siluf_(bflo(g.y)), o3 = O[dt][4 * i4 + 3] * inv * siluf_(bfhi(g.y));
            u32x2 w; w.x = pk2(o0, o1); w.y = pk2(o2, o3); *(u32x2*)(op + d0) = w; }
#undef ATT_ISSUE
#undef F4
#undef CV8
}

__device__ __forceinline__ void hg_oml8(PP P, int l, int dir, int hd0, float (&oml)[8]) {
    const float* hb = P->in[12] + dir * 1024 + hd0;
    const f32x4 a0 = *(const f32x4*)hb, a1 = *(const f32x4*)(hb + 4), b0 = *(const f32x4*)(hb + 512), b1 = *(const f32x4*)(hb + 516);
#pragma unroll
    for (int j = 0; j < 4; ++j) { const float s0 = sigmoidf_(b0[j] - a0[j]), s1 = sigmoidf_(b1[j] - a1[j]); oml[j] = l ? 1.0f - s0 : 1.0f; oml[4 + j] = l ? 1.0f - s1 : 1.0f; }
}
constexpr int H2_TG = 0, H2_QE = 16896, H2_KE = 25600, H2_QG = 34304, H2_KG = 42752, H2_V = 52992, H2_OBA = 63232, H2_OBB = 80128, H2_DK = 97024;
constexpr size_t WS_DLC_OFF = 0;
__device__ __forceinline__ void hgrn2_unit(PP P, LAS unsigned char* lds, int l, int kind, int idx, int tid) {
    const int lane = tid & 63, wave = __builtin_amdgcn_readfirstlane(tid >> 6), r32 = lane & 31, hh = lane >> 5, i16 = lane & 15, cg = (lane >> 4) & 1;
    const bf16* Z = (const bf16*)(P->ws + WS_Z); bf16* MIX = (bf16*)(P->ws + WS_H); float* OL = (float*)(P->ws + WS_OL);
    LAS float* ldsf = (LAS float*)lds;
    int h, row0, seglen, nch, b = 0;
    if (kind == 0) { b = idx >> 2; h = idx & 3; row0 = b * 256; seglen = 256; nch = 8; }
    else { const int blk = idx & 15; h = (idx >> 4) & 3; const int lb = idx >> 6; row0 = NCTX + lb * 2048 + blk * 128; seglen = 128; nch = 4; }
    const int ti = tid >> 4, d0 = 8 * (tid & 15), nt = wave & 3, kp = wave >> 2;
    const f32x4 n0 = *(const f32x4*)(P->in[13] + l * 512 + h * 128 + d0), n1 = *(const f32x4*)(P->in[13] + l * 512 + h * 128 + d0 + 4);
    for (int dir = 0; dir < 2; ++dir) {
        float oml[8]; hg_oml8(P, l, dir, h * 128 + d0, oml);
        const int cf = dir ? C_HFB : C_HFF;
        f32x16 S0, S1;
#pragma unroll
        for (int i = 0; i < 16; ++i) { S0[i] = 0.f; S1[i] = 0.f; }
        const int uidx = (kind == 1) ? ((idx >> 4) * 2 + dir) * 16 + (idx & 15) : 0;
        u32x4 uq, uv, uf;
        { const int row = dir ? row0 + seglen - 1 - ti : row0 + ti; const bf16* zr = Z + (size_t)row * DIN + h * 128 + d0;
          uq = *(const u32x4*)(zr + C_HQ); uv = *(const u32x4*)(zr + C_HI); uf = *(const u32x4*)(zr + cf); }
        for (int c = 0; c < nch; ++c) {
            const int nc = dir ? nch - 1 - c : c; const int rown = row0 + 32 * nc + ti;
            f32x4 olp0 = {0.f, 0.f, 0.f, 0.f}, olp1 = {0.f, 0.f, 0.f, 0.f}; u32x4 ug = {0u, 0u, 0u, 0u};
            float* olr = OL + (size_t)rown * 512 + h * 128 + d0;
            if (dir == 1) { olp0 = *(const f32x4*)olr; olp1 = *(const f32x4*)(olr + 4); if (kind == 0) ug = *(const u32x4*)(Z + (size_t)rown * DIN + C_HG + h * 128 + d0); }
            float q[8], kk[8];
            {
                float g2[8], vv[8];
#pragma unroll
                for (int j = 0; j < 4; ++j) { const unsigned wq = uq[j], wv = uv[j], wf = uf[j];
                    q[2 * j] = siluf_(bflo(wq)) * 0.08838834764831845f; q[2 * j + 1] = siluf_(bfhi(wq)) * 0.08838834764831845f;
                    vv[2 * j] = bflo(wv); vv[2 * j + 1] = bfhi(wv);
                    kk[2 * j] = oml[2 * j] * sigmoidf_(-bflo(wf)); kk[2 * j + 1] = oml[2 * j + 1] * sigmoidf_(-bfhi(wf)); }
#pragma unroll
                for (int j = 0; j < 8; ++j) g2[j] = __builtin_amdgcn_logf(1.0f - fminf(kk[j], 1.0f - 1e-6f));
                LAS float* pg = ldsf + (H2_TG >> 2) + ti * 132 + d0;
                *(LAS f32x4*)pg = (f32x4){g2[0], g2[1], g2[2], g2[3]}; *(LAS f32x4*)(pg + 4) = (f32x4){g2[4], g2[5], g2[6], g2[7]};
                *(LAS u32x4*)(lds + H2_V + ti * 320 + d0 * 2) = uv;
            }
            if (c + 1 < nch) { const int tl = 32 * (c + 1) + ti; const int row = dir ? row0 + seglen - 1 - tl : row0 + tl; const bf16* zr = Z + (size_t)row * DIN + h * 128 + d0;
                uq = *(const u32x4*)(zr + C_HQ); uv = *(const u32x4*)(zr + C_HI); uf = *(const u32x4*)(zr + cf); }
            __syncthreads();
            if (tid < 128) {
                LAS float* gc = ldsf + (H2_TG >> 2) + tid; float run = 0.f; float gv[32];
#pragma unroll
                for (int i = 0; i < 32; ++i) gv[i] = gc[i * 132];
                SBAR
#pragma unroll
                for (int i = 0; i < 32; ++i) { run += gv[i]; gc[i * 132] = run; }
                ldsf[(H2_DK >> 2) + tid] = __builtin_amdgcn_exp2f(run);
                if (kind == 1) ((float*)(P->ws + WS_DLOG))[(uidx * 4 + c) * 128 + tid] = run;
            }
            __syncthreads();
            {
                const LAS float* gr = ldsf + (H2_TG >> 2) + ti * 132 + d0; const LAS float* gm = ldsf + (H2_TG >> 2) + 15 * 132 + d0; const LAS float* gl = ldsf + (H2_TG >> 2) + 31 * 132 + d0;
                float qe[8], ke[8], qg[8], kg[8];
#pragma unroll
                for (int j = 0; j < 8; ++j) { const float G = gr[j], Gm = gm[j], Gl = gl[j];
                    qe[j] = q[j] * __builtin_amdgcn_exp2f(fminf(G - Gm, 100.f)); ke[j] = kk[j] * __builtin_amdgcn_exp2f(fminf(Gm - G, 100.f));
                    qg[j] = q[j] * __builtin_amdgcn_exp2f(G); kg[j] = kk[j] * __builtin_amdgcn_exp2f(Gl - G); }
                *(LAS bf16x8*)(lds + H2_QE + ti * 272 + d0 * 2) = pack8(qe[0], qe[1], qe[2], qe[3], qe[4], qe[5], qe[6], qe[7]);
                *(LAS bf16x8*)(lds + H2_KE + ti * 272 + d0 * 2) = pack8(ke[0], ke[1], ke[2], ke[3], ke[4], ke[5], ke[6], ke[7]);
                *(LAS bf16x8*)(lds + H2_KG + ti * 320 + d0 * 2) = pack8(kg[0], kg[1], kg[2], kg[3], kg[4], kg[5], kg[6], kg[7]);
                u32x2 w0, w1; w0.x = pk2(qg[0], qg[1]); w0.y = pk2(qg[2], qg[3]); w1.x = pk2(qg[4], qg[5]); w1.y = pk2(qg[6], qg[7]);
                *(LAS u32x2*)(lds + H2_QG + ti * 264 + d0 * 2) = w0; *(LAS u32x2*)(lds + H2_QG + ti * 264 + d0 * 2 + 8) = w1;
            }
            __syncthreads();
            {
                f32x16 at;
#pragma unroll
                for (int i = 0; i < 16; ++i) at[i] = 0.f;
                const LAS unsigned char* kep = lds + H2_KE + r32 * 272 + 16 * hh; const LAS unsigned char* qep = lds + H2_QE + r32 * 272 + 16 * hh;
#pragma unroll
                for (int k = 0; k < 8; ++k) at = __builtin_amdgcn_mfma_f32_32x32x16_bf16(*(const LAS bf16x8*)(kep + 32 * k), *(const LAS bf16x8*)(qep + 32 * k), at, 0, 0, 0);
                float am[8];
#pragma unroll
                for (int j = 0; j < 8; ++j) { const float lo = at[j], hi = at[8 + j]; const float v = kp ? hi : lo; const int s = 16 * kp + 8 * (j >> 2) + 4 * hh + (j & 3); am[j] = (s <= r32) ? v : 0.f; }
                const bf16x8 afrag = pack8(am[0], am[1], am[2], am[3], am[4], am[5], am[6], am[7]);
                f32x16 ot;
#pragma unroll
                for (int i = 0; i < 16; ++i) ot[i] = 0.f;
                { const bf16x8 vfrag = trpair(lds + H2_V + (16 * kp + 4 * hh + (i16 >> 2)) * 320 + (32 * nt + 16 * cg + 4 * (i16 & 3)) * 2, 8 * 320);
                  ot = __builtin_amdgcn_mfma_f32_32x32x16_bf16(vfrag, afrag, ot, 0, 0, 0); }
                const LAS unsigned char* qgp = lds + H2_QG + r32 * 264 + (64 * kp + 4 * hh) * 2;
#pragma unroll
                for (int kl = 0; kl < 2; ++kl)
#pragma unroll
                    for (int sp = 0; sp < 2; ++sp) {
                        const u32x2 qlo = *(const LAS u32x2*)(qgp + (32 * kl + 16 * sp) * 2), qhi = *(const LAS u32x2*)(qgp + (32 * kl + 16 * sp) * 2 + 16);
                        const u32x4 qq = {qlo.x, qlo.y, qhi.x, qhi.y};
                        bf16x8 sfrag;
                        if (kl == 0) sfrag = pack8(S0[8 * sp], S0[8 * sp + 1], S0[8 * sp + 2], S0[8 * sp + 3], S0[8 * sp + 4], S0[8 * sp + 5], S0[8 * sp + 6], S0[8 * sp + 7]);
                        else sfrag = pack8(S1[8 * sp], S1[8 * sp + 1], S1[8 * sp + 2], S1[8 * sp + 3], S1[8 * sp + 4], S1[8 * sp + 5], S1[8 * sp + 6], S1[8 * sp + 7]);
                        ot = __builtin_amdgcn_mfma_f32_32x32x16_bf16(sfrag, __builtin_bit_cast(bf16x8, qq), ot, 0, 0, 0);
                    }
                { LAS float* ob = ldsf + ((kp ? H2_OBB : H2_OBA) >> 2) + (32 * nt + 4 * hh) * 33 + r32;
#pragma unroll
                  for (int i = 0; i < 16; ++i) ob[R0(i) * 33] = ot[i]; }
                const LAS float* dkp = ldsf + (H2_DK >> 2) + 64 * kp + 4 * hh;
#pragma unroll
                for (int i = 0; i < 16; ++i) { S0[i] *= dkp[R0(i)]; S1[i] *= dkp[32 + R0(i)]; }
#pragma unroll
                for (int ks = 0; ks < 2; ++ks) {
                    const int roff = (16 * ks + 8 * hh + (i16 >> 2)) * 320, coff = (16 * cg + 4 * (i16 & 3)) * 2;
                    const bf16x8 vf = trpair(lds + H2_V + roff + 64 * nt + coff, 4 * 320);
                    const bf16x8 k0 = trpair(lds + H2_KG + roff + 64 * (2 * kp) + coff, 4 * 320), k1 = trpair(lds + H2_KG + roff + 64 * (2 * kp + 1) + coff, 4 * 320);
                    S0 = __builtin_amdgcn_mfma_f32_32x32x16_bf16(k0, vf, S0, 0, 0, 0); S1 = __builtin_amdgcn_mfma_f32_32x32x16_bf16(k1, vf, S1, 0, 0, 0);
                }
            }
            __syncthreads();
            {
                const int t = dir ? 31 - ti : ti;
                const LAS float* oa = ldsf + (H2_OBA >> 2) + d0 * 33 + t; const LAS float* obb = ldsf + (H2_OBB >> 2) + d0 * 33 + t;
                float o[8];
#pragma unroll
                for (int j = 0; j < 8; ++j) o[j] = oa[j * 33] + obb[j * 33];
                if (dir == 1) { o[0] += olp0[0]; o[1] += olp0[1]; o[2] += olp0[2]; o[3] += olp0[3]; o[4] += olp1[0]; o[5] += olp1[1]; o[6] += olp1[2]; o[7] += olp1[3]; }
                if (dir == 0 || kind == 1) { *(f32x4*)olr = (f32x4){o[0], o[1], o[2], o[3]}; *(f32x4*)(olr + 4) = (f32x4){o[4], o[5], o[6], o[7]}; }
                else {
                    float ss = 0.f;
#pragma unroll
                    for (int j = 0; j < 8; ++j) ss += o[j] * o[j];
                    ss += __shfl_xor(ss, 1); ss += __shfl_xor(ss, 2); ss += __shfl_xor(ss, 4); ss += __shfl_xor(ss, 8);
                    const float r = __builtin_amdgcn_rsqf(ss * (1.0f / 128.0f) + 1e-6f);
                    u32x4 w;
                    w.x = pk2(o[0] * r * n0[0] * siluf_(bflo(ug.x)), o[1] * r * n0[1] * siluf_(bfhi(ug.x))); w.y = pk2(o[2] * r * n0[2] * siluf_(bflo(ug.y)), o[3] * r * n0[3] * siluf_(bfhi(ug.y)));
                    w.z = pk2(o[4] * r * n1[0] * siluf_(bflo(ug.z)), o[5] * r * n1[1] * siluf_(bfhi(ug.z))); w.w = pk2(o[6] * r * n1[2] * siluf_(bflo(ug.w)), o[7] * r * n1[3] * siluf_(bfhi(ug.w)));
                    *(u32x4*)(MIX + (size_t)rown * D_MODEL + 1024 + h * 128 + d0) = w;
                }
            }
        }
        {
            float* Sd = (kind == 0) ? P->out + OUT_ST + (size_t)((((b * 2 + l) * 2 + dir) * 4 + h)) * 16384 : (float*)(P->ws + WS_U) + (size_t)uidx * 16384;
            float* sp = Sd + (64 * kp + 4 * hh) * 128 + 32 * nt + r32;
#pragma unroll
            for (int i = 0; i < 16; ++i) { sp[R0(i) * 128] = S0[i]; sp[(32 + R0(i)) * 128] = S1[i]; }
        }
    }
}

__device__ __forceinline__ void hgrn_scan(PP P, int l, int tid) {
    float* U = (float*)(P->ws + WS_U); const float* DLC = (const float*)(P->ws + WS_DLOG);
    for (int e = blockIdx.x * NTHREADS + tid; e < 16 * 16384; e += gridDim.x * NTHREADS) {
        const int sq = e >> 14, el = e & 16383, dk = el >> 7, lb = sq >> 3, h = (sq >> 1) & 3, dir = sq & 1;
        float S = P->in[4][(size_t)((((lb * 2 + l) * 2 + dir) * 4 + h)) * 16384 + el];
        float u[16], dl[16];
#pragma unroll
        for (int p = 0; p < 16; ++p) { const int blk = dir ? 15 - p : p; const int uidx = sq * 16 + blk; u[p] = U[(size_t)uidx * 16384 + el];
            const float* d = DLC + (uidx * 4) * 128 + dk; dl[p] = (d[0] + d[128]) + (d[256] + d[384]); }
#pragma unroll
        for (int p = 0; p < 16; ++p) { const int blk = dir ? 15 - p : p; const int uidx = sq * 16 + blk; U[(size_t)uidx * 16384 + el] = S; S = __builtin_amdgcn_exp2f(dl[p]) * S + u[p]; }
    }
}

constexpr int HF_S0 = 0, HF_S1 = 40960, HF_TG0 = 81920, HF_TG1 = 98816, HF_QG0 = 115712, HF_QG1 = 124416;
__device__ __forceinline__ void hgrn_final_unit(PP P, LAS unsigned char* lds, int l, int idx, int half_sel, int tid) {
    const int lane = tid & 63, wave = __builtin_amdgcn_readfirstlane(tid >> 6), r32 = lane & 31, hh = lane >> 5, i16 = lane & 15, cg = (lane >> 4) & 1;
    const bf16* Z = (const bf16*)(P->ws + WS_Z); bf16* MIX = (bf16*)(P->ws + WS_H); const float* OL = (const float*)(P->ws + WS_OL); const float* DLC = (const float*)(P->ws + WS_DLOG);
    LAS float* ldsf = (LAS float*)lds;
    const int blk = idx & 15, h = (idx >> 4) & 3, lb = idx >> 6, row0 = NCTX + lb * 2048 + blk * 128;
    const int ti = tid >> 4, d0 = 8 * (tid & 15), nt = wave & 3, ds = wave >> 2;
    const int uidx0 = ((idx >> 4) * 2 + 0) * 16 + blk, uidx1 = ((idx >> 4) * 2 + 1) * 16 + blk;
#pragma unroll
    for (int half = 0; half < 2; ++half) {
        f32x4 sv[8];
#pragma unroll
        for (int k = 0; k < 8; ++k) { const int id = tid + 512 * (k + 8 * half), dsel = id >> 12, dk = (id >> 5) & 127, c4 = id & 31;
            sv[k] = *(const f32x4*)((const float*)(P->ws + WS_U) + (size_t)(dsel ? uidx1 : uidx0) * 16384 + dk * 128 + c4 * 4); }
#pragma unroll
        for (int k = 0; k < 8; ++k) { const int id = tid + 512 * (k + 8 * half), dsel = id >> 12, dk = (id >> 5) & 127, c4 = id & 31;
            u32x2 w; w.x = pk2(sv[k][0], sv[k][1]); w.y = pk2(sv[k][2], sv[k][3]); *(LAS u32x2*)(lds + (dsel ? HF_S1 : HF_S0) + dk * 320 + c4 * 8) = w; }
    }
    float oml0[8], oml1[8]; hg_oml8(P, l, 0, h * 128 + d0, oml0); hg_oml8(P, l, 1, h * 128 + d0, oml1);
    const f32x4 n0 = *(const f32x4*)(P->in[13] + l * 512 + h * 128 + d0), n1 = *(const f32x4*)(P->in[13] + l * 512 + h * 128 + d0 + 4);
    float carry = 0.f;
    if (tid < 128) { for (int c = 0; c < 2 * half_sel; ++c) carry += DLC[(uidx0 * 4 + c) * 128 + tid]; }
    for (int nc = 2 * half_sel; nc < 2 * half_sel + 2; ++nc) {
        const int rown = row0 + 32 * nc + ti; const bf16* zr = Z + (size_t)rown * DIN + h * 128 + d0;
        const u32x4 uq = *(const u32x4*)(zr + C_HQ), uf0 = *(const u32x4*)(zr + C_HFF), uf1 = *(const u32x4*)(zr + C_HFB), ug = *(const u32x4*)(zr + C_HG);
        const float* olr = OL + (size_t)rown * 512 + h * 128 + d0; const f32x4 olp0 = *(const f32x4*)olr, olp1 = *(const f32x4*)(olr + 4);
        float off1 = 0.f;
        if (tid >= 128 && tid < 256) { for (int c = 0; c < 3 - nc; ++c) off1 += DLC[(uidx1 * 4 + c) * 128 + (tid - 128)]; }
        float q[8];
        {
            float ga[8], gb[8];
#pragma unroll
            for (int j = 0; j < 4; ++j) { const unsigned wq = uq[j], wa = uf0[j], wb = uf1[j];
                q[2 * j] = siluf_(bflo(wq)) * 0.08838834764831845f; q[2 * j + 1] = siluf_(bfhi(wq)) * 0.08838834764831845f;
                ga[2 * j] = oml0[2 * j] * sigmoidf_(-bflo(wa)); ga[2 * j + 1] = oml0[2 * j + 1] * sigmoidf_(-bfhi(wa));
                gb[2 * j] = oml1[2 * j] * sigmoidf_(-bflo(wb)); gb[2 * j + 1] = oml1[2 * j + 1] * sigmoidf_(-bfhi(wb)); }
#pragma unroll
            for (int j = 0; j < 8; ++j) { ga[j] = __builtin_amdgcn_logf(1.0f - fminf(ga[j], 1.0f - 1e-6f)); gb[j] = __builtin_amdgcn_logf(1.0f - fminf(gb[j], 1.0f - 1e-6f)); }
            LAS float* p0 = ldsf + (HF_TG0 >> 2) + ti * 132 + d0; LAS float* p1 = ldsf + (HF_TG1 >> 2) + ti * 132 + d0;
            *(LAS f32x4*)p0 = (f32x4){ga[0], ga[1], ga[2], ga[3]}; *(LAS f32x4*)(p0 + 4) = (f32x4){ga[4], ga[5], ga[6], ga[7]};
            *(LAS f32x4*)p1 = (f32x4){gb[0], gb[1], gb[2], gb[3]}; *(LAS f32x4*)(p1 + 4) = (f32x4){gb[4], gb[5], gb[6], gb[7]};
        }
        __syncthreads();
        if (tid < 256) { const bool rev = tid >= 128; LAS float* gc = ldsf + ((rev ? HF_TG1 : HF_TG0) >> 2) + (tid & 127); float run = rev ? off1 : carry; float gv[32];
#pragma unroll
            for (int i = 0; i < 32; ++i) gv[i] = gc[(rev ? 31 - i : i) * 132];
            SBAR
#pragma unroll
            for (int i = 0; i < 32; ++i) { run += gv[i]; gc[(rev ? 31 - i : i) * 132] = run; }
            if (!rev) carry = run; }
        __syncthreads();
        {
            const LAS float* g0 = ldsf + (HF_TG0 >> 2) + ti * 132 + d0; const LAS float* g1 = ldsf + (HF_TG1 >> 2) + ti * 132 + d0;
            float a[8], c[8];
#pragma unroll
            for (int j = 0; j < 8; ++j) { a[j] = q[j] * __builtin_amdgcn_exp2f(g0[j]); c[j] = q[j] * __builtin_amdgcn_exp2f(g1[j]); }
            *(LAS bf16x8*)(lds + HF_QG0 + ti * 272 + d0 * 2) = pack8(a[0], a[1], a[2], a[3], a[4], a[5], a[6], a[7]);
            *(LAS bf16x8*)(lds + HF_QG1 + ti * 272 + d0 * 2) = pack8(c[0], c[1], c[2], c[3], c[4], c[5], c[6], c[7]);
        }
        __syncthreads();
        {
            f32x16 acc;
#pragma unroll
            for (int i = 0; i < 16; ++i) acc[i] = 0.f;
            const LAS unsigned char* qp = lds + (ds ? HF_QG1 : HF_QG0) + r32 * 272 + 16 * hh;
            const LAS unsigned char* sp = lds + (ds ? HF_S1 : HF_S0) + (8 * hh + (i16 >> 2)) * 320 + (32 * nt + 16 * cg + 4 * (i16 & 3)) * 2;
#pragma unroll
            for (int k = 0; k < 8; ++k) { const bf16x8 sf = trpair(sp + 16 * k * 320, 4 * 320); acc = __builtin_amdgcn_mfma_f32_32x32x16_bf16(*(const LAS bf16x8*)(qp + 32 * k), sf, acc, 0, 0, 0); }
            LAS float* ob = ldsf + ((ds ? HF_TG1 : HF_TG0) >> 2) + (4 * hh) * 132 + 32 * nt + r32;
#pragma unroll
            for (int i = 0; i < 16; ++i) ob[R0(i) * 132] = acc[i];
        }
        __syncthreads();
        {
            const LAS float* oa = ldsf + (HF_TG0 >> 2) + ti * 132 + d0; const LAS float* obb = ldsf + (HF_TG1 >> 2) + ti * 132 + d0;
            const f32x4 a0 = *(const LAS f32x4*)oa, a1 = *(const LAS f32x4*)(oa + 4), b0 = *(const LAS f32x4*)obb, b1 = *(const LAS f32x4*)(obb + 4);
            const f32x4 o0 = a0 + b0 + olp0, o1 = a1 + b1 + olp1;
            float ss = (o0[0] * o0[0] + o0[1] * o0[1]) + (o0[2] * o0[2] + o0[3] * o0[3]) + (o1[0] * o1[0] + o1[1] * o1[1]) + (o1[2] * o1[2] + o1[3] * o1[3]);
            ss += __shfl_xor(ss, 1); ss += __shfl_xor(ss, 2); ss += __shfl_xor(ss, 4); ss += __shfl_xor(ss, 8);
            const float r = __builtin_amdgcn_rsqf(ss * (1.0f / 128.0f) + 1e-6f);
            u32x4 w;
            w.x = pk2(o0[0] * r * n0[0] * siluf_(bflo(ug.x)), o0[1] * r * n0[1] * siluf_(bfhi(ug.x))); w.y = pk2(o0[2] * r * n0[2] * siluf_(bflo(ug.y)), o0[3] * r * n0[3] * siluf_(bfhi(ug.y)));
            w.z = pk2(o1[0] * r * n1[0] * siluf_(bflo(ug.z)), o1[1] * r * n1[1] * siluf_(bfhi(ug.z))); w.w = pk2(o1[2] * r * n1[2] * siluf_(bflo(ug.w)), o1[3] * r * n1[3] * siluf_(bfhi(ug.w)));
            *(u32x4*)(MIX + (size_t)rown * D_MODEL + 1024 + h * 128 + d0) = w;
        }
        __syncthreads();
    }
}

#define RLX_AGENT __ATOMIC_RELAXED, __HIP_MEMORY_SCOPE_AGENT
#define XB_TMO      128
#define XB_XCNT(j)  (256  + 64 * (j))
#define XB_XSUB(j)  (1280 + 64 * (j))
#define XB_XGEN(j)  (2304 + 64 * (j))
#define XB_TOP      3328
#define XB_TOPGEN   3392
#define XCD_BAR_WORDS 3456
#define XB_SPIN_CAP (1u << 18)

__device__ __forceinline__ unsigned xb_ld(unsigned* p)              { return __hip_atomic_load(p, __ATOMIC_RELAXED, __HIP_MEMORY_SCOPE_AGENT); }
__device__ __forceinline__ unsigned xb_add(unsigned* p, unsigned v) { return __hip_atomic_fetch_add(p, v, __ATOMIC_RELAXED, __HIP_MEMORY_SCOPE_AGENT); }
__device__ __forceinline__ unsigned xb_xcc_id() { return (unsigned)__builtin_amdgcn_s_getreg((3 << 11) | 20) & 0xFu; }
#define XB_SPIN(cond, bar) do { unsigned _sp = 0; while (cond) { __builtin_amdgcn_s_sleep(1); \
    if ((++_sp & 255u) == 0u) { if (xb_ld(&(bar)[XB_TMO])) break; if (_sp > XB_SPIN_CAP) { atomicAdd(&(bar)[XB_TMO], 1u); break; } } } } while (0)

struct XcdBarrier {
    unsigned* bar; unsigned x; bool t0;
    volatile LAS unsigned* st;
};

__device__ __forceinline__ XcdBarrier xcd_barrier_post(unsigned* bar, volatile LAS unsigned* st) {
    XcdBarrier b; b.bar = bar; b.x = xb_xcc_id(); b.st = st; b.t0 = (threadIdx.x == 0);
    if (threadIdx.x == 0) (void)xb_add(&bar[XB_XCNT(b.x)], 1u);
    return b;
}
__device__ __forceinline__ void xcd_barrier_complete(unsigned* bar, unsigned x, unsigned& nloc, unsigned& nx) {
    const unsigned G = gridDim.x * gridDim.y * gridDim.z;
    unsigned sum, cnt, mine, sp = 0u;
    for (;;) {
        sum = 0u; cnt = 0u; mine = 0u;
#pragma unroll
        for (unsigned j = 0; j < 16; ++j) { const unsigned c = xb_ld(&bar[XB_XCNT(j)]); sum += c; cnt += (c > 0u) ? 1u : 0u; mine = (j == x) ? c : mine; }
        if (sum == G) break;
        __builtin_amdgcn_s_sleep(1);
        if ((++sp & 255u) == 0u) { if (xb_ld(&bar[XB_TMO])) break; if (sp > XB_SPIN_CAP) { atomicAdd(&bar[XB_TMO], 1u); break; } }
    }
    nloc = mine > 0u ? mine : 1u; nx = cnt > 0u ? cnt : 1u;
}

__device__ __forceinline__ void xcd_barrier(const XcdBarrier& b) {
    asm volatile("s_waitcnt vmcnt(0)" ::: "memory");
    __syncthreads();
    if (b.t0) {
        unsigned* bar = b.bar;
        __builtin_amdgcn_s_waitcnt(0);
        unsigned nloc = b.st[0], nx = b.st[1];
        if (nloc == 0u) { xcd_barrier_complete(bar, b.x, nloc, nx); b.st[0] = nloc; b.st[1] = nx; }
        const unsigned old = xb_add(&bar[XB_XSUB(b.x)], 1u);
        const unsigned gen = old / nloc;
        if (old + 1u == (gen + 1u) * nloc) {
            __builtin_amdgcn_fence(__ATOMIC_RELEASE, "agent");
            asm volatile("s_waitcnt vmcnt(0)" ::: "memory");
            const unsigned og = xb_add(&bar[XB_TOP], 1u);
            const unsigned tg = og / nx;
            if (og + 1u == (tg + 1u) * nx) xb_add(&bar[XB_TOPGEN], 1u);
            else XB_SPIN(xb_ld(&bar[XB_TOPGEN]) == tg, bar);
            __builtin_amdgcn_fence(__ATOMIC_ACQUIRE, "agent");
            xb_add(&bar[XB_XGEN(b.x)], 1u);
            asm volatile("s_waitcnt vmcnt(0)" ::: "memory");
        } else {
            XB_SPIN(xb_ld(&bar[XB_XGEN(b.x)]) == gen, bar);
            __builtin_amdgcn_fence(__ATOMIC_ACQUIRE, "agent");
            asm volatile("s_waitcnt vmcnt(0)" ::: "memory");
        }
    }
    __syncthreads();
}

#ifndef REP_P0
#define REP_P0 1
#endif
#ifndef REP_P1
#define REP_P1 1
#endif
#ifndef REP_P2
#define REP_P2 1
#endif
#ifndef P0_MASK
#define P0_MASK 3
#endif
#ifndef P2_MASK
#define P2_MASK 31
#endif
#ifndef REP_P3
#define REP_P3 1
#endif
#ifndef REP_P4
#define REP_P4 1
#endif
__global__ void __launch_bounds__(NTHREADS, 2) fwd_kernel(Params Pkarg) {
    extern __shared__ __attribute__((aligned(16))) unsigned char lds_raw[];
    cg::grid_group grid = cg::this_grid();
    LAS unsigned char* lds = (LAS unsigned char*)lds_raw;
    LAS float* ldsf = (LAS float*)lds;
    volatile LAS unsigned* qslot = (volatile LAS unsigned*)(lds + 131072 + 1024);
    volatile LAS unsigned* xbst = (volatile LAS unsigned*)(lds + 131072 + 2048);
    if (threadIdx.x < 2) xbst[threadIdx.x] = 0u;
    __syncthreads();
    (void)xcd_barrier_post((unsigned*)(Pkarg.ws + WS_CTL) + 1024, xbst);
#define GSYNC() do { PP Pb_ = (PP)__builtin_amdgcn_kernarg_segment_ptr(); asm volatile("" : "+s"(Pb_)); XcdBarrier xb_; xb_.bar = (unsigned*)(Pb_->ws + WS_CTL) + 1024; xb_.x = xb_xcc_id(); xb_.st = xbst; int ln_; asm volatile("v_mbcnt_lo_u32_b32 %0, -1, 0\n\tv_mbcnt_hi_u32_b32 %0, -1, %0" : "=v"(ln_)); xb_.t0 = (wave_s == 0) && (ln_ == 0); xcd_barrier(xb_); } while (0)
    const int wave_s = __builtin_amdgcn_readfirstlane(threadIdx.x >> 6);
#define PHASE_IDS int tid; asm volatile("v_mbcnt_lo_u32_b32 %0, -1, 0\n\tv_mbcnt_hi_u32_b32 %0, -1, %0" : "=v"(tid)); tid += wave_s * 64; const int lane = tid & 63, wave = wave_s, gw = blockIdx.x * NWAVES + wave; (void)lane; (void)gw; \
    PP P = (PP)__builtin_amdgcn_kernarg_segment_ptr(); asm volatile("" : "+s"(P)); unsigned char* ws = P->ws; unsigned* ctl = (unsigned*)(ws + WS_CTL); float* MOD = (float*)(ws + WS_MOD); \
    bf16* H = (bf16*)(ws + WS_H); bf16* Z = (bf16*)(ws + WS_Z); bf16* WTIN = (bf16*)(ws + WS_WTIN); bf16* WTOUT = (bf16*)(ws + WS_WTOUT); const float* xp = P->in[0]; const float* xs = P->in[1]; \
    (void)ctl; (void)MOD; (void)H; (void)Z; (void)WTIN; (void)WTOUT; (void)xp; (void)xs;
    const int G = gridDim.x, NGW = G * NWAVES;

    for (int rep = 0; rep < REP_P0; ++rep) {
        PHASE_IDS
        const int m0 = (rep == 0) ? 3 : P0_MASK;
        if (m0 & 1) for (int u = blockIdx.x; u < 384; u += G) mod_unit(P, ldsf, u / 192, u % 192, tid);
        LAS float* scr = ldsf + wave * 4096;
        if (m0 & 2) for (int it = gw; it < 6656 + 2048 + 2048; it += NGW) {
            if (it < 6656) transpose_item(P->in[9], 2048, DIN, WTIN, scr, it, lane);
            else if (it < 6656 + 2048) transpose_item(P->in[10], 2048, 2048, WTOUT, scr, it - 6656, lane);
            else transpose_item(P->in[10] + (size_t)2048 * 2048, 2048, 2048, WTOUT + (size_t)2048 * 2048, scr, it - 6656 - 2048, lane);
        }
        const int gt = blockIdx.x * NTHREADS + tid;
        if (gt < 2048) { const int pos = gt >> 5, i = gt & 31; const float inv = powf(10000.0f, -(float)i / 32.0f); const float ang = (float)pos * inv;
            float sn, cs; sincosf(ang, &sn, &cs); float* CS = (float*)(ws + WS_CS); CS[gt * 2] = cs; CS[gt * 2 + 1] = sn; }
        grid.sync();
    }
    { PHASE_IDS
    for (int row = gw; row < MTOK; row += NGW) {
        const int cond = (row < NCTX) ? 0 : 1 + ((row - NCTX) >> 11);
        const float* xrow = (row < NCTX) ? xp + (size_t)row * D_MODEL : xs + (size_t)(row - NCTX) * D_MODEL;
        hprep_row(xrow, MOD + (0 * 3 + cond) * 6144, H + (size_t)row * D_MODEL, lane);
    } }
    GSYNC();

    for (int l = 0; l < DEPTH; ++l) {
        for (int rep = 0; rep < REP_P1; ++rep) {
            PHASE_IDS
            pg8::Gemm g{H, WTIN, MTOK, DIN, D_MODEL}; pg8::StaticOrder S; S.init(MTOK, DIN, D_MODEL, G, (int)blockIdx.x);
            pg8::EpiZ E{Z, P->out + OUT_CK, P->out + OUT_CV, l};
            pg8::gemm_phase<pg8::EpiZ, pg8::StaticOrder, true, true>(lds, g, S, E, tid);
            GSYNC();
        }
        for (int rep = 0; rep < REP_P2; ++rep) {
            PHASE_IDS
            unsigned* ctr = ctl + 64 * (l * 2 + 0 + 4 * rep);
            const int n_cvt = (l == 0) ? 832 : 0;
            const int msk = (rep == 0) ? 31 : P2_MASK;
            unsigned pend = 0u;
            for (int u = q_first(ctr, qslot, tid, pend); u < 1408 + n_cvt; u = q_next(ctr, qslot, tid, pend)) {
                asm volatile("" : "+v"(tid));
                if (u < 128) { if (msk & 2) attn_unit(P, lds, l, 1, u, tid); continue; } u -= 128;
                if (u < 128) { if (msk & 1) hgrn2_unit(P, lds, l, 0, u, tid); continue; } u -= 128;
                if (u < 256) { if (msk & 4) attn_unit(P, lds, l, 0, u, tid); continue; } u -= 256;
                if (u < 128) { if (msk & 1) hgrn2_unit(P, lds, l, 1, u, tid); continue; } u -= 128;
                if (u < 768) { if (msk & 8) conv_unit(P, ldsf, l, u, tid); continue; } u -= 768;
                if (msk & 16) { const int lane2 = tid & 63; LAS float* scr = ldsf + wave * 4096; transpose_item(P->in[9] + (size_t)2048 * DIN, 2048, DIN, WTIN, scr, u * 8 + wave, lane2); }
            }
            GSYNC();
        }
        { PHASE_IDS hgrn_scan(P, l, tid); }
        GSYNC();
        for (int rep = 0; rep < REP_P3; ++rep) {
            PHASE_IDS
            unsigned* ctr = ctl + 64 * (l * 2 + 1 + 4 * rep);
            unsigned pend = 0u;
            for (int u = q_first(ctr, qslot, tid, pend); u < 256; u = q_next(ctr, qslot, tid, pend)) {
                asm volatile("" : "+v"(tid));
                hgrn_final_unit(P, lds, l, u >> 1, u & 1, tid);
            }
            GSYNC();
        }
        for (int rep = 0; rep < ((l == 0) ? REP_P4 : 1); ++rep) {
            PHASE_IDS
            pg8::Gemm g{H, WTOUT + (size_t)l * 2048 * 2048, MTOK, D_MODEL, D_MODEL}; pg8::StaticOrder S; S.init(MTOK, D_MODEL, D_MODEL, G, (int)blockIdx.x, 0);
            pg8::EpiV E{(l == 0) ? xp : P->out, (l == 0) ? xs : P->out + OUT_YS, P->out, MOD + l * 3 * 6144 + 4096, (float*)(ws + WS_OL), ctl + 8192 + (l * 2 + rep) * 128 * 64};
            pg8::gemm_phase<pg8::EpiV, pg8::StaticOrder, true, true>(lds, g, S, E, tid);
            GSYNC();
        }
        { PHASE_IDS
        for (int row = gw; row < MTOK; row += NGW) {
            const int cond = (row < NCTX) ? 0 : 1 + ((row - NCTX) >> 11);
            ln_row(P->out + (size_t)row * D_MODEL, P->in[18] + l * D_MODEL, P->in[19] + l * D_MODEL, MOD + (3 + cond) * 6144, (l == 0) ? H + (size_t)row * D_MODEL : (bf16*)nullptr, lane);
        } }
        if (l + 1 < DEPTH) GSYNC();
    }
}

extern "C" void kernel_launch(void* const* d_in, const int* in_sizes, int n_in, void* d_out, int out_size, void* d_ws, size_t ws_size, hipStream_t stream) {
    static int grid = 0;
    if (grid == 0) {
        if (n_in != 20 || out_size != (int)OUT_TOTAL || ws_size < WS_END) { fprintf(stderr, "kernel_launch: unexpected shapes (n_in %d, out %d, ws %zu)\n", n_in, out_size, ws_size); grid = -1; return; }
        int dev = 0, cus = 0, per_cu = 0;
        hipGetDevice(&dev); hipDeviceGetAttribute(&cus, hipDeviceAttributeMultiprocessorCount, dev);
        hipFuncSetAttribute((const void*)fwd_kernel, hipFuncAttributeMaxDynamicSharedMemorySize, LDS_BYTES);
        hipOccupancyMaxActiveBlocksPerMultiprocessor(&per_cu, (const void*)fwd_kernel, NTHREADS, LDS_BYTES);
        if (per_cu < 1) { fprintf(stderr, "kernel_launch: occupancy query says %d blocks per CU\n", per_cu); grid = -1; return; }
        grid = cus;
    }
    if (grid < 0) return;
    hipMemsetAsync((char*)d_ws + WS_CTL, 0, CTL_ZERO_BYTES, stream);
    Params p{};
    for (int i = 0; i < 20; ++i) p.in[i] = (const float*)d_in[i];
    p.out = (float*)d_out; p.ws = (unsigned char*)d_ws;
    void* args[] = {&p};
    hipError_t e = hipLaunchCooperativeKernel((const void*)fwd_kernel, dim3(grid), dim3(NTHREADS), args, LDS_BYTES, stream);
    if (e != hipSuccess) fprintf(stderr, "cooperative launch failed: %s (grid %d)\n", hipGetErrorString(e), grid);
}
```

```cpp
#include <hip/hip_runtime.h>
#include <hip/hip_cooperative_groups.h>
#include <cstdio>
#include <cstdint>
namespace cg = cooperative_groups;

constexpr int D_MODEL = 2048, DIN = 6656, NCTX = 8192, NLAT = 4096, MTOK = 12288, DEPTH = 2;
constexpr int C_AQ = 0, C_AK = 1024, C_AV = 1280, C_AG = 1536, C_HQ = 2560, C_HI = 3072, C_HFF = 3584, C_HFB = 4096, C_HG = 4608, C_CA = 5120, C_CB = 5632, C_CG = 6144;
constexpr float ALPHA_DN = 1.4142135623730951f;
constexpr size_t OUT_YP = 0, OUT_YS = 16777216, OUT_CK = 25165824, OUT_CV = 29360128, OUT_ST = 33554432, OUT_TOTAL = 41943040;
namespace pg8 {
#define PG8_LAS __attribute__((address_space(3)))
typedef unsigned short bf16_t;
typedef short bf16x8 __attribute__((ext_vector_type(8)));
typedef float f32x4 __attribute__((ext_vector_type(4)));
typedef unsigned u32x4 __attribute__((ext_vector_type(4)));
constexpr int BM = 256, BK = 64, HALF = 128, HTB = HALF * BK * 2  , STAGE_BYTES = 8 * HTB, NXCD = 8, WGM = 8;

__host__ __device__ __forceinline__ int lds_byte(int r, int c) { const int st = (r >> 4) * 2 + (c >> 5), rr = r & 15, cc = c & 31, ob = rr * 64 + cc * 2; return st * 1024 + (ob ^ (((ob >> 9) & 1) << 5)); }
__host__ __device__ __forceinline__ void stage_rc(int b, int& R, int& C) { const int st = b / 1024, sb = b % 1024, swz = sb ^ (((sb >> 9) & 1) << 5); R = (st >> 1) * 16 + swz / 64; C = (st & 1) * 32 + (swz % 64) / 2; }
__host__ __device__ __forceinline__ int perm32(int rho) { const int n = rho >> 4, i = rho & 15; return 8 * (i >> 2) + 4 * n + (i & 3); }

struct Unit { int pm, pn, k0, nk, role, pair; };
struct Gemm { const bf16_t* A; const bf16_t* Bt; int M, N, K; };

struct StaticOrder {
    int nM, nN, nwg, G, c, nkt, split;
    __host__ __device__ void init(int M, int N, int K, int G_, int c_, int split_ = 0) { nM = M / BM; nN = N / BM; nwg = nM * nN; G = G_; c = c_; nkt = K / BK; split = split_ && (G_ % 16 == 0) && (2 * nwg == 3 * G_) && (nkt % 4 == 0); }
    __host__ __device__ void map(long L, Unit& u) const {
        int wgid = (int)L; { const int q = nwg / NXCD, r = nwg % NXCD, xcd = wgid % NXCD, off = wgid / NXCD; wgid = (xcd < r ? xcd * (q + 1) : r * (q + 1) + (xcd - r) * q) + off; }
        const int nig = WGM * nN, gid = wgid / nig, fm = gid * WGM, gsz = (nM - fm) < WGM ? (nM - fm) : WGM;
        u.pm = fm + ((wgid % nig) % gsz); u.pn = (wgid % nig) / gsz; u.k0 = 0; u.nk = nkt; u.role = 0; u.pair = 0;
    }
    __host__ __device__ bool next(int i, Unit& u) const {
        if (split) {
            if (i == 0) { map(c, u); return true; }
            if (i == 1) { const int j = (c >> 4) * 8 + (c & 7), half = (c >> 3) & 1; map(G + j, u); u.k0 = half * (nkt / 2); u.nk = nkt / 2; u.role = 1 + half; u.pair = j; return true; }
            return false;
        }
        const long L = (long)i * G + c; if (L >= nwg) return false;
        map(L, u); return true;
    }
    __device__ __forceinline__ void a_ready(const Unit&) const {}
    __device__ __forceinline__ void done(const Unit&) const {}
};

__device__ __forceinline__ unsigned cvt_pk_bf16(float lo, float hi) { unsigned r; asm volatile("v_cvt_pk_bf16_f32 %0, %1, %2" : "=v"(r) : "v"(lo), "v"(hi)); return r; }
typedef float f32x2 __attribute__((ext_vector_type(2)));

struct EpiZ {
    static constexpr bool PERM = true, AFTER_DRAIN = false;
    bf16_t* Z; float* ck; float* cv; int layer;
    __device__ __forceinline__ void operator()(f32x4 (&acc)[2][2][4][2], const Unit& u, int wr, int wc, int fr_in, int fq_in) const {
        int fr = fr_in, fq = fq_in; asm volatile("" : "+v"(fr), "+v"(fq));
        const int row0 = u.pm * BM + wr * 64 + fr; const int col0 = u.pn * BM + wc * 32 + 8 * fq;
#pragma unroll
        for (int ai = 0; ai < 2; ++ai)
#pragma unroll
            for (int m = 0; m < 4; ++m) { bf16_t* rowp = Z + (size_t)(row0 + ai * HALF + m * 16) * DIN + col0;
#pragma unroll
                for (int bj = 0; bj < 2; ++bj) { const f32x4 v0 = acc[ai][bj][m][0], v1 = acc[ai][bj][m][1];
                    u32x4 w; w.x = cvt_pk_bf16(v0[0], v0[1]); w.y = cvt_pk_bf16(v0[2], v0[3]); w.z = cvt_pk_bf16(v1[0], v1[1]); w.w = cvt_pk_bf16(v1[2], v1[3]);
                    *(u32x4*)(rowp + bj * HALF) = w; } }
        if ((u.pn == 4 || u.pn == 5) && u.pm < 32) {
            float* base = (u.pn == 4) ? ck : cv;
#pragma unroll
            for (int ai = 0; ai < 2; ++ai)
#pragma unroll
                for (int m = 0; m < 4; ++m) { const int row = row0 + ai * HALF + m * 16; const int b = row >> 8, s = row & 255;
                    float* p = base + ((size_t)((b * 2 + layer) * 256 + s)) * 256 + (wc * 32 + 8 * fq);
#pragma unroll
                    for (int bj = 0; bj < 2; ++bj) { *(f32x4*)(p + bj * HALF) = acc[ai][bj][m][0]; *(f32x4*)(p + bj * HALF + 4) = acc[ai][bj][m][1]; } }
        }
    }
};
struct EpiV {
    static constexpr bool PERM = false, AFTER_DRAIN = false;
    const float* xp; const float* xs; float* V; const float* gate;
    float* slab; unsigned* flags;
    __device__ __forceinline__ void operator()(f32x4 (&acc)[2][2][4][2], const Unit& u, int wr, int wc, int fr_in, int fq_in) const {
        int fr = fr_in, fq = fq_in; asm volatile("" : "+v"(fr), "+v"(fq));
        const int lane = fq * 16 + fr, tid = (wr * 4 + wc) * 64 + lane;
        float* sp = slab + (size_t)u.pair * 65536 + tid * 4; unsigned* fl = flags + 64 * u.pair;
        if (u.role == 1) {
            { float* q = sp;
#pragma unroll
              for (int ai = 0; ai < 2; ++ai)
#pragma unroll
                for (int m = 0; m < 4; ++m)
#pragma unroll
                    for (int bj = 0; bj < 2; ++bj)
#pragma unroll
                        for (int n = 0; n < 2; ++n) {
                            asm volatile("global_store_dwordx4 %0, %1, off sc1\n\ts_nop 1" :: "v"(q), "v"(acc[ai][bj][m][n]) : "memory");
                            q += 2048; asm volatile("" : "+v"(q)); } }
            asm volatile("s_waitcnt vmcnt(0)" ::: "memory");
            if (lane == 0) __hip_atomic_fetch_add(fl, 1u, __ATOMIC_RELAXED, __HIP_MEMORY_SCOPE_AGENT);
            return;
        }
        const bool red = (u.role == 2);
        if (red) {
            unsigned sp_ = 0;
            while ((unsigned)__builtin_amdgcn_readfirstlane(__hip_atomic_load(fl, __ATOMIC_RELAXED, __HIP_MEMORY_SCOPE_AGENT)) < 8u) { __builtin_amdgcn_s_sleep(2); if (++sp_ > (1u << 20)) break; }
            asm volatile("" ::: "memory");
        }
        const int row0 = u.pm * BM + wr * 64 + fr; const int col0 = u.pn * BM + wc * 32 + 4 * fq;
        const int cond = (u.pm < 32) ? 0 : 1 + ((u.pm - 32) >> 3);
        const float* g = gate + cond * 6144 + col0;
        f32x4 gv[2][2];
#pragma unroll
        for (int bj = 0; bj < 2; ++bj)
#pragma unroll
            for (int n = 0; n < 2; ++n) gv[bj][n] = *(const f32x4*)(g + bj * HALF + n * 16);
        if (!red) {
            f32x4 xq[2][4];
            { const int row = row0; const float* xr = ((row < NCTX) ? xp + (size_t)row * D_MODEL : xs + (size_t)(row - NCTX) * D_MODEL) + col0;
#pragma unroll
              for (int e = 0; e < 4; ++e) xq[0][e] = *(const f32x4*)(xr + (e >> 1) * HALF + (e & 1) * 16); }
#pragma unroll
            for (int g8 = 0; g8 < 8; ++g8) { const int ai = g8 >> 2, m = g8 & 3; const int row = row0 + ai * HALF + m * 16;
                if (g8 + 1 < 8) { const int rown = row0 + ((g8 + 1) >> 2) * HALF + ((g8 + 1) & 3) * 16;
                    const float* xr = ((rown < NCTX) ? xp + (size_t)rown * D_MODEL : xs + (size_t)(rown - NCTX) * D_MODEL) + col0;
#pragma unroll
                    for (int e = 0; e < 4; ++e) xq[(g8 + 1) & 1][e] = *(const f32x4*)(xr + (e >> 1) * HALF + (e & 1) * 16); }
                float* vr = V + (size_t)row * D_MODEL + col0;
#pragma unroll
                for (int e = 0; e < 4; ++e) *(f32x4*)(vr + (e >> 1) * HALF + (e & 1) * 16) = xq[g8 & 1][e] * ALPHA_DN + gv[e >> 1][e & 1] * acc[ai][e >> 1][m][e & 1];
                asm volatile("" ::: "memory"); }
        } else {
            const float* rq = sp;
#pragma unroll
            for (int ai = 0; ai < 2; ++ai)
#pragma unroll
                for (int m = 0; m < 4; ++m) { const int row = row0 + ai * HALF + m * 16;
                    const float* xr = ((row < NCTX) ? xp + (size_t)row * D_MODEL : xs + (size_t)(row - NCTX) * D_MODEL) + col0;
                    float* vr = V + (size_t)row * D_MODEL + col0;
                    f32x4 t[2][2];
#pragma unroll
                    for (int bj = 0; bj < 2; ++bj)
#pragma unroll
                        for (int n = 0; n < 2; ++n) { const unsigned long long* q8 = (const unsigned long long*)rq;
                            const unsigned long long a8 = __hip_atomic_load(q8, __ATOMIC_RELAXED, __HIP_MEMORY_SCOPE_AGENT), b8 = __hip_atomic_load(q8 + 1, __ATOMIC_RELAXED, __HIP_MEMORY_SCOPE_AGENT);
                            t[bj][n] = (f32x4){__builtin_bit_cast(float, (unsigned)a8), __builtin_bit_cast(float, (unsigned)(a8 >> 32)), __builtin_bit_cast(float, (unsigned)b8), __builtin_bit_cast(float, (unsigned)(b8 >> 32))};
                            rq += 2048; asm volatile("" : "+v"(rq)); }
#pragma unroll
                    for (int bj = 0; bj < 2; ++bj)
#pragma unroll
                        for (int n = 0; n < 2; ++n) { const f32x4 xv = *(const f32x4*)(xr + bj * HALF + n * 16);
                            *(f32x4*)(vr + bj * HALF + n * 16) = xv * ALPHA_DN + gv[bj][n] * (acc[ai][bj][m][n] + t[bj][n]); }
                    asm volatile("" ::: "memory"); }
        }
    }
};
template <class Epi, class Sched, bool ALIGN_EPI = false, bool SP2 = false>
__device__ __forceinline__ void gemm_phase(PG8_LAS unsigned char* lds, const Gemm g, const Sched& S, const Epi& E, int tid_in) {
    int tid_l = tid_in; asm volatile("" : "+v"(tid_l));
    const int tid = tid_l, wid = __builtin_amdgcn_readfirstlane(tid >> 6), lane = tid & 63, wr = wid >> 2, wc = wid & 3, fr = lane & 15, fq = lane >> 4;
    const int K = g.K;
    unsigned voffA[2], voffB[2];
#pragma unroll
    for (int i = 0; i < 2; ++i) { int R, C; stage_rc(tid * 16 + i * 8192, R, C); const int Rb = Epi::PERM ? ((R & ~31) + perm32(R & 31)) : R;
        voffA[i] = (unsigned)(R * K + C) * 2u; voffB[i] = (unsigned)(Rb * K + C) * 2u; }
    const size_t kstep = (size_t)(BK * 2);
    const size_t hstep = (size_t)HALF * K * 2;
    const size_t tstep = 2 * hstep;
    const unsigned ldsw = (unsigned)wid * 1024u;
    const int aoff = lds_byte(wr * 64 + fr, fq * 8), boff = lds_byte(wc * 32 + fr, fq * 8);
#define PG8_SA(b, h) (((b) * 2 + (h)) * HTB)
#define PG8_SB(b, h) ((4 + (b) * 2 + (h)) * HTB)
#define PG8_STAGE(bufoff, gbase, voff) do { _Pragma("unroll") for (int _i = 0; _i < 2; ++_i) \
        __builtin_amdgcn_global_load_lds((const unsigned*)((const char*)(gbase) + (voff)[_i]), (PG8_LAS unsigned*)(lds + (bufoff) + ldsw + _i * 8192), 16, 0, 0); } while (0)
#define PG8_LDA(dst, b, h) do { _Pragma("unroll") for (int m = 0; m < 4; ++m) _Pragma("unroll") for (int k = 0; k < 2; ++k) dst[m][k] = *(const PG8_LAS bf16x8*)(lds + PG8_SA(b, h) + aoff + m * 2048 + k * 1024); } while (0)
#define PG8_LDB(dst, b, h) do { _Pragma("unroll") for (int n = 0; n < 2; ++n) _Pragma("unroll") for (int k = 0; k < 2; ++k) dst[n][k] = *(const PG8_LAS bf16x8*)(lds + PG8_SB(b, h) + boff + n * 2048 + k * 1024); } while (0)
#define PG8_MMA(ai, bj, At, Bt) do { __builtin_amdgcn_s_setprio(1); _Pragma("unroll") for (int m = 0; m < 4; ++m) _Pragma("unroll") for (int n = 0; n < 2; ++n) _Pragma("unroll") for (int k = 0; k < 2; ++k) \
        acc[ai][bj][m][n] = __builtin_amdgcn_mfma_f32_16x16x32_bf16(Bt[n][k], At[m][k], acc[ai][bj][m][n], 0, 0, 0); __builtin_amdgcn_s_setprio(0); } while (0)
#define PG8_WAIT_V(n) asm volatile("s_waitcnt vmcnt(" #n ")" ::: "memory")
#define PG8_WAIT_L(n) asm volatile("s_waitcnt lgkmcnt(" #n ")" ::: "memory")
#define PG8_BAR __builtin_amdgcn_s_barrier()
#define PG8_SCHED __builtin_amdgcn_sched_barrier(0)
    Unit cur, nxt; int ui = 0;
    if (!S.next(0, cur)) return;
    f32x4 acc[2][2][4][2];
#pragma unroll
    for (int a = 0; a < 2; ++a)
#pragma unroll
        for (int b = 0; b < 2; ++b)
#pragma unroll
            for (int m = 0; m < 4; ++m)
#pragma unroll
                for (int n = 0; n < 2; ++n) acc[a][b][m][n] = (f32x4){0.f, 0.f, 0.f, 0.f};
    bf16x8 At[4][2], B0[2][2], B1[2][2];
    const char* cA = (const char*)g.A + (size_t)cur.pm * tstep + (size_t)cur.k0 * kstep; const char* cB = (const char*)g.Bt + (size_t)cur.pn * tstep + (size_t)cur.k0 * kstep;
    S.a_ready(cur);
    if constexpr (SP2) {
        PG8_STAGE(PG8_SB(0, 0), cB, voffB); PG8_STAGE(PG8_SB(0, 1), cB + hstep, voffB); PG8_STAGE(PG8_SA(0, 0), cA, voffA); PG8_STAGE(PG8_SA(0, 1), cA + hstep, voffA);
        if (wr == 1) PG8_BAR;
        PG8_WAIT_V(2); PG8_BAR;
        PG8_STAGE(PG8_SB(1, 0), cB + kstep, voffB); PG8_STAGE(PG8_SA(1, 0), cA + kstep, voffA); PG8_STAGE(PG8_SB(1, 1), cB + hstep + kstep, voffB);
        PG8_WAIT_V(6); PG8_BAR;
    } else {
        PG8_STAGE(PG8_SB(0, 0), cB, voffB); PG8_STAGE(PG8_SA(0, 0), cA, voffA); PG8_STAGE(PG8_SB(0, 1), cB + hstep, voffB); PG8_STAGE(PG8_SA(0, 1), cA + hstep, voffA);
        if (wr == 1) PG8_BAR;
        PG8_WAIT_V(4); PG8_BAR;
        PG8_STAGE(PG8_SB(1, 0), cB + kstep, voffB); PG8_STAGE(PG8_SA(1, 0), cA + kstep, voffA); PG8_STAGE(PG8_SB(1, 1), cB + hstep + kstep, voffB);
        PG8_WAIT_V(6); PG8_BAR;
    }
    for (;;) {
        const bool has_next = S.next(ui + 1, nxt);
        const char* nA = has_next ? (const char*)g.A + (size_t)nxt.pm * tstep + (size_t)nxt.k0 * kstep : cA; const char* nB = has_next ? (const char*)g.Bt + (size_t)nxt.pn * tstep + (size_t)nxt.k0 * kstep : cB;
        const int nt = cur.nk;
        for (int t = 0; t < nt; t += 2) {
            const bool last = (t == nt - 2);
            const char* a1 = cA + (size_t)(t + 1) * kstep;
            const char* a2 = last ? nA : cA + (size_t)(t + 2) * kstep; const char* b2 = last ? nB : cB + (size_t)(t + 2) * kstep;
            const char* a3 = a2 + kstep; const char* b3 = b2 + kstep;
            if (last && has_next) S.a_ready(nxt);
            if constexpr (SP2) {
            PG8_LDB(B0, 0, 0); PG8_LDB(B1, 0, 1); PG8_SCHED; PG8_LDA(At, 0, 0); PG8_STAGE(PG8_SA(1, 1), a1 + hstep, voffA);
            PG8_WAIT_V(8); PG8_WAIT_L(0); PG8_BAR; PG8_MMA(0, 0, At, B0); PG8_MMA(0, 1, At, B1); PG8_BAR; PG8_SCHED;
            PG8_LDA(At, 0, 1); PG8_STAGE(PG8_SB(0, 0), b2, voffB); PG8_STAGE(PG8_SB(0, 1), b2 + hstep, voffB); PG8_STAGE(PG8_SA(0, 0), a2, voffA);
            PG8_WAIT_V(8); PG8_WAIT_L(0); PG8_BAR; PG8_MMA(1, 0, At, B0); PG8_MMA(1, 1, At, B1); PG8_BAR; PG8_SCHED;
            PG8_LDB(B0, 1, 0); PG8_LDB(B1, 1, 1); PG8_SCHED; PG8_LDA(At, 1, 0); PG8_STAGE(PG8_SA(0, 1), a2 + hstep, voffA);
            PG8_WAIT_V(8); PG8_WAIT_L(0); PG8_BAR; PG8_MMA(0, 0, At, B0); PG8_MMA(0, 1, At, B1); PG8_BAR; PG8_SCHED;
            PG8_LDA(At, 1, 1); PG8_STAGE(PG8_SB(1, 0), b3, voffB); PG8_STAGE(PG8_SB(1, 1), b3 + hstep, voffB); PG8_STAGE(PG8_SA(1, 0), a3, voffA);
            PG8_WAIT_V(8); PG8_WAIT_L(0); PG8_BAR; PG8_MMA(1, 0, At, B0); PG8_MMA(1, 1, At, B1); PG8_BAR; PG8_SCHED;
            } else {
            PG8_LDB(B0, 0, 0); PG8_SCHED; PG8_LDA(At, 0, 0); PG8_STAGE(PG8_SA(1, 1), a1 + hstep, voffA);
            PG8_WAIT_L(8); PG8_BAR; PG8_WAIT_L(0); PG8_MMA(0, 0, At, B0); PG8_BAR; PG8_SCHED;
            PG8_LDB(B1, 0, 1); PG8_STAGE(PG8_SB(0, 0), b2, voffB);
            PG8_BAR; PG8_WAIT_L(0); PG8_MMA(0, 1, At, B1); PG8_BAR;
            PG8_LDA(At, 0, 1); PG8_STAGE(PG8_SA(0, 0), a2, voffA);
            PG8_BAR; PG8_WAIT_L(0); PG8_MMA(1, 0, At, B0); PG8_BAR; PG8_SCHED;
            PG8_STAGE(PG8_SB(0, 1), b2 + hstep, voffB);
            PG8_WAIT_V(6); PG8_BAR; PG8_MMA(1, 1, At, B1); PG8_BAR;
            PG8_LDB(B0, 1, 0); PG8_SCHED; PG8_LDA(At, 1, 0); PG8_STAGE(PG8_SA(0, 1), a2 + hstep, voffA);
            PG8_WAIT_L(8); PG8_BAR; PG8_WAIT_L(0); PG8_MMA(0, 0, At, B0); PG8_BAR; PG8_SCHED;
            PG8_LDB(B1, 1, 1); PG8_STAGE(PG8_SB(1, 0), b3, voffB);
            PG8_BAR; PG8_WAIT_L(0); PG8_MMA(0, 1, At, B1); PG8_BAR;
            PG8_LDA(At, 1, 1); PG8_STAGE(PG8_SA(1, 0), a3, voffA);
            PG8_BAR; PG8_WAIT_L(0); PG8_MMA(1, 0, At, B0); PG8_BAR; PG8_SCHED;
            PG8_STAGE(PG8_SB(1, 1), b3 + hstep, voffB);
            PG8_WAIT_V(6); PG8_BAR; PG8_MMA(1, 1, At, B1); PG8_BAR;
            }
        }
        if constexpr (ALIGN_EPI) { if (wr == 0) PG8_BAR; }
        if constexpr (!Epi::AFTER_DRAIN) { E(acc, cur, wr, wc, fr, fq); S.done(cur); }
        if (!has_next) break;
#pragma unroll
        for (int a = 0; a < 2; ++a)
#pragma unroll
            for (int b = 0; b < 2; ++b)
#pragma unroll
                for (int m = 0; m < 4; ++m)
#pragma unroll
                    for (int n = 0; n < 2; ++n) acc[a][b][m][n] = (f32x4){0.f, 0.f, 0.f, 0.f};
        cur = nxt; cA = nA; cB = nB; ++ui;
        if constexpr (ALIGN_EPI) { if (wr == 1) PG8_BAR; }
    }
    PG8_WAIT_V(0);
    if constexpr (!ALIGN_EPI) { if (wr == 0) PG8_BAR; }
    PG8_BAR;
    if constexpr (Epi::AFTER_DRAIN) { E.fused(acc, cur, wr, wc, fr, fq, lds, wid, lane); S.done(cur); }
#undef PG8_SA
#undef PG8_SB
#undef PG8_STAGE
#undef PG8_LDA
#undef PG8_LDB
#undef PG8_MMA
#undef PG8_WAIT_V
#undef PG8_WAIT_L
#undef PG8_BAR
#undef PG8_SCHED
}
}

constexpr size_t MiB = 1u << 20;
constexpr size_t WS_CTL = 0, CTL_ZERO_BYTES = 262144;
constexpr size_t WS_MOD = 1 * MiB;
constexpr size_t WS_CS = 1 * MiB + 192 * 1024;
constexpr size_t WS_DLOG = 1 * MiB + 256 * 1024;
constexpr size_t WS_WTOUT = 2 * MiB;
constexpr size_t WS_WTIN = 18 * MiB;
constexpr size_t WS_H = 44 * MiB;
constexpr size_t WS_Z = 92 * MiB;
constexpr size_t WS_U = 248 * MiB;
constexpr size_t WS_OL = 264 * MiB;
constexpr size_t WS_CKV = 312 * MiB;
constexpr size_t WS_END = 313 * MiB;
constexpr int LDS_BYTES = 163840;
constexpr int LDS_CTLW = 163840 - 256;
constexpr int NWAVES = 8, NTHREADS = 512;

#define LAS __attribute__((address_space(3)))
typedef unsigned short bf16;
typedef float f32x4 __attribute__((ext_vector_type(4)));
typedef float f32x16 __attribute__((ext_vector_type(16)));
typedef unsigned u32x4 __attribute__((ext_vector_type(4)));
typedef unsigned u32x2 __attribute__((ext_vector_type(2)));
typedef short bf16x8 __attribute__((ext_vector_type(8)));

__device__ __forceinline__ float bf2f(unsigned short u) { return __builtin_bit_cast(float, (unsigned)u << 16); }
__device__ __forceinline__ float bflo(unsigned u) { return __builtin_bit_cast(float, u << 16); }
__device__ __forceinline__ float bfhi(unsigned u) { return __builtin_bit_cast(float, u & 0xffff0000u); }
typedef float f32x2_t_ __attribute__((ext_vector_type(2))); typedef __bf16 bf16x2_t_ __attribute__((ext_vector_type(2)));
__device__ __forceinline__ unsigned pk2(float lo, float hi) { const f32x2_t_ v = {lo, hi}; return __builtin_bit_cast(unsigned, __builtin_convertvector(v, bf16x2_t_)); }
__device__ __forceinline__ unsigned f2bf(float f) { return pk2(f, f) & 0xffffu; }
__device__ __forceinline__ float sigmoidf_(float x) { return __builtin_amdgcn_rcpf(1.0f + __builtin_amdgcn_exp2f(-1.4426950408889634f * x)); }
__device__ __forceinline__ float siluf_(float x) { return x * __builtin_amdgcn_rcpf(1.0f + __builtin_amdgcn_exp2f(-1.4426950408889634f * x)); }
__device__ __forceinline__ float dpp_add_(float v, const int ctrl_sel) {
    const int x = __builtin_bit_cast(int, v); int y;
    if (ctrl_sel == 0) y = __builtin_amdgcn_update_dpp(0, x, 0xB1, 0xf, 0xf, true);
    else if (ctrl_sel == 1) y = __builtin_amdgcn_update_dpp(0, x, 0x4E, 0xf, 0xf, true);
    else if (ctrl_sel == 2) y = __builtin_amdgcn_update_dpp(0, x, 0x141, 0xf, 0xf, true);
    else y = __builtin_amdgcn_update_dpp(0, x, 0x140, 0xf, 0xf, true);
    return v + __builtin_bit_cast(float, y);
}
__device__ __forceinline__ float wave_sum(float v) {
    v = dpp_add_(v, 0); v = dpp_add_(v, 1); v = dpp_add_(v, 2); v = dpp_add_(v, 3);
    const float r0 = __builtin_bit_cast(float, __builtin_amdgcn_readlane(__builtin_bit_cast(int, v), 0)), r1 = __builtin_bit_cast(float, __builtin_amdgcn_readlane(__builtin_bit_cast(int, v), 16));
    const float r2 = __builtin_bit_cast(float, __builtin_amdgcn_readlane(__builtin_bit_cast(int, v), 32)), r3 = __builtin_bit_cast(float, __builtin_amdgcn_readlane(__builtin_bit_cast(int, v), 48));
    return (r0 + r1) + (r2 + r3);
}

struct Params {
    const float* in[20];
    float* out; unsigned char* ws;
};
typedef const __attribute__((address_space(4))) Params* PP;

__device__ __forceinline__ int next_unit(unsigned* ctr, volatile LAS unsigned* slot, int tid) {
    __syncthreads();
    if (tid == 0) *slot = __hip_atomic_fetch_add(ctr, 1u, __ATOMIC_RELAXED, __HIP_MEMORY_SCOPE_AGENT);
    __syncthreads();
    return (int)*slot;
}
__device__ __forceinline__ int q_first(unsigned* ctr, volatile LAS unsigned* slot, int tid, unsigned& pend) {
    unsigned cur = 0u;
    if (tid == 0) { cur = __hip_atomic_fetch_add(ctr, 1u, __ATOMIC_RELAXED, __HIP_MEMORY_SCOPE_AGENT); *slot = cur; pend = __hip_atomic_fetch_add(ctr, 1u, __ATOMIC_RELAXED, __HIP_MEMORY_SCOPE_AGENT); }
    __syncthreads();
    return (int)*slot;
}
__device__ __forceinline__ int q_next(unsigned* ctr, volatile LAS unsigned* slot, int tid, unsigned& pend) {
    __syncthreads();
    if (tid == 0) { *slot = pend; pend = __hip_atomic_fetch_add(ctr, 1u, __ATOMIC_RELAXED, __HIP_MEMORY_SCOPE_AGENT); }
    __syncthreads();
    return (int)*slot;
}

__device__ __forceinline__ void transpose_item(const float* W, int K, int N, bf16* WT, LAS float* scr, int item, int lane) {
    const int nblk = N / 32, kb = item / nblk, nb = item % nblk, k0 = 64 * kb, n0 = 32 * nb;
    float wv[32];
    const float* wp = W + (size_t)(k0 + (lane >> 5)) * N + n0 + (lane & 31);
#pragma unroll
    for (int i = 0; i < 32; ++i) wv[i] = wp[(size_t)(2 * i) * N];
    __builtin_amdgcn_sched_barrier(0);
#pragma unroll
    for (int i = 0; i < 32; ++i) { const int kk = 2 * i + (lane >> 5); scr[kk * 33 + (lane & 31)] = wv[i]; }
    asm volatile("s_waitcnt lgkmcnt(0)" ::: "memory");
    const int c = lane & 7;
#pragma unroll
    for (int j = 0; j < 4; ++j) { const int n = (lane >> 3) + 8 * j; const LAS float* s = scr + (8 * c) * 33 + n;
        u32x4 o; o.x = pk2(s[0 * 33], s[1 * 33]); o.y = pk2(s[2 * 33], s[3 * 33]); o.z = pk2(s[4 * 33], s[5 * 33]); o.w = pk2(s[6 * 33], s[7 * 33]);
        *(u32x4*)(WT + (size_t)(n0 + n) * K + k0 + 8 * c) = o; }
    asm volatile("s_waitcnt lgkmcnt(0)" ::: "memory");
}

__device__ __forceinline__ void mod_unit(PP P, LAS float* lds, int l, int nc, int tid) {
    const float* c = P->in[5]; const float* cctx = P->in[6]; const float* aw = P->in[7] + (size_t)l * 2048 * 6144; const float* ab = P->in[8] + l * 6144;
    LAS float* sc = lds;
    LAS float* red = lds + 3 * 2048;
    for (int i = tid; i < 3 * 2048; i += NTHREADS) { const int j = i >> 11, k = i & 2047; const float v = (j == 0) ? cctx[k] : c[(j - 1) * 2048 + k]; sc[i] = siluf_(v); }
    __syncthreads();
    const int tn = tid & 7, tk = tid >> 3, n0 = nc * 32 + 4 * tn;
    float a[3][4] = {};
    for (int k8 = 0; k8 < 32; k8 += 16) {
        f32x4 w[16];
#pragma unroll
        for (int kk = 0; kk < 16; ++kk) w[kk] = *(const f32x4*)(aw + (size_t)(tk * 32 + k8 + kk) * 6144 + n0);
        __builtin_amdgcn_sched_barrier(0);
#pragma unroll
        for (int kk = 0; kk < 16; ++kk) { const int k = tk * 32 + k8 + kk;
#pragma unroll
            for (int j = 0; j < 3; ++j) { const float s = sc[j * 2048 + k]; a[j][0] += s * w[kk][0]; a[j][1] += s * w[kk][1]; a[j][2] += s * w[kk][2]; a[j][3] += s * w[kk][3]; } }
    }
#pragma unroll
    for (int j = 0; j < 3; ++j)
#pragma unroll
        for (int e = 0; e < 4; ++e) red[(tk * 8 + tn) * 12 + j * 4 + e] = a[j][e];
    __syncthreads();
    if (tid < 96) { const int tn2 = tid / 12, je = tid % 12; float s = 0.f; for (int t = 0; t < 64; ++t) s += red[(t * 8 + tn2) * 12 + je];
        const int j = je >> 2, e = je & 3, n = nc * 32 + 4 * tn2 + e;
        ((float*)(P->ws + WS_MOD))[(l * 3 + j) * 6144 + n] = s + ab[n]; }
    __syncthreads();
}

__device__ __forceinline__ void hprep_row(const float* xrow, const float* mod  , bf16* hrow, int lane) {
#pragma unroll
    for (int j = 0; j < 8; ++j) { const int c = 4 * lane + 256 * j; const f32x4 x = *(const f32x4*)(xrow + c), sh = *(const f32x4*)(mod + c), sc = *(const f32x4*)(mod + 2048 + c);
        const f32x4 h = x * (sc + 1.0f) + sh; u32x2 o; o.x = pk2(h[0], h[1]); o.y = pk2(h[2], h[3]); *(u32x2*)(hrow + c) = o; }
}
__device__ __forceinline__ void ln_row(float* vrow, const float* w, const float* b, const float* modn, bf16* hrow, int lane) {
    f32x4 v[8]; float s = 0.f;
#pragma unroll
    for (int j = 0; j < 8; ++j) { v[j] = *(const f32x4*)(vrow + 4 * lane + 256 * j); s += (v[j][0] + v[j][1]) + (v[j][2] + v[j][3]); }
    const float mean = wave_sum(s) * (1.0f / 2048.0f); float q = 0.f;
#pragma unroll
    for (int j = 0; j < 8; ++j) { v[j] = v[j] - mean; q += (v[j][0] * v[j][0] + v[j][1] * v[j][1]) + (v[j][2] * v[j][2] + v[j][3] * v[j][3]); }
    const float rstd = __builtin_amdgcn_rsqf(wave_sum(q) * (1.0f / 2048.0f) + 1e-5f);
#pragma unroll
    for (int j = 0; j < 8; ++j) { const int c = 4 * lane + 256 * j; const f32x4 y = v[j] * rstd * *(const f32x4*)(w + c) + *(const f32x4*)(b + c);
        *(f32x4*)(vrow + c) = y;
        if (hrow) { const f32x4 sh = *(const f32x4*)(modn + c), sc = *(const f32x4*)(modn + 2048 + c); const f32x4 h = y * (sc + 1.0f) + sh;
            u32x2 o; o.x = pk2(h[0], h[1]); o.y = pk2(h[2], h[3]); *(u32x2*)(hrow + c) = o; } }
}

typedef float f32x2 __attribute__((ext_vector_type(2)));
__device__ __forceinline__ void conv_unit(PP P, LAS float* lds, int l, int unit, int tid) {
    const int lane = tid & 63, wave = tid >> 6;
    const bf16* Z = (const bf16*)(P->ws + WS_Z); bf16* MIX = (bf16*)(P->ws + WS_H);
    const int t0 = unit * 32;
    int s0, s1; if (t0 < NCTX) { s0 = t0 & ~255; s1 = s0 + 256; } else { s0 = NCTX + ((t0 - NCTX) & ~2047); s1 = s0 + 2048; }
    const int c2 = 2 * (tid & 255), tb = t0 + 16 * (tid >> 8);
    u32x4 gq[4];
#pragma unroll
    for (int k = 0; k < 4; ++k) gq[k] = *(const u32x4*)(Z + (size_t)(t0 + 4 * wave + k) * DIN + C_CG + 8 * lane);
    const float* lw = P->in[16] + l * 512 + 8 * lane; const float* lb = P->in[17] + l * 512 + 8 * lane;
    const f32x4 w0 = *(const f32x4*)lw, w1 = *(const f32x4*)(lw + 4), b0 = *(const f32x4*)lb, b1 = *(const f32x4*)(lb + 4);
    f32x2 u[46];
#pragma unroll
    for (int hb = 0; hb < 2; ++hb) {
        unsigned ra[23], rb[23];
#pragma unroll
        for (int r = 0; r < 23; ++r) { const int row = tb - 15 + 23 * hb + r; const int rc = row < s0 ? s0 : (row >= s1 ? s1 - 1 : row);
            ra[r] = *(const unsigned*)(Z + (size_t)rc * DIN + C_CA + c2); rb[r] = *(const unsigned*)(Z + (size_t)rc * DIN + C_CB + c2); }
        __builtin_amdgcn_sched_barrier(0);
#pragma unroll
        for (int r = 0; r < 23; ++r) { const int row = tb - 15 + 23 * hb + r; const bool ok = (row >= s0 && row < s1);
            const f32x2 a = {bflo(ra[r]), bfhi(ra[r])}; const f32x2 g = {sigmoidf_(bflo(rb[r])), sigmoidf_(bfhi(rb[r]))};
            const f32x2 v = a * g; u[23 * hb + r] = ok ? v : (f32x2){0.f, 0.f}; }
    }
    f32x2 acc[16]; const f32x2 bias = *(const f32x2*)(P->in[15] + l * 512 + c2);
#pragma unroll
    for (int i = 0; i < 16; ++i) acc[i] = bias;
    const float* cw = P->in[14] + (size_t)l * 31 * 512 + c2;
#pragma unroll
    for (int j = 0; j < 31; ++j) { const f32x2 w = *(const f32x2*)(cw + j * 512);
#pragma unroll
        for (int i = 0; i < 16; ++i) acc[i] += u[i + j] * w; }
    LAS float* yb = lds;
#pragma unroll
    for (int i = 0; i < 16; ++i) *(LAS f32x2*)(yb + (16 * (tid >> 8) + i) * 512 + c2) = acc[i];
    __syncthreads();
#pragma unroll
    for (int k = 0; k < 4; ++k) { const int ti = wave * 4 + k, row = t0 + ti;
        f32x4 a = *(const LAS f32x4*)(yb + ti * 512 + 8 * lane), b = *(const LAS f32x4*)(yb + ti * 512 + 8 * lane + 4);
        float s = (a[0] + a[1]) + (a[2] + a[3]) + (b[0] + b[1]) + (b[2] + b[3]);
        const float mean = wave_sum(s) * (1.0f / 512.0f); a = a - mean; b = b - mean;
        float q = (a[0] * a[0] + a[1] * a[1]) + (a[2] * a[2] + a[3] * a[3]) + (b[0] * b[0] + b[1] * b[1]) + (b[2] * b[2] + b[3] * b[3]);
        const float rstd = __builtin_amdgcn_rsqf(wave_sum(q) * (1.0f / 512.0f) + 1e-5f);
        a = a * rstd * w0 + b0; b = b * rstd * w1 + b1;
        const u32x4 g = gq[k];
        float o[8];
        o[0] = siluf_(a[0]) * siluf_(bflo(g.x)); o[1] = siluf_(a[1]) * siluf_(bfhi(g.x)); o[2] = siluf_(a[2]) * siluf_(bflo(g.y)); o[3] = siluf_(a[3]) * siluf_(bfhi(g.y));
        o[4] = siluf_(b[0]) * siluf_(bflo(g.z)); o[5] = siluf_(b[1]) * siluf_(bfhi(g.z)); o[6] = siluf_(b[2]) * siluf_(bflo(g.w)); o[7] = siluf_(b[3]) * siluf_(bfhi(g.w));
        u32x4 w; w.x = pk2(o[0], o[1]); w.y = pk2(o[2], o[3]); w.z = pk2(o[4], o[5]); w.w = pk2(o[6], o[7]);
        *(u32x4*)(MIX + (size_t)row * D_MODEL + 1536 + 8 * lane) = w; }
}

typedef short v4i16_t __attribute__((ext_vector_type(4)));
#define SBAR __builtin_amdgcn_sched_barrier(0);
#define R0(i) (((i) & 3) + 8 * ((i) >> 2))
constexpr float ATT_C2 = 0.08838834764831845f * 1.4426950408889634f;
constexpr float LOG2E = 1.4426950408889634f;
constexpr int KROW = 272, VROW = 320, ATT_V_OFF = 64 * KROW;

__device__ __forceinline__ bf16x8 trpair(const LAS unsigned char* p, int second_off) {
    const v4i16_t lo = __builtin_amdgcn_ds_read_tr16_b64_v4i16((LAS v4i16_t*)p), hi = __builtin_amdgcn_ds_read_tr16_b64_v4i16((LAS v4i16_t*)(p + second_off));
    return (bf16x8){lo[0], lo[1], lo[2], lo[3], hi[0], hi[1], hi[2], hi[3]};
}
__device__ __forceinline__ bf16x8 pack8(float a, float b, float c, float d, float e, float f, float g, float h) {
    const u32x4 w = {pk2(a, b), pk2(c, d), pk2(e, f), pk2(g, h)}; return __builtin_bit_cast(bf16x8, w);
}
__device__ __forceinline__ void rope8(bf16x8& a, bf16x8& b, const float* cs) {
    float ra[8], rb[8];
#pragma unroll
    for (int j = 0; j < 8; ++j) { const float x1 = bf2f((unsigned short)a[j]), x2 = bf2f((unsigned short)b[j]), c = cs[2 * j], s = cs[2 * j + 1]; ra[j] = x1 * c - x2 * s; rb[j] = x2 * c + x1 * s; }
    a = pack8(ra[0], ra[1], ra[2], ra[3], ra[4], ra[5], ra[6], ra[7]); b = pack8(rb[0], rb[1], rb[2], rb[3], rb[4], rb[5], rb[6], rb[7]);
}
__device__ __forceinline__ void rope8l(bf16x8& a, bf16x8& b, const LAS float* cs) {
    const f32x4 c0 = *(const LAS f32x4*)cs, c1 = *(const LAS f32x4*)(cs + 4), c2 = *(const LAS f32x4*)(cs + 8), c3 = *(const LAS f32x4*)(cs + 12);
    const float cc[8] = {c0[0], c0[2], c1[0], c1[2], c2[0], c2[2], c3[0], c3[2]}, sn[8] = {c0[1], c0[3], c1[1], c1[3], c2[1], c2[3], c3[1], c3[3]};
    float ra[8], rb[8];
#pragma unroll
    for (int j = 0; j < 8; ++j) { const float x1 = bf2f((unsigned short)a[j]), x2 = bf2f((unsigned short)b[j]); ra[j] = x1 * cc[j] - x2 * sn[j]; rb[j] = x2 * cc[j] + x1 * sn[j]; }
    a = pack8(ra[0], ra[1], ra[2], ra[3], ra[4], ra[5], ra[6], ra[7]); b = pack8(rb[0], rb[1], rb[2], rb[3], rb[4], rb[5], rb[6], rb[7]);
}
__device__ __forceinline__ bf16x8 cvt8(const float* p) {
    const f32x4 a = *(const f32x4*)p, b = *(const f32x4*)(p + 4);
    return pack8(a[0], a[1], a[2], a[3], b[0], b[1], b[2], b[3]);
}

typedef _Float16 f16x8_t_ __attribute__((ext_vector_type(8)));
__device__ __forceinline__ void rope8h(u32x4& a, u32x4& b, const LAS unsigned char* cs) {
    const f16x8_t_ t0 = *(const LAS f16x8_t_*)cs, t1 = *(const LAS f16x8_t_*)(cs + 16);
    float ra[8], rb[8];
#pragma unroll
    for (int j = 0; j < 8; ++j) { const unsigned wa = a[j >> 1], wb = b[j >> 1]; const float x1 = (j & 1) ? bfhi(wa) : bflo(wa), x2 = (j & 1) ? bfhi(wb) : bflo(wb);
        const float c = (float)((j < 4) ? t0[2 * j] : t1[2 * (j - 4)]), sn = (float)((j < 4) ? t0[2 * j + 1] : t1[2 * (j - 4) + 1]);
        ra[j] = x1 * c - x2 * sn; rb[j] = x2 * c + x1 * sn; }
    a = (u32x4){pk2(ra[0], ra[1]), pk2(ra[2], ra[3]), pk2(ra[4], ra[5]), pk2(ra[6], ra[7])}; b = (u32x4){pk2(rb[0], rb[1]), pk2(rb[2], rb[3]), pk2(rb[4], rb[5]), pk2(rb[6], rb[7])};
}
constexpr int AT_BUF = 75776, AT_V = 34816, AT_ROPE = 151552;
__device__ __forceinline__ void attn_tile(const LAS unsigned char* kt, const LAS unsigned char* vt, const bf16x8 (&qf)[8], f32x16 (&O)[4], float& m, float& lsum,
                                          bool local, int tk0, int qpos, int lane) {
    const int r32 = lane & 31, hh = lane >> 5, i16 = lane & 15;
    f32x16 p0, p1;
#pragma unroll
    for (int i = 0; i < 16; ++i) { p0[i] = 0.f; p1[i] = 0.f; }
    const LAS unsigned char* kb = kt + r32 * KROW + 16 * hh;
#pragma unroll
    for (int s = 0; s < 8; ++s) { const bf16x8 kf0 = *(const LAS bf16x8*)(kb + 32 * s), kf1 = *(const LAS bf16x8*)(kb + 32 * KROW + 32 * s);
        p0 = __builtin_amdgcn_mfma_f32_32x32x16_bf16(kf0, qf[s], p0, 0, 0, 0); p1 = __builtin_amdgcn_mfma_f32_32x32x16_bf16(kf1, qf[s], p1, 0, 0, 0); }
    const LAS unsigned char* vb = vt + (4 * hh + (i16 >> 2)) * VROW + (16 * ((lane >> 4) & 1) + 4 * (i16 & 3)) * 2;
    bf16x8 vfa[4], vfb[4];
#pragma unroll
    for (int ks = 0; ks < 4; ++ks) vfa[ks] = trpair(vb + (16 * ks) * VROW, 8 * VROW);
    float mx = -3e38f;
    if (local) { const unsigned mb = (unsigned)(qpos - tk0 - 4 * hh + 128);
#pragma unroll
        for (int i = 0; i < 16; ++i) { const unsigned d0 = mb - (unsigned)R0(i), d1 = d0 - 32u;
            p0[i] = (d0 <= 256u) ? p0[i] : -1e30f; p1[i] = (d1 <= 256u) ? p1[i] : -1e30f; } }
#pragma unroll
    for (int i = 0; i < 16; ++i) mx = fmaxf(mx, fmaxf(p0[i], p1[i]));
    mx = fmaxf(mx, __shfl_xor(mx, 32)) * ATT_C2;
    const float mn = fmaxf(m, mx), alpha = __builtin_amdgcn_exp2f(m - mn); m = mn;
    float ps = 0.f;
#pragma unroll
    for (int i = 0; i < 16; ++i) { p0[i] = __builtin_amdgcn_exp2f(__builtin_fmaf(p0[i], ATT_C2, -mn)); p1[i] = __builtin_amdgcn_exp2f(__builtin_fmaf(p1[i], ATT_C2, -mn)); ps += p0[i] + p1[i]; }
    lsum = lsum * alpha + ps;
    if (__builtin_amdgcn_ballot_w64(alpha != 1.0f) != 0ull) {
#pragma unroll
        for (int d = 0; d < 4; ++d)
#pragma unroll
            for (int i = 0; i < 16; ++i) O[d][i] *= alpha;
    }
    bf16x8 pb[4];
#pragma unroll
    for (int s = 0; s < 2; ++s) { pb[s] = pack8(p0[8 * s], p0[8 * s + 1], p0[8 * s + 2], p0[8 * s + 3], p0[8 * s + 4], p0[8 * s + 5], p0[8 * s + 6], p0[8 * s + 7]);
        pb[2 + s] = pack8(p1[8 * s], p1[8 * s + 1], p1[8 * s + 2], p1[8 * s + 3], p1[8 * s + 4], p1[8 * s + 5], p1[8 * s + 6], p1[8 * s + 7]); }
#pragma unroll
    for (int dt = 0; dt < 4; ++dt) {
        if (dt + 1 < 4) {
#pragma unroll
            for (int ks = 0; ks < 4; ++ks) { const bf16x8 t_ = trpair(vb + (16 * ks) * VROW + 64 * (dt + 1), 8 * VROW); if (dt & 1) vfa[ks] = t_; else vfb[ks] = t_; }
        }
#pragma unroll
        for (int ks = 0; ks < 4; ++ks) O[dt] = __builtin_amdgcn_mfma_f32_32x32x16_bf16((dt & 1) ? vfb[ks] : vfa[ks], pb[ks], O[dt], 0, 0, 0);
    }
}
__device__ __forceinline__ void attn_unit(PP P, LAS unsigned char* lds, int l, int kind, int idx, int tid) {
    const int lane = tid & 63, wave = __builtin_amdgcn_readfirstlane(tid >> 6), r32 = lane & 31, hh = lane >> 5;
    const bf16* Z = (const bf16*)(P->ws + WS_Z); bf16* MIX = (bf16*)(P->ws + WS_H); const float* CS = (const float*)(P->ws + WS_CS); const bf16* CKV = (const bf16*)(P->ws + WS_CKV);
    int b, h, qpos0, grow0, kpos0, klrow0, nls, ncs;
    if (kind == 0) { b = idx >> 3; h = idx & 7; qpos0 = 0; grow0 = b * 256; kpos0 = 0; klrow0 = b * 256; nls = 2; ncs = 0; }
    else { const int qb = idx & 7; h = (idx >> 3) & 7; b = idx >> 6; qpos0 = qb * 256; grow0 = NCTX + b * 2048 + qpos0;
        kpos0 = qpos0 - 128 < 0 ? 0 : qpos0 - 128; const int kend = qpos0 + 384 > 2048 ? 2048 : qpos0 + 384; nls = (kend - kpos0) >> 7; klrow0 = NCTX + b * 2048 + kpos0; ncs = 2; }
    const bool lat = (kind == 1);
    const int kv = h >> 2;
    if (lat) {
#pragma unroll
        for (int k = 0; k < 4; ++k) { const int e = tid + 512 * k; const float c = CS[2 * e], sn = CS[2 * e + 1];
            typedef _Float16 h2_ __attribute__((ext_vector_type(2))); const h2_ hv = {(_Float16)c, (_Float16)sn}; *(LAS unsigned*)(lds + AT_ROPE + 4 * e) = __builtin_bit_cast(unsigned, hv); }
    }
    const int qrow = grow0 + 32 * wave + r32, qpos = qpos0 + 32 * wave + r32, qw0 = qpos0 + 32 * wave;
    bf16x8 qf[8];
    { const bf16* qp = Z + (size_t)qrow * DIN + C_AQ + h * 128 + 8 * hh;
#pragma unroll
      for (int s = 0; s < 8; ++s) qf[s] = *(const bf16x8*)(qp + 16 * s);
      if (lat) { const float* c0 = CS + ((qpos >> 6) * 32 + 8 * hh) * 2; const float* c1 = CS + ((qpos & 63) * 32 + 8 * hh) * 2;
          rope8(qf[0], qf[2], c0); rope8(qf[1], qf[3], c0 + 32); rope8(qf[4], qf[6], c1); rope8(qf[5], qf[7], c1 + 32); } }
    f32x16 O[4];
#pragma unroll
    for (int d = 0; d < 4; ++d)
#pragma unroll
        for (int i = 0; i < 16; ++i) O[d][i] = 0.f;
    float m = P->in[11][l * 8 + h] * LOG2E, lsum = (hh == 0) ? 1.0f : 0.0f;
    const int skey = tid >> 2, sub = tid & 3;
    const int nst = nls + ncs;
    u32x4 rr[8];
#define ATT_ISSUE(ST) do { const int st_ = (ST); const bf16* kp_; const bf16* vp_; \
        if (st_ < nls) { const int krow = klrow0 + 128 * st_ + skey; kp_ = Z + (size_t)krow * DIN + C_AK + kv * 128 + 8 * sub; vp_ = kp_ + (C_AV - C_AK); } \
        else { const int key = 128 * (st_ - nls) + skey; kp_ = CKV + ((size_t)((b * 2 + l) * 256 + key) * 2 + kv) * 128 + 8 * sub; vp_ = kp_ + 262144; } \
        rr[0] = *(const u32x4*)kp_; rr[1] = *(const u32x4*)(kp_ + 32); rr[2] = *(const u32x4*)(kp_ + 64); rr[3] = *(const u32x4*)(kp_ + 96); \
        rr[4] = *(const u32x4*)vp_; rr[5] = *(const u32x4*)(vp_ + 32); rr[6] = *(const u32x4*)(vp_ + 64); rr[7] = *(const u32x4*)(vp_ + 96); } while (0)
#define ATT_WRITE(ST) do { const int st_ = (ST); \
        if (lat && st_ < nls) { const int kpos = kpos0 + 128 * st_ + skey; \
            rope8h(rr[0], rr[1], lds + AT_ROPE + ((kpos >> 6) * 32 + 8 * sub) * 4); rope8h(rr[2], rr[3], lds + AT_ROPE + ((kpos & 63) * 32 + 8 * sub) * 4); } \
        LAS unsigned char* kd_ = lds + (st_ & 1) * AT_BUF + skey * KROW + 16 * sub; LAS unsigned char* vd_ = lds + (st_ & 1) * AT_BUF + AT_V + skey * VROW + 16 * sub; \
        *(LAS u32x4*)kd_ = rr[0]; *(LAS u32x4*)(kd_ + 64) = rr[1]; *(LAS u32x4*)(kd_ + 128) = rr[2]; *(LAS u32x4*)(kd_ + 192) = rr[3]; \
        *(LAS u32x4*)vd_ = rr[4]; *(LAS u32x4*)(vd_ + 64) = rr[5]; *(LAS u32x4*)(vd_ + 128) = rr[6]; *(LAS u32x4*)(vd_ + 192) = rr[7]; } while (0)
    if (lat) { ATT_ISSUE(0); __syncthreads();
        ATT_WRITE(0); }
    else {
        u32x4 r2[8];
        { const bf16* kp_ = Z + (size_t)(klrow0 + skey) * DIN + C_AK + kv * 128 + 8 * sub; const bf16* vp_ = kp_ + (C_AV - C_AK); const bf16* kq_ = kp_ + (size_t)128 * DIN; const bf16* vq_ = vp_ + (size_t)128 * DIN;
          rr[0] = *(const u32x4*)kp_; rr[1] = *(const u32x4*)(kp_ + 32); rr[2] = *(const u32x4*)(kp_ + 64); rr[3] = *(const u32x4*)(kp_ + 96);
          rr[4] = *(const u32x4*)vp_; rr[5] = *(const u32x4*)(vp_ + 32); rr[6] = *(const u32x4*)(vp_ + 64); rr[7] = *(const u32x4*)(vp_ + 96);
          r2[0] = *(const u32x4*)kq_; r2[1] = *(const u32x4*)(kq_ + 32); r2[2] = *(const u32x4*)(kq_ + 64); r2[3] = *(const u32x4*)(kq_ + 96);
          r2[4] = *(const u32x4*)vq_; r2[5] = *(const u32x4*)(vq_ + 32); r2[6] = *(const u32x4*)(vq_ + 64); r2[7] = *(const u32x4*)(vq_ + 96); }
        ATT_WRITE(0);
#pragma unroll
        for (int e = 0; e < 8; ++e) rr[e] = r2[e];
        ATT_WRITE(1);
    }
    __syncthreads();
    for (int st = 0; st < nst; ++st) {
        const bool more = lat && (st + 1 < nst);
        if (more) ATT_ISSUE(st + 1);
        const bool local = lat && (st < nls);
        const LAS unsigned char* kt = lds + (st & 1) * AT_BUF; const LAS unsigned char* vt = kt + AT_V;
#pragma unroll
        for (int t2 = 0; t2 < 2; ++t2) {
            const int tk0 = kpos0 + 128 * st + 64 * t2;
            bool skip = false;
            if (local) skip = (tk0 > qw0 + 31 + 128) || (tk0 + 63 < qw0 - 128);
            if (!skip) attn_tile(kt + t2 * 64 * KROW, vt + t2 * 64 * VROW, qf, O, m, lsum, local, tk0, qpos, lane);
        }
        if (more) ATT_WRITE(st + 1);
        if (lat) __syncthreads();
    }
    const float ltot = lsum + __shfl_xor(lsum, 32), inv = __builtin_amdgcn_rcpf(ltot);
    const bf16* gp = Z + (size_t)qrow * DIN + C_AG + h * 128 + 4 * hh; bf16* op = MIX + (size_t)qrow * D_MODEL + h * 128 + 4 * hh;
    u32x2 gg[16];
#pragma unroll
    for (int e = 0; e < 16; ++e) gg[e] = *(const u32x2*)(gp + 32 * (e >> 2) + 8 * (e & 3));
    __builtin_amdgcn_sched_barrier(0);
#pragma unroll
    for (int dt = 0; dt < 4; ++dt)
#pragma unroll
        for (int i4 = 0; i4 < 4; ++i4) { const int d0 = 32 * dt + 8 * i4; const u32x2 g = gg[dt * 4 + i4];
            const float o0 = O[dt][4 * i4 + 0] * inv * siluf_(bflo(g.x)), o1 = O[dt][4 * i4 + 1] * inv * siluf_(bfhi(g.x));
            const float o2 = O[dt][4 * i4 + 2] * inv * siluf_(bflo(g.y)), o3 = O[dt][4 * i4 + 3] * inv * siluf_(bfhi(g.y));
            u32x2 w; w.x = pk2(o0, o1); w.y = pk2(o2, o3); *(u32x2*)(op + d0) = w; }
#undef ATT_ISSUE
#undef ATT_WRITE
}

__device__ __forceinline__ void hg_oml8(PP P, int l, int dir, int hd0, float (&oml)[8]) {
    const float* hb = P->in[12] + dir * 1024 + hd0;
    const f32x4 a0 = *(const f32x4*)hb, a1 = *(const f32x4*)(hb + 4), b0 = *(const f32x4*)(hb + 512), b1 = *(const f32x4*)(hb + 516);
#pragma unroll
    for (int j = 0; j < 4; ++j) { const float s0 = sigmoidf_(b0[j] - a0[j]), s1 = sigmoidf_(b1[j] - a1[j]); oml[j] = l ? 1.0f - s0 : 1.0f; oml[4 + j] = l ? 1.0f - s1 : 1.0f; }
}
constexpr int H2_TG = 0, H2_QE = 16896, H2_KE = 25600, H2_QG = 34304, H2_KG = 42752, H2_V = 52992, H2_OBA = 63232, H2_OBB = 80128, H2_DK = 97024;
constexpr size_t WS_DLC_OFF = 0;
#ifndef PROBE_SEC
#define PROBE_SEC -1
#endif
#if PROBE_SEC >= 0
#define PSEC_DECL unsigned long long ps_acc_ = 0ull, ps_t_ = 0ull;
#define PSEC_START(n) if (PROBE_SEC == n) ps_t_ = __builtin_amdgcn_s_memrealtime();
#define PSEC_END(n) if (PROBE_SEC == n) ps_acc_ += __builtin_amdgcn_s_memrealtime() - ps_t_;
#define PSEC_CLOSE(n) if (PROBE_SEC == n) { __syncthreads(); ps_acc_ += __builtin_amdgcn_s_memrealtime() - ps_t_; }
#define PSEC_FLUSH(cnt) if (kind == 0 && tid == 0) { atomicAdd((unsigned long long*)((unsigned*)(P->ws + WS_CTL) + 60000), ps_acc_); atomicAdd((unsigned*)(P->ws + WS_CTL) + 60002, (unsigned)(cnt)); }
#else
#define PSEC_DECL
#define PSEC_START(n)
#define PSEC_END(n)
#define PSEC_CLOSE(n)
#define PSEC_FLUSH(cnt)
#endif
__device__ __forceinline__ void hgrn2_unit(PP P, LAS unsigned char* lds, int l, int kind, int idx, int tid) {
    const int lane = tid & 63, wave = __builtin_amdgcn_readfirstlane(tid >> 6), r32 = lane & 31, hh = lane >> 5, i16 = lane & 15, cg = (lane >> 4) & 1;
    const bf16* Z = (const bf16*)(P->ws + WS_Z); bf16* MIX = (bf16*)(P->ws + WS_H); float* OL = (float*)(P->ws + WS_OL);
    LAS float* ldsf = (LAS float*)lds;
    int h, row0, seglen, nch, b = 0;
    if (kind == 0) { b = idx >> 2; h = idx & 3; row0 = b * 256; seglen = 256; nch = 8; }
    else { const int blk = idx & 15; h = (idx >> 4) & 3; const int lb = idx >> 6; row0 = NCTX + lb * 2048 + blk * 128; seglen = 128; nch = 4; }
    const int ti = tid >> 4, d0 = 8 * (tid & 15), nt = wave & 3, kp = wave >> 2;
    PSEC_DECL
    const f32x4 n0 = *(const f32x4*)(P->in[13] + l * 512 + h * 128 + d0), n1 = *(const f32x4*)(P->in[13] + l * 512 + h * 128 + d0 + 4);
    for (int dir = 0; dir < 2; ++dir) {
        float oml[8]; hg_oml8(P, l, dir, h * 128 + d0, oml);
        const int cf = dir ? C_HFB : C_HFF;
        f32x16 S0, S1;
#pragma unroll
        for (int i = 0; i < 16; ++i) { S0[i] = 0.f; S1[i] = 0.f; }
        const int uidx = (kind == 1) ? ((idx >> 4) * 2 + dir) * 16 + (idx & 15) : 0;
        u32x4 uq, uv, uf;
        { const int row = dir ? row0 + seglen - 1 - ti : row0 + ti; const bf16* zr = Z + (size_t)row * DIN + h * 128 + d0;
          uq = *(const u32x4*)(zr + C_HQ); uv = *(const u32x4*)(zr + C_HI); uf = *(const u32x4*)(zr + cf); }
        for (int c = 0; c < nch; ++c) {
            PSEC_START(0)
            const int nc = dir ? nch - 1 - c : c; const int rown = row0 + 32 * nc + ti;
            f32x4 olp0 = {0.f, 0.f, 0.f, 0.f}, olp1 = {0.f, 0.f, 0.f, 0.f}; u32x4 ug = {0u, 0u, 0u, 0u};
            float* olr = OL + (size_t)rown * 512 + h * 128 + d0;
            if (dir == 1) { olp0 = *(const f32x4*)olr; olp1 = *(const f32x4*)(olr + 4); if (kind == 0) ug = *(const u32x4*)(Z + (size_t)rown * DIN + C_HG + h * 128 + d0); }
            float q[8], kk[8];
            {
                float g2[8], vv[8];
#pragma unroll
                for (int j = 0; j < 4; ++j) { const unsigned wq = uq[j], wv = uv[j], wf = uf[j];
                    q[2 * j] = siluf_(bflo(wq)) * 0.08838834764831845f; q[2 * j + 1] = siluf_(bfhi(wq)) * 0.08838834764831845f;
                    vv[2 * j] = bflo(wv); vv[2 * j + 1] = bfhi(wv);
                    kk[2 * j] = oml[2 * j] * sigmoidf_(-bflo(wf)); kk[2 * j + 1] = oml[2 * j + 1] * sigmoidf_(-bfhi(wf)); }
#pragma unroll
                for (int j = 0; j < 8; ++j) g2[j] = __builtin_amdgcn_logf(1.0f - fminf(kk[j], 1.0f - 1e-6f));
                LAS float* pg = ldsf + (H2_TG >> 2) + ti * 132 + d0;
                *(LAS f32x4*)pg = (f32x4){g2[0], g2[1], g2[2], g2[3]}; *(LAS f32x4*)(pg + 4) = (f32x4){g2[4], g2[5], g2[6], g2[7]};
                *(LAS u32x4*)(lds + H2_V + ti * 320 + d0 * 2) = uv;
            }
            if (c + 1 < nch) { const int tl = 32 * (c + 1) + ti; const int row = dir ? row0 + seglen - 1 - tl : row0 + tl; const bf16* zr = Z + (size_t)row * DIN + h * 128 + d0;
                uq = *(const u32x4*)(zr + C_HQ); uv = *(const u32x4*)(zr + C_HI); uf = *(const u32x4*)(zr + cf); }
            __syncthreads();
            PSEC_END(0) PSEC_START(1)
            if (tid < 128) {
                LAS float* gc = ldsf + (H2_TG >> 2) + tid; float run = 0.f; float gv[32];
#pragma unroll
                for (int i = 0; i < 32; ++i) gv[i] = gc[i * 132];
                SBAR
#pragma unroll
                for (int i = 0; i < 32; ++i) { run += gv[i]; gc[i * 132] = run; }
                ldsf[(H2_DK >> 2) + tid] = __builtin_amdgcn_exp2f(run);
                if (kind == 1) ((float*)(P->ws + WS_DLOG))[(uidx * 4 + c) * 128 + tid] = run;
            }
            __syncthreads();
            PSEC_END(1) PSEC_START(2)
            {
                const LAS float* gr = ldsf + (H2_TG >> 2) + ti * 132 + d0; const LAS float* gm = ldsf + (H2_TG >> 2) + 15 * 132 + d0; const LAS float* gl = ldsf + (H2_TG >> 2) + 31 * 132 + d0;
                float qe[8], ke[8], qg[8], kg[8];
#pragma unroll
                for (int j = 0; j < 8; ++j) { const float G = gr[j], Gm = gm[j], Gl = gl[j];
                    qe[j] = q[j] * __builtin_amdgcn_exp2f(fminf(G - Gm, 100.f)); ke[j] = kk[j] * __builtin_amdgcn_exp2f(fminf(Gm - G, 100.f));
                    qg[j] = q[j] * __builtin_amdgcn_exp2f(G); kg[j] = kk[j] * __builtin_amdgcn_exp2f(Gl - G); }
                *(LAS bf16x8*)(lds + H2_QE + ti * 272 + d0 * 2) = pack8(qe[0], qe[1], qe[2], qe[3], qe[4], qe[5], qe[6], qe[7]);
                *(LAS bf16x8*)(lds + H2_KE + ti * 272 + d0 * 2) = pack8(ke[0], ke[1], ke[2], ke[3], ke[4], ke[5], ke[6], ke[7]);
                *(LAS bf16x8*)(lds + H2_KG + ti * 320 + d0 * 2) = pack8(kg[0], kg[1], kg[2], kg[3], kg[4], kg[5], kg[6], kg[7]);
                u32x2 w0, w1; w0.x = pk2(qg[0], qg[1]); w0.y = pk2(qg[2], qg[3]); w1.x = pk2(qg[4], qg[5]); w1.y = pk2(qg[6], qg[7]);
                *(LAS u32x2*)(lds + H2_QG + ti * 264 + d0 * 2) = w0; *(LAS u32x2*)(lds + H2_QG + ti * 264 + d0 * 2 + 8) = w1;
            }
            __syncthreads();
            PSEC_END(2) PSEC_START(3)
            {
                f32x16 at;
#pragma unroll
                for (int i = 0; i < 16; ++i) at[i] = 0.f;
                const LAS unsigned char* kep = lds + H2_KE + r32 * 272 + 16 * hh; const LAS unsigned char* qep = lds + H2_QE + r32 * 272 + 16 * hh;
#pragma unroll
                for (int k = 0; k < 8; ++k) at = __builtin_amdgcn_mfma_f32_32x32x16_bf16(*(const LAS bf16x8*)(kep + 32 * k), *(const LAS bf16x8*)(qep + 32 * k), at, 0, 0, 0);
                float am[8];
#pragma unroll
                for (int j = 0; j < 8; ++j) { const float lo = at[j], hi = at[8 + j]; const float v = kp ? hi : lo; const int s = 16 * kp + 8 * (j >> 2) + 4 * hh + (j & 3); am[j] = (s <= r32) ? v : 0.f; }
                const bf16x8 afrag = pack8(am[0], am[1], am[2], am[3], am[4], am[5], am[6], am[7]);
                f32x16 ot;
#pragma unroll
                for (int i = 0; i < 16; ++i) ot[i] = 0.f;
                { const bf16x8 vfrag = trpair(lds + H2_V + (16 * kp + 4 * hh + (i16 >> 2)) * 320 + (32 * nt + 16 * cg + 4 * (i16 & 3)) * 2, 8 * 320);
                  ot = __builtin_amdgcn_mfma_f32_32x32x16_bf16(vfrag, afrag, ot, 0, 0, 0); }
                const LAS unsigned char* qgp = lds + H2_QG + r32 * 264 + (64 * kp + 4 * hh) * 2;
#pragma unroll
                for (int kl = 0; kl < 2; ++kl)
#pragma unroll
                    for (int sp = 0; sp < 2; ++sp) {
                        const u32x2 qlo = *(const LAS u32x2*)(qgp + (32 * kl + 16 * sp) * 2), qhi = *(const LAS u32x2*)(qgp + (32 * kl + 16 * sp) * 2 + 16);
                        const u32x4 qq = {qlo.x, qlo.y, qhi.x, qhi.y};
                        bf16x8 sfrag;
                        if (kl == 0) sfrag = pack8(S0[8 * sp], S0[8 * sp + 1], S0[8 * sp + 2], S0[8 * sp + 3], S0[8 * sp + 4], S0[8 * sp + 5], S0[8 * sp + 6], S0[8 * sp + 7]);
                        else sfrag = pack8(S1[8 * sp], S1[8 * sp + 1], S1[8 * sp + 2], S1[8 * sp + 3], S1[8 * sp + 4], S1[8 * sp + 5], S1[8 * sp + 6], S1[8 * sp + 7]);
                        ot = __builtin_amdgcn_mfma_f32_32x32x16_bf16(sfrag, __builtin_bit_cast(bf16x8, qq), ot, 0, 0, 0);
                    }
                { LAS float* ob = ldsf + ((kp ? H2_OBB : H2_OBA) >> 2) + (32 * nt + 4 * hh) * 33 + r32;
#pragma unroll
                  for (int i = 0; i < 16; ++i) ob[R0(i) * 33] = ot[i]; }
                const LAS float* dkp = ldsf + (H2_DK >> 2) + 64 * kp + 4 * hh;
#pragma unroll
                for (int i = 0; i < 16; ++i) { S0[i] *= dkp[R0(i)]; S1[i] *= dkp[32 + R0(i)]; }
#pragma unroll
                for (int ks = 0; ks < 2; ++ks) {
                    const int roff = (16 * ks + 8 * hh + (i16 >> 2)) * 320, coff = (16 * cg + 4 * (i16 & 3)) * 2;
                    const bf16x8 vf = trpair(lds + H2_V + roff + 64 * nt + coff, 4 * 320);
                    const bf16x8 k0 = trpair(lds + H2_KG + roff + 64 * (2 * kp) + coff, 4 * 320), k1 = trpair(lds + H2_KG + roff + 64 * (2 * kp + 1) + coff, 4 * 320);
                    S0 = __builtin_amdgcn_mfma_f32_32x32x16_bf16(k0, vf, S0, 0, 0, 0); S1 = __builtin_amdgcn_mfma_f32_32x32x16_bf16(k1, vf, S1, 0, 0, 0);
                }
            }
            __syncthreads();
            PSEC_END(3) PSEC_START(4)
            {
                const int t = dir ? 31 - ti : ti;
                const LAS float* oa = ldsf + (H2_OBA >> 2) + d0 * 33 + t; const LAS float* obb = ldsf + (H2_OBB >> 2) + d0 * 33 + t;
                float o[8];
#pragma unroll
                for (int j = 0; j < 8; ++j) o[j] = oa[j * 33] + obb[j * 33];
                if (dir == 1) { o[0] += olp0[0]; o[1] += olp0[1]; o[2] += olp0[2]; o[3] += olp0[3]; o[4] += olp1[0]; o[5] += olp1[1]; o[6] += olp1[2]; o[7] += olp1[3]; }
                if (dir == 0 || kind == 1) { *(f32x4*)olr = (f32x4){o[0], o[1], o[2], o[3]}; *(f32x4*)(olr + 4) = (f32x4){o[4], o[5], o[6], o[7]}; }
                else {
                    float ss = 0.f;
#pragma unroll
                    for (int j = 0; j < 8; ++j) ss += o[j] * o[j];
                    ss += __shfl_xor(ss, 1); ss += __shfl_xor(ss, 2); ss += __shfl_xor(ss, 4); ss += __shfl_xor(ss, 8);
                    const float r = __builtin_amdgcn_rsqf(ss * (1.0f / 128.0f) + 1e-6f);
                    u32x4 w;
                    w.x = pk2(o[0] * r * n0[0] * siluf_(bflo(ug.x)), o[1] * r * n0[1] * siluf_(bfhi(ug.x))); w.y = pk2(o[2] * r * n0[2] * siluf_(bflo(ug.y)), o[3] * r * n0[3] * siluf_(bfhi(ug.y)));
                    w.z = pk2(o[4] * r * n1[0] * siluf_(bflo(ug.z)), o[5] * r * n1[1] * siluf_(bfhi(ug.z))); w.w = pk2(o[6] * r * n1[2] * siluf_(bflo(ug.w)), o[7] * r * n1[3] * siluf_(bfhi(ug.w)));
                    *(u32x4*)(MIX + (size_t)rown * D_MODEL + 1024 + h * 128 + d0) = w;
                }
            }
            PSEC_CLOSE(4)
        }
        {
            float* Sd = (kind == 0) ? P->out + OUT_ST + (size_t)((((b * 2 + l) * 2 + dir) * 4 + h)) * 16384 : (float*)(P->ws + WS_U) + (size_t)uidx * 16384;
            float* sp = Sd + (64 * kp + 4 * hh) * 128 + 32 * nt + r32;
#pragma unroll
            for (int i = 0; i < 16; ++i) { sp[R0(i) * 128] = S0[i]; sp[(32 + R0(i)) * 128] = S1[i]; }
        }
    }
    PSEC_FLUSH(2 * nch)
}

__device__ __forceinline__ void hgrn_scan(PP P, int l, int tid) {
    float* U = (float*)(P->ws + WS_U); const float* DLC = (const float*)(P->ws + WS_DLOG);
    for (int e = blockIdx.x * NTHREADS + tid; e < 16 * 16384; e += gridDim.x * NTHREADS) {
        const int sq = e >> 14, el = e & 16383, dk = el >> 7, lb = sq >> 3, h = (sq >> 1) & 3, dir = sq & 1;
        float S = P->in[4][(size_t)((((lb * 2 + l) * 2 + dir) * 4 + h)) * 16384 + el];
        float u[16], dl[16];
#pragma unroll
        for (int p = 0; p < 16; ++p) { const int blk = dir ? 15 - p : p; const int uidx = sq * 16 + blk; u[p] = U[(size_t)uidx * 16384 + el];
            const float* d = DLC + (uidx * 4) * 128 + dk; dl[p] = (d[0] + d[128]) + (d[256] + d[384]); }
#pragma unroll
        for (int p = 0; p < 16; ++p) { const int blk = dir ? 15 - p : p; const int uidx = sq * 16 + blk; U[(size_t)uidx * 16384 + el] = S; S = __builtin_amdgcn_exp2f(dl[p]) * S + u[p]; }
    }
}

constexpr int HF_S0 = 0, HF_S1 = 40960, HF_TG0 = 81920, HF_TG1 = 98816, HF_QG0 = 115712, HF_QG1 = 124416;
__device__ __forceinline__ void hgrn_final_unit(PP P, LAS unsigned char* lds, int l, int idx, int half_sel, int tid) {
    const int lane = tid & 63, wave = __builtin_amdgcn_readfirstlane(tid >> 6), r32 = lane & 31, hh = lane >> 5, i16 = lane & 15, cg = (lane >> 4) & 1;
    const bf16* Z = (const bf16*)(P->ws + WS_Z); bf16* MIX = (bf16*)(P->ws + WS_H); const float* OL = (const float*)(P->ws + WS_OL); const float* DLC = (const float*)(P->ws + WS_DLOG);
    LAS float* ldsf = (LAS float*)lds;
    const int blk = idx & 15, h = (idx >> 4) & 3, lb = idx >> 6, row0 = NCTX + lb * 2048 + blk * 128;
    const int ti = tid >> 4, d0 = 8 * (tid & 15), nt = wave & 3, ds = wave >> 2;
    const int uidx0 = ((idx >> 4) * 2 + 0) * 16 + blk, uidx1 = ((idx >> 4) * 2 + 1) * 16 + blk;
#pragma unroll
    for (int half = 0; half < 2; ++half) {
        f32x4 sv[8];
#pragma unroll
        for (int k = 0; k < 8; ++k) { const int id = tid + 512 * (k + 8 * half), dsel = id >> 12, dk = (id >> 5) & 127, c4 = id & 31;
            sv[k] = *(const f32x4*)((const float*)(P->ws + WS_U) + (size_t)(dsel ? uidx1 : uidx0) * 16384 + dk * 128 + c4 * 4); }
#pragma unroll
        for (int k = 0; k < 8; ++k) { const int id = tid + 512 * (k + 8 * half), dsel = id >> 12, dk = (id >> 5) & 127, c4 = id & 31;
            u32x2 w; w.x = pk2(sv[k][0], sv[k][1]); w.y = pk2(sv[k][2], sv[k][3]); *(LAS u32x2*)(lds + (dsel ? HF_S1 : HF_S0) + dk * 320 + c4 * 8) = w; }
    }
    float oml0[8], oml1[8]; hg_oml8(P, l, 0, h * 128 + d0, oml0); hg_oml8(P, l, 1, h * 128 + d0, oml1);
    const f32x4 n0 = *(const f32x4*)(P->in[13] + l * 512 + h * 128 + d0), n1 = *(const f32x4*)(P->in[13] + l * 512 + h * 128 + d0 + 4);
    float carry = 0.f;
    if (tid < 128) { for (int c = 0; c < 2 * half_sel; ++c) carry += DLC[(uidx0 * 4 + c) * 128 + tid]; }
    for (int nc = 2 * half_sel; nc < 2 * half_sel + 2; ++nc) {
        const int rown = row0 + 32 * nc + ti; const bf16* zr = Z + (size_t)rown * DIN + h * 128 + d0;
        const u32x4 uq = *(const u32x4*)(zr + C_HQ), uf0 = *(const u32x4*)(zr + C_HFF), uf1 = *(const u32x4*)(zr + C_HFB), ug = *(const u32x4*)(zr + C_HG);
        const float* olr = OL + (size_t)rown * 512 + h * 128 + d0; const f32x4 olp0 = *(const f32x4*)olr, olp1 = *(const f32x4*)(olr + 4);
        float off1 = 0.f;
        if (tid >= 128 && tid < 256) { for (int c = 0; c < 3 - nc; ++c) off1 += DLC[(uidx1 * 4 + c) * 128 + (tid - 128)]; }
        float q[8];
        {
            float ga[8], gb[8];
#pragma unroll
            for (int j = 0; j < 4; ++j) { const unsigned wq = uq[j], wa = uf0[j], wb = uf1[j];
                q[2 * j] = siluf_(bflo(wq)) * 0.08838834764831845f; q[2 * j + 1] = siluf_(bfhi(wq)) * 0.08838834764831845f;
                ga[2 * j] = oml0[2 * j] * sigmoidf_(-bflo(wa)); ga[2 * j + 1] = oml0[2 * j + 1] * sigmoidf_(-bfhi(wa));
                gb[2 * j] = oml1[2 * j] * sigmoidf_(-bflo(wb)); gb[2 * j + 1] = oml1[2 * j + 1] * sigmoidf_(-bfhi(wb)); }
#pragma unroll
            for (int j = 0; j < 8; ++j) { ga[j] = __builtin_amdgcn_logf(1.0f - fminf(ga[j], 1.0f - 1e-6f)); gb[j] = __builtin_amdgcn_logf(1.0f - fminf(gb[j], 1.0f - 1e-6f)); }
            LAS float* p0 = ldsf + (HF_TG0 >> 2) + ti * 132 + d0; LAS float* p1 = ldsf + (HF_TG1 >> 2) + ti * 132 + d0;
            *(LAS f32x4*)p0 = (f32x4){ga[0], ga[1], ga[2], ga[3]}; *(LAS f32x4*)(p0 + 4) = (f32x4){ga[4], ga[5], ga[6], ga[7]};
            *(LAS f32x4*)p1 = (f32x4){gb[0], gb[1], gb[2], gb[3]}; *(LAS f32x4*)(p1 + 4) = (f32x4){gb[4], gb[5], gb[6], gb[7]};
        }
        __syncthreads();
        if (tid < 256) { const bool rev = tid >= 128; LAS float* gc = ldsf + ((rev ? HF_TG1 : HF_TG0) >> 2) + (tid & 127); float run = rev ? off1 : carry; float gv[32];
#pragma unroll
            for (int i = 0; i < 32; ++i) gv[i] = gc[(rev ? 31 - i : i) * 132];
            SBAR
#pragma unroll
            for (int i = 0; i < 32; ++i) { run += gv[i]; gc[(rev ? 31 - i : i) * 132] = run; }
            if (!rev) carry = run; }
        __syncthreads();
        {
            const LAS float* g0 = ldsf + (HF_TG0 >> 2) + ti * 132 + d0; const LAS float* g1 = ldsf + (HF_TG1 >> 2) + ti * 132 + d0;
            float a[8], c[8];
#pragma unroll
            for (int j = 0; j < 8; ++j) { a[j] = q[j] * __builtin_amdgcn_exp2f(g0[j]); c[j] = q[j] * __builtin_amdgcn_exp2f(g1[j]); }
            *(LAS bf16x8*)(lds + HF_QG0 + ti * 272 + d0 * 2) = pack8(a[0], a[1], a[2], a[3], a[4], a[5], a[6], a[7]);
            *(LAS bf16x8*)(lds + HF_QG1 + ti * 272 + d0 * 2) = pack8(c[0], c[1], c[2], c[3], c[4], c[5], c[6], c[7]);
        }
        __syncthreads();
        {
            f32x16 acc;
#pragma unroll
            for (int i = 0; i < 16; ++i) acc[i] = 0.f;
            const LAS unsigned char* qp = lds + (ds ? HF_QG1 : HF_QG0) + r32 * 272 + 16 * hh;
            const LAS unsigned char* sp = lds + (ds ? HF_S1 : HF_S0) + (8 * hh + (i16 >> 2)) * 320 + (32 * nt + 16 * cg + 4 * (i16 & 3)) * 2;
#pragma unroll
            for (int k = 0; k < 8; ++k) { const bf16x8 sf = trpair(sp + 16 * k * 320, 4 * 320); acc = __builtin_amdgcn_mfma_f32_32x32x16_bf16(*(const LAS bf16x8*)(qp + 32 * k), sf, acc, 0, 0, 0); }
            LAS float* ob = ldsf + ((ds ? HF_TG1 : HF_TG0) >> 2) + (4 * hh) * 132 + 32 * nt + r32;
#pragma unroll
            for (int i = 0; i < 16; ++i) ob[R0(i) * 132] = acc[i];
        }
        __syncthreads();
        {
            const LAS float* oa = ldsf + (HF_TG0 >> 2) + ti * 132 + d0; const LAS float* obb = ldsf + (HF_TG1 >> 2) + ti * 132 + d0;
            const f32x4 a0 = *(const LAS f32x4*)oa, a1 = *(const LAS f32x4*)(oa + 4), b0 = *(const LAS f32x4*)obb, b1 = *(const LAS f32x4*)(obb + 4);
            const f32x4 o0 = a0 + b0 + olp0, o1 = a1 + b1 + olp1;
            float ss = (o0[0] * o0[0] + o0[1] * o0[1]) + (o0[2] * o0[2] + o0[3] * o0[3]) + (o1[0] * o1[0] + o1[1] * o1[1]) + (o1[2] * o1[2] + o1[3] * o1[3]);
            ss += __shfl_xor(ss, 1); ss += __shfl_xor(ss, 2); ss += __shfl_xor(ss, 4); ss += __shfl_xor(ss, 8);
            const float r = __builtin_amdgcn_rsqf(ss * (1.0f / 128.0f) + 1e-6f);
            u32x4 w;
            w.x = pk2(o0[0] * r * n0[0] * siluf_(bflo(ug.x)), o0[1] * r * n0[1] * siluf_(bfhi(ug.x))); w.y = pk2(o0[2] * r * n0[2] * siluf_(bflo(ug.y)), o0[3] * r * n0[3] * siluf_(bfhi(ug.y)));
            w.z = pk2(o1[0] * r * n1[0] * siluf_(bflo(ug.z)), o1[1] * r * n1[1] * siluf_(bfhi(ug.z))); w.w = pk2(o1[2] * r * n1[2] * siluf_(bflo(ug.w)), o1[3] * r * n1[3] * siluf_(bfhi(ug.w)));
            *(u32x4*)(MIX + (size_t)rown * D_MODEL + 1024 + h * 128 + d0) = w;
        }
        __syncthreads();
    }
}

#define RLX_AGENT __ATOMIC_RELAXED, __HIP_MEMORY_SCOPE_AGENT
#define XB_TMO      128
#define XB_XCNT(j)  (256  + 64 * (j))
#define XB_XSUB(j)  (1280 + 64 * (j))
#define XB_XGEN(j)  (2304 + 64 * (j))
#define XB_TOP      3328
#define XB_TOPGEN   3392
#define XCD_BAR_WORDS 3456
#define XB_SPIN_CAP (1u << 18)

__device__ __forceinline__ unsigned xb_ld(unsigned* p)              { return __hip_atomic_load(p, __ATOMIC_RELAXED, __HIP_MEMORY_SCOPE_AGENT); }
__device__ __forceinline__ unsigned xb_add(unsigned* p, unsigned v) { return __hip_atomic_fetch_add(p, v, __ATOMIC_RELAXED, __HIP_MEMORY_SCOPE_AGENT); }
__device__ __forceinline__ unsigned xb_xcc_id() { return (unsigned)__builtin_amdgcn_s_getreg((3 << 11) | 20) & 0xFu; }
#define XB_SPIN(cond, bar) do { unsigned _sp = 0; while (cond) { __builtin_amdgcn_s_sleep(1); \
    if ((++_sp & 255u) == 0u) { if (xb_ld(&(bar)[XB_TMO])) break; if (_sp > XB_SPIN_CAP) { atomicAdd(&(bar)[XB_TMO], 1u); break; } } } } while (0)

struct XcdBarrier {
    unsigned* bar; unsigned x; bool t0;
    volatile LAS unsigned* st;
};

__device__ __forceinline__ XcdBarrier xcd_barrier_post(unsigned* bar, volatile LAS unsigned* st) {
    XcdBarrier b; b.bar = bar; b.x = xb_xcc_id(); b.st = st; b.t0 = (threadIdx.x == 0);
    if (threadIdx.x == 0) (void)xb_add(&bar[XB_XCNT(b.x)], 1u);
    return b;
}
__device__ __forceinline__ void xcd_barrier_complete(unsigned* bar, unsigned x, unsigned& nloc, unsigned& nx) {
    const unsigned G = gridDim.x * gridDim.y * gridDim.z;
    unsigned sum, cnt, mine, sp = 0u;
    for (;;) {
        sum = 0u; cnt = 0u; mine = 0u;
#pragma unroll
        for (unsigned j = 0; j < 16; ++j) { const unsigned c = xb_ld(&bar[XB_XCNT(j)]); sum += c; cnt += (c > 0u) ? 1u : 0u; mine = (j == x) ? c : mine; }
        if (sum == G) break;
        __builtin_amdgcn_s_sleep(1);
        if ((++sp & 255u) == 0u) { if (xb_ld(&bar[XB_TMO])) break; if (sp > XB_SPIN_CAP) { atomicAdd(&bar[XB_TMO], 1u); break; } }
    }
    nloc = mine > 0u ? mine : 1u; nx = cnt > 0u ? cnt : 1u;
}

__device__ __forceinline__ void xcd_barrier(const XcdBarrier& b) {
    asm volatile("s_waitcnt vmcnt(0)" ::: "memory");
    __syncthreads();
    if (b.t0) {
        unsigned* bar = b.bar;
        __builtin_amdgcn_s_waitcnt(0);
        unsigned nloc = b.st[0], nx = b.st[1];
        if (nloc == 0u) { xcd_barrier_complete(bar, b.x, nloc, nx); b.st[0] = nloc; b.st[1] = nx; }
        const unsigned old = xb_add(&bar[XB_XSUB(b.x)], 1u);
        const unsigned gen = old / nloc;
        if (old + 1u == (gen + 1u) * nloc) {
            __builtin_amdgcn_fence(__ATOMIC_RELEASE, "agent");
            asm volatile("s_waitcnt vmcnt(0)" ::: "memory");
            const unsigned og = xb_add(&bar[XB_TOP], 1u);
            const unsigned tg = og / nx;
            if (og + 1u == (tg + 1u) * nx) xb_add(&bar[XB_TOPGEN], 1u);
            else XB_SPIN(xb_ld(&bar[XB_TOPGEN]) == tg, bar);
            __builtin_amdgcn_fence(__ATOMIC_ACQUIRE, "agent");
            xb_add(&bar[XB_XGEN(b.x)], 1u);
            asm volatile("s_waitcnt vmcnt(0)" ::: "memory");
        } else {
            XB_SPIN(xb_ld(&bar[XB_XGEN(b.x)]) == gen, bar);
            __builtin_amdgcn_fence(__ATOMIC_ACQUIRE, "agent");
            asm volatile("s_waitcnt vmcnt(0)" ::: "memory");
        }
    }
    __syncthreads();
}

#ifndef REP_P0
#define REP_P0 1
#endif
#ifndef REP_P1
#define REP_P1 1
#endif
#ifndef REP_P2
#define REP_P2 1
#endif
#ifndef PROBE_KIND
#define PROBE_KIND -1
#endif
#ifndef P0_MASK
#define P0_MASK 3
#endif
#ifndef P2_MASK
#define P2_MASK 31
#endif
#ifndef REP_P3
#define REP_P3 1
#endif
#ifndef REP_P4
#define REP_P4 1
#endif
__global__ void __launch_bounds__(NTHREADS, 2) fwd_kernel(Params Pkarg) {
    extern __shared__ __attribute__((aligned(16))) unsigned char lds_raw[];
    cg::grid_group grid = cg::this_grid();
    LAS unsigned char* lds = (LAS unsigned char*)lds_raw;
    LAS float* ldsf = (LAS float*)lds;
    volatile LAS unsigned* qslot = (volatile LAS unsigned*)(lds + LDS_CTLW);
    volatile LAS unsigned* xbst = (volatile LAS unsigned*)(lds + LDS_CTLW + 128);
    if (threadIdx.x < 2) xbst[threadIdx.x] = 0u;
    __syncthreads();
    (void)xcd_barrier_post((unsigned*)(Pkarg.ws + WS_CTL) + 1024, xbst);
#define GSYNC() do { PP Pb_ = (PP)__builtin_amdgcn_kernarg_segment_ptr(); asm volatile("" : "+s"(Pb_)); XcdBarrier xb_; xb_.bar = (unsigned*)(Pb_->ws + WS_CTL) + 1024; xb_.x = xb_xcc_id(); xb_.st = xbst; int ln_; asm volatile("v_mbcnt_lo_u32_b32 %0, -1, 0\n\tv_mbcnt_hi_u32_b32 %0, -1, %0" : "=v"(ln_)); xb_.t0 = (wave_s == 0) && (ln_ == 0); xcd_barrier(xb_); } while (0)
    const int wave_s = __builtin_amdgcn_readfirstlane(threadIdx.x >> 6);
#define PHASE_IDS int tid; asm volatile("v_mbcnt_lo_u32_b32 %0, -1, 0\n\tv_mbcnt_hi_u32_b32 %0, -1, %0" : "=v"(tid)); tid += wave_s * 64; const int lane = tid & 63, wave = wave_s, gw = blockIdx.x * NWAVES + wave; (void)lane; (void)gw; \
    PP P = (PP)__builtin_amdgcn_kernarg_segment_ptr(); asm volatile("" : "+s"(P)); unsigned char* ws = P->ws; unsigned* ctl = (unsigned*)(ws + WS_CTL); float* MOD = (float*)(ws + WS_MOD); \
    bf16* H = (bf16*)(ws + WS_H); bf16* Z = (bf16*)(ws + WS_Z); bf16* WTIN = (bf16*)(ws + WS_WTIN); bf16* WTOUT = (bf16*)(ws + WS_WTOUT); const float* xp = P->in[0]; const float* xs = P->in[1]; \
    (void)ctl; (void)MOD; (void)H; (void)Z; (void)WTIN; (void)WTOUT; (void)xp; (void)xs;
    const int G = gridDim.x, NGW = G * NWAVES;

    for (int rep = 0; rep < REP_P0; ++rep) {
        PHASE_IDS
        const int m0 = (rep == 0) ? 3 : P0_MASK;
        if (m0 & 1) for (int u = blockIdx.x; u < 384; u += G) mod_unit(P, ldsf, u / 192, u % 192, tid);
        LAS float* scr = ldsf + wave * 4096;
        if (m0 & 2) for (int it = gw; it < 6656 + 2048 + 2048; it += NGW) {
            if (it < 6656) transpose_item(P->in[9], 2048, DIN, WTIN, scr, it, lane);
            else if (it < 6656 + 2048) transpose_item(P->in[10], 2048, 2048, WTOUT, scr, it - 6656, lane);
            else transpose_item(P->in[10] + (size_t)2048 * 2048, 2048, 2048, WTOUT + (size_t)2048 * 2048, scr, it - 6656 - 2048, lane);
        }
        { const int gt4 = (blockIdx.x * NTHREADS + tid) * 4;
          if (gt4 < 524288) { const float* src = (gt4 < 262144) ? P->in[2] + gt4 : P->in[3] + (gt4 - 262144); const f32x4 v = *(const f32x4*)src;
              u32x2 w; w.x = pk2(v[0], v[1]); w.y = pk2(v[2], v[3]); *(u32x2*)((bf16*)(ws + WS_CKV) + gt4) = w; } }
        const int gt = blockIdx.x * NTHREADS + tid;
        if (gt < 2048) { const int pos = gt >> 5, i = gt & 31; const float inv = powf(10000.0f, -(float)i / 32.0f); const float ang = (float)pos * inv;
            float sn, cs; sincosf(ang, &sn, &cs); float* CS = (float*)(ws + WS_CS); CS[gt * 2] = cs; CS[gt * 2 + 1] = sn; }
        grid.sync();
    }
    { PHASE_IDS
    for (int row = gw; row < MTOK; row += NGW) {
        const int cond = (row < NCTX) ? 0 : 1 + ((row - NCTX) >> 11);
        const float* xrow = (row < NCTX) ? xp + (size_t)row * D_MODEL : xs + (size_t)(row - NCTX) * D_MODEL;
        hprep_row(xrow, MOD + (0 * 3 + cond) * 6144, H + (size_t)row * D_MODEL, lane);
    } }
    GSYNC();

    for (int l = 0; l < DEPTH; ++l) {
        for (int rep = 0; rep < REP_P1; ++rep) {
            PHASE_IDS
            pg8::Gemm g{H, WTIN, MTOK, DIN, D_MODEL}; pg8::StaticOrder S; S.init(MTOK, DIN, D_MODEL, G, (int)blockIdx.x);
            pg8::EpiZ E{Z, P->out + OUT_CK, P->out + OUT_CV, l};
            pg8::gemm_phase<pg8::EpiZ, pg8::StaticOrder, true, true>(lds, g, S, E, tid);
            GSYNC();
        }
        for (int rep = 0; rep < REP_P2; ++rep) {
            PHASE_IDS
            unsigned* ctr = ctl + 64 * (l * 2 + 0 + 4 * rep);
            const int n_cvt = (l == 0) ? 832 : 0;
            const int msk = (rep == 0) ? 31 : P2_MASK;
            unsigned pend = 0u;
            unsigned long long pr_sum = 0ull; unsigned pr_cnt = 0u;
            for (int u = q_first(ctr, qslot, tid, pend); u < 1024 + n_cvt; u = q_next(ctr, qslot, tid, pend)) {
                asm volatile("" : "+v"(tid));
                const int ukind = (u < 128) ? 0 : (u < 256) ? 1 : (u < 512) ? 2 : (u < 640) ? 3 : (u < 1024) ? 4 : 5;
                const unsigned long long pr_t0 = (PROBE_KIND >= 0) ? __builtin_amdgcn_s_memrealtime() : 0ull;
                struct PrEnd { unsigned long long t0; unsigned long long& s; unsigned& c; int k; __device__ ~PrEnd() { if (PROBE_KIND >= 0 && k == PROBE_KIND) { __syncthreads(); s += __builtin_amdgcn_s_memrealtime() - t0; c += 1u; } } } pr_end{pr_t0, pr_sum, pr_cnt, ukind};
                if (u < 128) { if (msk & 2) attn_unit(P, lds, l, 1, u, tid); continue; } u -= 128;
                if (u < 128) { if (msk & 1) hgrn2_unit(P, lds, l, 0, u, tid); continue; } u -= 128;
                if (u < 256) { if (msk & 4) attn_unit(P, lds, l, 0, u, tid); continue; } u -= 256;
                if (u < 128) { if (msk & 1) hgrn2_unit(P, lds, l, 1, u, tid); continue; } u -= 128;
                if (u < 384) { if (msk & 8) conv_unit(P, ldsf, l, u, tid); continue; } u -= 384;
                if (msk & 16) { const int lane2 = tid & 63; LAS float* scr = ldsf + wave * 4096; transpose_item(P->in[9] + (size_t)2048 * DIN, 2048, DIN, WTIN, scr, u * 8 + wave, lane2); }
            }
            if (PROBE_KIND >= 0 && l == 0 && tid == 0) { atomicAdd((unsigned long long*)(ctl + 60000), pr_sum); atomicAdd(ctl + 60002, pr_cnt); }
            GSYNC();
        }
        { PHASE_IDS hgrn_scan(P, l, tid); }
        GSYNC();
        for (int rep = 0; rep < REP_P3; ++rep) {
            PHASE_IDS
            unsigned* ctr = ctl + 64 * (l * 2 + 1 + 4 * rep);
            unsigned pend = 0u;
            for (int u = q_first(ctr, qslot, tid, pend); u < 256; u = q_next(ctr, qslot, tid, pend)) {
                asm volatile("" : "+v"(tid));
                hgrn_final_unit(P, lds, l, u >> 1, u & 1, tid);
            }
            GSYNC();
        }
        for (int rep = 0; rep < ((l == 0) ? REP_P4 : 1); ++rep) {
            PHASE_IDS
            pg8::Gemm g{H, WTOUT + (size_t)l * 2048 * 2048, MTOK, D_MODEL, D_MODEL}; pg8::StaticOrder S; S.init(MTOK, D_MODEL, D_MODEL, G, (int)blockIdx.x, 0);
            pg8::EpiV E{(l == 0) ? xp : P->out, (l == 0) ? xs : P->out + OUT_YS, P->out, MOD + l * 3 * 6144 + 4096, (float*)(ws + WS_OL), ctl + 8192 + (l * 2 + rep) * 128 * 64};
            pg8::gemm_phase<pg8::EpiV, pg8::StaticOrder, true, true>(lds, g, S, E, tid);
            GSYNC();
        }
        { PHASE_IDS
        for (int row = gw; row < MTOK; row += NGW) {
            const int cond = (row < NCTX) ? 0 : 1 + ((row - NCTX) >> 11);
            ln_row(P->out + (size_t)row * D_MODEL, P->in[18] + l * D_MODEL, P->in[19] + l * D_MODEL, MOD + (3 + cond) * 6144, (l == 0) ? H + (size_t)row * D_MODEL : (bf16*)nullptr, lane);
        } }
        if (l + 1 < DEPTH) GSYNC();
    }
    if (PROBE_KIND >= 0) { GSYNC(); PHASE_IDS if (blockIdx.x == 0 && tid == 0) { const unsigned long long sm = *(volatile unsigned long long*)(ctl + 60000); const unsigned cn = *(volatile unsigned*)(ctl + 60002); const float pv_ = ((PROBE_KIND == 9) ? 0.1f : 0.01f) * (float)sm / (float)(cn ? cn : 1u);     P->out[0] = pv_; P->out[1] = pv_; P->out[2] = pv_; P->out[3] = pv_; }     }
}

extern "C" void kernel_launch(void* const* d_in, const int* in_sizes, int n_in, void* d_out, int out_size, void* d_ws, size_t ws_size, hipStream_t stream) {
    static int grid = 0;
    if (grid == 0) {
        if (n_in != 20 || out_size != (int)OUT_TOTAL || ws_size < WS_END) { fprintf(stderr, "kernel_launch: unexpected shapes (n_in %d, out %d, ws %zu)\n", n_in, out_size, ws_size); grid = -1; return; }
        int dev = 0, cus = 0, per_cu = 0;
        hipGetDevice(&dev); hipDeviceGetAttribute(&cus, hipDeviceAttributeMultiprocessorCount, dev);
        hipFuncSetAttribute((const void*)fwd_kernel, hipFuncAttributeMaxDynamicSharedMemorySize, LDS_BYTES);
        hipOccupancyMaxActiveBlocksPerMultiprocessor(&per_cu, (const void*)fwd_kernel, NTHREADS, LDS_BYTES);
        if (per_cu < 1) { fprintf(stderr, "kernel_launch: occupancy query says %d blocks per CU\n", per_cu); grid = -1; return; }
        grid = cus;
    }
    if (grid < 0) return;
    hipMemsetAsync((char*)d_ws + WS_CTL, 0, CTL_ZERO_BYTES, stream);
    Params p{};
    for (int i = 0; i < 20; ++i) p.in[i] = (const float*)d_in[i];
    p.out = (float*)d_out; p.ws = (unsigned char*)d_ws;
    void* args[] = {&p};
    hipError_t e = hipLaunchCooperativeKernel((const void*)fwd_kernel, dim3(grid), dim3(NTHREADS), args, LDS_BYTES, stream);
    if (e != hipSuccess) fprintf(stderr, "cooperative launch failed: %s (grid %d)\n", hipGetErrorString(e), grid);
}
```

```cpp
#include <hip/hip_runtime.h>
#include <hip/hip_cooperative_groups.h>
#include <cstdio>
#include <cstdint>
namespace cg = cooperative_groups;

constexpr int D_MODEL = 2048, DIN = 6656, NCTX = 8192, NLAT = 4096, MTOK = 12288, DEPTH = 2;
constexpr int C_AQ = 0, C_AK = 1024, C_AV = 1280, C_AG = 1536, C_HQ = 2560, C_HI = 3072, C_HFF = 3584, C_HFB = 4096, C_HG = 4608, C_CA = 5120, C_CB = 5632, C_CG = 6144;
constexpr float ALPHA_DN = 1.4142135623730951f;
constexpr size_t OUT_YP = 0, OUT_YS = 16777216, OUT_CK = 25165824, OUT_CV = 29360128, OUT_ST = 33554432, OUT_TOTAL = 41943040;
namespace pg8 {
#define PG8_LAS __attribute__((address_space(3)))
typedef unsigned short bf16_t;
typedef short bf16x8 __attribute__((ext_vector_type(8)));
typedef float f32x4 __attribute__((ext_vector_type(4)));
typedef unsigned u32x4 __attribute__((ext_vector_type(4)));
constexpr int BM = 256, BK = 64, HALF = 128, HTB = HALF * BK * 2  , STAGE_BYTES = 8 * HTB, NXCD = 8, WGM = 8;

__host__ __device__ __forceinline__ int lds_byte(int r, int c) { const int st = (r >> 4) * 2 + (c >> 5), rr = r & 15, cc = c & 31, ob = rr * 64 + cc * 2; return st * 1024 + (ob ^ (((ob >> 9) & 1) << 5)); }
__host__ __device__ __forceinline__ void stage_rc(int b, int& R, int& C) { const int st = b / 1024, sb = b % 1024, swz = sb ^ (((sb >> 9) & 1) << 5); R = (st >> 1) * 16 + swz / 64; C = (st & 1) * 32 + (swz % 64) / 2; }
__host__ __device__ __forceinline__ int perm32(int rho) { const int n = rho >> 4, i = rho & 15; return 8 * (i >> 2) + 4 * n + (i & 3); }

struct Unit { int pm, pn, k0, nk, role, pair; };
struct Gemm { const bf16_t* A; const bf16_t* Bt; int M, N, K; };

struct StaticOrder {
    int nM, nN, nwg, G, c, nkt, split, rset;
    __host__ __device__ void init(int M, int N, int K, int G_, int c_, int split_ = 0) { nM = M / BM; nN = N / BM; nwg = nM * nN; G = G_; c = c_; nkt = K / BK; split = split_ && (G_ % 16 == 0) && (2 * nwg == 3 * G_) && (nkt % 4 == 0); rset = -1; }
    __host__ __device__ void map(long L, Unit& u) const {
        int wgid = (int)L; { const int q = nwg / NXCD, r = nwg % NXCD, xcd = wgid % NXCD, off = wgid / NXCD; wgid = (xcd < r ? xcd * (q + 1) : r * (q + 1) + (xcd - r) * q) + off; }
        const int nig = WGM * nN, gid = wgid / nig, fm = gid * WGM, gsz = (nM - fm) < WGM ? (nM - fm) : WGM;
        u.pm = fm + ((wgid % nig) % gsz); u.pn = (wgid % nig) / gsz; u.k0 = 0; u.nk = nkt; u.role = 0; u.pair = 0;
    }
    __host__ __device__ bool next(int i, Unit& u) const {
        if (rset >= 0) {
            if (i != 0) return false;
            const int xcd = c & 7, ix = c >> 3;
            if (rset == 0) { u.pm = xcd * 4 + (ix >> 3); u.pn = ix & 7; } else { if (c >= 128) return false; u.pm = 32 + xcd * 2 + (ix >> 3); u.pn = ix & 7; }
            u.k0 = 0; u.nk = nkt; u.role = 0; u.pair = 0; return true;
        }
        if (split) {
            if (i == 0) { map(c, u); return true; }
            if (i == 1) { const int j = (c >> 4) * 8 + (c & 7), half = (c >> 3) & 1; map(G + j, u); u.k0 = half * (nkt / 2); u.nk = nkt / 2; u.role = 1 + half; u.pair = j; return true; }
            return false;
        }
        const long L = (long)i * G + c; if (L >= nwg) return false;
        map(L, u); return true;
    }
    __device__ __forceinline__ void a_ready(const Unit&) const {}
    __device__ __forceinline__ void done(const Unit&) const {}
};

__device__ __forceinline__ unsigned cvt_pk_bf16(float lo, float hi) { unsigned r; asm volatile("v_cvt_pk_bf16_f32 %0, %1, %2" : "=v"(r) : "v"(lo), "v"(hi)); return r; }
typedef float f32x2 __attribute__((ext_vector_type(2)));

struct EpiZ {
    static constexpr bool PERM = true, AFTER_DRAIN = false;
    bf16_t* Z; float* ck; float* cv; int layer;
    __device__ __forceinline__ void operator()(f32x4 (&acc)[2][2][4][2], const Unit& u, int wr, int wc, int fr_in, int fq_in) const {
        int fr = fr_in, fq = fq_in; asm volatile("" : "+v"(fr), "+v"(fq));
        const int row0 = u.pm * BM + wr * 64 + fr; const int col0 = u.pn * BM + wc * 32 + 8 * fq;
#pragma unroll
        for (int ai = 0; ai < 2; ++ai)
#pragma unroll
            for (int m = 0; m < 4; ++m) { bf16_t* rowp = Z + (size_t)(row0 + ai * HALF + m * 16) * DIN + col0;
#pragma unroll
                for (int bj = 0; bj < 2; ++bj) { const f32x4 v0 = acc[ai][bj][m][0], v1 = acc[ai][bj][m][1];
                    u32x4 w; w.x = cvt_pk_bf16(v0[0], v0[1]); w.y = cvt_pk_bf16(v0[2], v0[3]); w.z = cvt_pk_bf16(v1[0], v1[1]); w.w = cvt_pk_bf16(v1[2], v1[3]);
                    *(u32x4*)(rowp + bj * HALF) = w; } }
        if ((u.pn == 4 || u.pn == 5) && u.pm < 32) {
            float* base = (u.pn == 4) ? ck : cv;
#pragma unroll
            for (int ai = 0; ai < 2; ++ai)
#pragma unroll
                for (int m = 0; m < 4; ++m) { const int row = row0 + ai * HALF + m * 16; const int b = row >> 8, s = row & 255;
                    float* p = base + ((size_t)((b * 2 + layer) * 256 + s)) * 256 + (wc * 32 + 8 * fq);
#pragma unroll
                    for (int bj = 0; bj < 2; ++bj) { *(f32x4*)(p + bj * HALF) = acc[ai][bj][m][0]; *(f32x4*)(p + bj * HALF + 4) = acc[ai][bj][m][1]; } }
        }
    }
};
struct EpiV {
    static constexpr bool PERM = false, AFTER_DRAIN = false;
    const float* xp; const float* xs; float* V; const float* gate;
    float* slab; unsigned* flags;
    __device__ __forceinline__ void operator()(f32x4 (&acc)[2][2][4][2], const Unit& u, int wr, int wc, int fr_in, int fq_in) const {
        int fr = fr_in, fq = fq_in; asm volatile("" : "+v"(fr), "+v"(fq));
        const int lane = fq * 16 + fr, tid = (wr * 4 + wc) * 64 + lane;
        float* sp = slab + (size_t)u.pair * 65536 + tid * 4; unsigned* fl = flags + 64 * u.pair;
        if (u.role == 1) {
            { float* q = sp;
#pragma unroll
              for (int ai = 0; ai < 2; ++ai)
#pragma unroll
                for (int m = 0; m < 4; ++m)
#pragma unroll
                    for (int bj = 0; bj < 2; ++bj)
#pragma unroll
                        for (int n = 0; n < 2; ++n) {
                            asm volatile("global_store_dwordx4 %0, %1, off sc1\n\ts_nop 1" :: "v"(q), "v"(acc[ai][bj][m][n]) : "memory");
                            q += 2048; asm volatile("" : "+v"(q)); } }
            asm volatile("s_waitcnt vmcnt(0)" ::: "memory");
            if (lane == 0) __hip_atomic_fetch_add(fl, 1u, __ATOMIC_RELAXED, __HIP_MEMORY_SCOPE_AGENT);
            return;
        }
        const bool red = (u.role == 2);
        if (red) {
            unsigned sp_ = 0;
            while ((unsigned)__builtin_amdgcn_readfirstlane(__hip_atomic_load(fl, __ATOMIC_RELAXED, __HIP_MEMORY_SCOPE_AGENT)) < 8u) { __builtin_amdgcn_s_sleep(2); if (++sp_ > (1u << 20)) break; }
            asm volatile("" ::: "memory");
        }
        const int row0 = u.pm * BM + wr * 64 + fr; const int col0 = u.pn * BM + wc * 32 + 4 * fq;
        const int cond = (u.pm < 32) ? 0 : 1 + ((u.pm - 32) >> 3);
        const float* g = gate + cond * 6144 + col0;
        f32x4 gv[2][2];
#pragma unroll
        for (int bj = 0; bj < 2; ++bj)
#pragma unroll
            for (int n = 0; n < 2; ++n) gv[bj][n] = *(const f32x4*)(g + bj * HALF + n * 16);
        if (!red) {
            f32x4 xq[2][4];
            { const int row = row0; const float* xr = ((row < NCTX) ? xp + (size_t)row * D_MODEL : xs + (size_t)(row - NCTX) * D_MODEL) + col0;
#pragma unroll
              for (int e = 0; e < 4; ++e) xq[0][e] = *(const f32x4*)(xr + (e >> 1) * HALF + (e & 1) * 16); }
#pragma unroll
            for (int g8 = 0; g8 < 8; ++g8) { const int ai = g8 >> 2, m = g8 & 3; const int row = row0 + ai * HALF + m * 16;
                if (g8 + 1 < 8) { const int rown = row0 + ((g8 + 1) >> 2) * HALF + ((g8 + 1) & 3) * 16;
                    const float* xr = ((rown < NCTX) ? xp + (size_t)rown * D_MODEL : xs + (size_t)(rown - NCTX) * D_MODEL) + col0;
#pragma unroll
                    for (int e = 0; e < 4; ++e) xq[(g8 + 1) & 1][e] = *(const f32x4*)(xr + (e >> 1) * HALF + (e & 1) * 16); }
                float* vr = V + (size_t)row * D_MODEL + col0;
#pragma unroll
                for (int e = 0; e < 4; ++e) *(f32x4*)(vr + (e >> 1) * HALF + (e & 1) * 16) = xq[g8 & 1][e] * ALPHA_DN + gv[e >> 1][e & 1] * acc[ai][e >> 1][m][e & 1];
                asm volatile("" ::: "memory"); }
        } else {
            const float* rq = sp;
#pragma unroll
            for (int ai = 0; ai < 2; ++ai)
#pragma unroll
                for (int m = 0; m < 4; ++m) { const int row = row0 + ai * HALF + m * 16;
                    const float* xr = ((row < NCTX) ? xp + (size_t)row * D_MODEL : xs + (size_t)(row - NCTX) * D_MODEL) + col0;
                    float* vr = V + (size_t)row * D_MODEL + col0;
                    f32x4 t[2][2];
#pragma unroll
                    for (int bj = 0; bj < 2; ++bj)
#pragma unroll
                        for (int n = 0; n < 2; ++n) { const unsigned long long* q8 = (const unsigned long long*)rq;
                            const unsigned long long a8 = __hip_atomic_load(q8, __ATOMIC_RELAXED, __HIP_MEMORY_SCOPE_AGENT), b8 = __hip_atomic_load(q8 + 1, __ATOMIC_RELAXED, __HIP_MEMORY_SCOPE_AGENT);
                            t[bj][n] = (f32x4){__builtin_bit_cast(float, (unsigned)a8), __builtin_bit_cast(float, (unsigned)(a8 >> 32)), __builtin_bit_cast(float, (unsigned)b8), __builtin_bit_cast(float, (unsigned)(b8 >> 32))};
                            rq += 2048; asm volatile("" : "+v"(rq)); }
#pragma unroll
                    for (int bj = 0; bj < 2; ++bj)
#pragma unroll
                        for (int n = 0; n < 2; ++n) { const f32x4 xv = *(const f32x4*)(xr + bj * HALF + n * 16);
                            *(f32x4*)(vr + bj * HALF + n * 16) = xv * ALPHA_DN + gv[bj][n] * (acc[ai][bj][m][n] + t[bj][n]); }
                    asm volatile("" ::: "memory"); }
        }
    }
};
template <class Epi, class Sched, bool ALIGN_EPI = false, bool SP2 = false>
__device__ __forceinline__ void gemm_phase(PG8_LAS unsigned char* lds, const Gemm g, const Sched& S, const Epi& E, int tid_in) {
    int tid_l = tid_in; asm volatile("" : "+v"(tid_l));
    const int tid = tid_l, wid = __builtin_amdgcn_readfirstlane(tid >> 6), lane = tid & 63, wr = wid >> 2, wc = wid & 3, fr = lane & 15, fq = lane >> 4;
    const int K = g.K;
    unsigned voffA[2], voffB[2];
#pragma unroll
    for (int i = 0; i < 2; ++i) { int R, C; stage_rc(tid * 16 + i * 8192, R, C); const int Rb = Epi::PERM ? ((R & ~31) + perm32(R & 31)) : R;
        voffA[i] = (unsigned)(R * K + C) * 2u; voffB[i] = (unsigned)(Rb * K + C) * 2u; }
    const size_t kstep = (size_t)(BK * 2);
    const size_t hstep = (size_t)HALF * K * 2;
    const size_t tstep = 2 * hstep;
    const unsigned ldsw = (unsigned)wid * 1024u;
    const int aoff = lds_byte(wr * 64 + fr, fq * 8), boff = lds_byte(wc * 32 + fr, fq * 8);
#define PG8_SA(b, h) (((b) * 2 + (h)) * HTB)
#define PG8_SB(b, h) ((4 + (b) * 2 + (h)) * HTB)
#define PG8_STAGE(bufoff, gbase, voff) do { _Pragma("unroll") for (int _i = 0; _i < 2; ++_i) \
        __builtin_amdgcn_global_load_lds((const unsigned*)((const char*)(gbase) + (voff)[_i]), (PG8_LAS unsigned*)(lds + (bufoff) + ldsw + _i * 8192), 16, 0, 0); } while (0)
#define PG8_LDA(dst, b, h) do { _Pragma("unroll") for (int m = 0; m < 4; ++m) _Pragma("unroll") for (int k = 0; k < 2; ++k) dst[m][k] = *(const PG8_LAS bf16x8*)(lds + PG8_SA(b, h) + aoff + m * 2048 + k * 1024); } while (0)
#define PG8_LDB(dst, b, h) do { _Pragma("unroll") for (int n = 0; n < 2; ++n) _Pragma("unroll") for (int k = 0; k < 2; ++k) dst[n][k] = *(const PG8_LAS bf16x8*)(lds + PG8_SB(b, h) + boff + n * 2048 + k * 1024); } while (0)
#define PG8_MMA(ai, bj, At, Bt) do { __builtin_amdgcn_s_setprio(1); _Pragma("unroll") for (int m = 0; m < 4; ++m) _Pragma("unroll") for (int n = 0; n < 2; ++n) _Pragma("unroll") for (int k = 0; k < 2; ++k) \
        acc[ai][bj][m][n] = __builtin_amdgcn_mfma_f32_16x16x32_bf16(Bt[n][k], At[m][k], acc[ai][bj][m][n], 0, 0, 0); __builtin_amdgcn_s_setprio(0); } while (0)
#define PG8_WAIT_V(n) asm volatile("s_waitcnt vmcnt(" #n ")" ::: "memory")
#define PG8_WAIT_L(n) asm volatile("s_waitcnt lgkmcnt(" #n ")" ::: "memory")
#define PG8_BAR __builtin_amdgcn_s_barrier()
#define PG8_SCHED __builtin_amdgcn_sched_barrier(0)
    Unit cur, nxt; int ui = 0;
    if (!S.next(0, cur)) return;
    f32x4 acc[2][2][4][2];
#pragma unroll
    for (int a = 0; a < 2; ++a)
#pragma unroll
        for (int b = 0; b < 2; ++b)
#pragma unroll
            for (int m = 0; m < 4; ++m)
#pragma unroll
                for (int n = 0; n < 2; ++n) acc[a][b][m][n] = (f32x4){0.f, 0.f, 0.f, 0.f};
    bf16x8 At[4][2], B0[2][2], B1[2][2];
    const char* cA = (const char*)g.A + (size_t)cur.pm * tstep + (size_t)cur.k0 * kstep; const char* cB = (const char*)g.Bt + (size_t)cur.pn * tstep + (size_t)cur.k0 * kstep;
    S.a_ready(cur);
    if constexpr (SP2) {
        PG8_STAGE(PG8_SB(0, 0), cB, voffB); PG8_STAGE(PG8_SB(0, 1), cB + hstep, voffB); PG8_STAGE(PG8_SA(0, 0), cA, voffA); PG8_STAGE(PG8_SA(0, 1), cA + hstep, voffA);
        if (wr == 1) PG8_BAR;
        PG8_WAIT_V(2); PG8_BAR;
        PG8_STAGE(PG8_SB(1, 0), cB + kstep, voffB); PG8_STAGE(PG8_SA(1, 0), cA + kstep, voffA); PG8_STAGE(PG8_SB(1, 1), cB + hstep + kstep, voffB);
        PG8_WAIT_V(6); PG8_BAR;
    } else {
        PG8_STAGE(PG8_SB(0, 0), cB, voffB); PG8_STAGE(PG8_SA(0, 0), cA, voffA); PG8_STAGE(PG8_SB(0, 1), cB + hstep, voffB); PG8_STAGE(PG8_SA(0, 1), cA + hstep, voffA);
        if (wr == 1) PG8_BAR;
        PG8_WAIT_V(4); PG8_BAR;
        PG8_STAGE(PG8_SB(1, 0), cB + kstep, voffB); PG8_STAGE(PG8_SA(1, 0), cA + kstep, voffA); PG8_STAGE(PG8_SB(1, 1), cB + hstep + kstep, voffB);
        PG8_WAIT_V(6); PG8_BAR;
    }
    for (;;) {
        const bool has_next = S.next(ui + 1, nxt);
        const char* nA = has_next ? (const char*)g.A + (size_t)nxt.pm * tstep + (size_t)nxt.k0 * kstep : cA; const char* nB = has_next ? (const char*)g.Bt + (size_t)nxt.pn * tstep + (size_t)nxt.k0 * kstep : cB;
        const int nt = cur.nk;
        for (int t = 0; t < nt; t += 2) {
            const bool last = (t == nt - 2);
            const char* a1 = cA + (size_t)(t + 1) * kstep;
            const char* a2 = last ? nA : cA + (size_t)(t + 2) * kstep; const char* b2 = last ? nB : cB + (size_t)(t + 2) * kstep;
            const char* a3 = a2 + kstep; const char* b3 = b2 + kstep;
            if (last && has_next) S.a_ready(nxt);
            if constexpr (SP2) {
            PG8_LDB(B0, 0, 0); PG8_LDB(B1, 0, 1); PG8_SCHED; PG8_LDA(At, 0, 0); PG8_STAGE(PG8_SA(1, 1), a1 + hstep, voffA);
            PG8_WAIT_V(8); PG8_WAIT_L(0); PG8_BAR; PG8_MMA(0, 0, At, B0); PG8_MMA(0, 1, At, B1); PG8_BAR; PG8_SCHED;
            PG8_LDA(At, 0, 1); PG8_STAGE(PG8_SB(0, 0), b2, voffB); PG8_STAGE(PG8_SB(0, 1), b2 + hstep, voffB); PG8_STAGE(PG8_SA(0, 0), a2, voffA);
            PG8_WAIT_V(8); PG8_WAIT_L(0); PG8_BAR; PG8_MMA(1, 0, At, B0); PG8_MMA(1, 1, At, B1); PG8_BAR; PG8_SCHED;
            PG8_LDB(B0, 1, 0); PG8_LDB(B1, 1, 1); PG8_SCHED; PG8_LDA(At, 1, 0); PG8_STAGE(PG8_SA(0, 1), a2 + hstep, voffA);
            PG8_WAIT_V(8); PG8_WAIT_L(0); PG8_BAR; PG8_MMA(0, 0, At, B0); PG8_MMA(0, 1, At, B1); PG8_BAR; PG8_SCHED;
            PG8_LDA(At, 1, 1); PG8_STAGE(PG8_SB(1, 0), b3, voffB); PG8_STAGE(PG8_SB(1, 1), b3 + hstep, voffB); PG8_STAGE(PG8_SA(1, 0), a3, voffA);
            PG8_WAIT_V(8); PG8_WAIT_L(0); PG8_BAR; PG8_MMA(1, 0, At, B0); PG8_MMA(1, 1, At, B1); PG8_BAR; PG8_SCHED;
            } else {
            PG8_LDB(B0, 0, 0); PG8_SCHED; PG8_LDA(At, 0, 0); PG8_STAGE(PG8_SA(1, 1), a1 + hstep, voffA);
            PG8_WAIT_L(8); PG8_BAR; PG8_WAIT_L(0); PG8_MMA(0, 0, At, B0); PG8_BAR; PG8_SCHED;
            PG8_LDB(B1, 0, 1); PG8_STAGE(PG8_SB(0, 0), b2, voffB);
            PG8_BAR; PG8_WAIT_L(0); PG8_MMA(0, 1, At, B1); PG8_BAR;
            PG8_LDA(At, 0, 1); PG8_STAGE(PG8_SA(0, 0), a2, voffA);
            PG8_BAR; PG8_WAIT_L(0); PG8_MMA(1, 0, At, B0); PG8_BAR; PG8_SCHED;
            PG8_STAGE(PG8_SB(0, 1), b2 + hstep, voffB);
            PG8_WAIT_V(6); PG8_BAR; PG8_MMA(1, 1, At, B1); PG8_BAR;
            PG8_LDB(B0, 1, 0); PG8_SCHED; PG8_LDA(At, 1, 0); PG8_STAGE(PG8_SA(0, 1), a2 + hstep, voffA);
            PG8_WAIT_L(8); PG8_BAR; PG8_WAIT_L(0); PG8_MMA(0, 0, At, B0); PG8_BAR; PG8_SCHED;
            PG8_LDB(B1, 1, 1); PG8_STAGE(PG8_SB(1, 0), b3, voffB);
            PG8_BAR; PG8_WAIT_L(0); PG8_MMA(0, 1, At, B1); PG8_BAR;
            PG8_LDA(At, 1, 1); PG8_STAGE(PG8_SA(1, 0), a3, voffA);
            PG8_BAR; PG8_WAIT_L(0); PG8_MMA(1, 0, At, B0); PG8_BAR; PG8_SCHED;
            PG8_STAGE(PG8_SB(1, 1), b3 + hstep, voffB);
            PG8_WAIT_V(6); PG8_BAR; PG8_MMA(1, 1, At, B1); PG8_BAR;
            }
        }
        if constexpr (ALIGN_EPI) { if (wr == 0) PG8_BAR; }
        if constexpr (!Epi::AFTER_DRAIN) { E(acc, cur, wr, wc, fr, fq); S.done(cur); }
        if (!has_next) break;
#pragma unroll
        for (int a = 0; a < 2; ++a)
#pragma unroll
            for (int b = 0; b < 2; ++b)
#pragma unroll
                for (int m = 0; m < 4; ++m)
#pragma unroll
                    for (int n = 0; n < 2; ++n) acc[a][b][m][n] = (f32x4){0.f, 0.f, 0.f, 0.f};
        cur = nxt; cA = nA; cB = nB; ++ui;
        if constexpr (ALIGN_EPI) { if (wr == 1) PG8_BAR; }
    }
    PG8_WAIT_V(0);
    if constexpr (!ALIGN_EPI) { if (wr == 0) PG8_BAR; }
    PG8_BAR;
    if constexpr (Epi::AFTER_DRAIN) { E.fused(acc, cur, wr, wc, fr, fq, lds, wid, lane); S.done(cur); }
#undef PG8_SA
#undef PG8_SB
#undef PG8_STAGE
#undef PG8_LDA
#undef PG8_LDB
#undef PG8_MMA
#undef PG8_WAIT_V
#undef PG8_WAIT_L
#undef PG8_BAR
#undef PG8_SCHED
}
}

constexpr size_t MiB = 1u << 20;
constexpr size_t WS_CTL = 0, CTL_ZERO_BYTES = 262144;
constexpr size_t WS_MOD = 1 * MiB;
constexpr size_t WS_CS = 1 * MiB + 192 * 1024;
constexpr size_t WS_DLOG = 1 * MiB + 256 * 1024;
constexpr size_t WS_WTOUT = 2 * MiB;
constexpr size_t WS_WTIN = 18 * MiB;
constexpr size_t WS_H = 44 * MiB;
constexpr size_t WS_Z = 92 * MiB;
constexpr size_t WS_U = 248 * MiB;
constexpr size_t WS_OL = 264 * MiB;
constexpr size_t WS_CKV = 312 * MiB;
constexpr size_t WS_END = 313 * MiB;
constexpr int LDS_BYTES = 163840;
constexpr int LDS_CTLW = 163840 - 256;
constexpr int NWAVES = 8, NTHREADS = 512;

#define LAS __attribute__((address_space(3)))
typedef unsigned short bf16;
typedef float f32x4 __attribute__((ext_vector_type(4)));
typedef float f32x16 __attribute__((ext_vector_type(16)));
typedef unsigned u32x4 __attribute__((ext_vector_type(4)));
typedef unsigned u32x2 __attribute__((ext_vector_type(2)));
typedef short bf16x8 __attribute__((ext_vector_type(8)));

__device__ __forceinline__ float bf2f(unsigned short u) { return __builtin_bit_cast(float, (unsigned)u << 16); }
__device__ __forceinline__ float bflo(unsigned u) { return __builtin_bit_cast(float, u << 16); }
__device__ __forceinline__ float bfhi(unsigned u) { return __builtin_bit_cast(float, u & 0xffff0000u); }
typedef float f32x2_t_ __attribute__((ext_vector_type(2))); typedef __bf16 bf16x2_t_ __attribute__((ext_vector_type(2)));
__device__ __forceinline__ unsigned pk2(float lo, float hi) { const f32x2_t_ v = {lo, hi}; return __builtin_bit_cast(unsigned, __builtin_convertvector(v, bf16x2_t_)); }
__device__ __forceinline__ unsigned f2bf(float f) { return pk2(f, f) & 0xffffu; }
__device__ __forceinline__ float sigmoidf_(float x) { return __builtin_amdgcn_rcpf(1.0f + __builtin_amdgcn_exp2f(-1.4426950408889634f * x)); }
__device__ __forceinline__ float siluf_(float x) { return x * __builtin_amdgcn_rcpf(1.0f + __builtin_amdgcn_exp2f(-1.4426950408889634f * x)); }
__device__ __forceinline__ float dpp_add_(float v, const int ctrl_sel) {
    const int x = __builtin_bit_cast(int, v); int y;
    if (ctrl_sel == 0) y = __builtin_amdgcn_update_dpp(0, x, 0xB1, 0xf, 0xf, true);
    else if (ctrl_sel == 1) y = __builtin_amdgcn_update_dpp(0, x, 0x4E, 0xf, 0xf, true);
    else if (ctrl_sel == 2) y = __builtin_amdgcn_update_dpp(0, x, 0x141, 0xf, 0xf, true);
    else y = __builtin_amdgcn_update_dpp(0, x, 0x140, 0xf, 0xf, true);
    return v + __builtin_bit_cast(float, y);
}
__device__ __forceinline__ float wave_sum(float v) {
    v = dpp_add_(v, 0); v = dpp_add_(v, 1); v = dpp_add_(v, 2); v = dpp_add_(v, 3);
    const float r0 = __builtin_bit_cast(float, __builtin_amdgcn_readlane(__builtin_bit_cast(int, v), 0)), r1 = __builtin_bit_cast(float, __builtin_amdgcn_readlane(__builtin_bit_cast(int, v), 16));
    const float r2 = __builtin_bit_cast(float, __builtin_amdgcn_readlane(__builtin_bit_cast(int, v), 32)), r3 = __builtin_bit_cast(float, __builtin_amdgcn_readlane(__builtin_bit_cast(int, v), 48));
    return (r0 + r1) + (r2 + r3);
}

struct Params {
    const float* in[20];
    float* out; unsigned char* ws;
};
typedef const __attribute__((address_space(4))) Params* PP;

__device__ __forceinline__ int next_unit(unsigned* ctr, volatile LAS unsigned* slot, int tid) {
    __syncthreads();
    if (tid == 0) *slot = __hip_atomic_fetch_add(ctr, 1u, __ATOMIC_RELAXED, __HIP_MEMORY_SCOPE_AGENT);
    __syncthreads();
    return (int)*slot;
}
__device__ __forceinline__ int q_pop(unsigned* ctr, volatile LAS unsigned* slot, int tid, int& pend, int pf_from) {
    __syncthreads();
    if (tid == 0) { const int cur = (pend >= 0) ? pend : (int)__hip_atomic_fetch_add(ctr, 1u, __ATOMIC_RELAXED, __HIP_MEMORY_SCOPE_AGENT);
        *slot = (unsigned)cur; pend = (cur >= pf_from) ? (int)__hip_atomic_fetch_add(ctr, 1u, __ATOMIC_RELAXED, __HIP_MEMORY_SCOPE_AGENT) : -1; }
    __syncthreads();
    return (int)*slot;
}
__device__ __forceinline__ void transpose_item(const float* W, int K, int N, bf16* WT, LAS float* scr, int item, int lane) {
    const int nblk = N / 32, kb = item / nblk, nb = item % nblk, k0 = 64 * kb, n0 = 32 * nb;
    float wv[32];
    const float* wp = W + (size_t)(k0 + (lane >> 5)) * N + n0 + (lane & 31);
#pragma unroll
    for (int i = 0; i < 32; ++i) wv[i] = wp[(size_t)(2 * i) * N];
    __builtin_amdgcn_sched_barrier(0);
#pragma unroll
    for (int i = 0; i < 32; ++i) { const int kk = 2 * i + (lane >> 5); scr[kk * 33 + (lane & 31)] = wv[i]; }
    asm volatile("s_waitcnt lgkmcnt(0)" ::: "memory");
    const int c = lane & 7;
#pragma unroll
    for (int j = 0; j < 4; ++j) { const int n = (lane >> 3) + 8 * j; const LAS float* s = scr + (8 * c) * 33 + n;
        u32x4 o; o.x = pk2(s[0 * 33], s[1 * 33]); o.y = pk2(s[2 * 33], s[3 * 33]); o.z = pk2(s[4 * 33], s[5 * 33]); o.w = pk2(s[6 * 33], s[7 * 33]);
        *(u32x4*)(WT + (size_t)(n0 + n) * K + k0 + 8 * c) = o; }
    asm volatile("s_waitcnt lgkmcnt(0)" ::: "memory");
}

__device__ __forceinline__ void mod_unit(PP P, LAS float* lds, int l, int nc, int tid) {
    const float* c = P->in[5]; const float* cctx = P->in[6]; const float* aw = P->in[7] + (size_t)l * 2048 * 6144; const float* ab = P->in[8] + l * 6144;
    LAS float* sc = lds;
    LAS float* red = lds + 3 * 2048;
    for (int i = tid; i < 3 * 2048; i += NTHREADS) { const int j = i >> 11, k = i & 2047; const float v = (j == 0) ? cctx[k] : c[(j - 1) * 2048 + k]; sc[i] = siluf_(v); }
    __syncthreads();
    const int tn = tid & 7, tk = tid >> 3, n0 = nc * 32 + 4 * tn;
    float a[3][4] = {};
    for (int k8 = 0; k8 < 32; k8 += 16) {
        f32x4 w[16];
#pragma unroll
        for (int kk = 0; kk < 16; ++kk) w[kk] = *(const f32x4*)(aw + (size_t)(tk * 32 + k8 + kk) * 6144 + n0);
        __builtin_amdgcn_sched_barrier(0);
#pragma unroll
        for (int kk = 0; kk < 16; ++kk) { const int k = tk * 32 + k8 + kk;
#pragma unroll
            for (int j = 0; j < 3; ++j) { const float s = sc[j * 2048 + k]; a[j][0] += s * w[kk][0]; a[j][1] += s * w[kk][1]; a[j][2] += s * w[kk][2]; a[j][3] += s * w[kk][3]; } }
    }
#pragma unroll
    for (int j = 0; j < 3; ++j)
#pragma unroll
        for (int e = 0; e < 4; ++e) red[(tk * 8 + tn) * 12 + j * 4 + e] = a[j][e];
    __syncthreads();
    if (tid < 96) { const int tn2 = tid / 12, je = tid % 12; float s = 0.f; for (int t = 0; t < 64; ++t) s += red[(t * 8 + tn2) * 12 + je];
        const int j = je >> 2, e = je & 3, n = nc * 32 + 4 * tn2 + e;
        ((float*)(P->ws + WS_MOD))[(l * 3 + j) * 6144 + n] = s + ab[n]; }
    __syncthreads();
}

__device__ __forceinline__ void hprep_row(const float* xrow, const float* mod  , bf16* hrow, int lane) {
#pragma unroll
    for (int j = 0; j < 8; ++j) { const int c = 4 * lane + 256 * j; const f32x4 x = *(const f32x4*)(xrow + c), sh = *(const f32x4*)(mod + c), sc = *(const f32x4*)(mod + 2048 + c);
        const f32x4 h = x * (sc + 1.0f) + sh; u32x2 o; o.x = pk2(h[0], h[1]); o.y = pk2(h[2], h[3]); *(u32x2*)(hrow + c) = o; }
}
template <bool WITH_H>
__device__ __forceinline__ void ln_row_t(float* vrow, const float* w, const float* b, const float* modn, bf16* hrow, int lane_in) {
    int lane = lane_in; asm volatile("" : "+v"(lane));
    f32x4 v[8], pw[8], pb[8]; float s = 0.f;
#pragma unroll
    for (int j = 0; j < 8; ++j) v[j] = *(const f32x4*)(vrow + 4 * lane + 256 * j);
#pragma unroll
    for (int j = 0; j < 8; ++j) { pw[j] = *(const f32x4*)(w + 4 * lane + 256 * j); pb[j] = *(const f32x4*)(b + 4 * lane + 256 * j); }
#pragma unroll
    for (int j = 0; j < 8; ++j) s += (v[j][0] + v[j][1]) + (v[j][2] + v[j][3]);
    const float mean = wave_sum(s) * (1.0f / 2048.0f); float q = 0.f;
#pragma unroll
    for (int j = 0; j < 8; ++j) { v[j] = v[j] - mean; q += (v[j][0] * v[j][0] + v[j][1] * v[j][1]) + (v[j][2] * v[j][2] + v[j][3] * v[j][3]); }
    const float rstd = __builtin_amdgcn_rsqf(wave_sum(q) * (1.0f / 2048.0f) + 1e-5f);
#pragma unroll
    for (int j = 0; j < 8; ++j) { v[j] = v[j] * rstd * pw[j] + pb[j]; *(f32x4*)(vrow + 4 * lane + 256 * j) = v[j]; }
    if (WITH_H) {
#pragma unroll
        for (int j = 0; j < 8; ++j) { pw[j] = *(const f32x4*)(modn + 4 * lane + 256 * j); pb[j] = *(const f32x4*)(modn + 2048 + 4 * lane + 256 * j); }
#pragma unroll
        for (int j = 0; j < 8; ++j) { const f32x4 h = v[j] * (pb[j] + 1.0f) + pw[j]; u32x2 o; o.x = pk2(h[0], h[1]); o.y = pk2(h[2], h[3]); *(u32x2*)(hrow + 4 * lane + 256 * j) = o; }
    }
}
__device__ __forceinline__ void ln_row(float* vrow, const float* w, const float* b, const float* modn, bf16* hrow, int lane) {
    if (hrow) ln_row_t<true>(vrow, w, b, modn, hrow, lane); else ln_row_t<false>(vrow, w, b, modn, hrow, lane);
}

typedef float f32x2 __attribute__((ext_vector_type(2)));
__device__ __forceinline__ void conv_unit(PP P, LAS float* lds, int l, int unit, int tid) {
    const int lane = tid & 63, wave = tid >> 6;
    const bf16* Z = (const bf16*)(P->ws + WS_Z); bf16* MIX = (bf16*)(P->ws + WS_H);
    const int t0 = unit * 32;
    int s0, s1; if (t0 < NCTX) { s0 = t0 & ~255; s1 = s0 + 256; } else { s0 = NCTX + ((t0 - NCTX) & ~2047); s1 = s0 + 2048; }
    const int c2 = 2 * (tid & 255), tb = t0 + 16 * (tid >> 8);
    u32x4 gq[4];
#pragma unroll
    for (int k = 0; k < 4; ++k) gq[k] = *(const u32x4*)(Z + (size_t)(t0 + 4 * wave + k) * DIN + C_CG + 8 * lane);
    const float* lw = P->in[16] + l * 512 + 8 * lane; const float* lb = P->in[17] + l * 512 + 8 * lane;
    const f32x4 w0 = *(const f32x4*)lw, w1 = *(const f32x4*)(lw + 4), b0 = *(const f32x4*)lb, b1 = *(const f32x4*)(lb + 4);
    f32x2 u[46];
#pragma unroll
    for (int hb = 0; hb < 2; ++hb) {
        unsigned ra[23], rb[23];
#pragma unroll
        for (int r = 0; r < 23; ++r) { const int row = tb - 15 + 23 * hb + r; const int rc = row < s0 ? s0 : (row >= s1 ? s1 - 1 : row);
            ra[r] = *(const unsigned*)(Z + (size_t)rc * DIN + C_CA + c2); rb[r] = *(const unsigned*)(Z + (size_t)rc * DIN + C_CB + c2); }
        __builtin_amdgcn_sched_barrier(0);
#pragma unroll
        for (int r = 0; r < 23; ++r) { const int row = tb - 15 + 23 * hb + r; const bool ok = (row >= s0 && row < s1);
            const f32x2 a = {bflo(ra[r]), bfhi(ra[r])}; const f32x2 g = {sigmoidf_(bflo(rb[r])), sigmoidf_(bfhi(rb[r]))};
            const f32x2 v = a * g; u[23 * hb + r] = ok ? v : (f32x2){0.f, 0.f}; }
    }
    f32x2 acc[16]; const f32x2 bias = *(const f32x2*)(P->in[15] + l * 512 + c2);
#pragma unroll
    for (int i = 0; i < 16; ++i) acc[i] = bias;
    const float* cw = P->in[14] + (size_t)l * 31 * 512 + c2;
#pragma unroll
    for (int j = 0; j < 31; ++j) { const f32x2 w = *(const f32x2*)(cw + j * 512);
#pragma unroll
        for (int i = 0; i < 16; ++i) acc[i] += u[i + j] * w; }
    LAS float* yb = lds;
#pragma unroll
    for (int i = 0; i < 16; ++i) *(LAS f32x2*)(yb + (16 * (tid >> 8) + i) * 512 + c2) = acc[i];
    __syncthreads();
#pragma unroll
    for (int k = 0; k < 4; ++k) { const int ti = wave * 4 + k, row = t0 + ti;
        f32x4 a = *(const LAS f32x4*)(yb + ti * 512 + 8 * lane), b = *(const LAS f32x4*)(yb + ti * 512 + 8 * lane + 4);
        float s = (a[0] + a[1]) + (a[2] + a[3]) + (b[0] + b[1]) + (b[2] + b[3]);
        const float mean = wave_sum(s) * (1.0f / 512.0f); a = a - mean; b = b - mean;
        float q = (a[0] * a[0] + a[1] * a[1]) + (a[2] * a[2] + a[3] * a[3]) + (b[0] * b[0] + b[1] * b[1]) + (b[2] * b[2] + b[3] * b[3]);
        const float rstd = __builtin_amdgcn_rsqf(wave_sum(q) * (1.0f / 512.0f) + 1e-5f);
        a = a * rstd * w0 + b0; b = b * rstd * w1 + b1;
        const u32x4 g = gq[k];
        float o[8];
        o[0] = siluf_(a[0]) * siluf_(bflo(g.x)); o[1] = siluf_(a[1]) * siluf_(bfhi(g.x)); o[2] = siluf_(a[2]) * siluf_(bflo(g.y)); o[3] = siluf_(a[3]) * siluf_(bfhi(g.y));
        o[4] = siluf_(b[0]) * siluf_(bflo(g.z)); o[5] = siluf_(b[1]) * siluf_(bfhi(g.z)); o[6] = siluf_(b[2]) * siluf_(bflo(g.w)); o[7] = siluf_(b[3]) * siluf_(bfhi(g.w));
        u32x4 w; w.x = pk2(o[0], o[1]); w.y = pk2(o[2], o[3]); w.z = pk2(o[4], o[5]); w.w = pk2(o[6], o[7]);
        *(u32x4*)(MIX + (size_t)row * D_MODEL + 1536 + 8 * lane) = w; }
}

typedef short v4i16_t __attribute__((ext_vector_type(4)));
#define SBAR __builtin_amdgcn_sched_barrier(0);
#define R0(i) (((i) & 3) + 8 * ((i) >> 2))
constexpr float ATT_C2 = 0.08838834764831845f * 1.4426950408889634f;
constexpr float LOG2E = 1.4426950408889634f;
constexpr int KROW = 272, VROW = 320, ATT_V_OFF = 64 * KROW;

__device__ __forceinline__ bf16x8 trpair(const LAS unsigned char* p, int second_off) {
    const v4i16_t lo = __builtin_amdgcn_ds_read_tr16_b64_v4i16((LAS v4i16_t*)p), hi = __builtin_amdgcn_ds_read_tr16_b64_v4i16((LAS v4i16_t*)(p + second_off));
    return (bf16x8){lo[0], lo[1], lo[2], lo[3], hi[0], hi[1], hi[2], hi[3]};
}
__device__ __forceinline__ bf16x8 pack8(float a, float b, float c, float d, float e, float f, float g, float h) {
    const u32x4 w = {pk2(a, b), pk2(c, d), pk2(e, f), pk2(g, h)}; return __builtin_bit_cast(bf16x8, w);
}
__device__ __forceinline__ void rope8(bf16x8& a, bf16x8& b, const float* cs) {
    float ra[8], rb[8];
#pragma unroll
    for (int j = 0; j < 8; ++j) { const float x1 = bf2f((unsigned short)a[j]), x2 = bf2f((unsigned short)b[j]), c = cs[2 * j], s = cs[2 * j + 1]; ra[j] = x1 * c - x2 * s; rb[j] = x2 * c + x1 * s; }
    a = pack8(ra[0], ra[1], ra[2], ra[3], ra[4], ra[5], ra[6], ra[7]); b = pack8(rb[0], rb[1], rb[2], rb[3], rb[4], rb[5], rb[6], rb[7]);
}
__device__ __forceinline__ void rope8l(bf16x8& a, bf16x8& b, const LAS float* cs) {
    const f32x4 c0 = *(const LAS f32x4*)cs, c1 = *(const LAS f32x4*)(cs + 4), c2 = *(const LAS f32x4*)(cs + 8), c3 = *(const LAS f32x4*)(cs + 12);
    const float cc[8] = {c0[0], c0[2], c1[0], c1[2], c2[0], c2[2], c3[0], c3[2]}, sn[8] = {c0[1], c0[3], c1[1], c1[3], c2[1], c2[3], c3[1], c3[3]};
    float ra[8], rb[8];
#pragma unroll
    for (int j = 0; j < 8; ++j) { const float x1 = bf2f((unsigned short)a[j]), x2 = bf2f((unsigned short)b[j]); ra[j] = x1 * cc[j] - x2 * sn[j]; rb[j] = x2 * cc[j] + x1 * sn[j]; }
    a = pack8(ra[0], ra[1], ra[2], ra[3], ra[4], ra[5], ra[6], ra[7]); b = pack8(rb[0], rb[1], rb[2], rb[3], rb[4], rb[5], rb[6], rb[7]);
}
__device__ __forceinline__ bf16x8 cvt8(const float* p) {
    const f32x4 a = *(const f32x4*)p, b = *(const f32x4*)(p + 4);
    return pack8(a[0], a[1], a[2], a[3], b[0], b[1], b[2], b[3]);
}

typedef _Float16 f16x8_t_ __attribute__((ext_vector_type(8)));
__device__ __forceinline__ void rope8h(u32x4& a, u32x4& b, const LAS unsigned char* cs) {
    const f16x8_t_ t0 = *(const LAS f16x8_t_*)cs, t1 = *(const LAS f16x8_t_*)(cs + 16);
    float ra[8], rb[8];
#pragma unroll
    for (int j = 0; j < 8; ++j) { const unsigned wa = a[j >> 1], wb = b[j >> 1]; const float x1 = (j & 1) ? bfhi(wa) : bflo(wa), x2 = (j & 1) ? bfhi(wb) : bflo(wb);
        const float c = (float)((j < 4) ? t0[2 * j] : t1[2 * (j - 4)]), sn = (float)((j < 4) ? t0[2 * j + 1] : t1[2 * (j - 4) + 1]);
        ra[j] = x1 * c - x2 * sn; rb[j] = x2 * c + x1 * sn; }
    a = (u32x4){pk2(ra[0], ra[1]), pk2(ra[2], ra[3]), pk2(ra[4], ra[5]), pk2(ra[6], ra[7])}; b = (u32x4){pk2(rb[0], rb[1]), pk2(rb[2], rb[3]), pk2(rb[4], rb[5]), pk2(rb[6], rb[7])};
}
constexpr int AT_BUF = 75776, AT_V = 34816, AT_ROPE = 151552;
__device__ __forceinline__ void attn_tile(const LAS unsigned char* kt, const LAS unsigned char* vt, const bf16x8 (&qf)[8], f32x16 (&O)[4], float& m, float& lsum,
                                          bool local, int tk0, int qpos, int lane) {
    const int r32 = lane & 31, hh = lane >> 5, i16 = lane & 15;
    f32x16 p0, p1;
#pragma unroll
    for (int i = 0; i < 16; ++i) { p0[i] = 0.f; p1[i] = 0.f; }
    const LAS unsigned char* kb = kt + r32 * KROW + 16 * hh;
#pragma unroll
    for (int s = 0; s < 8; ++s) { const bf16x8 kf0 = *(const LAS bf16x8*)(kb + 32 * s), kf1 = *(const LAS bf16x8*)(kb + 32 * KROW + 32 * s);
        p0 = __builtin_amdgcn_mfma_f32_32x32x16_bf16(kf0, qf[s], p0, 0, 0, 0); p1 = __builtin_amdgcn_mfma_f32_32x32x16_bf16(kf1, qf[s], p1, 0, 0, 0); }
    const LAS unsigned char* vb = vt + (4 * hh + (i16 >> 2)) * VROW + (16 * ((lane >> 4) & 1) + 4 * (i16 & 3)) * 2;
    bf16x8 vfa[4], vfb[4];
#pragma unroll
    for (int ks = 0; ks < 4; ++ks) vfa[ks] = trpair(vb + (16 * ks) * VROW, 8 * VROW);
    float mx = -3e38f;
    if (local) { const unsigned mb = (unsigned)(qpos - tk0 - 4 * hh + 128);
#pragma unroll
        for (int i = 0; i < 16; ++i) { const unsigned d0 = mb - (unsigned)R0(i), d1 = d0 - 32u;
            p0[i] = (d0 <= 256u) ? p0[i] : -1e30f; p1[i] = (d1 <= 256u) ? p1[i] : -1e30f; } }
#pragma unroll
    for (int i = 0; i < 16; ++i) mx = fmaxf(mx, fmaxf(p0[i], p1[i]));
    mx = fmaxf(mx, __shfl_xor(mx, 32)) * ATT_C2;
    const float mn = fmaxf(m, mx), alpha = __builtin_amdgcn_exp2f(m - mn); m = mn;
    float ps = 0.f;
#pragma unroll
    for (int i = 0; i < 16; ++i) { p0[i] = __builtin_amdgcn_exp2f(__builtin_fmaf(p0[i], ATT_C2, -mn)); p1[i] = __builtin_amdgcn_exp2f(__builtin_fmaf(p1[i], ATT_C2, -mn)); ps += p0[i] + p1[i]; }
    lsum = lsum * alpha + ps;
    if (__builtin_amdgcn_ballot_w64(alpha != 1.0f) != 0ull) {
#pragma unroll
        for (int d = 0; d < 4; ++d)
#pragma unroll
            for (int i = 0; i < 16; ++i) O[d][i] *= alpha;
    }
    bf16x8 pb[4];
#pragma unroll
    for (int s = 0; s < 2; ++s) { pb[s] = pack8(p0[8 * s], p0[8 * s + 1], p0[8 * s + 2], p0[8 * s + 3], p0[8 * s + 4], p0[8 * s + 5], p0[8 * s + 6], p0[8 * s + 7]);
        pb[2 + s] = pack8(p1[8 * s], p1[8 * s + 1], p1[8 * s + 2], p1[8 * s + 3], p1[8 * s + 4], p1[8 * s + 5], p1[8 * s + 6], p1[8 * s + 7]); }
#pragma unroll
    for (int dt = 0; dt < 4; ++dt) {
        if (dt + 1 < 4) {
#pragma unroll
            for (int ks = 0; ks < 4; ++ks) { const bf16x8 t_ = trpair(vb + (16 * ks) * VROW + 64 * (dt + 1), 8 * VROW); if (dt & 1) vfa[ks] = t_; else vfb[ks] = t_; }
        }
#pragma unroll
        for (int ks = 0; ks < 4; ++ks) O[dt] = __builtin_amdgcn_mfma_f32_32x32x16_bf16((dt & 1) ? vfb[ks] : vfa[ks], pb[ks], O[dt], 0, 0, 0);
    }
}
__device__ __forceinline__ void attn_unit(PP P, LAS unsigned char* lds, int l, int kind, int idx, int tid) {
    const int lane = tid & 63, wave = __builtin_amdgcn_readfirstlane(tid >> 6), r32 = lane & 31, hh = lane >> 5;
    const bf16* Z = (const bf16*)(P->ws + WS_Z); bf16* MIX = (bf16*)(P->ws + WS_H); const float* CS = (const float*)(P->ws + WS_CS); const bf16* CKV = (const bf16*)(P->ws + WS_CKV);
    int b, h, qpos0, grow0, kpos0, klrow0, nls, ncs;
    if (kind == 0) { b = idx >> 3; h = idx & 7; qpos0 = 0; grow0 = b * 256; kpos0 = 0; klrow0 = b * 256; nls = 2; ncs = 0; }
    else { const int qb = idx & 7; h = (idx >> 3) & 7; b = idx >> 6; qpos0 = qb * 256; grow0 = NCTX + b * 2048 + qpos0;
        kpos0 = qpos0 - 128 < 0 ? 0 : qpos0 - 128; const int kend = qpos0 + 384 > 2048 ? 2048 : qpos0 + 384; nls = (kend - kpos0) >> 7; klrow0 = NCTX + b * 2048 + kpos0; ncs = 2; }
    const bool lat = (kind == 1);
    const int kv = h >> 2;
    if (lat) {
#pragma unroll
        for (int k = 0; k < 4; ++k) { const int e = tid + 512 * k; const float c = CS[2 * e], sn = CS[2 * e + 1];
            typedef _Float16 h2_ __attribute__((ext_vector_type(2))); const h2_ hv = {(_Float16)c, (_Float16)sn}; *(LAS unsigned*)(lds + AT_ROPE + 4 * e) = __builtin_bit_cast(unsigned, hv); }
    }
    const int qrow = grow0 + 32 * wave + r32, qpos = qpos0 + 32 * wave + r32, qw0 = qpos0 + 32 * wave;
    bf16x8 qf[8];
    { const bf16* qp = Z + (size_t)qrow * DIN + C_AQ + h * 128 + 8 * hh;
#pragma unroll
      for (int s = 0; s < 8; ++s) qf[s] = *(const bf16x8*)(qp + 16 * s);
      if (lat) { const float* c0 = CS + ((qpos >> 6) * 32 + 8 * hh) * 2; const float* c1 = CS + ((qpos & 63) * 32 + 8 * hh) * 2;
          rope8(qf[0], qf[2], c0); rope8(qf[1], qf[3], c0 + 32); rope8(qf[4], qf[6], c1); rope8(qf[5], qf[7], c1 + 32); } }
    f32x16 O[4];
#pragma unroll
    for (int d = 0; d < 4; ++d)
#pragma unroll
        for (int i = 0; i < 16; ++i) O[d][i] = 0.f;
    float m = P->in[11][l * 8 + h] * LOG2E, lsum = (hh == 0) ? 1.0f : 0.0f;
    const int skey = tid >> 2, sub = tid & 3;
    const int nst = nls + ncs;
    u32x4 rr[8];
#define ATT_ISSUE(ST) do { const int st_ = (ST); const bf16* kp_; const bf16* vp_; \
        if (st_ < nls) { const int krow = klrow0 + 128 * st_ + skey; kp_ = Z + (size_t)krow * DIN + C_AK + kv * 128 + 8 * sub; vp_ = kp_ + (C_AV - C_AK); } \
        else { const int key = 128 * (st_ - nls) + skey; kp_ = CKV + ((size_t)((b * 2 + l) * 256 + key) * 2 + kv) * 128 + 8 * sub; vp_ = kp_ + 262144; } \
        rr[0] = *(const u32x4*)kp_; rr[1] = *(const u32x4*)(kp_ + 32); rr[2] = *(const u32x4*)(kp_ + 64); rr[3] = *(const u32x4*)(kp_ + 96); \
        rr[4] = *(const u32x4*)vp_; rr[5] = *(const u32x4*)(vp_ + 32); rr[6] = *(const u32x4*)(vp_ + 64); rr[7] = *(const u32x4*)(vp_ + 96); } while (0)
#define ATT_WRITE(ST) do { const int st_ = (ST); \
        if (lat && st_ < nls) { const int kpos = kpos0 + 128 * st_ + skey; \
            rope8h(rr[0], rr[1], lds + AT_ROPE + ((kpos >> 6) * 32 + 8 * sub) * 4); rope8h(rr[2], rr[3], lds + AT_ROPE + ((kpos & 63) * 32 + 8 * sub) * 4); } \
        LAS unsigned char* kd_ = lds + (st_ & 1) * AT_BUF + skey * KROW + 16 * sub; LAS unsigned char* vd_ = lds + (st_ & 1) * AT_BUF + AT_V + skey * VROW + 16 * sub; \
        *(LAS u32x4*)kd_ = rr[0]; *(LAS u32x4*)(kd_ + 64) = rr[1]; *(LAS u32x4*)(kd_ + 128) = rr[2]; *(LAS u32x4*)(kd_ + 192) = rr[3]; \
        *(LAS u32x4*)vd_ = rr[4]; *(LAS u32x4*)(vd_ + 64) = rr[5]; *(LAS u32x4*)(vd_ + 128) = rr[6]; *(LAS u32x4*)(vd_ + 192) = rr[7]; } while (0)
    if (lat) { ATT_ISSUE(0); __syncthreads();
        ATT_WRITE(0); }
    else {
        u32x4 r2[8];
        { const bf16* kp_ = Z + (size_t)(klrow0 + skey) * DIN + C_AK + kv * 128 + 8 * sub; const bf16* vp_ = kp_ + (C_AV - C_AK); const bf16* kq_ = kp_ + (size_t)128 * DIN; const bf16* vq_ = vp_ + (size_t)128 * DIN;
          rr[0] = *(const u32x4*)kp_; rr[1] = *(const u32x4*)(kp_ + 32); rr[2] = *(const u32x4*)(kp_ + 64); rr[3] = *(const u32x4*)(kp_ + 96);
          rr[4] = *(const u32x4*)vp_; rr[5] = *(const u32x4*)(vp_ + 32); rr[6] = *(const u32x4*)(vp_ + 64); rr[7] = *(const u32x4*)(vp_ + 96);
          r2[0] = *(const u32x4*)kq_; r2[1] = *(const u32x4*)(kq_ + 32); r2[2] = *(const u32x4*)(kq_ + 64); r2[3] = *(const u32x4*)(kq_ + 96);
          r2[4] = *(const u32x4*)vq_; r2[5] = *(const u32x4*)(vq_ + 32); r2[6] = *(const u32x4*)(vq_ + 64); r2[7] = *(const u32x4*)(vq_ + 96); }
        ATT_WRITE(0);
#pragma unroll
        for (int e = 0; e < 8; ++e) rr[e] = r2[e];
        ATT_WRITE(1);
    }
    __syncthreads();
    for (int st = 0; st < nst; ++st) {
        const bool more = lat && (st + 1 < nst);
        if (more) ATT_ISSUE(st + 1);
        const bool local = lat && (st < nls);
        const LAS unsigned char* kt = lds + (st & 1) * AT_BUF; const LAS unsigned char* vt = kt + AT_V;
#pragma unroll
        for (int t2 = 0; t2 < 2; ++t2) {
            const int tk0 = kpos0 + 128 * st + 64 * t2;
            bool skip = false;
            if (local) skip = (tk0 > qw0 + 31 + 128) || (tk0 + 63 < qw0 - 128);
            if (!skip) attn_tile(kt + t2 * 64 * KROW, vt + t2 * 64 * VROW, qf, O, m, lsum, local, tk0, qpos, lane);
        }
        if (more) ATT_WRITE(st + 1);
        if (lat) __syncthreads();
    }
    const float ltot = lsum + __shfl_xor(lsum, 32), inv = __builtin_amdgcn_rcpf(ltot);
    const bf16* gp = Z + (size_t)qrow * DIN + C_AG + h * 128 + 4 * hh; bf16* op = MIX + (size_t)qrow * D_MODEL + h * 128 + 4 * hh;
    u32x2 gg[16];
#pragma unroll
    for (int e = 0; e < 16; ++e) gg[e] = *(const u32x2*)(gp + 32 * (e >> 2) + 8 * (e & 3));
    __builtin_amdgcn_sched_barrier(0);
#pragma unroll
    for (int dt = 0; dt < 4; ++dt)
#pragma unroll
        for (int i4 = 0; i4 < 4; ++i4) { const int d0 = 32 * dt + 8 * i4; const u32x2 g = gg[dt * 4 + i4];
            const float o0 = O[dt][4 * i4 + 0] * inv * siluf_(bflo(g.x)), o1 = O[dt][4 * i4 + 1] * inv * siluf_(bfhi(g.x));
            const float o2 = O[dt][4 * i4 + 2] * inv * siluf_(bflo(g.y)), o3 = O[dt][4 * i4 + 3] * inv * siluf_(bfhi(g.y));
            u32x2 w; w.x = pk2(o0, o1); w.y = pk2(o2, o3); *(u32x2*)(op + d0) = w; }
#undef ATT_ISSUE
#undef ATT_WRITE
}

__device__ __forceinline__ void hg_oml8(PP P, int l, int dir, int hd0, float (&oml)[8]) {
    const float* hb = P->in[12] + dir * 1024 + hd0;
    const f32x4 a0 = *(const f32x4*)hb, a1 = *(const f32x4*)(hb + 4), b0 = *(const f32x4*)(hb + 512), b1 = *(const f32x4*)(hb + 516);
#pragma unroll
    for (int j = 0; j < 4; ++j) { const float s0 = sigmoidf_(b0[j] - a0[j]), s1 = sigmoidf_(b1[j] - a1[j]); oml[j] = l ? 1.0f - s0 : 1.0f; oml[4 + j] = l ? 1.0f - s1 : 1.0f; }
}
constexpr int H2_TG = 0, H2_QE = 16896, H2_KE = 25600, H2_QG = 34304, H2_KG = 42752, H2_V = 52992, H2_OBA = 63232, H2_OBB = 80128, H2_DK = 97024;
constexpr size_t WS_DLC_OFF = 0;
#ifndef PROBE_SEC
#define PROBE_SEC -1
#endif
#if PROBE_SEC >= 0
#define PSEC_DECL unsigned long long ps_acc_ = 0ull, ps_t_ = 0ull;
#define PSEC_START(n) if (PROBE_SEC == n) ps_t_ = __builtin_amdgcn_s_memrealtime();
#define PSEC_END(n) if (PROBE_SEC == n) ps_acc_ += __builtin_amdgcn_s_memrealtime() - ps_t_;
#define PSEC_CLOSE(n) if (PROBE_SEC == n) { __syncthreads(); ps_acc_ += __builtin_amdgcn_s_memrealtime() - ps_t_; }
#define PSEC_FLUSH(cnt) if (kind == 0 && tid == 0) { atomicAdd((unsigned long long*)((unsigned*)(P->ws + WS_CTL) + 60000), ps_acc_); atomicAdd((unsigned*)(P->ws + WS_CTL) + 60002, (unsigned)(cnt)); }
#else
#define PSEC_DECL
#define PSEC_START(n)
#define PSEC_END(n)
#define PSEC_CLOSE(n)
#define PSEC_FLUSH(cnt)
#endif
__device__ __forceinline__ void hgrn2_unit(PP P, LAS unsigned char* lds, int l, int kind, int idx, int tid) {
    const int lane = tid & 63, wave = __builtin_amdgcn_readfirstlane(tid >> 6), r32 = lane & 31, hh = lane >> 5, i16 = lane & 15, cg = (lane >> 4) & 1;
    const bf16* Z = (const bf16*)(P->ws + WS_Z); bf16* MIX = (bf16*)(P->ws + WS_H); float* OL = (float*)(P->ws + WS_OL);
    LAS float* ldsf = (LAS float*)lds;
    int h, row0, seglen, nch, b = 0;
    if (kind == 0) { b = idx >> 2; h = idx & 3; row0 = b * 256; seglen = 256; nch = 8; }
    else { const int blk = idx & 15; h = (idx >> 4) & 3; const int lb = idx >> 6; row0 = NCTX + lb * 2048 + blk * 128; seglen = 128; nch = 4; }
    const int ti = tid >> 4, d0 = 8 * (tid & 15), nt = wave & 3, kp = wave >> 2;
    PSEC_DECL
    const f32x4 n0 = *(const f32x4*)(P->in[13] + l * 512 + h * 128 + d0), n1 = *(const f32x4*)(P->in[13] + l * 512 + h * 128 + d0 + 4);
    for (int dir = 0; dir < 2; ++dir) {
        float oml[8]; hg_oml8(P, l, dir, h * 128 + d0, oml);
        const int cf = dir ? C_HFB : C_HFF;
        f32x16 S0, S1;
#pragma unroll
        for (int i = 0; i < 16; ++i) { S0[i] = 0.f; S1[i] = 0.f; }
        const int uidx = (kind == 1) ? ((idx >> 4) * 2 + dir) * 16 + (idx & 15) : 0;
        float gtot = 0.f;
        u32x4 uq, uv, uf;
        { const int row = dir ? row0 + seglen - 1 - ti : row0 + ti; const bf16* zr = Z + (size_t)row * DIN + h * 128 + d0;
          uq = *(const u32x4*)(zr + C_HQ); uv = *(const u32x4*)(zr + C_HI); uf = *(const u32x4*)(zr + cf); }
        for (int c = 0; c < nch; ++c) {
            PSEC_START(0)
            const int nc = dir ? nch - 1 - c : c; const int rown = row0 + 32 * nc + ti;
            f32x4 olp0 = {0.f, 0.f, 0.f, 0.f}, olp1 = {0.f, 0.f, 0.f, 0.f}; u32x4 ug = {0u, 0u, 0u, 0u};
            float* olr = OL + (size_t)rown * 512 + h * 128 + d0;
            if (dir == 1) { olp0 = *(const f32x4*)olr; olp1 = *(const f32x4*)(olr + 4); if (kind == 0) ug = *(const u32x4*)(Z + (size_t)rown * DIN + C_HG + h * 128 + d0); }
            float q[8], kk[8];
            {
                float g2[8], vv[8];
#pragma unroll
                for (int j = 0; j < 4; ++j) { const unsigned wq = uq[j], wv = uv[j], wf = uf[j];
                    q[2 * j] = siluf_(bflo(wq)) * 0.08838834764831845f; q[2 * j + 1] = siluf_(bfhi(wq)) * 0.08838834764831845f;
                    vv[2 * j] = bflo(wv); vv[2 * j + 1] = bfhi(wv);
                    kk[2 * j] = oml[2 * j] * sigmoidf_(-bflo(wf)); kk[2 * j + 1] = oml[2 * j + 1] * sigmoidf_(-bfhi(wf)); }
#pragma unroll
                for (int j = 0; j < 8; ++j) g2[j] = __builtin_amdgcn_logf(1.0f - fminf(kk[j], 1.0f - 1e-6f));
                LAS float* pg = ldsf + (H2_TG >> 2) + ti * 132 + d0;
                *(LAS f32x4*)pg = (f32x4){g2[0], g2[1], g2[2], g2[3]}; *(LAS f32x4*)(pg + 4) = (f32x4){g2[4], g2[5], g2[6], g2[7]};
                *(LAS u32x4*)(lds + H2_V + ti * 320 + d0 * 2) = uv;
            }
            if (c + 1 < nch) { const int tl = 32 * (c + 1) + ti; const int row = dir ? row0 + seglen - 1 - tl : row0 + tl; const bf16* zr = Z + (size_t)row * DIN + h * 128 + d0;
                uq = *(const u32x4*)(zr + C_HQ); uv = *(const u32x4*)(zr + C_HI); uf = *(const u32x4*)(zr + cf); }
            __syncthreads();
            PSEC_END(0) PSEC_START(1)
            if (tid < 128) {
                LAS float* gc = ldsf + (H2_TG >> 2) + tid; float run = 0.f; float gv[32];
#pragma unroll
                for (int i = 0; i < 32; ++i) gv[i] = gc[i * 132];
                SBAR
#pragma unroll
                for (int i = 0; i < 32; ++i) { run += gv[i]; gc[i * 132] = run; }
                ldsf[(H2_DK >> 2) + tid] = __builtin_amdgcn_exp2f(run);
                if (kind == 1) ((float*)(P->ws + WS_DLOG))[(uidx * 4 + c) * 128 + tid] = run;
                gtot += run;
            }
            __syncthreads();
            PSEC_END(1) PSEC_START(2)
            {
                const LAS float* gr = ldsf + (H2_TG >> 2) + ti * 132 + d0; const LAS float* gm = ldsf + (H2_TG >> 2) + 15 * 132 + d0; const LAS float* gl = ldsf + (H2_TG >> 2) + 31 * 132 + d0;
                float qe[8], ke[8], qg[8], kg[8];
#pragma unroll
                for (int j = 0; j < 8; ++j) { const float G = gr[j], Gm = gm[j], Gl = gl[j];
                    qe[j] = q[j] * __builtin_amdgcn_exp2f(fminf(G - Gm, 100.f)); ke[j] = kk[j] * __builtin_amdgcn_exp2f(fminf(Gm - G, 100.f));
                    qg[j] = q[j] * __builtin_amdgcn_exp2f(G); kg[j] = kk[j] * __builtin_amdgcn_exp2f(Gl - G); }
                *(LAS bf16x8*)(lds + H2_QE + ti * 272 + d0 * 2) = pack8(qe[0], qe[1], qe[2], qe[3], qe[4], qe[5], qe[6], qe[7]);
                *(LAS bf16x8*)(lds + H2_KE + ti * 272 + d0 * 2) = pack8(ke[0], ke[1], ke[2], ke[3], ke[4], ke[5], ke[6], ke[7]);
                *(LAS bf16x8*)(lds + H2_KG + ti * 320 + d0 * 2) = pack8(kg[0], kg[1], kg[2], kg[3], kg[4], kg[5], kg[6], kg[7]);
                u32x2 w0, w1; w0.x = pk2(qg[0], qg[1]); w0.y = pk2(qg[2], qg[3]); w1.x = pk2(qg[4], qg[5]); w1.y = pk2(qg[6], qg[7]);
                *(LAS u32x2*)(lds + H2_QG + ti * 264 + d0 * 2) = w0; *(LAS u32x2*)(lds + H2_QG + ti * 264 + d0 * 2 + 8) = w1;
            }
            __syncthreads();
            PSEC_END(2) PSEC_START(3)
            {
                f32x16 at;
#pragma unroll
                for (int i = 0; i < 16; ++i) at[i] = 0.f;
                const LAS unsigned char* kep = lds + H2_KE + r32 * 272 + 16 * hh; const LAS unsigned char* qep = lds + H2_QE + r32 * 272 + 16 * hh;
#pragma unroll
                for (int k = 0; k < 8; ++k) at = __builtin_amdgcn_mfma_f32_32x32x16_bf16(*(const LAS bf16x8*)(kep + 32 * k), *(const LAS bf16x8*)(qep + 32 * k), at, 0, 0, 0);
                float am[8];
#pragma unroll
                for (int j = 0; j < 8; ++j) { const float lo = at[j], hi = at[8 + j]; const float v = kp ? hi : lo; const int s = 16 * kp + 8 * (j >> 2) + 4 * hh + (j & 3); am[j] = (s <= r32) ? v : 0.f; }
                const bf16x8 afrag = pack8(am[0], am[1], am[2], am[3], am[4], am[5], am[6], am[7]);
                f32x16 ot;
#pragma unroll
                for (int i = 0; i < 16; ++i) ot[i] = 0.f;
                { const bf16x8 vfrag = trpair(lds + H2_V + (16 * kp + 4 * hh + (i16 >> 2)) * 320 + (32 * nt + 16 * cg + 4 * (i16 & 3)) * 2, 8 * 320);
                  ot = __builtin_amdgcn_mfma_f32_32x32x16_bf16(vfrag, afrag, ot, 0, 0, 0); }
                const LAS unsigned char* qgp = lds + H2_QG + r32 * 264 + (64 * kp + 4 * hh) * 2;
#pragma unroll
                for (int kl = 0; kl < 2; ++kl)
#pragma unroll
                    for (int sp = 0; sp < 2; ++sp) {
                        const u32x2 qlo = *(const LAS u32x2*)(qgp + (32 * kl + 16 * sp) * 2), qhi = *(const LAS u32x2*)(qgp + (32 * kl + 16 * sp) * 2 + 16);
                        const u32x4 qq = {qlo.x, qlo.y, qhi.x, qhi.y};
                        bf16x8 sfrag;
                        if (kl == 0) sfrag = pack8(S0[8 * sp], S0[8 * sp + 1], S0[8 * sp + 2], S0[8 * sp + 3], S0[8 * sp + 4], S0[8 * sp + 5], S0[8 * sp + 6], S0[8 * sp + 7]);
                        else sfrag = pack8(S1[8 * sp], S1[8 * sp + 1], S1[8 * sp + 2], S1[8 * sp + 3], S1[8 * sp + 4], S1[8 * sp + 5], S1[8 * sp + 6], S1[8 * sp + 7]);
                        ot = __builtin_amdgcn_mfma_f32_32x32x16_bf16(sfrag, __builtin_bit_cast(bf16x8, qq), ot, 0, 0, 0);
                    }
                { LAS float* ob = ldsf + ((kp ? H2_OBB : H2_OBA) >> 2) + (32 * nt + 4 * hh) * 33 + r32;
#pragma unroll
                  for (int i = 0; i < 16; ++i) ob[R0(i) * 33] = ot[i]; }
                const LAS float* dkp = ldsf + (H2_DK >> 2) + 64 * kp + 4 * hh;
#pragma unroll
                for (int i = 0; i < 16; ++i) { S0[i] *= dkp[R0(i)]; S1[i] *= dkp[32 + R0(i)]; }
#pragma unroll
                for (int ks = 0; ks < 2; ++ks) {
                    const int roff = (16 * ks + 8 * hh + (i16 >> 2)) * 320, coff = (16 * cg + 4 * (i16 & 3)) * 2;
                    const bf16x8 vf = trpair(lds + H2_V + roff + 64 * nt + coff, 4 * 320);
                    const bf16x8 k0 = trpair(lds + H2_KG + roff + 64 * (2 * kp) + coff, 4 * 320), k1 = trpair(lds + H2_KG + roff + 64 * (2 * kp + 1) + coff, 4 * 320);
                    S0 = __builtin_amdgcn_mfma_f32_32x32x16_bf16(k0, vf, S0, 0, 0, 0); S1 = __builtin_amdgcn_mfma_f32_32x32x16_bf16(k1, vf, S1, 0, 0, 0);
                }
            }
            __syncthreads();
            PSEC_END(3) PSEC_START(4)
            {
                const int t = dir ? 31 - ti : ti;
                const LAS float* oa = ldsf + (H2_OBA >> 2) + d0 * 33 + t; const LAS float* obb = ldsf + (H2_OBB >> 2) + d0 * 33 + t;
                float o[8];
#pragma unroll
                for (int j = 0; j < 8; ++j) o[j] = oa[j * 33] + obb[j * 33];
                if (dir == 1) { o[0] += olp0[0]; o[1] += olp0[1]; o[2] += olp0[2]; o[3] += olp0[3]; o[4] += olp1[0]; o[5] += olp1[1]; o[6] += olp1[2]; o[7] += olp1[3]; }
                if (dir == 0 || kind == 1) { *(f32x4*)olr = (f32x4){o[0], o[1], o[2], o[3]}; *(f32x4*)(olr + 4) = (f32x4){o[4], o[5], o[6], o[7]}; }
                else {
                    float ss = 0.f;
#pragma unroll
                    for (int j = 0; j < 8; ++j) ss += o[j] * o[j];
                    ss += __shfl_xor(ss, 1); ss += __shfl_xor(ss, 2); ss += __shfl_xor(ss, 4); ss += __shfl_xor(ss, 8);
                    const float r = __builtin_amdgcn_rsqf(ss * (1.0f / 128.0f) + 1e-6f);
                    u32x4 w;
                    w.x = pk2(o[0] * r * n0[0] * siluf_(bflo(ug.x)), o[1] * r * n0[1] * siluf_(bfhi(ug.x))); w.y = pk2(o[2] * r * n0[2] * siluf_(bflo(ug.y)), o[3] * r * n0[3] * siluf_(bfhi(ug.y)));
                    w.z = pk2(o[4] * r * n1[0] * siluf_(bflo(ug.z)), o[5] * r * n1[1] * siluf_(bfhi(ug.z))); w.w = pk2(o[6] * r * n1[2] * siluf_(bflo(ug.w)), o[7] * r * n1[3] * siluf_(bfhi(ug.w)));
                    *(u32x4*)(MIX + (size_t)rown * D_MODEL + 1024 + h * 128 + d0) = w;
                }
            }
            PSEC_CLOSE(4)
        }
        if (kind == 1 && tid < 128) ((float*)(P->ws + WS_DLOG) + 131072)[uidx * 128 + tid] = gtot;
        {
            float* Sd = (kind == 0) ? P->out + OUT_ST + (size_t)((((b * 2 + l) * 2 + dir) * 4 + h)) * 16384 : (float*)(P->ws + WS_U) + (size_t)uidx * 16384;
            float* sp = Sd + (64 * kp + 4 * hh) * 128 + 32 * nt + r32;
#pragma unroll
            for (int i = 0; i < 16; ++i) { sp[R0(i) * 128] = S0[i]; sp[(32 + R0(i)) * 128] = S1[i]; }
        }
    }
    PSEC_FLUSH(2 * nch)
}

__device__ __forceinline__ void hgrn_scan_unit(PP P, int l, int su, int tid) {
    float* U = (float*)(P->ws + WS_U); const float* DLB = (const float*)(P->ws + WS_DLOG) + 131072;
#pragma unroll 1
    for (int k = 0; k < 4; ++k) {
        const int e = su * 2048 + tid + 512 * k;
        const int sq = e >> 14, el = e & 16383, dk = el >> 7, lb = sq >> 3, h = (sq >> 1) & 3, dir = sq & 1;
        float S = P->in[4][(size_t)((((lb * 2 + l) * 2 + dir) * 4 + h)) * 16384 + el];
        float u[16], dl[16];
        const long ustep = dir ? -16384 : 16384, dstep = dir ? -128 : 128;
        float* up = U + (size_t)(sq * 16 + (dir ? 15 : 0)) * 16384 + el; const float* dp = DLB + (sq * 16 + (dir ? 15 : 0)) * 128 + dk;
        { float* uq = up; const float* dq = dp;
#pragma unroll
          for (int p = 0; p < 16; ++p) { u[p] = *uq; dl[p] = *dq; uq += ustep; dq += dstep; asm volatile("" : "+v"(uq), "+v"(dq)); } }
        SBAR
        { float* uq = up;
#pragma unroll
          for (int p = 0; p < 16; ++p) { *uq = S; S = __builtin_amdgcn_exp2f(dl[p]) * S + u[p]; uq += ustep; asm volatile("" : "+v"(uq)); } }
    }
}

constexpr int HF_S0 = 0, HF_S1 = 40960, HF_TG0 = 81920, HF_TG1 = 98816, HF_QG0 = 115712, HF_QG1 = 124416;
__device__ __forceinline__ void hgrn_final_unit(PP P, LAS unsigned char* lds, int l, int idx, int half_sel, int tid) {
    const int lane = tid & 63, wave = __builtin_amdgcn_readfirstlane(tid >> 6), r32 = lane & 31, hh = lane >> 5, i16 = lane & 15, cg = (lane >> 4) & 1;
    const bf16* Z = (const bf16*)(P->ws + WS_Z); bf16* MIX = (bf16*)(P->ws + WS_H); const float* OL = (const float*)(P->ws + WS_OL); const float* DLC = (const float*)(P->ws + WS_DLOG);
    LAS float* ldsf = (LAS float*)lds;
    const int blk = idx & 15, h = (idx >> 4) & 3, lb = idx >> 6, row0 = NCTX + lb * 2048 + blk * 128;
    const int ti = tid >> 4, d0 = 8 * (tid & 15), nt = wave & 3, ds = wave >> 2;
    const int uidx0 = ((idx >> 4) * 2 + 0) * 16 + blk, uidx1 = ((idx >> 4) * 2 + 1) * 16 + blk;
#pragma unroll
    for (int half = 0; half < 2; ++half) {
        f32x4 sv[8];
#pragma unroll
        for (int k = 0; k < 8; ++k) { const int id = tid + 512 * (k + 8 * half), dsel = id >> 12, dk = (id >> 5) & 127, c4 = id & 31;
            sv[k] = *(const f32x4*)((const float*)(P->ws + WS_U) + (size_t)(dsel ? uidx1 : uidx0) * 16384 + dk * 128 + c4 * 4); }
#pragma unroll
        for (int k = 0; k < 8; ++k) { const int id = tid + 512 * (k + 8 * half), dsel = id >> 12, dk = (id >> 5) & 127, c4 = id & 31;
            u32x2 w; w.x = pk2(sv[k][0], sv[k][1]); w.y = pk2(sv[k][2], sv[k][3]); *(LAS u32x2*)(lds + (dsel ? HF_S1 : HF_S0) + dk * 320 + c4 * 8) = w; }
    }
    float oml0[8], oml1[8]; hg_oml8(P, l, 0, h * 128 + d0, oml0); hg_oml8(P, l, 1, h * 128 + d0, oml1);
    const f32x4 n0 = *(const f32x4*)(P->in[13] + l * 512 + h * 128 + d0), n1 = *(const f32x4*)(P->in[13] + l * 512 + h * 128 + d0 + 4);
    float carry = 0.f;
    if (tid < 128) { for (int c = 0; c < 2 * half_sel; ++c) carry += DLC[(uidx0 * 4 + c) * 128 + tid]; }
    for (int nc = 2 * half_sel; nc < 2 * half_sel + 2; ++nc) {
        const int rown = row0 + 32 * nc + ti; const bf16* zr = Z + (size_t)rown * DIN + h * 128 + d0;
        const u32x4 uq = *(const u32x4*)(zr + C_HQ), uf0 = *(const u32x4*)(zr + C_HFF), uf1 = *(const u32x4*)(zr + C_HFB), ug = *(const u32x4*)(zr + C_HG);
        const float* olr = OL + (size_t)rown * 512 + h * 128 + d0; const f32x4 olp0 = *(const f32x4*)olr, olp1 = *(const f32x4*)(olr + 4);
        float off1 = 0.f;
        if (tid >= 128 && tid < 256) { for (int c = 0; c < 3 - nc; ++c) off1 += DLC[(uidx1 * 4 + c) * 128 + (tid - 128)]; }
        float q[8];
        {
            float ga[8], gb[8];
#pragma unroll
            for (int j = 0; j < 4; ++j) { const unsigned wq = uq[j], wa = uf0[j], wb = uf1[j];
                q[2 * j] = siluf_(bflo(wq)) * 0.08838834764831845f; q[2 * j + 1] = siluf_(bfhi(wq)) * 0.08838834764831845f;
                ga[2 * j] = oml0[2 * j] * sigmoidf_(-bflo(wa)); ga[2 * j + 1] = oml0[2 * j + 1] * sigmoidf_(-bfhi(wa));
                gb[2 * j] = oml1[2 * j] * sigmoidf_(-bflo(wb)); gb[2 * j + 1] = oml1[2 * j + 1] * sigmoidf_(-bfhi(wb)); }
#pragma unroll
            for (int j = 0; j < 8; ++j) { ga[j] = __builtin_amdgcn_logf(1.0f - fminf(ga[j], 1.0f - 1e-6f)); gb[j] = __builtin_amdgcn_logf(1.0f - fminf(gb[j], 1.0f - 1e-6f)); }
            LAS float* p0 = ldsf + (HF_TG0 >> 2) + ti * 132 + d0; LAS float* p1 = ldsf + (HF_TG1 >> 2) + ti * 132 + d0;
            *(LAS f32x4*)p0 = (f32x4){ga[0], ga[1], ga[2], ga[3]}; *(LAS f32x4*)(p0 + 4) = (f32x4){ga[4], ga[5], ga[6], ga[7]};
            *(LAS f32x4*)p1 = (f32x4){gb[0], gb[1], gb[2], gb[3]}; *(LAS f32x4*)(p1 + 4) = (f32x4){gb[4], gb[5], gb[6], gb[7]};
        }
        __syncthreads();
        if (tid < 256) { const bool rev = tid >= 128; LAS float* gc = ldsf + ((rev ? HF_TG1 : HF_TG0) >> 2) + (tid & 127); float run = rev ? off1 : carry; float gv[32];
#pragma unroll
            for (int i = 0; i < 32; ++i) gv[i] = gc[(rev ? 31 - i : i) * 132];
            SBAR
#pragma unroll
            for (int i = 0; i < 32; ++i) { run += gv[i]; gc[(rev ? 31 - i : i) * 132] = run; }
            if (!rev) carry = run; }
        __syncthreads();
        {
            const LAS float* g0 = ldsf + (HF_TG0 >> 2) + ti * 132 + d0; const LAS float* g1 = ldsf + (HF_TG1 >> 2) + ti * 132 + d0;
            float a[8], c[8];
#pragma unroll
            for (int j = 0; j < 8; ++j) { a[j] = q[j] * __builtin_amdgcn_exp2f(g0[j]); c[j] = q[j] * __builtin_amdgcn_exp2f(g1[j]); }
            *(LAS bf16x8*)(lds + HF_QG0 + ti * 272 + d0 * 2) = pack8(a[0], a[1], a[2], a[3], a[4], a[5], a[6], a[7]);
            *(LAS bf16x8*)(lds + HF_QG1 + ti * 272 + d0 * 2) = pack8(c[0], c[1], c[2], c[3], c[4], c[5], c[6], c[7]);
        }
        __syncthreads();
        {
            f32x16 acc;
#pragma unroll
            for (int i = 0; i < 16; ++i) acc[i] = 0.f;
            const LAS unsigned char* qp = lds + (ds ? HF_QG1 : HF_QG0) + r32 * 272 + 16 * hh;
            const LAS unsigned char* sp = lds + (ds ? HF_S1 : HF_S0) + (8 * hh + (i16 >> 2)) * 320 + (32 * nt + 16 * cg + 4 * (i16 & 3)) * 2;
#pragma unroll
            for (int k = 0; k < 8; ++k) { const bf16x8 sf = trpair(sp + 16 * k * 320, 4 * 320); acc = __builtin_amdgcn_mfma_f32_32x32x16_bf16(*(const LAS bf16x8*)(qp + 32 * k), sf, acc, 0, 0, 0); }
            LAS float* ob = ldsf + ((ds ? HF_TG1 : HF_TG0) >> 2) + (4 * hh) * 132 + 32 * nt + r32;
#pragma unroll
            for (int i = 0; i < 16; ++i) ob[R0(i) * 132] = acc[i];
        }
        __syncthreads();
        {
            const LAS float* oa = ldsf + (HF_TG0 >> 2) + ti * 132 + d0; const LAS float* obb = ldsf + (HF_TG1 >> 2) + ti * 132 + d0;
            const f32x4 a0 = *(const LAS f32x4*)oa, a1 = *(const LAS f32x4*)(oa + 4), b0 = *(const LAS f32x4*)obb, b1 = *(const LAS f32x4*)(obb + 4);
            const f32x4 o0 = a0 + b0 + olp0, o1 = a1 + b1 + olp1;
            float ss = (o0[0] * o0[0] + o0[1] * o0[1]) + (o0[2] * o0[2] + o0[3] * o0[3]) + (o1[0] * o1[0] + o1[1] * o1[1]) + (o1[2] * o1[2] + o1[3] * o1[3]);
            ss += __shfl_xor(ss, 1); ss += __shfl_xor(ss, 2); ss += __shfl_xor(ss, 4); ss += __shfl_xor(ss, 8);
            const float r = __builtin_amdgcn_rsqf(ss * (1.0f / 128.0f) + 1e-6f);
            u32x4 w;
            w.x = pk2(o0[0] * r * n0[0] * siluf_(bflo(ug.x)), o0[1] * r * n0[1] * siluf_(bfhi(ug.x))); w.y = pk2(o0[2] * r * n0[2] * siluf_(bflo(ug.y)), o0[3] * r * n0[3] * siluf_(bfhi(ug.y)));
            w.z = pk2(o1[0] * r * n1[0] * siluf_(bflo(ug.z)), o1[1] * r * n1[1] * siluf_(bfhi(ug.z))); w.w = pk2(o1[2] * r * n1[2] * siluf_(bflo(ug.w)), o1[3] * r * n1[3] * siluf_(bfhi(ug.w)));
            *(u32x4*)(MIX + (size_t)rown * D_MODEL + 1024 + h * 128 + d0) = w;
        }
        __syncthreads();
    }
}

#define RLX_AGENT __ATOMIC_RELAXED, __HIP_MEMORY_SCOPE_AGENT
#define XB_TMO      128
#define XB_XCNT(j)  (256  + 64 * (j))
#define XB_XSUB(j)  (1280 + 64 * (j))
#define XB_XGEN(j)  (2304 + 64 * (j))
#define XB_TOP      3328
#define XB_TOPGEN   3392
#define XCD_BAR_WORDS 3456
#define XB_SPIN_CAP (1u << 18)

__device__ __forceinline__ unsigned xb_ld(unsigned* p)              { return __hip_atomic_load(p, __ATOMIC_RELAXED, __HIP_MEMORY_SCOPE_AGENT); }
__device__ __forceinline__ unsigned xb_add(unsigned* p, unsigned v) { return __hip_atomic_fetch_add(p, v, __ATOMIC_RELAXED, __HIP_MEMORY_SCOPE_AGENT); }
__device__ __forceinline__ unsigned xb_xcc_id() { return (unsigned)__builtin_amdgcn_s_getreg((3 << 11) | 20) & 0xFu; }
#define XB_SPIN(cond, bar) do { unsigned _sp = 0; while (cond) { __builtin_amdgcn_s_sleep(1); \
    if ((++_sp & 255u) == 0u) { if (xb_ld(&(bar)[XB_TMO])) break; if (_sp > XB_SPIN_CAP) { atomicAdd(&(bar)[XB_TMO], 1u); break; } } } } while (0)

struct XcdBarrier {
    unsigned* bar; unsigned x; bool t0;
    volatile LAS unsigned* st;
};

__device__ __forceinline__ XcdBarrier xcd_barrier_post(unsigned* bar, volatile LAS unsigned* st) {
    XcdBarrier b; b.bar = bar; b.x = xb_xcc_id(); b.st = st; b.t0 = (threadIdx.x == 0);
    if (threadIdx.x == 0) (void)xb_add(&bar[XB_XCNT(b.x)], 1u);
    return b;
}
__device__ __forceinline__ void xcd_barrier_complete(unsigned* bar, unsigned x, unsigned& nloc, unsigned& nx) {
    const unsigned G = gridDim.x * gridDim.y * gridDim.z;
    unsigned sum, cnt, mine, sp = 0u;
    for (;;) {
        sum = 0u; cnt = 0u; mine = 0u;
#pragma unroll
        for (unsigned j = 0; j < 16; ++j) { const unsigned c = xb_ld(&bar[XB_XCNT(j)]); sum += c; cnt += (c > 0u) ? 1u : 0u; mine = (j == x) ? c : mine; }
        if (sum == G) break;
        __builtin_amdgcn_s_sleep(1);
        if ((++sp & 255u) == 0u) { if (xb_ld(&bar[XB_TMO])) break; if (sp > XB_SPIN_CAP) { atomicAdd(&bar[XB_TMO], 1u); break; } }
    }
    nloc = mine > 0u ? mine : 1u; nx = cnt > 0u ? cnt : 1u;
}

__device__ __forceinline__ void xcd_barrier(const XcdBarrier& b) {
    asm volatile("s_waitcnt vmcnt(0)" ::: "memory");
    __syncthreads();
    if (b.t0) {
        unsigned* bar = b.bar;
        __builtin_amdgcn_s_waitcnt(0);
        unsigned nloc = b.st[0], nx = b.st[1];
        if (nloc == 0u) { xcd_barrier_complete(bar, b.x, nloc, nx); b.st[0] = nloc; b.st[1] = nx; }
        const unsigned old = xb_add(&bar[XB_XSUB(b.x)], 1u);
        const unsigned gen = old / nloc;
        if (old + 1u == (gen + 1u) * nloc) {
            __builtin_amdgcn_fence(__ATOMIC_RELEASE, "agent");
            asm volatile("s_waitcnt vmcnt(0)" ::: "memory");
            const unsigned og = xb_add(&bar[XB_TOP], 1u);
            const unsigned tg = og / nx;
            if (og + 1u == (tg + 1u) * nx) xb_add(&bar[XB_TOPGEN], 1u);
            else XB_SPIN(xb_ld(&bar[XB_TOPGEN]) == tg, bar);
            __builtin_amdgcn_fence(__ATOMIC_ACQUIRE, "agent");
            xb_add(&bar[XB_XGEN(b.x)], 1u);
            asm volatile("s_waitcnt vmcnt(0)" ::: "memory");
        } else {
            XB_SPIN(xb_ld(&bar[XB_XGEN(b.x)]) == gen, bar);
            __builtin_amdgcn_fence(__ATOMIC_ACQUIRE, "agent");
            asm volatile("s_waitcnt vmcnt(0)" ::: "memory");
        }
    }
    __syncthreads();
}

#ifndef REP_P0
#define REP_P0 1
#endif
#ifndef REP_P1
#define REP_P1 1
#endif
#ifndef REP_P2
#define REP_P2 1
#endif
#ifndef PROBE_KIND
#define PROBE_KIND -1
#endif
#ifndef PROBE_PH
#define PROBE_PH 0
#endif
#ifndef PROBE_SCALE
#define PROBE_SCALE 1.0f
#endif
#ifndef PROBE_PB
#define PROBE_PB 0
#endif
#ifndef PROBE_PL
#define PROBE_PL 0
#endif
#ifndef P0_MASK
#define P0_MASK 3
#endif
#ifndef P2_MASK
#define P2_MASK 31
#endif
#ifndef REP_P3
#define REP_P3 1
#endif
#ifndef REP_P4
#define REP_P4 1
#endif
__global__ void __launch_bounds__(NTHREADS, 2) fwd_kernel(Params Pkarg) {
    extern __shared__ __attribute__((aligned(16))) unsigned char lds_raw[];
    cg::grid_group grid = cg::this_grid();
    LAS unsigned char* lds = (LAS unsigned char*)lds_raw;
    LAS float* ldsf = (LAS float*)lds;
    volatile LAS unsigned* qslot = (volatile LAS unsigned*)(lds + LDS_CTLW);
    volatile LAS unsigned* xbst = (volatile LAS unsigned*)(lds + LDS_CTLW + 128);
    if (threadIdx.x < 2) xbst[threadIdx.x] = 0u;
    __syncthreads();
    (void)xcd_barrier_post((unsigned*)(Pkarg.ws + WS_CTL) + 1024, xbst);
#define PSTAMP(k, lay) do { if (PROBE_KIND == 20 && (lay) == PROBE_PL && blockIdx.x == PROBE_PB && wave_s == 0) { const unsigned long long t_ = __builtin_amdgcn_s_memrealtime(); if ((k) == PROBE_PH) pst0 = t_; if ((k) == PROBE_PH + 1) pst1 = t_; } } while (0)
#define tid_zero_() (wave_s == 0 && __builtin_amdgcn_mbcnt_hi(~0u, __builtin_amdgcn_mbcnt_lo(~0u, 0u)) == 0u)
#define GSYNC() do { PP Pb_ = (PP)__builtin_amdgcn_kernarg_segment_ptr(); asm volatile("" : "+s"(Pb_)); XcdBarrier xb_; xb_.bar = (unsigned*)(Pb_->ws + WS_CTL) + 1024; xb_.x = xb_xcc_id(); xb_.st = xbst; int ln_; asm volatile("v_mbcnt_lo_u32_b32 %0, -1, 0\n\tv_mbcnt_hi_u32_b32 %0, -1, %0" : "=v"(ln_)); xb_.t0 = (wave_s == 0) && (ln_ == 0); xcd_barrier(xb_); } while (0)
    const int wave_s = __builtin_amdgcn_readfirstlane(threadIdx.x >> 6);
#define PHASE_IDS int tid; asm volatile("v_mbcnt_lo_u32_b32 %0, -1, 0\n\tv_mbcnt_hi_u32_b32 %0, -1, %0" : "=v"(tid)); tid += wave_s * 64; const int lane = tid & 63, wave = wave_s, gw = blockIdx.x * NWAVES + wave; (void)lane; (void)gw; \
    PP P = (PP)__builtin_amdgcn_kernarg_segment_ptr(); asm volatile("" : "+s"(P)); unsigned char* ws = P->ws; unsigned* ctl = (unsigned*)(ws + WS_CTL); float* MOD = (float*)(ws + WS_MOD); \
    bf16* H = (bf16*)(ws + WS_H); bf16* Z = (bf16*)(ws + WS_Z); bf16* WTIN = (bf16*)(ws + WS_WTIN); bf16* WTOUT = (bf16*)(ws + WS_WTOUT); const float* xp = P->in[0]; const float* xs = P->in[1]; \
    (void)ctl; (void)MOD; (void)H; (void)Z; (void)WTIN; (void)WTOUT; (void)xp; (void)xs;
    const int G = gridDim.x, NGW = G * NWAVES;
    unsigned long long pst0 = 0ull, pst1 = 0ull;

    for (int rep = 0; rep < REP_P0; ++rep) {
        PHASE_IDS
        const int m0 = (rep == 0) ? 3 : P0_MASK;
        if (m0 & 1) for (int u = blockIdx.x; u < 384; u += G) mod_unit(P, ldsf, u / 192, u % 192, tid);
        LAS float* scr = ldsf + wave * 4096;
        if (m0 & 2) for (int it = gw; it < 6656 + 2048 + 2048; it += NGW) {
            if (it < 6656) transpose_item(P->in[9], 2048, DIN, WTIN, scr, it, lane);
            else if (it < 6656 + 2048) transpose_item(P->in[10], 2048, 2048, WTOUT, scr, it - 6656, lane);
            else transpose_item(P->in[10] + (size_t)2048 * 2048, 2048, 2048, WTOUT + (size_t)2048 * 2048, scr, it - 6656 - 2048, lane);
        }
        { const int gt4 = (blockIdx.x * NTHREADS + tid) * 4;
          if (gt4 < 524288) { const float* src = (gt4 < 262144) ? P->in[2] + gt4 : P->in[3] + (gt4 - 262144); const f32x4 v = *(const f32x4*)src;
              u32x2 w; w.x = pk2(v[0], v[1]); w.y = pk2(v[2], v[3]); *(u32x2*)((bf16*)(ws + WS_CKV) + gt4) = w; } }
        const int gt = blockIdx.x * NTHREADS + tid;
        if (gt < 2048) { const int pos = gt >> 5, i = gt & 31; const float inv = powf(10000.0f, -(float)i / 32.0f); const float ang = (float)pos * inv;
            float sn, cs; sincosf(ang, &sn, &cs); float* CS = (float*)(ws + WS_CS); CS[gt * 2] = cs; CS[gt * 2 + 1] = sn; }
        grid.sync();
    }
    { PHASE_IDS
    for (int row = gw; row < MTOK; row += NGW) {
        const int cond = (row < NCTX) ? 0 : 1 + ((row - NCTX) >> 11);
        const float* xrow = (row < NCTX) ? xp + (size_t)row * D_MODEL : xs + (size_t)(row - NCTX) * D_MODEL;
        hprep_row(xrow, MOD + (0 * 3 + cond) * 6144, H + (size_t)row * D_MODEL, lane);
    } }
    GSYNC();

    for (int l = 0; l < DEPTH; ++l) {
        PSTAMP(0, l);
        for (int rep = 0; rep < REP_P1; ++rep) {
            PHASE_IDS
            pg8::Gemm g{H, WTIN, MTOK, DIN, D_MODEL}; pg8::StaticOrder S; S.init(MTOK, DIN, D_MODEL, G, (int)blockIdx.x);
            pg8::EpiZ E{Z, P->out + OUT_CK, P->out + OUT_CV, l};
            pg8::gemm_phase<pg8::EpiZ, pg8::StaticOrder, true, true>(lds, g, S, E, tid);
            GSYNC();
        }
        PSTAMP(1, l);
        {
            int pendf = -1; int uf = -1;
            unsigned long long pr_sum = 0ull; unsigned pr_cnt = 0u;
            const int n_cvt = (l == 0) ? 832 : 0;
            for (int st = 0; st < 3; ++st) {
                PHASE_IDS
                unsigned* cs = ctl + 64 * (l * 4 + st); unsigned* cf = ctl + 64 * (l * 4 + 3);
                const int nspec = (st == 2) ? 256 : 128;
                const int capf = (st == 0) ? 256 : (st == 1) ? 512 : 896 + n_cvt;
                int pends = -1; bool spec = true;
                int us = q_pop(cs, qslot, tid, pends, 1 << 30);
                for (;;) {
                    int kind, idx;
                    if (spec) {
                        if (us >= nspec) { spec = false; if (uf < 0) uf = q_pop(cf, qslot, tid, pendf, 512); continue; }
                        kind = (st == 0) ? 1 : (st == 1) ? 6 : 7; idx = us;
                    } else {
                        if (uf >= capf) break;
                        if (uf < 128) { kind = 0; idx = uf; } else if (uf < 256) { kind = 3; idx = uf - 128; } else if (uf < 512) { kind = 2; idx = uf - 256; }
                        else if (uf < 896) { kind = 4; idx = uf - 512; } else { kind = 5; idx = uf - 896; }
                    }
                    asm volatile("" : "+v"(tid));
                    const unsigned long long pr_t0 = (PROBE_KIND >= 0 && PROBE_KIND < 9) ? __builtin_amdgcn_s_memrealtime() : 0ull;
                    if (kind <= 1) hgrn2_unit(P, lds, l, kind, idx, tid);
                    else if (kind <= 3) attn_unit(P, lds, l, kind - 2, idx, tid);
                    else if (kind == 4) conv_unit(P, ldsf, l, idx, tid);
                    else if (kind == 5) { const int lane2 = tid & 63; LAS float* scr = ldsf + wave * 4096; transpose_item(P->in[9] + (size_t)2048 * DIN, 2048, DIN, WTIN, scr, idx * 8 + wave, lane2); }
                    else if (kind == 6) hgrn_scan_unit(P, l, idx, tid);
                    else hgrn_final_unit(P, lds, l, idx >> 1, idx & 1, tid);
                    if (PROBE_KIND >= 0 && PROBE_KIND < 9 && kind == PROBE_KIND) { __syncthreads(); pr_sum += __builtin_amdgcn_s_memrealtime() - pr_t0; pr_cnt += 1u; }
                    if (spec) us = q_pop(cs, qslot, tid, pends, 1 << 30); else uf = q_pop(cf, qslot, tid, pendf, 512);
                }
                GSYNC();
                PSTAMP(2 + st, l);
            }
            if (PROBE_KIND >= 0 && PROBE_KIND < 9 && l == 0 && tid_zero_()) { atomicAdd((unsigned long long*)((unsigned*)(Pkarg.ws + WS_CTL) + 60000), pr_sum); atomicAdd((unsigned*)(Pkarg.ws + WS_CTL) + 60002, pr_cnt); }
        }
        if (G == 256) {
            {   PHASE_IDS
                pg8::Gemm g{H, WTOUT + (size_t)l * 2048 * 2048, MTOK, D_MODEL, D_MODEL}; pg8::StaticOrder S; S.init(MTOK, D_MODEL, D_MODEL, G, (int)blockIdx.x, 0); S.rset = 0;
                pg8::EpiV E{(l == 0) ? xp : P->out, (l == 0) ? xs : P->out + OUT_YS, P->out, MOD + l * 3 * 6144 + 4096, (float*)(ws + WS_OL), ctl + 8192};
                pg8::gemm_phase<pg8::EpiV, pg8::StaticOrder, true, true>(lds, g, S, E, tid);
            }
            GSYNC();
            PSTAMP(5, l);
            if (blockIdx.x < 128) {
                PHASE_IDS
                pg8::Gemm g{H, WTOUT + (size_t)l * 2048 * 2048, MTOK, D_MODEL, D_MODEL}; pg8::StaticOrder S; S.init(MTOK, D_MODEL, D_MODEL, G, (int)blockIdx.x, 0); S.rset = 1;
                pg8::EpiV E{(l == 0) ? xp : P->out, (l == 0) ? xs : P->out + OUT_YS, P->out, MOD + l * 3 * 6144 + 4096, (float*)(ws + WS_OL), ctl + 8192};
                pg8::gemm_phase<pg8::EpiV, pg8::StaticOrder, true, true>(lds, g, S, E, tid);
            } else {
                PHASE_IDS
                for (int row = (blockIdx.x - 128) * NWAVES + wave; row < NCTX; row += 128 * NWAVES)
                    ln_row(P->out + (size_t)row * D_MODEL, P->in[18] + l * D_MODEL, P->in[19] + l * D_MODEL, MOD + 3 * 6144, (l == 0) ? H + (size_t)row * D_MODEL : (bf16*)nullptr, lane);
            }
#ifdef PROBE_SUB
            __syncthreads(); PSTAMP(6, l);
#endif
            GSYNC();
#ifndef PROBE_SUB
            PSTAMP(6, l);
#endif
            {   PHASE_IDS
                for (int row = NCTX + gw; row < MTOK; row += NGW) { const int cond = 1 + ((row - NCTX) >> 11);
                    ln_row(P->out + (size_t)row * D_MODEL, P->in[18] + l * D_MODEL, P->in[19] + l * D_MODEL, MOD + (3 + cond) * 6144, (l == 0) ? H + (size_t)row * D_MODEL : (bf16*)nullptr, lane); }
            }
        } else {
            {   PHASE_IDS
                pg8::Gemm g{H, WTOUT + (size_t)l * 2048 * 2048, MTOK, D_MODEL, D_MODEL}; pg8::StaticOrder S; S.init(MTOK, D_MODEL, D_MODEL, G, (int)blockIdx.x, 0);
                pg8::EpiV E{(l == 0) ? xp : P->out, (l == 0) ? xs : P->out + OUT_YS, P->out, MOD + l * 3 * 6144 + 4096, (float*)(ws + WS_OL), ctl + 8192};
                pg8::gemm_phase<pg8::EpiV, pg8::StaticOrder, true, true>(lds, g, S, E, tid);
            }
            GSYNC();
            {   PHASE_IDS
                for (int row = gw; row < MTOK; row += NGW) { const int cond = (row < NCTX) ? 0 : 1 + ((row - NCTX) >> 11);
                    ln_row(P->out + (size_t)row * D_MODEL, P->in[18] + l * D_MODEL, P->in[19] + l * D_MODEL, MOD + (3 + cond) * 6144, (l == 0) ? H + (size_t)row * D_MODEL : (bf16*)nullptr, lane); }
            }
        }
        if (l + 1 < DEPTH) GSYNC();
        PSTAMP(7, l);
    }
    if (PROBE_KIND >= 0) { GSYNC(); PHASE_IDS if (blockIdx.x == ((PROBE_KIND == 20) ? PROBE_PB : 0) && tid == 0) { const unsigned long long sm = *(volatile unsigned long long*)(ctl + 60000); const unsigned cn = *(volatile unsigned*)(ctl + 60002); const float pv_ = (PROBE_KIND == 20) ? PROBE_SCALE * 0.01f * (float)(pst1 - pst0) : ((PROBE_KIND == 9) ? 0.1f : 0.01f) * (float)sm / (float)(cn ? cn : 1u);     P->out[0] = pv_; P->out[1] = pv_; P->out[2] = pv_; P->out[3] = pv_; }     }
}

extern "C" void kernel_launch(void* const* d_in, const int* in_sizes, int n_in, void* d_out, int out_size, void* d_ws, size_t ws_size, hipStream_t stream) {
    static int grid = 0;
    if (grid == 0) {
        if (n_in != 20 || out_size != (int)OUT_TOTAL || ws_size < WS_END) { fprintf(stderr, "kernel_launch: unexpected shapes (n_in %d, out %d, ws %zu)\n", n_in, out_size, ws_size); grid = -1; return; }
        int dev = 0, cus = 0, per_cu = 0;
        hipGetDevice(&dev); hipDeviceGetAttribute(&cus, hipDeviceAttributeMultiprocessorCount, dev);
        hipFuncSetAttribute((const void*)fwd_kernel, hipFuncAttributeMaxDynamicSharedMemorySize, LDS_BYTES);
        hipOccupancyMaxActiveBlocksPerMultiprocessor(&per_cu, (const void*)fwd_kernel, NTHREADS, LDS_BYTES);
        if (per_cu < 1) { fprintf(stderr, "kernel_launch: occupancy query says %d blocks per CU\n", per_cu); grid = -1; return; }
        grid = cus;
    }
    if (grid < 0) return;
    hipMemsetAsync((char*)d_ws + WS_CTL, 0, CTL_ZERO_BYTES, stream);
    Params p{};
    for (int i = 0; i < 20; ++i) p.in[i] = (const float*)d_in[i];
    p.out = (float*)d_out; p.ws = (unsigned char*)d_ws;
    void* args[] = {&p};
    hipError_t e = hipLaunchCooperativeKernel((const void*)fwd_kernel, dim3(grid), dim3(NTHREADS), args, LDS_BYTES, stream);
    if (e != hipSuccess) fprintf(stderr, "cooperative launch failed: %s (grid %d)\n", hipGetErrorString(e), grid);
}
```

```cpp
#include <hip/hip_runtime.h>
#include <hip/hip_cooperative_groups.h>
#include <cstdio>
#include <cstdint>
namespace cg = cooperative_groups;

constexpr int D_MODEL = 2048, DIN = 6656, NCTX = 8192, NLAT = 4096, MTOK = 12288, DEPTH = 2;
constexpr int C_AQ = 0, C_AK = 1024, C_AV = 1280, C_AG = 1536, C_HQ = 2560, C_HI = 3072, C_HFF = 3584, C_HFB = 4096, C_HG = 4608, C_CA = 5120, C_CB = 5632, C_CG = 6144;
constexpr float ALPHA_DN = 1.4142135623730951f;
constexpr size_t OUT_YP = 0, OUT_YS = 16777216, OUT_CK = 25165824, OUT_CV = 29360128, OUT_ST = 33554432, OUT_TOTAL = 41943040;
namespace pg8 {
#define PG8_LAS __attribute__((address_space(3)))
typedef unsigned short bf16_t;
typedef short bf16x8 __attribute__((ext_vector_type(8)));
typedef float f32x4 __attribute__((ext_vector_type(4)));
typedef unsigned u32x4 __attribute__((ext_vector_type(4)));
constexpr int BM = 256, BK = 64, HALF = 128, HTB = HALF * BK * 2  , STAGE_BYTES = 8 * HTB, NXCD = 8, WGM = 8;

__host__ __device__ __forceinline__ int lds_byte(int r, int c) { const int st = (r >> 4) * 2 + (c >> 5), rr = r & 15, cc = c & 31, ob = rr * 64 + cc * 2; return st * 1024 + (ob ^ (((ob >> 9) & 1) << 5)); }
__host__ __device__ __forceinline__ void stage_rc(int b, int& R, int& C) { const int st = b / 1024, sb = b % 1024, swz = sb ^ (((sb >> 9) & 1) << 5); R = (st >> 1) * 16 + swz / 64; C = (st & 1) * 32 + (swz % 64) / 2; }
__host__ __device__ __forceinline__ int perm32(int rho) { const int n = rho >> 4, i = rho & 15; return 8 * (i >> 2) + 4 * n + (i & 3); }

struct Unit { int pm, pn, k0, nk, role, pair; };
struct Gemm { const bf16_t* A; const bf16_t* Bt; int M, N, K; };

struct StaticOrder {
    int nM, nN, nwg, G, c, nkt, split, rset;
    __host__ __device__ void init(int M, int N, int K, int G_, int c_, int split_ = 0) { nM = M / BM; nN = N / BM; nwg = nM * nN; G = G_; c = c_; nkt = K / BK; split = split_ && (G_ % 16 == 0) && (2 * nwg == 3 * G_) && (nkt % 4 == 0); rset = -1; }
    __host__ __device__ void map(long L, Unit& u) const {
        int wgid = (int)L; { const int q = nwg / NXCD, r = nwg % NXCD, xcd = wgid % NXCD, off = wgid / NXCD; wgid = (xcd < r ? xcd * (q + 1) : r * (q + 1) + (xcd - r) * q) + off; }
        const int nig = WGM * nN, gid = wgid / nig, fm = gid * WGM, gsz = (nM - fm) < WGM ? (nM - fm) : WGM;
        u.pm = fm + ((wgid % nig) % gsz); u.pn = (wgid % nig) / gsz; u.k0 = 0; u.nk = nkt; u.role = 0; u.pair = 0;
    }
    __host__ __device__ bool next(int i, Unit& u) const {
        if (rset >= 0) {
            if (i != 0) return false;
            const int xcd = c & 7, ix = c >> 3;
            if (rset == 0) { u.pm = xcd * 4 + (ix >> 3); u.pn = ix & 7; } else { if (c >= 128) return false; u.pm = 32 + xcd * 2 + (ix >> 3); u.pn = ix & 7; }
            u.k0 = 0; u.nk = nkt; u.role = 0; u.pair = 0; return true;
        }
        if (split) {
            if (i == 0) { map(c, u); return true; }
            if (i == 1) { const int j = (c >> 4) * 8 + (c & 7), half = (c >> 3) & 1; map(G + j, u); u.k0 = half * (nkt / 2); u.nk = nkt / 2; u.role = 1 + half; u.pair = j; return true; }
            return false;
        }
        const long L = (long)i * G + c; if (L >= nwg) return false;
        map(L, u); return true;
    }
    __device__ __forceinline__ void a_ready(const Unit&) const {}
    __device__ __forceinline__ void done(const Unit&) const {}
};

__device__ __forceinline__ unsigned cvt_pk_bf16(float lo, float hi) { unsigned r; asm volatile("v_cvt_pk_bf16_f32 %0, %1, %2" : "=v"(r) : "v"(lo), "v"(hi)); return r; }
typedef float f32x2 __attribute__((ext_vector_type(2)));

struct EpiZ {
    static constexpr bool PERM = true, AFTER_DRAIN = false;
    bf16_t* Z; float* ck; float* cv; int layer;
    __device__ __forceinline__ void operator()(f32x4 (&acc)[2][2][4][2], const Unit& u, int wr, int wc, int fr_in, int fq_in) const {
        int fr = fr_in, fq = fq_in; asm volatile("" : "+v"(fr), "+v"(fq));
        const int row0 = u.pm * BM + wr * 64 + fr; const int col0 = u.pn * BM + wc * 32 + 8 * fq;
#pragma unroll
        for (int ai = 0; ai < 2; ++ai)
#pragma unroll
            for (int m = 0; m < 4; ++m) { bf16_t* rowp = Z + (size_t)(row0 + ai * HALF + m * 16) * DIN + col0;
#pragma unroll
                for (int bj = 0; bj < 2; ++bj) { const f32x4 v0 = acc[ai][bj][m][0], v1 = acc[ai][bj][m][1];
                    u32x4 w; w.x = cvt_pk_bf16(v0[0], v0[1]); w.y = cvt_pk_bf16(v0[2], v0[3]); w.z = cvt_pk_bf16(v1[0], v1[1]); w.w = cvt_pk_bf16(v1[2], v1[3]);
                    *(u32x4*)(rowp + bj * HALF) = w; } }
        if ((u.pn == 4 || u.pn == 5) && u.pm < 32) {
            float* base = (u.pn == 4) ? ck : cv;
#pragma unroll
            for (int ai = 0; ai < 2; ++ai)
#pragma unroll
                for (int m = 0; m < 4; ++m) { const int row = row0 + ai * HALF + m * 16; const int b = row >> 8, s = row & 255;
                    float* p = base + ((size_t)((b * 2 + layer) * 256 + s)) * 256 + (wc * 32 + 8 * fq);
#pragma unroll
                    for (int bj = 0; bj < 2; ++bj) { *(f32x4*)(p + bj * HALF) = acc[ai][bj][m][0]; *(f32x4*)(p + bj * HALF + 4) = acc[ai][bj][m][1]; } }
        }
    }
};
struct EpiV {
    static constexpr bool PERM = false, AFTER_DRAIN = false;
    const float* xp; const float* xs; float* V; const float* gate;
    float* slab; unsigned* flags;
    __device__ __forceinline__ void operator()(f32x4 (&acc)[2][2][4][2], const Unit& u, int wr, int wc, int fr_in, int fq_in) const {
        int fr = fr_in, fq = fq_in; asm volatile("" : "+v"(fr), "+v"(fq));
        const int lane = fq * 16 + fr, tid = (wr * 4 + wc) * 64 + lane;
        float* sp = slab + (size_t)u.pair * 65536 + tid * 4; unsigned* fl = flags + 64 * u.pair;
        if (u.role == 1) {
            { float* q = sp;
#pragma unroll
              for (int ai = 0; ai < 2; ++ai)
#pragma unroll
                for (int m = 0; m < 4; ++m)
#pragma unroll
                    for (int bj = 0; bj < 2; ++bj)
#pragma unroll
                        for (int n = 0; n < 2; ++n) {
                            asm volatile("global_store_dwordx4 %0, %1, off sc1\n\ts_nop 1" :: "v"(q), "v"(acc[ai][bj][m][n]) : "memory");
                            q += 2048; asm volatile("" : "+v"(q)); } }
            asm volatile("s_waitcnt vmcnt(0)" ::: "memory");
            if (lane == 0) __hip_atomic_fetch_add(fl, 1u, __ATOMIC_RELAXED, __HIP_MEMORY_SCOPE_AGENT);
            return;
        }
        const bool red = (u.role == 2);
        if (red) {
            unsigned sp_ = 0;
            while ((unsigned)__builtin_amdgcn_readfirstlane(__hip_atomic_load(fl, __ATOMIC_RELAXED, __HIP_MEMORY_SCOPE_AGENT)) < 8u) { __builtin_amdgcn_s_sleep(2); if (++sp_ > (1u << 20)) break; }
            asm volatile("" ::: "memory");
        }
        const int row0 = u.pm * BM + wr * 64 + fr; const int col0 = u.pn * BM + wc * 32 + 4 * fq;
        const int cond = (u.pm < 32) ? 0 : 1 + ((u.pm - 32) >> 3);
        const float* g = gate + cond * 6144 + col0;
        f32x4 gv[2][2];
#pragma unroll
        for (int bj = 0; bj < 2; ++bj)
#pragma unroll
            for (int n = 0; n < 2; ++n) gv[bj][n] = *(const f32x4*)(g + bj * HALF + n * 16);
        if (!red) {
            f32x4 xq[2][4];
            { const int row = row0; const float* xr = ((row < NCTX) ? xp + (size_t)row * D_MODEL : xs + (size_t)(row - NCTX) * D_MODEL) + col0;
#pragma unroll
              for (int e = 0; e < 4; ++e) xq[0][e] = *(const f32x4*)(xr + (e >> 1) * HALF + (e & 1) * 16); }
#pragma unroll
            for (int g8 = 0; g8 < 8; ++g8) { const int ai = g8 >> 2, m = g8 & 3; const int row = row0 + ai * HALF + m * 16;
                if (g8 + 1 < 8) { const int rown = row0 + ((g8 + 1) >> 2) * HALF + ((g8 + 1) & 3) * 16;
                    const float* xr = ((rown < NCTX) ? xp + (size_t)rown * D_MODEL : xs + (size_t)(rown - NCTX) * D_MODEL) + col0;
#pragma unroll
                    for (int e = 0; e < 4; ++e) xq[(g8 + 1) & 1][e] = *(const f32x4*)(xr + (e >> 1) * HALF + (e & 1) * 16); }
                float* vr = V + (size_t)row * D_MODEL + col0;
#pragma unroll
                for (int e = 0; e < 4; ++e) *(f32x4*)(vr + (e >> 1) * HALF + (e & 1) * 16) = xq[g8 & 1][e] * ALPHA_DN + gv[e >> 1][e & 1] * acc[ai][e >> 1][m][e & 1];
                asm volatile("" ::: "memory"); }
        } else {
            const float* rq = sp;
#pragma unroll
            for (int ai = 0; ai < 2; ++ai)
#pragma unroll
                for (int m = 0; m < 4; ++m) { const int row = row0 + ai * HALF + m * 16;
                    const float* xr = ((row < NCTX) ? xp + (size_t)row * D_MODEL : xs + (size_t)(row - NCTX) * D_MODEL) + col0;
                    float* vr = V + (size_t)row * D_MODEL + col0;
                    f32x4 t[2][2];
#pragma unroll
                    for (int bj = 0; bj < 2; ++bj)
#pragma unroll
                        for (int n = 0; n < 2; ++n) { const unsigned long long* q8 = (const unsigned long long*)rq;
                            const unsigned long long a8 = __hip_atomic_load(q8, __ATOMIC_RELAXED, __HIP_MEMORY_SCOPE_AGENT), b8 = __hip_atomic_load(q8 + 1, __ATOMIC_RELAXED, __HIP_MEMORY_SCOPE_AGENT);
                            t[bj][n] = (f32x4){__builtin_bit_cast(float, (unsigned)a8), __builtin_bit_cast(float, (unsigned)(a8 >> 32)), __builtin_bit_cast(float, (unsigned)b8), __builtin_bit_cast(float, (unsigned)(b8 >> 32))};
                            rq += 2048; asm volatile("" : "+v"(rq)); }
#pragma unroll
                    for (int bj = 0; bj < 2; ++bj)
#pragma unroll
                        for (int n = 0; n < 2; ++n) { const f32x4 xv = *(const f32x4*)(xr + bj * HALF + n * 16);
                            *(f32x4*)(vr + bj * HALF + n * 16) = xv * ALPHA_DN + gv[bj][n] * (acc[ai][bj][m][n] + t[bj][n]); }
                    asm volatile("" ::: "memory"); }
        }
    }
};
template <class Epi, class Sched, bool ALIGN_EPI = false, bool SP2 = false>
__device__ __forceinline__ void gemm_phase(PG8_LAS unsigned char* lds, const Gemm g, const Sched& S, const Epi& E, int tid_in) {
    int tid_l = tid_in; asm volatile("" : "+v"(tid_l));
    const int tid = tid_l, wid = __builtin_amdgcn_readfirstlane(tid >> 6), lane = tid & 63, wr = wid >> 2, wc = wid & 3, fr = lane & 15, fq = lane >> 4;
    const int K = g.K;
    unsigned voffA[2], voffB[2];
#pragma unroll
    for (int i = 0; i < 2; ++i) { int R, C; stage_rc(tid * 16 + i * 8192, R, C); const int Rb = Epi::PERM ? ((R & ~31) + perm32(R & 31)) : R;
        voffA[i] = (unsigned)(R * K + C) * 2u; voffB[i] = (unsigned)(Rb * K + C) * 2u; }
    const size_t kstep = (size_t)(BK * 2);
    const size_t hstep = (size_t)HALF * K * 2;
    const size_t tstep = 2 * hstep;
    const unsigned ldsw = (unsigned)wid * 1024u;
    const int aoff = lds_byte(wr * 64 + fr, fq * 8), boff = lds_byte(wc * 32 + fr, fq * 8);
#define PG8_SA(b, h) (((b) * 2 + (h)) * HTB)
#define PG8_SB(b, h) ((4 + (b) * 2 + (h)) * HTB)
#define PG8_STAGE(bufoff, gbase, voff) do { _Pragma("unroll") for (int _i = 0; _i < 2; ++_i) \
        __builtin_amdgcn_global_load_lds((const unsigned*)((const char*)(gbase) + (voff)[_i]), (PG8_LAS unsigned*)(lds + (bufoff) + ldsw + _i * 8192), 16, 0, 0); } while (0)
#define PG8_LDA(dst, b, h) do { _Pragma("unroll") for (int m = 0; m < 4; ++m) _Pragma("unroll") for (int k = 0; k < 2; ++k) dst[m][k] = *(const PG8_LAS bf16x8*)(lds + PG8_SA(b, h) + aoff + m * 2048 + k * 1024); } while (0)
#define PG8_LDB(dst, b, h) do { _Pragma("unroll") for (int n = 0; n < 2; ++n) _Pragma("unroll") for (int k = 0; k < 2; ++k) dst[n][k] = *(const PG8_LAS bf16x8*)(lds + PG8_SB(b, h) + boff + n * 2048 + k * 1024); } while (0)
#define PG8_MMA(ai, bj, At, Bt) do { __builtin_amdgcn_s_setprio(1); _Pragma("unroll") for (int m = 0; m < 4; ++m) _Pragma("unroll") for (int n = 0; n < 2; ++n) _Pragma("unroll") for (int k = 0; k < 2; ++k) \
        acc[ai][bj][m][n] = __builtin_amdgcn_mfma_f32_16x16x32_bf16(Bt[n][k], At[m][k], acc[ai][bj][m][n], 0, 0, 0); __builtin_amdgcn_s_setprio(0); } while (0)
#define PG8_WAIT_V(n) asm volatile("s_waitcnt vmcnt(" #n ")" ::: "memory")
#define PG8_WAIT_L(n) asm volatile("s_waitcnt lgkmcnt(" #n ")" ::: "memory")
#define PG8_BAR __builtin_amdgcn_s_barrier()
#define PG8_SCHED __builtin_amdgcn_sched_barrier(0)
    Unit cur, nxt; int ui = 0;
    if (!S.next(0, cur)) return;
    f32x4 acc[2][2][4][2];
#pragma unroll
    for (int a = 0; a < 2; ++a)
#pragma unroll
        for (int b = 0; b < 2; ++b)
#pragma unroll
            for (int m = 0; m < 4; ++m)
#pragma unroll
                for (int n = 0; n < 2; ++n) acc[a][b][m][n] = (f32x4){0.f, 0.f, 0.f, 0.f};
    bf16x8 At[4][2], B0[2][2], B1[2][2];
    const char* cA = (const char*)g.A + (size_t)cur.pm * tstep + (size_t)cur.k0 * kstep; const char* cB = (const char*)g.Bt + (size_t)cur.pn * tstep + (size_t)cur.k0 * kstep;
    S.a_ready(cur);
    if constexpr (SP2) {
        PG8_STAGE(PG8_SB(0, 0), cB, voffB); PG8_STAGE(PG8_SB(0, 1), cB + hstep, voffB); PG8_STAGE(PG8_SA(0, 0), cA, voffA); PG8_STAGE(PG8_SA(0, 1), cA + hstep, voffA);
        if (wr == 1) PG8_BAR;
        PG8_WAIT_V(2); PG8_BAR;
        PG8_STAGE(PG8_SB(1, 0), cB + kstep, voffB); PG8_STAGE(PG8_SA(1, 0), cA + kstep, voffA); PG8_STAGE(PG8_SB(1, 1), cB + hstep + kstep, voffB);
        PG8_WAIT_V(6); PG8_BAR;
    } else {
        PG8_STAGE(PG8_SB(0, 0), cB, voffB); PG8_STAGE(PG8_SA(0, 0), cA, voffA); PG8_STAGE(PG8_SB(0, 1), cB + hstep, voffB); PG8_STAGE(PG8_SA(0, 1), cA + hstep, voffA);
        if (wr == 1) PG8_BAR;
        PG8_WAIT_V(4); PG8_BAR;
        PG8_STAGE(PG8_SB(1, 0), cB + kstep, voffB); PG8_STAGE(PG8_SA(1, 0), cA + kstep, voffA); PG8_STAGE(PG8_SB(1, 1), cB + hstep + kstep, voffB);
        PG8_WAIT_V(6); PG8_BAR;
    }
    for (;;) {
        const bool has_next = S.next(ui + 1, nxt);
        const char* nA = has_next ? (const char*)g.A + (size_t)nxt.pm * tstep + (size_t)nxt.k0 * kstep : cA; const char* nB = has_next ? (const char*)g.Bt + (size_t)nxt.pn * tstep + (size_t)nxt.k0 * kstep : cB;
        const int nt = cur.nk;
        for (int t = 0; t < nt; t += 2) {
            const bool last = (t == nt - 2);
            const char* a1 = cA + (size_t)(t + 1) * kstep;
            const char* a2 = last ? nA : cA + (size_t)(t + 2) * kstep; const char* b2 = last ? nB : cB + (size_t)(t + 2) * kstep;
            const char* a3 = a2 + kstep; const char* b3 = b2 + kstep;
            if (last && has_next) S.a_ready(nxt);
            if constexpr (SP2) {
            PG8_LDB(B0, 0, 0); PG8_LDB(B1, 0, 1); PG8_SCHED; PG8_LDA(At, 0, 0); PG8_STAGE(PG8_SA(1, 1), a1 + hstep, voffA);
            PG8_WAIT_V(8); PG8_WAIT_L(0); PG8_BAR; PG8_MMA(0, 0, At, B0); PG8_MMA(0, 1, At, B1); PG8_BAR; PG8_SCHED;
            PG8_LDA(At, 0, 1); PG8_STAGE(PG8_SB(0, 0), b2, voffB); PG8_STAGE(PG8_SB(0, 1), b2 + hstep, voffB); PG8_STAGE(PG8_SA(0, 0), a2, voffA);
            PG8_WAIT_V(8); PG8_WAIT_L(0); PG8_BAR; PG8_MMA(1, 0, At, B0); PG8_MMA(1, 1, At, B1); PG8_BAR; PG8_SCHED;
            PG8_LDB(B0, 1, 0); PG8_LDB(B1, 1, 1); PG8_SCHED; PG8_LDA(At, 1, 0); PG8_STAGE(PG8_SA(0, 1), a2 + hstep, voffA);
            PG8_WAIT_V(8); PG8_WAIT_L(0); PG8_BAR; PG8_MMA(0, 0, At, B0); PG8_MMA(0, 1, At, B1); PG8_BAR; PG8_SCHED;
            PG8_LDA(At, 1, 1); PG8_STAGE(PG8_SB(1, 0), b3, voffB); PG8_STAGE(PG8_SB(1, 1), b3 + hstep, voffB); PG8_STAGE(PG8_SA(1, 0), a3, voffA);
            PG8_WAIT_V(8); PG8_WAIT_L(0); PG8_BAR; PG8_MMA(1, 0, At, B0); PG8_MMA(1, 1, At, B1); PG8_BAR; PG8_SCHED;
            } else {
            PG8_LDB(B0, 0, 0); PG8_SCHED; PG8_LDA(At, 0, 0); PG8_STAGE(PG8_SA(1, 1), a1 + hstep, voffA);
            PG8_WAIT_L(8); PG8_BAR; PG8_WAIT_L(0); PG8_MMA(0, 0, At, B0); PG8_BAR; PG8_SCHED;
            PG8_LDB(B1, 0, 1); PG8_STAGE(PG8_SB(0, 0), b2, voffB);
            PG8_BAR; PG8_WAIT_L(0); PG8_MMA(0, 1, At, B1); PG8_BAR;
            PG8_LDA(At, 0, 1); PG8_STAGE(PG8_SA(0, 0), a2, voffA);
            PG8_BAR; PG8_WAIT_L(0); PG8_MMA(1, 0, At, B0); PG8_BAR; PG8_SCHED;
            PG8_STAGE(PG8_SB(0, 1), b2 + hstep, voffB);
            PG8_WAIT_V(6); PG8_BAR; PG8_MMA(1, 1, At, B1); PG8_BAR;
            PG8_LDB(B0, 1, 0); PG8_SCHED; PG8_LDA(At, 1, 0); PG8_STAGE(PG8_SA(0, 1), a2 + hstep, voffA);
            PG8_WAIT_L(8); PG8_BAR; PG8_WAIT_L(0); PG8_MMA(0, 0, At, B0); PG8_BAR; PG8_SCHED;
            PG8_LDB(B1, 1, 1); PG8_STAGE(PG8_SB(1, 0), b3, voffB);
            PG8_BAR; PG8_WAIT_L(0); PG8_MMA(0, 1, At, B1); PG8_BAR;
            PG8_LDA(At, 1, 1); PG8_STAGE(PG8_SA(1, 0), a3, voffA);
            PG8_BAR; PG8_WAIT_L(0); PG8_MMA(1, 0, At, B0); PG8_BAR; PG8_SCHED;
            PG8_STAGE(PG8_SB(1, 1), b3 + hstep, voffB);
            PG8_WAIT_V(6); PG8_BAR; PG8_MMA(1, 1, At, B1); PG8_BAR;
            }
        }
        if constexpr (ALIGN_EPI) { if (wr == 0) PG8_BAR; }
        if constexpr (!Epi::AFTER_DRAIN) { E(acc, cur, wr, wc, fr, fq); S.done(cur); }
        if (!has_next) break;
#pragma unroll
        for (int a = 0; a < 2; ++a)
#pragma unroll
            for (int b = 0; b < 2; ++b)
#pragma unroll
                for (int m = 0; m < 4; ++m)
#pragma unroll
                    for (int n = 0; n < 2; ++n) acc[a][b][m][n] = (f32x4){0.f, 0.f, 0.f, 0.f};
        cur = nxt; cA = nA; cB = nB; ++ui;
        if constexpr (ALIGN_EPI) { if (wr == 1) PG8_BAR; }
    }
    PG8_WAIT_V(0);
    if constexpr (!ALIGN_EPI) { if (wr == 0) PG8_BAR; }
    PG8_BAR;
    if constexpr (Epi::AFTER_DRAIN) { E.fused(acc, cur, wr, wc, fr, fq, lds, wid, lane); S.done(cur); }
#undef PG8_SA
#undef PG8_SB
#undef PG8_STAGE
#undef PG8_LDA
#undef PG8_LDB
#undef PG8_MMA
#undef PG8_WAIT_V
#undef PG8_WAIT_L
#undef PG8_BAR
#undef PG8_SCHED
}
}

constexpr size_t MiB = 1u << 20;
constexpr size_t WS_CTL = 0, CTL_ZERO_BYTES = 262144;
constexpr size_t WS_MOD = 1 * MiB;
constexpr size_t WS_CS = 1 * MiB + 192 * 1024;
constexpr size_t WS_DLOG = 1 * MiB + 256 * 1024;
constexpr size_t WS_WTOUT = 2 * MiB;
constexpr size_t WS_WTIN = 18 * MiB;
constexpr size_t WS_H = 44 * MiB;
constexpr size_t WS_Z = 92 * MiB;
constexpr size_t WS_U = 248 * MiB;
constexpr size_t WS_OL = 264 * MiB;
constexpr size_t WS_CKV = 312 * MiB;
constexpr size_t WS_END = 313 * MiB;
constexpr int LDS_BYTES = 163840;
constexpr int LDS_CTLW = 163840 - 256;
constexpr int NWAVES = 8, NTHREADS = 512;

#define LAS __attribute__((address_space(3)))
typedef unsigned short bf16;
typedef float f32x4 __attribute__((ext_vector_type(4)));
typedef float f32x16 __attribute__((ext_vector_type(16)));
typedef unsigned u32x4 __attribute__((ext_vector_type(4)));
typedef unsigned u32x2 __attribute__((ext_vector_type(2)));
typedef short bf16x8 __attribute__((ext_vector_type(8)));

__device__ __forceinline__ float bf2f(unsigned short u) { return __builtin_bit_cast(float, (unsigned)u << 16); }
__device__ __forceinline__ float bflo(unsigned u) { return __builtin_bit_cast(float, u << 16); }
__device__ __forceinline__ float bfhi(unsigned u) { return __builtin_bit_cast(float, u & 0xffff0000u); }
typedef float f32x2_t_ __attribute__((ext_vector_type(2))); typedef __bf16 bf16x2_t_ __attribute__((ext_vector_type(2)));
__device__ __forceinline__ unsigned pk2(float lo, float hi) { const f32x2_t_ v = {lo, hi}; return __builtin_bit_cast(unsigned, __builtin_convertvector(v, bf16x2_t_)); }
__device__ __forceinline__ unsigned f2bf(float f) { return pk2(f, f) & 0xffffu; }
__device__ __forceinline__ float sigmoidf_(float x) { return __builtin_amdgcn_rcpf(1.0f + __builtin_amdgcn_exp2f(-1.4426950408889634f * x)); }
__device__ __forceinline__ float siluf_(float x) { return x * __builtin_amdgcn_rcpf(1.0f + __builtin_amdgcn_exp2f(-1.4426950408889634f * x)); }
__device__ __forceinline__ float dpp_add_(float v, const int ctrl_sel) {
    const int x = __builtin_bit_cast(int, v); int y;
    if (ctrl_sel == 0) y = __builtin_amdgcn_update_dpp(0, x, 0xB1, 0xf, 0xf, true);
    else if (ctrl_sel == 1) y = __builtin_amdgcn_update_dpp(0, x, 0x4E, 0xf, 0xf, true);
    else if (ctrl_sel == 2) y = __builtin_amdgcn_update_dpp(0, x, 0x141, 0xf, 0xf, true);
    else y = __builtin_amdgcn_update_dpp(0, x, 0x140, 0xf, 0xf, true);
    return v + __builtin_bit_cast(float, y);
}
__device__ __forceinline__ float wave_sum(float v) {
    v = dpp_add_(v, 0); v = dpp_add_(v, 1); v = dpp_add_(v, 2); v = dpp_add_(v, 3);
    const float r0 = __builtin_bit_cast(float, __builtin_amdgcn_readlane(__builtin_bit_cast(int, v), 0)), r1 = __builtin_bit_cast(float, __builtin_amdgcn_readlane(__builtin_bit_cast(int, v), 16));
    const float r2 = __builtin_bit_cast(float, __builtin_amdgcn_readlane(__builtin_bit_cast(int, v), 32)), r3 = __builtin_bit_cast(float, __builtin_amdgcn_readlane(__builtin_bit_cast(int, v), 48));
    return (r0 + r1) + (r2 + r3);
}

struct Params {
    const float* in[20];
    float* out; unsigned char* ws;
};
typedef const __attribute__((address_space(4))) Params* PP;

__device__ __forceinline__ int next_unit(unsigned* ctr, volatile LAS unsigned* slot, int tid) {
    __syncthreads();
    if (tid == 0) *slot = __hip_atomic_fetch_add(ctr, 1u, __ATOMIC_RELAXED, __HIP_MEMORY_SCOPE_AGENT);
    __syncthreads();
    return (int)*slot;
}
__device__ __forceinline__ int q_pop(unsigned* ctr, volatile LAS unsigned* slot, int tid, int& pend, int pf_from) {
    __syncthreads();
    if (tid == 0) { const int cur = (pend >= 0) ? pend : (int)__hip_atomic_fetch_add(ctr, 1u, __ATOMIC_RELAXED, __HIP_MEMORY_SCOPE_AGENT);
        *slot = (unsigned)cur; pend = (cur >= pf_from) ? (int)__hip_atomic_fetch_add(ctr, 1u, __ATOMIC_RELAXED, __HIP_MEMORY_SCOPE_AGENT) : -1; }
    __syncthreads();
    return (int)*slot;
}
__device__ __forceinline__ void transpose_item(const float* W, int K, int N, bf16* WT, LAS float* scr, int item, int lane) {
    const int nblk = N / 32, kb = item / nblk, nb = item % nblk, k0 = 64 * kb, n0 = 32 * nb;
    float wv[32];
    const float* wp = W + (size_t)(k0 + (lane >> 5)) * N + n0 + (lane & 31);
#pragma unroll
    for (int i = 0; i < 32; ++i) wv[i] = wp[(size_t)(2 * i) * N];
    __builtin_amdgcn_sched_barrier(0);
#pragma unroll
    for (int i = 0; i < 32; ++i) { const int kk = 2 * i + (lane >> 5); scr[kk * 33 + (lane & 31)] = wv[i]; }
    asm volatile("s_waitcnt lgkmcnt(0)" ::: "memory");
    const int c = lane & 7;
#pragma unroll
    for (int j = 0; j < 4; ++j) { const int n = (lane >> 3) + 8 * j; const LAS float* s = scr + (8 * c) * 33 + n;
        u32x4 o; o.x = pk2(s[0 * 33], s[1 * 33]); o.y = pk2(s[2 * 33], s[3 * 33]); o.z = pk2(s[4 * 33], s[5 * 33]); o.w = pk2(s[6 * 33], s[7 * 33]);
        *(u32x4*)(WT + (size_t)(n0 + n) * K + k0 + 8 * c) = o; }
    asm volatile("s_waitcnt lgkmcnt(0)" ::: "memory");
}

__device__ __forceinline__ void mod_unit(PP P, LAS float* lds, int l, int nc, int tid) {
    const float* c = P->in[5]; const float* cctx = P->in[6]; const float* aw = P->in[7] + (size_t)l * 2048 * 6144; const float* ab = P->in[8] + l * 6144;
    LAS float* sc = lds;
    LAS float* red = lds + 3 * 2048;
    for (int i = tid; i < 3 * 2048; i += NTHREADS) { const int j = i >> 11, k = i & 2047; const float v = (j == 0) ? cctx[k] : c[(j - 1) * 2048 + k]; sc[i] = siluf_(v); }
    __syncthreads();
    const int tn = tid & 7, tk = tid >> 3, n0 = nc * 32 + 4 * tn;
    float a[3][4] = {};
    for (int k8 = 0; k8 < 32; k8 += 16) {
        f32x4 w[16];
#pragma unroll
        for (int kk = 0; kk < 16; ++kk) w[kk] = *(const f32x4*)(aw + (size_t)(tk * 32 + k8 + kk) * 6144 + n0);
        __builtin_amdgcn_sched_barrier(0);
#pragma unroll
        for (int kk = 0; kk < 16; ++kk) { const int k = tk * 32 + k8 + kk;
#pragma unroll
            for (int j = 0; j < 3; ++j) { const float s = sc[j * 2048 + k]; a[j][0] += s * w[kk][0]; a[j][1] += s * w[kk][1]; a[j][2] += s * w[kk][2]; a[j][3] += s * w[kk][3]; } }
    }
#pragma unroll
    for (int j = 0; j < 3; ++j)
#pragma unroll
        for (int e = 0; e < 4; ++e) red[(tk * 8 + tn) * 12 + j * 4 + e] = a[j][e];
    __syncthreads();
    if (tid < 96) { const int tn2 = tid / 12, je = tid % 12; float s = 0.f; for (int t = 0; t < 64; ++t) s += red[(t * 8 + tn2) * 12 + je];
        const int j = je >> 2, e = je & 3, n = nc * 32 + 4 * tn2 + e;
        ((float*)(P->ws + WS_MOD))[(l * 3 + j) * 6144 + n] = s + ab[n]; }
    __syncthreads();
}

__device__ __forceinline__ void hprep_row(const float* xrow, const float* mod  , bf16* hrow, int lane) {
#pragma unroll
    for (int j = 0; j < 8; ++j) { const int c = 4 * lane + 256 * j; const f32x4 x = *(const f32x4*)(xrow + c), sh = *(const f32x4*)(mod + c), sc = *(const f32x4*)(mod + 2048 + c);
        const f32x4 h = x * (sc + 1.0f) + sh; u32x2 o; o.x = pk2(h[0], h[1]); o.y = pk2(h[2], h[3]); *(u32x2*)(hrow + c) = o; }
}
template <bool WITH_H>
__device__ __forceinline__ void ln_row_t(float* vrow, const float* w, const float* b, const float* modn, bf16* hrow, int lane_in) {
    int lane = lane_in; asm volatile("" : "+v"(lane));
    f32x4 v[8], pw[8], pb[8]; float s = 0.f;
#pragma unroll
    for (int j = 0; j < 8; ++j) v[j] = *(const f32x4*)(vrow + 4 * lane + 256 * j);
#pragma unroll
    for (int j = 0; j < 8; ++j) { pw[j] = *(const f32x4*)(w + 4 * lane + 256 * j); pb[j] = *(const f32x4*)(b + 4 * lane + 256 * j); }
#pragma unroll
    for (int j = 0; j < 8; ++j) s += (v[j][0] + v[j][1]) + (v[j][2] + v[j][3]);
    const float mean = wave_sum(s) * (1.0f / 2048.0f); float q = 0.f;
#pragma unroll
    for (int j = 0; j < 8; ++j) { v[j] = v[j] - mean; q += (v[j][0] * v[j][0] + v[j][1] * v[j][1]) + (v[j][2] * v[j][2] + v[j][3] * v[j][3]); }
    const float rstd = __builtin_amdgcn_rsqf(wave_sum(q) * (1.0f / 2048.0f) + 1e-5f);
#pragma unroll
    for (int j = 0; j < 8; ++j) { v[j] = v[j] * rstd * pw[j] + pb[j]; *(f32x4*)(vrow + 4 * lane + 256 * j) = v[j]; }
    if (WITH_H) {
#pragma unroll
        for (int j = 0; j < 8; ++j) { pw[j] = *(const f32x4*)(modn + 4 * lane + 256 * j); pb[j] = *(const f32x4*)(modn + 2048 + 4 * lane + 256 * j); }
#pragma unroll
        for (int j = 0; j < 8; ++j) { const f32x4 h = v[j] * (pb[j] + 1.0f) + pw[j]; u32x2 o; o.x = pk2(h[0], h[1]); o.y = pk2(h[2], h[3]); *(u32x2*)(hrow + 4 * lane + 256 * j) = o; }
    }
}
__device__ __forceinline__ void ln_row(float* vrow, const float* w, const float* b, const float* modn, bf16* hrow, int lane) {
    if (hrow) ln_row_t<true>(vrow, w, b, modn, hrow, lane); else ln_row_t<false>(vrow, w, b, modn, hrow, lane);
}

typedef float f32x2 __attribute__((ext_vector_type(2)));
__device__ __forceinline__ void conv_unit(PP P, LAS float* lds, int l, int unit, int tid) {
    const int lane = tid & 63, wave = tid >> 6;
    const bf16* Z = (const bf16*)(P->ws + WS_Z); bf16* MIX = (bf16*)(P->ws + WS_H);
    const int t0 = unit * 32;
    int s0, s1; if (t0 < NCTX) { s0 = t0 & ~255; s1 = s0 + 256; } else { s0 = NCTX + ((t0 - NCTX) & ~2047); s1 = s0 + 2048; }
    const int c2 = 2 * (tid & 255), tb = t0 + 16 * (tid >> 8);
    u32x4 gq[4];
#pragma unroll
    for (int k = 0; k < 4; ++k) gq[k] = *(const u32x4*)(Z + (size_t)(t0 + 4 * wave + k) * DIN + C_CG + 8 * lane);
    const float* lw = P->in[16] + l * 512 + 8 * lane; const float* lb = P->in[17] + l * 512 + 8 * lane;
    const f32x4 w0 = *(const f32x4*)lw, w1 = *(const f32x4*)(lw + 4), b0 = *(const f32x4*)lb, b1 = *(const f32x4*)(lb + 4);
    f32x2 u[46];
#pragma unroll
    for (int hb = 0; hb < 2; ++hb) {
        unsigned ra[23], rb[23];
#pragma unroll
        for (int r = 0; r < 23; ++r) { const int row = tb - 15 + 23 * hb + r; const int rc = row < s0 ? s0 : (row >= s1 ? s1 - 1 : row);
            ra[r] = *(const unsigned*)(Z + (size_t)rc * DIN + C_CA + c2); rb[r] = *(const unsigned*)(Z + (size_t)rc * DIN + C_CB + c2); }
        __builtin_amdgcn_sched_barrier(0);
#pragma unroll
        for (int r = 0; r < 23; ++r) { const int row = tb - 15 + 23 * hb + r; const bool ok = (row >= s0 && row < s1);
            const f32x2 a = {bflo(ra[r]), bfhi(ra[r])}; const f32x2 g = {sigmoidf_(bflo(rb[r])), sigmoidf_(bfhi(rb[r]))};
            const f32x2 v = a * g; u[23 * hb + r] = ok ? v : (f32x2){0.f, 0.f}; }
    }
    f32x2 acc[16]; const f32x2 bias = *(const f32x2*)(P->in[15] + l * 512 + c2);
#pragma unroll
    for (int i = 0; i < 16; ++i) acc[i] = bias;
    const float* cw = P->in[14] + (size_t)l * 31 * 512 + c2;
#pragma unroll
    for (int j = 0; j < 31; ++j) { const f32x2 w = *(const f32x2*)(cw + j * 512);
#pragma unroll
        for (int i = 0; i < 16; ++i) acc[i] += u[i + j] * w; }
    LAS float* yb = lds;
#pragma unroll
    for (int i = 0; i < 16; ++i) *(LAS f32x2*)(yb + (16 * (tid >> 8) + i) * 512 + c2) = acc[i];
    __syncthreads();
#pragma unroll
    for (int k = 0; k < 4; ++k) { const int ti = wave * 4 + k, row = t0 + ti;
        f32x4 a = *(const LAS f32x4*)(yb + ti * 512 + 8 * lane), b = *(const LAS f32x4*)(yb + ti * 512 + 8 * lane + 4);
        float s = (a[0] + a[1]) + (a[2] + a[3]) + (b[0] + b[1]) + (b[2] + b[3]);
        const float mean = wave_sum(s) * (1.0f / 512.0f); a = a - mean; b = b - mean;
        float q = (a[0] * a[0] + a[1] * a[1]) + (a[2] * a[2] + a[3] * a[3]) + (b[0] * b[0] + b[1] * b[1]) + (b[2] * b[2] + b[3] * b[3]);
        const float rstd = __builtin_amdgcn_rsqf(wave_sum(q) * (1.0f / 512.0f) + 1e-5f);
        a = a * rstd * w0 + b0; b = b * rstd * w1 + b1;
        const u32x4 g = gq[k];
        float o[8];
        o[0] = siluf_(a[0]) * siluf_(bflo(g.x)); o[1] = siluf_(a[1]) * siluf_(bfhi(g.x)); o[2] = siluf_(a[2]) * siluf_(bflo(g.y)); o[3] = siluf_(a[3]) * siluf_(bfhi(g.y));
        o[4] = siluf_(b[0]) * siluf_(bflo(g.z)); o[5] = siluf_(b[1]) * siluf_(bfhi(g.z)); o[6] = siluf_(b[2]) * siluf_(bflo(g.w)); o[7] = siluf_(b[3]) * siluf_(bfhi(g.w));
        u32x4 w; w.x = pk2(o[0], o[1]); w.y = pk2(o[2], o[3]); w.z = pk2(o[4], o[5]); w.w = pk2(o[6], o[7]);
        *(u32x4*)(MIX + (size_t)row * D_MODEL + 1536 + 8 * lane) = w; }
}

typedef short v4i16_t __attribute__((ext_vector_type(4)));
#define SBAR __builtin_amdgcn_sched_barrier(0);
#define R0(i) (((i) & 3) + 8 * ((i) >> 2))
constexpr float ATT_C2 = 0.08838834764831845f * 1.4426950408889634f;
constexpr float LOG2E = 1.4426950408889634f;
constexpr int KROW = 272, VROW = 320, ATT_V_OFF = 64 * KROW;

__device__ __forceinline__ bf16x8 trpair(const LAS unsigned char* p, int second_off) {
    const v4i16_t lo = __builtin_amdgcn_ds_read_tr16_b64_v4i16((LAS v4i16_t*)p), hi = __builtin_amdgcn_ds_read_tr16_b64_v4i16((LAS v4i16_t*)(p + second_off));
    return (bf16x8){lo[0], lo[1], lo[2], lo[3], hi[0], hi[1], hi[2], hi[3]};
}
__device__ __forceinline__ bf16x8 pack8(float a, float b, float c, float d, float e, float f, float g, float h) {
    const u32x4 w = {pk2(a, b), pk2(c, d), pk2(e, f), pk2(g, h)}; return __builtin_bit_cast(bf16x8, w);
}
__device__ __forceinline__ void rope8(bf16x8& a, bf16x8& b, const float* cs) {
    float ra[8], rb[8];
#pragma unroll
    for (int j = 0; j < 8; ++j) { const float x1 = bf2f((unsigned short)a[j]), x2 = bf2f((unsigned short)b[j]), c = cs[2 * j], s = cs[2 * j + 1]; ra[j] = x1 * c - x2 * s; rb[j] = x2 * c + x1 * s; }
    a = pack8(ra[0], ra[1], ra[2], ra[3], ra[4], ra[5], ra[6], ra[7]); b = pack8(rb[0], rb[1], rb[2], rb[3], rb[4], rb[5], rb[6], rb[7]);
}
__device__ __forceinline__ void rope8l(bf16x8& a, bf16x8& b, const LAS float* cs) {
    const f32x4 c0 = *(const LAS f32x4*)cs, c1 = *(const LAS f32x4*)(cs + 4), c2 = *(const LAS f32x4*)(cs + 8), c3 = *(const LAS f32x4*)(cs + 12);
    const float cc[8] = {c0[0], c0[2], c1[0], c1[2], c2[0], c2[2], c3[0], c3[2]}, sn[8] = {c0[1], c0[3], c1[1], c1[3], c2[1], c2[3], c3[1], c3[3]};
    float ra[8], rb[8];
#pragma unroll
    for (int j = 0; j < 8; ++j) { const float x1 = bf2f((unsigned short)a[j]), x2 = bf2f((unsigned short)b[j]); ra[j] = x1 * cc[j] - x2 * sn[j]; rb[j] = x2 * cc[j] + x1 * sn[j]; }
    a = pack8(ra[0], ra[1], ra[2], ra[3], ra[4], ra[5], ra[6], ra[7]); b = pack8(rb[0], rb[1], rb[2], rb[3], rb[4], rb[5], rb[6], rb[7]);
}
__device__ __forceinline__ bf16x8 cvt8(const float* p) {
    const f32x4 a = *(const f32x4*)p, b = *(const f32x4*)(p + 4);
    return pack8(a[0], a[1], a[2], a[3], b[0], b[1], b[2], b[3]);
}

typedef _Float16 f16x8_t_ __attribute__((ext_vector_type(8)));
__device__ __forceinline__ void rope8h(u32x4& a, u32x4& b, const LAS unsigned char* cs) {
    const f16x8_t_ t0 = *(const LAS f16x8_t_*)cs, t1 = *(const LAS f16x8_t_*)(cs + 16);
    float ra[8], rb[8];
#pragma unroll
    for (int j = 0; j < 8; ++j) { const unsigned wa = a[j >> 1], wb = b[j >> 1]; const float x1 = (j & 1) ? bfhi(wa) : bflo(wa), x2 = (j & 1) ? bfhi(wb) : bflo(wb);
        const float c = (float)((j < 4) ? t0[2 * j] : t1[2 * (j - 4)]), sn = (float)((j < 4) ? t0[2 * j + 1] : t1[2 * (j - 4) + 1]);
        ra[j] = x1 * c - x2 * sn; rb[j] = x2 * c + x1 * sn; }
    a = (u32x4){pk2(ra[0], ra[1]), pk2(ra[2], ra[3]), pk2(ra[4], ra[5]), pk2(ra[6], ra[7])}; b = (u32x4){pk2(rb[0], rb[1]), pk2(rb[2], rb[3]), pk2(rb[4], rb[5]), pk2(rb[6], rb[7])};
}
constexpr int AT_BUF = 75776, AT_V = 34816, AT_ROPE = 151552;
__device__ __forceinline__ void attn_tile(const LAS unsigned char* kt, const LAS unsigned char* vt, const bf16x8 (&qf)[8], f32x16 (&O)[4], float& m, float& lsum,
                                          bool local, int tk0, int qpos, int lane) {
    const int r32 = lane & 31, hh = lane >> 5, i16 = lane & 15;
    f32x16 p0, p1;
#pragma unroll
    for (int i = 0; i < 16; ++i) { p0[i] = 0.f; p1[i] = 0.f; }
    const LAS unsigned char* kb = kt + r32 * KROW + 16 * hh;
#pragma unroll
    for (int s = 0; s < 8; ++s) { const bf16x8 kf0 = *(const LAS bf16x8*)(kb + 32 * s), kf1 = *(const LAS bf16x8*)(kb + 32 * KROW + 32 * s);
        p0 = __builtin_amdgcn_mfma_f32_32x32x16_bf16(kf0, qf[s], p0, 0, 0, 0); p1 = __builtin_amdgcn_mfma_f32_32x32x16_bf16(kf1, qf[s], p1, 0, 0, 0); }
    const LAS unsigned char* vb = vt + (4 * hh + (i16 >> 2)) * VROW + (16 * ((lane >> 4) & 1) + 4 * (i16 & 3)) * 2;
    bf16x8 vfa[4], vfb[4];
#pragma unroll
    for (int ks = 0; ks < 4; ++ks) vfa[ks] = trpair(vb + (16 * ks) * VROW, 8 * VROW);
    float mx = -3e38f;
    if (local) { const unsigned mb = (unsigned)(qpos - tk0 - 4 * hh + 128);
#pragma unroll
        for (int i = 0; i < 16; ++i) { const unsigned d0 = mb - (unsigned)R0(i), d1 = d0 - 32u;
            p0[i] = (d0 <= 256u) ? p0[i] : -1e30f; p1[i] = (d1 <= 256u) ? p1[i] : -1e30f; } }
#pragma unroll
    for (int i = 0; i < 16; ++i) mx = fmaxf(mx, fmaxf(p0[i], p1[i]));
    mx = fmaxf(mx, __shfl_xor(mx, 32)) * ATT_C2;
    const float mn = fmaxf(m, mx), alpha = __builtin_amdgcn_exp2f(m - mn); m = mn;
    float ps = 0.f;
#pragma unroll
    for (int i = 0; i < 16; ++i) { p0[i] = __builtin_amdgcn_exp2f(__builtin_fmaf(p0[i], ATT_C2, -mn)); p1[i] = __builtin_amdgcn_exp2f(__builtin_fmaf(p1[i], ATT_C2, -mn)); ps += p0[i] + p1[i]; }
    lsum = lsum * alpha + ps;
    if (__builtin_amdgcn_ballot_w64(alpha != 1.0f) != 0ull) {
#pragma unroll
        for (int d = 0; d < 4; ++d)
#pragma unroll
            for (int i = 0; i < 16; ++i) O[d][i] *= alpha;
    }
    bf16x8 pb[4];
#pragma unroll
    for (int s = 0; s < 2; ++s) { pb[s] = pack8(p0[8 * s], p0[8 * s + 1], p0[8 * s + 2], p0[8 * s + 3], p0[8 * s + 4], p0[8 * s + 5], p0[8 * s + 6], p0[8 * s + 7]);
        pb[2 + s] = pack8(p1[8 * s], p1[8 * s + 1], p1[8 * s + 2], p1[8 * s + 3], p1[8 * s + 4], p1[8 * s + 5], p1[8 * s + 6], p1[8 * s + 7]); }
#pragma unroll
    for (int dt = 0; dt < 4; ++dt) {
        if (dt + 1 < 4) {
#pragma unroll
            for (int ks = 0; ks < 4; ++ks) { const bf16x8 t_ = trpair(vb + (16 * ks) * VROW + 64 * (dt + 1), 8 * VROW); if (dt & 1) vfa[ks] = t_; else vfb[ks] = t_; }
        }
#pragma unroll
        for (int ks = 0; ks < 4; ++ks) O[dt] = __builtin_amdgcn_mfma_f32_32x32x16_bf16((dt & 1) ? vfb[ks] : vfa[ks], pb[ks], O[dt], 0, 0, 0);
    }
}
__device__ __forceinline__ void attn_unit(PP P, LAS unsigned char* lds, int l, int kind, int idx, int tid) {
    const int lane = tid & 63, wave = __builtin_amdgcn_readfirstlane(tid >> 6), r32 = lane & 31, hh = lane >> 5;
    const bf16* Z = (const bf16*)(P->ws + WS_Z); bf16* MIX = (bf16*)(P->ws + WS_H); const float* CS = (const float*)(P->ws + WS_CS); const bf16* CKV = (const bf16*)(P->ws + WS_CKV);
    int b, h, qpos0, grow0, kpos0, klrow0, nls, ncs;
    if (kind == 0) { b = idx >> 3; h = idx & 7; qpos0 = 0; grow0 = b * 256; kpos0 = 0; klrow0 = b * 256; nls = 2; ncs = 0; }
    else { const int qb = idx & 7; h = (idx >> 3) & 7; b = idx >> 6; qpos0 = qb * 256; grow0 = NCTX + b * 2048 + qpos0;
        kpos0 = qpos0 - 128 < 0 ? 0 : qpos0 - 128; const int kend = qpos0 + 384 > 2048 ? 2048 : qpos0 + 384; nls = (kend - kpos0) >> 7; klrow0 = NCTX + b * 2048 + kpos0; ncs = 2; }
    const bool lat = (kind == 1);
    const int kv = h >> 2;
    if (lat) {
#pragma unroll
        for (int k = 0; k < 4; ++k) { const int e = tid + 512 * k; const float c = CS[2 * e], sn = CS[2 * e + 1];
            typedef _Float16 h2_ __attribute__((ext_vector_type(2))); const h2_ hv = {(_Float16)c, (_Float16)sn}; *(LAS unsigned*)(lds + AT_ROPE + 4 * e) = __builtin_bit_cast(unsigned, hv); }
    }
    const int qrow = grow0 + 32 * wave + r32, qpos = qpos0 + 32 * wave + r32, qw0 = qpos0 + 32 * wave;
    bf16x8 qf[8];
    { const bf16* qp = Z + (size_t)qrow * DIN + C_AQ + h * 128 + 8 * hh;
#pragma unroll
      for (int s = 0; s < 8; ++s) qf[s] = *(const bf16x8*)(qp + 16 * s);
      if (lat) { const float* c0 = CS + ((qpos >> 6) * 32 + 8 * hh) * 2; const float* c1 = CS + ((qpos & 63) * 32 + 8 * hh) * 2;
          rope8(qf[0], qf[2], c0); rope8(qf[1], qf[3], c0 + 32); rope8(qf[4], qf[6], c1); rope8(qf[5], qf[7], c1 + 32); } }
    f32x16 O[4];
#pragma unroll
    for (int d = 0; d < 4; ++d)
#pragma unroll
        for (int i = 0; i < 16; ++i) O[d][i] = 0.f;
    float m = P->in[11][l * 8 + h] * LOG2E, lsum = (hh == 0) ? 1.0f : 0.0f;
    const int skey = tid >> 2, sub = tid & 3;
    const int nst = nls + ncs;
    u32x4 rr[8];
#define ATT_ISSUE(ST) do { const int st_ = (ST); const bf16* kp_; const bf16* vp_; \
        if (st_ < nls) { const int krow = klrow0 + 128 * st_ + skey; kp_ = Z + (size_t)krow * DIN + C_AK + kv * 128 + 8 * sub; vp_ = kp_ + (C_AV - C_AK); } \
        else { const int key = 128 * (st_ - nls) + skey; kp_ = CKV + ((size_t)((b * 2 + l) * 256 + key) * 2 + kv) * 128 + 8 * sub; vp_ = kp_ + 262144; } \
        rr[0] = *(const u32x4*)kp_; rr[1] = *(const u32x4*)(kp_ + 32); rr[2] = *(const u32x4*)(kp_ + 64); rr[3] = *(const u32x4*)(kp_ + 96); \
        rr[4] = *(const u32x4*)vp_; rr[5] = *(const u32x4*)(vp_ + 32); rr[6] = *(const u32x4*)(vp_ + 64); rr[7] = *(const u32x4*)(vp_ + 96); } while (0)
#define ATT_WRITE(ST) do { const int st_ = (ST); \
        if (lat && st_ < nls) { const int kpos = kpos0 + 128 * st_ + skey; \
            rope8h(rr[0], rr[1], lds + AT_ROPE + ((kpos >> 6) * 32 + 8 * sub) * 4); rope8h(rr[2], rr[3], lds + AT_ROPE + ((kpos & 63) * 32 + 8 * sub) * 4); } \
        LAS unsigned char* kd_ = lds + (st_ & 1) * AT_BUF + skey * KROW + 16 * sub; LAS unsigned char* vd_ = lds + (st_ & 1) * AT_BUF + AT_V + skey * VROW + 16 * sub; \
        *(LAS u32x4*)kd_ = rr[0]; *(LAS u32x4*)(kd_ + 64) = rr[1]; *(LAS u32x4*)(kd_ + 128) = rr[2]; *(LAS u32x4*)(kd_ + 192) = rr[3]; \
        *(LAS u32x4*)vd_ = rr[4]; *(LAS u32x4*)(vd_ + 64) = rr[5]; *(LAS u32x4*)(vd_ + 128) = rr[6]; *(LAS u32x4*)(vd_ + 192) = rr[7]; } while (0)
    if (lat) { ATT_ISSUE(0); __syncthreads();
        ATT_WRITE(0); }
    else {
        u32x4 r2[8];
        { const bf16* kp_ = Z + (size_t)(klrow0 + skey) * DIN + C_AK + kv * 128 + 8 * sub; const bf16* vp_ = kp_ + (C_AV - C_AK); const bf16* kq_ = kp_ + (size_t)128 * DIN; const bf16* vq_ = vp_ + (size_t)128 * DIN;
          rr[0] = *(const u32x4*)kp_; rr[1] = *(const u32x4*)(kp_ + 32); rr[2] = *(const u32x4*)(kp_ + 64); rr[3] = *(const u32x4*)(kp_ + 96);
          rr[4] = *(const u32x4*)vp_; rr[5] = *(const u32x4*)(vp_ + 32); rr[6] = *(const u32x4*)(vp_ + 64); rr[7] = *(const u32x4*)(vp_ + 96);
          r2[0] = *(const u32x4*)kq_; r2[1] = *(const u32x4*)(kq_ + 32); r2[2] = *(const u32x4*)(kq_ + 64); r2[3] = *(const u32x4*)(kq_ + 96);
          r2[4] = *(const u32x4*)vq_; r2[5] = *(const u32x4*)(vq_ + 32); r2[6] = *(const u32x4*)(vq_ + 64); r2[7] = *(const u32x4*)(vq_ + 96); }
        ATT_WRITE(0);
#pragma unroll
        for (int e = 0; e < 8; ++e) rr[e] = r2[e];
        ATT_WRITE(1);
    }
    __syncthreads();
    for (int st = 0; st < nst; ++st) {
        const bool more = lat && (st + 1 < nst);
        if (more) ATT_ISSUE(st + 1);
        const bool local = lat && (st < nls);
        const LAS unsigned char* kt = lds + (st & 1) * AT_BUF; const LAS unsigned char* vt = kt + AT_V;
#pragma unroll
        for (int t2 = 0; t2 < 2; ++t2) {
            const int tk0 = kpos0 + 128 * st + 64 * t2;
            bool skip = false;
            if (local) skip = (tk0 > qw0 + 31 + 128) || (tk0 + 63 < qw0 - 128);
            if (!skip) attn_tile(kt + t2 * 64 * KROW, vt + t2 * 64 * VROW, qf, O, m, lsum, local, tk0, qpos, lane);
        }
        if (more) ATT_WRITE(st + 1);
        if (lat) __syncthreads();
    }
    const float ltot = lsum + __shfl_xor(lsum, 32), inv = __builtin_amdgcn_rcpf(ltot);
    const bf16* gp = Z + (size_t)qrow * DIN + C_AG + h * 128 + 4 * hh; bf16* op = MIX + (size_t)qrow * D_MODEL + h * 128 + 4 * hh;
    u32x2 gg[16];
#pragma unroll
    for (int e = 0; e < 16; ++e) gg[e] = *(const u32x2*)(gp + 32 * (e >> 2) + 8 * (e & 3));
    __builtin_amdgcn_sched_barrier(0);
#pragma unroll
    for (int dt = 0; dt < 4; ++dt)
#pragma unroll
        for (int i4 = 0; i4 < 4; ++i4) { const int d0 = 32 * dt + 8 * i4; const u32x2 g = gg[dt * 4 + i4];
            const float o0 = O[dt][4 * i4 + 0] * inv * siluf_(bflo(g.x)), o1 = O[dt][4 * i4 + 1] * inv * siluf_(bfhi(g.x));
            const float o2 = O[dt][4 * i4 + 2] * inv * siluf_(bflo(g.y)), o3 = O[dt][4 * i4 + 3] * inv * siluf_(bfhi(g.y));
            u32x2 w; w.x = pk2(o0, o1); w.y = pk2(o2, o3); *(u32x2*)(op + d0) = w; }
#undef ATT_ISSUE
#undef ATT_WRITE
}

__device__ __forceinline__ void hg_oml8(PP P, int l, int dir, int hd0, float (&oml)[8]) {
    const float* hb = P->in[12] + dir * 1024 + hd0;
    const f32x4 a0 = *(const f32x4*)hb, a1 = *(const f32x4*)(hb + 4), b0 = *(const f32x4*)(hb + 512), b1 = *(const f32x4*)(hb + 516);
#pragma unroll
    for (int j = 0; j < 4; ++j) { const float s0 = sigmoidf_(b0[j] - a0[j]), s1 = sigmoidf_(b1[j] - a1[j]); oml[j] = l ? 1.0f - s0 : 1.0f; oml[4 + j] = l ? 1.0f - s1 : 1.0f; }
}
constexpr int H2_TG = 0, H2_QE = 16896, H2_KE = 25600, H2_QG = 34304, H2_KG = 42752, H2_V = 52992, H2_OBA = 63232, H2_OBB = 80128, H2_DK = 97024;
constexpr size_t WS_DLC_OFF = 0;
#ifndef PROBE_SEC
#define PROBE_SEC -1
#endif
#if PROBE_SEC >= 0
#define PSEC_DECL unsigned long long ps_acc_ = 0ull, ps_t_ = 0ull;
#define PSEC_START(n) if (PROBE_SEC == n) ps_t_ = __builtin_amdgcn_s_memrealtime();
#define PSEC_END(n) if (PROBE_SEC == n) ps_acc_ += __builtin_amdgcn_s_memrealtime() - ps_t_;
#define PSEC_CLOSE(n) if (PROBE_SEC == n) { __syncthreads(); ps_acc_ += __builtin_amdgcn_s_memrealtime() - ps_t_; }
#define PSEC_FLUSH(cnt) if (kind == 0 && tid == 0) { atomicAdd((unsigned long long*)((unsigned*)(P->ws + WS_CTL) + 60000), ps_acc_); atomicAdd((unsigned*)(P->ws + WS_CTL) + 60002, (unsigned)(cnt)); }
#else
#define PSEC_DECL
#define PSEC_START(n)
#define PSEC_END(n)
#define PSEC_CLOSE(n)
#define PSEC_FLUSH(cnt)
#endif
__device__ __forceinline__ void hgrn2_unit(PP P, LAS unsigned char* lds, int l, int kind, int idx, int tid) {
    const int lane = tid & 63, wave = __builtin_amdgcn_readfirstlane(tid >> 6), r32 = lane & 31, hh = lane >> 5, i16 = lane & 15, cg = (lane >> 4) & 1;
    const bf16* Z = (const bf16*)(P->ws + WS_Z); bf16* MIX = (bf16*)(P->ws + WS_H); float* OL = (float*)(P->ws + WS_OL);
    LAS float* ldsf = (LAS float*)lds;
    int h, row0, seglen, nch, b = 0;
    if (kind == 0) { b = idx >> 2; h = idx & 3; row0 = b * 256; seglen = 256; nch = 8; }
    else { const int blk = idx & 15; h = (idx >> 4) & 3; const int lb = idx >> 6; row0 = NCTX + lb * 2048 + blk * 128; seglen = 128; nch = 4; }
    const int ti = tid >> 4, d0 = 8 * (tid & 15), nt = wave & 3, kp = wave >> 2;
    PSEC_DECL
    const f32x4 n0 = *(const f32x4*)(P->in[13] + l * 512 + h * 128 + d0), n1 = *(const f32x4*)(P->in[13] + l * 512 + h * 128 + d0 + 4);
    for (int dir = 0; dir < 2; ++dir) {
        float oml[8]; hg_oml8(P, l, dir, h * 128 + d0, oml);
        const int cf = dir ? C_HFB : C_HFF;
        f32x16 S0, S1;
#pragma unroll
        for (int i = 0; i < 16; ++i) { S0[i] = 0.f; S1[i] = 0.f; }
        const int uidx = (kind == 1) ? ((idx >> 4) * 2 + dir) * 16 + (idx & 15) : 0;
        float gtot = 0.f;
        u32x4 uq, uv, uf;
        { const int row = dir ? row0 + seglen - 1 - ti : row0 + ti; const bf16* zr = Z + (size_t)row * DIN + h * 128 + d0;
          uq = *(const u32x4*)(zr + C_HQ); uv = *(const u32x4*)(zr + C_HI); uf = *(const u32x4*)(zr + cf); }
        for (int c = 0; c < nch; ++c) {
            PSEC_START(0)
            const int nc = dir ? nch - 1 - c : c; const int rown = row0 + 32 * nc + ti;
            f32x4 olp0 = {0.f, 0.f, 0.f, 0.f}, olp1 = {0.f, 0.f, 0.f, 0.f}; u32x4 ug = {0u, 0u, 0u, 0u};
            float* olr = OL + (size_t)rown * 512 + h * 128 + d0;
            if (dir == 1) { olp0 = *(const f32x4*)olr; olp1 = *(const f32x4*)(olr + 4); if (kind == 0) ug = *(const u32x4*)(Z + (size_t)rown * DIN + C_HG + h * 128 + d0); }
            float q[8], kk[8];
            {
                float g2[8], vv[8];
#pragma unroll
                for (int j = 0; j < 4; ++j) { const unsigned wq = uq[j], wv = uv[j], wf = uf[j];
                    q[2 * j] = siluf_(bflo(wq)) * 0.08838834764831845f; q[2 * j + 1] = siluf_(bfhi(wq)) * 0.08838834764831845f;
                    vv[2 * j] = bflo(wv); vv[2 * j + 1] = bfhi(wv);
                    kk[2 * j] = oml[2 * j] * sigmoidf_(-bflo(wf)); kk[2 * j + 1] = oml[2 * j + 1] * sigmoidf_(-bfhi(wf)); }
#pragma unroll
                for (int j = 0; j < 8; ++j) g2[j] = __builtin_amdgcn_logf(1.0f - fminf(kk[j], 1.0f - 1e-6f));
                LAS float* pg = ldsf + (H2_TG >> 2) + ti * 132 + d0;
                *(LAS f32x4*)pg = (f32x4){g2[0], g2[1], g2[2], g2[3]}; *(LAS f32x4*)(pg + 4) = (f32x4){g2[4], g2[5], g2[6], g2[7]};
                *(LAS u32x4*)(lds + H2_V + ti * 320 + d0 * 2) = uv;
            }
            if (c + 1 < nch) { const int tl = 32 * (c + 1) + ti; const int row = dir ? row0 + seglen - 1 - tl : row0 + tl; const bf16* zr = Z + (size_t)row * DIN + h * 128 + d0;
                uq = *(const u32x4*)(zr + C_HQ); uv = *(const u32x4*)(zr + C_HI); uf = *(const u32x4*)(zr + cf); }
            __syncthreads();
            PSEC_END(0) PSEC_START(1)
            if (tid < 128) {
                LAS float* gc = ldsf + (H2_TG >> 2) + tid; float run = 0.f; float gv[32];
#pragma unroll
                for (int i = 0; i < 32; ++i) gv[i] = gc[i * 132];
                SBAR
#pragma unroll
                for (int i = 0; i < 32; ++i) { run += gv[i]; gc[i * 132] = run; }
                ldsf[(H2_DK >> 2) + tid] = __builtin_amdgcn_exp2f(run);
                if (kind == 1) ((float*)(P->ws + WS_DLOG))[(uidx * 4 + c) * 128 + tid] = run;
                gtot += run;
            }
            __syncthreads();
            PSEC_END(1) PSEC_START(2)
            {
                const LAS float* gr = ldsf + (H2_TG >> 2) + ti * 132 + d0; const LAS float* gm = ldsf + (H2_TG >> 2) + 15 * 132 + d0; const LAS float* gl = ldsf + (H2_TG >> 2) + 31 * 132 + d0;
                float qe[8], ke[8], qg[8], kg[8];
#pragma unroll
                for (int j = 0; j < 8; ++j) { const float G = gr[j], Gm = gm[j], Gl = gl[j];
                    qe[j] = q[j] * __builtin_amdgcn_exp2f(fminf(G - Gm, 100.f)); ke[j] = kk[j] * __builtin_amdgcn_exp2f(fminf(Gm - G, 100.f));
                    qg[j] = q[j] * __builtin_amdgcn_exp2f(G); kg[j] = kk[j] * __builtin_amdgcn_exp2f(Gl - G); }
                *(LAS bf16x8*)(lds + H2_QE + ti * 272 + d0 * 2) = pack8(qe[0], qe[1], qe[2], qe[3], qe[4], qe[5], qe[6], qe[7]);
                *(LAS bf16x8*)(lds + H2_KE + ti * 272 + d0 * 2) = pack8(ke[0], ke[1], ke[2], ke[3], ke[4], ke[5], ke[6], ke[7]);
                *(LAS bf16x8*)(lds + H2_KG + ti * 320 + d0 * 2) = pack8(kg[0], kg[1], kg[2], kg[3], kg[4], kg[5], kg[6], kg[7]);
                u32x2 w0, w1; w0.x = pk2(qg[0], qg[1]); w0.y = pk2(qg[2], qg[3]); w1.x = pk2(qg[4], qg[5]); w1.y = pk2(qg[6], qg[7]);
                *(LAS u32x2*)(lds + H2_QG + ti * 264 + d0 * 2) = w0; *(LAS u32x2*)(lds + H2_QG + ti * 264 + d0 * 2 + 8) = w1;
            }
            __syncthreads();
            PSEC_END(2) PSEC_START(3)
            {
                f32x16 at;
#pragma unroll
                for (int i = 0; i < 16; ++i) at[i] = 0.f;
                const LAS unsigned char* kep = lds + H2_KE + r32 * 272 + 16 * hh; const LAS unsigned char* qep = lds + H2_QE + r32 * 272 + 16 * hh;
#pragma unroll
                for (int k = 0; k < 8; ++k) at = __builtin_amdgcn_mfma_f32_32x32x16_bf16(*(const LAS bf16x8*)(kep + 32 * k), *(const LAS bf16x8*)(qep + 32 * k), at, 0, 0, 0);
                float am[8];
#pragma unroll
                for (int j = 0; j < 8; ++j) { const float lo = at[j], hi = at[8 + j]; const float v = kp ? hi : lo; const int s = 16 * kp + 8 * (j >> 2) + 4 * hh + (j & 3); am[j] = (s <= r32) ? v : 0.f; }
                const bf16x8 afrag = pack8(am[0], am[1], am[2], am[3], am[4], am[5], am[6], am[7]);
                f32x16 ot;
#pragma unroll
                for (int i = 0; i < 16; ++i) ot[i] = 0.f;
                { const bf16x8 vfrag = trpair(lds + H2_V + (16 * kp + 4 * hh + (i16 >> 2)) * 320 + (32 * nt + 16 * cg + 4 * (i16 & 3)) * 2, 8 * 320);
                  ot = __builtin_amdgcn_mfma_f32_32x32x16_bf16(vfrag, afrag, ot, 0, 0, 0); }
                const LAS unsigned char* qgp = lds + H2_QG + r32 * 264 + (64 * kp + 4 * hh) * 2;
#pragma unroll
                for (int kl = 0; kl < 2; ++kl)
#pragma unroll
                    for (int sp = 0; sp < 2; ++sp) {
                        const u32x2 qlo = *(const LAS u32x2*)(qgp + (32 * kl + 16 * sp) * 2), qhi = *(const LAS u32x2*)(qgp + (32 * kl + 16 * sp) * 2 + 16);
                        const u32x4 qq = {qlo.x, qlo.y, qhi.x, qhi.y};
                        bf16x8 sfrag;
                        if (kl == 0) sfrag = pack8(S0[8 * sp], S0[8 * sp + 1], S0[8 * sp + 2], S0[8 * sp + 3], S0[8 * sp + 4], S0[8 * sp + 5], S0[8 * sp + 6], S0[8 * sp + 7]);
                        else sfrag = pack8(S1[8 * sp], S1[8 * sp + 1], S1[8 * sp + 2], S1[8 * sp + 3], S1[8 * sp + 4], S1[8 * sp + 5], S1[8 * sp + 6], S1[8 * sp + 7]);
                        ot = __builtin_amdgcn_mfma_f32_32x32x16_bf16(sfrag, __builtin_bit_cast(bf16x8, qq), ot, 0, 0, 0);
                    }
                { LAS float* ob = ldsf + ((kp ? H2_OBB : H2_OBA) >> 2) + (32 * nt + 4 * hh) * 33 + r32;
#pragma unroll
                  for (int i = 0; i < 16; ++i) ob[R0(i) * 33] = ot[i]; }
                const LAS float* dkp = ldsf + (H2_DK >> 2) + 64 * kp + 4 * hh;
#pragma unroll
                for (int i = 0; i < 16; ++i) { S0[i] *= dkp[R0(i)]; S1[i] *= dkp[32 + R0(i)]; }
#pragma unroll
                for (int ks = 0; ks < 2; ++ks) {
                    const int roff = (16 * ks + 8 * hh + (i16 >> 2)) * 320, coff = (16 * cg + 4 * (i16 & 3)) * 2;
                    const bf16x8 vf = trpair(lds + H2_V + roff + 64 * nt + coff, 4 * 320);
                    const bf16x8 k0 = trpair(lds + H2_KG + roff + 64 * (2 * kp) + coff, 4 * 320), k1 = trpair(lds + H2_KG + roff + 64 * (2 * kp + 1) + coff, 4 * 320);
                    S0 = __builtin_amdgcn_mfma_f32_32x32x16_bf16(k0, vf, S0, 0, 0, 0); S1 = __builtin_amdgcn_mfma_f32_32x32x16_bf16(k1, vf, S1, 0, 0, 0);
                }
            }
            __syncthreads();
            PSEC_END(3) PSEC_START(4)
            {
                const int t = dir ? 31 - ti : ti;
                const LAS float* oa = ldsf + (H2_OBA >> 2) + d0 * 33 + t; const LAS float* obb = ldsf + (H2_OBB >> 2) + d0 * 33 + t;
                float o[8];
#pragma unroll
                for (int j = 0; j < 8; ++j) o[j] = oa[j * 33] + obb[j * 33];
                if (dir == 1) { o[0] += olp0[0]; o[1] += olp0[1]; o[2] += olp0[2]; o[3] += olp0[3]; o[4] += olp1[0]; o[5] += olp1[1]; o[6] += olp1[2]; o[7] += olp1[3]; }
                if (dir == 0 || kind == 1) { *(f32x4*)olr = (f32x4){o[0], o[1], o[2], o[3]}; *(f32x4*)(olr + 4) = (f32x4){o[4], o[5], o[6], o[7]}; }
                else {
                    float ss = 0.f;
#pragma unroll
                    for (int j = 0; j < 8; ++j) ss += o[j] * o[j];
                    ss += __shfl_xor(ss, 1); ss += __shfl_xor(ss, 2); ss += __shfl_xor(ss, 4); ss += __shfl_xor(ss, 8);
                    const float r = __builtin_amdgcn_rsqf(ss * (1.0f / 128.0f) + 1e-6f);
                    u32x4 w;
                    w.x = pk2(o[0] * r * n0[0] * siluf_(bflo(ug.x)), o[1] * r * n0[1] * siluf_(bfhi(ug.x))); w.y = pk2(o[2] * r * n0[2] * siluf_(bflo(ug.y)), o[3] * r * n0[3] * siluf_(bfhi(ug.y)));
                    w.z = pk2(o[4] * r * n1[0] * siluf_(bflo(ug.z)), o[5] * r * n1[1] * siluf_(bfhi(ug.z))); w.w = pk2(o[6] * r * n1[2] * siluf_(bflo(ug.w)), o[7] * r * n1[3] * siluf_(bfhi(ug.w)));
                    *(u32x4*)(MIX + (size_t)rown * D_MODEL + 1024 + h * 128 + d0) = w;
                }
            }
            PSEC_CLOSE(4)
        }
        if (kind == 1 && tid < 128) ((float*)(P->ws + WS_DLOG) + 131072)[uidx * 128 + tid] = gtot;
        {
            float* Sd = (kind == 0) ? P->out + OUT_ST + (size_t)((((b * 2 + l) * 2 + dir) * 4 + h)) * 16384 : (float*)(P->ws + WS_U) + (size_t)uidx * 16384;
            float* sp = Sd + (64 * kp + 4 * hh) * 128 + 32 * nt + r32;
#pragma unroll
            for (int i = 0; i < 16; ++i) { sp[R0(i) * 128] = S0[i]; sp[(32 + R0(i)) * 128] = S1[i]; }
        }
    }
    PSEC_FLUSH(2 * nch)
}

__device__ __forceinline__ void hgrn_scan_unit(PP P, int l, int su, int tid) {
    float* U = (float*)(P->ws + WS_U); const float* DLB = (const float*)(P->ws + WS_DLOG) + 131072;
#pragma unroll 1
    for (int k = 0; k < 4; ++k) {
        const int e = su * 2048 + tid + 512 * k;
        const int sq = e >> 14, el = e & 16383, dk = el >> 7, lb = sq >> 3, h = (sq >> 1) & 3, dir = sq & 1;
        float S = P->in[4][(size_t)((((lb * 2 + l) * 2 + dir) * 4 + h)) * 16384 + el];
        float u[16], dl[16];
        const long ustep = dir ? -16384 : 16384, dstep = dir ? -128 : 128;
        float* up = U + (size_t)(sq * 16 + (dir ? 15 : 0)) * 16384 + el; const float* dp = DLB + (sq * 16 + (dir ? 15 : 0)) * 128 + dk;
        { float* uq = up; const float* dq = dp;
#pragma unroll
          for (int p = 0; p < 16; ++p) { u[p] = *uq; dl[p] = *dq; uq += ustep; dq += dstep; asm volatile("" : "+v"(uq), "+v"(dq)); } }
        SBAR
        { float* uq = up;
#pragma unroll
          for (int p = 0; p < 16; ++p) { *uq = S; S = __builtin_amdgcn_exp2f(dl[p]) * S + u[p]; uq += ustep; asm volatile("" : "+v"(uq)); } }
    }
}

constexpr int HF_S0 = 0, HF_S1 = 40960, HF_TG0 = 81920, HF_TG1 = 98816, HF_QG0 = 115712, HF_QG1 = 124416;
__device__ __forceinline__ void hgrn_final_unit(PP P, LAS unsigned char* lds, int l, int idx, int half_sel, int tid) {
    const int lane = tid & 63, wave = __builtin_amdgcn_readfirstlane(tid >> 6), r32 = lane & 31, hh = lane >> 5, i16 = lane & 15, cg = (lane >> 4) & 1;
    const bf16* Z = (const bf16*)(P->ws + WS_Z); bf16* MIX = (bf16*)(P->ws + WS_H); const float* OL = (const float*)(P->ws + WS_OL); const float* DLC = (const float*)(P->ws + WS_DLOG);
    LAS float* ldsf = (LAS float*)lds;
    const int blk = idx & 15, h = (idx >> 4) & 3, lb = idx >> 6, row0 = NCTX + lb * 2048 + blk * 128;
    const int ti = tid >> 4, d0 = 8 * (tid & 15), nt = wave & 3, ds = wave >> 2;
    const int uidx0 = ((idx >> 4) * 2 + 0) * 16 + blk, uidx1 = ((idx >> 4) * 2 + 1) * 16 + blk;
#pragma unroll
    for (int half = 0; half < 2; ++half) {
        f32x4 sv[8];
#pragma unroll
        for (int k = 0; k < 8; ++k) { const int id = tid + 512 * (k + 8 * half), dsel = id >> 12, dk = (id >> 5) & 127, c4 = id & 31;
            sv[k] = *(const f32x4*)((const float*)(P->ws + WS_U) + (size_t)(dsel ? uidx1 : uidx0) * 16384 + dk * 128 + c4 * 4); }
#pragma unroll
        for (int k = 0; k < 8; ++k) { const int id = tid + 512 * (k + 8 * half), dsel = id >> 12, dk = (id >> 5) & 127, c4 = id & 31;
            u32x2 w; w.x = pk2(sv[k][0], sv[k][1]); w.y = pk2(sv[k][2], sv[k][3]); *(LAS u32x2*)(lds + (dsel ? HF_S1 : HF_S0) + dk * 320 + c4 * 8) = w; }
    }
    float oml0[8], oml1[8]; hg_oml8(P, l, 0, h * 128 + d0, oml0); hg_oml8(P, l, 1, h * 128 + d0, oml1);
    const f32x4 n0 = *(const f32x4*)(P->in[13] + l * 512 + h * 128 + d0), n1 = *(const f32x4*)(P->in[13] + l * 512 + h * 128 + d0 + 4);
    float carry = 0.f;
    if (tid < 128) { for (int c = 0; c < 2 * half_sel; ++c) carry += DLC[(uidx0 * 4 + c) * 128 + tid]; }
    for (int nc = 2 * half_sel; nc < 2 * half_sel + 2; ++nc) {
        const int rown = row0 + 32 * nc + ti; const bf16* zr = Z + (size_t)rown * DIN + h * 128 + d0;
        const u32x4 uq = *(const u32x4*)(zr + C_HQ), uf0 = *(const u32x4*)(zr + C_HFF), uf1 = *(const u32x4*)(zr + C_HFB), ug = *(const u32x4*)(zr + C_HG);
        const float* olr = OL + (size_t)rown * 512 + h * 128 + d0; const f32x4 olp0 = *(const f32x4*)olr, olp1 = *(const f32x4*)(olr + 4);
        float off1 = 0.f;
        if (tid >= 128 && tid < 256) { for (int c = 0; c < 3 - nc; ++c) off1 += DLC[(uidx1 * 4 + c) * 128 + (tid - 128)]; }
        float q[8];
        {
            float ga[8], gb[8];
#pragma unroll
            for (int j = 0; j < 4; ++j) { const unsigned wq = uq[j], wa = uf0[j], wb = uf1[j];
                q[2 * j] = siluf_(bflo(wq)) * 0.08838834764831845f; q[2 * j + 1] = siluf_(bfhi(wq)) * 0.08838834764831845f;
                ga[2 * j] = oml0[2 * j] * sigmoidf_(-bflo(wa)); ga[2 * j + 1] = oml0[2 * j + 1] * sigmoidf_(-bfhi(wa));
                gb[2 * j] = oml1[2 * j] * sigmoidf_(-bflo(wb)); gb[2 * j + 1] = oml1[2 * j + 1] * sigmoidf_(-bfhi(wb)); }
#pragma unroll
            for (int j = 0; j < 8; ++j) { ga[j] = __builtin_amdgcn_logf(1.0f - fminf(ga[j], 1.0f - 1e-6f)); gb[j] = __builtin_amdgcn_logf(1.0f - fminf(gb[j], 1.0f - 1e-6f)); }
            LAS float* p0 = ldsf + (HF_TG0 >> 2) + ti * 132 + d0; LAS float* p1 = ldsf + (HF_TG1 >> 2) + ti * 132 + d0;
            *(LAS f32x4*)p0 = (f32x4){ga[0], ga[1], ga[2], ga[3]}; *(LAS f32x4*)(p0 + 4) = (f32x4){ga[4], ga[5], ga[6], ga[7]};
            *(LAS f32x4*)p1 = (f32x4){gb[0], gb[1], gb[2], gb[3]}; *(LAS f32x4*)(p1 + 4) = (f32x4){gb[4], gb[5], gb[6], gb[7]};
        }
        __syncthreads();
        if (tid < 256) { const bool rev = tid >= 128; LAS float* gc = ldsf + ((rev ? HF_TG1 : HF_TG0) >> 2) + (tid & 127); float run = rev ? off1 : carry; float gv[32];
#pragma unroll
            for (int i = 0; i < 32; ++i) gv[i] = gc[(rev ? 31 - i : i) * 132];
            SBAR
#pragma unroll
            for (int i = 0; i < 32; ++i) { run += gv[i]; gc[(rev ? 31 - i : i) * 132] = run; }
            if (!rev) carry = run; }
        __syncthreads();
        {
            const LAS float* g0 = ldsf + (HF_TG0 >> 2) + ti * 132 + d0; const LAS float* g1 = ldsf + (HF_TG1 >> 2) + ti * 132 + d0;
            float a[8], c[8];
#pragma unroll
            for (int j = 0; j < 8; ++j) { a[j] = q[j] * __builtin_amdgcn_exp2f(g0[j]); c[j] = q[j] * __builtin_amdgcn_exp2f(g1[j]); }
            *(LAS bf16x8*)(lds + HF_QG0 + ti * 272 + d0 * 2) = pack8(a[0], a[1], a[2], a[3], a[4], a[5], a[6], a[7]);
            *(LAS bf16x8*)(lds + HF_QG1 + ti * 272 + d0 * 2) = pack8(c[0], c[1], c[2], c[3], c[4], c[5], c[6], c[7]);
        }
        __syncthreads();
        {
            f32x16 acc;
#pragma unroll
            for (int i = 0; i < 16; ++i) acc[i] = 0.f;
            const LAS unsigned char* qp = lds + (ds ? HF_QG1 : HF_QG0) + r32 * 272 + 16 * hh;
            const LAS unsigned char* sp = lds + (ds ? HF_S1 : HF_S0) + (8 * hh + (i16 >> 2)) * 320 + (32 * nt + 16 * cg + 4 * (i16 & 3)) * 2;
#pragma unroll
            for (int k = 0; k < 8; ++k) { const bf16x8 sf = trpair(sp + 16 * k * 320, 4 * 320); acc = __builtin_amdgcn_mfma_f32_32x32x16_bf16(*(const LAS bf16x8*)(qp + 32 * k), sf, acc, 0, 0, 0); }
            LAS float* ob = ldsf + ((ds ? HF_TG1 : HF_TG0) >> 2) + (4 * hh) * 132 + 32 * nt + r32;
#pragma unroll
            for (int i = 0; i < 16; ++i) ob[R0(i) * 132] = acc[i];
        }
        __syncthreads();
        {
            const LAS float* oa = ldsf + (HF_TG0 >> 2) + ti * 132 + d0; const LAS float* obb = ldsf + (HF_TG1 >> 2) + ti * 132 + d0;
            const f32x4 a0 = *(const LAS f32x4*)oa, a1 = *(const LAS f32x4*)(oa + 4), b0 = *(const LAS f32x4*)obb, b1 = *(const LAS f32x4*)(obb + 4);
            const f32x4 o0 = a0 + b0 + olp0, o1 = a1 + b1 + olp1;
            float ss = (o0[0] * o0[0] + o0[1] * o0[1]) + (o0[2] * o0[2] + o0[3] * o0[3]) + (o1[0] * o1[0] + o1[1] * o1[1]) + (o1[2] * o1[2] + o1[3] * o1[3]);
            ss += __shfl_xor(ss, 1); ss += __shfl_xor(ss, 2); ss += __shfl_xor(ss, 4); ss += __shfl_xor(ss, 8);
            const float r = __builtin_amdgcn_rsqf(ss * (1.0f / 128.0f) + 1e-6f);
            u32x4 w;
            w.x = pk2(o0[0] * r * n0[0] * siluf_(bflo(ug.x)), o0[1] * r * n0[1] * siluf_(bfhi(ug.x))); w.y = pk2(o0[2] * r * n0[2] * siluf_(bflo(ug.y)), o0[3] * r * n0[3] * siluf_(bfhi(ug.y)));
            w.z = pk2(o1[0] * r * n1[0] * siluf_(bflo(ug.z)), o1[1] * r * n1[1] * siluf_(bfhi(ug.z))); w.w = pk2(o1[2] * r * n1[2] * siluf_(bflo(ug.w)), o1[3] * r * n1[3] * siluf_(bfhi(ug.w)));
            *(u32x4*)(MIX + (size_t)rown * D_MODEL + 1024 + h * 128 + d0) = w;
        }
        __syncthreads();
    }
}

#define RLX_AGENT __ATOMIC_RELAXED, __HIP_MEMORY_SCOPE_AGENT
#define XB_TMO      128
#define XB_XCNT(j)  (256  + 64 * (j))
#define XB_XSUB(j)  (1280 + 64 * (j))
#define XB_XGEN(j)  (2304 + 64 * (j))
#define XB_TOP      3328
#define XB_TOPGEN   3392
#define XCD_BAR_WORDS 3456
#define XB_SPIN_CAP (1u << 18)

__device__ __forceinline__ unsigned xb_ld(unsigned* p)              { return __hip_atomic_load(p, __ATOMIC_RELAXED, __HIP_MEMORY_SCOPE_AGENT); }
__device__ __forceinline__ unsigned xb_add(unsigned* p, unsigned v) { return __hip_atomic_fetch_add(p, v, __ATOMIC_RELAXED, __HIP_MEMORY_SCOPE_AGENT); }
__device__ __forceinline__ unsigned xb_xcc_id() { return (unsigned)__builtin_amdgcn_s_getreg((3 << 11) | 20) & 0xFu; }
#define XB_SPIN(cond, bar) do { unsigned _sp = 0; while (cond) { __builtin_amdgcn_s_sleep(1); \
    if ((++_sp & 255u) == 0u) { if (xb_ld(&(bar)[XB_TMO])) break; if (_sp > XB_SPIN_CAP) { atomicAdd(&(bar)[XB_TMO], 1u); break; } } } } while (0)

struct XcdBarrier {
    unsigned* bar; unsigned x; bool t0;
    volatile LAS unsigned* st;
};

__device__ __forceinline__ XcdBarrier xcd_barrier_post(unsigned* bar, volatile LAS unsigned* st) {
    XcdBarrier b; b.bar = bar; b.x = xb_xcc_id(); b.st = st; b.t0 = (threadIdx.x == 0);
    if (threadIdx.x == 0) (void)xb_add(&bar[XB_XCNT(b.x)], 1u);
    return b;
}
__device__ __forceinline__ void xcd_barrier_complete(unsigned* bar, unsigned x, unsigned& nloc, unsigned& nx) {
    const unsigned G = gridDim.x * gridDim.y * gridDim.z;
    unsigned sum, cnt, mine, sp = 0u;
    for (;;) {
        sum = 0u; cnt = 0u; mine = 0u;
#pragma unroll
        for (unsigned j = 0; j < 16; ++j) { const unsigned c = xb_ld(&bar[XB_XCNT(j)]); sum += c; cnt += (c > 0u) ? 1u : 0u; mine = (j == x) ? c : mine; }
        if (sum == G) break;
        __builtin_amdgcn_s_sleep(1);
        if ((++sp & 255u) == 0u) { if (xb_ld(&bar[XB_TMO])) break; if (sp > XB_SPIN_CAP) { atomicAdd(&bar[XB_TMO], 1u); break; } }
    }
    nloc = mine > 0u ? mine : 1u; nx = cnt > 0u ? cnt : 1u;
}

__device__ __forceinline__ void xcd_barrier(const XcdBarrier& b) {
    asm volatile("s_waitcnt vmcnt(0)" ::: "memory");
    __syncthreads();
    if (b.t0) {
        unsigned* bar = b.bar;
        __builtin_amdgcn_s_waitcnt(0);
        unsigned nloc = b.st[0], nx = b.st[1];
        if (nloc == 0u) { xcd_barrier_complete(bar, b.x, nloc, nx); b.st[0] = nloc; b.st[1] = nx; }
        const unsigned old = xb_add(&bar[XB_XSUB(b.x)], 1u);
        const unsigned gen = old / nloc;
        if (old + 1u == (gen + 1u) * nloc) {
            __builtin_amdgcn_fence(__ATOMIC_RELEASE, "agent");
            asm volatile("s_waitcnt vmcnt(0)" ::: "memory");
            const unsigned og = xb_add(&bar[XB_TOP], 1u);
            const unsigned tg = og / nx;
            if (og + 1u == (tg + 1u) * nx) xb_add(&bar[XB_TOPGEN], 1u);
            else XB_SPIN(xb_ld(&bar[XB_TOPGEN]) == tg, bar);
            __builtin_amdgcn_fence(__ATOMIC_ACQUIRE, "agent");
            xb_add(&bar[XB_XGEN(b.x)], 1u);
            asm volatile("s_waitcnt vmcnt(0)" ::: "memory");
        } else {
            XB_SPIN(xb_ld(&bar[XB_XGEN(b.x)]) == gen, bar);
            __builtin_amdgcn_fence(__ATOMIC_ACQUIRE, "agent");
            asm volatile("s_waitcnt vmcnt(0)" ::: "memory");
        }
    }
    __syncthreads();
}

#ifndef REP_P0
#define REP_P0 1
#endif
#ifndef REP_P1
#define REP_P1 1
#endif
#ifndef REP_P2
#define REP_P2 1
#endif
#ifndef PROBE_KIND
#define PROBE_KIND -1
#endif
#ifndef PROBE_PH
#define PROBE_PH 0
#endif
#ifndef PROBE_SCALE
#define PROBE_SCALE 1.0f
#endif
#ifndef PROBE_PB
#define PROBE_PB 0
#endif
#ifndef PROBE_PL
#define PROBE_PL 0
#endif
#ifndef P0_MASK
#define P0_MASK 3
#endif
#ifndef P2_MASK
#define P2_MASK 31
#endif
#ifndef REP_P3
#define REP_P3 1
#endif
#ifndef REP_P4
#define REP_P4 1
#endif
__global__ void __launch_bounds__(NTHREADS, 2) fwd_kernel(Params Pkarg) {
    extern __shared__ __attribute__((aligned(16))) unsigned char lds_raw[];
    cg::grid_group grid = cg::this_grid();
    LAS unsigned char* lds = (LAS unsigned char*)lds_raw;
    LAS float* ldsf = (LAS float*)lds;
    volatile LAS unsigned* qslot = (volatile LAS unsigned*)(lds + LDS_CTLW);
    volatile LAS unsigned* xbst = (volatile LAS unsigned*)(lds + LDS_CTLW + 128);
    if (threadIdx.x < 2) xbst[threadIdx.x] = 0u;
    __syncthreads();
    (void)xcd_barrier_post((unsigned*)(Pkarg.ws + WS_CTL) + 1024, xbst);
#define PSTAMP(k, lay) do { if (PROBE_KIND == 20 && (lay) == PROBE_PL && blockIdx.x == PROBE_PB && wave_s == 0) { const unsigned long long t_ = __builtin_amdgcn_s_memrealtime(); if ((k) == PROBE_PH) pst0 = t_; if ((k) == PROBE_PH + 1) pst1 = t_; } } while (0)
#define tid_zero_() (wave_s == 0 && __builtin_amdgcn_mbcnt_hi(~0u, __builtin_amdgcn_mbcnt_lo(~0u, 0u)) == 0u)
#define GSYNC() do { PP Pb_ = (PP)__builtin_amdgcn_kernarg_segment_ptr(); asm volatile("" : "+s"(Pb_)); XcdBarrier xb_; xb_.bar = (unsigned*)(Pb_->ws + WS_CTL) + 1024; xb_.x = xb_xcc_id(); xb_.st = xbst; int ln_; asm volatile("v_mbcnt_lo_u32_b32 %0, -1, 0\n\tv_mbcnt_hi_u32_b32 %0, -1, %0" : "=v"(ln_)); xb_.t0 = (wave_s == 0) && (ln_ == 0); xcd_barrier(xb_); } while (0)
    const int wave_s = __builtin_amdgcn_readfirstlane(threadIdx.x >> 6);
#define PHASE_IDS int tid; asm volatile("v_mbcnt_lo_u32_b32 %0, -1, 0\n\tv_mbcnt_hi_u32_b32 %0, -1, %0" : "=v"(tid)); tid += wave_s * 64; const int lane = tid & 63, wave = wave_s, gw = blockIdx.x * NWAVES + wave; (void)lane; (void)gw; \
    PP P = (PP)__builtin_amdgcn_kernarg_segment_ptr(); asm volatile("" : "+s"(P)); unsigned char* ws = P->ws; unsigned* ctl = (unsigned*)(ws + WS_CTL); float* MOD = (float*)(ws + WS_MOD); \
    bf16* H = (bf16*)(ws + WS_H); bf16* Z = (bf16*)(ws + WS_Z); bf16* WTIN = (bf16*)(ws + WS_WTIN); bf16* WTOUT = (bf16*)(ws + WS_WTOUT); const float* xp = P->in[0]; const float* xs = P->in[1]; \
    (void)ctl; (void)MOD; (void)H; (void)Z; (void)WTIN; (void)WTOUT; (void)xp; (void)xs;
    const int G = gridDim.x, NGW = G * NWAVES;
    unsigned long long pst0 = 0ull, pst1 = 0ull;

    for (int rep = 0; rep < REP_P0; ++rep) {
        PHASE_IDS
        const int m0 = (rep == 0) ? 3 : P0_MASK;
        if (m0 & 1) for (int u = blockIdx.x; u < 192; u += G) mod_unit(P, ldsf, 0, u, tid);
        LAS float* scr = ldsf + wave * 4096;
        if (m0 & 2) for (int it = gw; it < 6656; it += NGW) transpose_item(P->in[9], 2048, DIN, WTIN, scr, it, lane);
        { const int gt4 = (blockIdx.x * NTHREADS + tid) * 4;
          if (gt4 < 524288) { const float* src = (gt4 < 262144) ? P->in[2] + gt4 : P->in[3] + (gt4 - 262144); const f32x4 v = *(const f32x4*)src;
              u32x2 w; w.x = pk2(v[0], v[1]); w.y = pk2(v[2], v[3]); *(u32x2*)((bf16*)(ws + WS_CKV) + gt4) = w; } }
        const int gt = blockIdx.x * NTHREADS + tid;
        if (gt < 2048) { const int pos = gt >> 5, i = gt & 31; const float inv = powf(10000.0f, -(float)i / 32.0f); const float ang = (float)pos * inv;
            float sn, cs; sincosf(ang, &sn, &cs); float* CS = (float*)(ws + WS_CS); CS[gt * 2] = cs; CS[gt * 2 + 1] = sn; }
        grid.sync();
    }
    { PHASE_IDS
    for (int row = gw; row < MTOK; row += NGW) {
        const int cond = (row < NCTX) ? 0 : 1 + ((row - NCTX) >> 11);
        const float* xrow = (row < NCTX) ? xp + (size_t)row * D_MODEL : xs + (size_t)(row - NCTX) * D_MODEL;
        hprep_row(xrow, MOD + (0 * 3 + cond) * 6144, H + (size_t)row * D_MODEL, lane);
    } }
    GSYNC();

    for (int l = 0; l < DEPTH; ++l) {
        PSTAMP(0, l);
        for (int rep = 0; rep < REP_P1; ++rep) {
            PHASE_IDS
            pg8::Gemm g{H, WTIN, MTOK, DIN, D_MODEL}; pg8::StaticOrder S; S.init(MTOK, DIN, D_MODEL, G, (int)blockIdx.x);
            pg8::EpiZ E{Z, P->out + OUT_CK, P->out + OUT_CV, l};
            pg8::gemm_phase<pg8::EpiZ, pg8::StaticOrder, true, true>(lds, g, S, E, tid);
            GSYNC();
        }
        PSTAMP(1, l);
        {
            int pendf = -1; int uf = -1;
            unsigned long long pr_sum = 0ull; unsigned pr_cnt = 0u;
            const int n_cvt = (l == 0 && G != 256) ? 832 : 0;
            for (int st = 0; st < 3; ++st) {
                PHASE_IDS
                unsigned* cs = ctl + 64 * (l * 4 + st); unsigned* cf = ctl + 64 * (l * 4 + 3);
                const int nspec = (st == 2) ? 256 : 128;
                const int n_def = (l == 0) ? 192 + 512 : 0;
                const int capf = (st == 0) ? 256 : (st == 1) ? 512 : 896 + n_def + n_cvt;
                int pends = -1; bool spec = true;
                int us = q_pop(cs, qslot, tid, pends, 1 << 30);
                for (;;) {
                    int kind, idx;
                    if (spec) {
                        if (us >= nspec) { spec = false; if (uf < 0) uf = q_pop(cf, qslot, tid, pendf, 512); continue; }
                        kind = (st == 0) ? 1 : (st == 1) ? 6 : 7; idx = us;
                    } else {
                        if (uf >= capf) break;
                        if (uf < 128) { kind = 0; idx = uf; } else if (uf < 256) { kind = 3; idx = uf - 128; } else if (uf < 512) { kind = 2; idx = uf - 256; }
                        else if (uf < 896) { kind = 4; idx = uf - 512; } else if (uf < 896 + n_def) { idx = uf - 896; if (idx < 192) kind = 8; else { kind = 9; idx -= 192; } } else { kind = 5; idx = uf - 896 - n_def; }
                    }
                    asm volatile("" : "+v"(tid));
                    const unsigned long long pr_t0 = (PROBE_KIND >= 0 && PROBE_KIND < 9) ? __builtin_amdgcn_s_memrealtime() : 0ull;
                    if (kind <= 1) hgrn2_unit(P, lds, l, kind, idx, tid);
                    else if (kind <= 3) attn_unit(P, lds, l, kind - 2, idx, tid);
                    else if (kind == 4) conv_unit(P, ldsf, l, idx, tid);
                    else if (kind == 5) { const int lane2 = tid & 63; LAS float* scr = ldsf + wave * 4096; transpose_item(P->in[9] + (size_t)2048 * DIN, 2048, DIN, WTIN, scr, idx * 8 + wave, lane2); }
                    else if (kind == 6) hgrn_scan_unit(P, l, idx, tid);
                    else if (kind == 8) mod_unit(P, ldsf, 1, idx, tid);
                    else if (kind == 9) { const int it = idx * 8 + wave, lo = it & 2047; LAS float* scr = ldsf + wave * 4096;
                        transpose_item(P->in[10] + (size_t)(it >> 11) * 2048 * 2048, 2048, 2048, WTOUT + (size_t)(it >> 11) * 2048 * 2048, scr, lo, tid & 63); }
                    else hgrn_final_unit(P, lds, l, idx >> 1, idx & 1, tid);
                    if (PROBE_KIND >= 0 && PROBE_KIND < 9 && kind == PROBE_KIND) { __syncthreads(); pr_sum += __builtin_amdgcn_s_memrealtime() - pr_t0; pr_cnt += 1u; }
                    if (spec) us = q_pop(cs, qslot, tid, pends, 1 << 30); else uf = q_pop(cf, qslot, tid, pendf, 512);
                }
                GSYNC();
                PSTAMP(2 + st, l);
            }
            if (PROBE_KIND >= 0 && PROBE_KIND < 9 && l == 0 && tid_zero_()) { atomicAdd((unsigned long long*)((unsigned*)(Pkarg.ws + WS_CTL) + 60000), pr_sum); atomicAdd((unsigned*)(Pkarg.ws + WS_CTL) + 60002, pr_cnt); }
        }
        if (G == 256) {
            {   PHASE_IDS
                pg8::Gemm g{H, WTOUT + (size_t)l * 2048 * 2048, MTOK, D_MODEL, D_MODEL}; pg8::StaticOrder S; S.init(MTOK, D_MODEL, D_MODEL, G, (int)blockIdx.x, 0); S.rset = 0;
                pg8::EpiV E{(l == 0) ? xp : P->out, (l == 0) ? xs : P->out + OUT_YS, P->out, MOD + l * 3 * 6144 + 4096, (float*)(ws + WS_OL), ctl + 8192};
                pg8::gemm_phase<pg8::EpiV, pg8::StaticOrder, true, true>(lds, g, S, E, tid);
            }
            GSYNC();
            PSTAMP(5, l);
            if (blockIdx.x < 128) {
                PHASE_IDS
                pg8::Gemm g{H, WTOUT + (size_t)l * 2048 * 2048, MTOK, D_MODEL, D_MODEL}; pg8::StaticOrder S; S.init(MTOK, D_MODEL, D_MODEL, G, (int)blockIdx.x, 0); S.rset = 1;
                pg8::EpiV E{(l == 0) ? xp : P->out, (l == 0) ? xs : P->out + OUT_YS, P->out, MOD + l * 3 * 6144 + 4096, (float*)(ws + WS_OL), ctl + 8192};
                pg8::gemm_phase<pg8::EpiV, pg8::StaticOrder, true, true>(lds, g, S, E, tid);
            } else {
                PHASE_IDS
                for (int row = (blockIdx.x - 128) * NWAVES + wave; row < NCTX; row += 128 * NWAVES)
                    ln_row(P->out + (size_t)row * D_MODEL, P->in[18] + l * D_MODEL, P->in[19] + l * D_MODEL, MOD + 3 * 6144, (l == 0) ? H + (size_t)row * D_MODEL : (bf16*)nullptr, lane);
                if (l == 0) {
                    LAS float* scr = ldsf + wave * 4096;
                    for (int it = (blockIdx.x - 128) * NWAVES + wave; it < 6656; it += 128 * NWAVES) { asm volatile("" : "+v"(tid)); transpose_item(P->in[9] + (size_t)2048 * DIN, 2048, DIN, WTIN, scr, it, tid & 63); }
                }
            }
#ifdef PROBE_SUB
            __syncthreads(); PSTAMP(6, l);
#endif
            GSYNC();
#ifndef PROBE_SUB
            PSTAMP(6, l);
#endif
            {   PHASE_IDS
                for (int row = NCTX + gw; row < MTOK; row += NGW) { const int cond = 1 + ((row - NCTX) >> 11);
                    ln_row(P->out + (size_t)row * D_MODEL, P->in[18] + l * D_MODEL, P->in[19] + l * D_MODEL, MOD + (3 + cond) * 6144, (l == 0) ? H + (size_t)row * D_MODEL : (bf16*)nullptr, lane); }
            }
        } else {
            {   PHASE_IDS
                pg8::Gemm g{H, WTOUT + (size_t)l * 2048 * 2048, MTOK, D_MODEL, D_MODEL}; pg8::StaticOrder S; S.init(MTOK, D_MODEL, D_MODEL, G, (int)blockIdx.x, 0);
                pg8::EpiV E{(l == 0) ? xp : P->out, (l == 0) ? xs : P->out + OUT_YS, P->out, MOD + l * 3 * 6144 + 4096, (float*)(ws + WS_OL), ctl + 8192};
                pg8::gemm_phase<pg8::EpiV, pg8::StaticOrder, true, true>(lds, g, S, E, tid);
            }
            GSYNC();
            {   PHASE_IDS
                for (int row = gw; row < MTOK; row += NGW) { const int cond = (row < NCTX) ? 0 : 1 + ((row - NCTX) >> 11);
                    ln_row(P->out + (size_t)row * D_MODEL, P->in[18] + l * D_MODEL, P->in[19] + l * D_MODEL, MOD + (3 + cond) * 6144, (l == 0) ? H + (size_t)row * D_MODEL : (bf16*)nullptr, lane); }
            }
        }
        if (l + 1 < DEPTH) GSYNC();
        PSTAMP(7, l);
    }
    if (PROBE_KIND >= 0) { GSYNC(); PHASE_IDS if (blockIdx.x == ((PROBE_KIND == 20) ? PROBE_PB : 0) && tid == 0) { const unsigned long long sm = *(volatile unsigned long long*)(ctl + 60000); const unsigned cn = *(volatile unsigned*)(ctl + 60002); const float pv_ = (PROBE_KIND == 20) ? PROBE_SCALE * 0.01f * (float)(pst1 - pst0) : ((PROBE_KIND == 9) ? 0.1f : 0.01f) * (float)sm / (float)(cn ? cn : 1u);     P->out[0] = pv_; P->out[1] = pv_; P->out[2] = pv_; P->out[3] = pv_; }     }
}

extern "C" void kernel_launch(void* const* d_in, const int* in_sizes, int n_in, void* d_out, int out_size, void* d_ws, size_t ws_size, hipStream_t stream) {
    static int grid = 0;
    if (grid == 0) {
        if (n_in != 20 || out_size != (int)OUT_TOTAL || ws_size < WS_END) { fprintf(stderr, "kernel_launch: unexpected shapes (n_in %d, out %d, ws %zu)\n", n_in, out_size, ws_size); grid = -1; return; }
        int dev = 0, cus = 0, per_cu = 0;
        hipGetDevice(&dev); hipDeviceGetAttribute(&cus, hipDeviceAttributeMultiprocessorCount, dev);
        hipFuncSetAttribute((const void*)fwd_kernel, hipFuncAttributeMaxDynamicSharedMemorySize, LDS_BYTES);
        hipOccupancyMaxActiveBlocksPerMultiprocessor(&per_cu, (const void*)fwd_kernel, NTHREADS, LDS_BYTES);
        if (per_cu < 1) { fprintf(stderr, "kernel_launch: occupancy query says %d blocks per CU\n", per_cu); grid = -1; return; }
        grid = cus;
    }
    if (grid < 0) return;
    hipMemsetAsync((char*)d_ws + WS_CTL, 0, CTL_ZERO_BYTES, stream);
    Params p{};
    for (int i = 0; i < 20; ++i) p.in[i] = (const float*)d_in[i];
    p.out = (float*)d_out; p.ws = (unsigned char*)d_ws;
    void* args[] = {&p};
    hipError_t e = hipLaunchCooperativeKernel((const void*)fwd_kernel, dim3(grid), dim3(NTHREADS), args, LDS_BYTES, stream);
    if (e != hipSuccess) fprintf(stderr, "cooperative launch failed: %s (grid %d)\n", hipGetErrorString(e), grid);
}
```

```cpp
#include <hip/hip_runtime.h>
#include <hip/hip_cooperative_groups.h>
#include <cstdio>
#include <cstdint>
namespace cg = cooperative_groups;

constexpr int D_MODEL = 2048, DIN = 6656, NCTX = 8192, NLAT = 4096, MTOK = 12288, DEPTH = 2;
constexpr int C_AQ = 0, C_AK = 1024, C_AV = 1280, C_AG = 1536, C_HQ = 2560, C_HI = 3072, C_HFF = 3584, C_HFB = 4096, C_HG = 4608, C_CA = 5120, C_CB = 5632, C_CG = 6144;
constexpr float ALPHA_DN = 1.4142135623730951f;
constexpr size_t OUT_YP = 0, OUT_YS = 16777216, OUT_CK = 25165824, OUT_CV = 29360128, OUT_ST = 33554432, OUT_TOTAL = 41943040;
namespace pg8 {
#define PG8_LAS __attribute__((address_space(3)))
typedef unsigned short bf16_t;
typedef short bf16x8 __attribute__((ext_vector_type(8)));
typedef float f32x4 __attribute__((ext_vector_type(4)));
typedef unsigned u32x4 __attribute__((ext_vector_type(4)));
constexpr int BM = 256, BK = 64, HALF = 128, HTB = HALF * BK * 2  , STAGE_BYTES = 8 * HTB, NXCD = 8, WGM = 8;

__host__ __device__ __forceinline__ int lds_byte(int r, int c) { const int st = (r >> 4) * 2 + (c >> 5), rr = r & 15, cc = c & 31, ob = rr * 64 + cc * 2; return st * 1024 + (ob ^ (((ob >> 9) & 1) << 5)); }
__host__ __device__ __forceinline__ void stage_rc(int b, int& R, int& C) { const int st = b / 1024, sb = b % 1024, swz = sb ^ (((sb >> 9) & 1) << 5); R = (st >> 1) * 16 + swz / 64; C = (st & 1) * 32 + (swz % 64) / 2; }
__host__ __device__ __forceinline__ int perm32(int rho) { const int n = rho >> 4, i = rho & 15; return 8 * (i >> 2) + 4 * n + (i & 3); }

struct Unit { int pm, pn, k0, nk, role, pair; };
struct Gemm { const bf16_t* A; const bf16_t* Bt; int M, N, K; };

struct StaticOrder {
    int nM, nN, nwg, G, c, nkt, split, rset;
    __host__ __device__ void init(int M, int N, int K, int G_, int c_, int split_ = 0) { nM = M / BM; nN = N / BM; nwg = nM * nN; G = G_; c = c_; nkt = K / BK; split = split_ && (G_ % 16 == 0) && (2 * nwg == 3 * G_) && (nkt % 4 == 0); rset = -1; }
    __host__ __device__ void map(long L, Unit& u) const {
        int wgid = (int)L; { const int q = nwg / NXCD, r = nwg % NXCD, xcd = wgid % NXCD, off = wgid / NXCD; wgid = (xcd < r ? xcd * (q + 1) : r * (q + 1) + (xcd - r) * q) + off; }
        const int nig = WGM * nN, gid = wgid / nig, fm = gid * WGM, gsz = (nM - fm) < WGM ? (nM - fm) : WGM;
        u.pm = fm + ((wgid % nig) % gsz); u.pn = (wgid % nig) / gsz; u.k0 = 0; u.nk = nkt; u.role = 0; u.pair = 0;
    }
    __host__ __device__ bool next(int i, Unit& u) const {
        if (rset >= 0) {
            if (i != 0) return false;
            const int xcd = c & 7, ix = c >> 3;
            if (rset == 0) { u.pm = xcd * 4 + (ix >> 3); u.pn = ix & 7; } else { if (c >= 128) return false; u.pm = 32 + xcd * 2 + (ix >> 3); u.pn = ix & 7; }
            u.k0 = 0; u.nk = nkt; u.role = 0; u.pair = 0; return true;
        }
        if (split) {
            if (i == 0) { map(c, u); return true; }
            if (i == 1) { const int j = (c >> 4) * 8 + (c & 7), half = (c >> 3) & 1; map(G + j, u); u.k0 = half * (nkt / 2); u.nk = nkt / 2; u.role = 1 + half; u.pair = j; return true; }
            return false;
        }
        const long L = (long)i * G + c; if (L >= nwg) return false;
        map(L, u); return true;
    }
    __device__ __forceinline__ void a_ready(const Unit&) const {}
    __device__ __forceinline__ void done(const Unit&) const {}
};

__device__ __forceinline__ unsigned cvt_pk_bf16(float lo, float hi) { unsigned r; asm volatile("v_cvt_pk_bf16_f32 %0, %1, %2" : "=v"(r) : "v"(lo), "v"(hi)); return r; }
typedef float f32x2 __attribute__((ext_vector_type(2)));

struct EpiZ {
    static constexpr bool PERM = true, AFTER_DRAIN = false;
    bf16_t* Z; float* ck; float* cv; int layer;
    __device__ __forceinline__ void operator()(f32x4 (&acc)[2][2][4][2], const Unit& u, int wr, int wc, int fr_in, int fq_in) const {
        int fr = fr_in, fq = fq_in; asm volatile("" : "+v"(fr), "+v"(fq));
        const int row0 = u.pm * BM + wr * 64 + fr; const int col0 = u.pn * BM + wc * 32 + 8 * fq;
#pragma unroll
        for (int ai = 0; ai < 2; ++ai)
#pragma unroll
            for (int m = 0; m < 4; ++m) { bf16_t* rowp = Z + (size_t)(row0 + ai * HALF + m * 16) * DIN + col0;
#pragma unroll
                for (int bj = 0; bj < 2; ++bj) { const f32x4 v0 = acc[ai][bj][m][0], v1 = acc[ai][bj][m][1];
                    u32x4 w; w.x = cvt_pk_bf16(v0[0], v0[1]); w.y = cvt_pk_bf16(v0[2], v0[3]); w.z = cvt_pk_bf16(v1[0], v1[1]); w.w = cvt_pk_bf16(v1[2], v1[3]);
                    *(u32x4*)(rowp + bj * HALF) = w; } }
        if ((u.pn == 4 || u.pn == 5) && u.pm < 32) {
            float* base = (u.pn == 4) ? ck : cv;
#pragma unroll
            for (int ai = 0; ai < 2; ++ai)
#pragma unroll
                for (int m = 0; m < 4; ++m) { const int row = row0 + ai * HALF + m * 16; const int b = row >> 8, s = row & 255;
                    float* p = base + ((size_t)((b * 2 + layer) * 256 + s)) * 256 + (wc * 32 + 8 * fq);
#pragma unroll
                    for (int bj = 0; bj < 2; ++bj) { *(f32x4*)(p + bj * HALF) = acc[ai][bj][m][0]; *(f32x4*)(p + bj * HALF + 4) = acc[ai][bj][m][1]; } }
        }
    }
};
typedef unsigned u32x2v_ __attribute__((ext_vector_type(2)));
struct EpiV {
    static constexpr bool PERM = false, AFTER_DRAIN = false;
    const float* xp; const float* xs; bf16_t* V; const float* gate;
    float* slab; unsigned* flags;
    __device__ __forceinline__ void operator()(f32x4 (&acc)[2][2][4][2], const Unit& u, int wr, int wc, int fr_in, int fq_in) const {
        int fr = fr_in, fq = fq_in; asm volatile("" : "+v"(fr), "+v"(fq));
        const int lane = fq * 16 + fr, tid = (wr * 4 + wc) * 64 + lane;
        float* sp = slab + (size_t)u.pair * 65536 + tid * 4; unsigned* fl = flags + 64 * u.pair;
        if (u.role == 1) {
            { float* q = sp;
#pragma unroll
              for (int ai = 0; ai < 2; ++ai)
#pragma unroll
                for (int m = 0; m < 4; ++m)
#pragma unroll
                    for (int bj = 0; bj < 2; ++bj)
#pragma unroll
                        for (int n = 0; n < 2; ++n) {
                            asm volatile("global_store_dwordx4 %0, %1, off sc1\n\ts_nop 1" :: "v"(q), "v"(acc[ai][bj][m][n]) : "memory");
                            q += 2048; asm volatile("" : "+v"(q)); } }
            asm volatile("s_waitcnt vmcnt(0)" ::: "memory");
            if (lane == 0) __hip_atomic_fetch_add(fl, 1u, __ATOMIC_RELAXED, __HIP_MEMORY_SCOPE_AGENT);
            return;
        }
        const bool red = (u.role == 2);
        if (red) {
            unsigned sp_ = 0;
            while ((unsigned)__builtin_amdgcn_readfirstlane(__hip_atomic_load(fl, __ATOMIC_RELAXED, __HIP_MEMORY_SCOPE_AGENT)) < 8u) { __builtin_amdgcn_s_sleep(2); if (++sp_ > (1u << 20)) break; }
            asm volatile("" ::: "memory");
        }
        const int row0 = u.pm * BM + wr * 64 + fr; const int col0 = u.pn * BM + wc * 32 + 4 * fq;
        const int cond = (u.pm < 32) ? 0 : 1 + ((u.pm - 32) >> 3);
        const float* g = gate + cond * 6144 + col0;
        f32x4 gv[2][2];
#pragma unroll
        for (int bj = 0; bj < 2; ++bj)
#pragma unroll
            for (int n = 0; n < 2; ++n) gv[bj][n] = *(const f32x4*)(g + bj * HALF + n * 16);
        if (!red) {
            f32x4 xq[2][4];
            { const int row = row0; const float* xr = ((row < NCTX) ? xp + (size_t)row * D_MODEL : xs + (size_t)(row - NCTX) * D_MODEL) + col0;
#pragma unroll
              for (int e = 0; e < 4; ++e) xq[0][e] = *(const f32x4*)(xr + (e >> 1) * HALF + (e & 1) * 16); }
#pragma unroll
            for (int g8 = 0; g8 < 8; ++g8) { const int ai = g8 >> 2, m = g8 & 3; const int row = row0 + ai * HALF + m * 16;
                if (g8 + 1 < 8) { const int rown = row0 + ((g8 + 1) >> 2) * HALF + ((g8 + 1) & 3) * 16;
                    const float* xr = ((rown < NCTX) ? xp + (size_t)rown * D_MODEL : xs + (size_t)(rown - NCTX) * D_MODEL) + col0;
#pragma unroll
                    for (int e = 0; e < 4; ++e) xq[(g8 + 1) & 1][e] = *(const f32x4*)(xr + (e >> 1) * HALF + (e & 1) * 16); }
                bf16_t* vr = V + (size_t)row * D_MODEL + col0;
#pragma unroll
                for (int e = 0; e < 4; ++e) { const f32x4 o = xq[g8 & 1][e] * ALPHA_DN + gv[e >> 1][e & 1] * acc[ai][e >> 1][m][e & 1];
                    u32x2v_ w; w.x = cvt_pk_bf16(o[0], o[1]); w.y = cvt_pk_bf16(o[2], o[3]); *(u32x2v_*)(vr + (e >> 1) * HALF + (e & 1) * 16) = w; }
                asm volatile("" ::: "memory"); }
        } else {
            const float* rq = sp;
#pragma unroll
            for (int ai = 0; ai < 2; ++ai)
#pragma unroll
                for (int m = 0; m < 4; ++m) { const int row = row0 + ai * HALF + m * 16;
                    const float* xr = ((row < NCTX) ? xp + (size_t)row * D_MODEL : xs + (size_t)(row - NCTX) * D_MODEL) + col0;
                    bf16_t* vr = V + (size_t)row * D_MODEL + col0;
                    f32x4 t[2][2];
#pragma unroll
                    for (int bj = 0; bj < 2; ++bj)
#pragma unroll
                        for (int n = 0; n < 2; ++n) { const unsigned long long* q8 = (const unsigned long long*)rq;
                            const unsigned long long a8 = __hip_atomic_load(q8, __ATOMIC_RELAXED, __HIP_MEMORY_SCOPE_AGENT), b8 = __hip_atomic_load(q8 + 1, __ATOMIC_RELAXED, __HIP_MEMORY_SCOPE_AGENT);
                            t[bj][n] = (f32x4){__builtin_bit_cast(float, (unsigned)a8), __builtin_bit_cast(float, (unsigned)(a8 >> 32)), __builtin_bit_cast(float, (unsigned)b8), __builtin_bit_cast(float, (unsigned)(b8 >> 32))};
                            rq += 2048; asm volatile("" : "+v"(rq)); }
#pragma unroll
                    for (int bj = 0; bj < 2; ++bj)
#pragma unroll
                        for (int n = 0; n < 2; ++n) { const f32x4 xv = *(const f32x4*)(xr + bj * HALF + n * 16); const f32x4 o = xv * ALPHA_DN + gv[bj][n] * (acc[ai][bj][m][n] + t[bj][n]);
                            u32x2v_ w; w.x = cvt_pk_bf16(o[0], o[1]); w.y = cvt_pk_bf16(o[2], o[3]); *(u32x2v_*)(vr + bj * HALF + n * 16) = w; }
                    asm volatile("" ::: "memory"); }
        }
    }
};
template <class Epi, class Sched, bool ALIGN_EPI = false, bool SP2 = false>
__device__ __forceinline__ void gemm_phase(PG8_LAS unsigned char* lds, const Gemm g, const Sched& S, const Epi& E, int tid_in) {
    int tid_l = tid_in; asm volatile("" : "+v"(tid_l));
    const int tid = tid_l, wid = __builtin_amdgcn_readfirstlane(tid >> 6), lane = tid & 63, wr = wid >> 2, wc = wid & 3, fr = lane & 15, fq = lane >> 4;
    const int K = g.K;
    unsigned voffA[2], voffB[2];
#pragma unroll
    for (int i = 0; i < 2; ++i) { int R, C; stage_rc(tid * 16 + i * 8192, R, C); const int Rb = Epi::PERM ? ((R & ~31) + perm32(R & 31)) : R;
        voffA[i] = (unsigned)(R * K + C) * 2u; voffB[i] = (unsigned)(Rb * K + C) * 2u; }
    const size_t kstep = (size_t)(BK * 2);
    const size_t hstep = (size_t)HALF * K * 2;
    const size_t tstep = 2 * hstep;
    const unsigned ldsw = (unsigned)wid * 1024u;
    const int aoff = lds_byte(wr * 64 + fr, fq * 8), boff = lds_byte(wc * 32 + fr, fq * 8);
#define PG8_SA(b, h) (((b) * 2 + (h)) * HTB)
#define PG8_SB(b, h) ((4 + (b) * 2 + (h)) * HTB)
#define PG8_STAGE(bufoff, gbase, voff) do { _Pragma("unroll") for (int _i = 0; _i < 2; ++_i) \
        __builtin_amdgcn_global_load_lds((const unsigned*)((const char*)(gbase) + (voff)[_i]), (PG8_LAS unsigned*)(lds + (bufoff) + ldsw + _i * 8192), 16, 0, 0); } while (0)
#define PG8_LDA(dst, b, h) do { _Pragma("unroll") for (int m = 0; m < 4; ++m) _Pragma("unroll") for (int k = 0; k < 2; ++k) dst[m][k] = *(const PG8_LAS bf16x8*)(lds + PG8_SA(b, h) + aoff + m * 2048 + k * 1024); } while (0)
#define PG8_LDB(dst, b, h) do { _Pragma("unroll") for (int n = 0; n < 2; ++n) _Pragma("unroll") for (int k = 0; k < 2; ++k) dst[n][k] = *(const PG8_LAS bf16x8*)(lds + PG8_SB(b, h) + boff + n * 2048 + k * 1024); } while (0)
#define PG8_MMA(ai, bj, At, Bt) do { __builtin_amdgcn_s_setprio(1); _Pragma("unroll") for (int m = 0; m < 4; ++m) _Pragma("unroll") for (int n = 0; n < 2; ++n) _Pragma("unroll") for (int k = 0; k < 2; ++k) \
        acc[ai][bj][m][n] = __builtin_amdgcn_mfma_f32_16x16x32_bf16(Bt[n][k], At[m][k], acc[ai][bj][m][n], 0, 0, 0); __builtin_amdgcn_s_setprio(0); } while (0)
#define PG8_WAIT_V(n) asm volatile("s_waitcnt vmcnt(" #n ")" ::: "memory")
#define PG8_WAIT_L(n) asm volatile("s_waitcnt lgkmcnt(" #n ")" ::: "memory")
#define PG8_BAR __builtin_amdgcn_s_barrier()
#define PG8_SCHED __builtin_amdgcn_sched_barrier(0)
    Unit cur, nxt; int ui = 0;
    if (!S.next(0, cur)) return;
    f32x4 acc[2][2][4][2];
#pragma unroll
    for (int a = 0; a < 2; ++a)
#pragma unroll
        for (int b = 0; b < 2; ++b)
#pragma unroll
            for (int m = 0; m < 4; ++m)
#pragma unroll
                for (int n = 0; n < 2; ++n) acc[a][b][m][n] = (f32x4){0.f, 0.f, 0.f, 0.f};
    bf16x8 At[4][2], B0[2][2], B1[2][2];
    const char* cA = (const char*)g.A + (size_t)cur.pm * tstep + (size_t)cur.k0 * kstep; const char* cB = (const char*)g.Bt + (size_t)cur.pn * tstep + (size_t)cur.k0 * kstep;
    S.a_ready(cur);
    if constexpr (SP2) {
        PG8_STAGE(PG8_SB(0, 0), cB, voffB); PG8_STAGE(PG8_SB(0, 1), cB + hstep, voffB); PG8_STAGE(PG8_SA(0, 0), cA, voffA); PG8_STAGE(PG8_SA(0, 1), cA + hstep, voffA);
        if (wr == 1) PG8_BAR;
        PG8_WAIT_V(2); PG8_BAR;
        PG8_STAGE(PG8_SB(1, 0), cB + kstep, voffB); PG8_STAGE(PG8_SA(1, 0), cA + kstep, voffA); PG8_STAGE(PG8_SB(1, 1), cB + hstep + kstep, voffB);
        PG8_WAIT_V(6); PG8_BAR;
    } else {
        PG8_STAGE(PG8_SB(0, 0), cB, voffB); PG8_STAGE(PG8_SA(0, 0), cA, voffA); PG8_STAGE(PG8_SB(0, 1), cB + hstep, voffB); PG8_STAGE(PG8_SA(0, 1), cA + hstep, voffA);
        if (wr == 1) PG8_BAR;
        PG8_WAIT_V(4); PG8_BAR;
        PG8_STAGE(PG8_SB(1, 0), cB + kstep, voffB); PG8_STAGE(PG8_SA(1, 0), cA + kstep, voffA); PG8_STAGE(PG8_SB(1, 1), cB + hstep + kstep, voffB);
        PG8_WAIT_V(6); PG8_BAR;
    }
    for (;;) {
        const bool has_next = S.next(ui + 1, nxt);
        const char* nA = has_next ? (const char*)g.A + (size_t)nxt.pm * tstep + (size_t)nxt.k0 * kstep : cA; const char* nB = has_next ? (const char*)g.Bt + (size_t)nxt.pn * tstep + (size_t)nxt.k0 * kstep : cB;
        const int nt = cur.nk;
        for (int t = 0; t < nt; t += 2) {
            const bool last = (t == nt - 2);
            const char* a1 = cA + (size_t)(t + 1) * kstep;
            const char* a2 = last ? nA : cA + (size_t)(t + 2) * kstep; const char* b2 = last ? nB : cB + (size_t)(t + 2) * kstep;
            const char* a3 = a2 + kstep; const char* b3 = b2 + kstep;
            if (last && has_next) S.a_ready(nxt);
            if constexpr (SP2) {
            PG8_LDB(B0, 0, 0); PG8_LDB(B1, 0, 1); PG8_SCHED; PG8_LDA(At, 0, 0); PG8_STAGE(PG8_SA(1, 1), a1 + hstep, voffA);
            PG8_WAIT_V(8); PG8_WAIT_L(0); PG8_BAR; PG8_MMA(0, 0, At, B0); PG8_MMA(0, 1, At, B1); PG8_BAR; PG8_SCHED;
            PG8_LDA(At, 0, 1); PG8_STAGE(PG8_SB(0, 0), b2, voffB); PG8_STAGE(PG8_SB(0, 1), b2 + hstep, voffB); PG8_STAGE(PG8_SA(0, 0), a2, voffA);
            PG8_WAIT_V(8); PG8_WAIT_L(0); PG8_BAR; PG8_MMA(1, 0, At, B0); PG8_MMA(1, 1, At, B1); PG8_BAR; PG8_SCHED;
            PG8_LDB(B0, 1, 0); PG8_LDB(B1, 1, 1); PG8_SCHED; PG8_LDA(At, 1, 0); PG8_STAGE(PG8_SA(0, 1), a2 + hstep, voffA);
            PG8_WAIT_V(8); PG8_WAIT_L(0); PG8_BAR; PG8_MMA(0, 0, At, B0); PG8_MMA(0, 1, At, B1); PG8_BAR; PG8_SCHED;
            PG8_LDA(At, 1, 1); PG8_STAGE(PG8_SB(1, 0), b3, voffB); PG8_STAGE(PG8_SB(1, 1), b3 + hstep, voffB); PG8_STAGE(PG8_SA(1, 0), a3, voffA);
            PG8_WAIT_V(8); PG8_WAIT_L(0); PG8_BAR; PG8_MMA(1, 0, At, B0); PG8_MMA(1, 1, At, B1); PG8_BAR; PG8_SCHED;
            } else {
            PG8_LDB(B0, 0, 0); PG8_SCHED; PG8_LDA(At, 0, 0); PG8_STAGE(PG8_SA(1, 1), a1 + hstep, voffA);
            PG8_WAIT_L(8); PG8_BAR; PG8_WAIT_L(0); PG8_MMA(0, 0, At, B0); PG8_BAR; PG8_SCHED;
            PG8_LDB(B1, 0, 1); PG8_STAGE(PG8_SB(0, 0), b2, voffB);
            PG8_BAR; PG8_WAIT_L(0); PG8_MMA(0, 1, At, B1); PG8_BAR;
            PG8_LDA(At, 0, 1); PG8_STAGE(PG8_SA(0, 0), a2, voffA);
            PG8_BAR; PG8_WAIT_L(0); PG8_MMA(1, 0, At, B0); PG8_BAR; PG8_SCHED;
            PG8_STAGE(PG8_SB(0, 1), b2 + hstep, voffB);
            PG8_WAIT_V(6); PG8_BAR; PG8_MMA(1, 1, At, B1); PG8_BAR;
            PG8_LDB(B0, 1, 0); PG8_SCHED; PG8_LDA(At, 1, 0); PG8_STAGE(PG8_SA(0, 1), a2 + hstep, voffA);
            PG8_WAIT_L(8); PG8_BAR; PG8_WAIT_L(0); PG8_MMA(0, 0, At, B0); PG8_BAR; PG8_SCHED;
            PG8_LDB(B1, 1, 1); PG8_STAGE(PG8_SB(1, 0), b3, voffB);
            PG8_BAR; PG8_WAIT_L(0); PG8_MMA(0, 1, At, B1); PG8_BAR;
            PG8_LDA(At, 1, 1); PG8_STAGE(PG8_SA(1, 0), a3, voffA);
            PG8_BAR; PG8_WAIT_L(0); PG8_MMA(1, 0, At, B0); PG8_BAR; PG8_SCHED;
            PG8_STAGE(PG8_SB(1, 1), b3 + hstep, voffB);
            PG8_WAIT_V(6); PG8_BAR; PG8_MMA(1, 1, At, B1); PG8_BAR;
            }
        }
        if constexpr (ALIGN_EPI) { if (wr == 0) PG8_BAR; }
        if constexpr (!Epi::AFTER_DRAIN) { E(acc, cur, wr, wc, fr, fq); S.done(cur); }
        if (!has_next) break;
#pragma unroll
        for (int a = 0; a < 2; ++a)
#pragma unroll
            for (int b = 0; b < 2; ++b)
#pragma unroll
                for (int m = 0; m < 4; ++m)
#pragma unroll
                    for (int n = 0; n < 2; ++n) acc[a][b][m][n] = (f32x4){0.f, 0.f, 0.f, 0.f};
        cur = nxt; cA = nA; cB = nB; ++ui;
        if constexpr (ALIGN_EPI) { if (wr == 1) PG8_BAR; }
    }
    PG8_WAIT_V(0);
    if constexpr (!ALIGN_EPI) { if (wr == 0) PG8_BAR; }
    PG8_BAR;
    if constexpr (Epi::AFTER_DRAIN) { E.fused(acc, cur, wr, wc, fr, fq, lds, wid, lane); S.done(cur); }
#undef PG8_SA
#undef PG8_SB
#undef PG8_STAGE
#undef PG8_LDA
#undef PG8_LDB
#undef PG8_MMA
#undef PG8_WAIT_V
#undef PG8_WAIT_L
#undef PG8_BAR
#undef PG8_SCHED
}
}

constexpr size_t MiB = 1u << 20;
constexpr size_t WS_CTL = 0, CTL_ZERO_BYTES = 262144;
constexpr size_t WS_MOD = 1 * MiB;
constexpr size_t WS_CS = 1 * MiB + 192 * 1024;
constexpr size_t WS_DLOG = 1 * MiB + 256 * 1024;
constexpr size_t WS_WTOUT = 2 * MiB;
constexpr size_t WS_WTIN = 18 * MiB;
constexpr size_t WS_H = 44 * MiB;
constexpr size_t WS_Z = 92 * MiB;
constexpr size_t WS_U = 248 * MiB;
constexpr size_t WS_OL = 264 * MiB;
constexpr size_t WS_CKV = 312 * MiB;
constexpr size_t WS_END = 313 * MiB;
constexpr int LDS_BYTES = 163840;
constexpr int LDS_CTLW = 163840 - 256;
constexpr int NWAVES = 8, NTHREADS = 512;

#define LAS __attribute__((address_space(3)))
typedef unsigned short bf16;
typedef float f32x4 __attribute__((ext_vector_type(4)));
typedef float f32x16 __attribute__((ext_vector_type(16)));
typedef unsigned u32x4 __attribute__((ext_vector_type(4)));
typedef unsigned u32x2 __attribute__((ext_vector_type(2)));
typedef short bf16x8 __attribute__((ext_vector_type(8)));

__device__ __forceinline__ float bf2f(unsigned short u) { return __builtin_bit_cast(float, (unsigned)u << 16); }
__device__ __forceinline__ float bflo(unsigned u) { return __builtin_bit_cast(float, u << 16); }
__device__ __forceinline__ float bfhi(unsigned u) { return __builtin_bit_cast(float, u & 0xffff0000u); }
typedef float f32x2_t_ __attribute__((ext_vector_type(2))); typedef __bf16 bf16x2_t_ __attribute__((ext_vector_type(2)));
__device__ __forceinline__ unsigned pk2(float lo, float hi) { const f32x2_t_ v = {lo, hi}; return __builtin_bit_cast(unsigned, __builtin_convertvector(v, bf16x2_t_)); }
__device__ __forceinline__ unsigned f2bf(float f) { return pk2(f, f) & 0xffffu; }
__device__ __forceinline__ float sigmoidf_(float x) { return __builtin_amdgcn_rcpf(1.0f + __builtin_amdgcn_exp2f(-1.4426950408889634f * x)); }
__device__ __forceinline__ float siluf_(float x) { return x * __builtin_amdgcn_rcpf(1.0f + __builtin_amdgcn_exp2f(-1.4426950408889634f * x)); }
__device__ __forceinline__ float dpp_add_(float v, const int ctrl_sel) {
    const int x = __builtin_bit_cast(int, v); int y;
    if (ctrl_sel == 0) y = __builtin_amdgcn_update_dpp(0, x, 0xB1, 0xf, 0xf, true);
    else if (ctrl_sel == 1) y = __builtin_amdgcn_update_dpp(0, x, 0x4E, 0xf, 0xf, true);
    else if (ctrl_sel == 2) y = __builtin_amdgcn_update_dpp(0, x, 0x141, 0xf, 0xf, true);
    else y = __builtin_amdgcn_update_dpp(0, x, 0x140, 0xf, 0xf, true);
    return v + __builtin_bit_cast(float, y);
}
__device__ __forceinline__ float wave_sum(float v) {
    v = dpp_add_(v, 0); v = dpp_add_(v, 1); v = dpp_add_(v, 2); v = dpp_add_(v, 3);
    const float r0 = __builtin_bit_cast(float, __builtin_amdgcn_readlane(__builtin_bit_cast(int, v), 0)), r1 = __builtin_bit_cast(float, __builtin_amdgcn_readlane(__builtin_bit_cast(int, v), 16));
    const float r2 = __builtin_bit_cast(float, __builtin_amdgcn_readlane(__builtin_bit_cast(int, v), 32)), r3 = __builtin_bit_cast(float, __builtin_amdgcn_readlane(__builtin_bit_cast(int, v), 48));
    return (r0 + r1) + (r2 + r3);
}

struct Params {
    const float* in[20];
    float* out; unsigned char* ws;
};
typedef const __attribute__((address_space(4))) Params* PP;

__device__ __forceinline__ int next_unit(unsigned* ctr, volatile LAS unsigned* slot, int tid) {
    __syncthreads();
    if (tid == 0) *slot = __hip_atomic_fetch_add(ctr, 1u, __ATOMIC_RELAXED, __HIP_MEMORY_SCOPE_AGENT);
    __syncthreads();
    return (int)*slot;
}
__device__ __forceinline__ int q_pop(unsigned* ctr, volatile LAS unsigned* slot, int tid, int& pend, int pf_from) {
    __syncthreads();
    if (tid == 0) { const int cur = (pend >= 0) ? pend : (int)__hip_atomic_fetch_add(ctr, 1u, __ATOMIC_RELAXED, __HIP_MEMORY_SCOPE_AGENT);
        *slot = (unsigned)cur; pend = (cur >= pf_from) ? (int)__hip_atomic_fetch_add(ctr, 1u, __ATOMIC_RELAXED, __HIP_MEMORY_SCOPE_AGENT) : -1; }
    __syncthreads();
    return (int)*slot;
}
__device__ __forceinline__ void transpose_item(const float* W, int K, int N, bf16* WT, LAS float* scr, int item, int lane) {
    const int nblk = N / 32, kb = item / nblk, nb = item % nblk, k0 = 64 * kb, n0 = 32 * nb;
    float wv[32];
    const float* wp = W + (size_t)(k0 + (lane >> 5)) * N + n0 + (lane & 31);
#pragma unroll
    for (int i = 0; i < 32; ++i) wv[i] = wp[(size_t)(2 * i) * N];
    __builtin_amdgcn_sched_barrier(0);
#pragma unroll
    for (int i = 0; i < 32; ++i) { const int kk = 2 * i + (lane >> 5); scr[kk * 33 + (lane & 31)] = wv[i]; }
    asm volatile("s_waitcnt lgkmcnt(0)" ::: "memory");
    const int c = lane & 7;
#pragma unroll
    for (int j = 0; j < 4; ++j) { const int n = (lane >> 3) + 8 * j; const LAS float* s = scr + (8 * c) * 33 + n;
        u32x4 o; o.x = pk2(s[0 * 33], s[1 * 33]); o.y = pk2(s[2 * 33], s[3 * 33]); o.z = pk2(s[4 * 33], s[5 * 33]); o.w = pk2(s[6 * 33], s[7 * 33]);
        *(u32x4*)(WT + (size_t)(n0 + n) * K + k0 + 8 * c) = o; }
    asm volatile("s_waitcnt lgkmcnt(0)" ::: "memory");
}

__device__ __forceinline__ void mod_unit(PP P, LAS float* lds, int l, int nc, int tid) {
    const float* c = P->in[5]; const float* cctx = P->in[6]; const float* aw = P->in[7] + (size_t)l * 2048 * 6144; const float* ab = P->in[8] + l * 6144;
    LAS float* sc = lds;
    LAS float* red = lds + 3 * 2048;
    for (int i = tid; i < 3 * 2048; i += NTHREADS) { const int j = i >> 11, k = i & 2047; const float v = (j == 0) ? cctx[k] : c[(j - 1) * 2048 + k]; sc[i] = siluf_(v); }
    __syncthreads();
    const int tn = tid & 7, tk = tid >> 3, n0 = nc * 32 + 4 * tn;
    float a[3][4] = {};
    for (int k8 = 0; k8 < 32; k8 += 16) {
        f32x4 w[16];
#pragma unroll
        for (int kk = 0; kk < 16; ++kk) w[kk] = *(const f32x4*)(aw + (size_t)(tk * 32 + k8 + kk) * 6144 + n0);
        __builtin_amdgcn_sched_barrier(0);
#pragma unroll
        for (int kk = 0; kk < 16; ++kk) { const int k = tk * 32 + k8 + kk;
#pragma unroll
            for (int j = 0; j < 3; ++j) { const float s = sc[j * 2048 + k]; a[j][0] += s * w[kk][0]; a[j][1] += s * w[kk][1]; a[j][2] += s * w[kk][2]; a[j][3] += s * w[kk][3]; } }
    }
#pragma unroll
    for (int j = 0; j < 3; ++j)
#pragma unroll
        for (int e = 0; e < 4; ++e) red[(tk * 8 + tn) * 12 + j * 4 + e] = a[j][e];
    __syncthreads();
    if (tid < 96) { const int tn2 = tid / 12, je = tid % 12; float s = 0.f; for (int t = 0; t < 64; ++t) s += red[(t * 8 + tn2) * 12 + je];
        const int j = je >> 2, e = je & 3, n = nc * 32 + 4 * tn2 + e;
        ((float*)(P->ws + WS_MOD))[(l * 3 + j) * 6144 + n] = s + ab[n]; }
    __syncthreads();
}

__device__ __forceinline__ void hprep_row(const float* xrow, const float* mod  , bf16* hrow, int lane) {
#pragma unroll
    for (int j = 0; j < 8; ++j) { const int c = 4 * lane + 256 * j; const f32x4 x = *(const f32x4*)(xrow + c), sh = *(const f32x4*)(mod + c), sc = *(const f32x4*)(mod + 2048 + c);
        const f32x4 h = x * (sc + 1.0f) + sh; u32x2 o; o.x = pk2(h[0], h[1]); o.y = pk2(h[2], h[3]); *(u32x2*)(hrow + c) = o; }
}
template <bool WITH_H>
__device__ __forceinline__ void ln_row_t(const bf16* vsrc, float* yrow, const float* w, const float* b, const float* modn, bf16* hrow, int lane_in) {
    int lane = lane_in; asm volatile("" : "+v"(lane));
    f32x4 v[8], pw[8], pb[8]; float s = 0.f;
#pragma unroll
    for (int j = 0; j < 8; ++j) { const u32x2 r = *(const u32x2*)(vsrc + 4 * lane + 256 * j); v[j] = (f32x4){bflo(r.x), bfhi(r.x), bflo(r.y), bfhi(r.y)}; }
#pragma unroll
    for (int j = 0; j < 8; ++j) { pw[j] = *(const f32x4*)(w + 4 * lane + 256 * j); pb[j] = *(const f32x4*)(b + 4 * lane + 256 * j); }
#pragma unroll
    for (int j = 0; j < 8; ++j) s += (v[j][0] + v[j][1]) + (v[j][2] + v[j][3]);
    const float mean = wave_sum(s) * (1.0f / 2048.0f); float q = 0.f;
#pragma unroll
    for (int j = 0; j < 8; ++j) { v[j] = v[j] - mean; q += (v[j][0] * v[j][0] + v[j][1] * v[j][1]) + (v[j][2] * v[j][2] + v[j][3] * v[j][3]); }
    const float rstd = __builtin_amdgcn_rsqf(wave_sum(q) * (1.0f / 2048.0f) + 1e-5f);
#pragma unroll
    for (int j = 0; j < 8; ++j) { v[j] = v[j] * rstd * pw[j] + pb[j]; *(f32x4*)(yrow + 4 * lane + 256 * j) = v[j]; }
    if (WITH_H) {
#pragma unroll
        for (int j = 0; j < 8; ++j) { pw[j] = *(const f32x4*)(modn + 4 * lane + 256 * j); pb[j] = *(const f32x4*)(modn + 2048 + 4 * lane + 256 * j); }
#pragma unroll
        for (int j = 0; j < 8; ++j) { const f32x4 h = v[j] * (pb[j] + 1.0f) + pw[j]; u32x2 o; o.x = pk2(h[0], h[1]); o.y = pk2(h[2], h[3]); *(u32x2*)(hrow + 4 * lane + 256 * j) = o; }
    }
}
__device__ __forceinline__ void ln_row(const bf16* vsrc, float* yrow, const float* w, const float* b, const float* modn, bf16* hrow, int lane) {
    if (hrow) ln_row_t<true>(vsrc, yrow, w, b, modn, hrow, lane); else ln_row_t<false>(vsrc, yrow, w, b, modn, hrow, lane);
}

typedef float f32x2 __attribute__((ext_vector_type(2)));
__device__ __forceinline__ void conv_unit(PP P, LAS float* lds, int l, int unit, int tid) {
    const int lane = tid & 63, wave = tid >> 6;
    const bf16* Z = (const bf16*)(P->ws + WS_Z); bf16* MIX = (bf16*)(P->ws + WS_H);
    const int t0 = unit * 32;
    int s0, s1; if (t0 < NCTX) { s0 = t0 & ~255; s1 = s0 + 256; } else { s0 = NCTX + ((t0 - NCTX) & ~2047); s1 = s0 + 2048; }
    const int c2 = 2 * (tid & 255), tb = t0 + 16 * (tid >> 8);
    u32x4 gq[4];
#pragma unroll
    for (int k = 0; k < 4; ++k) gq[k] = *(const u32x4*)(Z + (size_t)(t0 + 4 * wave + k) * DIN + C_CG + 8 * lane);
    const float* lw = P->in[16] + l * 512 + 8 * lane; const float* lb = P->in[17] + l * 512 + 8 * lane;
    const f32x4 w0 = *(const f32x4*)lw, w1 = *(const f32x4*)(lw + 4), b0 = *(const f32x4*)lb, b1 = *(const f32x4*)(lb + 4);
    f32x2 u[46];
#pragma unroll
    for (int hb = 0; hb < 2; ++hb) {
        unsigned ra[23], rb[23];
#pragma unroll
        for (int r = 0; r < 23; ++r) { const int row = tb - 15 + 23 * hb + r; const int rc = row < s0 ? s0 : (row >= s1 ? s1 - 1 : row);
            ra[r] = *(const unsigned*)(Z + (size_t)rc * DIN + C_CA + c2); rb[r] = *(const unsigned*)(Z + (size_t)rc * DIN + C_CB + c2); }
        __builtin_amdgcn_sched_barrier(0);
#pragma unroll
        for (int r = 0; r < 23; ++r) { const int row = tb - 15 + 23 * hb + r; const bool ok = (row >= s0 && row < s1);
            const f32x2 a = {bflo(ra[r]), bfhi(ra[r])}; const f32x2 g = {sigmoidf_(bflo(rb[r])), sigmoidf_(bfhi(rb[r]))};
            const f32x2 v = a * g; u[23 * hb + r] = ok ? v : (f32x2){0.f, 0.f}; }
    }
    f32x2 acc[16]; const f32x2 bias = *(const f32x2*)(P->in[15] + l * 512 + c2);
#pragma unroll
    for (int i = 0; i < 16; ++i) acc[i] = bias;
    const float* cw = P->in[14] + (size_t)l * 31 * 512 + c2;
#pragma unroll
    for (int j = 0; j < 31; ++j) { const f32x2 w = *(const f32x2*)(cw + j * 512);
#pragma unroll
        for (int i = 0; i < 16; ++i) acc[i] += u[i + j] * w; }
    LAS float* yb = lds;
#pragma unroll
    for (int i = 0; i < 16; ++i) *(LAS f32x2*)(yb + (16 * (tid >> 8) + i) * 512 + c2) = acc[i];
    __syncthreads();
#pragma unroll
    for (int k = 0; k < 4; ++k) { const int ti = wave * 4 + k, row = t0 + ti;
        f32x4 a = *(const LAS f32x4*)(yb + ti * 512 + 8 * lane), b = *(const LAS f32x4*)(yb + ti * 512 + 8 * lane + 4);
        float s = (a[0] + a[1]) + (a[2] + a[3]) + (b[0] + b[1]) + (b[2] + b[3]);
        const float mean = wave_sum(s) * (1.0f / 512.0f); a = a - mean; b = b - mean;
        float q = (a[0] * a[0] + a[1] * a[1]) + (a[2] * a[2] + a[3] * a[3]) + (b[0] * b[0] + b[1] * b[1]) + (b[2] * b[2] + b[3] * b[3]);
        const float rstd = __builtin_amdgcn_rsqf(wave_sum(q) * (1.0f / 512.0f) + 1e-5f);
        a = a * rstd * w0 + b0; b = b * rstd * w1 + b1;
        const u32x4 g = gq[k];
        float o[8];
        o[0] = siluf_(a[0]) * siluf_(bflo(g.x)); o[1] = siluf_(a[1]) * siluf_(bfhi(g.x)); o[2] = siluf_(a[2]) * siluf_(bflo(g.y)); o[3] = siluf_(a[3]) * siluf_(bfhi(g.y));
        o[4] = siluf_(b[0]) * siluf_(bflo(g.z)); o[5] = siluf_(b[1]) * siluf_(bfhi(g.z)); o[6] = siluf_(b[2]) * siluf_(bflo(g.w)); o[7] = siluf_(b[3]) * siluf_(bfhi(g.w));
        u32x4 w; w.x = pk2(o[0], o[1]); w.y = pk2(o[2], o[3]); w.z = pk2(o[4], o[5]); w.w = pk2(o[6], o[7]);
        *(u32x4*)(MIX + (size_t)row * D_MODEL + 1536 + 8 * lane) = w; }
}

typedef short v4i16_t __attribute__((ext_vector_type(4)));
#define SBAR __builtin_amdgcn_sched_barrier(0);
#define R0(i) (((i) & 3) + 8 * ((i) >> 2))
constexpr float ATT_C2 = 0.08838834764831845f * 1.4426950408889634f;
constexpr float LOG2E = 1.4426950408889634f;
constexpr int KROW = 272, VROW = 320, ATT_V_OFF = 64 * KROW;

__device__ __forceinline__ bf16x8 trpair(const LAS unsigned char* p, int second_off) {
    const v4i16_t lo = __builtin_amdgcn_ds_read_tr16_b64_v4i16((LAS v4i16_t*)p), hi = __builtin_amdgcn_ds_read_tr16_b64_v4i16((LAS v4i16_t*)(p + second_off));
    return (bf16x8){lo[0], lo[1], lo[2], lo[3], hi[0], hi[1], hi[2], hi[3]};
}
__device__ __forceinline__ bf16x8 pack8(float a, float b, float c, float d, float e, float f, float g, float h) {
    const u32x4 w = {pk2(a, b), pk2(c, d), pk2(e, f), pk2(g, h)}; return __builtin_bit_cast(bf16x8, w);
}
__device__ __forceinline__ void rope8(bf16x8& a, bf16x8& b, const float* cs) {
    float ra[8], rb[8];
#pragma unroll
    for (int j = 0; j < 8; ++j) { const float x1 = bf2f((unsigned short)a[j]), x2 = bf2f((unsigned short)b[j]), c = cs[2 * j], s = cs[2 * j + 1]; ra[j] = x1 * c - x2 * s; rb[j] = x2 * c + x1 * s; }
    a = pack8(ra[0], ra[1], ra[2], ra[3], ra[4], ra[5], ra[6], ra[7]); b = pack8(rb[0], rb[1], rb[2], rb[3], rb[4], rb[5], rb[6], rb[7]);
}
__device__ __forceinline__ void rope8l(bf16x8& a, bf16x8& b, const LAS float* cs) {
    const f32x4 c0 = *(const LAS f32x4*)cs, c1 = *(const LAS f32x4*)(cs + 4), c2 = *(const LAS f32x4*)(cs + 8), c3 = *(const LAS f32x4*)(cs + 12);
    const float cc[8] = {c0[0], c0[2], c1[0], c1[2], c2[0], c2[2], c3[0], c3[2]}, sn[8] = {c0[1], c0[3], c1[1], c1[3], c2[1], c2[3], c3[1], c3[3]};
    float ra[8], rb[8];
#pragma unroll
    for (int j = 0; j < 8; ++j) { const float x1 = bf2f((unsigned short)a[j]), x2 = bf2f((unsigned short)b[j]); ra[j] = x1 * cc[j] - x2 * sn[j]; rb[j] = x2 * cc[j] + x1 * sn[j]; }
    a = pack8(ra[0], ra[1], ra[2], ra[3], ra[4], ra[5], ra[6], ra[7]); b = pack8(rb[0], rb[1], rb[2], rb[3], rb[4], rb[5], rb[6], rb[7]);
}
__device__ __forceinline__ bf16x8 cvt8(const float* p) {
    const f32x4 a = *(const f32x4*)p, b = *(const f32x4*)(p + 4);
    return pack8(a[0], a[1], a[2], a[3], b[0], b[1], b[2], b[3]);
}

typedef _Float16 f16x8_t_ __attribute__((ext_vector_type(8)));
__device__ __forceinline__ void rope8h(u32x4& a, u32x4& b, const LAS unsigned char* cs) {
    const f16x8_t_ t0 = *(const LAS f16x8_t_*)cs, t1 = *(const LAS f16x8_t_*)(cs + 16);
    float ra[8], rb[8];
#pragma unroll
    for (int j = 0; j < 8; ++j) { const unsigned wa = a[j >> 1], wb = b[j >> 1]; const float x1 = (j & 1) ? bfhi(wa) : bflo(wa), x2 = (j & 1) ? bfhi(wb) : bflo(wb);
        const float c = (float)((j < 4) ? t0[2 * j] : t1[2 * (j - 4)]), sn = (float)((j < 4) ? t0[2 * j + 1] : t1[2 * (j - 4) + 1]);
        ra[j] = x1 * c - x2 * sn; rb[j] = x2 * c + x1 * sn; }
    a = (u32x4){pk2(ra[0], ra[1]), pk2(ra[2], ra[3]), pk2(ra[4], ra[5]), pk2(ra[6], ra[7])}; b = (u32x4){pk2(rb[0], rb[1]), pk2(rb[2], rb[3]), pk2(rb[4], rb[5]), pk2(rb[6], rb[7])};
}
constexpr int AT_BUF = 75776, AT_V = 34816, AT_ROPE = 151552;
__device__ __forceinline__ void attn_tile(const LAS unsigned char* kt, const LAS unsigned char* vt, const bf16x8 (&qf)[8], f32x16 (&O)[4], float& m, float& lsum,
                                          bool local, int tk0, int qpos, int lane) {
    const int r32 = lane & 31, hh = lane >> 5, i16 = lane & 15;
    f32x16 p0, p1;
#pragma unroll
    for (int i = 0; i < 16; ++i) { p0[i] = 0.f; p1[i] = 0.f; }
    const LAS unsigned char* kb = kt + r32 * KROW + 16 * hh;
#pragma unroll
    for (int s = 0; s < 8; ++s) { const bf16x8 kf0 = *(const LAS bf16x8*)(kb + 32 * s), kf1 = *(const LAS bf16x8*)(kb + 32 * KROW + 32 * s);
        p0 = __builtin_amdgcn_mfma_f32_32x32x16_bf16(kf0, qf[s], p0, 0, 0, 0); p1 = __builtin_amdgcn_mfma_f32_32x32x16_bf16(kf1, qf[s], p1, 0, 0, 0); }
    const LAS unsigned char* vb = vt + (4 * hh + (i16 >> 2)) * VROW + (16 * ((lane >> 4) & 1) + 4 * (i16 & 3)) * 2;
    bf16x8 vfa[4], vfb[4];
#pragma unroll
    for (int ks = 0; ks < 4; ++ks) vfa[ks] = trpair(vb + (16 * ks) * VROW, 8 * VROW);
    float mx = -3e38f;
    if (local) { const unsigned mb = (unsigned)(qpos - tk0 - 4 * hh + 128);
#pragma unroll
        for (int i = 0; i < 16; ++i) { const unsigned d0 = mb - (unsigned)R0(i), d1 = d0 - 32u;
            p0[i] = (d0 <= 256u) ? p0[i] : -1e30f; p1[i] = (d1 <= 256u) ? p1[i] : -1e30f; } }
#pragma unroll
    for (int i = 0; i < 16; ++i) mx = fmaxf(mx, fmaxf(p0[i], p1[i]));
    mx = fmaxf(mx, __shfl_xor(mx, 32)) * ATT_C2;
    const float mn = fmaxf(m, mx), alpha = __builtin_amdgcn_exp2f(m - mn); m = mn;
    float ps = 0.f;
#pragma unroll
    for (int i = 0; i < 16; ++i) { p0[i] = __builtin_amdgcn_exp2f(__builtin_fmaf(p0[i], ATT_C2, -mn)); p1[i] = __builtin_amdgcn_exp2f(__builtin_fmaf(p1[i], ATT_C2, -mn)); ps += p0[i] + p1[i]; }
    lsum = lsum * alpha + ps;
    if (__builtin_amdgcn_ballot_w64(alpha != 1.0f) != 0ull) {
#pragma unroll
        for (int d = 0; d < 4; ++d)
#pragma unroll
            for (int i = 0; i < 16; ++i) O[d][i] *= alpha;
    }
    bf16x8 pb[4];
#pragma unroll
    for (int s = 0; s < 2; ++s) { pb[s] = pack8(p0[8 * s], p0[8 * s + 1], p0[8 * s + 2], p0[8 * s + 3], p0[8 * s + 4], p0[8 * s + 5], p0[8 * s + 6], p0[8 * s + 7]);
        pb[2 + s] = pack8(p1[8 * s], p1[8 * s + 1], p1[8 * s + 2], p1[8 * s + 3], p1[8 * s + 4], p1[8 * s + 5], p1[8 * s + 6], p1[8 * s + 7]); }
#pragma unroll
    for (int dt = 0; dt < 4; ++dt) {
        if (dt + 1 < 4) {
#pragma unroll
            for (int ks = 0; ks < 4; ++ks) { const bf16x8 t_ = trpair(vb + (16 * ks) * VROW + 64 * (dt + 1), 8 * VROW); if (dt & 1) vfa[ks] = t_; else vfb[ks] = t_; }
        }
#pragma unroll
        for (int ks = 0; ks < 4; ++ks) O[dt] = __builtin_amdgcn_mfma_f32_32x32x16_bf16((dt & 1) ? vfb[ks] : vfa[ks], pb[ks], O[dt], 0, 0, 0);
    }
}
__device__ __forceinline__ void attn_unit(PP P, LAS unsigned char* lds, int l, int kind, int idx, int tid) {
    const int lane = tid & 63, wave = __builtin_amdgcn_readfirstlane(tid >> 6), r32 = lane & 31, hh = lane >> 5;
    const bf16* Z = (const bf16*)(P->ws + WS_Z); bf16* MIX = (bf16*)(P->ws + WS_H); const float* CS = (const float*)(P->ws + WS_CS); const bf16* CKV = (const bf16*)(P->ws + WS_CKV);
    int b, h, qpos0, grow0, kpos0, klrow0, nls, ncs;
    if (kind == 0) { b = idx >> 3; h = idx & 7; qpos0 = 0; grow0 = b * 256; kpos0 = 0; klrow0 = b * 256; nls = 2; ncs = 0; }
    else { const int qb = idx & 7; h = (idx >> 3) & 7; b = idx >> 6; qpos0 = qb * 256; grow0 = NCTX + b * 2048 + qpos0;
        kpos0 = qpos0 - 128 < 0 ? 0 : qpos0 - 128; const int kend = qpos0 + 384 > 2048 ? 2048 : qpos0 + 384; nls = (kend - kpos0) >> 7; klrow0 = NCTX + b * 2048 + kpos0; ncs = 2; }
    const bool lat = (kind == 1);
    const int kv = h >> 2;
    if (lat) {
#pragma unroll
        for (int k = 0; k < 4; ++k) { const int e = tid + 512 * k; const float c = CS[2 * e], sn = CS[2 * e + 1];
            typedef _Float16 h2_ __attribute__((ext_vector_type(2))); const h2_ hv = {(_Float16)c, (_Float16)sn}; *(LAS unsigned*)(lds + AT_ROPE + 4 * e) = __builtin_bit_cast(unsigned, hv); }
    }
    const int qrow = grow0 + 32 * wave + r32, qpos = qpos0 + 32 * wave + r32, qw0 = qpos0 + 32 * wave;
    bf16x8 qf[8];
    { const bf16* qp = Z + (size_t)qrow * DIN + C_AQ + h * 128 + 8 * hh;
#pragma unroll
      for (int s = 0; s < 8; ++s) qf[s] = *(const bf16x8*)(qp + 16 * s);
      if (lat) { const float* c0 = CS + ((qpos >> 6) * 32 + 8 * hh) * 2; const float* c1 = CS + ((qpos & 63) * 32 + 8 * hh) * 2;
          rope8(qf[0], qf[2], c0); rope8(qf[1], qf[3], c0 + 32); rope8(qf[4], qf[6], c1); rope8(qf[5], qf[7], c1 + 32); } }
    f32x16 O[4];
#pragma unroll
    for (int d = 0; d < 4; ++d)
#pragma unroll
        for (int i = 0; i < 16; ++i) O[d][i] = 0.f;
    float m = P->in[11][l * 8 + h] * LOG2E, lsum = (hh == 0) ? 1.0f : 0.0f;
    const int skey = tid >> 2, sub = tid & 3;
    const int nst = nls + ncs;
    u32x4 rr[8];
#define ATT_ISSUE(ST) do { const int st_ = (ST); const bf16* kp_; const bf16* vp_; \
        if (st_ < nls) { const int krow = klrow0 + 128 * st_ + skey; kp_ = Z + (size_t)krow * DIN + C_AK + kv * 128 + 8 * sub; vp_ = kp_ + (C_AV - C_AK); } \
        else { const int key = 128 * (st_ - nls) + skey; kp_ = CKV + ((size_t)((b * 2 + l) * 256 + key) * 2 + kv) * 128 + 8 * sub; vp_ = kp_ + 262144; } \
        rr[0] = *(const u32x4*)kp_; rr[1] = *(const u32x4*)(kp_ + 32); rr[2] = *(const u32x4*)(kp_ + 64); rr[3] = *(const u32x4*)(kp_ + 96); \
        rr[4] = *(const u32x4*)vp_; rr[5] = *(const u32x4*)(vp_ + 32); rr[6] = *(const u32x4*)(vp_ + 64); rr[7] = *(const u32x4*)(vp_ + 96); } while (0)
#define ATT_WRITE(ST) do { const int st_ = (ST); \
        if (lat && st_ < nls) { const int kpos = kpos0 + 128 * st_ + skey; \
            rope8h(rr[0], rr[1], lds + AT_ROPE + ((kpos >> 6) * 32 + 8 * sub) * 4); rope8h(rr[2], rr[3], lds + AT_ROPE + ((kpos & 63) * 32 + 8 * sub) * 4); } \
        LAS unsigned char* kd_ = lds + (st_ & 1) * AT_BUF + skey * KROW + 16 * sub; LAS unsigned char* vd_ = lds + (st_ & 1) * AT_BUF + AT_V + skey * VROW + 16 * sub; \
        *(LAS u32x4*)kd_ = rr[0]; *(LAS u32x4*)(kd_ + 64) = rr[1]; *(LAS u32x4*)(kd_ + 128) = rr[2]; *(LAS u32x4*)(kd_ + 192) = rr[3]; \
        *(LAS u32x4*)vd_ = rr[4]; *(LAS u32x4*)(vd_ + 64) = rr[5]; *(LAS u32x4*)(vd_ + 128) = rr[6]; *(LAS u32x4*)(vd_ + 192) = rr[7]; } while (0)
    if (lat) { ATT_ISSUE(0); __syncthreads();
        ATT_WRITE(0); }
    else {
        u32x4 r2[8];
        { const bf16* kp_ = Z + (size_t)(klrow0 + skey) * DIN + C_AK + kv * 128 + 8 * sub; const bf16* vp_ = kp_ + (C_AV - C_AK); const bf16* kq_ = kp_ + (size_t)128 * DIN; const bf16* vq_ = vp_ + (size_t)128 * DIN;
          rr[0] = *(const u32x4*)kp_; rr[1] = *(const u32x4*)(kp_ + 32); rr[2] = *(const u32x4*)(kp_ + 64); rr[3] = *(const u32x4*)(kp_ + 96);
          rr[4] = *(const u32x4*)vp_; rr[5] = *(const u32x4*)(vp_ + 32); rr[6] = *(const u32x4*)(vp_ + 64); rr[7] = *(const u32x4*)(vp_ + 96);
          r2[0] = *(const u32x4*)kq_; r2[1] = *(const u32x4*)(kq_ + 32); r2[2] = *(const u32x4*)(kq_ + 64); r2[3] = *(const u32x4*)(kq_ + 96);
          r2[4] = *(const u32x4*)vq_; r2[5] = *(const u32x4*)(vq_ + 32); r2[6] = *(const u32x4*)(vq_ + 64); r2[7] = *(const u32x4*)(vq_ + 96); }
        ATT_WRITE(0);
#pragma unroll
        for (int e = 0; e < 8; ++e) rr[e] = r2[e];
        ATT_WRITE(1);
    }
    __syncthreads();
    for (int st = 0; st < nst; ++st) {
        const bool more = lat && (st + 1 < nst);
        if (more) ATT_ISSUE(st + 1);
        const bool local = lat && (st < nls);
        const LAS unsigned char* kt = lds + (st & 1) * AT_BUF; const LAS unsigned char* vt = kt + AT_V;
#pragma unroll
        for (int t2 = 0; t2 < 2; ++t2) {
            const int tk0 = kpos0 + 128 * st + 64 * t2;
            bool skip = false;
            if (local) skip = (tk0 > qw0 + 31 + 128) || (tk0 + 63 < qw0 - 128);
            if (!skip) attn_tile(kt + t2 * 64 * KROW, vt + t2 * 64 * VROW, qf, O, m, lsum, local, tk0, qpos, lane);
        }
        if (more) ATT_WRITE(st + 1);
        if (lat) __syncthreads();
    }
    const float ltot = lsum + __shfl_xor(lsum, 32), inv = __builtin_amdgcn_rcpf(ltot);
    const bf16* gp = Z + (size_t)qrow * DIN + C_AG + h * 128 + 4 * hh; bf16* op = MIX + (size_t)qrow * D_MODEL + h * 128 + 4 * hh;
    u32x2 gg[16];
#pragma unroll
    for (int e = 0; e < 16; ++e) gg[e] = *(const u32x2*)(gp + 32 * (e >> 2) + 8 * (e & 3));
    __builtin_amdgcn_sched_barrier(0);
#pragma unroll
    for (int dt = 0; dt < 4; ++dt)
#pragma unroll
        for (int i4 = 0; i4 < 4; ++i4) { const int d0 = 32 * dt + 8 * i4; const u32x2 g = gg[dt * 4 + i4];
            const float o0 = O[dt][4 * i4 + 0] * inv * siluf_(bflo(g.x)), o1 = O[dt][4 * i4 + 1] * inv * siluf_(bfhi(g.x));
            const float o2 = O[dt][4 * i4 + 2] * inv * siluf_(bflo(g.y)), o3 = O[dt][4 * i4 + 3] * inv * siluf_(bfhi(g.y));
            u32x2 w; w.x = pk2(o0, o1); w.y = pk2(o2, o3); *(u32x2*)(op + d0) = w; }
#undef ATT_ISSUE
#undef ATT_WRITE
}

__device__ __forceinline__ void hg_oml8(PP P, int l, int dir, int hd0, float (&oml)[8]) {
    const float* hb = P->in[12] + dir * 1024 + hd0;
    const f32x4 a0 = *(const f32x4*)hb, a1 = *(const f32x4*)(hb + 4), b0 = *(const f32x4*)(hb + 512), b1 = *(const f32x4*)(hb + 516);
#pragma unroll
    for (int j = 0; j < 4; ++j) { const float s0 = sigmoidf_(b0[j] - a0[j]), s1 = sigmoidf_(b1[j] - a1[j]); oml[j] = l ? 1.0f - s0 : 1.0f; oml[4 + j] = l ? 1.0f - s1 : 1.0f; }
}
constexpr int H2_TG = 0, H2_QE = 16896, H2_KE = 25600, H2_QG = 34304, H2_KG = 42752, H2_V = 52992, H2_OBA = 63232, H2_OBB = 80128, H2_DK = 97024;
constexpr size_t WS_DLC_OFF = 0;
#ifndef PROBE_SEC
#define PROBE_SEC -1
#endif
#if PROBE_SEC >= 0
#define PSEC_DECL unsigned long long ps_acc_ = 0ull, ps_t_ = 0ull;
#define PSEC_START(n) if (PROBE_SEC == n) ps_t_ = __builtin_amdgcn_s_memrealtime();
#define PSEC_END(n) if (PROBE_SEC == n) ps_acc_ += __builtin_amdgcn_s_memrealtime() - ps_t_;
#define PSEC_CLOSE(n) if (PROBE_SEC == n) { __syncthreads(); ps_acc_ += __builtin_amdgcn_s_memrealtime() - ps_t_; }
#define PSEC_FLUSH(cnt) if (kind == 0 && tid == 0) { atomicAdd((unsigned long long*)((unsigned*)(P->ws + WS_CTL) + 60000), ps_acc_); atomicAdd((unsigned*)(P->ws + WS_CTL) + 60002, (unsigned)(cnt)); }
#else
#define PSEC_DECL
#define PSEC_START(n)
#define PSEC_END(n)
#define PSEC_CLOSE(n)
#define PSEC_FLUSH(cnt)
#endif
__device__ __forceinline__ void hgrn2_unit(PP P, LAS unsigned char* lds, int l, int kind, int idx, int tid) {
    const int lane = tid & 63, wave = __builtin_amdgcn_readfirstlane(tid >> 6), r32 = lane & 31, hh = lane >> 5, i16 = lane & 15, cg = (lane >> 4) & 1;
    const bf16* Z = (const bf16*)(P->ws + WS_Z); bf16* MIX = (bf16*)(P->ws + WS_H); float* OL = (float*)(P->ws + WS_OL);
    LAS float* ldsf = (LAS float*)lds;
    int h, row0, seglen, nch, b = 0;
    if (kind == 0) { b = idx >> 2; h = idx & 3; row0 = b * 256; seglen = 256; nch = 8; }
    else { const int blk = idx & 15; h = (idx >> 4) & 3; const int lb = idx >> 6; row0 = NCTX + lb * 2048 + blk * 128; seglen = 128; nch = 4; }
    const int ti = tid >> 4, d0 = 8 * (tid & 15), nt = wave & 3, kp = wave >> 2;
    PSEC_DECL
    const f32x4 n0 = *(const f32x4*)(P->in[13] + l * 512 + h * 128 + d0), n1 = *(const f32x4*)(P->in[13] + l * 512 + h * 128 + d0 + 4);
    for (int dir = 0; dir < 2; ++dir) {
        float oml[8]; hg_oml8(P, l, dir, h * 128 + d0, oml);
        const int cf = dir ? C_HFB : C_HFF;
        f32x16 S0, S1;
#pragma unroll
        for (int i = 0; i < 16; ++i) { S0[i] = 0.f; S1[i] = 0.f; }
        const int uidx = (kind == 1) ? ((idx >> 4) * 2 + dir) * 16 + (idx & 15) : 0;
        float gtot = 0.f;
        u32x4 uq, uv, uf;
        { const int row = dir ? row0 + seglen - 1 - ti : row0 + ti; const bf16* zr = Z + (size_t)row * DIN + h * 128 + d0;
          uq = *(const u32x4*)(zr + C_HQ); uv = *(const u32x4*)(zr + C_HI); uf = *(const u32x4*)(zr + cf); }
        for (int c = 0; c < nch; ++c) {
            PSEC_START(0)
            const int nc = dir ? nch - 1 - c : c; const int rown = row0 + 32 * nc + ti;
            f32x4 olp0 = {0.f, 0.f, 0.f, 0.f}, olp1 = {0.f, 0.f, 0.f, 0.f}; u32x4 ug = {0u, 0u, 0u, 0u};
            float* olr = OL + (size_t)rown * 512 + h * 128 + d0;
            if (dir == 1) { olp0 = *(const f32x4*)olr; olp1 = *(const f32x4*)(olr + 4); if (kind == 0) ug = *(const u32x4*)(Z + (size_t)rown * DIN + C_HG + h * 128 + d0); }
            float q[8], kk[8];
            {
                float g2[8], vv[8];
#pragma unroll
                for (int j = 0; j < 4; ++j) { const unsigned wq = uq[j], wv = uv[j], wf = uf[j];
                    q[2 * j] = siluf_(bflo(wq)) * 0.08838834764831845f; q[2 * j + 1] = siluf_(bfhi(wq)) * 0.08838834764831845f;
                    vv[2 * j] = bflo(wv); vv[2 * j + 1] = bfhi(wv);
                    kk[2 * j] = oml[2 * j] * sigmoidf_(-bflo(wf)); kk[2 * j + 1] = oml[2 * j + 1] * sigmoidf_(-bfhi(wf)); }
#pragma unroll
                for (int j = 0; j < 8; ++j) g2[j] = __builtin_amdgcn_logf(1.0f - fminf(kk[j], 1.0f - 1e-6f));
                LAS float* pg = ldsf + (H2_TG >> 2) + ti * 132 + d0;
                *(LAS f32x4*)pg = (f32x4){g2[0], g2[1], g2[2], g2[3]}; *(LAS f32x4*)(pg + 4) = (f32x4){g2[4], g2[5], g2[6], g2[7]};
                *(LAS u32x4*)(lds + H2_V + ti * 320 + d0 * 2) = uv;
            }
            if (c + 1 < nch) { const int tl = 32 * (c + 1) + ti; const int row = dir ? row0 + seglen - 1 - tl : row0 + tl; const bf16* zr = Z + (size_t)row * DIN + h * 128 + d0;
                uq = *(const u32x4*)(zr + C_HQ); uv = *(const u32x4*)(zr + C_HI); uf = *(const u32x4*)(zr + cf); }
            __syncthreads();
            PSEC_END(0) PSEC_START(1)
            if (tid < 128) {
                LAS float* gc = ldsf + (H2_TG >> 2) + tid; float run = 0.f; float gv[32];
#pragma unroll
                for (int i = 0; i < 32; ++i) gv[i] = gc[i * 132];
                SBAR
#pragma unroll
                for (int i = 0; i < 32; ++i) { run += gv[i]; gc[i * 132] = run; }
                ldsf[(H2_DK >> 2) + tid] = __builtin_amdgcn_exp2f(run);
                if (kind == 1) ((float*)(P->ws + WS_DLOG))[(uidx * 4 + c) * 128 + tid] = run;
                gtot += run;
            }
            __syncthreads();
            PSEC_END(1) PSEC_START(2)
            {
                const LAS float* gr = ldsf + (H2_TG >> 2) + ti * 132 + d0; const LAS float* gm = ldsf + (H2_TG >> 2) + 15 * 132 + d0; const LAS float* gl = ldsf + (H2_TG >> 2) + 31 * 132 + d0;
                float qe[8], ke[8], qg[8], kg[8];
#pragma unroll
                for (int j = 0; j < 8; ++j) { const float G = gr[j], Gm = gm[j], Gl = gl[j];
                    qe[j] = q[j] * __builtin_amdgcn_exp2f(fminf(G - Gm, 100.f)); ke[j] = kk[j] * __builtin_amdgcn_exp2f(fminf(Gm - G, 100.f));
                    qg[j] = q[j] * __builtin_amdgcn_exp2f(G); kg[j] = kk[j] * __builtin_amdgcn_exp2f(Gl - G); }
                *(LAS bf16x8*)(lds + H2_QE + ti * 272 + d0 * 2) = pack8(qe[0], qe[1], qe[2], qe[3], qe[4], qe[5], qe[6], qe[7]);
                *(LAS bf16x8*)(lds + H2_KE + ti * 272 + d0 * 2) = pack8(ke[0], ke[1], ke[2], ke[3], ke[4], ke[5], ke[6], ke[7]);
                *(LAS bf16x8*)(lds + H2_KG + ti * 320 + d0 * 2) = pack8(kg[0], kg[1], kg[2], kg[3], kg[4], kg[5], kg[6], kg[7]);
                u32x2 w0, w1; w0.x = pk2(qg[0], qg[1]); w0.y = pk2(qg[2], qg[3]); w1.x = pk2(qg[4], qg[5]); w1.y = pk2(qg[6], qg[7]);
                *(LAS u32x2*)(lds + H2_QG + ti * 264 + d0 * 2) = w0; *(LAS u32x2*)(lds + H2_QG + ti * 264 + d0 * 2 + 8) = w1;
            }
            __syncthreads();
            PSEC_END(2) PSEC_START(3)
            {
                f32x16 at;
#pragma unroll
                for (int i = 0; i < 16; ++i) at[i] = 0.f;
                const LAS unsigned char* kep = lds + H2_KE + r32 * 272 + 16 * hh; const LAS unsigned char* qep = lds + H2_QE + r32 * 272 + 16 * hh;
#pragma unroll
                for (int k = 0; k < 8; ++k) at = __builtin_amdgcn_mfma_f32_32x32x16_bf16(*(const LAS bf16x8*)(kep + 32 * k), *(const LAS bf16x8*)(qep + 32 * k), at, 0, 0, 0);
                float am[8];
#pragma unroll
                for (int j = 0; j < 8; ++j) { const float lo = at[j], hi = at[8 + j]; const float v = kp ? hi : lo; const int s = 16 * kp + 8 * (j >> 2) + 4 * hh + (j & 3); am[j] = (s <= r32) ? v : 0.f; }
                const bf16x8 afrag = pack8(am[0], am[1], am[2], am[3], am[4], am[5], am[6], am[7]);
                f32x16 ot;
#pragma unroll
                for (int i = 0; i < 16; ++i) ot[i] = 0.f;
                { const bf16x8 vfrag = trpair(lds + H2_V + (16 * kp + 4 * hh + (i16 >> 2)) * 320 + (32 * nt + 16 * cg + 4 * (i16 & 3)) * 2, 8 * 320);
                  ot = __builtin_amdgcn_mfma_f32_32x32x16_bf16(vfrag, afrag, ot, 0, 0, 0); }
                const LAS unsigned char* qgp = lds + H2_QG + r32 * 264 + (64 * kp + 4 * hh) * 2;
#pragma unroll
                for (int kl = 0; kl < 2; ++kl)
#pragma unroll
                    for (int sp = 0; sp < 2; ++sp) {
                        const u32x2 qlo = *(const LAS u32x2*)(qgp + (32 * kl + 16 * sp) * 2), qhi = *(const LAS u32x2*)(qgp + (32 * kl + 16 * sp) * 2 + 16);
                        const u32x4 qq = {qlo.x, qlo.y, qhi.x, qhi.y};
                        bf16x8 sfrag;
                        if (kl == 0) sfrag = pack8(S0[8 * sp], S0[8 * sp + 1], S0[8 * sp + 2], S0[8 * sp + 3], S0[8 * sp + 4], S0[8 * sp + 5], S0[8 * sp + 6], S0[8 * sp + 7]);
                        else sfrag = pack8(S1[8 * sp], S1[8 * sp + 1], S1[8 * sp + 2], S1[8 * sp + 3], S1[8 * sp + 4], S1[8 * sp + 5], S1[8 * sp + 6], S1[8 * sp + 7]);
                        ot = __builtin_amdgcn_mfma_f32_32x32x16_bf16(sfrag, __builtin_bit_cast(bf16x8, qq), ot, 0, 0, 0);
                    }
                { LAS float* ob = ldsf + ((kp ? H2_OBB : H2_OBA) >> 2) + (32 * nt + 4 * hh) * 33 + r32;
#pragma unroll
                  for (int i = 0; i < 16; ++i) ob[R0(i) * 33] = ot[i]; }
                const LAS float* dkp = ldsf + (H2_DK >> 2) + 64 * kp + 4 * hh;
#pragma unroll
                for (int i = 0; i < 16; ++i) { S0[i] *= dkp[R0(i)]; S1[i] *= dkp[32 + R0(i)]; }
#pragma unroll
                for (int ks = 0; ks < 2; ++ks) {
                    const int roff = (16 * ks + 8 * hh + (i16 >> 2)) * 320, coff = (16 * cg + 4 * (i16 & 3)) * 2;
                    const bf16x8 vf = trpair(lds + H2_V + roff + 64 * nt + coff, 4 * 320);
                    const bf16x8 k0 = trpair(lds + H2_KG + roff + 64 * (2 * kp) + coff, 4 * 320), k1 = trpair(lds + H2_KG + roff + 64 * (2 * kp + 1) + coff, 4 * 320);
                    S0 = __builtin_amdgcn_mfma_f32_32x32x16_bf16(k0, vf, S0, 0, 0, 0); S1 = __builtin_amdgcn_mfma_f32_32x32x16_bf16(k1, vf, S1, 0, 0, 0);
                }
            }
            __syncthreads();
            PSEC_END(3) PSEC_START(4)
            {
                const int t = dir ? 31 - ti : ti;
                const LAS float* oa = ldsf + (H2_OBA >> 2) + d0 * 33 + t; const LAS float* obb = ldsf + (H2_OBB >> 2) + d0 * 33 + t;
                float o[8];
#pragma unroll
                for (int j = 0; j < 8; ++j) o[j] = oa[j * 33] + obb[j * 33];
                if (dir == 1) { o[0] += olp0[0]; o[1] += olp0[1]; o[2] += olp0[2]; o[3] += olp0[3]; o[4] += olp1[0]; o[5] += olp1[1]; o[6] += olp1[2]; o[7] += olp1[3]; }
                if (dir == 0 || kind == 1) { *(f32x4*)olr = (f32x4){o[0], o[1], o[2], o[3]}; *(f32x4*)(olr + 4) = (f32x4){o[4], o[5], o[6], o[7]}; }
                else {
                    float ss = 0.f;
#pragma unroll
                    for (int j = 0; j < 8; ++j) ss += o[j] * o[j];
                    ss += __shfl_xor(ss, 1); ss += __shfl_xor(ss, 2); ss += __shfl_xor(ss, 4); ss += __shfl_xor(ss, 8);
                    const float r = __builtin_amdgcn_rsqf(ss * (1.0f / 128.0f) + 1e-6f);
                    u32x4 w;
                    w.x = pk2(o[0] * r * n0[0] * siluf_(bflo(ug.x)), o[1] * r * n0[1] * siluf_(bfhi(ug.x))); w.y = pk2(o[2] * r * n0[2] * siluf_(bflo(ug.y)), o[3] * r * n0[3] * siluf_(bfhi(ug.y)));
                    w.z = pk2(o[4] * r * n1[0] * siluf_(bflo(ug.z)), o[5] * r * n1[1] * siluf_(bfhi(ug.z))); w.w = pk2(o[6] * r * n1[2] * siluf_(bflo(ug.w)), o[7] * r * n1[3] * siluf_(bfhi(ug.w)));
                    *(u32x4*)(MIX + (size_t)rown * D_MODEL + 1024 + h * 128 + d0) = w;
                }
            }
            PSEC_CLOSE(4)
        }
        if (kind == 1 && tid < 128) ((float*)(P->ws + WS_DLOG) + 131072)[uidx * 128 + tid] = gtot;
        {
            float* Sd = (kind == 0) ? P->out + OUT_ST + (size_t)((((b * 2 + l) * 2 + dir) * 4 + h)) * 16384 : (float*)(P->ws + WS_U) + (size_t)uidx * 16384;
            float* sp = Sd + (64 * kp + 4 * hh) * 128 + 32 * nt + r32;
#pragma unroll
            for (int i = 0; i < 16; ++i) { sp[R0(i) * 128] = S0[i]; sp[(32 + R0(i)) * 128] = S1[i]; }
        }
    }
    PSEC_FLUSH(2 * nch)
}

__device__ __forceinline__ void hgrn_scan_unit(PP P, int l, int su, int tid) {
    float* U = (float*)(P->ws + WS_U); const float* DLB = (const float*)(P->ws + WS_DLOG) + 131072;
#pragma unroll 1
    for (int k = 0; k < 4; ++k) {
        const int e = su * 2048 + tid + 512 * k;
        const int sq = e >> 14, el = e & 16383, dk = el >> 7, lb = sq >> 3, h = (sq >> 1) & 3, dir = sq & 1;
        float S = P->in[4][(size_t)((((lb * 2 + l) * 2 + dir) * 4 + h)) * 16384 + el];
        float u[16], dl[16];
        const long ustep = dir ? -16384 : 16384, dstep = dir ? -128 : 128;
        float* up = U + (size_t)(sq * 16 + (dir ? 15 : 0)) * 16384 + el; const float* dp = DLB + (sq * 16 + (dir ? 15 : 0)) * 128 + dk;
        { float* uq = up; const float* dq = dp;
#pragma unroll
          for (int p = 0; p < 16; ++p) { u[p] = *uq; dl[p] = *dq; uq += ustep; dq += dstep; asm volatile("" : "+v"(uq), "+v"(dq)); } }
        SBAR
        { float* uq = up;
#pragma unroll
          for (int p = 0; p < 16; ++p) { *uq = S; S = __builtin_amdgcn_exp2f(dl[p]) * S + u[p]; uq += ustep; asm volatile("" : "+v"(uq)); } }
    }
}

constexpr int HF_S0 = 0, HF_S1 = 40960, HF_TG0 = 81920, HF_TG1 = 98816, HF_QG0 = 115712, HF_QG1 = 124416;
__device__ __forceinline__ void hgrn_final_unit(PP P, LAS unsigned char* lds, int l, int idx, int half_sel, int tid) {
    const int lane = tid & 63, wave = __builtin_amdgcn_readfirstlane(tid >> 6), r32 = lane & 31, hh = lane >> 5, i16 = lane & 15, cg = (lane >> 4) & 1;
    const bf16* Z = (const bf16*)(P->ws + WS_Z); bf16* MIX = (bf16*)(P->ws + WS_H); const float* OL = (const float*)(P->ws + WS_OL); const float* DLC = (const float*)(P->ws + WS_DLOG);
    LAS float* ldsf = (LAS float*)lds;
    const int blk = idx & 15, h = (idx >> 4) & 3, lb = idx >> 6, row0 = NCTX + lb * 2048 + blk * 128;
    const int ti = tid >> 4, d0 = 8 * (tid & 15), nt = wave & 3, ds = wave >> 2;
    const int uidx0 = ((idx >> 4) * 2 + 0) * 16 + blk, uidx1 = ((idx >> 4) * 2 + 1) * 16 + blk;
#pragma unroll
    for (int half = 0; half < 2; ++half) {
        f32x4 sv[8];
#pragma unroll
        for (int k = 0; k < 8; ++k) { const int id = tid + 512 * (k + 8 * half), dsel = id >> 12, dk = (id >> 5) & 127, c4 = id & 31;
            sv[k] = *(const f32x4*)((const float*)(P->ws + WS_U) + (size_t)(dsel ? uidx1 : uidx0) * 16384 + dk * 128 + c4 * 4); }
#pragma unroll
        for (int k = 0; k < 8; ++k) { const int id = tid + 512 * (k + 8 * half), dsel = id >> 12, dk = (id >> 5) & 127, c4 = id & 31;
            u32x2 w; w.x = pk2(sv[k][0], sv[k][1]); w.y = pk2(sv[k][2], sv[k][3]); *(LAS u32x2*)(lds + (dsel ? HF_S1 : HF_S0) + dk * 320 + c4 * 8) = w; }
    }
    float oml0[8], oml1[8]; hg_oml8(P, l, 0, h * 128 + d0, oml0); hg_oml8(P, l, 1, h * 128 + d0, oml1);
    const f32x4 n0 = *(const f32x4*)(P->in[13] + l * 512 + h * 128 + d0), n1 = *(const f32x4*)(P->in[13] + l * 512 + h * 128 + d0 + 4);
    float carry = 0.f;
    if (tid < 128) { for (int c = 0; c < 2 * half_sel; ++c) carry += DLC[(uidx0 * 4 + c) * 128 + tid]; }
    for (int nc = 2 * half_sel; nc < 2 * half_sel + 2; ++nc) {
        const int rown = row0 + 32 * nc + ti; const bf16* zr = Z + (size_t)rown * DIN + h * 128 + d0;
        const u32x4 uq = *(const u32x4*)(zr + C_HQ), uf0 = *(const u32x4*)(zr + C_HFF), uf1 = *(const u32x4*)(zr + C_HFB), ug = *(const u32x4*)(zr + C_HG);
        const float* olr = OL + (size_t)rown * 512 + h * 128 + d0; const f32x4 olp0 = *(const f32x4*)olr, olp1 = *(const f32x4*)(olr + 4);
        float off1 = 0.f;
        if (tid >= 128 && tid < 256) { for (int c = 0; c < 3 - nc; ++c) off1 += DLC[(uidx1 * 4 + c) * 128 + (tid - 128)]; }
        float q[8];
        {
            float ga[8], gb[8];
#pragma unroll
            for (int j = 0; j < 4; ++j) { const unsigned wq = uq[j], wa = uf0[j], wb = uf1[j];
                q[2 * j] = siluf_(bflo(wq)) * 0.08838834764831845f; q[2 * j + 1] = siluf_(bfhi(wq)) * 0.08838834764831845f;
                ga[2 * j] = oml0[2 * j] * sigmoidf_(-bflo(wa)); ga[2 * j + 1] = oml0[2 * j + 1] * sigmoidf_(-bfhi(wa));
                gb[2 * j] = oml1[2 * j] * sigmoidf_(-bflo(wb)); gb[2 * j + 1] = oml1[2 * j + 1] * sigmoidf_(-bfhi(wb)); }
#pragma unroll
            for (int j = 0; j < 8; ++j) { ga[j] = __builtin_amdgcn_logf(1.0f - fminf(ga[j], 1.0f - 1e-6f)); gb[j] = __builtin_amdgcn_logf(1.0f - fminf(gb[j], 1.0f - 1e-6f)); }
            LAS float* p0 = ldsf + (HF_TG0 >> 2) + ti * 132 + d0; LAS float* p1 = ldsf + (HF_TG1 >> 2) + ti * 132 + d0;
            *(LAS f32x4*)p0 = (f32x4){ga[0], ga[1], ga[2], ga[3]}; *(LAS f32x4*)(p0 + 4) = (f32x4){ga[4], ga[5], ga[6], ga[7]};
            *(LAS f32x4*)p1 = (f32x4){gb[0], gb[1], gb[2], gb[3]}; *(LAS f32x4*)(p1 + 4) = (f32x4){gb[4], gb[5], gb[6], gb[7]};
        }
        __syncthreads();
        if (tid < 256) { const bool rev = tid >= 128; LAS float* gc = ldsf + ((rev ? HF_TG1 : HF_TG0) >> 2) + (tid & 127); float run = rev ? off1 : carry; float gv[32];
#pragma unroll
            for (int i = 0; i < 32; ++i) gv[i] = gc[(rev ? 31 - i : i) * 132];
            SBAR
#pragma unroll
            for (int i = 0; i < 32; ++i) { run += gv[i]; gc[(rev ? 31 - i : i) * 132] = run; }
            if (!rev) carry = run; }
        __syncthreads();
        {
            const LAS float* g0 = ldsf + (HF_TG0 >> 2) + ti * 132 + d0; const LAS float* g1 = ldsf + (HF_TG1 >> 2) + ti * 132 + d0;
            float a[8], c[8];
#pragma unroll
            for (int j = 0; j < 8; ++j) { a[j] = q[j] * __builtin_amdgcn_exp2f(g0[j]); c[j] = q[j] * __builtin_amdgcn_exp2f(g1[j]); }
            *(LAS bf16x8*)(lds + HF_QG0 + ti * 272 + d0 * 2) = pack8(a[0], a[1], a[2], a[3], a[4], a[5], a[6], a[7]);
            *(LAS bf16x8*)(lds + HF_QG1 + ti * 272 + d0 * 2) = pack8(c[0], c[1], c[2], c[3], c[4], c[5], c[6], c[7]);
        }
        __syncthreads();
        {
            f32x16 acc;
#pragma unroll
            for (int i = 0; i < 16; ++i) acc[i] = 0.f;
            const LAS unsigned char* qp = lds + (ds ? HF_QG1 : HF_QG0) + r32 * 272 + 16 * hh;
            const LAS unsigned char* sp = lds + (ds ? HF_S1 : HF_S0) + (8 * hh + (i16 >> 2)) * 320 + (32 * nt + 16 * cg + 4 * (i16 & 3)) * 2;
#pragma unroll
            for (int k = 0; k < 8; ++k) { const bf16x8 sf = trpair(sp + 16 * k * 320, 4 * 320); acc = __builtin_amdgcn_mfma_f32_32x32x16_bf16(*(const LAS bf16x8*)(qp + 32 * k), sf, acc, 0, 0, 0); }
            LAS float* ob = ldsf + ((ds ? HF_TG1 : HF_TG0) >> 2) + (4 * hh) * 132 + 32 * nt + r32;
#pragma unroll
            for (int i = 0; i < 16; ++i) ob[R0(i) * 132] = acc[i];
        }
        __syncthreads();
        {
            const LAS float* oa = ldsf + (HF_TG0 >> 2) + ti * 132 + d0; const LAS float* obb = ldsf + (HF_TG1 >> 2) + ti * 132 + d0;
            const f32x4 a0 = *(const LAS f32x4*)oa, a1 = *(const LAS f32x4*)(oa + 4), b0 = *(const LAS f32x4*)obb, b1 = *(const LAS f32x4*)(obb + 4);
            const f32x4 o0 = a0 + b0 + olp0, o1 = a1 + b1 + olp1;
            float ss = (o0[0] * o0[0] + o0[1] * o0[1]) + (o0[2] * o0[2] + o0[3] * o0[3]) + (o1[0] * o1[0] + o1[1] * o1[1]) + (o1[2] * o1[2] + o1[3] * o1[3]);
            ss += __shfl_xor(ss, 1); ss += __shfl_xor(ss, 2); ss += __shfl_xor(ss, 4); ss += __shfl_xor(ss, 8);
            const float r = __builtin_amdgcn_rsqf(ss * (1.0f / 128.0f) + 1e-6f);
            u32x4 w;
            w.x = pk2(o0[0] * r * n0[0] * siluf_(bflo(ug.x)), o0[1] * r * n0[1] * siluf_(bfhi(ug.x))); w.y = pk2(o0[2] * r * n0[2] * siluf_(bflo(ug.y)), o0[3] * r * n0[3] * siluf_(bfhi(ug.y)));
            w.z = pk2(o1[0] * r * n1[0] * siluf_(bflo(ug.z)), o1[1] * r * n1[1] * siluf_(bfhi(ug.z))); w.w = pk2(o1[2] * r * n1[2] * siluf_(bflo(ug.w)), o1[3] * r * n1[3] * siluf_(bfhi(ug.w)));
            *(u32x4*)(MIX + (size_t)rown * D_MODEL + 1024 + h * 128 + d0) = w;
        }
        __syncthreads();
    }
}

#define RLX_AGENT __ATOMIC_RELAXED, __HIP_MEMORY_SCOPE_AGENT
#define XB_TMO      128
#define XB_XCNT(j)  (256  + 64 * (j))
#define XB_XSUB(j)  (1280 + 64 * (j))
#define XB_XGEN(j)  (2304 + 64 * (j))
#define XB_TOP      3328
#define XB_TOPGEN   3392
#define XCD_BAR_WORDS 3456
#define XB_SPIN_CAP (1u << 18)

__device__ __forceinline__ unsigned xb_ld(unsigned* p)              { return __hip_atomic_load(p, __ATOMIC_RELAXED, __HIP_MEMORY_SCOPE_AGENT); }
__device__ __forceinline__ unsigned xb_add(unsigned* p, unsigned v) { return __hip_atomic_fetch_add(p, v, __ATOMIC_RELAXED, __HIP_MEMORY_SCOPE_AGENT); }
__device__ __forceinline__ unsigned xb_xcc_id() { return (unsigned)__builtin_amdgcn_s_getreg((3 << 11) | 20) & 0xFu; }
#define XB_SPIN(cond, bar) do { unsigned _sp = 0; while (cond) { __builtin_amdgcn_s_sleep(1); \
    if ((++_sp & 255u) == 0u) { if (xb_ld(&(bar)[XB_TMO])) break; if (_sp > XB_SPIN_CAP) { atomicAdd(&(bar)[XB_TMO], 1u); break; } } } } while (0)

struct XcdBarrier {
    unsigned* bar; unsigned x; bool t0;
    volatile LAS unsigned* st;
};

__device__ __forceinline__ XcdBarrier xcd_barrier_post(unsigned* bar, volatile LAS unsigned* st) {
    XcdBarrier b; b.bar = bar; b.x = xb_xcc_id(); b.st = st; b.t0 = (threadIdx.x == 0);
    if (threadIdx.x == 0) (void)xb_add(&bar[XB_XCNT(b.x)], 1u);
    return b;
}
__device__ __forceinline__ void xcd_barrier_complete(unsigned* bar, unsigned x, unsigned& nloc, unsigned& nx) {
    const unsigned G = gridDim.x * gridDim.y * gridDim.z;
    unsigned sum, cnt, mine, sp = 0u;
    for (;;) {
        sum = 0u; cnt = 0u; mine = 0u;
#pragma unroll
        for (unsigned j = 0; j < 16; ++j) { const unsigned c = xb_ld(&bar[XB_XCNT(j)]); sum += c; cnt += (c > 0u) ? 1u : 0u; mine = (j == x) ? c : mine; }
        if (sum == G) break;
        __builtin_amdgcn_s_sleep(1);
        if ((++sp & 255u) == 0u) { if (xb_ld(&bar[XB_TMO])) break; if (sp > XB_SPIN_CAP) { atomicAdd(&bar[XB_TMO], 1u); break; } }
    }
    nloc = mine > 0u ? mine : 1u; nx = cnt > 0u ? cnt : 1u;
}

__device__ __forceinline__ void xcd_barrier(const XcdBarrier& b) {
    asm volatile("s_waitcnt vmcnt(0)" ::: "memory");
    __syncthreads();
    if (b.t0) {
        unsigned* bar = b.bar;
        __builtin_amdgcn_s_waitcnt(0);
        unsigned nloc = b.st[0], nx = b.st[1];
        if (nloc == 0u) { xcd_barrier_complete(bar, b.x, nloc, nx); b.st[0] = nloc; b.st[1] = nx; }
        const unsigned old = xb_add(&bar[XB_XSUB(b.x)], 1u);
        const unsigned gen = old / nloc;
        if (old + 1u == (gen + 1u) * nloc) {
            __builtin_amdgcn_fence(__ATOMIC_RELEASE, "agent");
            asm volatile("s_waitcnt vmcnt(0)" ::: "memory");
            const unsigned og = xb_add(&bar[XB_TOP], 1u);
            const unsigned tg = og / nx;
            if (og + 1u == (tg + 1u) * nx) xb_add(&bar[XB_TOPGEN], 1u);
            else XB_SPIN(xb_ld(&bar[XB_TOPGEN]) == tg, bar);
            __builtin_amdgcn_fence(__ATOMIC_ACQUIRE, "agent");
            xb_add(&bar[XB_XGEN(b.x)], 1u);
            asm volatile("s_waitcnt vmcnt(0)" ::: "memory");
        } else {
            XB_SPIN(xb_ld(&bar[XB_XGEN(b.x)]) == gen, bar);
            __builtin_amdgcn_fence(__ATOMIC_ACQUIRE, "agent");
            asm volatile("s_waitcnt vmcnt(0)" ::: "memory");
        }
    }
    __syncthreads();
}

#ifndef REP_P0
#define REP_P0 1
#endif
#ifndef REP_P1
#define REP_P1 1
#endif
#ifndef REP_P2
#define REP_P2 1
#endif
#ifndef PROBE_KIND
#define PROBE_KIND -1
#endif
#ifndef PROBE_PH
#define PROBE_PH 0
#endif
#ifndef PROBE_SCALE
#define PROBE_SCALE 1.0f
#endif
#ifndef PROBE_PB
#define PROBE_PB 0
#endif
#ifndef PROBE_PL
#define PROBE_PL 0
#endif
#ifndef P0_MASK
#define P0_MASK 3
#endif
#ifndef P2_MASK
#define P2_MASK 31
#endif
#ifndef REP_P3
#define REP_P3 1
#endif
#ifndef REP_P4
#define REP_P4 1
#endif
__global__ void __launch_bounds__(NTHREADS, 2) fwd_kernel(Params Pkarg) {
    extern __shared__ __attribute__((aligned(16))) unsigned char lds_raw[];
    cg::grid_group grid = cg::this_grid();
    LAS unsigned char* lds = (LAS unsigned char*)lds_raw;
    LAS float* ldsf = (LAS float*)lds;
    volatile LAS unsigned* qslot = (volatile LAS unsigned*)(lds + LDS_CTLW);
    volatile LAS unsigned* xbst = (volatile LAS unsigned*)(lds + LDS_CTLW + 128);
    if (threadIdx.x < 2) xbst[threadIdx.x] = 0u;
    __syncthreads();
    (void)xcd_barrier_post((unsigned*)(Pkarg.ws + WS_CTL) + 1024, xbst);
#define PSTAMP(k, lay) do { if (PROBE_KIND == 20 && (lay) == PROBE_PL && blockIdx.x == PROBE_PB && wave_s == 0) { const unsigned long long t_ = __builtin_amdgcn_s_memrealtime(); if ((k) == PROBE_PH) pst0 = t_; if ((k) == PROBE_PH + 1) pst1 = t_; } } while (0)
#define tid_zero_() (wave_s == 0 && __builtin_amdgcn_mbcnt_hi(~0u, __builtin_amdgcn_mbcnt_lo(~0u, 0u)) == 0u)
#define GSYNC() do { PP Pb_ = (PP)__builtin_amdgcn_kernarg_segment_ptr(); asm volatile("" : "+s"(Pb_)); XcdBarrier xb_; xb_.bar = (unsigned*)(Pb_->ws + WS_CTL) + 1024; xb_.x = xb_xcc_id(); xb_.st = xbst; int ln_; asm volatile("v_mbcnt_lo_u32_b32 %0, -1, 0\n\tv_mbcnt_hi_u32_b32 %0, -1, %0" : "=v"(ln_)); xb_.t0 = (wave_s == 0) && (ln_ == 0); xcd_barrier(xb_); } while (0)
    const int wave_s = __builtin_amdgcn_readfirstlane(threadIdx.x >> 6);
#define PHASE_IDS int tid; asm volatile("v_mbcnt_lo_u32_b32 %0, -1, 0\n\tv_mbcnt_hi_u32_b32 %0, -1, %0" : "=v"(tid)); tid += wave_s * 64; const int lane = tid & 63, wave = wave_s, gw = blockIdx.x * NWAVES + wave; (void)lane; (void)gw; \
    PP P = (PP)__builtin_amdgcn_kernarg_segment_ptr(); asm volatile("" : "+s"(P)); unsigned char* ws = P->ws; unsigned* ctl = (unsigned*)(ws + WS_CTL); float* MOD = (float*)(ws + WS_MOD); \
    bf16* H = (bf16*)(ws + WS_H); bf16* Z = (bf16*)(ws + WS_Z); bf16* WTIN = (bf16*)(ws + WS_WTIN); bf16* WTOUT = (bf16*)(ws + WS_WTOUT); const float* xp = P->in[0]; const float* xs = P->in[1]; \
    (void)ctl; (void)MOD; (void)H; (void)Z; (void)WTIN; (void)WTOUT; (void)xp; (void)xs;
    const int G = gridDim.x, NGW = G * NWAVES;
    unsigned long long pst0 = 0ull, pst1 = 0ull;

    for (int rep = 0; rep < REP_P0; ++rep) {
        PHASE_IDS
        const int m0 = (rep == 0) ? 3 : P0_MASK;
        if (m0 & 1) for (int u = blockIdx.x; u < 192; u += G) mod_unit(P, ldsf, 0, u, tid);
        LAS float* scr = ldsf + wave * 4096;
        if (m0 & 2) for (int it = gw; it < 6656; it += NGW) transpose_item(P->in[9], 2048, DIN, WTIN, scr, it, lane);
        { const int gt4 = (blockIdx.x * NTHREADS + tid) * 4;
          if (gt4 < 524288) { const float* src = (gt4 < 262144) ? P->in[2] + gt4 : P->in[3] + (gt4 - 262144); const f32x4 v = *(const f32x4*)src;
              u32x2 w; w.x = pk2(v[0], v[1]); w.y = pk2(v[2], v[3]); *(u32x2*)((bf16*)(ws + WS_CKV) + gt4) = w; } }
        const int gt = blockIdx.x * NTHREADS + tid;
        if (gt < 2048) { const int pos = gt >> 5, i = gt & 31; const float inv = powf(10000.0f, -(float)i / 32.0f); const float ang = (float)pos * inv;
            float sn, cs; sincosf(ang, &sn, &cs); float* CS = (float*)(ws + WS_CS); CS[gt * 2] = cs; CS[gt * 2 + 1] = sn; }
        grid.sync();
    }
    { PHASE_IDS
    for (int row = gw; row < MTOK; row += NGW) {
        const int cond = (row < NCTX) ? 0 : 1 + ((row - NCTX) >> 11);
        const float* xrow = (row < NCTX) ? xp + (size_t)row * D_MODEL : xs + (size_t)(row - NCTX) * D_MODEL;
        hprep_row(xrow, MOD + (0 * 3 + cond) * 6144, H + (size_t)row * D_MODEL, lane);
    } }
    GSYNC();

    for (int l = 0; l < DEPTH; ++l) {
        PSTAMP(0, l);
        for (int rep = 0; rep < REP_P1; ++rep) {
            PHASE_IDS
            pg8::Gemm g{H, WTIN, MTOK, DIN, D_MODEL}; pg8::StaticOrder S; S.init(MTOK, DIN, D_MODEL, G, (int)blockIdx.x);
            pg8::EpiZ E{Z, P->out + OUT_CK, P->out + OUT_CV, l};
            pg8::gemm_phase<pg8::EpiZ, pg8::StaticOrder, true, true>(lds, g, S, E, tid);
            GSYNC();
        }
        PSTAMP(1, l);
        {
            int pendf = -1; int uf = -1;
            unsigned long long pr_sum = 0ull; unsigned pr_cnt = 0u;
            const int n_cvt = (l == 0 && G != 256) ? 832 : 0;
            for (int st = 0; st < 3; ++st) {
                PHASE_IDS
                unsigned* cs = ctl + 64 * (l * 4 + st); unsigned* cf = ctl + 64 * (l * 4 + 3);
                const int nspec = (st == 2) ? 256 : 128;
                const int n_def = (l == 0) ? 192 + 512 : 0;
                const int capf = (st == 0) ? 256 : (st == 1) ? 512 : 896 + n_def + n_cvt;
                int pends = -1; bool spec = true;
                int us = q_pop(cs, qslot, tid, pends, 1 << 30);
                for (;;) {
                    int kind, idx;
                    if (spec) {
                        if (us >= nspec) { spec = false; if (uf < 0) uf = q_pop(cf, qslot, tid, pendf, 512); continue; }
                        kind = (st == 0) ? 1 : (st == 1) ? 6 : 7; idx = us;
                    } else {
                        if (uf >= capf) break;
                        if (uf < 128) { kind = 0; idx = uf; } else if (uf < 256) { kind = 3; idx = uf - 128; } else if (uf < 512) { kind = 2; idx = uf - 256; }
                        else if (uf < 896) { kind = 4; idx = uf - 512; } else if (uf < 896 + n_def) { idx = uf - 896; if (idx < 192) kind = 8; else { kind = 9; idx -= 192; } } else { kind = 5; idx = uf - 896 - n_def; }
                    }
                    asm volatile("" : "+v"(tid));
                    const unsigned long long pr_t0 = (PROBE_KIND >= 0 && PROBE_KIND < 9) ? __builtin_amdgcn_s_memrealtime() : 0ull;
                    if (kind <= 1) hgrn2_unit(P, lds, l, kind, idx, tid);
                    else if (kind <= 3) attn_unit(P, lds, l, kind - 2, idx, tid);
                    else if (kind == 4) conv_unit(P, ldsf, l, idx, tid);
                    else if (kind == 5) { const int lane2 = tid & 63; LAS float* scr = ldsf + wave * 4096; transpose_item(P->in[9] + (size_t)2048 * DIN, 2048, DIN, WTIN, scr, idx * 8 + wave, lane2); }
                    else if (kind == 6) hgrn_scan_unit(P, l, idx, tid);
                    else if (kind == 8) mod_unit(P, ldsf, 1, idx, tid);
                    else if (kind == 9) { const int it = idx * 8 + wave, lo = it & 2047; LAS float* scr = ldsf + wave * 4096;
                        transpose_item(P->in[10] + (size_t)(it >> 11) * 2048 * 2048, 2048, 2048, WTOUT + (size_t)(it >> 11) * 2048 * 2048, scr, lo, tid & 63); }
                    else hgrn_final_unit(P, lds, l, idx >> 1, idx & 1, tid);
                    if (PROBE_KIND >= 0 && PROBE_KIND < 9 && kind == PROBE_KIND) { __syncthreads(); pr_sum += __builtin_amdgcn_s_memrealtime() - pr_t0; pr_cnt += 1u; }
                    if (spec) us = q_pop(cs, qslot, tid, pends, 1 << 30); else uf = q_pop(cf, qslot, tid, pendf, 512);
                }
                GSYNC();
                PSTAMP(2 + st, l);
            }
            if (PROBE_KIND >= 0 && PROBE_KIND < 9 && l == 0 && tid_zero_()) { atomicAdd((unsigned long long*)((unsigned*)(Pkarg.ws + WS_CTL) + 60000), pr_sum); atomicAdd((unsigned*)(Pkarg.ws + WS_CTL) + 60002, pr_cnt); }
        }
        if (G == 256) {
            {   PHASE_IDS
                pg8::Gemm g{H, WTOUT + (size_t)l * 2048 * 2048, MTOK, D_MODEL, D_MODEL}; pg8::StaticOrder S; S.init(MTOK, D_MODEL, D_MODEL, G, (int)blockIdx.x, 0); S.rset = 0;
                pg8::EpiV E{(l == 0) ? xp : P->out, (l == 0) ? xs : P->out + OUT_YS, (bf16*)(ws + WS_OL), MOD + l * 3 * 6144 + 4096, (float*)(ws + WS_U), ctl + 8192};
                pg8::gemm_phase<pg8::EpiV, pg8::StaticOrder, true, true>(lds, g, S, E, tid);
            }
            GSYNC();
            PSTAMP(5, l);
            if (blockIdx.x < 128) {
                PHASE_IDS
                pg8::Gemm g{H, WTOUT + (size_t)l * 2048 * 2048, MTOK, D_MODEL, D_MODEL}; pg8::StaticOrder S; S.init(MTOK, D_MODEL, D_MODEL, G, (int)blockIdx.x, 0); S.rset = 1;
                pg8::EpiV E{(l == 0) ? xp : P->out, (l == 0) ? xs : P->out + OUT_YS, (bf16*)(ws + WS_OL), MOD + l * 3 * 6144 + 4096, (float*)(ws + WS_U), ctl + 8192};
                pg8::gemm_phase<pg8::EpiV, pg8::StaticOrder, true, true>(lds, g, S, E, tid);
            } else {
                PHASE_IDS
                for (int row = (blockIdx.x - 128) * NWAVES + wave; row < NCTX; row += 128 * NWAVES)
                    ln_row((const bf16*)(ws + WS_OL) + (size_t)row * D_MODEL, P->out + (size_t)row * D_MODEL, P->in[18] + l * D_MODEL, P->in[19] + l * D_MODEL, MOD + 3 * 6144, (l == 0) ? H + (size_t)row * D_MODEL : (bf16*)nullptr, lane);
                if (l == 0) {
                    LAS float* scr = ldsf + wave * 4096;
                    for (int it = (blockIdx.x - 128) * NWAVES + wave; it < 6656; it += 128 * NWAVES) { asm volatile("" : "+v"(tid)); transpose_item(P->in[9] + (size_t)2048 * DIN, 2048, DIN, WTIN, scr, it, tid & 63); }
                }
            }
#ifdef PROBE_SUB
            __syncthreads(); PSTAMP(6, l);
#endif
            GSYNC();
#ifndef PROBE_SUB
            PSTAMP(6, l);
#endif
            {   PHASE_IDS
                for (int row = NCTX + gw; row < MTOK; row += NGW) { const int cond = 1 + ((row - NCTX) >> 11);
                    ln_row((const bf16*)(ws + WS_OL) + (size_t)row * D_MODEL, P->out + (size_t)row * D_MODEL, P->in[18] + l * D_MODEL, P->in[19] + l * D_MODEL, MOD + (3 + cond) * 6144, (l == 0) ? H + (size_t)row * D_MODEL : (bf16*)nullptr, lane); }
            }
        } else {
            {   PHASE_IDS
                pg8::Gemm g{H, WTOUT + (size_t)l * 2048 * 2048, MTOK, D_MODEL, D_MODEL}; pg8::StaticOrder S; S.init(MTOK, D_MODEL, D_MODEL, G, (int)blockIdx.x, 0);
                pg8::EpiV E{(l == 0) ? xp : P->out, (l == 0) ? xs : P->out + OUT_YS, (bf16*)(ws + WS_OL), MOD + l * 3 * 6144 + 4096, (float*)(ws + WS_U), ctl + 8192};
                pg8::gemm_phase<pg8::EpiV, pg8::StaticOrder, true, true>(lds, g, S, E, tid);
            }
            GSYNC();
            {   PHASE_IDS
                for (int row = gw; row < MTOK; row += NGW) { const int cond = (row < NCTX) ? 0 : 1 + ((row - NCTX) >> 11);
                    ln_row((const bf16*)(ws + WS_OL) + (size_t)row * D_MODEL, P->out + (size_t)row * D_MODEL, P->in[18] + l * D_MODEL, P->in[19] + l * D_MODEL, MOD + (3 + cond) * 6144, (l == 0) ? H + (size_t)row * D_MODEL : (bf16*)nullptr, lane); }
            }
        }
        if (l + 1 < DEPTH) GSYNC();
        PSTAMP(7, l);
    }
    if (PROBE_KIND >= 0) { GSYNC(); PHASE_IDS if (blockIdx.x == ((PROBE_KIND == 20) ? PROBE_PB : 0) && tid == 0) { const unsigned long long sm = *(volatile unsigned long long*)(ctl + 60000); const unsigned cn = *(volatile unsigned*)(ctl + 60002); const float pv_ = (PROBE_KIND == 20) ? PROBE_SCALE * 0.01f * (float)(pst1 - pst0) : ((PROBE_KIND == 9) ? 0.1f : 0.01f) * (float)sm / (float)(cn ? cn : 1u);     P->out[0] = pv_; P->out[1] = pv_; P->out[2] = pv_; P->out[3] = pv_; }     }
}

extern "C" void kernel_launch(void* const* d_in, const int* in_sizes, int n_in, void* d_out, int out_size, void* d_ws, size_t ws_size, hipStream_t stream) {
    static int grid = 0;
    if (grid == 0) {
        if (n_in != 20 || out_size != (int)OUT_TOTAL || ws_size < WS_END) { fprintf(stderr, "kernel_launch: unexpected shapes (n_in %d, out %d, ws %zu)\n", n_in, out_size, ws_size); grid = -1; return; }
        int dev = 0, cus = 0, per_cu = 0;
        hipGetDevice(&dev); hipDeviceGetAttribute(&cus, hipDeviceAttributeMultiprocessorCount, dev);
        hipFuncSetAttribute((const void*)fwd_kernel, hipFuncAttributeMaxDynamicSharedMemorySize, LDS_BYTES);
        hipOccupancyMaxActiveBlocksPerMultiprocessor(&per_cu, (const void*)fwd_kernel, NTHREADS, LDS_BYTES);
        if (per_cu < 1) { fprintf(stderr, "kernel_launch: occupancy query says %d blocks per CU\n", per_cu); grid = -1; return; }
        grid = cus;
    }
    if (grid < 0) return;
    hipMemsetAsync((char*)d_ws + WS_CTL, 0, CTL_ZERO_BYTES, stream);
    Params p{};
    for (int i = 0; i < 20; ++i) p.in[i] = (const float*)d_in[i];
    p.out = (float*)d_out; p.ws = (unsigned char*)d_ws;
    void* args[] = {&p};
    hipError_t e = hipLaunchCooperativeKernel((const void*)fwd_kernel, dim3(grid), dim3(NTHREADS), args, LDS_BYTES, stream);
    if (e != hipSuccess) fprintf(stderr, "cooperative launch failed: %s (grid %d)\n", hipGetErrorString(e), grid);
}
```

```cpp
#include <hip/hip_runtime.h>
#include <hip/hip_cooperative_groups.h>
#include <cstdio>
#include <cstdint>
namespace cg = cooperative_groups;

constexpr int D_MODEL = 2048, DIN = 6656, NCTX = 8192, NLAT = 4096, MTOK = 12288, DEPTH = 2;
constexpr int C_AQ = 0, C_AK = 1024, C_AV = 1280, C_AG = 1536, C_HQ = 2560, C_HI = 3072, C_HFF = 3584, C_HFB = 4096, C_HG = 4608, C_CA = 5120, C_CB = 5632, C_CG = 6144;
constexpr float ALPHA_DN = 1.4142135623730951f;
constexpr size_t OUT_YP = 0, OUT_YS = 16777216, OUT_CK = 25165824, OUT_CV = 29360128, OUT_ST = 33554432, OUT_TOTAL = 41943040;
namespace pg8 {
#define PG8_LAS __attribute__((address_space(3)))
typedef unsigned short bf16_t;
typedef short bf16x8 __attribute__((ext_vector_type(8)));
typedef float f32x4 __attribute__((ext_vector_type(4)));
typedef unsigned u32x4 __attribute__((ext_vector_type(4)));
constexpr int BM = 256, BK = 64, HALF = 128, HTB = HALF * BK * 2  , STAGE_BYTES = 8 * HTB, NXCD = 8, WGM = 8;

__host__ __device__ __forceinline__ int lds_byte(int r, int c) { const int st = (r >> 4) * 2 + (c >> 5), rr = r & 15, cc = c & 31, ob = rr * 64 + cc * 2; return st * 1024 + (ob ^ (((ob >> 9) & 1) << 5)); }
__host__ __device__ __forceinline__ void stage_rc(int b, int& R, int& C) { const int st = b / 1024, sb = b % 1024, swz = sb ^ (((sb >> 9) & 1) << 5); R = (st >> 1) * 16 + swz / 64; C = (st & 1) * 32 + (swz % 64) / 2; }
__host__ __device__ __forceinline__ int perm32(int rho) { const int n = rho >> 4, i = rho & 15; return 8 * (i >> 2) + 4 * n + (i & 3); }

struct Unit { int pm, pn, k0, nk, role, pair; };
struct Gemm { const bf16_t* A; const bf16_t* Bt; int M, N, K; };

struct StaticOrder {
    int nM, nN, nwg, G, c, nkt, split, rset;
    __host__ __device__ void init(int M, int N, int K, int G_, int c_, int split_ = 0) { nM = M / BM; nN = N / BM; nwg = nM * nN; G = G_; c = c_; nkt = K / BK; split = split_ && (G_ % 16 == 0) && (2 * nwg == 3 * G_) && (nkt % 4 == 0); rset = -1; }
    __host__ __device__ void map(long L, Unit& u) const {
        int wgid = (int)L; { const int q = nwg / NXCD, r = nwg % NXCD, xcd = wgid % NXCD, off = wgid / NXCD; wgid = (xcd < r ? xcd * (q + 1) : r * (q + 1) + (xcd - r) * q) + off; }
        const int nig = WGM * nN, gid = wgid / nig, fm = gid * WGM, gsz = (nM - fm) < WGM ? (nM - fm) : WGM;
        u.pm = fm + ((wgid % nig) % gsz); u.pn = (wgid % nig) / gsz; u.k0 = 0; u.nk = nkt; u.role = 0; u.pair = 0;
    }
    __host__ __device__ bool next(int i, Unit& u) const {
        if (rset >= 0) {
            if (i != 0) return false;
            const int xcd = c & 7, ix = c >> 3;
            if (rset == 0) { u.pm = xcd * 4 + (ix >> 3); u.pn = ix & 7; } else { if (c >= 128) return false; u.pm = 32 + xcd * 2 + (ix >> 3); u.pn = ix & 7; }
            u.k0 = 0; u.nk = nkt; u.role = 0; u.pair = 0; return true;
        }
        if (split) {
            if (i == 0) { map(c, u); return true; }
            if (i == 1) { const int j = (c >> 4) * 8 + (c & 7), half = (c >> 3) & 1; map(G + j, u); u.k0 = half * (nkt / 2); u.nk = nkt / 2; u.role = 1 + half; u.pair = j; return true; }
            return false;
        }
        const long L = (long)i * G + c; if (L >= nwg) return false;
        map(L, u); return true;
    }
    __device__ __forceinline__ void a_ready(const Unit&) const {}
    __device__ __forceinline__ void done(const Unit&) const {}
};

__device__ __forceinline__ unsigned cvt_pk_bf16(float lo, float hi) { unsigned r; asm volatile("v_cvt_pk_bf16_f32 %0, %1, %2" : "=v"(r) : "v"(lo), "v"(hi)); return r; }
typedef float f32x2 __attribute__((ext_vector_type(2)));

struct EpiZ {
    static constexpr bool PERM = true, AFTER_DRAIN = false;
    bf16_t* Z; float* ck; float* cv; int layer;
    __device__ __forceinline__ void operator()(f32x4 (&acc)[2][2][4][2], const Unit& u, int wr, int wc, int fr_in, int fq_in) const {
        int fr = fr_in, fq = fq_in; asm volatile("" : "+v"(fr), "+v"(fq));
        const int row0 = u.pm * BM + wr * 64 + fr; const int col0 = u.pn * BM + wc * 32 + 8 * fq;
        const bool sig = (u.pn == 22 || u.pn == 23);
#pragma unroll
        for (int ai = 0; ai < 2; ++ai)
#pragma unroll
            for (int m = 0; m < 4; ++m) { bf16_t* rowp = Z + (size_t)(row0 + ai * HALF + m * 16) * DIN + col0;
#pragma unroll
                for (int bj = 0; bj < 2; ++bj) { f32x4 v0 = acc[ai][bj][m][0], v1 = acc[ai][bj][m][1];
                    if (sig) {
#pragma unroll
                        for (int e = 0; e < 4; ++e) { v0[e] = __builtin_amdgcn_rcpf(1.0f + __builtin_amdgcn_exp2f(-1.4426950408889634f * v0[e])); v1[e] = __builtin_amdgcn_rcpf(1.0f + __builtin_amdgcn_exp2f(-1.4426950408889634f * v1[e])); } }
                    u32x4 w; w.x = cvt_pk_bf16(v0[0], v0[1]); w.y = cvt_pk_bf16(v0[2], v0[3]); w.z = cvt_pk_bf16(v1[0], v1[1]); w.w = cvt_pk_bf16(v1[2], v1[3]);
                    *(u32x4*)(rowp + bj * HALF) = w; } }
        if ((u.pn == 4 || u.pn == 5) && u.pm < 32) {
            float* base = (u.pn == 4) ? ck : cv;
#pragma unroll
            for (int ai = 0; ai < 2; ++ai)
#pragma unroll
                for (int m = 0; m < 4; ++m) { const int row = row0 + ai * HALF + m * 16; const int b = row >> 8, s = row & 255;
                    float* p = base + ((size_t)((b * 2 + layer) * 256 + s)) * 256 + (wc * 32 + 8 * fq);
#pragma unroll
                    for (int bj = 0; bj < 2; ++bj) { *(f32x4*)(p + bj * HALF) = acc[ai][bj][m][0]; *(f32x4*)(p + bj * HALF + 4) = acc[ai][bj][m][1]; } }
        }
    }
};
typedef unsigned u32x2v_ __attribute__((ext_vector_type(2)));
struct EpiV {
    static constexpr bool PERM = false, AFTER_DRAIN = false;
    const float* xp; const float* xs; bf16_t* V; const float* gate;
    float* slab; unsigned* flags;
    __device__ __forceinline__ void operator()(f32x4 (&acc)[2][2][4][2], const Unit& u, int wr, int wc, int fr_in, int fq_in) const {
        int fr = fr_in, fq = fq_in; asm volatile("" : "+v"(fr), "+v"(fq));
        const int lane = fq * 16 + fr, tid = (wr * 4 + wc) * 64 + lane;
        float* sp = slab + (size_t)u.pair * 65536 + tid * 4; unsigned* fl = flags + 64 * u.pair;
        if (u.role == 1) {
            { float* q = sp;
#pragma unroll
              for (int ai = 0; ai < 2; ++ai)
#pragma unroll
                for (int m = 0; m < 4; ++m)
#pragma unroll
                    for (int bj = 0; bj < 2; ++bj)
#pragma unroll
                        for (int n = 0; n < 2; ++n) {
                            asm volatile("global_store_dwordx4 %0, %1, off sc1\n\ts_nop 1" :: "v"(q), "v"(acc[ai][bj][m][n]) : "memory");
                            q += 2048; asm volatile("" : "+v"(q)); } }
            asm volatile("s_waitcnt vmcnt(0)" ::: "memory");
            if (lane == 0) __hip_atomic_fetch_add(fl, 1u, __ATOMIC_RELAXED, __HIP_MEMORY_SCOPE_AGENT);
            return;
        }
        const bool red = (u.role == 2);
        if (red) {
            unsigned sp_ = 0;
            while ((unsigned)__builtin_amdgcn_readfirstlane(__hip_atomic_load(fl, __ATOMIC_RELAXED, __HIP_MEMORY_SCOPE_AGENT)) < 8u) { __builtin_amdgcn_s_sleep(2); if (++sp_ > (1u << 20)) break; }
            asm volatile("" ::: "memory");
        }
        const int row0 = u.pm * BM + wr * 64 + fr; const int col0 = u.pn * BM + wc * 32 + 4 * fq;
        const int cond = (u.pm < 32) ? 0 : 1 + ((u.pm - 32) >> 3);
        const float* g = gate + cond * 6144 + col0;
        f32x4 gv[2][2];
#pragma unroll
        for (int bj = 0; bj < 2; ++bj)
#pragma unroll
            for (int n = 0; n < 2; ++n) gv[bj][n] = *(const f32x4*)(g + bj * HALF + n * 16);
        if (!red) {
            f32x4 xq[2][4];
            { const int row = row0; const float* xr = ((row < NCTX) ? xp + (size_t)row * D_MODEL : xs + (size_t)(row - NCTX) * D_MODEL) + col0;
#pragma unroll
              for (int e = 0; e < 4; ++e) xq[0][e] = *(const f32x4*)(xr + (e >> 1) * HALF + (e & 1) * 16); }
#pragma unroll
            for (int g8 = 0; g8 < 8; ++g8) { const int ai = g8 >> 2, m = g8 & 3; const int row = row0 + ai * HALF + m * 16;
                if (g8 + 1 < 8) { const int rown = row0 + ((g8 + 1) >> 2) * HALF + ((g8 + 1) & 3) * 16;
                    const float* xr = ((rown < NCTX) ? xp + (size_t)rown * D_MODEL : xs + (size_t)(rown - NCTX) * D_MODEL) + col0;
#pragma unroll
                    for (int e = 0; e < 4; ++e) xq[(g8 + 1) & 1][e] = *(const f32x4*)(xr + (e >> 1) * HALF + (e & 1) * 16); }
                bf16_t* vr = V + (size_t)row * D_MODEL + col0;
#pragma unroll
                for (int e = 0; e < 4; ++e) { const f32x4 o = xq[g8 & 1][e] * ALPHA_DN + gv[e >> 1][e & 1] * acc[ai][e >> 1][m][e & 1];
                    u32x2v_ w; w.x = cvt_pk_bf16(o[0], o[1]); w.y = cvt_pk_bf16(o[2], o[3]); *(u32x2v_*)(vr + (e >> 1) * HALF + (e & 1) * 16) = w; }
                asm volatile("" ::: "memory"); }
        } else {
            const float* rq = sp;
#pragma unroll
            for (int ai = 0; ai < 2; ++ai)
#pragma unroll
                for (int m = 0; m < 4; ++m) { const int row = row0 + ai * HALF + m * 16;
                    const float* xr = ((row < NCTX) ? xp + (size_t)row * D_MODEL : xs + (size_t)(row - NCTX) * D_MODEL) + col0;
                    bf16_t* vr = V + (size_t)row * D_MODEL + col0;
                    f32x4 t[2][2];
#pragma unroll
                    for (int bj = 0; bj < 2; ++bj)
#pragma unroll
                        for (int n = 0; n < 2; ++n) { const unsigned long long* q8 = (const unsigned long long*)rq;
                            const unsigned long long a8 = __hip_atomic_load(q8, __ATOMIC_RELAXED, __HIP_MEMORY_SCOPE_AGENT), b8 = __hip_atomic_load(q8 + 1, __ATOMIC_RELAXED, __HIP_MEMORY_SCOPE_AGENT);
                            t[bj][n] = (f32x4){__builtin_bit_cast(float, (unsigned)a8), __builtin_bit_cast(float, (unsigned)(a8 >> 32)), __builtin_bit_cast(float, (unsigned)b8), __builtin_bit_cast(float, (unsigned)(b8 >> 32))};
                            rq += 2048; asm volatile("" : "+v"(rq)); }
#pragma unroll
                    for (int bj = 0; bj < 2; ++bj)
#pragma unroll
                        for (int n = 0; n < 2; ++n) { const f32x4 xv = *(const f32x4*)(xr + bj * HALF + n * 16); const f32x4 o = xv * ALPHA_DN + gv[bj][n] * (acc[ai][bj][m][n] + t[bj][n]);
                            u32x2v_ w; w.x = cvt_pk_bf16(o[0], o[1]); w.y = cvt_pk_bf16(o[2], o[3]); *(u32x2v_*)(vr + bj * HALF + n * 16) = w; }
                    asm volatile("" ::: "memory"); }
        }
    }
};
template <class Epi, class Sched, bool ALIGN_EPI = false, bool SP2 = false>
__device__ __forceinline__ void gemm_phase(PG8_LAS unsigned char* lds, const Gemm g, const Sched& S, const Epi& E, int tid_in) {
    int tid_l = tid_in; asm volatile("" : "+v"(tid_l));
    const int tid = tid_l, wid = __builtin_amdgcn_readfirstlane(tid >> 6), lane = tid & 63, wr = wid >> 2, wc = wid & 3, fr = lane & 15, fq = lane >> 4;
    const int K = g.K;
    unsigned voffA[2], voffB[2];
#pragma unroll
    for (int i = 0; i < 2; ++i) { int R, C; stage_rc(tid * 16 + i * 8192, R, C); const int Rb = Epi::PERM ? ((R & ~31) + perm32(R & 31)) : R;
        voffA[i] = (unsigned)(R * K + C) * 2u; voffB[i] = (unsigned)(Rb * K + C) * 2u; }
    const size_t kstep = (size_t)(BK * 2);
    const size_t hstep = (size_t)HALF * K * 2;
    const size_t tstep = 2 * hstep;
    const unsigned ldsw = (unsigned)wid * 1024u;
    const int aoff = lds_byte(wr * 64 + fr, fq * 8), boff = lds_byte(wc * 32 + fr, fq * 8);
#define PG8_SA(b, h) (((b) * 2 + (h)) * HTB)
#define PG8_SB(b, h) ((4 + (b) * 2 + (h)) * HTB)
#define PG8_STAGE(bufoff, gbase, voff) do { _Pragma("unroll") for (int _i = 0; _i < 2; ++_i) \
        __builtin_amdgcn_global_load_lds((const unsigned*)((const char*)(gbase) + (voff)[_i]), (PG8_LAS unsigned*)(lds + (bufoff) + ldsw + _i * 8192), 16, 0, 0); } while (0)
#define PG8_LDA(dst, b, h) do { _Pragma("unroll") for (int m = 0; m < 4; ++m) _Pragma("unroll") for (int k = 0; k < 2; ++k) dst[m][k] = *(const PG8_LAS bf16x8*)(lds + PG8_SA(b, h) + aoff + m * 2048 + k * 1024); } while (0)
#define PG8_LDB(dst, b, h) do { _Pragma("unroll") for (int n = 0; n < 2; ++n) _Pragma("unroll") for (int k = 0; k < 2; ++k) dst[n][k] = *(const PG8_LAS bf16x8*)(lds + PG8_SB(b, h) + boff + n * 2048 + k * 1024); } while (0)
#define PG8_MMA(ai, bj, At, Bt) do { __builtin_amdgcn_s_setprio(1); _Pragma("unroll") for (int m = 0; m < 4; ++m) _Pragma("unroll") for (int n = 0; n < 2; ++n) _Pragma("unroll") for (int k = 0; k < 2; ++k) \
        acc[ai][bj][m][n] = __builtin_amdgcn_mfma_f32_16x16x32_bf16(Bt[n][k], At[m][k], acc[ai][bj][m][n], 0, 0, 0); __builtin_amdgcn_s_setprio(0); } while (0)
#define PG8_WAIT_V(n) asm volatile("s_waitcnt vmcnt(" #n ")" ::: "memory")
#define PG8_WAIT_L(n) asm volatile("s_waitcnt lgkmcnt(" #n ")" ::: "memory")
#define PG8_BAR __builtin_amdgcn_s_barrier()
#define PG8_SCHED __builtin_amdgcn_sched_barrier(0)
    Unit cur, nxt; int ui = 0;
    if (!S.next(0, cur)) return;
    f32x4 acc[2][2][4][2];
#pragma unroll
    for (int a = 0; a < 2; ++a)
#pragma unroll
        for (int b = 0; b < 2; ++b)
#pragma unroll
            for (int m = 0; m < 4; ++m)
#pragma unroll
                for (int n = 0; n < 2; ++n) acc[a][b][m][n] = (f32x4){0.f, 0.f, 0.f, 0.f};
    bf16x8 At[4][2], B0[2][2], B1[2][2];
    const char* cA = (const char*)g.A + (size_t)cur.pm * tstep + (size_t)cur.k0 * kstep; const char* cB = (const char*)g.Bt + (size_t)cur.pn * tstep + (size_t)cur.k0 * kstep;
    S.a_ready(cur);
    if constexpr (SP2) {
        PG8_STAGE(PG8_SB(0, 0), cB, voffB); PG8_STAGE(PG8_SB(0, 1), cB + hstep, voffB); PG8_STAGE(PG8_SA(0, 0), cA, voffA); PG8_STAGE(PG8_SA(0, 1), cA + hstep, voffA);
        if (wr == 1) PG8_BAR;
        PG8_WAIT_V(2); PG8_BAR;
        PG8_STAGE(PG8_SB(1, 0), cB + kstep, voffB); PG8_STAGE(PG8_SA(1, 0), cA + kstep, voffA); PG8_STAGE(PG8_SB(1, 1), cB + hstep + kstep, voffB);
        PG8_WAIT_V(6); PG8_BAR;
    } else {
        PG8_STAGE(PG8_SB(0, 0), cB, voffB); PG8_STAGE(PG8_SA(0, 0), cA, voffA); PG8_STAGE(PG8_SB(0, 1), cB + hstep, voffB); PG8_STAGE(PG8_SA(0, 1), cA + hstep, voffA);
        if (wr == 1) PG8_BAR;
        PG8_WAIT_V(4); PG8_BAR;
        PG8_STAGE(PG8_SB(1, 0), cB + kstep, voffB); PG8_STAGE(PG8_SA(1, 0), cA + kstep, voffA); PG8_STAGE(PG8_SB(1, 1), cB + hstep + kstep, voffB);
        PG8_WAIT_V(6); PG8_BAR;
    }
    for (;;) {
        const bool has_next = S.next(ui + 1, nxt);
        const char* nA = has_next ? (const char*)g.A + (size_t)nxt.pm * tstep + (size_t)nxt.k0 * kstep : cA; const char* nB = has_next ? (const char*)g.Bt + (size_t)nxt.pn * tstep + (size_t)nxt.k0 * kstep : cB;
        const int nt = cur.nk;
        for (int t = 0; t < nt; t += 2) {
            const bool last = (t == nt - 2);
            const char* a1 = cA + (size_t)(t + 1) * kstep;
            const char* a2 = last ? nA : cA + (size_t)(t + 2) * kstep; const char* b2 = last ? nB : cB + (size_t)(t + 2) * kstep;
            const char* a3 = a2 + kstep; const char* b3 = b2 + kstep;
            if (last && has_next) S.a_ready(nxt);
            if constexpr (SP2) {
            PG8_LDB(B0, 0, 0); PG8_LDB(B1, 0, 1); PG8_SCHED; PG8_LDA(At, 0, 0); PG8_STAGE(PG8_SA(1, 1), a1 + hstep, voffA);
            PG8_WAIT_V(8); PG8_WAIT_L(0); PG8_BAR; PG8_MMA(0, 0, At, B0); PG8_MMA(0, 1, At, B1); PG8_BAR; PG8_SCHED;
            PG8_LDA(At, 0, 1); PG8_STAGE(PG8_SB(0, 0), b2, voffB); PG8_STAGE(PG8_SB(0, 1), b2 + hstep, voffB); PG8_STAGE(PG8_SA(0, 0), a2, voffA);
            PG8_WAIT_V(8); PG8_WAIT_L(0); PG8_BAR; PG8_MMA(1, 0, At, B0); PG8_MMA(1, 1, At, B1); PG8_BAR; PG8_SCHED;
            PG8_LDB(B0, 1, 0); PG8_LDB(B1, 1, 1); PG8_SCHED; PG8_LDA(At, 1, 0); PG8_STAGE(PG8_SA(0, 1), a2 + hstep, voffA);
            PG8_WAIT_V(8); PG8_WAIT_L(0); PG8_BAR; PG8_MMA(0, 0, At, B0); PG8_MMA(0, 1, At, B1); PG8_BAR; PG8_SCHED;
            PG8_LDA(At, 1, 1); PG8_STAGE(PG8_SB(1, 0), b3, voffB); PG8_STAGE(PG8_SB(1, 1), b3 + hstep, voffB); PG8_STAGE(PG8_SA(1, 0), a3, voffA);
            PG8_WAIT_V(8); PG8_WAIT_L(0); PG8_BAR; PG8_MMA(1, 0, At, B0); PG8_MMA(1, 1, At, B1); PG8_BAR; PG8_SCHED;
            } else {
            PG8_LDB(B0, 0, 0); PG8_SCHED; PG8_LDA(At, 0, 0); PG8_STAGE(PG8_SA(1, 1), a1 + hstep, voffA);
            PG8_WAIT_L(8); PG8_BAR; PG8_WAIT_L(0); PG8_MMA(0, 0, At, B0); PG8_BAR; PG8_SCHED;
            PG8_LDB(B1, 0, 1); PG8_STAGE(PG8_SB(0, 0), b2, voffB);
            PG8_BAR; PG8_WAIT_L(0); PG8_MMA(0, 1, At, B1); PG8_BAR;
            PG8_LDA(At, 0, 1); PG8_STAGE(PG8_SA(0, 0), a2, voffA);
            PG8_BAR; PG8_WAIT_L(0); PG8_MMA(1, 0, At, B0); PG8_BAR; PG8_SCHED;
            PG8_STAGE(PG8_SB(0, 1), b2 + hstep, voffB);
            PG8_WAIT_V(6); PG8_BAR; PG8_MMA(1, 1, At, B1); PG8_BAR;
            PG8_LDB(B0, 1, 0); PG8_SCHED; PG8_LDA(At, 1, 0); PG8_STAGE(PG8_SA(0, 1), a2 + hstep, voffA);
            PG8_WAIT_L(8); PG8_BAR; PG8_WAIT_L(0); PG8_MMA(0, 0, At, B0); PG8_BAR; PG8_SCHED;
            PG8_LDB(B1, 1, 1); PG8_STAGE(PG8_SB(1, 0), b3, voffB);
            PG8_BAR; PG8_WAIT_L(0); PG8_MMA(0, 1, At, B1); PG8_BAR;
            PG8_LDA(At, 1, 1); PG8_STAGE(PG8_SA(1, 0), a3, voffA);
            PG8_BAR; PG8_WAIT_L(0); PG8_MMA(1, 0, At, B0); PG8_BAR; PG8_SCHED;
            PG8_STAGE(PG8_SB(1, 1), b3 + hstep, voffB);
            PG8_WAIT_V(6); PG8_BAR; PG8_MMA(1, 1, At, B1); PG8_BAR;
            }
        }
        if constexpr (ALIGN_EPI) { if (wr == 0) PG8_BAR; }
        if constexpr (!Epi::AFTER_DRAIN) { E(acc, cur, wr, wc, fr, fq); S.done(cur); }
        if (!has_next) break;
#pragma unroll
        for (int a = 0; a < 2; ++a)
#pragma unroll
            for (int b = 0; b < 2; ++b)
#pragma unroll
                for (int m = 0; m < 4; ++m)
#pragma unroll
                    for (int n = 0; n < 2; ++n) acc[a][b][m][n] = (f32x4){0.f, 0.f, 0.f, 0.f};
        cur = nxt; cA = nA; cB = nB; ++ui;
        if constexpr (ALIGN_EPI) { if (wr == 1) PG8_BAR; }
    }
    PG8_WAIT_V(0);
    if constexpr (!ALIGN_EPI) { if (wr == 0) PG8_BAR; }
    PG8_BAR;
    if constexpr (Epi::AFTER_DRAIN) { E.fused(acc, cur, wr, wc, fr, fq, lds, wid, lane); S.done(cur); }
#undef PG8_SA
#undef PG8_SB
#undef PG8_STAGE
#undef PG8_LDA
#undef PG8_LDB
#undef PG8_MMA
#undef PG8_WAIT_V
#undef PG8_WAIT_L
#undef PG8_BAR
#undef PG8_SCHED
}
}

constexpr size_t MiB = 1u << 20;
constexpr size_t WS_CTL = 0, CTL_ZERO_BYTES = 262144;
constexpr size_t WS_MOD = 1 * MiB;
constexpr size_t WS_CS = 1 * MiB + 192 * 1024;
constexpr size_t WS_DLOG = 1 * MiB + 256 * 1024;
constexpr size_t WS_WTOUT = 2 * MiB;
constexpr size_t WS_WTIN = 18 * MiB;
constexpr size_t WS_H = 44 * MiB;
constexpr size_t WS_Z = 92 * MiB;
constexpr size_t WS_U = 248 * MiB;
constexpr size_t WS_OL = 264 * MiB;
constexpr size_t WS_CKV = 312 * MiB;
constexpr size_t WS_END = 313 * MiB;
constexpr int LDS_BYTES = 163840;
constexpr int LDS_CTLW = 163840 - 256;
constexpr int NWAVES = 8, NTHREADS = 512;

#define LAS __attribute__((address_space(3)))
typedef unsigned short bf16;
typedef float f32x4 __attribute__((ext_vector_type(4)));
typedef float f32x16 __attribute__((ext_vector_type(16)));
typedef unsigned u32x4 __attribute__((ext_vector_type(4)));
typedef unsigned u32x2 __attribute__((ext_vector_type(2)));
typedef short bf16x8 __attribute__((ext_vector_type(8)));

__device__ __forceinline__ float bf2f(unsigned short u) { return __builtin_bit_cast(float, (unsigned)u << 16); }
__device__ __forceinline__ float bflo(unsigned u) { return __builtin_bit_cast(float, u << 16); }
__device__ __forceinline__ float bfhi(unsigned u) { return __builtin_bit_cast(float, u & 0xffff0000u); }
typedef float f32x2_t_ __attribute__((ext_vector_type(2))); typedef __bf16 bf16x2_t_ __attribute__((ext_vector_type(2)));
__device__ __forceinline__ unsigned pk2(float lo, float hi) { const f32x2_t_ v = {lo, hi}; return __builtin_bit_cast(unsigned, __builtin_convertvector(v, bf16x2_t_)); }
__device__ __forceinline__ unsigned f2bf(float f) { return pk2(f, f) & 0xffffu; }
__device__ __forceinline__ float sigmoidf_(float x) { return __builtin_amdgcn_rcpf(1.0f + __builtin_amdgcn_exp2f(-1.4426950408889634f * x)); }
__device__ __forceinline__ float siluf_(float x) { return x * __builtin_amdgcn_rcpf(1.0f + __builtin_amdgcn_exp2f(-1.4426950408889634f * x)); }
__device__ __forceinline__ float dpp_add_(float v, const int ctrl_sel) {
    const int x = __builtin_bit_cast(int, v); int y;
    if (ctrl_sel == 0) y = __builtin_amdgcn_update_dpp(0, x, 0xB1, 0xf, 0xf, true);
    else if (ctrl_sel == 1) y = __builtin_amdgcn_update_dpp(0, x, 0x4E, 0xf, 0xf, true);
    else if (ctrl_sel == 2) y = __builtin_amdgcn_update_dpp(0, x, 0x141, 0xf, 0xf, true);
    else y = __builtin_amdgcn_update_dpp(0, x, 0x140, 0xf, 0xf, true);
    return v + __builtin_bit_cast(float, y);
}
__device__ __forceinline__ float wave_sum(float v) {
    v = dpp_add_(v, 0); v = dpp_add_(v, 1); v = dpp_add_(v, 2); v = dpp_add_(v, 3);
    const float r0 = __builtin_bit_cast(float, __builtin_amdgcn_readlane(__builtin_bit_cast(int, v), 0)), r1 = __builtin_bit_cast(float, __builtin_amdgcn_readlane(__builtin_bit_cast(int, v), 16));
    const float r2 = __builtin_bit_cast(float, __builtin_amdgcn_readlane(__builtin_bit_cast(int, v), 32)), r3 = __builtin_bit_cast(float, __builtin_amdgcn_readlane(__builtin_bit_cast(int, v), 48));
    return (r0 + r1) + (r2 + r3);
}

struct Params {
    const float* in[20];
    float* out; unsigned char* ws;
};
typedef const __attribute__((address_space(4))) Params* PP;

__device__ __forceinline__ int next_unit(unsigned* ctr, volatile LAS unsigned* slot, int tid) {
    __syncthreads();
    if (tid == 0) *slot = __hip_atomic_fetch_add(ctr, 1u, __ATOMIC_RELAXED, __HIP_MEMORY_SCOPE_AGENT);
    __syncthreads();
    return (int)*slot;
}
__device__ __forceinline__ int q_pop(unsigned* ctr, volatile LAS unsigned* slot, int tid, int& pend, int pf_from) {
    __syncthreads();
    if (tid == 0) { const int cur = (pend >= 0) ? pend : (int)__hip_atomic_fetch_add(ctr, 1u, __ATOMIC_RELAXED, __HIP_MEMORY_SCOPE_AGENT);
        *slot = (unsigned)cur; pend = (cur >= pf_from) ? (int)__hip_atomic_fetch_add(ctr, 1u, __ATOMIC_RELAXED, __HIP_MEMORY_SCOPE_AGENT) : -1; }
    __syncthreads();
    return (int)*slot;
}
__device__ __forceinline__ void transpose_item(const float* W, int K, int N, bf16* WT, LAS float* scr, int item, int lane) {
    const int nblk = N / 32, kb = item / nblk, nb = item % nblk, k0 = 64 * kb, n0 = 32 * nb;
    float wv[32];
    const float* wp = W + (size_t)(k0 + (lane >> 5)) * N + n0 + (lane & 31);
#pragma unroll
    for (int i = 0; i < 32; ++i) wv[i] = wp[(size_t)(2 * i) * N];
    __builtin_amdgcn_sched_barrier(0);
#pragma unroll
    for (int i = 0; i < 32; ++i) { const int kk = 2 * i + (lane >> 5); scr[kk * 33 + (lane & 31)] = wv[i]; }
    asm volatile("s_waitcnt lgkmcnt(0)" ::: "memory");
    const int c = lane & 7;
#pragma unroll
    for (int j = 0; j < 4; ++j) { const int n = (lane >> 3) + 8 * j; const LAS float* s = scr + (8 * c) * 33 + n;
        u32x4 o; o.x = pk2(s[0 * 33], s[1 * 33]); o.y = pk2(s[2 * 33], s[3 * 33]); o.z = pk2(s[4 * 33], s[5 * 33]); o.w = pk2(s[6 * 33], s[7 * 33]);
        *(u32x4*)(WT + (size_t)(n0 + n) * K + k0 + 8 * c) = o; }
    asm volatile("s_waitcnt lgkmcnt(0)" ::: "memory");
}

__device__ __forceinline__ void mod_unit(PP P, LAS float* lds, int l, int nc, int tid) {
    const float* c = P->in[5]; const float* cctx = P->in[6]; const float* aw = P->in[7] + (size_t)l * 2048 * 6144; const float* ab = P->in[8] + l * 6144;
    LAS float* sc = lds;
    LAS float* red = lds + 3 * 2048;
    for (int i = tid; i < 3 * 2048; i += NTHREADS) { const int j = i >> 11, k = i & 2047; const float v = (j == 0) ? cctx[k] : c[(j - 1) * 2048 + k]; sc[i] = siluf_(v); }
    __syncthreads();
    const int tn = tid & 7, tk = tid >> 3, n0 = nc * 32 + 4 * tn;
    float a[3][4] = {};
    for (int k8 = 0; k8 < 32; k8 += 16) {
        f32x4 w[16];
#pragma unroll
        for (int kk = 0; kk < 16; ++kk) w[kk] = *(const f32x4*)(aw + (size_t)(tk * 32 + k8 + kk) * 6144 + n0);
        __builtin_amdgcn_sched_barrier(0);
#pragma unroll
        for (int kk = 0; kk < 16; ++kk) { const int k = tk * 32 + k8 + kk;
#pragma unroll
            for (int j = 0; j < 3; ++j) { const float s = sc[j * 2048 + k]; a[j][0] += s * w[kk][0]; a[j][1] += s * w[kk][1]; a[j][2] += s * w[kk][2]; a[j][3] += s * w[kk][3]; } }
    }
#pragma unroll
    for (int j = 0; j < 3; ++j)
#pragma unroll
        for (int e = 0; e < 4; ++e) red[(tk * 8 + tn) * 12 + j * 4 + e] = a[j][e];
    __syncthreads();
    if (tid < 96) { const int tn2 = tid / 12, je = tid % 12; float s = 0.f; for (int t = 0; t < 64; ++t) s += red[(t * 8 + tn2) * 12 + je];
        const int j = je >> 2, e = je & 3, n = nc * 32 + 4 * tn2 + e;
        ((float*)(P->ws + WS_MOD))[(l * 3 + j) * 6144 + n] = s + ab[n]; }
    __syncthreads();
}

__device__ __forceinline__ void hprep_row(const float* xrow, const float* mod  , bf16* hrow, int lane) {
#pragma unroll
    for (int j = 0; j < 8; ++j) { const int c = 4 * lane + 256 * j; const f32x4 x = *(const f32x4*)(xrow + c), sh = *(const f32x4*)(mod + c), sc = *(const f32x4*)(mod + 2048 + c);
        const f32x4 h = x * (sc + 1.0f) + sh; u32x2 o; o.x = pk2(h[0], h[1]); o.y = pk2(h[2], h[3]); *(u32x2*)(hrow + c) = o; }
}
template <bool WITH_H>
__device__ __forceinline__ void ln_row_t(const bf16* vsrc, float* yrow, const float* w, const float* b, const float* modn, bf16* hrow, int lane_in) {
    int lane = lane_in; asm volatile("" : "+v"(lane));
    f32x4 v[8], pw[8], pb[8]; float s = 0.f;
#pragma unroll
    for (int j = 0; j < 8; ++j) { const u32x2 r = *(const u32x2*)(vsrc + 4 * lane + 256 * j); v[j] = (f32x4){bflo(r.x), bfhi(r.x), bflo(r.y), bfhi(r.y)}; }
#pragma unroll
    for (int j = 0; j < 8; ++j) { pw[j] = *(const f32x4*)(w + 4 * lane + 256 * j); pb[j] = *(const f32x4*)(b + 4 * lane + 256 * j); }
#pragma unroll
    for (int j = 0; j < 8; ++j) s += (v[j][0] + v[j][1]) + (v[j][2] + v[j][3]);
    const float mean = wave_sum(s) * (1.0f / 2048.0f); float q = 0.f;
#pragma unroll
    for (int j = 0; j < 8; ++j) { v[j] = v[j] - mean; q += (v[j][0] * v[j][0] + v[j][1] * v[j][1]) + (v[j][2] * v[j][2] + v[j][3] * v[j][3]); }
    const float rstd = __builtin_amdgcn_rsqf(wave_sum(q) * (1.0f / 2048.0f) + 1e-5f);
#pragma unroll
    for (int j = 0; j < 8; ++j) { v[j] = v[j] * rstd * pw[j] + pb[j]; *(f32x4*)(yrow + 4 * lane + 256 * j) = v[j]; }
    if (WITH_H) {
#pragma unroll
        for (int j = 0; j < 8; ++j) { pw[j] = *(const f32x4*)(modn + 4 * lane + 256 * j); pb[j] = *(const f32x4*)(modn + 2048 + 4 * lane + 256 * j); }
#pragma unroll
        for (int j = 0; j < 8; ++j) { const f32x4 h = v[j] * (pb[j] + 1.0f) + pw[j]; u32x2 o; o.x = pk2(h[0], h[1]); o.y = pk2(h[2], h[3]); *(u32x2*)(hrow + 4 * lane + 256 * j) = o; }
    }
}
__device__ __forceinline__ void ln_row(const bf16* vsrc, float* yrow, const float* w, const float* b, const float* modn, bf16* hrow, int lane) {
    if (hrow) ln_row_t<true>(vsrc, yrow, w, b, modn, hrow, lane); else ln_row_t<false>(vsrc, yrow, w, b, modn, hrow, lane);
}

typedef float f32x2 __attribute__((ext_vector_type(2)));
__device__ __forceinline__ void conv_unit(PP P, LAS float* lds, int l, int unit, int tid) {
    const int lane = tid & 63, wave = tid >> 6;
    const bf16* Z = (const bf16*)(P->ws + WS_Z); bf16* MIX = (bf16*)(P->ws + WS_H);
    const int t0 = unit * 32;
    int s0, s1; if (t0 < NCTX) { s0 = t0 & ~255; s1 = s0 + 256; } else { s0 = NCTX + ((t0 - NCTX) & ~2047); s1 = s0 + 2048; }
    const int tgs = __builtin_amdgcn_readfirstlane(tid >> 8);
    const int c2 = 2 * (tid & 255), tb = t0 + 16 * tgs;
    u32x4 gq[4];
#pragma unroll
    for (int k = 0; k < 4; ++k) gq[k] = *(const u32x4*)(Z + (size_t)(t0 + 4 * wave + k) * DIN + C_CG + 8 * lane);
    const float* lw = P->in[16] + l * 512 + 8 * lane; const float* lb = P->in[17] + l * 512 + 8 * lane;
    const f32x4 w0 = *(const f32x4*)lw, w1 = *(const f32x4*)(lw + 4), b0 = *(const f32x4*)lb, b1 = *(const f32x4*)(lb + 4);
    f32x2 u[46];
#pragma unroll
    for (int hb = 0; hb < 2; ++hb) {
        unsigned ra[23], rb[23];
#pragma unroll
        for (int r = 0; r < 23; ++r) { const int row = tb - 15 + 23 * hb + r; const int rc = row < s0 ? s0 : (row >= s1 ? s1 - 1 : row);
            const unsigned off = (unsigned)rc * (unsigned)(DIN * 2) + (unsigned)((C_CA + c2) * 2);
            ra[r] = *(const unsigned*)((const char*)Z + off); rb[r] = *(const unsigned*)((const char*)Z + off + (C_CB - C_CA) * 2); }
        __builtin_amdgcn_sched_barrier(0);
#pragma unroll
        for (int r = 0; r < 23; ++r) { const int row = tb - 15 + 23 * hb + r; const bool ok = (row >= s0 && row < s1);
            const f32x2 a = {bflo(ra[r]), bfhi(ra[r])}; const f32x2 g = {bflo(rb[r]), bfhi(rb[r])};
            const f32x2 v = a * g; u[23 * hb + r] = ok ? v : (f32x2){0.f, 0.f}; }
    }
    f32x2 acc[16]; const f32x2 bias = *(const f32x2*)(P->in[15] + l * 512 + c2);
#pragma unroll
    for (int i = 0; i < 16; ++i) acc[i] = bias;
    const float* cw = P->in[14] + (size_t)l * 31 * 512 + c2;
#pragma unroll
    for (int j = 0; j < 31; ++j) { const f32x2 w = *(const f32x2*)(cw + j * 512);
#pragma unroll
        for (int i = 0; i < 16; ++i) acc[i] += u[i + j] * w; }
    LAS float* yb = lds;
#pragma unroll
    for (int i = 0; i < 16; ++i) *(LAS f32x2*)(yb + (16 * tgs + i) * 512 + c2) = acc[i];
    __syncthreads();
#pragma unroll
    for (int k = 0; k < 4; ++k) { const int ti = wave * 4 + k, row = t0 + ti;
        f32x4 a = *(const LAS f32x4*)(yb + ti * 512 + 8 * lane), b = *(const LAS f32x4*)(yb + ti * 512 + 8 * lane + 4);
        float s = (a[0] + a[1]) + (a[2] + a[3]) + (b[0] + b[1]) + (b[2] + b[3]);
        const float mean = wave_sum(s) * (1.0f / 512.0f); a = a - mean; b = b - mean;
        float q = (a[0] * a[0] + a[1] * a[1]) + (a[2] * a[2] + a[3] * a[3]) + (b[0] * b[0] + b[1] * b[1]) + (b[2] * b[2] + b[3] * b[3]);
        const float rstd = __builtin_amdgcn_rsqf(wave_sum(q) * (1.0f / 512.0f) + 1e-5f);
        a = a * rstd * w0 + b0; b = b * rstd * w1 + b1;
        const u32x4 g = gq[k];
        float o[8];
        o[0] = siluf_(a[0]) * siluf_(bflo(g.x)); o[1] = siluf_(a[1]) * siluf_(bfhi(g.x)); o[2] = siluf_(a[2]) * siluf_(bflo(g.y)); o[3] = siluf_(a[3]) * siluf_(bfhi(g.y));
        o[4] = siluf_(b[0]) * siluf_(bflo(g.z)); o[5] = siluf_(b[1]) * siluf_(bfhi(g.z)); o[6] = siluf_(b[2]) * siluf_(bflo(g.w)); o[7] = siluf_(b[3]) * siluf_(bfhi(g.w));
        u32x4 w; w.x = pk2(o[0], o[1]); w.y = pk2(o[2], o[3]); w.z = pk2(o[4], o[5]); w.w = pk2(o[6], o[7]);
        *(u32x4*)(MIX + (size_t)row * D_MODEL + 1536 + 8 * lane) = w; }
}

typedef short v4i16_t __attribute__((ext_vector_type(4)));
#define SBAR __builtin_amdgcn_sched_barrier(0);
#define R0(i) (((i) & 3) + 8 * ((i) >> 2))
constexpr float ATT_C2 = 0.08838834764831845f * 1.4426950408889634f;
constexpr float LOG2E = 1.4426950408889634f;
constexpr int KROW = 272, VROW = 320, ATT_V_OFF = 64 * KROW;

__device__ __forceinline__ bf16x8 trpair(const LAS unsigned char* p, int second_off) {
    const v4i16_t lo = __builtin_amdgcn_ds_read_tr16_b64_v4i16((LAS v4i16_t*)p), hi = __builtin_amdgcn_ds_read_tr16_b64_v4i16((LAS v4i16_t*)(p + second_off));
    return (bf16x8){lo[0], lo[1], lo[2], lo[3], hi[0], hi[1], hi[2], hi[3]};
}
__device__ __forceinline__ bf16x8 pack8(float a, float b, float c, float d, float e, float f, float g, float h) {
    const u32x4 w = {pk2(a, b), pk2(c, d), pk2(e, f), pk2(g, h)}; return __builtin_bit_cast(bf16x8, w);
}
__device__ __forceinline__ void rope8(bf16x8& a, bf16x8& b, const float* cs) {
    float ra[8], rb[8];
#pragma unroll
    for (int j = 0; j < 8; ++j) { const float x1 = bf2f((unsigned short)a[j]), x2 = bf2f((unsigned short)b[j]), c = cs[2 * j], s = cs[2 * j + 1]; ra[j] = x1 * c - x2 * s; rb[j] = x2 * c + x1 * s; }
    a = pack8(ra[0], ra[1], ra[2], ra[3], ra[4], ra[5], ra[6], ra[7]); b = pack8(rb[0], rb[1], rb[2], rb[3], rb[4], rb[5], rb[6], rb[7]);
}
__device__ __forceinline__ void rope8l(bf16x8& a, bf16x8& b, const LAS float* cs) {
    const f32x4 c0 = *(const LAS f32x4*)cs, c1 = *(const LAS f32x4*)(cs + 4), c2 = *(const LAS f32x4*)(cs + 8), c3 = *(const LAS f32x4*)(cs + 12);
    const float cc[8] = {c0[0], c0[2], c1[0], c1[2], c2[0], c2[2], c3[0], c3[2]}, sn[8] = {c0[1], c0[3], c1[1], c1[3], c2[1], c2[3], c3[1], c3[3]};
    float ra[8], rb[8];
#pragma unroll
    for (int j = 0; j < 8; ++j) { const float x1 = bf2f((unsigned short)a[j]), x2 = bf2f((unsigned short)b[j]); ra[j] = x1 * cc[j] - x2 * sn[j]; rb[j] = x2 * cc[j] + x1 * sn[j]; }
    a = pack8(ra[0], ra[1], ra[2], ra[3], ra[4], ra[5], ra[6], ra[7]); b = pack8(rb[0], rb[1], rb[2], rb[3], rb[4], rb[5], rb[6], rb[7]);
}
__device__ __forceinline__ bf16x8 cvt8(const float* p) {
    const f32x4 a = *(const f32x4*)p, b = *(const f32x4*)(p + 4);
    return pack8(a[0], a[1], a[2], a[3], b[0], b[1], b[2], b[3]);
}

typedef _Float16 f16x8_t_ __attribute__((ext_vector_type(8)));
__device__ __forceinline__ void rope8h(u32x4& a, u32x4& b, const LAS unsigned char* cs) {
    const f16x8_t_ t0 = *(const LAS f16x8_t_*)cs, t1 = *(const LAS f16x8_t_*)(cs + 16);
    float ra[8], rb[8];
#pragma unroll
    for (int j = 0; j < 8; ++j) { const unsigned wa = a[j >> 1], wb = b[j >> 1]; const float x1 = (j & 1) ? bfhi(wa) : bflo(wa), x2 = (j & 1) ? bfhi(wb) : bflo(wb);
        const float c = (float)((j < 4) ? t0[2 * j] : t1[2 * (j - 4)]), sn = (float)((j < 4) ? t0[2 * j + 1] : t1[2 * (j - 4) + 1]);
        ra[j] = x1 * c - x2 * sn; rb[j] = x2 * c + x1 * sn; }
    a = (u32x4){pk2(ra[0], ra[1]), pk2(ra[2], ra[3]), pk2(ra[4], ra[5]), pk2(ra[6], ra[7])}; b = (u32x4){pk2(rb[0], rb[1]), pk2(rb[2], rb[3]), pk2(rb[4], rb[5]), pk2(rb[6], rb[7])};
}
constexpr int AT_BUF = 75776, AT_V = 34816, AT_ROPE = 151552;
__device__ __forceinline__ void attn_tile(const LAS unsigned char* kt, const LAS unsigned char* vt, const bf16x8 (&qf)[8], f32x16 (&O)[4], float& m, float& lsum,
                                          bool local, int tk0, int qpos, int lane) {
    const int r32 = lane & 31, hh = lane >> 5, i16 = lane & 15;
    f32x16 p0, p1;
#pragma unroll
    for (int i = 0; i < 16; ++i) { p0[i] = 0.f; p1[i] = 0.f; }
    const LAS unsigned char* kb = kt + r32 * KROW + 16 * hh;
#pragma unroll
    for (int s = 0; s < 8; ++s) { const bf16x8 kf0 = *(const LAS bf16x8*)(kb + 32 * s), kf1 = *(const LAS bf16x8*)(kb + 32 * KROW + 32 * s);
        p0 = __builtin_amdgcn_mfma_f32_32x32x16_bf16(kf0, qf[s], p0, 0, 0, 0); p1 = __builtin_amdgcn_mfma_f32_32x32x16_bf16(kf1, qf[s], p1, 0, 0, 0); }
    const LAS unsigned char* vb = vt + (4 * hh + (i16 >> 2)) * VROW + (16 * ((lane >> 4) & 1) + 4 * (i16 & 3)) * 2;
    bf16x8 vfa[4], vfb[4];
#pragma unroll
    for (int ks = 0; ks < 4; ++ks) vfa[ks] = trpair(vb + (16 * ks) * VROW, 8 * VROW);
    float mx = -3e38f;
    if (local) { const unsigned mb = (unsigned)(qpos - tk0 - 4 * hh + 128);
#pragma unroll
        for (int i = 0; i < 16; ++i) { const unsigned d0 = mb - (unsigned)R0(i), d1 = d0 - 32u;
            p0[i] = (d0 <= 256u) ? p0[i] : -1e30f; p1[i] = (d1 <= 256u) ? p1[i] : -1e30f; } }
#pragma unroll
    for (int i = 0; i < 16; ++i) mx = fmaxf(mx, fmaxf(p0[i], p1[i]));
    mx = fmaxf(mx, __shfl_xor(mx, 32)) * ATT_C2;
    const float mn = fmaxf(m, mx), alpha = __builtin_amdgcn_exp2f(m - mn); m = mn;
    float ps = 0.f;
#pragma unroll
    for (int i = 0; i < 16; ++i) { p0[i] = __builtin_amdgcn_exp2f(__builtin_fmaf(p0[i], ATT_C2, -mn)); p1[i] = __builtin_amdgcn_exp2f(__builtin_fmaf(p1[i], ATT_C2, -mn)); ps += p0[i] + p1[i]; }
    lsum = lsum * alpha + ps;
    if (__builtin_amdgcn_ballot_w64(alpha != 1.0f) != 0ull) {
#pragma unroll
        for (int d = 0; d < 4; ++d)
#pragma unroll
            for (int i = 0; i < 16; ++i) O[d][i] *= alpha;
    }
    bf16x8 pb[4];
#pragma unroll
    for (int s = 0; s < 2; ++s) { pb[s] = pack8(p0[8 * s], p0[8 * s + 1], p0[8 * s + 2], p0[8 * s + 3], p0[8 * s + 4], p0[8 * s + 5], p0[8 * s + 6], p0[8 * s + 7]);
        pb[2 + s] = pack8(p1[8 * s], p1[8 * s + 1], p1[8 * s + 2], p1[8 * s + 3], p1[8 * s + 4], p1[8 * s + 5], p1[8 * s + 6], p1[8 * s + 7]); }
#pragma unroll
    for (int dt = 0; dt < 4; ++dt) {
        if (dt + 1 < 4) {
#pragma unroll
            for (int ks = 0; ks < 4; ++ks) { const bf16x8 t_ = trpair(vb + (16 * ks) * VROW + 64 * (dt + 1), 8 * VROW); if (dt & 1) vfa[ks] = t_; else vfb[ks] = t_; }
        }
#pragma unroll
        for (int ks = 0; ks < 4; ++ks) O[dt] = __builtin_amdgcn_mfma_f32_32x32x16_bf16((dt & 1) ? vfb[ks] : vfa[ks], pb[ks], O[dt], 0, 0, 0);
    }
}
__device__ __forceinline__ void attn_unit(PP P, LAS unsigned char* lds, int l, int kind, int idx, int tid) {
    const int lane = tid & 63, wave = __builtin_amdgcn_readfirstlane(tid >> 6), r32 = lane & 31, hh = lane >> 5;
    const bf16* Z = (const bf16*)(P->ws + WS_Z); bf16* MIX = (bf16*)(P->ws + WS_H); const float* CS = (const float*)(P->ws + WS_CS); const bf16* CKV = (const bf16*)(P->ws + WS_CKV);
    int b, h, qpos0, grow0, kpos0, klrow0, nls, ncs;
    if (kind == 0) { b = idx >> 3; h = idx & 7; qpos0 = 0; grow0 = b * 256; kpos0 = 0; klrow0 = b * 256; nls = 2; ncs = 0; }
    else { const int qb = idx & 7; h = (idx >> 3) & 7; b = idx >> 6; qpos0 = qb * 256; grow0 = NCTX + b * 2048 + qpos0;
        kpos0 = qpos0 - 128 < 0 ? 0 : qpos0 - 128; const int kend = qpos0 + 384 > 2048 ? 2048 : qpos0 + 384; nls = (kend - kpos0) >> 7; klrow0 = NCTX + b * 2048 + kpos0; ncs = 2; }
    const bool lat = (kind == 1);
    const int kv = h >> 2;
    if (lat) {
#pragma unroll
        for (int k = 0; k < 4; ++k) { const int e = tid + 512 * k; const float c = CS[2 * e], sn = CS[2 * e + 1];
            typedef _Float16 h2_ __attribute__((ext_vector_type(2))); const h2_ hv = {(_Float16)c, (_Float16)sn}; *(LAS unsigned*)(lds + AT_ROPE + 4 * e) = __builtin_bit_cast(unsigned, hv); }
    }
    const int qrow = grow0 + 32 * wave + r32, qpos = qpos0 + 32 * wave + r32, qw0 = qpos0 + 32 * wave;
    bf16x8 qf[8];
    { const bf16* qp = Z + (size_t)qrow * DIN + C_AQ + h * 128 + 8 * hh;
#pragma unroll
      for (int s = 0; s < 8; ++s) qf[s] = *(const bf16x8*)(qp + 16 * s);
      if (lat) { const float* c0 = CS + ((qpos >> 6) * 32 + 8 * hh) * 2; const float* c1 = CS + ((qpos & 63) * 32 + 8 * hh) * 2;
          rope8(qf[0], qf[2], c0); rope8(qf[1], qf[3], c0 + 32); rope8(qf[4], qf[6], c1); rope8(qf[5], qf[7], c1 + 32); } }
    f32x16 O[4];
#pragma unroll
    for (int d = 0; d < 4; ++d)
#pragma unroll
        for (int i = 0; i < 16; ++i) O[d][i] = 0.f;
    float m = P->in[11][l * 8 + h] * LOG2E, lsum = (hh == 0) ? 1.0f : 0.0f;
    const int skey = tid >> 2, sub = tid & 3;
    const int nst = nls + ncs;
    u32x4 rr[8];
#define ATT_ISSUE(ST) do { const int st_ = (ST); const bf16* kp_; const bf16* vp_; \
        if (st_ < nls) { const int krow = klrow0 + 128 * st_ + skey; kp_ = Z + (size_t)krow * DIN + C_AK + kv * 128 + 8 * sub; vp_ = kp_ + (C_AV - C_AK); } \
        else { const int key = 128 * (st_ - nls) + skey; kp_ = CKV + ((size_t)((b * 2 + l) * 256 + key) * 2 + kv) * 128 + 8 * sub; vp_ = kp_ + 262144; } \
        rr[0] = *(const u32x4*)kp_; rr[1] = *(const u32x4*)(kp_ + 32); rr[2] = *(const u32x4*)(kp_ + 64); rr[3] = *(const u32x4*)(kp_ + 96); \
        rr[4] = *(const u32x4*)vp_; rr[5] = *(const u32x4*)(vp_ + 32); rr[6] = *(const u32x4*)(vp_ + 64); rr[7] = *(const u32x4*)(vp_ + 96); } while (0)
#define ATT_WRITE(ST) do { const int st_ = (ST); \
        if (lat && st_ < nls) { const int kpos = kpos0 + 128 * st_ + skey; \
            rope8h(rr[0], rr[1], lds + AT_ROPE + ((kpos >> 6) * 32 + 8 * sub) * 4); rope8h(rr[2], rr[3], lds + AT_ROPE + ((kpos & 63) * 32 + 8 * sub) * 4); } \
        LAS unsigned char* kd_ = lds + (st_ & 1) * AT_BUF + skey * KROW + 16 * sub; LAS unsigned char* vd_ = lds + (st_ & 1) * AT_BUF + AT_V + skey * VROW + 16 * sub; \
        *(LAS u32x4*)kd_ = rr[0]; *(LAS u32x4*)(kd_ + 64) = rr[1]; *(LAS u32x4*)(kd_ + 128) = rr[2]; *(LAS u32x4*)(kd_ + 192) = rr[3]; \
        *(LAS u32x4*)vd_ = rr[4]; *(LAS u32x4*)(vd_ + 64) = rr[5]; *(LAS u32x4*)(vd_ + 128) = rr[6]; *(LAS u32x4*)(vd_ + 192) = rr[7]; } while (0)
    if (lat) { ATT_ISSUE(0); __syncthreads();
        ATT_WRITE(0); }
    else {
        u32x4 r2[8];
        { const bf16* kp_ = Z + (size_t)(klrow0 + skey) * DIN + C_AK + kv * 128 + 8 * sub; const bf16* vp_ = kp_ + (C_AV - C_AK); const bf16* kq_ = kp_ + (size_t)128 * DIN; const bf16* vq_ = vp_ + (size_t)128 * DIN;
          rr[0] = *(const u32x4*)kp_; rr[1] = *(const u32x4*)(kp_ + 32); rr[2] = *(const u32x4*)(kp_ + 64); rr[3] = *(const u32x4*)(kp_ + 96);
          rr[4] = *(const u32x4*)vp_; rr[5] = *(const u32x4*)(vp_ + 32); rr[6] = *(const u32x4*)(vp_ + 64); rr[7] = *(const u32x4*)(vp_ + 96);
          r2[0] = *(const u32x4*)kq_; r2[1] = *(const u32x4*)(kq_ + 32); r2[2] = *(const u32x4*)(kq_ + 64); r2[3] = *(const u32x4*)(kq_ + 96);
          r2[4] = *(const u32x4*)vq_; r2[5] = *(const u32x4*)(vq_ + 32); r2[6] = *(const u32x4*)(vq_ + 64); r2[7] = *(const u32x4*)(vq_ + 96); }
        ATT_WRITE(0);
#pragma unroll
        for (int e = 0; e < 8; ++e) rr[e] = r2[e];
        ATT_WRITE(1);
    }
    __syncthreads();
    for (int st = 0; st < nst; ++st) {
        const bool more = lat && (st + 1 < nst);
        if (more) ATT_ISSUE(st + 1);
        const bool local = lat && (st < nls);
        const LAS unsigned char* kt = lds + (st & 1) * AT_BUF; const LAS unsigned char* vt = kt + AT_V;
#pragma unroll
        for (int t2 = 0; t2 < 2; ++t2) {
            const int tk0 = kpos0 + 128 * st + 64 * t2;
            bool skip = false;
            if (local) skip = (tk0 > qw0 + 31 + 128) || (tk0 + 63 < qw0 - 128);
            if (!skip) attn_tile(kt + t2 * 64 * KROW, vt + t2 * 64 * VROW, qf, O, m, lsum, local, tk0, qpos, lane);
        }
        if (more) ATT_WRITE(st + 1);
        if (lat) __syncthreads();
    }
    const float ltot = lsum + __shfl_xor(lsum, 32), inv = __builtin_amdgcn_rcpf(ltot);
    const bf16* gp = Z + (size_t)qrow * DIN + C_AG + h * 128 + 4 * hh; bf16* op = MIX + (size_t)qrow * D_MODEL + h * 128 + 4 * hh;
    u32x2 gg[16];
#pragma unroll
    for (int e = 0; e < 16; ++e) gg[e] = *(const u32x2*)(gp + 32 * (e >> 2) + 8 * (e & 3));
    __builtin_amdgcn_sched_barrier(0);
#pragma unroll
    for (int dt = 0; dt < 4; ++dt)
#pragma unroll
        for (int i4 = 0; i4 < 4; ++i4) { const int d0 = 32 * dt + 8 * i4; const u32x2 g = gg[dt * 4 + i4];
            const float o0 = O[dt][4 * i4 + 0] * inv * siluf_(bflo(g.x)), o1 = O[dt][4 * i4 + 1] * inv * siluf_(bfhi(g.x));
            const float o2 = O[dt][4 * i4 + 2] * inv * siluf_(bflo(g.y)), o3 = O[dt][4 * i4 + 3] * inv * siluf_(bfhi(g.y));
            u32x2 w; w.x = pk2(o0, o1); w.y = pk2(o2, o3); *(u32x2*)(op + d0) = w; }
#undef ATT_ISSUE
#undef ATT_WRITE
}

__device__ __forceinline__ void hg_oml8(PP P, int l, int dir, int hd0, float (&oml)[8]) {
    const float* hb = P->in[12] + dir * 1024 + hd0;
    const f32x4 a0 = *(const f32x4*)hb, a1 = *(const f32x4*)(hb + 4), b0 = *(const f32x4*)(hb + 512), b1 = *(const f32x4*)(hb + 516);
#pragma unroll
    for (int j = 0; j < 4; ++j) { const float s0 = sigmoidf_(b0[j] - a0[j]), s1 = sigmoidf_(b1[j] - a1[j]); oml[j] = l ? 1.0f - s0 : 1.0f; oml[4 + j] = l ? 1.0f - s1 : 1.0f; }
}
constexpr int H2_TG = 0, H2_QE = 16896, H2_KE = 25600, H2_QG = 34304, H2_KG = 42752, H2_V = 52992, H2_OBA = 63232, H2_OBB = 80128, H2_DK = 97024;
constexpr size_t WS_DLC_OFF = 0;
#ifndef PROBE_SEC
#define PROBE_SEC -1
#endif
#if PROBE_SEC >= 0
#define PSEC_DECL unsigned long long ps_acc_ = 0ull, ps_t_ = 0ull;
#define PSEC_START(n) if (PROBE_SEC == n) ps_t_ = __builtin_amdgcn_s_memrealtime();
#define PSEC_END(n) if (PROBE_SEC == n) ps_acc_ += __builtin_amdgcn_s_memrealtime() - ps_t_;
#define PSEC_CLOSE(n) if (PROBE_SEC == n) { __syncthreads(); ps_acc_ += __builtin_amdgcn_s_memrealtime() - ps_t_; }
#define PSEC_FLUSH(cnt) if (kind == 0 && tid == 0) { atomicAdd((unsigned long long*)((unsigned*)(P->ws + WS_CTL) + 60000), ps_acc_); atomicAdd((unsigned*)(P->ws + WS_CTL) + 60002, (unsigned)(cnt)); }
#else
#define PSEC_DECL
#define PSEC_START(n)
#define PSEC_END(n)
#define PSEC_CLOSE(n)
#define PSEC_FLUSH(cnt)
#endif
__device__ __forceinline__ void hgrn2_unit(PP P, LAS unsigned char* lds, int l, int kind, int idx, int tid) {
    const int lane = tid & 63, wave = __builtin_amdgcn_readfirstlane(tid >> 6), r32 = lane & 31, hh = lane >> 5, i16 = lane & 15, cg = (lane >> 4) & 1;
    const bf16* Z = (const bf16*)(P->ws + WS_Z); bf16* MIX = (bf16*)(P->ws + WS_H); float* OL = (float*)(P->ws + WS_OL);
    LAS float* ldsf = (LAS float*)lds;
    int h, row0, seglen, nch, b = 0;
    if (kind == 0) { b = idx >> 2; h = idx & 3; row0 = b * 256; seglen = 256; nch = 8; }
    else { const int blk = idx & 15; h = (idx >> 4) & 3; const int lb = idx >> 6; row0 = NCTX + lb * 2048 + blk * 128; seglen = 128; nch = 4; }
    const int ti = tid >> 4, d0 = 8 * (tid & 15), nt = wave & 3, kp = wave >> 2;
    PSEC_DECL
    const f32x4 n0 = *(const f32x4*)(P->in[13] + l * 512 + h * 128 + d0), n1 = *(const f32x4*)(P->in[13] + l * 512 + h * 128 + d0 + 4);
    for (int dir = 0; dir < 2; ++dir) {
        float oml[8]; hg_oml8(P, l, dir, h * 128 + d0, oml);
        const int cf = dir ? C_HFB : C_HFF;
        f32x16 S0, S1;
#pragma unroll
        for (int i = 0; i < 16; ++i) { S0[i] = 0.f; S1[i] = 0.f; }
        const int uidx = (kind == 1) ? ((idx >> 4) * 2 + dir) * 16 + (idx & 15) : 0;
        float gtot = 0.f;
        u32x4 uq, uv, uf;
        { const int row = dir ? row0 + seglen - 1 - ti : row0 + ti; const bf16* zr = Z + (size_t)row * DIN + h * 128 + d0;
          uq = *(const u32x4*)(zr + C_HQ); uv = *(const u32x4*)(zr + C_HI); uf = *(const u32x4*)(zr + cf); }
        for (int c = 0; c < nch; ++c) {
            PSEC_START(0)
            const int nc = dir ? nch - 1 - c : c; const int rown = row0 + 32 * nc + ti;
            f32x4 olp0 = {0.f, 0.f, 0.f, 0.f}, olp1 = {0.f, 0.f, 0.f, 0.f}; u32x4 ug = {0u, 0u, 0u, 0u};
            float* olr = OL + (size_t)rown * 512 + h * 128 + d0;
            if (dir == 1) { olp0 = *(const f32x4*)olr; olp1 = *(const f32x4*)(olr + 4); if (kind == 0) ug = *(const u32x4*)(Z + (size_t)rown * DIN + C_HG + h * 128 + d0); }
            float q[8], kk[8];
            {
                float g2[8], vv[8];
#pragma unroll
                for (int j = 0; j < 4; ++j) { const unsigned wq = uq[j], wv = uv[j], wf = uf[j];
                    q[2 * j] = siluf_(bflo(wq)) * 0.08838834764831845f; q[2 * j + 1] = siluf_(bfhi(wq)) * 0.08838834764831845f;
                    vv[2 * j] = bflo(wv); vv[2 * j + 1] = bfhi(wv);
                    kk[2 * j] = oml[2 * j] * sigmoidf_(-bflo(wf)); kk[2 * j + 1] = oml[2 * j + 1] * sigmoidf_(-bfhi(wf)); }
#pragma unroll
                for (int j = 0; j < 8; ++j) g2[j] = __builtin_amdgcn_logf(1.0f - fminf(kk[j], 1.0f - 1e-6f));
                LAS float* pg = ldsf + (H2_TG >> 2) + ti * 132 + d0;
                *(LAS f32x4*)pg = (f32x4){g2[0], g2[1], g2[2], g2[3]}; *(LAS f32x4*)(pg + 4) = (f32x4){g2[4], g2[5], g2[6], g2[7]};
                *(LAS u32x4*)(lds + H2_V + ti * 320 + d0 * 2) = uv;
            }
            if (c + 1 < nch) { const int tl = 32 * (c + 1) + ti; const int row = dir ? row0 + seglen - 1 - tl : row0 + tl; const bf16* zr = Z + (size_t)row * DIN + h * 128 + d0;
                uq = *(const u32x4*)(zr + C_HQ); uv = *(const u32x4*)(zr + C_HI); uf = *(const u32x4*)(zr + cf); }
            __syncthreads();
            PSEC_END(0) PSEC_START(1)
            if (tid < 128) {
                LAS float* gc = ldsf + (H2_TG >> 2) + tid; float run = 0.f; float gv[32];
#pragma unroll
                for (int i = 0; i < 32; ++i) gv[i] = gc[i * 132];
                SBAR
#pragma unroll
                for (int i = 0; i < 32; ++i) { run += gv[i]; gc[i * 132] = run; }
                ldsf[(H2_DK >> 2) + tid] = __builtin_amdgcn_exp2f(run);
                if (kind == 1) ((float*)(P->ws + WS_DLOG))[(uidx * 4 + c) * 128 + tid] = run;
                gtot += run;
            }
            __syncthreads();
            PSEC_END(1) PSEC_START(2)
            {
                const LAS float* gr = ldsf + (H2_TG >> 2) + ti * 132 + d0; const LAS float* gm = ldsf + (H2_TG >> 2) + 15 * 132 + d0; const LAS float* gl = ldsf + (H2_TG >> 2) + 31 * 132 + d0;
                float qe[8], ke[8], qg[8], kg[8];
#pragma unroll
                for (int j = 0; j < 8; ++j) { const float G = gr[j], Gm = gm[j], Gl = gl[j];
                    qe[j] = q[j] * __builtin_amdgcn_exp2f(fminf(G - Gm, 100.f)); ke[j] = kk[j] * __builtin_amdgcn_exp2f(fminf(Gm - G, 100.f));
                    qg[j] = q[j] * __builtin_amdgcn_exp2f(G); kg[j] = kk[j] * __builtin_amdgcn_exp2f(Gl - G); }
                *(LAS bf16x8*)(lds + H2_QE + ti * 272 + d0 * 2) = pack8(qe[0], qe[1], qe[2], qe[3], qe[4], qe[5], qe[6], qe[7]);
                *(LAS bf16x8*)(lds + H2_KE + ti * 272 + d0 * 2) = pack8(ke[0], ke[1], ke[2], ke[3], ke[4], ke[5], ke[6], ke[7]);
                *(LAS bf16x8*)(lds + H2_KG + ti * 320 + d0 * 2) = pack8(kg[0], kg[1], kg[2], kg[3], kg[4], kg[5], kg[6], kg[7]);
                u32x2 w0, w1; w0.x = pk2(qg[0], qg[1]); w0.y = pk2(qg[2], qg[3]); w1.x = pk2(qg[4], qg[5]); w1.y = pk2(qg[6], qg[7]);
                *(LAS u32x2*)(lds + H2_QG + ti * 264 + d0 * 2) = w0; *(LAS u32x2*)(lds + H2_QG + ti * 264 + d0 * 2 + 8) = w1;
            }
            __syncthreads();
            PSEC_END(2) PSEC_START(3)
            {
                f32x16 at;
#pragma unroll
                for (int i = 0; i < 16; ++i) at[i] = 0.f;
                const LAS unsigned char* kep = lds + H2_KE + r32 * 272 + 16 * hh; const LAS unsigned char* qep = lds + H2_QE + r32 * 272 + 16 * hh;
#pragma unroll
                for (int k = 0; k < 8; ++k) at = __builtin_amdgcn_mfma_f32_32x32x16_bf16(*(const LAS bf16x8*)(kep + 32 * k), *(const LAS bf16x8*)(qep + 32 * k), at, 0, 0, 0);
                float am[8];
#pragma unroll
                for (int j = 0; j < 8; ++j) { const float lo = at[j], hi = at[8 + j]; const float v = kp ? hi : lo; const int s = 16 * kp + 8 * (j >> 2) + 4 * hh + (j & 3); am[j] = (s <= r32) ? v : 0.f; }
                const bf16x8 afrag = pack8(am[0], am[1], am[2], am[3], am[4], am[5], am[6], am[7]);
                f32x16 ot;
#pragma unroll
                for (int i = 0; i < 16; ++i) ot[i] = 0.f;
                { const bf16x8 vfrag = trpair(lds + H2_V + (16 * kp + 4 * hh + (i16 >> 2)) * 320 + (32 * nt + 16 * cg + 4 * (i16 & 3)) * 2, 8 * 320);
                  ot = __builtin_amdgcn_mfma_f32_32x32x16_bf16(vfrag, afrag, ot, 0, 0, 0); }
                const LAS unsigned char* qgp = lds + H2_QG + r32 * 264 + (64 * kp + 4 * hh) * 2;
#pragma unroll
                for (int kl = 0; kl < 2; ++kl)
#pragma unroll
                    for (int sp = 0; sp < 2; ++sp) {
                        const u32x2 qlo = *(const LAS u32x2*)(qgp + (32 * kl + 16 * sp) * 2), qhi = *(const LAS u32x2*)(qgp + (32 * kl + 16 * sp) * 2 + 16);
                        const u32x4 qq = {qlo.x, qlo.y, qhi.x, qhi.y};
                        bf16x8 sfrag;
                        if (kl == 0) sfrag = pack8(S0[8 * sp], S0[8 * sp + 1], S0[8 * sp + 2], S0[8 * sp + 3], S0[8 * sp + 4], S0[8 * sp + 5], S0[8 * sp + 6], S0[8 * sp + 7]);
                        else sfrag = pack8(S1[8 * sp], S1[8 * sp + 1], S1[8 * sp + 2], S1[8 * sp + 3], S1[8 * sp + 4], S1[8 * sp + 5], S1[8 * sp + 6], S1[8 * sp + 7]);
                        ot = __builtin_amdgcn_mfma_f32_32x32x16_bf16(sfrag, __builtin_bit_cast(bf16x8, qq), ot, 0, 0, 0);
                    }
                { LAS float* ob = ldsf + ((kp ? H2_OBB : H2_OBA) >> 2) + (32 * nt + 4 * hh) * 33 + r32;
#pragma unroll
                  for (int i = 0; i < 16; ++i) ob[R0(i) * 33] = ot[i]; }
                const LAS float* dkp = ldsf + (H2_DK >> 2) + 64 * kp + 4 * hh;
#pragma unroll
                for (int i = 0; i < 16; ++i) { S0[i] *= dkp[R0(i)]; S1[i] *= dkp[32 + R0(i)]; }
#pragma unroll
                for (int ks = 0; ks < 2; ++ks) {
                    const int roff = (16 * ks + 8 * hh + (i16 >> 2)) * 320, coff = (16 * cg + 4 * (i16 & 3)) * 2;
                    const bf16x8 vf = trpair(lds + H2_V + roff + 64 * nt + coff, 4 * 320);
                    const bf16x8 k0 = trpair(lds + H2_KG + roff + 64 * (2 * kp) + coff, 4 * 320), k1 = trpair(lds + H2_KG + roff + 64 * (2 * kp + 1) + coff, 4 * 320);
                    S0 = __builtin_amdgcn_mfma_f32_32x32x16_bf16(k0, vf, S0, 0, 0, 0); S1 = __builtin_amdgcn_mfma_f32_32x32x16_bf16(k1, vf, S1, 0, 0, 0);
                }
            }
            __syncthreads();
            PSEC_END(3) PSEC_START(4)
            {
                const int t = dir ? 31 - ti : ti;
                const LAS float* oa = ldsf + (H2_OBA >> 2) + d0 * 33 + t; const LAS float* obb = ldsf + (H2_OBB >> 2) + d0 * 33 + t;
                float o[8];
#pragma unroll
                for (int j = 0; j < 8; ++j) o[j] = oa[j * 33] + obb[j * 33];
                if (dir == 1) { o[0] += olp0[0]; o[1] += olp0[1]; o[2] += olp0[2]; o[3] += olp0[3]; o[4] += olp1[0]; o[5] += olp1[1]; o[6] += olp1[2]; o[7] += olp1[3]; }
                if (dir == 0 || kind == 1) { *(f32x4*)olr = (f32x4){o[0], o[1], o[2], o[3]}; *(f32x4*)(olr + 4) = (f32x4){o[4], o[5], o[6], o[7]}; }
                else {
                    float ss = 0.f;
#pragma unroll
                    for (int j = 0; j < 8; ++j) ss += o[j] * o[j];
                    ss += __shfl_xor(ss, 1); ss += __shfl_xor(ss, 2); ss += __shfl_xor(ss, 4); ss += __shfl_xor(ss, 8);
                    const float r = __builtin_amdgcn_rsqf(ss * (1.0f / 128.0f) + 1e-6f);
                    u32x4 w;
                    w.x = pk2(o[0] * r * n0[0] * siluf_(bflo(ug.x)), o[1] * r * n0[1] * siluf_(bfhi(ug.x))); w.y = pk2(o[2] * r * n0[2] * siluf_(bflo(ug.y)), o[3] * r * n0[3] * siluf_(bfhi(ug.y)));
                    w.z = pk2(o[4] * r * n1[0] * siluf_(bflo(ug.z)), o[5] * r * n1[1] * siluf_(bfhi(ug.z))); w.w = pk2(o[6] * r * n1[2] * siluf_(bflo(ug.w)), o[7] * r * n1[3] * siluf_(bfhi(ug.w)));
                    *(u32x4*)(MIX + (size_t)rown * D_MODEL + 1024 + h * 128 + d0) = w;
                }
            }
            PSEC_CLOSE(4)
        }
        if (kind == 1 && tid < 128) ((float*)(P->ws + WS_DLOG) + 131072)[uidx * 128 + tid] = gtot;
        {
            float* Sd = (kind == 0) ? P->out + OUT_ST + (size_t)((((b * 2 + l) * 2 + dir) * 4 + h)) * 16384 : (float*)(P->ws + WS_U) + (size_t)uidx * 16384;
            float* sp = Sd + (64 * kp + 4 * hh) * 128 + 32 * nt + r32;
#pragma unroll
            for (int i = 0; i < 16; ++i) { sp[R0(i) * 128] = S0[i]; sp[(32 + R0(i)) * 128] = S1[i]; }
        }
    }
    PSEC_FLUSH(2 * nch)
}

__device__ __forceinline__ void hgrn_scan_unit(PP P, int l, int su, int tid) {
    float* U = (float*)(P->ws + WS_U); const float* DLB = (const float*)(P->ws + WS_DLOG) + 131072;
#pragma unroll 1
    for (int k = 0; k < 4; ++k) {
        const int e = su * 2048 + tid + 512 * k;
        const int sq = e >> 14, el = e & 16383, dk = el >> 7, lb = sq >> 3, h = (sq >> 1) & 3, dir = sq & 1;
        float S = P->in[4][(size_t)((((lb * 2 + l) * 2 + dir) * 4 + h)) * 16384 + el];
        float u[16], dl[16];
        const long ustep = dir ? -16384 : 16384, dstep = dir ? -128 : 128;
        float* up = U + (size_t)(sq * 16 + (dir ? 15 : 0)) * 16384 + el; const float* dp = DLB + (sq * 16 + (dir ? 15 : 0)) * 128 + dk;
        { float* uq = up; const float* dq = dp;
#pragma unroll
          for (int p = 0; p < 16; ++p) { u[p] = *uq; dl[p] = *dq; uq += ustep; dq += dstep; asm volatile("" : "+v"(uq), "+v"(dq)); } }
        SBAR
        { float* uq = up;
#pragma unroll
          for (int p = 0; p < 16; ++p) { *uq = S; S = __builtin_amdgcn_exp2f(dl[p]) * S + u[p]; uq += ustep; asm volatile("" : "+v"(uq)); } }
    }
}

constexpr int HF_S0 = 0, HF_S1 = 40960, HF_TG0 = 81920, HF_TG1 = 98816, HF_QG0 = 115712, HF_QG1 = 124416;
__device__ __forceinline__ void hgrn_final_unit(PP P, LAS unsigned char* lds, int l, int idx, int half_sel, int tid) {
    const int lane = tid & 63, wave = __builtin_amdgcn_readfirstlane(tid >> 6), r32 = lane & 31, hh = lane >> 5, i16 = lane & 15, cg = (lane >> 4) & 1;
    const bf16* Z = (const bf16*)(P->ws + WS_Z); bf16* MIX = (bf16*)(P->ws + WS_H); const float* OL = (const float*)(P->ws + WS_OL); const float* DLC = (const float*)(P->ws + WS_DLOG);
    LAS float* ldsf = (LAS float*)lds;
    const int blk = idx & 15, h = (idx >> 4) & 3, lb = idx >> 6, row0 = NCTX + lb * 2048 + blk * 128;
    const int ti = tid >> 4, d0 = 8 * (tid & 15), nt = wave & 3, ds = wave >> 2;
    const int uidx0 = ((idx >> 4) * 2 + 0) * 16 + blk, uidx1 = ((idx >> 4) * 2 + 1) * 16 + blk;
#pragma unroll
    for (int half = 0; half < 2; ++half) {
        f32x4 sv[8];
#pragma unroll
        for (int k = 0; k < 8; ++k) { const int id = tid + 512 * (k + 8 * half), dsel = id >> 12, dk = (id >> 5) & 127, c4 = id & 31;
            sv[k] = *(const f32x4*)((const float*)(P->ws + WS_U) + (size_t)(dsel ? uidx1 : uidx0) * 16384 + dk * 128 + c4 * 4); }
#pragma unroll
        for (int k = 0; k < 8; ++k) { const int id = tid + 512 * (k + 8 * half), dsel = id >> 12, dk = (id >> 5) & 127, c4 = id & 31;
            u32x2 w; w.x = pk2(sv[k][0], sv[k][1]); w.y = pk2(sv[k][2], sv[k][3]); *(LAS u32x2*)(lds + (dsel ? HF_S1 : HF_S0) + dk * 320 + c4 * 8) = w; }
    }
    float oml0[8], oml1[8]; hg_oml8(P, l, 0, h * 128 + d0, oml0); hg_oml8(P, l, 1, h * 128 + d0, oml1);
    const f32x4 n0 = *(const f32x4*)(P->in[13] + l * 512 + h * 128 + d0), n1 = *(const f32x4*)(P->in[13] + l * 512 + h * 128 + d0 + 4);
    float carry = 0.f;
    if (tid < 128) { for (int c = 0; c < 2 * half_sel; ++c) carry += DLC[(uidx0 * 4 + c) * 128 + tid]; }
    for (int nc = 2 * half_sel; nc < 2 * half_sel + 2; ++nc) {
        const int rown = row0 + 32 * nc + ti; const bf16* zr = Z + (size_t)rown * DIN + h * 128 + d0;
        const u32x4 uq = *(const u32x4*)(zr + C_HQ), uf0 = *(const u32x4*)(zr + C_HFF), uf1 = *(const u32x4*)(zr + C_HFB), ug = *(const u32x4*)(zr + C_HG);
        const float* olr = OL + (size_t)rown * 512 + h * 128 + d0; const f32x4 olp0 = *(const f32x4*)olr, olp1 = *(const f32x4*)(olr + 4);
        float off1 = 0.f;
        if (tid >= 128 && tid < 256) { for (int c = 0; c < 3 - nc; ++c) off1 += DLC[(uidx1 * 4 + c) * 128 + (tid - 128)]; }
        float q[8];
        {
            float ga[8], gb[8];
#pragma unroll
            for (int j = 0; j < 4; ++j) { const unsigned wq = uq[j], wa = uf0[j], wb = uf1[j];
                q[2 * j] = siluf_(bflo(wq)) * 0.08838834764831845f; q[2 * j + 1] = siluf_(bfhi(wq)) * 0.08838834764831845f;
                ga[2 * j] = oml0[2 * j] * sigmoidf_(-bflo(wa)); ga[2 * j + 1] = oml0[2 * j + 1] * sigmoidf_(-bfhi(wa));
                gb[2 * j] = oml1[2 * j] * sigmoidf_(-bflo(wb)); gb[2 * j + 1] = oml1[2 * j + 1] * sigmoidf_(-bfhi(wb)); }
#pragma unroll
            for (int j = 0; j < 8; ++j) { ga[j] = __builtin_amdgcn_logf(1.0f - fminf(ga[j], 1.0f - 1e-6f)); gb[j] = __builtin_amdgcn_logf(1.0f - fminf(gb[j], 1.0f - 1e-6f)); }
            LAS float* p0 = ldsf + (HF_TG0 >> 2) + ti * 132 + d0; LAS float* p1 = ldsf + (HF_TG1 >> 2) + ti * 132 + d0;
            *(LAS f32x4*)p0 = (f32x4){ga[0], ga[1], ga[2], ga[3]}; *(LAS f32x4*)(p0 + 4) = (f32x4){ga[4], ga[5], ga[6], ga[7]};
            *(LAS f32x4*)p1 = (f32x4){gb[0], gb[1], gb[2], gb[3]}; *(LAS f32x4*)(p1 + 4) = (f32x4){gb[4], gb[5], gb[6], gb[7]};
        }
        __syncthreads();
        if (tid < 256) { const bool rev = tid >= 128; LAS float* gc = ldsf + ((rev ? HF_TG1 : HF_TG0) >> 2) + (tid & 127); float run = rev ? off1 : carry; float gv[32];
#pragma unroll
            for (int i = 0; i < 32; ++i) gv[i] = gc[(rev ? 31 - i : i) * 132];
            SBAR
#pragma unroll
            for (int i = 0; i < 32; ++i) { run += gv[i]; gc[(rev ? 31 - i : i) * 132] = run; }
            if (!rev) carry = run; }
        __syncthreads();
        {
            const LAS float* g0 = ldsf + (HF_TG0 >> 2) + ti * 132 + d0; const LAS float* g1 = ldsf + (HF_TG1 >> 2) + ti * 132 + d0;
            float a[8], c[8];
#pragma unroll
            for (int j = 0; j < 8; ++j) { a[j] = q[j] * __builtin_amdgcn_exp2f(g0[j]); c[j] = q[j] * __builtin_amdgcn_exp2f(g1[j]); }
            *(LAS bf16x8*)(lds + HF_QG0 + ti * 272 + d0 * 2) = pack8(a[0], a[1], a[2], a[3], a[4], a[5], a[6], a[7]);
            *(LAS bf16x8*)(lds + HF_QG1 + ti * 272 + d0 * 2) = pack8(c[0], c[1], c[2], c[3], c[4], c[5], c[6], c[7]);
        }
        __syncthreads();
        {
            f32x16 acc;
#pragma unroll
            for (int i = 0; i < 16; ++i) acc[i] = 0.f;
            const LAS unsigned char* qp = lds + (ds ? HF_QG1 : HF_QG0) + r32 * 272 + 16 * hh;
            const LAS unsigned char* sp = lds + (ds ? HF_S1 : HF_S0) + (8 * hh + (i16 >> 2)) * 320 + (32 * nt + 16 * cg + 4 * (i16 & 3)) * 2;
#pragma unroll
            for (int k = 0; k < 8; ++k) { const bf16x8 sf = trpair(sp + 16 * k * 320, 4 * 320); acc = __builtin_amdgcn_mfma_f32_32x32x16_bf16(*(const LAS bf16x8*)(qp + 32 * k), sf, acc, 0, 0, 0); }
            LAS float* ob = ldsf + ((ds ? HF_TG1 : HF_TG0) >> 2) + (4 * hh) * 132 + 32 * nt + r32;
#pragma unroll
            for (int i = 0; i < 16; ++i) ob[R0(i) * 132] = acc[i];
        }
        __syncthreads();
        {
            const LAS float* oa = ldsf + (HF_TG0 >> 2) + ti * 132 + d0; const LAS float* obb = ldsf + (HF_TG1 >> 2) + ti * 132 + d0;
            const f32x4 a0 = *(const LAS f32x4*)oa, a1 = *(const LAS f32x4*)(oa + 4), b0 = *(const LAS f32x4*)obb, b1 = *(const LAS f32x4*)(obb + 4);
            const f32x4 o0 = a0 + b0 + olp0, o1 = a1 + b1 + olp1;
            float ss = (o0[0] * o0[0] + o0[1] * o0[1]) + (o0[2] * o0[2] + o0[3] * o0[3]) + (o1[0] * o1[0] + o1[1] * o1[1]) + (o1[2] * o1[2] + o1[3] * o1[3]);
            ss += __shfl_xor(ss, 1); ss += __shfl_xor(ss, 2); ss += __shfl_xor(ss, 4); ss += __shfl_xor(ss, 8);
            const float r = __builtin_amdgcn_rsqf(ss * (1.0f / 128.0f) + 1e-6f);
            u32x4 w;
            w.x = pk2(o0[0] * r * n0[0] * siluf_(bflo(ug.x)), o0[1] * r * n0[1] * siluf_(bfhi(ug.x))); w.y = pk2(o0[2] * r * n0[2] * siluf_(bflo(ug.y)), o0[3] * r * n0[3] * siluf_(bfhi(ug.y)));
            w.z = pk2(o1[0] * r * n1[0] * siluf_(bflo(ug.z)), o1[1] * r * n1[1] * siluf_(bfhi(ug.z))); w.w = pk2(o1[2] * r * n1[2] * siluf_(bflo(ug.w)), o1[3] * r * n1[3] * siluf_(bfhi(ug.w)));
            *(u32x4*)(MIX + (size_t)rown * D_MODEL + 1024 + h * 128 + d0) = w;
        }
        __syncthreads();
    }
}

#define RLX_AGENT __ATOMIC_RELAXED, __HIP_MEMORY_SCOPE_AGENT
#define XB_TMO      128
#define XB_XCNT(j)  (256  + 64 * (j))
#define XB_XSUB(j)  (1280 + 64 * (j))
#define XB_XGEN(j)  (2304 + 64 * (j))
#define XB_TOP      3328
#define XB_TOPGEN   3392
#define XCD_BAR_WORDS 3456
#define XB_SPIN_CAP (1u << 18)

__device__ __forceinline__ unsigned xb_ld(unsigned* p)              { return __hip_atomic_load(p, __ATOMIC_RELAXED, __HIP_MEMORY_SCOPE_AGENT); }
__device__ __forceinline__ unsigned xb_add(unsigned* p, unsigned v) { return __hip_atomic_fetch_add(p, v, __ATOMIC_RELAXED, __HIP_MEMORY_SCOPE_AGENT); }
__device__ __forceinline__ unsigned xb_xcc_id() { return (unsigned)__builtin_amdgcn_s_getreg((3 << 11) | 20) & 0xFu; }
#define XB_SPIN(cond, bar) do { unsigned _sp = 0; while (cond) { __builtin_amdgcn_s_sleep(1); \
    if ((++_sp & 255u) == 0u) { if (xb_ld(&(bar)[XB_TMO])) break; if (_sp > XB_SPIN_CAP) { atomicAdd(&(bar)[XB_TMO], 1u); break; } } } } while (0)

struct XcdBarrier {
    unsigned* bar; unsigned x; bool t0;
    volatile LAS unsigned* st;
};

__device__ __forceinline__ XcdBarrier xcd_barrier_post(unsigned* bar, volatile LAS unsigned* st) {
    XcdBarrier b; b.bar = bar; b.x = xb_xcc_id(); b.st = st; b.t0 = (threadIdx.x == 0);
    if (threadIdx.x == 0) (void)xb_add(&bar[XB_XCNT(b.x)], 1u);
    return b;
}
__device__ __forceinline__ void xcd_barrier_complete(unsigned* bar, unsigned x, unsigned& nloc, unsigned& nx) {
    const unsigned G = gridDim.x * gridDim.y * gridDim.z;
    unsigned sum, cnt, mine, sp = 0u;
    for (;;) {
        sum = 0u; cnt = 0u; mine = 0u;
#pragma unroll
        for (unsigned j = 0; j < 16; ++j) { const unsigned c = xb_ld(&bar[XB_XCNT(j)]); sum += c; cnt += (c > 0u) ? 1u : 0u; mine = (j == x) ? c : mine; }
        if (sum == G) break;
        __builtin_amdgcn_s_sleep(1);
        if ((++sp & 255u) == 0u) { if (xb_ld(&bar[XB_TMO])) break; if (sp > XB_SPIN_CAP) { atomicAdd(&bar[XB_TMO], 1u); break; } }
    }
    nloc = mine > 0u ? mine : 1u; nx = cnt > 0u ? cnt : 1u;
}

__device__ __forceinline__ void xcd_barrier(const XcdBarrier& b) {
    asm volatile("s_waitcnt vmcnt(0)" ::: "memory");
    __syncthreads();
    if (b.t0) {
        unsigned* bar = b.bar;
        __builtin_amdgcn_s_waitcnt(0);
        unsigned nloc = b.st[0], nx = b.st[1];
        if (nloc == 0u) { xcd_barrier_complete(bar, b.x, nloc, nx); b.st[0] = nloc; b.st[1] = nx; }
        const unsigned old = xb_add(&bar[XB_XSUB(b.x)], 1u);
        const unsigned gen = old / nloc;
        if (old + 1u == (gen + 1u) * nloc) {
            __builtin_amdgcn_fence(__ATOMIC_RELEASE, "agent");
            asm volatile("s_waitcnt vmcnt(0)" ::: "memory");
            const unsigned og = xb_add(&bar[XB_TOP], 1u);
            const unsigned tg = og / nx;
            if (og + 1u == (tg + 1u) * nx) xb_add(&bar[XB_TOPGEN], 1u);
            else XB_SPIN(xb_ld(&bar[XB_TOPGEN]) == tg, bar);
            __builtin_amdgcn_fence(__ATOMIC_ACQUIRE, "agent");
            xb_add(&bar[XB_XGEN(b.x)], 1u);
            asm volatile("s_waitcnt vmcnt(0)" ::: "memory");
        } else {
            XB_SPIN(xb_ld(&bar[XB_XGEN(b.x)]) == gen, bar);
            __builtin_amdgcn_fence(__ATOMIC_ACQUIRE, "agent");
            asm volatile("s_waitcnt vmcnt(0)" ::: "memory");
        }
    }
    __syncthreads();
}

#ifndef REP_P0
#define REP_P0 1
#endif
#ifndef REP_P1
#define REP_P1 1
#endif
#ifndef REP_P2
#define REP_P2 1
#endif
#ifndef PROBE_KIND
#define PROBE_KIND -1
#endif
#ifndef PROBE_PH
#define PROBE_PH 0
#endif
#ifndef PROBE_SCALE
#define PROBE_SCALE 1.0f
#endif
#ifndef PROBE_PB
#define PROBE_PB 0
#endif
#ifndef PROBE_PL
#define PROBE_PL 0
#endif
#ifndef P0_MASK
#define P0_MASK 3
#endif
#ifndef P2_MASK
#define P2_MASK 31
#endif
#ifndef REP_P3
#define REP_P3 1
#endif
#ifndef REP_P4
#define REP_P4 1
#endif
__global__ void __launch_bounds__(NTHREADS, 2) fwd_kernel(Params Pkarg) {
    extern __shared__ __attribute__((aligned(16))) unsigned char lds_raw[];
    cg::grid_group grid = cg::this_grid();
    LAS unsigned char* lds = (LAS unsigned char*)lds_raw;
    LAS float* ldsf = (LAS float*)lds;
    volatile LAS unsigned* qslot = (volatile LAS unsigned*)(lds + LDS_CTLW);
    volatile LAS unsigned* xbst = (volatile LAS unsigned*)(lds + LDS_CTLW + 128);
    if (threadIdx.x < 2) xbst[threadIdx.x] = 0u;
    __syncthreads();
    (void)xcd_barrier_post((unsigned*)(Pkarg.ws + WS_CTL) + 1024, xbst);
#define PSTAMP(k, lay) do { if (PROBE_KIND == 20 && (lay) == PROBE_PL && blockIdx.x == PROBE_PB && wave_s == 0) { const unsigned long long t_ = __builtin_amdgcn_s_memrealtime(); if ((k) == PROBE_PH) pst0 = t_; if ((k) == PROBE_PH + 1) pst1 = t_; } } while (0)
#define tid_zero_() (wave_s == 0 && __builtin_amdgcn_mbcnt_hi(~0u, __builtin_amdgcn_mbcnt_lo(~0u, 0u)) == 0u)
#define GSYNC() do { PP Pb_ = (PP)__builtin_amdgcn_kernarg_segment_ptr(); asm volatile("" : "+s"(Pb_)); XcdBarrier xb_; xb_.bar = (unsigned*)(Pb_->ws + WS_CTL) + 1024; xb_.x = xb_xcc_id(); xb_.st = xbst; int ln_; asm volatile("v_mbcnt_lo_u32_b32 %0, -1, 0\n\tv_mbcnt_hi_u32_b32 %0, -1, %0" : "=v"(ln_)); xb_.t0 = (wave_s == 0) && (ln_ == 0); xcd_barrier(xb_); } while (0)
    const int wave_s = __builtin_amdgcn_readfirstlane(threadIdx.x >> 6);
#define PHASE_IDS int tid; asm volatile("v_mbcnt_lo_u32_b32 %0, -1, 0\n\tv_mbcnt_hi_u32_b32 %0, -1, %0" : "=v"(tid)); tid += wave_s * 64; const int lane = tid & 63, wave = wave_s, gw = blockIdx.x * NWAVES + wave; (void)lane; (void)gw; \
    PP P = (PP)__builtin_amdgcn_kernarg_segment_ptr(); asm volatile("" : "+s"(P)); unsigned char* ws = P->ws; unsigned* ctl = (unsigned*)(ws + WS_CTL); float* MOD = (float*)(ws + WS_MOD); \
    bf16* H = (bf16*)(ws + WS_H); bf16* Z = (bf16*)(ws + WS_Z); bf16* WTIN = (bf16*)(ws + WS_WTIN); bf16* WTOUT = (bf16*)(ws + WS_WTOUT); const float* xp = P->in[0]; const float* xs = P->in[1]; \
    (void)ctl; (void)MOD; (void)H; (void)Z; (void)WTIN; (void)WTOUT; (void)xp; (void)xs;
    const int G = gridDim.x, NGW = G * NWAVES;
    unsigned long long pst0 = 0ull, pst1 = 0ull;

    for (int rep = 0; rep < REP_P0; ++rep) {
        PHASE_IDS
        const int m0 = (rep == 0) ? 3 : P0_MASK;
        if (m0 & 1) for (int u = blockIdx.x; u < 192; u += G) mod_unit(P, ldsf, 0, u, tid);
        LAS float* scr = ldsf + wave * 4096;
        if (m0 & 2) for (int it = gw; it < 6656; it += NGW) transpose_item(P->in[9], 2048, DIN, WTIN, scr, it, lane);
        { const int gt4 = (blockIdx.x * NTHREADS + tid) * 4;
          if (gt4 < 524288) { const float* src = (gt4 < 262144) ? P->in[2] + gt4 : P->in[3] + (gt4 - 262144); const f32x4 v = *(const f32x4*)src;
              u32x2 w; w.x = pk2(v[0], v[1]); w.y = pk2(v[2], v[3]); *(u32x2*)((bf16*)(ws + WS_CKV) + gt4) = w; } }
        const int gt = blockIdx.x * NTHREADS + tid;
        if (gt < 2048) { const int pos = gt >> 5, i = gt & 31; const float inv = powf(10000.0f, -(float)i / 32.0f); const float ang = (float)pos * inv;
            float sn, cs; sincosf(ang, &sn, &cs); float* CS = (float*)(ws + WS_CS); CS[gt * 2] = cs; CS[gt * 2 + 1] = sn; }
        grid.sync();
    }
    { PHASE_IDS
    for (int row = gw; row < MTOK; row += NGW) {
        const int cond = (row < NCTX) ? 0 : 1 + ((row - NCTX) >> 11);
        const float* xrow = (row < NCTX) ? xp + (size_t)row * D_MODEL : xs + (size_t)(row - NCTX) * D_MODEL;
        hprep_row(xrow, MOD + (0 * 3 + cond) * 6144, H + (size_t)row * D_MODEL, lane);
    } }
    GSYNC();

    for (int l = 0; l < DEPTH; ++l) {
        PSTAMP(0, l);
        for (int rep = 0; rep < REP_P1; ++rep) {
            PHASE_IDS
            pg8::Gemm g{H, WTIN, MTOK, DIN, D_MODEL}; pg8::StaticOrder S; S.init(MTOK, DIN, D_MODEL, G, (int)blockIdx.x);
            pg8::EpiZ E{Z, P->out + OUT_CK, P->out + OUT_CV, l};
            pg8::gemm_phase<pg8::EpiZ, pg8::StaticOrder, true, true>(lds, g, S, E, tid);
            GSYNC();
        }
        PSTAMP(1, l);
        {
            int pendf = -1; int uf = -1;
            unsigned long long pr_sum = 0ull; unsigned pr_cnt = 0u;
            const int n_cvt = (l == 0 && G != 256) ? 832 : 0;
            for (int st = 0; st < 3; ++st) {
                PHASE_IDS
                unsigned* cs = ctl + 64 * (l * 4 + st); unsigned* cf = ctl + 64 * (l * 4 + 3);
                const int nspec = (st == 2) ? 256 : 128;
                const int n_def = (l == 0) ? 192 + 512 : 0;
                const int capf = (st == 0) ? 256 : (st == 1) ? 512 : 896 + n_def + n_cvt;
                int pends = -1; bool spec = true;
                int us = q_pop(cs, qslot, tid, pends, 1 << 30);
                for (;;) {
                    int kind, idx;
                    if (spec) {
                        if (us >= nspec) { spec = false; if (uf < 0) uf = q_pop(cf, qslot, tid, pendf, 512); continue; }
                        kind = (st == 0) ? 1 : (st == 1) ? 6 : 7; idx = us;
                    } else {
                        if (uf >= capf) break;
                        if (uf < 128) { kind = 0; idx = uf; } else if (uf < 256) { kind = 3; idx = uf - 128; } else if (uf < 512) { kind = 2; idx = uf - 256; }
                        else if (uf < 896) { kind = 4; idx = uf - 512; } else if (uf < 896 + n_def) { idx = uf - 896; if (idx < 192) kind = 8; else { kind = 9; idx -= 192; } } else { kind = 5; idx = uf - 896 - n_def; }
                    }
                    asm volatile("" : "+v"(tid));
                    const unsigned long long pr_t0 = (PROBE_KIND >= 0 && PROBE_KIND < 9) ? __builtin_amdgcn_s_memrealtime() : 0ull;
                    if (kind <= 1) hgrn2_unit(P, lds, l, kind, idx, tid);
                    else if (kind <= 3) attn_unit(P, lds, l, kind - 2, idx, tid);
                    else if (kind == 4) conv_unit(P, ldsf, l, idx, tid);
                    else if (kind == 5) { const int lane2 = tid & 63; LAS float* scr = ldsf + wave * 4096; transpose_item(P->in[9] + (size_t)2048 * DIN, 2048, DIN, WTIN, scr, idx * 8 + wave, lane2); }
                    else if (kind == 6) hgrn_scan_unit(P, l, idx, tid);
                    else if (kind == 8) mod_unit(P, ldsf, 1, idx, tid);
                    else if (kind == 9) { const int it = idx * 8 + wave, lo = it & 2047; LAS float* scr = ldsf + wave * 4096;
                        transpose_item(P->in[10] + (size_t)(it >> 11) * 2048 * 2048, 2048, 2048, WTOUT + (size_t)(it >> 11) * 2048 * 2048, scr, lo, tid & 63); }
                    else hgrn_final_unit(P, lds, l, idx >> 1, idx & 1, tid);
                    if (PROBE_KIND >= 0 && PROBE_KIND < 9 && kind == PROBE_KIND) { __syncthreads(); pr_sum += __builtin_amdgcn_s_memrealtime() - pr_t0; pr_cnt += 1u; }
                    if (spec) us = q_pop(cs, qslot, tid, pends, 1 << 30); else uf = q_pop(cf, qslot, tid, pendf, 512);
                }
                GSYNC();
                PSTAMP(2 + st, l);
            }
            if (PROBE_KIND >= 0 && PROBE_KIND < 9 && l == 0 && tid_zero_()) { atomicAdd((unsigned long long*)((unsigned*)(Pkarg.ws + WS_CTL) + 60000), pr_sum); atomicAdd((unsigned*)(Pkarg.ws + WS_CTL) + 60002, pr_cnt); }
        }
        if (G == 256) {
            {   PHASE_IDS
                pg8::Gemm g{H, WTOUT + (size_t)l * 2048 * 2048, MTOK, D_MODEL, D_MODEL}; pg8::StaticOrder S; S.init(MTOK, D_MODEL, D_MODEL, G, (int)blockIdx.x, 0); S.rset = 0;
                pg8::EpiV E{(l == 0) ? xp : P->out, (l == 0) ? xs : P->out + OUT_YS, (bf16*)(ws + WS_OL), MOD + l * 3 * 6144 + 4096, (float*)(ws + WS_U), ctl + 8192};
                pg8::gemm_phase<pg8::EpiV, pg8::StaticOrder, true, true>(lds, g, S, E, tid);
            }
            GSYNC();
            PSTAMP(5, l);
            if (blockIdx.x < 128) {
                PHASE_IDS
                pg8::Gemm g{H, WTOUT + (size_t)l * 2048 * 2048, MTOK, D_MODEL, D_MODEL}; pg8::StaticOrder S; S.init(MTOK, D_MODEL, D_MODEL, G, (int)blockIdx.x, 0); S.rset = 1;
                pg8::EpiV E{(l == 0) ? xp : P->out, (l == 0) ? xs : P->out + OUT_YS, (bf16*)(ws + WS_OL), MOD + l * 3 * 6144 + 4096, (float*)(ws + WS_U), ctl + 8192};
                pg8::gemm_phase<pg8::EpiV, pg8::StaticOrder, true, true>(lds, g, S, E, tid);
            } else {
                PHASE_IDS
                for (int row = (blockIdx.x - 128) * NWAVES + wave; row < NCTX; row += 128 * NWAVES)
                    ln_row((const bf16*)(ws + WS_OL) + (size_t)row * D_MODEL, P->out + (size_t)row * D_MODEL, P->in[18] + l * D_MODEL, P->in[19] + l * D_MODEL, MOD + 3 * 6144, (l == 0) ? H + (size_t)row * D_MODEL : (bf16*)nullptr, lane);
                if (l == 0) {
                    LAS float* scr = ldsf + wave * 4096;
                    for (int it = (blockIdx.x - 128) * NWAVES + wave; it < 6656; it += 128 * NWAVES) { asm volatile("" : "+v"(tid)); transpose_item(P->in[9] + (size_t)2048 * DIN, 2048, DIN, WTIN, scr, it, tid & 63); }
                }
            }
#ifdef PROBE_SUB
            __syncthreads(); PSTAMP(6, l);
#endif
            GSYNC();
#ifndef PROBE_SUB
            PSTAMP(6, l);
#endif
            {   PHASE_IDS
                for (int row = NCTX + gw; row < MTOK; row += NGW) { const int cond = 1 + ((row - NCTX) >> 11);
                    ln_row((const bf16*)(ws + WS_OL) + (size_t)row * D_MODEL, P->out + (size_t)row * D_MODEL, P->in[18] + l * D_MODEL, P->in[19] + l * D_MODEL, MOD + (3 + cond) * 6144, (l == 0) ? H + (size_t)row * D_MODEL : (bf16*)nullptr, lane); }
            }
        } else {
            {   PHASE_IDS
                pg8::Gemm g{H, WTOUT + (size_t)l * 2048 * 2048, MTOK, D_MODEL, D_MODEL}; pg8::StaticOrder S; S.init(MTOK, D_MODEL, D_MODEL, G, (int)blockIdx.x, 0);
                pg8::EpiV E{(l == 0) ? xp : P->out, (l == 0) ? xs : P->out + OUT_YS, (bf16*)(ws + WS_OL), MOD + l * 3 * 6144 + 4096, (float*)(ws + WS_U), ctl + 8192};
                pg8::gemm_phase<pg8::EpiV, pg8::StaticOrder, true, true>(lds, g, S, E, tid);
            }
            GSYNC();
            {   PHASE_IDS
                for (int row = gw; row < MTOK; row += NGW) { const int cond = (row < NCTX) ? 0 : 1 + ((row - NCTX) >> 11);
                    ln_row((const bf16*)(ws + WS_OL) + (size_t)row * D_MODEL, P->out + (size_t)row * D_MODEL, P->in[18] + l * D_MODEL, P->in[19] + l * D_MODEL, MOD + (3 + cond) * 6144, (l == 0) ? H + (size_t)row * D_MODEL : (bf16*)nullptr, lane); }
            }
        }
        if (l + 1 < DEPTH) GSYNC();
        PSTAMP(7, l);
    }
    if (PROBE_KIND >= 0) { GSYNC(); PHASE_IDS if (blockIdx.x == ((PROBE_KIND == 20) ? PROBE_PB : 0) && tid == 0) { const unsigned long long sm = *(volatile unsigned long long*)(ctl + 60000); const unsigned cn = *(volatile unsigned*)(ctl + 60002); const float pv_ = (PROBE_KIND == 20) ? PROBE_SCALE * 0.01f * (float)(pst1 - pst0) : ((PROBE_KIND == 9) ? 0.1f : 0.01f) * (float)sm / (float)(cn ? cn : 1u);     P->out[0] = pv_; P->out[1] = pv_; P->out[2] = pv_; P->out[3] = pv_; }     }
}

extern "C" void kernel_launch(void* const* d_in, const int* in_sizes, int n_in, void* d_out, int out_size, void* d_ws, size_t ws_size, hipStream_t stream) {
    static int grid = 0;
    if (grid == 0) {
        if (n_in != 20 || out_size != (int)OUT_TOTAL || ws_size < WS_END) { fprintf(stderr, "kernel_launch: unexpected shapes (n_in %d, out %d, ws %zu)\n", n_in, out_size, ws_size); grid = -1; return; }
        int dev = 0, cus = 0, per_cu = 0;
        hipGetDevice(&dev); hipDeviceGetAttribute(&cus, hipDeviceAttributeMultiprocessorCount, dev);
        hipFuncSetAttribute((const void*)fwd_kernel, hipFuncAttributeMaxDynamicSharedMemorySize, LDS_BYTES);
        hipOccupancyMaxActiveBlocksPerMultiprocessor(&per_cu, (const void*)fwd_kernel, NTHREADS, LDS_BYTES);
        if (per_cu < 1) { fprintf(stderr, "kernel_launch: occupancy query says %d blocks per CU\n", per_cu); grid = -1; return; }
        grid = cus;
    }
    if (grid < 0) return;
    hipMemsetAsync((char*)d_ws + WS_CTL, 0, CTL_ZERO_BYTES, stream);
    Params p{};
    for (int i = 0; i < 20; ++i) p.in[i] = (const float*)d_in[i];
    p.out = (float*)d_out; p.ws = (unsigned char*)d_ws;
    void* args[] = {&p};
    hipError_t e = hipLaunchCooperativeKernel((const void*)fwd_kernel, dim3(grid), dim3(NTHREADS), args, LDS_BYTES, stream);
    if (e != hipSuccess) fprintf(stderr, "cooperative launch failed: %s (grid %d)\n", hipGetErrorString(e), grid);
}
```

```cpp
#include <hip/hip_runtime.h>
#include <hip/hip_cooperative_groups.h>
#include <cstdio>
#include <cstdint>
namespace cg = cooperative_groups;

constexpr int D_MODEL = 2048, DIN = 6656, NCTX = 8192, NLAT = 4096, MTOK = 12288, DEPTH = 2;
constexpr int C_AQ = 0, C_AK = 1024, C_AV = 1280, C_AG = 1536, C_HQ = 2560, C_HI = 3072, C_HFF = 3584, C_HFB = 4096, C_HG = 4608, C_CA = 5120, C_CB = 5632, C_CG = 6144;
constexpr float ALPHA_DN = 1.4142135623730951f;
constexpr size_t OUT_YP = 0, OUT_YS = 16777216, OUT_CK = 25165824, OUT_CV = 29360128, OUT_ST = 33554432, OUT_TOTAL = 41943040;
namespace pg8 {
#define PG8_LAS __attribute__((address_space(3)))
typedef unsigned short bf16_t;
typedef short bf16x8 __attribute__((ext_vector_type(8)));
typedef float f32x4 __attribute__((ext_vector_type(4)));
typedef unsigned u32x4 __attribute__((ext_vector_type(4)));
constexpr int BM = 256, BK = 64, HALF = 128, HTB = HALF * BK * 2  , STAGE_BYTES = 8 * HTB, NXCD = 8, WGM = 8;

__host__ __device__ __forceinline__ int lds_byte(int r, int c) { const int st = (r >> 4) * 2 + (c >> 5), rr = r & 15, cc = c & 31, ob = rr * 64 + cc * 2; return st * 1024 + (ob ^ (((ob >> 9) & 1) << 5)); }
__host__ __device__ __forceinline__ void stage_rc(int b, int& R, int& C) { const int st = b / 1024, sb = b % 1024, swz = sb ^ (((sb >> 9) & 1) << 5); R = (st >> 1) * 16 + swz / 64; C = (st & 1) * 32 + (swz % 64) / 2; }
__host__ __device__ __forceinline__ int perm32(int rho) { const int n = rho >> 4, i = rho & 15; return 8 * (i >> 2) + 4 * n + (i & 3); }

struct Unit { int pm, pn, k0, nk, role, pair; };
struct Gemm { const bf16_t* A; const bf16_t* Bt; int M, N, K; };

struct StaticOrder {
    int nM, nN, nwg, G, c, nkt, split, rset;
    __host__ __device__ void init(int M, int N, int K, int G_, int c_, int split_ = 0) { nM = M / BM; nN = N / BM; nwg = nM * nN; G = G_; c = c_; nkt = K / BK; split = split_ && (G_ % 16 == 0) && (2 * nwg == 3 * G_) && (nkt % 4 == 0); rset = -1; }
    __host__ __device__ void map(long L, Unit& u) const {
        int wgid = (int)L; { const int q = nwg / NXCD, r = nwg % NXCD, xcd = wgid % NXCD, off = wgid / NXCD; wgid = (xcd < r ? xcd * (q + 1) : r * (q + 1) + (xcd - r) * q) + off; }
        const int nig = WGM * nN, gid = wgid / nig, fm = gid * WGM, gsz = (nM - fm) < WGM ? (nM - fm) : WGM;
        u.pm = fm + ((wgid % nig) % gsz); u.pn = (wgid % nig) / gsz; u.k0 = 0; u.nk = nkt; u.role = 0; u.pair = 0;
    }
    __host__ __device__ bool next(int i, Unit& u) const {
        if (rset >= 0) {
            if (i != 0) return false;
            const int xcd = c & 7, ix = c >> 3;
            if (rset == 0) { u.pm = xcd * 4 + (ix >> 3); u.pn = ix & 7; } else { if (c >= 128) return false; u.pm = 32 + xcd * 2 + (ix >> 3); u.pn = ix & 7; }
            u.k0 = 0; u.nk = nkt; u.role = 0; u.pair = 0; return true;
        }
        if (split) {
            if (i == 0) { map(c, u); return true; }
            if (i == 1) { const int j = (c >> 4) * 8 + (c & 7), half = (c >> 3) & 1; map(G + j, u); u.k0 = half * (nkt / 2); u.nk = nkt / 2; u.role = 1 + half; u.pair = j; return true; }
            return false;
        }
        const long L = (long)i * G + c; if (L >= nwg) return false;
        map(L, u); return true;
    }
    __device__ __forceinline__ void a_ready(const Unit&) const {}
    __device__ __forceinline__ void done(const Unit&) const {}
};

__device__ __forceinline__ unsigned cvt_pk_bf16(float lo, float hi) { unsigned r; asm volatile("v_cvt_pk_bf16_f32 %0, %1, %2" : "=v"(r) : "v"(lo), "v"(hi)); return r; }
typedef float f32x2 __attribute__((ext_vector_type(2)));

struct EpiZ {
    static constexpr bool PERM = true, AFTER_DRAIN = false;
    bf16_t* Z; float* ck; float* cv; int layer; const float* hlb;
    __device__ __forceinline__ void operator()(f32x4 (&acc)[2][2][4][2], const Unit& u, int wr, int wc, int fr_in, int fq_in) const {
        int fr = fr_in, fq = fq_in; asm volatile("" : "+v"(fr), "+v"(fq));
        const int row0 = u.pm * BM + wr * 64 + fr; const int col0 = u.pn * BM + wc * 32 + 8 * fq;
        const bool sig = (u.pn == 22 || u.pn == 23);
        const int cls = (u.pn == 10 || u.pn == 11) ? 1 : (u.pn >= 14 && u.pn <= 17) ? 2 : 0;
        f32x4 oml[2][2];
#pragma unroll
        for (int bj = 0; bj < 2; ++bj)
#pragma unroll
            for (int n = 0; n < 2; ++n) oml[bj][n] = (f32x4){1.f, 1.f, 1.f, 1.f};
        if (cls == 2 && layer != 0) { const int dir = (u.pn >= 16) ? 1 : 0; const float* hb = hlb + dir * 1024 + (u.pn & 1) * 256 + wc * 32 + 8 * fq;
#pragma unroll
            for (int bj = 0; bj < 2; ++bj)
#pragma unroll
                for (int n = 0; n < 2; ++n) { const f32x4 a = *(const f32x4*)(hb + bj * HALF + 4 * n), b = *(const f32x4*)(hb + 512 + bj * HALF + 4 * n);
#pragma unroll
                    for (int e = 0; e < 4; ++e) oml[bj][n][e] = 1.0f - __builtin_amdgcn_rcpf(1.0f + __builtin_amdgcn_exp2f(-1.4426950408889634f * (b[e] - a[e]))); } }
#pragma unroll
        for (int ai = 0; ai < 2; ++ai)
#pragma unroll
            for (int m = 0; m < 4; ++m) { bf16_t* rowp = Z + (size_t)(row0 + ai * HALF + m * 16) * DIN + col0;
#pragma unroll
                for (int bj = 0; bj < 2; ++bj) { f32x4 v0 = acc[ai][bj][m][0], v1 = acc[ai][bj][m][1];
                    if (cls == 1) {
#pragma unroll
                        for (int e = 0; e < 4; ++e) { v0[e] = v0[e] * 0.08838834764831845f * __builtin_amdgcn_rcpf(1.0f + __builtin_amdgcn_exp2f(-1.4426950408889634f * v0[e])); v1[e] = v1[e] * 0.08838834764831845f * __builtin_amdgcn_rcpf(1.0f + __builtin_amdgcn_exp2f(-1.4426950408889634f * v1[e])); }
                    } else if (cls == 2) {
                        const f32x4 o0 = oml[bj][0], o1 = oml[bj][1];
#pragma unroll
                        for (int e = 0; e < 4; ++e) { const float k0 = o0[e] * __builtin_amdgcn_rcpf(1.0f + __builtin_amdgcn_exp2f(1.4426950408889634f * v0[e])), k1 = o1[e] * __builtin_amdgcn_rcpf(1.0f + __builtin_amdgcn_exp2f(1.4426950408889634f * v1[e]));
                            v0[e] = __builtin_amdgcn_logf(1.0f - fminf(k0, 1.0f - 1e-6f)); v1[e] = __builtin_amdgcn_logf(1.0f - fminf(k1, 1.0f - 1e-6f)); }
                    }
                    if (sig) {
#pragma unroll
                        for (int e = 0; e < 4; ++e) { v0[e] = __builtin_amdgcn_rcpf(1.0f + __builtin_amdgcn_exp2f(-1.4426950408889634f * v0[e])); v1[e] = __builtin_amdgcn_rcpf(1.0f + __builtin_amdgcn_exp2f(-1.4426950408889634f * v1[e])); } }
                    u32x4 w; w.x = cvt_pk_bf16(v0[0], v0[1]); w.y = cvt_pk_bf16(v0[2], v0[3]); w.z = cvt_pk_bf16(v1[0], v1[1]); w.w = cvt_pk_bf16(v1[2], v1[3]);
                    *(u32x4*)(rowp + bj * HALF) = w; } }
        if ((u.pn == 4 || u.pn == 5) && u.pm < 32) {
            float* base = (u.pn == 4) ? ck : cv;
#pragma unroll
            for (int ai = 0; ai < 2; ++ai)
#pragma unroll
                for (int m = 0; m < 4; ++m) { const int row = row0 + ai * HALF + m * 16; const int b = row >> 8, s = row & 255;
                    float* p = base + ((size_t)((b * 2 + layer) * 256 + s)) * 256 + (wc * 32 + 8 * fq);
#pragma unroll
                    for (int bj = 0; bj < 2; ++bj) { *(f32x4*)(p + bj * HALF) = acc[ai][bj][m][0]; *(f32x4*)(p + bj * HALF + 4) = acc[ai][bj][m][1]; } }
        }
    }
};
typedef unsigned u32x2v_ __attribute__((ext_vector_type(2)));
struct EpiV {
    static constexpr bool PERM = false, AFTER_DRAIN = false;
    const float* xp; const float* xs; bf16_t* V; const float* gate;
    float* slab; unsigned* flags;
    __device__ __forceinline__ void operator()(f32x4 (&acc)[2][2][4][2], const Unit& u, int wr, int wc, int fr_in, int fq_in) const {
        int fr = fr_in, fq = fq_in; asm volatile("" : "+v"(fr), "+v"(fq));
        const int lane = fq * 16 + fr, tid = (wr * 4 + wc) * 64 + lane;
        float* sp = slab + (size_t)u.pair * 65536 + tid * 4; unsigned* fl = flags + 64 * u.pair;
        if (u.role == 1) {
            { float* q = sp;
#pragma unroll
              for (int ai = 0; ai < 2; ++ai)
#pragma unroll
                for (int m = 0; m < 4; ++m)
#pragma unroll
                    for (int bj = 0; bj < 2; ++bj)
#pragma unroll
                        for (int n = 0; n < 2; ++n) {
                            asm volatile("global_store_dwordx4 %0, %1, off sc1\n\ts_nop 1" :: "v"(q), "v"(acc[ai][bj][m][n]) : "memory");
                            q += 2048; asm volatile("" : "+v"(q)); } }
            asm volatile("s_waitcnt vmcnt(0)" ::: "memory");
            if (lane == 0) __hip_atomic_fetch_add(fl, 1u, __ATOMIC_RELAXED, __HIP_MEMORY_SCOPE_AGENT);
            return;
        }
        const bool red = (u.role == 2);
        if (red) {
            unsigned sp_ = 0;
            while ((unsigned)__builtin_amdgcn_readfirstlane(__hip_atomic_load(fl, __ATOMIC_RELAXED, __HIP_MEMORY_SCOPE_AGENT)) < 8u) { __builtin_amdgcn_s_sleep(2); if (++sp_ > (1u << 20)) break; }
            asm volatile("" ::: "memory");
        }
        const int row0 = u.pm * BM + wr * 64 + fr; const int col0 = u.pn * BM + wc * 32 + 4 * fq;
        const int cond = (u.pm < 32) ? 0 : 1 + ((u.pm - 32) >> 3);
        const float* g = gate + cond * 6144 + col0;
        f32x4 gv[2][2];
#pragma unroll
        for (int bj = 0; bj < 2; ++bj)
#pragma unroll
            for (int n = 0; n < 2; ++n) gv[bj][n] = *(const f32x4*)(g + bj * HALF + n * 16);
        if (!red) {
            f32x4 xq[2][4];
            { const int row = row0; const float* xr = ((row < NCTX) ? xp + (size_t)row * D_MODEL : xs + (size_t)(row - NCTX) * D_MODEL) + col0;
#pragma unroll
              for (int e = 0; e < 4; ++e) xq[0][e] = *(const f32x4*)(xr + (e >> 1) * HALF + (e & 1) * 16); }
#pragma unroll
            for (int g8 = 0; g8 < 8; ++g8) { const int ai = g8 >> 2, m = g8 & 3; const int row = row0 + ai * HALF + m * 16;
                if (g8 + 1 < 8) { const int rown = row0 + ((g8 + 1) >> 2) * HALF + ((g8 + 1) & 3) * 16;
                    const float* xr = ((rown < NCTX) ? xp + (size_t)rown * D_MODEL : xs + (size_t)(rown - NCTX) * D_MODEL) + col0;
#pragma unroll
                    for (int e = 0; e < 4; ++e) xq[(g8 + 1) & 1][e] = *(const f32x4*)(xr + (e >> 1) * HALF + (e & 1) * 16); }
                bf16_t* vr = V + (size_t)row * D_MODEL + col0;
#pragma unroll
                for (int e = 0; e < 4; ++e) { const f32x4 o = xq[g8 & 1][e] * ALPHA_DN + gv[e >> 1][e & 1] * acc[ai][e >> 1][m][e & 1];
                    u32x2v_ w; w.x = cvt_pk_bf16(o[0], o[1]); w.y = cvt_pk_bf16(o[2], o[3]); *(u32x2v_*)(vr + (e >> 1) * HALF + (e & 1) * 16) = w; }
                asm volatile("" ::: "memory"); }
        } else {
            const float* rq = sp;
#pragma unroll
            for (int ai = 0; ai < 2; ++ai)
#pragma unroll
                for (int m = 0; m < 4; ++m) { const int row = row0 + ai * HALF + m * 16;
                    const float* xr = ((row < NCTX) ? xp + (size_t)row * D_MODEL : xs + (size_t)(row - NCTX) * D_MODEL) + col0;
                    bf16_t* vr = V + (size_t)row * D_MODEL + col0;
                    f32x4 t[2][2];
#pragma unroll
                    for (int bj = 0; bj < 2; ++bj)
#pragma unroll
                        for (int n = 0; n < 2; ++n) { const unsigned long long* q8 = (const unsigned long long*)rq;
                            const unsigned long long a8 = __hip_atomic_load(q8, __ATOMIC_RELAXED, __HIP_MEMORY_SCOPE_AGENT), b8 = __hip_atomic_load(q8 + 1, __ATOMIC_RELAXED, __HIP_MEMORY_SCOPE_AGENT);
                            t[bj][n] = (f32x4){__builtin_bit_cast(float, (unsigned)a8), __builtin_bit_cast(float, (unsigned)(a8 >> 32)), __builtin_bit_cast(float, (unsigned)b8), __builtin_bit_cast(float, (unsigned)(b8 >> 32))};
                            rq += 2048; asm volatile("" : "+v"(rq)); }
#pragma unroll
                    for (int bj = 0; bj < 2; ++bj)
#pragma unroll
                        for (int n = 0; n < 2; ++n) { const f32x4 xv = *(const f32x4*)(xr + bj * HALF + n * 16); const f32x4 o = xv * ALPHA_DN + gv[bj][n] * (acc[ai][bj][m][n] + t[bj][n]);
                            u32x2v_ w; w.x = cvt_pk_bf16(o[0], o[1]); w.y = cvt_pk_bf16(o[2], o[3]); *(u32x2v_*)(vr + bj * HALF + n * 16) = w; }
                    asm volatile("" ::: "memory"); }
        }
    }
};
template <class Epi, class Sched, bool ALIGN_EPI = false, bool SP2 = false>
__device__ __forceinline__ void gemm_phase(PG8_LAS unsigned char* lds, const Gemm g, const Sched& S, const Epi& E, int tid_in) {
    int tid_l = tid_in; asm volatile("" : "+v"(tid_l));
    const int tid = tid_l, wid = __builtin_amdgcn_readfirstlane(tid >> 6), lane = tid & 63, wr = wid >> 2, wc = wid & 3, fr = lane & 15, fq = lane >> 4;
    const int K = g.K;
    unsigned voffA[2], voffB[2];
#pragma unroll
    for (int i = 0; i < 2; ++i) { int R, C; stage_rc(tid * 16 + i * 8192, R, C); const int Rb = Epi::PERM ? ((R & ~31) + perm32(R & 31)) : R;
        voffA[i] = (unsigned)(R * K + C) * 2u; voffB[i] = (unsigned)(Rb * K + C) * 2u; }
    const size_t kstep = (size_t)(BK * 2);
    const size_t hstep = (size_t)HALF * K * 2;
    const size_t tstep = 2 * hstep;
    const unsigned ldsw = (unsigned)wid * 1024u;
    const int aoff = lds_byte(wr * 64 + fr, fq * 8), boff = lds_byte(wc * 32 + fr, fq * 8);
#define PG8_SA(b, h) (((b) * 2 + (h)) * HTB)
#define PG8_SB(b, h) ((4 + (b) * 2 + (h)) * HTB)
#define PG8_STAGE(bufoff, gbase, voff) do { _Pragma("unroll") for (int _i = 0; _i < 2; ++_i) \
        __builtin_amdgcn_global_load_lds((const unsigned*)((const char*)(gbase) + (voff)[_i]), (PG8_LAS unsigned*)(lds + (bufoff) + ldsw + _i * 8192), 16, 0, 0); } while (0)
#define PG8_LDA(dst, b, h) do { _Pragma("unroll") for (int m = 0; m < 4; ++m) _Pragma("unroll") for (int k = 0; k < 2; ++k) dst[m][k] = *(const PG8_LAS bf16x8*)(lds + PG8_SA(b, h) + aoff + m * 2048 + k * 1024); } while (0)
#define PG8_LDB(dst, b, h) do { _Pragma("unroll") for (int n = 0; n < 2; ++n) _Pragma("unroll") for (int k = 0; k < 2; ++k) dst[n][k] = *(const PG8_LAS bf16x8*)(lds + PG8_SB(b, h) + boff + n * 2048 + k * 1024); } while (0)
#define PG8_MMA(ai, bj, At, Bt) do { __builtin_amdgcn_s_setprio(1); _Pragma("unroll") for (int m = 0; m < 4; ++m) _Pragma("unroll") for (int n = 0; n < 2; ++n) _Pragma("unroll") for (int k = 0; k < 2; ++k) \
        acc[ai][bj][m][n] = __builtin_amdgcn_mfma_f32_16x16x32_bf16(Bt[n][k], At[m][k], acc[ai][bj][m][n], 0, 0, 0); __builtin_amdgcn_s_setprio(0); } while (0)
#define PG8_WAIT_V(n) asm volatile("s_waitcnt vmcnt(" #n ")" ::: "memory")
#define PG8_WAIT_L(n) asm volatile("s_waitcnt lgkmcnt(" #n ")" ::: "memory")
#define PG8_BAR __builtin_amdgcn_s_barrier()
#define PG8_SCHED __builtin_amdgcn_sched_barrier(0)
    Unit cur, nxt; int ui = 0;
    if (!S.next(0, cur)) return;
    f32x4 acc[2][2][4][2];
#pragma unroll
    for (int a = 0; a < 2; ++a)
#pragma unroll
        for (int b = 0; b < 2; ++b)
#pragma unroll
            for (int m = 0; m < 4; ++m)
#pragma unroll
                for (int n = 0; n < 2; ++n) acc[a][b][m][n] = (f32x4){0.f, 0.f, 0.f, 0.f};
    bf16x8 At[4][2], B0[2][2], B1[2][2];
    const char* cA = (const char*)g.A + (size_t)cur.pm * tstep + (size_t)cur.k0 * kstep; const char* cB = (const char*)g.Bt + (size_t)cur.pn * tstep + (size_t)cur.k0 * kstep;
    S.a_ready(cur);
    if constexpr (SP2) {
        PG8_STAGE(PG8_SB(0, 0), cB, voffB); PG8_STAGE(PG8_SB(0, 1), cB + hstep, voffB); PG8_STAGE(PG8_SA(0, 0), cA, voffA); PG8_STAGE(PG8_SA(0, 1), cA + hstep, voffA);
        if (wr == 1) PG8_BAR;
        PG8_WAIT_V(2); PG8_BAR;
        PG8_STAGE(PG8_SB(1, 0), cB + kstep, voffB); PG8_STAGE(PG8_SA(1, 0), cA + kstep, voffA); PG8_STAGE(PG8_SB(1, 1), cB + hstep + kstep, voffB);
        PG8_WAIT_V(6); PG8_BAR;
    } else {
        PG8_STAGE(PG8_SB(0, 0), cB, voffB); PG8_STAGE(PG8_SA(0, 0), cA, voffA); PG8_STAGE(PG8_SB(0, 1), cB + hstep, voffB); PG8_STAGE(PG8_SA(0, 1), cA + hstep, voffA);
        if (wr == 1) PG8_BAR;
        PG8_WAIT_V(4); PG8_BAR;
        PG8_STAGE(PG8_SB(1, 0), cB + kstep, voffB); PG8_STAGE(PG8_SA(1, 0), cA + kstep, voffA); PG8_STAGE(PG8_SB(1, 1), cB + hstep + kstep, voffB);
        PG8_WAIT_V(6); PG8_BAR;
    }
    for (;;) {
        const bool has_next = S.next(ui + 1, nxt);
        const char* nA = has_next ? (const char*)g.A + (size_t)nxt.pm * tstep + (size_t)nxt.k0 * kstep : cA; const char* nB = has_next ? (const char*)g.Bt + (size_t)nxt.pn * tstep + (size_t)nxt.k0 * kstep : cB;
        const int nt = cur.nk;
        for (int t = 0; t < nt; t += 2) {
            const bool last = (t == nt - 2);
            const char* a1 = cA + (size_t)(t + 1) * kstep;
            const char* a2 = last ? nA : cA + (size_t)(t + 2) * kstep; const char* b2 = last ? nB : cB + (size_t)(t + 2) * kstep;
            const char* a3 = a2 + kstep; const char* b3 = b2 + kstep;
            if (last && has_next) S.a_ready(nxt);
            if constexpr (SP2) {
            PG8_LDB(B0, 0, 0); PG8_LDB(B1, 0, 1); PG8_SCHED; PG8_LDA(At, 0, 0); PG8_STAGE(PG8_SA(1, 1), a1 + hstep, voffA);
            PG8_WAIT_V(8); PG8_WAIT_L(0); PG8_BAR; PG8_MMA(0, 0, At, B0); PG8_MMA(0, 1, At, B1); PG8_BAR; PG8_SCHED;
            PG8_LDA(At, 0, 1); PG8_STAGE(PG8_SB(0, 0), b2, voffB); PG8_STAGE(PG8_SB(0, 1), b2 + hstep, voffB); PG8_STAGE(PG8_SA(0, 0), a2, voffA);
            PG8_WAIT_V(8); PG8_WAIT_L(0); PG8_BAR; PG8_MMA(1, 0, At, B0); PG8_MMA(1, 1, At, B1); PG8_BAR; PG8_SCHED;
            PG8_LDB(B0, 1, 0); PG8_LDB(B1, 1, 1); PG8_SCHED; PG8_LDA(At, 1, 0); PG8_STAGE(PG8_SA(0, 1), a2 + hstep, voffA);
            PG8_WAIT_V(8); PG8_WAIT_L(0); PG8_BAR; PG8_MMA(0, 0, At, B0); PG8_MMA(0, 1, At, B1); PG8_BAR; PG8_SCHED;
            PG8_LDA(At, 1, 1); PG8_STAGE(PG8_SB(1, 0), b3, voffB); PG8_STAGE(PG8_SB(1, 1), b3 + hstep, voffB); PG8_STAGE(PG8_SA(1, 0), a3, voffA);
            PG8_WAIT_V(8); PG8_WAIT_L(0); PG8_BAR; PG8_MMA(1, 0, At, B0); PG8_MMA(1, 1, At, B1); PG8_BAR; PG8_SCHED;
            } else {
            PG8_LDB(B0, 0, 0); PG8_SCHED; PG8_LDA(At, 0, 0); PG8_STAGE(PG8_SA(1, 1), a1 + hstep, voffA);
            PG8_WAIT_L(8); PG8_BAR; PG8_WAIT_L(0); PG8_MMA(0, 0, At, B0); PG8_BAR; PG8_SCHED;
            PG8_LDB(B1, 0, 1); PG8_STAGE(PG8_SB(0, 0), b2, voffB);
            PG8_BAR; PG8_WAIT_L(0); PG8_MMA(0, 1, At, B1); PG8_BAR;
            PG8_LDA(At, 0, 1); PG8_STAGE(PG8_SA(0, 0), a2, voffA);
            PG8_BAR; PG8_WAIT_L(0); PG8_MMA(1, 0, At, B0); PG8_BAR; PG8_SCHED;
            PG8_STAGE(PG8_SB(0, 1), b2 + hstep, voffB);
            PG8_WAIT_V(6); PG8_BAR; PG8_MMA(1, 1, At, B1); PG8_BAR;
            PG8_LDB(B0, 1, 0); PG8_SCHED; PG8_LDA(At, 1, 0); PG8_STAGE(PG8_SA(0, 1), a2 + hstep, voffA);
            PG8_WAIT_L(8); PG8_BAR; PG8_WAIT_L(0); PG8_MMA(0, 0, At, B0); PG8_BAR; PG8_SCHED;
            PG8_LDB(B1, 1, 1); PG8_STAGE(PG8_SB(1, 0), b3, voffB);
            PG8_BAR; PG8_WAIT_L(0); PG8_MMA(0, 1, At, B1); PG8_BAR;
            PG8_LDA(At, 1, 1); PG8_STAGE(PG8_SA(1, 0), a3, voffA);
            PG8_BAR; PG8_WAIT_L(0); PG8_MMA(1, 0, At, B0); PG8_BAR; PG8_SCHED;
            PG8_STAGE(PG8_SB(1, 1), b3 + hstep, voffB);
            PG8_WAIT_V(6); PG8_BAR; PG8_MMA(1, 1, At, B1); PG8_BAR;
            }
        }
        if constexpr (ALIGN_EPI) { if (wr == 0) PG8_BAR; }
        if constexpr (!Epi::AFTER_DRAIN) { E(acc, cur, wr, wc, fr, fq); S.done(cur); }
        if (!has_next) break;
#pragma unroll
        for (int a = 0; a < 2; ++a)
#pragma unroll
            for (int b = 0; b < 2; ++b)
#pragma unroll
                for (int m = 0; m < 4; ++m)
#pragma unroll
                    for (int n = 0; n < 2; ++n) acc[a][b][m][n] = (f32x4){0.f, 0.f, 0.f, 0.f};
        cur = nxt; cA = nA; cB = nB; ++ui;
        if constexpr (ALIGN_EPI) { if (wr == 1) PG8_BAR; }
    }
    PG8_WAIT_V(0);
    if constexpr (!ALIGN_EPI) { if (wr == 0) PG8_BAR; }
    PG8_BAR;
    if constexpr (Epi::AFTER_DRAIN) { E.fused(acc, cur, wr, wc, fr, fq, lds, wid, lane); S.done(cur); }
#undef PG8_SA
#undef PG8_SB
#undef PG8_STAGE
#undef PG8_LDA
#undef PG8_LDB
#undef PG8_MMA
#undef PG8_WAIT_V
#undef PG8_WAIT_L
#undef PG8_BAR
#undef PG8_SCHED
}
}

constexpr size_t MiB = 1u << 20;
constexpr size_t WS_CTL = 0, CTL_ZERO_BYTES = 262144;
constexpr size_t WS_MOD = 1 * MiB;
constexpr size_t WS_CS = 1 * MiB + 192 * 1024;
constexpr size_t WS_DLOG = 1 * MiB + 256 * 1024;
constexpr size_t WS_WTOUT = 2 * MiB;
constexpr size_t WS_WTIN = 18 * MiB;
constexpr size_t WS_H = 44 * MiB;
constexpr size_t WS_Z = 92 * MiB;
constexpr size_t WS_U = 248 * MiB;
constexpr size_t WS_OL = 264 * MiB;
constexpr size_t WS_CKV = 312 * MiB;
constexpr size_t WS_END = 313 * MiB;
constexpr int LDS_BYTES = 163840;
constexpr int LDS_CTLW = 163840 - 256;
constexpr int NWAVES = 8, NTHREADS = 512;

#define LAS __attribute__((address_space(3)))
typedef unsigned short bf16;
typedef float f32x4 __attribute__((ext_vector_type(4)));
typedef float f32x16 __attribute__((ext_vector_type(16)));
typedef unsigned u32x4 __attribute__((ext_vector_type(4)));
typedef unsigned u32x2 __attribute__((ext_vector_type(2)));
typedef short bf16x8 __attribute__((ext_vector_type(8)));

__device__ __forceinline__ float bf2f(unsigned short u) { return __builtin_bit_cast(float, (unsigned)u << 16); }
__device__ __forceinline__ float bflo(unsigned u) { return __builtin_bit_cast(float, u << 16); }
__device__ __forceinline__ float bfhi(unsigned u) { return __builtin_bit_cast(float, u & 0xffff0000u); }
typedef float f32x2_t_ __attribute__((ext_vector_type(2))); typedef __bf16 bf16x2_t_ __attribute__((ext_vector_type(2)));
__device__ __forceinline__ unsigned pk2(float lo, float hi) { const f32x2_t_ v = {lo, hi}; return __builtin_bit_cast(unsigned, __builtin_convertvector(v, bf16x2_t_)); }
__device__ __forceinline__ unsigned f2bf(float f) { return pk2(f, f) & 0xffffu; }
__device__ __forceinline__ float sigmoidf_(float x) { return __builtin_amdgcn_rcpf(1.0f + __builtin_amdgcn_exp2f(-1.4426950408889634f * x)); }
__device__ __forceinline__ float siluf_(float x) { return x * __builtin_amdgcn_rcpf(1.0f + __builtin_amdgcn_exp2f(-1.4426950408889634f * x)); }
__device__ __forceinline__ float dpp_add_(float v, const int ctrl_sel) {
    const int x = __builtin_bit_cast(int, v); int y;
    if (ctrl_sel == 0) y = __builtin_amdgcn_update_dpp(0, x, 0xB1, 0xf, 0xf, true);
    else if (ctrl_sel == 1) y = __builtin_amdgcn_update_dpp(0, x, 0x4E, 0xf, 0xf, true);
    else if (ctrl_sel == 2) y = __builtin_amdgcn_update_dpp(0, x, 0x141, 0xf, 0xf, true);
    else y = __builtin_amdgcn_update_dpp(0, x, 0x140, 0xf, 0xf, true);
    return v + __builtin_bit_cast(float, y);
}
__device__ __forceinline__ float wave_sum(float v) {
    v = dpp_add_(v, 0); v = dpp_add_(v, 1); v = dpp_add_(v, 2); v = dpp_add_(v, 3);
    const float r0 = __builtin_bit_cast(float, __builtin_amdgcn_readlane(__builtin_bit_cast(int, v), 0)), r1 = __builtin_bit_cast(float, __builtin_amdgcn_readlane(__builtin_bit_cast(int, v), 16));
    const float r2 = __builtin_bit_cast(float, __builtin_amdgcn_readlane(__builtin_bit_cast(int, v), 32)), r3 = __builtin_bit_cast(float, __builtin_amdgcn_readlane(__builtin_bit_cast(int, v), 48));
    return (r0 + r1) + (r2 + r3);
}

struct Params {
    const float* in[20];
    float* out; unsigned char* ws;
};
typedef const __attribute__((address_space(4))) Params* PP;

__device__ __forceinline__ int next_unit(unsigned* ctr, volatile LAS unsigned* slot, int tid) {
    __syncthreads();
    if (tid == 0) *slot = __hip_atomic_fetch_add(ctr, 1u, __ATOMIC_RELAXED, __HIP_MEMORY_SCOPE_AGENT);
    __syncthreads();
    return (int)*slot;
}
__device__ __forceinline__ int q_pop(unsigned* ctr, volatile LAS unsigned* slot, int tid, int& pend, int pf_from) {
    __syncthreads();
    if (tid == 0) { const int cur = (pend >= 0) ? pend : (int)__hip_atomic_fetch_add(ctr, 1u, __ATOMIC_RELAXED, __HIP_MEMORY_SCOPE_AGENT);
        *slot = (unsigned)cur; pend = (cur >= pf_from) ? (int)__hip_atomic_fetch_add(ctr, 1u, __ATOMIC_RELAXED, __HIP_MEMORY_SCOPE_AGENT) : -1; }
    __syncthreads();
    return (int)*slot;
}
__device__ __forceinline__ void transpose_item(const float* W, int K, int N, bf16* WT, LAS float* scr, int item, int lane) {
    const int nblk = N / 32, kb = item / nblk, nb = item % nblk, k0 = 64 * kb, n0 = 32 * nb;
    float wv[32];
    const float* wp = W + (size_t)(k0 + (lane >> 5)) * N + n0 + (lane & 31);
#pragma unroll
    for (int i = 0; i < 32; ++i) wv[i] = wp[(size_t)(2 * i) * N];
    __builtin_amdgcn_sched_barrier(0);
#pragma unroll
    for (int i = 0; i < 32; ++i) { const int kk = 2 * i + (lane >> 5); scr[kk * 33 + (lane & 31)] = wv[i]; }
    asm volatile("s_waitcnt lgkmcnt(0)" ::: "memory");
    const int c = lane & 7;
#pragma unroll
    for (int j = 0; j < 4; ++j) { const int n = (lane >> 3) + 8 * j; const LAS float* s = scr + (8 * c) * 33 + n;
        u32x4 o; o.x = pk2(s[0 * 33], s[1 * 33]); o.y = pk2(s[2 * 33], s[3 * 33]); o.z = pk2(s[4 * 33], s[5 * 33]); o.w = pk2(s[6 * 33], s[7 * 33]);
        *(u32x4*)(WT + (size_t)(n0 + n) * K + k0 + 8 * c) = o; }
    asm volatile("s_waitcnt lgkmcnt(0)" ::: "memory");
}

__device__ __forceinline__ void mod_unit(PP P, LAS float* lds, int l, int nc, int tid) {
    const float* c = P->in[5]; const float* cctx = P->in[6]; const float* aw = P->in[7] + (size_t)l * 2048 * 6144; const float* ab = P->in[8] + l * 6144;
    LAS float* sc = lds;
    LAS float* red = lds + 3 * 2048;
    for (int i = tid; i < 3 * 2048; i += NTHREADS) { const int j = i >> 11, k = i & 2047; const float v = (j == 0) ? cctx[k] : c[(j - 1) * 2048 + k]; sc[i] = siluf_(v); }
    __syncthreads();
    const int tn = tid & 7, tk = tid >> 3, n0 = nc * 32 + 4 * tn;
    float a[3][4] = {};
    for (int k8 = 0; k8 < 32; k8 += 16) {
        f32x4 w[16];
#pragma unroll
        for (int kk = 0; kk < 16; ++kk) w[kk] = *(const f32x4*)(aw + (size_t)(tk * 32 + k8 + kk) * 6144 + n0);
        __builtin_amdgcn_sched_barrier(0);
#pragma unroll
        for (int kk = 0; kk < 16; ++kk) { const int k = tk * 32 + k8 + kk;
#pragma unroll
            for (int j = 0; j < 3; ++j) { const float s = sc[j * 2048 + k]; a[j][0] += s * w[kk][0]; a[j][1] += s * w[kk][1]; a[j][2] += s * w[kk][2]; a[j][3] += s * w[kk][3]; } }
    }
#pragma unroll
    for (int j = 0; j < 3; ++j)
#pragma unroll
        for (int e = 0; e < 4; ++e) red[(tk * 8 + tn) * 12 + j * 4 + e] = a[j][e];
    __syncthreads();
    if (tid < 96) { const int tn2 = tid / 12, je = tid % 12; float s = 0.f; for (int t = 0; t < 64; ++t) s += red[(t * 8 + tn2) * 12 + je];
        const int j = je >> 2, e = je & 3, n = nc * 32 + 4 * tn2 + e;
        ((float*)(P->ws + WS_MOD))[(l * 3 + j) * 6144 + n] = s + ab[n]; }
    __syncthreads();
}

__device__ __forceinline__ void hprep_row(const float* xrow, const float* mod  , bf16* hrow, int lane) {
#pragma unroll
    for (int j = 0; j < 8; ++j) { const int c = 4 * lane + 256 * j; const f32x4 x = *(const f32x4*)(xrow + c), sh = *(const f32x4*)(mod + c), sc = *(const f32x4*)(mod + 2048 + c);
        const f32x4 h = x * (sc + 1.0f) + sh; u32x2 o; o.x = pk2(h[0], h[1]); o.y = pk2(h[2], h[3]); *(u32x2*)(hrow + c) = o; }
}
template <bool WITH_H>
__device__ __forceinline__ void ln_row_t(const bf16* vsrc, float* yrow, const float* w, const float* b, const float* modn, bf16* hrow, int lane_in) {
    int lane = lane_in; asm volatile("" : "+v"(lane));
    f32x4 v[8], pw[8], pb[8]; float s = 0.f;
#pragma unroll
    for (int j = 0; j < 8; ++j) { const u32x2 r = *(const u32x2*)(vsrc + 4 * lane + 256 * j); v[j] = (f32x4){bflo(r.x), bfhi(r.x), bflo(r.y), bfhi(r.y)}; }
#pragma unroll
    for (int j = 0; j < 8; ++j) { pw[j] = *(const f32x4*)(w + 4 * lane + 256 * j); pb[j] = *(const f32x4*)(b + 4 * lane + 256 * j); }
#pragma unroll
    for (int j = 0; j < 8; ++j) s += (v[j][0] + v[j][1]) + (v[j][2] + v[j][3]);
    const float mean = wave_sum(s) * (1.0f / 2048.0f); float q = 0.f;
#pragma unroll
    for (int j = 0; j < 8; ++j) { v[j] = v[j] - mean; q += (v[j][0] * v[j][0] + v[j][1] * v[j][1]) + (v[j][2] * v[j][2] + v[j][3] * v[j][3]); }
    const float rstd = __builtin_amdgcn_rsqf(wave_sum(q) * (1.0f / 2048.0f) + 1e-5f);
#pragma unroll
    for (int j = 0; j < 8; ++j) { v[j] = v[j] * rstd * pw[j] + pb[j]; *(f32x4*)(yrow + 4 * lane + 256 * j) = v[j]; }
    if (WITH_H) {
#pragma unroll
        for (int j = 0; j < 8; ++j) { pw[j] = *(const f32x4*)(modn + 4 * lane + 256 * j); pb[j] = *(const f32x4*)(modn + 2048 + 4 * lane + 256 * j); }
#pragma unroll
        for (int j = 0; j < 8; ++j) { const f32x4 h = v[j] * (pb[j] + 1.0f) + pw[j]; u32x2 o; o.x = pk2(h[0], h[1]); o.y = pk2(h[2], h[3]); *(u32x2*)(hrow + 4 * lane + 256 * j) = o; }
    }
}
__device__ __forceinline__ void ln_row(const bf16* vsrc, float* yrow, const float* w, const float* b, const float* modn, bf16* hrow, int lane) {
    if (hrow) ln_row_t<true>(vsrc, yrow, w, b, modn, hrow, lane); else ln_row_t<false>(vsrc, yrow, w, b, modn, hrow, lane);
}

typedef float f32x2 __attribute__((ext_vector_type(2)));
__device__ __forceinline__ void conv_unit(PP P, LAS float* lds, int l, int unit, int tid) {
    const int lane = tid & 63, wave = tid >> 6;
    const bf16* Z = (const bf16*)(P->ws + WS_Z); bf16* MIX = (bf16*)(P->ws + WS_H);
    const int t0 = unit * 32;
    int s0, s1; if (t0 < NCTX) { s0 = t0 & ~255; s1 = s0 + 256; } else { s0 = NCTX + ((t0 - NCTX) & ~2047); s1 = s0 + 2048; }
    const int tgs = __builtin_amdgcn_readfirstlane(tid >> 8);
    const int c2 = 2 * (tid & 255), tb = t0 + 16 * tgs;
    u32x4 gq[4];
#pragma unroll
    for (int k = 0; k < 4; ++k) gq[k] = *(const u32x4*)(Z + (size_t)(t0 + 4 * wave + k) * DIN + C_CG + 8 * lane);
    const float* lw = P->in[16] + l * 512 + 8 * lane; const float* lb = P->in[17] + l * 512 + 8 * lane;
    const f32x4 w0 = *(const f32x4*)lw, w1 = *(const f32x4*)(lw + 4), b0 = *(const f32x4*)lb, b1 = *(const f32x4*)(lb + 4);
    f32x2 u[46];
#pragma unroll
    for (int hb = 0; hb < 2; ++hb) {
        unsigned ra[23], rb[23];
#pragma unroll
        for (int r = 0; r < 23; ++r) { const int row = tb - 15 + 23 * hb + r; const int rc = row < s0 ? s0 : (row >= s1 ? s1 - 1 : row);
            const unsigned off = (unsigned)rc * (unsigned)(DIN * 2) + (unsigned)((C_CA + c2) * 2);
            ra[r] = *(const unsigned*)((const char*)Z + off); rb[r] = *(const unsigned*)((const char*)Z + off + (C_CB - C_CA) * 2); }
        __builtin_amdgcn_sched_barrier(0);
#pragma unroll
        for (int r = 0; r < 23; ++r) { const int row = tb - 15 + 23 * hb + r; const bool ok = (row >= s0 && row < s1);
            const f32x2 a = {bflo(ra[r]), bfhi(ra[r])}; const f32x2 g = {bflo(rb[r]), bfhi(rb[r])};
            const f32x2 v = a * g; u[23 * hb + r] = ok ? v : (f32x2){0.f, 0.f}; }
    }
    f32x2 acc[16]; const f32x2 bias = *(const f32x2*)(P->in[15] + l * 512 + c2);
#pragma unroll
    for (int i = 0; i < 16; ++i) acc[i] = bias;
    const float* cw = P->in[14] + (size_t)l * 31 * 512 + c2;
#pragma unroll
    for (int j = 0; j < 31; ++j) { const f32x2 w = *(const f32x2*)(cw + j * 512);
#pragma unroll
        for (int i = 0; i < 16; ++i) acc[i] += u[i + j] * w; }
    LAS float* yb = lds;
#pragma unroll
    for (int i = 0; i < 16; ++i) *(LAS f32x2*)(yb + (16 * tgs + i) * 512 + c2) = acc[i];
    __syncthreads();
#pragma unroll
    for (int k = 0; k < 4; ++k) { const int ti = wave * 4 + k, row = t0 + ti;
        f32x4 a = *(const LAS f32x4*)(yb + ti * 512 + 8 * lane), b = *(const LAS f32x4*)(yb + ti * 512 + 8 * lane + 4);
        float s = (a[0] + a[1]) + (a[2] + a[3]) + (b[0] + b[1]) + (b[2] + b[3]);
        const float mean = wave_sum(s) * (1.0f / 512.0f); a = a - mean; b = b - mean;
        float q = (a[0] * a[0] + a[1] * a[1]) + (a[2] * a[2] + a[3] * a[3]) + (b[0] * b[0] + b[1] * b[1]) + (b[2] * b[2] + b[3] * b[3]);
        const float rstd = __builtin_amdgcn_rsqf(wave_sum(q) * (1.0f / 512.0f) + 1e-5f);
        a = a * rstd * w0 + b0; b = b * rstd * w1 + b1;
        const u32x4 g = gq[k];
        float o[8];
        o[0] = siluf_(a[0]) * siluf_(bflo(g.x)); o[1] = siluf_(a[1]) * siluf_(bfhi(g.x)); o[2] = siluf_(a[2]) * siluf_(bflo(g.y)); o[3] = siluf_(a[3]) * siluf_(bfhi(g.y));
        o[4] = siluf_(b[0]) * siluf_(bflo(g.z)); o[5] = siluf_(b[1]) * siluf_(bfhi(g.z)); o[6] = siluf_(b[2]) * siluf_(bflo(g.w)); o[7] = siluf_(b[3]) * siluf_(bfhi(g.w));
        u32x4 w; w.x = pk2(o[0], o[1]); w.y = pk2(o[2], o[3]); w.z = pk2(o[4], o[5]); w.w = pk2(o[6], o[7]);
        *(u32x4*)(MIX + (size_t)row * D_MODEL + 1536 + 8 * lane) = w; }
}

typedef short v4i16_t __attribute__((ext_vector_type(4)));
#define SBAR __builtin_amdgcn_sched_barrier(0);
#define R0(i) (((i) & 3) + 8 * ((i) >> 2))
constexpr float ATT_C2 = 0.08838834764831845f * 1.4426950408889634f;
constexpr float LOG2E = 1.4426950408889634f;
constexpr int KROW = 272, VROW = 320, ATT_V_OFF = 64 * KROW;

__device__ __forceinline__ bf16x8 trpair(const LAS unsigned char* p, int second_off) {
    const v4i16_t lo = __builtin_amdgcn_ds_read_tr16_b64_v4i16((LAS v4i16_t*)p), hi = __builtin_amdgcn_ds_read_tr16_b64_v4i16((LAS v4i16_t*)(p + second_off));
    return (bf16x8){lo[0], lo[1], lo[2], lo[3], hi[0], hi[1], hi[2], hi[3]};
}
__device__ __forceinline__ bf16x8 pack8(float a, float b, float c, float d, float e, float f, float g, float h) {
    const u32x4 w = {pk2(a, b), pk2(c, d), pk2(e, f), pk2(g, h)}; return __builtin_bit_cast(bf16x8, w);
}
__device__ __forceinline__ void rope8(bf16x8& a, bf16x8& b, const float* cs) {
    float ra[8], rb[8];
#pragma unroll
    for (int j = 0; j < 8; ++j) { const float x1 = bf2f((unsigned short)a[j]), x2 = bf2f((unsigned short)b[j]), c = cs[2 * j], s = cs[2 * j + 1]; ra[j] = x1 * c - x2 * s; rb[j] = x2 * c + x1 * s; }
    a = pack8(ra[0], ra[1], ra[2], ra[3], ra[4], ra[5], ra[6], ra[7]); b = pack8(rb[0], rb[1], rb[2], rb[3], rb[4], rb[5], rb[6], rb[7]);
}
__device__ __forceinline__ void rope8l(bf16x8& a, bf16x8& b, const LAS float* cs) {
    const f32x4 c0 = *(const LAS f32x4*)cs, c1 = *(const LAS f32x4*)(cs + 4), c2 = *(const LAS f32x4*)(cs + 8), c3 = *(const LAS f32x4*)(cs + 12);
    const float cc[8] = {c0[0], c0[2], c1[0], c1[2], c2[0], c2[2], c3[0], c3[2]}, sn[8] = {c0[1], c0[3], c1[1], c1[3], c2[1], c2[3], c3[1], c3[3]};
    float ra[8], rb[8];
#pragma unroll
    for (int j = 0; j < 8; ++j) { const float x1 = bf2f((unsigned short)a[j]), x2 = bf2f((unsigned short)b[j]); ra[j] = x1 * cc[j] - x2 * sn[j]; rb[j] = x2 * cc[j] + x1 * sn[j]; }
    a = pack8(ra[0], ra[1], ra[2], ra[3], ra[4], ra[5], ra[6], ra[7]); b = pack8(rb[0], rb[1], rb[2], rb[3], rb[4], rb[5], rb[6], rb[7]);
}
__device__ __forceinline__ bf16x8 cvt8(const float* p) {
    const f32x4 a = *(const f32x4*)p, b = *(const f32x4*)(p + 4);
    return pack8(a[0], a[1], a[2], a[3], b[0], b[1], b[2], b[3]);
}

typedef _Float16 f16x8_t_ __attribute__((ext_vector_type(8)));
__device__ __forceinline__ void rope8h(u32x4& a, u32x4& b, const LAS unsigned char* cs) {
    const f16x8_t_ t0 = *(const LAS f16x8_t_*)cs, t1 = *(const LAS f16x8_t_*)(cs + 16);
    float ra[8], rb[8];
#pragma unroll
    for (int j = 0; j < 8; ++j) { const unsigned wa = a[j >> 1], wb = b[j >> 1]; const float x1 = (j & 1) ? bfhi(wa) : bflo(wa), x2 = (j & 1) ? bfhi(wb) : bflo(wb);
        const float c = (float)((j < 4) ? t0[2 * j] : t1[2 * (j - 4)]), sn = (float)((j < 4) ? t0[2 * j + 1] : t1[2 * (j - 4) + 1]);
        ra[j] = x1 * c - x2 * sn; rb[j] = x2 * c + x1 * sn; }
    a = (u32x4){pk2(ra[0], ra[1]), pk2(ra[2], ra[3]), pk2(ra[4], ra[5]), pk2(ra[6], ra[7])}; b = (u32x4){pk2(rb[0], rb[1]), pk2(rb[2], rb[3]), pk2(rb[4], rb[5]), pk2(rb[6], rb[7])};
}
constexpr int AT_BUF = 75776, AT_V = 34816, AT_ROPE = 151552;
__device__ __forceinline__ void attn_tile(const LAS unsigned char* kt, const LAS unsigned char* vt, const bf16x8 (&qf)[8], f32x16 (&O)[4], float& m, float& lsum,
                                          bool local, int tk0, int qpos, int lane) {
    const int r32 = lane & 31, hh = lane >> 5, i16 = lane & 15;
    f32x16 p0, p1;
#pragma unroll
    for (int i = 0; i < 16; ++i) { p0[i] = 0.f; p1[i] = 0.f; }
    const LAS unsigned char* kb = kt + r32 * KROW + 16 * hh;
#pragma unroll
    for (int s = 0; s < 8; ++s) { const bf16x8 kf0 = *(const LAS bf16x8*)(kb + 32 * s), kf1 = *(const LAS bf16x8*)(kb + 32 * KROW + 32 * s);
        p0 = __builtin_amdgcn_mfma_f32_32x32x16_bf16(kf0, qf[s], p0, 0, 0, 0); p1 = __builtin_amdgcn_mfma_f32_32x32x16_bf16(kf1, qf[s], p1, 0, 0, 0); }
    const LAS unsigned char* vb = vt + (4 * hh + (i16 >> 2)) * VROW + (16 * ((lane >> 4) & 1) + 4 * (i16 & 3)) * 2;
    bf16x8 vfa[4], vfb[4];
#pragma unroll
    for (int ks = 0; ks < 4; ++ks) vfa[ks] = trpair(vb + (16 * ks) * VROW, 8 * VROW);
    float mx = -3e38f;
    if (local) { const unsigned mb = (unsigned)(qpos - tk0 - 4 * hh + 128);
#pragma unroll
        for (int i = 0; i < 16; ++i) { const unsigned d0 = mb - (unsigned)R0(i), d1 = d0 - 32u;
            p0[i] = (d0 <= 256u) ? p0[i] : -1e30f; p1[i] = (d1 <= 256u) ? p1[i] : -1e30f; } }
#pragma unroll
    for (int i = 0; i < 16; ++i) mx = fmaxf(mx, fmaxf(p0[i], p1[i]));
    mx = fmaxf(mx, __shfl_xor(mx, 32)) * ATT_C2;
    const float mn = fmaxf(m, mx), alpha = __builtin_amdgcn_exp2f(m - mn); m = mn;
    float ps = 0.f;
#pragma unroll
    for (int i = 0; i < 16; ++i) { p0[i] = __builtin_amdgcn_exp2f(__builtin_fmaf(p0[i], ATT_C2, -mn)); p1[i] = __builtin_amdgcn_exp2f(__builtin_fmaf(p1[i], ATT_C2, -mn)); ps += p0[i] + p1[i]; }
    lsum = lsum * alpha + ps;
    if (__builtin_amdgcn_ballot_w64(alpha != 1.0f) != 0ull) {
#pragma unroll
        for (int d = 0; d < 4; ++d)
#pragma unroll
            for (int i = 0; i < 16; ++i) O[d][i] *= alpha;
    }
    bf16x8 pb[4];
#pragma unroll
    for (int s = 0; s < 2; ++s) { pb[s] = pack8(p0[8 * s], p0[8 * s + 1], p0[8 * s + 2], p0[8 * s + 3], p0[8 * s + 4], p0[8 * s + 5], p0[8 * s + 6], p0[8 * s + 7]);
        pb[2 + s] = pack8(p1[8 * s], p1[8 * s + 1], p1[8 * s + 2], p1[8 * s + 3], p1[8 * s + 4], p1[8 * s + 5], p1[8 * s + 6], p1[8 * s + 7]); }
#pragma unroll
    for (int dt = 0; dt < 4; ++dt) {
        if (dt + 1 < 4) {
#pragma unroll
            for (int ks = 0; ks < 4; ++ks) { const bf16x8 t_ = trpair(vb + (16 * ks) * VROW + 64 * (dt + 1), 8 * VROW); if (dt & 1) vfa[ks] = t_; else vfb[ks] = t_; }
        }
#pragma unroll
        for (int ks = 0; ks < 4; ++ks) O[dt] = __builtin_amdgcn_mfma_f32_32x32x16_bf16((dt & 1) ? vfb[ks] : vfa[ks], pb[ks], O[dt], 0, 0, 0);
    }
}
__device__ __forceinline__ void attn_unit(PP P, LAS unsigned char* lds, int l, int kind, int idx, int tid) {
    const int lane = tid & 63, wave = __builtin_amdgcn_readfirstlane(tid >> 6), r32 = lane & 31, hh = lane >> 5;
    const bf16* Z = (const bf16*)(P->ws + WS_Z); bf16* MIX = (bf16*)(P->ws + WS_H); const float* CS = (const float*)(P->ws + WS_CS); const bf16* CKV = (const bf16*)(P->ws + WS_CKV);
    int b, h, qpos0, grow0, kpos0, klrow0, nls, ncs;
    if (kind == 0) { b = idx >> 3; h = idx & 7; qpos0 = 0; grow0 = b * 256; kpos0 = 0; klrow0 = b * 256; nls = 2; ncs = 0; }
    else { const int qb = idx & 7; h = (idx >> 3) & 7; b = idx >> 6; qpos0 = qb * 256; grow0 = NCTX + b * 2048 + qpos0;
        kpos0 = qpos0 - 128 < 0 ? 0 : qpos0 - 128; const int kend = qpos0 + 384 > 2048 ? 2048 : qpos0 + 384; nls = (kend - kpos0) >> 7; klrow0 = NCTX + b * 2048 + kpos0; ncs = 2; }
    const bool lat = (kind == 1);
    const int kv = h >> 2;
    if (lat) {
#pragma unroll
        for (int k = 0; k < 4; ++k) { const int e = tid + 512 * k; const float c = CS[2 * e], sn = CS[2 * e + 1];
            typedef _Float16 h2_ __attribute__((ext_vector_type(2))); const h2_ hv = {(_Float16)c, (_Float16)sn}; *(LAS unsigned*)(lds + AT_ROPE + 4 * e) = __builtin_bit_cast(unsigned, hv); }
    }
    const int qrow = grow0 + 32 * wave + r32, qpos = qpos0 + 32 * wave + r32, qw0 = qpos0 + 32 * wave;
    bf16x8 qf[8];
    { const bf16* qp = Z + (size_t)qrow * DIN + C_AQ + h * 128 + 8 * hh;
#pragma unroll
      for (int s = 0; s < 8; ++s) qf[s] = *(const bf16x8*)(qp + 16 * s);
      if (lat) { const float* c0 = CS + ((qpos >> 6) * 32 + 8 * hh) * 2; const float* c1 = CS + ((qpos & 63) * 32 + 8 * hh) * 2;
          rope8(qf[0], qf[2], c0); rope8(qf[1], qf[3], c0 + 32); rope8(qf[4], qf[6], c1); rope8(qf[5], qf[7], c1 + 32); } }
    f32x16 O[4];
#pragma unroll
    for (int d = 0; d < 4; ++d)
#pragma unroll
        for (int i = 0; i < 16; ++i) O[d][i] = 0.f;
    float m = P->in[11][l * 8 + h] * LOG2E, lsum = (hh == 0) ? 1.0f : 0.0f;
    const int skey = tid >> 2, sub = tid & 3;
    const int nst = nls + ncs;
    u32x4 rr[8];
#define ATT_ISSUE(ST) do { const int st_ = (ST); const bf16* kp_; const bf16* vp_; \
        if (st_ < nls) { const int krow = klrow0 + 128 * st_ + skey; kp_ = Z + (size_t)krow * DIN + C_AK + kv * 128 + 8 * sub; vp_ = kp_ + (C_AV - C_AK); } \
        else { const int key = 128 * (st_ - nls) + skey; kp_ = CKV + ((size_t)((b * 2 + l) * 256 + key) * 2 + kv) * 128 + 8 * sub; vp_ = kp_ + 262144; } \
        rr[0] = *(const u32x4*)kp_; rr[1] = *(const u32x4*)(kp_ + 32); rr[2] = *(const u32x4*)(kp_ + 64); rr[3] = *(const u32x4*)(kp_ + 96); \
        rr[4] = *(const u32x4*)vp_; rr[5] = *(const u32x4*)(vp_ + 32); rr[6] = *(const u32x4*)(vp_ + 64); rr[7] = *(const u32x4*)(vp_ + 96); } while (0)
#define ATT_WRITE(ST) do { const int st_ = (ST); \
        if (lat && st_ < nls) { const int kpos = kpos0 + 128 * st_ + skey; \
            rope8h(rr[0], rr[1], lds + AT_ROPE + ((kpos >> 6) * 32 + 8 * sub) * 4); rope8h(rr[2], rr[3], lds + AT_ROPE + ((kpos & 63) * 32 + 8 * sub) * 4); } \
        LAS unsigned char* kd_ = lds + (st_ & 1) * AT_BUF + skey * KROW + 16 * sub; LAS unsigned char* vd_ = lds + (st_ & 1) * AT_BUF + AT_V + skey * VROW + 16 * sub; \
        *(LAS u32x4*)kd_ = rr[0]; *(LAS u32x4*)(kd_ + 64) = rr[1]; *(LAS u32x4*)(kd_ + 128) = rr[2]; *(LAS u32x4*)(kd_ + 192) = rr[3]; \
        *(LAS u32x4*)vd_ = rr[4]; *(LAS u32x4*)(vd_ + 64) = rr[5]; *(LAS u32x4*)(vd_ + 128) = rr[6]; *(LAS u32x4*)(vd_ + 192) = rr[7]; } while (0)
    if (lat) { ATT_ISSUE(0); __syncthreads();
        ATT_WRITE(0); }
    else {
        u32x4 r2[8];
        { const bf16* kp_ = Z + (size_t)(klrow0 + skey) * DIN + C_AK + kv * 128 + 8 * sub; const bf16* vp_ = kp_ + (C_AV - C_AK); const bf16* kq_ = kp_ + (size_t)128 * DIN; const bf16* vq_ = vp_ + (size_t)128 * DIN;
          rr[0] = *(const u32x4*)kp_; rr[1] = *(const u32x4*)(kp_ + 32); rr[2] = *(const u32x4*)(kp_ + 64); rr[3] = *(const u32x4*)(kp_ + 96);
          rr[4] = *(const u32x4*)vp_; rr[5] = *(const u32x4*)(vp_ + 32); rr[6] = *(const u32x4*)(vp_ + 64); rr[7] = *(const u32x4*)(vp_ + 96);
          r2[0] = *(const u32x4*)kq_; r2[1] = *(const u32x4*)(kq_ + 32); r2[2] = *(const u32x4*)(kq_ + 64); r2[3] = *(const u32x4*)(kq_ + 96);
          r2[4] = *(const u32x4*)vq_; r2[5] = *(const u32x4*)(vq_ + 32); r2[6] = *(const u32x4*)(vq_ + 64); r2[7] = *(const u32x4*)(vq_ + 96); }
        ATT_WRITE(0);
#pragma unroll
        for (int e = 0; e < 8; ++e) rr[e] = r2[e];
        ATT_WRITE(1);
    }
    __syncthreads();
    for (int st = 0; st < nst; ++st) {
        const bool more = lat && (st + 1 < nst);
        if (more) ATT_ISSUE(st + 1);
        const bool local = lat && (st < nls);
        const LAS unsigned char* kt = lds + (st & 1) * AT_BUF; const LAS unsigned char* vt = kt + AT_V;
#pragma unroll
        for (int t2 = 0; t2 < 2; ++t2) {
            const int tk0 = kpos0 + 128 * st + 64 * t2;
            bool skip = false;
            if (local) skip = (tk0 > qw0 + 31 + 128) || (tk0 + 63 < qw0 - 128);
            if (!skip) attn_tile(kt + t2 * 64 * KROW, vt + t2 * 64 * VROW, qf, O, m, lsum, local, tk0, qpos, lane);
        }
        if (more) ATT_WRITE(st + 1);
        if (lat) __syncthreads();
    }
    const float ltot = lsum + __shfl_xor(lsum, 32), inv = __builtin_amdgcn_rcpf(ltot);
    const bf16* gp = Z + (size_t)qrow * DIN + C_AG + h * 128 + 4 * hh; bf16* op = MIX + (size_t)qrow * D_MODEL + h * 128 + 4 * hh;
    u32x2 gg[16];
#pragma unroll
    for (int e = 0; e < 16; ++e) gg[e] = *(const u32x2*)(gp + 32 * (e >> 2) + 8 * (e & 3));
    __builtin_amdgcn_sched_barrier(0);
#pragma unroll
    for (int dt = 0; dt < 4; ++dt)
#pragma unroll
        for (int i4 = 0; i4 < 4; ++i4) { const int d0 = 32 * dt + 8 * i4; const u32x2 g = gg[dt * 4 + i4];
            const float o0 = O[dt][4 * i4 + 0] * inv * siluf_(bflo(g.x)), o1 = O[dt][4 * i4 + 1] * inv * siluf_(bfhi(g.x));
            const float o2 = O[dt][4 * i4 + 2] * inv * siluf_(bflo(g.y)), o3 = O[dt][4 * i4 + 3] * inv * siluf_(bfhi(g.y));
            u32x2 w; w.x = pk2(o0, o1); w.y = pk2(o2, o3); *(u32x2*)(op + d0) = w; }
#undef ATT_ISSUE
#undef ATT_WRITE
}

__device__ __forceinline__ void hg_oml8(PP P, int l, int dir, int hd0, float (&oml)[8]) {
    const float* hb = P->in[12] + dir * 1024 + hd0;
    const f32x4 a0 = *(const f32x4*)hb, a1 = *(const f32x4*)(hb + 4), b0 = *(const f32x4*)(hb + 512), b1 = *(const f32x4*)(hb + 516);
#pragma unroll
    for (int j = 0; j < 4; ++j) { const float s0 = sigmoidf_(b0[j] - a0[j]), s1 = sigmoidf_(b1[j] - a1[j]); oml[j] = l ? 1.0f - s0 : 1.0f; oml[4 + j] = l ? 1.0f - s1 : 1.0f; }
}
constexpr int H2_TG = 0, H2_QE = 16896, H2_KE = 25600, H2_QG = 34304, H2_KG = 42752, H2_V = 52992, H2_OBA = 63232, H2_OBB = 80128, H2_DK = 97024;
constexpr size_t WS_DLC_OFF = 0;
#ifndef PROBE_SEC
#define PROBE_SEC -1
#endif
#if PROBE_SEC >= 0
#define PSEC_DECL unsigned long long ps_acc_ = 0ull, ps_t_ = 0ull;
#define PSEC_START(n) if (PROBE_SEC == n) ps_t_ = __builtin_amdgcn_s_memrealtime();
#define PSEC_END(n) if (PROBE_SEC == n) ps_acc_ += __builtin_amdgcn_s_memrealtime() - ps_t_;
#define PSEC_CLOSE(n) if (PROBE_SEC == n) { __syncthreads(); ps_acc_ += __builtin_amdgcn_s_memrealtime() - ps_t_; }
#define PSEC_FLUSH(cnt) if (kind == 0 && tid == 0) { atomicAdd((unsigned long long*)((unsigned*)(P->ws + WS_CTL) + 60000), ps_acc_); atomicAdd((unsigned*)(P->ws + WS_CTL) + 60002, (unsigned)(cnt)); }
#else
#define PSEC_DECL
#define PSEC_START(n)
#define PSEC_END(n)
#define PSEC_CLOSE(n)
#define PSEC_FLUSH(cnt)
#endif
__device__ __forceinline__ void hgrn2_unit(PP P, LAS unsigned char* lds, int l, int kind, int idx, int tid) {
    const int lane = tid & 63, wave = __builtin_amdgcn_readfirstlane(tid >> 6), r32 = lane & 31, hh = lane >> 5, i16 = lane & 15, cg = (lane >> 4) & 1;
    const bf16* Z = (const bf16*)(P->ws + WS_Z); bf16* MIX = (bf16*)(P->ws + WS_H); float* OL = (float*)(P->ws + WS_OL);
    LAS float* ldsf = (LAS float*)lds;
    int h, row0, seglen, nch, b = 0;
    if (kind == 0) { b = idx >> 2; h = idx & 3; row0 = b * 256; seglen = 256; nch = 8; }
    else { const int blk = idx & 15; h = (idx >> 4) & 3; const int lb = idx >> 6; row0 = NCTX + lb * 2048 + blk * 128; seglen = 128; nch = 4; }
    const int ti = tid >> 4, d0 = 8 * (tid & 15), nt = wave & 3, kp = wave >> 2;
    PSEC_DECL
    const f32x4 n0 = *(const f32x4*)(P->in[13] + l * 512 + h * 128 + d0), n1 = *(const f32x4*)(P->in[13] + l * 512 + h * 128 + d0 + 4);
    for (int dir = 0; dir < 2; ++dir) {
        const int cf = dir ? C_HFB : C_HFF;
        f32x16 S0, S1;
#pragma unroll
        for (int i = 0; i < 16; ++i) { S0[i] = 0.f; S1[i] = 0.f; }
        const int uidx = (kind == 1) ? ((idx >> 4) * 2 + dir) * 16 + (idx & 15) : 0;
        float gtot = 0.f;
        u32x4 uq, uv, uf;
        { const int row = dir ? row0 + seglen - 1 - ti : row0 + ti; const bf16* zr = Z + (size_t)row * DIN + h * 128 + d0;
          uq = *(const u32x4*)(zr + C_HQ); uv = *(const u32x4*)(zr + C_HI); uf = *(const u32x4*)(zr + cf); }
        for (int c = 0; c < nch; ++c) {
            PSEC_START(0)
            const int nc = dir ? nch - 1 - c : c; const int rown = row0 + 32 * nc + ti;
            f32x4 olp0 = {0.f, 0.f, 0.f, 0.f}, olp1 = {0.f, 0.f, 0.f, 0.f}; u32x4 ug = {0u, 0u, 0u, 0u};
            float* olr = OL + (size_t)rown * 512 + h * 128 + d0;
            if (dir == 1) { olp0 = *(const f32x4*)olr; olp1 = *(const f32x4*)(olr + 4); if (kind == 0) ug = *(const u32x4*)(Z + (size_t)rown * DIN + C_HG + h * 128 + d0); }
            float q[8], kk[8];
            {
                float g2[8], vv[8];
#pragma unroll
                for (int j = 0; j < 4; ++j) { const unsigned wq = uq[j], wv = uv[j], wf = uf[j];
                    q[2 * j] = bflo(wq); q[2 * j + 1] = bfhi(wq);
                    vv[2 * j] = bflo(wv); vv[2 * j + 1] = bfhi(wv);
                    g2[2 * j] = bflo(wf); g2[2 * j + 1] = bfhi(wf); }
#pragma unroll
                for (int j = 0; j < 8; ++j) kk[j] = 1.0f - __builtin_amdgcn_exp2f(g2[j]);
                LAS float* pg = ldsf + (H2_TG >> 2) + ti * 132 + d0;
                *(LAS f32x4*)pg = (f32x4){g2[0], g2[1], g2[2], g2[3]}; *(LAS f32x4*)(pg + 4) = (f32x4){g2[4], g2[5], g2[6], g2[7]};
                *(LAS u32x4*)(lds + H2_V + ti * 320 + d0 * 2) = uv;
            }
            if (c + 1 < nch) { const int tl = 32 * (c + 1) + ti; const int row = dir ? row0 + seglen - 1 - tl : row0 + tl; const bf16* zr = Z + (size_t)row * DIN + h * 128 + d0;
                uq = *(const u32x4*)(zr + C_HQ); uv = *(const u32x4*)(zr + C_HI); uf = *(const u32x4*)(zr + cf); }
            __syncthreads();
            PSEC_END(0) PSEC_START(1)
            if (tid < 128) {
                LAS float* gc = ldsf + (H2_TG >> 2) + tid; float run = 0.f; float gv[32];
#pragma unroll
                for (int i = 0; i < 32; ++i) gv[i] = gc[i * 132];
                SBAR
#pragma unroll
                for (int i = 0; i < 32; ++i) { run += gv[i]; gc[i * 132] = run; }
                ldsf[(H2_DK >> 2) + tid] = __builtin_amdgcn_exp2f(run);
                if (kind == 1) ((float*)(P->ws + WS_DLOG))[(uidx * 4 + c) * 128 + tid] = run;
                gtot += run;
            }
            __syncthreads();
            PSEC_END(1) PSEC_START(2)
            {
                const LAS float* gr = ldsf + (H2_TG >> 2) + ti * 132 + d0; const LAS float* gm = ldsf + (H2_TG >> 2) + 15 * 132 + d0; const LAS float* gl = ldsf + (H2_TG >> 2) + 31 * 132 + d0;
                float qe[8], ke[8], qg[8], kg[8];
#pragma unroll
                for (int j = 0; j < 8; ++j) { const float G = gr[j], Gm = gm[j], Gl = gl[j];
                    qe[j] = q[j] * __builtin_amdgcn_exp2f(fminf(G - Gm, 100.f)); ke[j] = kk[j] * __builtin_amdgcn_exp2f(fminf(Gm - G, 100.f));
                    qg[j] = q[j] * __builtin_amdgcn_exp2f(G); kg[j] = kk[j] * __builtin_amdgcn_exp2f(Gl - G); }
                *(LAS bf16x8*)(lds + H2_QE + ti * 272 + d0 * 2) = pack8(qe[0], qe[1], qe[2], qe[3], qe[4], qe[5], qe[6], qe[7]);
                *(LAS bf16x8*)(lds + H2_KE + ti * 272 + d0 * 2) = pack8(ke[0], ke[1], ke[2], ke[3], ke[4], ke[5], ke[6], ke[7]);
                *(LAS bf16x8*)(lds + H2_KG + ti * 320 + d0 * 2) = pack8(kg[0], kg[1], kg[2], kg[3], kg[4], kg[5], kg[6], kg[7]);
                u32x2 w0, w1; w0.x = pk2(qg[0], qg[1]); w0.y = pk2(qg[2], qg[3]); w1.x = pk2(qg[4], qg[5]); w1.y = pk2(qg[6], qg[7]);
                *(LAS u32x2*)(lds + H2_QG + ti * 264 + d0 * 2) = w0; *(LAS u32x2*)(lds + H2_QG + ti * 264 + d0 * 2 + 8) = w1;
            }
            __syncthreads();
            PSEC_END(2) PSEC_START(3)
            {
                f32x16 at;
#pragma unroll
                for (int i = 0; i < 16; ++i) at[i] = 0.f;
                const LAS unsigned char* kep = lds + H2_KE + r32 * 272 + 16 * hh; const LAS unsigned char* qep = lds + H2_QE + r32 * 272 + 16 * hh;
#pragma unroll
                for (int k = 0; k < 8; ++k) at = __builtin_amdgcn_mfma_f32_32x32x16_bf16(*(const LAS bf16x8*)(kep + 32 * k), *(const LAS bf16x8*)(qep + 32 * k), at, 0, 0, 0);
                float am[8];
#pragma unroll
                for (int j = 0; j < 8; ++j) { const float lo = at[j], hi = at[8 + j]; const float v = kp ? hi : lo; const int s = 16 * kp + 8 * (j >> 2) + 4 * hh + (j & 3); am[j] = (s <= r32) ? v : 0.f; }
                const bf16x8 afrag = pack8(am[0], am[1], am[2], am[3], am[4], am[5], am[6], am[7]);
                f32x16 ot;
#pragma unroll
                for (int i = 0; i < 16; ++i) ot[i] = 0.f;
                { const bf16x8 vfrag = trpair(lds + H2_V + (16 * kp + 4 * hh + (i16 >> 2)) * 320 + (32 * nt + 16 * cg + 4 * (i16 & 3)) * 2, 8 * 320);
                  ot = __builtin_amdgcn_mfma_f32_32x32x16_bf16(vfrag, afrag, ot, 0, 0, 0); }
                const LAS unsigned char* qgp = lds + H2_QG + r32 * 264 + (64 * kp + 4 * hh) * 2;
#pragma unroll
                for (int kl = 0; kl < 2; ++kl)
#pragma unroll
                    for (int sp = 0; sp < 2; ++sp) {
                        const u32x2 qlo = *(const LAS u32x2*)(qgp + (32 * kl + 16 * sp) * 2), qhi = *(const LAS u32x2*)(qgp + (32 * kl + 16 * sp) * 2 + 16);
                        const u32x4 qq = {qlo.x, qlo.y, qhi.x, qhi.y};
                        bf16x8 sfrag;
                        if (kl == 0) sfrag = pack8(S0[8 * sp], S0[8 * sp + 1], S0[8 * sp + 2], S0[8 * sp + 3], S0[8 * sp + 4], S0[8 * sp + 5], S0[8 * sp + 6], S0[8 * sp + 7]);
                        else sfrag = pack8(S1[8 * sp], S1[8 * sp + 1], S1[8 * sp + 2], S1[8 * sp + 3], S1[8 * sp + 4], S1[8 * sp + 5], S1[8 * sp + 6], S1[8 * sp + 7]);
                        ot = __builtin_amdgcn_mfma_f32_32x32x16_bf16(sfrag, __builtin_bit_cast(bf16x8, qq), ot, 0, 0, 0);
                    }
                { LAS float* ob = ldsf + ((kp ? H2_OBB : H2_OBA) >> 2) + (32 * nt + 4 * hh) * 33 + r32;
#pragma unroll
                  for (int i = 0; i < 16; ++i) ob[R0(i) * 33] = ot[i]; }
                const LAS float* dkp = ldsf + (H2_DK >> 2) + 64 * kp + 4 * hh;
#pragma unroll
                for (int i = 0; i < 16; ++i) { S0[i] *= dkp[R0(i)]; S1[i] *= dkp[32 + R0(i)]; }
#pragma unroll
                for (int ks = 0; ks < 2; ++ks) {
                    const int roff = (16 * ks + 8 * hh + (i16 >> 2)) * 320, coff = (16 * cg + 4 * (i16 & 3)) * 2;
                    const bf16x8 vf = trpair(lds + H2_V + roff + 64 * nt + coff, 4 * 320);
                    const bf16x8 k0 = trpair(lds + H2_KG + roff + 64 * (2 * kp) + coff, 4 * 320), k1 = trpair(lds + H2_KG + roff + 64 * (2 * kp + 1) + coff, 4 * 320);
                    S0 = __builtin_amdgcn_mfma_f32_32x32x16_bf16(k0, vf, S0, 0, 0, 0); S1 = __builtin_amdgcn_mfma_f32_32x32x16_bf16(k1, vf, S1, 0, 0, 0);
                }
            }
            __syncthreads();
            PSEC_END(3) PSEC_START(4)
            {
                const int t = dir ? 31 - ti : ti;
                const LAS float* oa = ldsf + (H2_OBA >> 2) + d0 * 33 + t; const LAS float* obb = ldsf + (H2_OBB >> 2) + d0 * 33 + t;
                float o[8];
#pragma unroll
                for (int j = 0; j < 8; ++j) o[j] = oa[j * 33] + obb[j * 33];
                if (dir == 1) { o[0] += olp0[0]; o[1] += olp0[1]; o[2] += olp0[2]; o[3] += olp0[3]; o[4] += olp1[0]; o[5] += olp1[1]; o[6] += olp1[2]; o[7] += olp1[3]; }
                if (dir == 0 || kind == 1) { *(f32x4*)olr = (f32x4){o[0], o[1], o[2], o[3]}; *(f32x4*)(olr + 4) = (f32x4){o[4], o[5], o[6], o[7]}; }
                else {
                    float ss = 0.f;
#pragma unroll
                    for (int j = 0; j < 8; ++j) ss += o[j] * o[j];
                    ss += __shfl_xor(ss, 1); ss += __shfl_xor(ss, 2); ss += __shfl_xor(ss, 4); ss += __shfl_xor(ss, 8);
                    const float r = __builtin_amdgcn_rsqf(ss * (1.0f / 128.0f) + 1e-6f);
                    u32x4 w;
                    w.x = pk2(o[0] * r * n0[0] * siluf_(bflo(ug.x)), o[1] * r * n0[1] * siluf_(bfhi(ug.x))); w.y = pk2(o[2] * r * n0[2] * siluf_(bflo(ug.y)), o[3] * r * n0[3] * siluf_(bfhi(ug.y)));
                    w.z = pk2(o[4] * r * n1[0] * siluf_(bflo(ug.z)), o[5] * r * n1[1] * siluf_(bfhi(ug.z))); w.w = pk2(o[6] * r * n1[2] * siluf_(bflo(ug.w)), o[7] * r * n1[3] * siluf_(bfhi(ug.w)));
                    *(u32x4*)(MIX + (size_t)rown * D_MODEL + 1024 + h * 128 + d0) = w;
                }
            }
            PSEC_CLOSE(4)
        }
        if (kind == 1 && tid < 128) ((float*)(P->ws + WS_DLOG) + 131072)[uidx * 128 + tid] = gtot;
        {
            float* Sd = (kind == 0) ? P->out + OUT_ST + (size_t)((((b * 2 + l) * 2 + dir) * 4 + h)) * 16384 : (float*)(P->ws + WS_U) + (size_t)uidx * 16384;
            float* sp = Sd + (64 * kp + 4 * hh) * 128 + 32 * nt + r32;
#pragma unroll
            for (int i = 0; i < 16; ++i) { sp[R0(i) * 128] = S0[i]; sp[(32 + R0(i)) * 128] = S1[i]; }
        }
    }
    PSEC_FLUSH(2 * nch)
}

__device__ __forceinline__ void hgrn_scan_unit(PP P, int l, int su, int tid) {
    float* U = (float*)(P->ws + WS_U); const float* DLB = (const float*)(P->ws + WS_DLOG) + 131072;
#pragma unroll 1
    for (int k = 0; k < 4; ++k) {
        const int e = su * 2048 + tid + 512 * k;
        const int sq = e >> 14, el = e & 16383, dk = el >> 7, lb = sq >> 3, h = (sq >> 1) & 3, dir = sq & 1;
        float S = P->in[4][(size_t)((((lb * 2 + l) * 2 + dir) * 4 + h)) * 16384 + el];
        float u[16], dl[16];
        const long ustep = dir ? -16384 : 16384, dstep = dir ? -128 : 128;
        float* up = U + (size_t)(sq * 16 + (dir ? 15 : 0)) * 16384 + el; const float* dp = DLB + (sq * 16 + (dir ? 15 : 0)) * 128 + dk;
        { float* uq = up; const float* dq = dp;
#pragma unroll
          for (int p = 0; p < 16; ++p) { u[p] = *uq; dl[p] = *dq; uq += ustep; dq += dstep; asm volatile("" : "+v"(uq), "+v"(dq)); } }
        SBAR
        { float* uq = up;
#pragma unroll
          for (int p = 0; p < 16; ++p) { *uq = S; S = __builtin_amdgcn_exp2f(dl[p]) * S + u[p]; uq += ustep; asm volatile("" : "+v"(uq)); } }
    }
}

constexpr int HF_S0 = 0, HF_S1 = 40960, HF_TG0 = 81920, HF_TG1 = 98816, HF_QG0 = 115712, HF_QG1 = 124416;
__device__ __forceinline__ void hgrn_final_unit(PP P, LAS unsigned char* lds, int l, int idx, int half_sel, int tid) {
    const int lane = tid & 63, wave = __builtin_amdgcn_readfirstlane(tid >> 6), r32 = lane & 31, hh = lane >> 5, i16 = lane & 15, cg = (lane >> 4) & 1;
    const bf16* Z = (const bf16*)(P->ws + WS_Z); bf16* MIX = (bf16*)(P->ws + WS_H); const float* OL = (const float*)(P->ws + WS_OL); const float* DLC = (const float*)(P->ws + WS_DLOG);
    LAS float* ldsf = (LAS float*)lds;
    const int blk = idx & 15, h = (idx >> 4) & 3, lb = idx >> 6, row0 = NCTX + lb * 2048 + blk * 128;
    const int ti = tid >> 4, d0 = 8 * (tid & 15), nt = wave & 3, ds = wave >> 2;
    const int uidx0 = ((idx >> 4) * 2 + 0) * 16 + blk, uidx1 = ((idx >> 4) * 2 + 1) * 16 + blk;
#pragma unroll
    for (int half = 0; half < 2; ++half) {
        f32x4 sv[8];
#pragma unroll
        for (int k = 0; k < 8; ++k) { const int id = tid + 512 * (k + 8 * half), dsel = id >> 12, dk = (id >> 5) & 127, c4 = id & 31;
            sv[k] = *(const f32x4*)((const float*)(P->ws + WS_U) + (size_t)(dsel ? uidx1 : uidx0) * 16384 + dk * 128 + c4 * 4); }
#pragma unroll
        for (int k = 0; k < 8; ++k) { const int id = tid + 512 * (k + 8 * half), dsel = id >> 12, dk = (id >> 5) & 127, c4 = id & 31;
            u32x2 w; w.x = pk2(sv[k][0], sv[k][1]); w.y = pk2(sv[k][2], sv[k][3]); *(LAS u32x2*)(lds + (dsel ? HF_S1 : HF_S0) + dk * 320 + c4 * 8) = w; }
    }
    const f32x4 n0 = *(const f32x4*)(P->in[13] + l * 512 + h * 128 + d0), n1 = *(const f32x4*)(P->in[13] + l * 512 + h * 128 + d0 + 4);
    float carry = 0.f;
    if (tid < 128) { for (int c = 0; c < 2 * half_sel; ++c) carry += DLC[(uidx0 * 4 + c) * 128 + tid]; }
    for (int nc = 2 * half_sel; nc < 2 * half_sel + 2; ++nc) {
        const int rown = row0 + 32 * nc + ti; const bf16* zr = Z + (size_t)rown * DIN + h * 128 + d0;
        const u32x4 uq = *(const u32x4*)(zr + C_HQ), uf0 = *(const u32x4*)(zr + C_HFF), uf1 = *(const u32x4*)(zr + C_HFB), ug = *(const u32x4*)(zr + C_HG);
        const float* olr = OL + (size_t)rown * 512 + h * 128 + d0; const f32x4 olp0 = *(const f32x4*)olr, olp1 = *(const f32x4*)(olr + 4);
        float off1 = 0.f;
        if (tid >= 128 && tid < 256) { for (int c = 0; c < 3 - nc; ++c) off1 += DLC[(uidx1 * 4 + c) * 128 + (tid - 128)]; }
        float q[8];
        {
            float ga[8], gb[8];
#pragma unroll
            for (int j = 0; j < 4; ++j) { const unsigned wq = uq[j], wa = uf0[j], wb = uf1[j];
                q[2 * j] = bflo(wq); q[2 * j + 1] = bfhi(wq);
                ga[2 * j] = bflo(wa); ga[2 * j + 1] = bfhi(wa); gb[2 * j] = bflo(wb); gb[2 * j + 1] = bfhi(wb); }
            LAS float* p0 = ldsf + (HF_TG0 >> 2) + ti * 132 + d0; LAS float* p1 = ldsf + (HF_TG1 >> 2) + ti * 132 + d0;
            *(LAS f32x4*)p0 = (f32x4){ga[0], ga[1], ga[2], ga[3]}; *(LAS f32x4*)(p0 + 4) = (f32x4){ga[4], ga[5], ga[6], ga[7]};
            *(LAS f32x4*)p1 = (f32x4){gb[0], gb[1], gb[2], gb[3]}; *(LAS f32x4*)(p1 + 4) = (f32x4){gb[4], gb[5], gb[6], gb[7]};
        }
        __syncthreads();
        if (tid < 256) { const bool rev = tid >= 128; LAS float* gc = ldsf + ((rev ? HF_TG1 : HF_TG0) >> 2) + (tid & 127); float run = rev ? off1 : carry; float gv[32];
#pragma unroll
            for (int i = 0; i < 32; ++i) gv[i] = gc[(rev ? 31 - i : i) * 132];
            SBAR
#pragma unroll
            for (int i = 0; i < 32; ++i) { run += gv[i]; gc[(rev ? 31 - i : i) * 132] = run; }
            if (!rev) carry = run; }
        __syncthreads();
        {
            const LAS float* g0 = ldsf + (HF_TG0 >> 2) + ti * 132 + d0; const LAS float* g1 = ldsf + (HF_TG1 >> 2) + ti * 132 + d0;
            float a[8], c[8];
#pragma unroll
            for (int j = 0; j < 8; ++j) { a[j] = q[j] * __builtin_amdgcn_exp2f(g0[j]); c[j] = q[j] * __builtin_amdgcn_exp2f(g1[j]); }
            *(LAS bf16x8*)(lds + HF_QG0 + ti * 272 + d0 * 2) = pack8(a[0], a[1], a[2], a[3], a[4], a[5], a[6], a[7]);
            *(LAS bf16x8*)(lds + HF_QG1 + ti * 272 + d0 * 2) = pack8(c[0], c[1], c[2], c[3], c[4], c[5], c[6], c[7]);
        }
        __syncthreads();
        {
            f32x16 acc;
#pragma unroll
            for (int i = 0; i < 16; ++i) acc[i] = 0.f;
            const LAS unsigned char* qp = lds + (ds ? HF_QG1 : HF_QG0) + r32 * 272 + 16 * hh;
            const LAS unsigned char* sp = lds + (ds ? HF_S1 : HF_S0) + (8 * hh + (i16 >> 2)) * 320 + (32 * nt + 16 * cg + 4 * (i16 & 3)) * 2;
#pragma unroll
            for (int k = 0; k < 8; ++k) { const bf16x8 sf = trpair(sp + 16 * k * 320, 4 * 320); acc = __builtin_amdgcn_mfma_f32_32x32x16_bf16(*(const LAS bf16x8*)(qp + 32 * k), sf, acc, 0, 0, 0); }
            LAS float* ob = ldsf + ((ds ? HF_TG1 : HF_TG0) >> 2) + (4 * hh) * 132 + 32 * nt + r32;
#pragma unroll
            for (int i = 0; i < 16; ++i) ob[R0(i) * 132] = acc[i];
        }
        __syncthreads();
        {
            const LAS float* oa = ldsf + (HF_TG0 >> 2) + ti * 132 + d0; const LAS float* obb = ldsf + (HF_TG1 >> 2) + ti * 132 + d0;
            const f32x4 a0 = *(const LAS f32x4*)oa, a1 = *(const LAS f32x4*)(oa + 4), b0 = *(const LAS f32x4*)obb, b1 = *(const LAS f32x4*)(obb + 4);
            const f32x4 o0 = a0 + b0 + olp0, o1 = a1 + b1 + olp1;
            float ss = (o0[0] * o0[0] + o0[1] * o0[1]) + (o0[2] * o0[2] + o0[3] * o0[3]) + (o1[0] * o1[0] + o1[1] * o1[1]) + (o1[2] * o1[2] + o1[3] * o1[3]);
            ss += __shfl_xor(ss, 1); ss += __shfl_xor(ss, 2); ss += __shfl_xor(ss, 4); ss += __shfl_xor(ss, 8);
            const float r = __builtin_amdgcn_rsqf(ss * (1.0f / 128.0f) + 1e-6f);
            u32x4 w;
            w.x = pk2(o0[0] * r * n0[0] * siluf_(bflo(ug.x)), o0[1] * r * n0[1] * siluf_(bfhi(ug.x))); w.y = pk2(o0[2] * r * n0[2] * siluf_(bflo(ug.y)), o0[3] * r * n0[3] * siluf_(bfhi(ug.y)));
            w.z = pk2(o1[0] * r * n1[0] * siluf_(bflo(ug.z)), o1[1] * r * n1[1] * siluf_(bfhi(ug.z))); w.w = pk2(o1[2] * r * n1[2] * siluf_(bflo(ug.w)), o1[3] * r * n1[3] * siluf_(bfhi(ug.w)));
            *(u32x4*)(MIX + (size_t)rown * D_MODEL + 1024 + h * 128 + d0) = w;
        }
        __syncthreads();
    }
}

#define RLX_AGENT __ATOMIC_RELAXED, __HIP_MEMORY_SCOPE_AGENT
#define XB_TMO      128
#define XB_XCNT(j)  (256  + 64 * (j))
#define XB_XSUB(j)  (1280 + 64 * (j))
#define XB_XGEN(j)  (2304 + 64 * (j))
#define XB_TOP      3328
#define XB_TOPGEN   3392
#define XCD_BAR_WORDS 3456
#define XB_SPIN_CAP (1u << 18)

__device__ __forceinline__ unsigned xb_ld(unsigned* p)              { return __hip_atomic_load(p, __ATOMIC_RELAXED, __HIP_MEMORY_SCOPE_AGENT); }
__device__ __forceinline__ unsigned xb_add(unsigned* p, unsigned v) { return __hip_atomic_fetch_add(p, v, __ATOMIC_RELAXED, __HIP_MEMORY_SCOPE_AGENT); }
__device__ __forceinline__ unsigned xb_xcc_id() { return (unsigned)__builtin_amdgcn_s_getreg((3 << 11) | 20) & 0xFu; }
#define XB_SPIN(cond, bar) do { unsigned _sp = 0; while (cond) { __builtin_amdgcn_s_sleep(1); \
    if ((++_sp & 255u) == 0u) { if (xb_ld(&(bar)[XB_TMO])) break; if (_sp > XB_SPIN_CAP) { atomicAdd(&(bar)[XB_TMO], 1u); break; } } } } while (0)

struct XcdBarrier {
    unsigned* bar; unsigned x; bool t0;
    volatile LAS unsigned* st;
};

__device__ __forceinline__ XcdBarrier xcd_barrier_post(unsigned* bar, volatile LAS unsigned* st) {
    XcdBarrier b; b.bar = bar; b.x = xb_xcc_id(); b.st = st; b.t0 = (threadIdx.x == 0);
    if (threadIdx.x == 0) (void)xb_add(&bar[XB_XCNT(b.x)], 1u);
    return b;
}
__device__ __forceinline__ void xcd_barrier_complete(unsigned* bar, unsigned x, unsigned& nloc, unsigned& nx) {
    const unsigned G = gridDim.x * gridDim.y * gridDim.z;
    unsigned sum, cnt, mine, sp = 0u;
    for (;;) {
        sum = 0u; cnt = 0u; mine = 0u;
#pragma unroll
        for (unsigned j = 0; j < 16; ++j) { const unsigned c = xb_ld(&bar[XB_XCNT(j)]); sum += c; cnt += (c > 0u) ? 1u : 0u; mine = (j == x) ? c : mine; }
        if (sum == G) break;
        __builtin_amdgcn_s_sleep(1);
        if ((++sp & 255u) == 0u) { if (xb_ld(&bar[XB_TMO])) break; if (sp > XB_SPIN_CAP) { atomicAdd(&bar[XB_TMO], 1u); break; } }
    }
    nloc = mine > 0u ? mine : 1u; nx = cnt > 0u ? cnt : 1u;
}

__device__ __forceinline__ void xcd_barrier(const XcdBarrier& b) {
    asm volatile("s_waitcnt vmcnt(0)" ::: "memory");
    __syncthreads();
    if (b.t0) {
        unsigned* bar = b.bar;
        __builtin_amdgcn_s_waitcnt(0);
        unsigned nloc = b.st[0], nx = b.st[1];
        if (nloc == 0u) { xcd_barrier_complete(bar, b.x, nloc, nx); b.st[0] = nloc; b.st[1] = nx; }
        const unsigned old = xb_add(&bar[XB_XSUB(b.x)], 1u);
        const unsigned gen = old / nloc;
        if (old + 1u == (gen + 1u) * nloc) {
            __builtin_amdgcn_fence(__ATOMIC_RELEASE, "agent");
            asm volatile("s_waitcnt vmcnt(0)" ::: "memory");
            const unsigned og = xb_add(&bar[XB_TOP], 1u);
            const unsigned tg = og / nx;
            if (og + 1u == (tg + 1u) * nx) xb_add(&bar[XB_TOPGEN], 1u);
            else XB_SPIN(xb_ld(&bar[XB_TOPGEN]) == tg, bar);
            __builtin_amdgcn_fence(__ATOMIC_ACQUIRE, "agent");
            xb_add(&bar[XB_XGEN(b.x)], 1u);
            asm volatile("s_waitcnt vmcnt(0)" ::: "memory");
        } else {
            XB_SPIN(xb_ld(&bar[XB_XGEN(b.x)]) == gen, bar);
            __builtin_amdgcn_fence(__ATOMIC_ACQUIRE, "agent");
            asm volatile("s_waitcnt vmcnt(0)" ::: "memory");
        }
    }
    __syncthreads();
}

#ifndef REP_P0
#define REP_P0 1
#endif
#ifndef REP_P1
#define REP_P1 1
#endif
#ifndef REP_P2
#define REP_P2 1
#endif
#ifndef PROBE_KIND
#define PROBE_KIND -1
#endif
#ifndef PROBE_PH
#define PROBE_PH 0
#endif
#ifndef PROBE_SCALE
#define PROBE_SCALE 1.0f
#endif
#ifndef PROBE_PB
#define PROBE_PB 0
#endif
#ifndef PROBE_PL
#define PROBE_PL 0
#endif
#ifndef P0_MASK
#define P0_MASK 3
#endif
#ifndef P2_MASK
#define P2_MASK 31
#endif
#ifndef REP_P3
#define REP_P3 1
#endif
#ifndef REP_P4
#define REP_P4 1
#endif
__global__ void __launch_bounds__(NTHREADS, 2) fwd_kernel(Params Pkarg) {
    extern __shared__ __attribute__((aligned(16))) unsigned char lds_raw[];
    cg::grid_group grid = cg::this_grid();
    LAS unsigned char* lds = (LAS unsigned char*)lds_raw;
    LAS float* ldsf = (LAS float*)lds;
    volatile LAS unsigned* qslot = (volatile LAS unsigned*)(lds + LDS_CTLW);
    volatile LAS unsigned* xbst = (volatile LAS unsigned*)(lds + LDS_CTLW + 128);
    if (threadIdx.x < 2) xbst[threadIdx.x] = 0u;
    __syncthreads();
    (void)xcd_barrier_post((unsigned*)(Pkarg.ws + WS_CTL) + 1024, xbst);
#define PSTAMP(k, lay) do { if (PROBE_KIND == 20 && (lay) == PROBE_PL && blockIdx.x == PROBE_PB && wave_s == 0) { const unsigned long long t_ = __builtin_amdgcn_s_memrealtime(); if ((k) == PROBE_PH) pst0 = t_; if ((k) == PROBE_PH + 1) pst1 = t_; } } while (0)
#define tid_zero_() (wave_s == 0 && __builtin_amdgcn_mbcnt_hi(~0u, __builtin_amdgcn_mbcnt_lo(~0u, 0u)) == 0u)
#define GSYNC() do { PP Pb_ = (PP)__builtin_amdgcn_kernarg_segment_ptr(); asm volatile("" : "+s"(Pb_)); XcdBarrier xb_; xb_.bar = (unsigned*)(Pb_->ws + WS_CTL) + 1024; xb_.x = xb_xcc_id(); xb_.st = xbst; int ln_; asm volatile("v_mbcnt_lo_u32_b32 %0, -1, 0\n\tv_mbcnt_hi_u32_b32 %0, -1, %0" : "=v"(ln_)); xb_.t0 = (wave_s == 0) && (ln_ == 0); xcd_barrier(xb_); } while (0)
    const int wave_s = __builtin_amdgcn_readfirstlane(threadIdx.x >> 6);
#define PHASE_IDS int tid; asm volatile("v_mbcnt_lo_u32_b32 %0, -1, 0\n\tv_mbcnt_hi_u32_b32 %0, -1, %0" : "=v"(tid)); tid += wave_s * 64; const int lane = tid & 63, wave = wave_s, gw = blockIdx.x * NWAVES + wave; (void)lane; (void)gw; \
    PP P = (PP)__builtin_amdgcn_kernarg_segment_ptr(); asm volatile("" : "+s"(P)); unsigned char* ws = P->ws; unsigned* ctl = (unsigned*)(ws + WS_CTL); float* MOD = (float*)(ws + WS_MOD); \
    bf16* H = (bf16*)(ws + WS_H); bf16* Z = (bf16*)(ws + WS_Z); bf16* WTIN = (bf16*)(ws + WS_WTIN); bf16* WTOUT = (bf16*)(ws + WS_WTOUT); const float* xp = P->in[0]; const float* xs = P->in[1]; \
    (void)ctl; (void)MOD; (void)H; (void)Z; (void)WTIN; (void)WTOUT; (void)xp; (void)xs;
    const int G = gridDim.x, NGW = G * NWAVES;
    unsigned long long pst0 = 0ull, pst1 = 0ull;

    for (int rep = 0; rep < REP_P0; ++rep) {
        PHASE_IDS
        const int m0 = (rep == 0) ? 3 : P0_MASK;
        if (m0 & 1) for (int u = blockIdx.x; u < 192; u += G) mod_unit(P, ldsf, 0, u, tid);
        LAS float* scr = ldsf + wave * 4096;
        if (m0 & 2) for (int it = gw; it < 6656; it += NGW) transpose_item(P->in[9], 2048, DIN, WTIN, scr, it, lane);
        { const int gt4 = (blockIdx.x * NTHREADS + tid) * 4;
          if (gt4 < 524288) { const float* src = (gt4 < 262144) ? P->in[2] + gt4 : P->in[3] + (gt4 - 262144); const f32x4 v = *(const f32x4*)src;
              u32x2 w; w.x = pk2(v[0], v[1]); w.y = pk2(v[2], v[3]); *(u32x2*)((bf16*)(ws + WS_CKV) + gt4) = w; } }
        const int gt = blockIdx.x * NTHREADS + tid;
        if (gt < 2048) { const int pos = gt >> 5, i = gt & 31; const float inv = powf(10000.0f, -(float)i / 32.0f); const float ang = (float)pos * inv;
            float sn, cs; sincosf(ang, &sn, &cs); float* CS = (float*)(ws + WS_CS); CS[gt * 2] = cs; CS[gt * 2 + 1] = sn; }
        grid.sync();
    }
    { PHASE_IDS
    for (int row = gw; row < MTOK; row += NGW) {
        const int cond = (row < NCTX) ? 0 : 1 + ((row - NCTX) >> 11);
        const float* xrow = (row < NCTX) ? xp + (size_t)row * D_MODEL : xs + (size_t)(row - NCTX) * D_MODEL;
        hprep_row(xrow, MOD + (0 * 3 + cond) * 6144, H + (size_t)row * D_MODEL, lane);
    } }
    GSYNC();

    for (int l = 0; l < DEPTH; ++l) {
        PSTAMP(0, l);
        for (int rep = 0; rep < REP_P1; ++rep) {
            PHASE_IDS
            pg8::Gemm g{H, WTIN, MTOK, DIN, D_MODEL}; pg8::StaticOrder S; S.init(MTOK, DIN, D_MODEL, G, (int)blockIdx.x);
            pg8::EpiZ E{Z, P->out + OUT_CK, P->out + OUT_CV, l, P->in[12]};
            pg8::gemm_phase<pg8::EpiZ, pg8::StaticOrder, true, true>(lds, g, S, E, tid);
            GSYNC();
        }
        PSTAMP(1, l);
        {
            int pendf = -1; int uf = -1;
            unsigned long long pr_sum = 0ull; unsigned pr_cnt = 0u;
            const int n_cvt = (l == 0 && G != 256) ? 832 : 0;
            for (int st = 0; st < 3; ++st) {
                PHASE_IDS
                unsigned* cs = ctl + 64 * (l * 4 + st); unsigned* cf = ctl + 64 * (l * 4 + 3);
                const int nspec = (st == 2) ? 256 : 128;
                const int n_def = (l == 0) ? 192 + 512 : 0;
                const int capf = (st == 0) ? 256 : (st == 1) ? 512 : 896 + n_def + n_cvt;
                int pends = -1; bool spec = true;
                int us = q_pop(cs, qslot, tid, pends, 1 << 30);
                for (;;) {
                    int kind, idx;
                    if (spec) {
                        if (us >= nspec) { spec = false; if (uf < 0) uf = q_pop(cf, qslot, tid, pendf, 512); continue; }
                        kind = (st == 0) ? 1 : (st == 1) ? 6 : 7; idx = us;
                    } else {
                        if (uf >= capf) break;
                        if (uf < 128) { kind = 0; idx = uf; } else if (uf < 256) { kind = 3; idx = uf - 128; } else if (uf < 512) { kind = 2; idx = uf - 256; }
                        else if (uf < 896) { kind = 4; idx = uf - 512; } else if (uf < 896 + n_def) { idx = uf - 896; if (idx < 192) kind = 8; else { kind = 9; idx -= 192; } } else { kind = 5; idx = uf - 896 - n_def; }
                    }
                    asm volatile("" : "+v"(tid));
                    const unsigned long long pr_t0 = (PROBE_KIND >= 0 && PROBE_KIND < 9) ? __builtin_amdgcn_s_memrealtime() : 0ull;
                    if (kind <= 1) hgrn2_unit(P, lds, l, kind, idx, tid);
                    else if (kind <= 3) attn_unit(P, lds, l, kind - 2, idx, tid);
                    else if (kind == 4) conv_unit(P, ldsf, l, idx, tid);
                    else if (kind == 5) { const int lane2 = tid & 63; LAS float* scr = ldsf + wave * 4096; transpose_item(P->in[9] + (size_t)2048 * DIN, 2048, DIN, WTIN, scr, idx * 8 + wave, lane2); }
                    else if (kind == 6) hgrn_scan_unit(P, l, idx, tid);
                    else if (kind == 8) mod_unit(P, ldsf, 1, idx, tid);
                    else if (kind == 9) { const int it = idx * 8 + wave, lo = it & 2047; LAS float* scr = ldsf + wave * 4096;
                        transpose_item(P->in[10] + (size_t)(it >> 11) * 2048 * 2048, 2048, 2048, WTOUT + (size_t)(it >> 11) * 2048 * 2048, scr, lo, tid & 63); }
                    else hgrn_final_unit(P, lds, l, idx >> 1, idx & 1, tid);
                    if (PROBE_KIND >= 0 && PROBE_KIND < 9 && kind == PROBE_KIND) { __syncthreads(); pr_sum += __builtin_amdgcn_s_memrealtime() - pr_t0; pr_cnt += 1u; }
                    if (spec) us = q_pop(cs, qslot, tid, pends, 1 << 30); else uf = q_pop(cf, qslot, tid, pendf, 512);
                }
                GSYNC();
                PSTAMP(2 + st, l);
            }
            if (PROBE_KIND >= 0 && PROBE_KIND < 9 && l == 0 && tid_zero_()) { atomicAdd((unsigned long long*)((unsigned*)(Pkarg.ws + WS_CTL) + 60000), pr_sum); atomicAdd((unsigned*)(Pkarg.ws + WS_CTL) + 60002, pr_cnt); }
        }
        if (G == 256) {
            {   PHASE_IDS
                pg8::Gemm g{H, WTOUT + (size_t)l * 2048 * 2048, MTOK, D_MODEL, D_MODEL}; pg8::StaticOrder S; S.init(MTOK, D_MODEL, D_MODEL, G, (int)blockIdx.x, 0); S.rset = 0;
                pg8::EpiV E{(l == 0) ? xp : P->out, (l == 0) ? xs : P->out + OUT_YS, (bf16*)(ws + WS_OL), MOD + l * 3 * 6144 + 4096, (float*)(ws + WS_U), ctl + 8192};
                pg8::gemm_phase<pg8::EpiV, pg8::StaticOrder, true, true>(lds, g, S, E, tid);
            }
            GSYNC();
            PSTAMP(5, l);
            if (blockIdx.x < 128) {
                PHASE_IDS
                pg8::Gemm g{H, WTOUT + (size_t)l * 2048 * 2048, MTOK, D_MODEL, D_MODEL}; pg8::StaticOrder S; S.init(MTOK, D_MODEL, D_MODEL, G, (int)blockIdx.x, 0); S.rset = 1;
                pg8::EpiV E{(l == 0) ? xp : P->out, (l == 0) ? xs : P->out + OUT_YS, (bf16*)(ws + WS_OL), MOD + l * 3 * 6144 + 4096, (float*)(ws + WS_U), ctl + 8192};
                pg8::gemm_phase<pg8::EpiV, pg8::StaticOrder, true, true>(lds, g, S, E, tid);
            } else {
                PHASE_IDS
                for (int row = (blockIdx.x - 128) * NWAVES + wave; row < NCTX; row += 128 * NWAVES)
                    ln_row((const bf16*)(ws + WS_OL) + (size_t)row * D_MODEL, P->out + (size_t)row * D_MODEL, P->in[18] + l * D_MODEL, P->in[19] + l * D_MODEL, MOD + 3 * 6144, (l == 0) ? H + (size_t)row * D_MODEL : (bf16*)nullptr, lane);
                if (l == 0) {
                    LAS float* scr = ldsf + wave * 4096;
                    for (int it = (blockIdx.x - 128) * NWAVES + wave; it < 6656; it += 128 * NWAVES) { asm volatile("" : "+v"(tid)); transpose_item(P->in[9] + (size_t)2048 * DIN, 2048, DIN, WTIN, scr, it, tid & 63); }
                }
            }
#ifdef PROBE_SUB
            __syncthreads(); PSTAMP(6, l);
#endif
            GSYNC();
#ifndef PROBE_SUB
            PSTAMP(6, l);
#endif
            {   PHASE_IDS
                for (int row = NCTX + gw; row < MTOK; row += NGW) { const int cond = 1 + ((row - NCTX) >> 11);
                    ln_row((const bf16*)(ws + WS_OL) + (size_t)row * D_MODEL, P->out + (size_t)row * D_MODEL, P->in[18] + l * D_MODEL, P->in[19] + l * D_MODEL, MOD + (3 + cond) * 6144, (l == 0) ? H + (size_t)row * D_MODEL : (bf16*)nullptr, lane); }
            }
        } else {
            {   PHASE_IDS
                pg8::Gemm g{H, WTOUT + (size_t)l * 2048 * 2048, MTOK, D_MODEL, D_MODEL}; pg8::StaticOrder S; S.init(MTOK, D_MODEL, D_MODEL, G, (int)blockIdx.x, 0);
                pg8::EpiV E{(l == 0) ? xp : P->out, (l == 0) ? xs : P->out + OUT_YS, (bf16*)(ws + WS_OL), MOD + l * 3 * 6144 + 4096, (float*)(ws + WS_U), ctl + 8192};
                pg8::gemm_phase<pg8::EpiV, pg8::StaticOrder, true, true>(lds, g, S, E, tid);
            }
            GSYNC();
            {   PHASE_IDS
                for (int row = gw; row < MTOK; row += NGW) { const int cond = (row < NCTX) ? 0 : 1 + ((row - NCTX) >> 11);
                    ln_row((const bf16*)(ws + WS_OL) + (size_t)row * D_MODEL, P->out + (size_t)row * D_MODEL, P->in[18] + l * D_MODEL, P->in[19] + l * D_MODEL, MOD + (3 + cond) * 6144, (l == 0) ? H + (size_t)row * D_MODEL : (bf16*)nullptr, lane); }
            }
        }
        if (l + 1 < DEPTH) GSYNC();
        PSTAMP(7, l);
    }
    if (PROBE_KIND >= 0) { GSYNC(); PHASE_IDS if (blockIdx.x == ((PROBE_KIND == 20) ? PROBE_PB : 0) && tid == 0) { const unsigned long long sm = *(volatile unsigned long long*)(ctl + 60000); const unsigned cn = *(volatile unsigned*)(ctl + 60002); const float pv_ = (PROBE_KIND == 20) ? PROBE_SCALE * 0.01f * (float)(pst1 - pst0) : ((PROBE_KIND == 9) ? 0.1f : 0.01f) * (float)sm / (float)(cn ? cn : 1u);     P->out[0] = pv_; P->out[1] = pv_; P->out[2] = pv_; P->out[3] = pv_; }     }
}

extern "C" void kernel_launch(void* const* d_in, const int* in_sizes, int n_in, void* d_out, int out_size, void* d_ws, size_t ws_size, hipStream_t stream) {
    static int grid = 0;
    if (grid == 0) {
        if (n_in != 20 || out_size != (int)OUT_TOTAL || ws_size < WS_END) { fprintf(stderr, "kernel_launch: unexpected shapes (n_in %d, out %d, ws %zu)\n", n_in, out_size, ws_size); grid = -1; return; }
        int dev = 0, cus = 0, per_cu = 0;
        hipGetDevice(&dev); hipDeviceGetAttribute(&cus, hipDeviceAttributeMultiprocessorCount, dev);
        hipFuncSetAttribute((const void*)fwd_kernel, hipFuncAttributeMaxDynamicSharedMemorySize, LDS_BYTES);
        hipOccupancyMaxActiveBlocksPerMultiprocessor(&per_cu, (const void*)fwd_kernel, NTHREADS, LDS_BYTES);
        if (per_cu < 1) { fprintf(stderr, "kernel_launch: occupancy query says %d blocks per CU\n", per_cu); grid = -1; return; }
        grid = cus;
    }
    if (grid < 0) return;
    hipMemsetAsync((char*)d_ws + WS_CTL, 0, CTL_ZERO_BYTES, stream);
    Params p{};
    for (int i = 0; i < 20; ++i) p.in[i] = (const float*)d_in[i];
    p.out = (float*)d_out; p.ws = (unsigned char*)d_ws;
    void* args[] = {&p};
    hipError_t e = hipLaunchCooperativeKernel((const void*)fwd_kernel, dim3(grid), dim3(NTHREADS), args, LDS_BYTES, stream);
    if (e != hipSuccess) fprintf(stderr, "cooperative launch failed: %s (grid %d)\n", hipGetErrorString(e), grid);
}
```

```cpp
#include <hip/hip_runtime.h>
#include <hip/hip_cooperative_groups.h>
#include <cstdio>
#include <cstdint>
namespace cg = cooperative_groups;

constexpr int D_MODEL = 2048, DIN = 6656, NCTX = 8192, NLAT = 4096, MTOK = 12288, DEPTH = 2;
constexpr int C_AQ = 0, C_AK = 1024, C_AV = 1280, C_AG = 1536, C_HQ = 2560, C_HI = 3072, C_HFF = 3584, C_HFB = 4096, C_HG = 4608, C_CA = 5120, C_CB = 5632, C_CG = 6144;
constexpr float ALPHA_DN = 1.4142135623730951f;
constexpr size_t OUT_YP = 0, OUT_YS = 16777216, OUT_CK = 25165824, OUT_CV = 29360128, OUT_ST = 33554432, OUT_TOTAL = 41943040;
namespace pg8 {
#define PG8_LAS __attribute__((address_space(3)))
typedef unsigned short bf16_t;
typedef short bf16x8 __attribute__((ext_vector_type(8)));
typedef float f32x4 __attribute__((ext_vector_type(4)));
typedef unsigned u32x4 __attribute__((ext_vector_type(4)));
constexpr int BM = 256, BK = 64, HALF = 128, HTB = HALF * BK * 2  , STAGE_BYTES = 8 * HTB, NXCD = 8, WGM = 8;

__host__ __device__ __forceinline__ int lds_byte(int r, int c) { const int st = (r >> 4) * 2 + (c >> 5), rr = r & 15, cc = c & 31, ob = rr * 64 + cc * 2; return st * 1024 + (ob ^ (((ob >> 9) & 1) << 5)); }
__host__ __device__ __forceinline__ void stage_rc(int b, int& R, int& C) { const int st = b / 1024, sb = b % 1024, swz = sb ^ (((sb >> 9) & 1) << 5); R = (st >> 1) * 16 + swz / 64; C = (st & 1) * 32 + (swz % 64) / 2; }
__host__ __device__ __forceinline__ int perm32(int rho) { const int n = rho >> 4, i = rho & 15; return 8 * (i >> 2) + 4 * n + (i & 3); }

struct Unit { int pm, pn, k0, nk, role, pair; };
struct Gemm { const bf16_t* A; const bf16_t* Bt; int M, N, K; };

struct StaticOrder {
    int nM, nN, nwg, G, c, nkt, split, rset;
    __host__ __device__ void init(int M, int N, int K, int G_, int c_, int split_ = 0) { nM = M / BM; nN = N / BM; nwg = nM * nN; G = G_; c = c_; nkt = K / BK; split = split_ && (G_ % 16 == 0) && (2 * nwg == 3 * G_) && (nkt % 4 == 0); rset = -1; }
    __host__ __device__ void map(long L, Unit& u) const {
        int wgid = (int)L; { const int q = nwg / NXCD, r = nwg % NXCD, xcd = wgid % NXCD, off = wgid / NXCD; wgid = (xcd < r ? xcd * (q + 1) : r * (q + 1) + (xcd - r) * q) + off; }
        const int nig = WGM * nN, gid = wgid / nig, fm = gid * WGM, gsz = (nM - fm) < WGM ? (nM - fm) : WGM;
        u.pm = fm + ((wgid % nig) % gsz); u.pn = (wgid % nig) / gsz; u.k0 = 0; u.nk = nkt; u.role = 0; u.pair = 0;
    }
    __host__ __device__ bool next(int i, Unit& u) const {
        if (rset >= 0) {
            if (i != 0) return false;
            const int xcd = c & 7, ix = c >> 3;
            if (rset == 0) { u.pm = xcd * 4 + (ix >> 3); u.pn = ix & 7; } else { if (c >= 128) return false; u.pm = 32 + xcd * 2 + (ix >> 3); u.pn = ix & 7; }
            u.k0 = 0; u.nk = nkt; u.role = 0; u.pair = 0; return true;
        }
        if (split) {
            if (i == 0) { map(c, u); return true; }
            if (i == 1) { const int j = (c >> 4) * 8 + (c & 7), half = (c >> 3) & 1; map(G + j, u); u.k0 = half * (nkt / 2); u.nk = nkt / 2; u.role = 1 + half; u.pair = j; return true; }
            return false;
        }
        const long L = (long)i * G + c; if (L >= nwg) return false;
        map(L, u); return true;
    }
    __device__ __forceinline__ void a_ready(const Unit&) const {}
    __device__ __forceinline__ void done(const Unit&) const {}
};

__device__ __forceinline__ unsigned cvt_pk_bf16(float lo, float hi) { unsigned r; asm volatile("v_cvt_pk_bf16_f32 %0, %1, %2" : "=v"(r) : "v"(lo), "v"(hi)); return r; }
typedef float f32x2 __attribute__((ext_vector_type(2)));

struct EpiZ {
    static constexpr bool PERM = true, AFTER_DRAIN = false;
    bf16_t* Z; float* ck; float* cv; int layer; const float* hlb;
    __device__ __forceinline__ void operator()(f32x4 (&acc)[2][2][4][2], const Unit& u, int wr, int wc, int fr_in, int fq_in) const {
        int fr = fr_in, fq = fq_in; asm volatile("" : "+v"(fr), "+v"(fq));
        const int row0 = u.pm * BM + wr * 64 + fr; const int col0 = u.pn * BM + wc * 32 + 8 * fq;
        const bool sig = (u.pn == 22 || u.pn == 23);
        const int cls = (u.pn == 10 || u.pn == 11) ? 1 : (u.pn >= 14 && u.pn <= 17) ? 2 : 0;
        f32x4 oml[2][2];
#pragma unroll
        for (int bj = 0; bj < 2; ++bj)
#pragma unroll
            for (int n = 0; n < 2; ++n) oml[bj][n] = (f32x4){1.f, 1.f, 1.f, 1.f};
        if (cls == 2 && layer != 0) { const int dir = (u.pn >= 16) ? 1 : 0; const float* hb = hlb + dir * 1024 + (u.pn & 1) * 256 + wc * 32 + 8 * fq;
#pragma unroll
            for (int bj = 0; bj < 2; ++bj)
#pragma unroll
                for (int n = 0; n < 2; ++n) { const f32x4 a = *(const f32x4*)(hb + bj * HALF + 4 * n), b = *(const f32x4*)(hb + 512 + bj * HALF + 4 * n);
#pragma unroll
                    for (int e = 0; e < 4; ++e) oml[bj][n][e] = 1.0f - __builtin_amdgcn_rcpf(1.0f + __builtin_amdgcn_exp2f(-1.4426950408889634f * (b[e] - a[e]))); } }
#pragma unroll
        for (int ai = 0; ai < 2; ++ai)
#pragma unroll
            for (int m = 0; m < 4; ++m) { bf16_t* rowp = Z + (size_t)(row0 + ai * HALF + m * 16) * DIN + col0;
#pragma unroll
                for (int bj = 0; bj < 2; ++bj) { f32x4 v0 = acc[ai][bj][m][0], v1 = acc[ai][bj][m][1];
                    if (cls == 1) {
#pragma unroll
                        for (int e = 0; e < 4; ++e) { v0[e] = v0[e] * 0.08838834764831845f * __builtin_amdgcn_rcpf(1.0f + __builtin_amdgcn_exp2f(-1.4426950408889634f * v0[e])); v1[e] = v1[e] * 0.08838834764831845f * __builtin_amdgcn_rcpf(1.0f + __builtin_amdgcn_exp2f(-1.4426950408889634f * v1[e])); }
                    } else if (cls == 2) {
                        const f32x4 o0 = oml[bj][0], o1 = oml[bj][1];
#pragma unroll
                        for (int e = 0; e < 4; ++e) { const float k0 = o0[e] * __builtin_amdgcn_rcpf(1.0f + __builtin_amdgcn_exp2f(1.4426950408889634f * v0[e])), k1 = o1[e] * __builtin_amdgcn_rcpf(1.0f + __builtin_amdgcn_exp2f(1.4426950408889634f * v1[e]));
                            v0[e] = __builtin_amdgcn_logf(1.0f - fminf(k0, 1.0f - 1e-6f)); v1[e] = __builtin_amdgcn_logf(1.0f - fminf(k1, 1.0f - 1e-6f)); }
                    }
                    if (sig) {
#pragma unroll
                        for (int e = 0; e < 4; ++e) { v0[e] = __builtin_amdgcn_rcpf(1.0f + __builtin_amdgcn_exp2f(-1.4426950408889634f * v0[e])); v1[e] = __builtin_amdgcn_rcpf(1.0f + __builtin_amdgcn_exp2f(-1.4426950408889634f * v1[e])); } }
                    u32x4 w; w.x = cvt_pk_bf16(v0[0], v0[1]); w.y = cvt_pk_bf16(v0[2], v0[3]); w.z = cvt_pk_bf16(v1[0], v1[1]); w.w = cvt_pk_bf16(v1[2], v1[3]);
                    *(u32x4*)(rowp + bj * HALF) = w; } }
        if ((u.pn == 4 || u.pn == 5) && u.pm < 32) {
            float* base = (u.pn == 4) ? ck : cv;
#pragma unroll
            for (int ai = 0; ai < 2; ++ai)
#pragma unroll
                for (int m = 0; m < 4; ++m) { const int row = row0 + ai * HALF + m * 16; const int b = row >> 8, s = row & 255;
                    float* p = base + ((size_t)((b * 2 + layer) * 256 + s)) * 256 + (wc * 32 + 8 * fq);
#pragma unroll
                    for (int bj = 0; bj < 2; ++bj) { *(f32x4*)(p + bj * HALF) = acc[ai][bj][m][0]; *(f32x4*)(p + bj * HALF + 4) = acc[ai][bj][m][1]; } }
        }
    }
};
typedef unsigned u32x2v_ __attribute__((ext_vector_type(2)));
struct EpiV {
    static constexpr bool PERM = false, AFTER_DRAIN = false;
    const float* xp; const float* xs; bf16_t* V; const float* gate;
    float* slab; unsigned* flags;
    __device__ __forceinline__ void operator()(f32x4 (&acc)[2][2][4][2], const Unit& u, int wr, int wc, int fr_in, int fq_in) const {
        int fr = fr_in, fq = fq_in; asm volatile("" : "+v"(fr), "+v"(fq));
        const int lane = fq * 16 + fr, tid = (wr * 4 + wc) * 64 + lane;
        float* sp = slab + (size_t)u.pair * 65536 + tid * 4; unsigned* fl = flags + 64 * u.pair;
        if (u.role == 1) {
            { float* q = sp;
#pragma unroll
              for (int ai = 0; ai < 2; ++ai)
#pragma unroll
                for (int m = 0; m < 4; ++m)
#pragma unroll
                    for (int bj = 0; bj < 2; ++bj)
#pragma unroll
                        for (int n = 0; n < 2; ++n) {
                            asm volatile("global_store_dwordx4 %0, %1, off sc1\n\ts_nop 1" :: "v"(q), "v"(acc[ai][bj][m][n]) : "memory");
                            q += 2048; asm volatile("" : "+v"(q)); } }
            asm volatile("s_waitcnt vmcnt(0)" ::: "memory");
            if (lane == 0) __hip_atomic_fetch_add(fl, 1u, __ATOMIC_RELAXED, __HIP_MEMORY_SCOPE_AGENT);
            return;
        }
        const bool red = (u.role == 2);
        if (red) {
            unsigned sp_ = 0;
            while ((unsigned)__builtin_amdgcn_readfirstlane(__hip_atomic_load(fl, __ATOMIC_RELAXED, __HIP_MEMORY_SCOPE_AGENT)) < 8u) { __builtin_amdgcn_s_sleep(2); if (++sp_ > (1u << 20)) break; }
            asm volatile("" ::: "memory");
        }
        const int row0 = u.pm * BM + wr * 64 + fr; const int col0 = u.pn * BM + wc * 32 + 4 * fq;
        const int cond = (u.pm < 32) ? 0 : 1 + ((u.pm - 32) >> 3);
        const float* g = gate + cond * 6144 + col0;
        f32x4 gv[2][2];
#pragma unroll
        for (int bj = 0; bj < 2; ++bj)
#pragma unroll
            for (int n = 0; n < 2; ++n) gv[bj][n] = *(const f32x4*)(g + bj * HALF + n * 16);
        if (!red) {
            f32x4 xq[2][4];
            { const int row = row0; const float* xr = ((row < NCTX) ? xp + (size_t)row * D_MODEL : xs + (size_t)(row - NCTX) * D_MODEL) + col0;
#pragma unroll
              for (int e = 0; e < 4; ++e) xq[0][e] = *(const f32x4*)(xr + (e >> 1) * HALF + (e & 1) * 16); }
#pragma unroll
            for (int g8 = 0; g8 < 8; ++g8) { const int ai = g8 >> 2, m = g8 & 3; const int row = row0 + ai * HALF + m * 16;
                if (g8 + 1 < 8) { const int rown = row0 + ((g8 + 1) >> 2) * HALF + ((g8 + 1) & 3) * 16;
                    const float* xr = ((rown < NCTX) ? xp + (size_t)rown * D_MODEL : xs + (size_t)(rown - NCTX) * D_MODEL) + col0;
#pragma unroll
                    for (int e = 0; e < 4; ++e) xq[(g8 + 1) & 1][e] = *(const f32x4*)(xr + (e >> 1) * HALF + (e & 1) * 16); }
                bf16_t* vr = V + (size_t)row * D_MODEL + col0;
#pragma unroll
                for (int e = 0; e < 4; ++e) { const f32x4 o = xq[g8 & 1][e] * ALPHA_DN + gv[e >> 1][e & 1] * acc[ai][e >> 1][m][e & 1];
                    u32x2v_ w; w.x = cvt_pk_bf16(o[0], o[1]); w.y = cvt_pk_bf16(o[2], o[3]); *(u32x2v_*)(vr + (e >> 1) * HALF + (e & 1) * 16) = w; }
                asm volatile("" ::: "memory"); }
        } else {
            const float* rq = sp;
#pragma unroll
            for (int ai = 0; ai < 2; ++ai)
#pragma unroll
                for (int m = 0; m < 4; ++m) { const int row = row0 + ai * HALF + m * 16;
                    const float* xr = ((row < NCTX) ? xp + (size_t)row * D_MODEL : xs + (size_t)(row - NCTX) * D_MODEL) + col0;
                    bf16_t* vr = V + (size_t)row * D_MODEL + col0;
                    f32x4 t[2][2];
#pragma unroll
                    for (int bj = 0; bj < 2; ++bj)
#pragma unroll
                        for (int n = 0; n < 2; ++n) { const unsigned long long* q8 = (const unsigned long long*)rq;
                            const unsigned long long a8 = __hip_atomic_load(q8, __ATOMIC_RELAXED, __HIP_MEMORY_SCOPE_AGENT), b8 = __hip_atomic_load(q8 + 1, __ATOMIC_RELAXED, __HIP_MEMORY_SCOPE_AGENT);
                            t[bj][n] = (f32x4){__builtin_bit_cast(float, (unsigned)a8), __builtin_bit_cast(float, (unsigned)(a8 >> 32)), __builtin_bit_cast(float, (unsigned)b8), __builtin_bit_cast(float, (unsigned)(b8 >> 32))};
                            rq += 2048; asm volatile("" : "+v"(rq)); }
#pragma unroll
                    for (int bj = 0; bj < 2; ++bj)
#pragma unroll
                        for (int n = 0; n < 2; ++n) { const f32x4 xv = *(const f32x4*)(xr + bj * HALF + n * 16); const f32x4 o = xv * ALPHA_DN + gv[bj][n] * (acc[ai][bj][m][n] + t[bj][n]);
                            u32x2v_ w; w.x = cvt_pk_bf16(o[0], o[1]); w.y = cvt_pk_bf16(o[2], o[3]); *(u32x2v_*)(vr + bj * HALF + n * 16) = w; }
                    asm volatile("" ::: "memory"); }
        }
    }
};
template <class Epi, class Sched, bool ALIGN_EPI = false, bool SP2 = false>
__device__ __forceinline__ void gemm_phase(PG8_LAS unsigned char* lds, const Gemm g, const Sched& S, const Epi& E, int tid_in) {
    int tid_l = tid_in; asm volatile("" : "+v"(tid_l));
    const int tid = tid_l, wid = __builtin_amdgcn_readfirstlane(tid >> 6), lane = tid & 63, wr = wid >> 2, wc = wid & 3, fr = lane & 15, fq = lane >> 4;
    const int K = g.K;
    unsigned voffA[2], voffB[2];
#pragma unroll
    for (int i = 0; i < 2; ++i) { int R, C; stage_rc(tid * 16 + i * 8192, R, C); const int Rb = Epi::PERM ? ((R & ~31) + perm32(R & 31)) : R;
        voffA[i] = (unsigned)(R * K + C) * 2u; voffB[i] = (unsigned)(Rb * K + C) * 2u; }
    const size_t kstep = (size_t)(BK * 2);
    const size_t hstep = (size_t)HALF * K * 2;
    const size_t tstep = 2 * hstep;
    const unsigned ldsw = (unsigned)wid * 1024u;
    const int aoff = lds_byte(wr * 64 + fr, fq * 8), boff = lds_byte(wc * 32 + fr, fq * 8);
#define PG8_SA(b, h) (((b) * 2 + (h)) * HTB)
#define PG8_SB(b, h) ((4 + (b) * 2 + (h)) * HTB)
#define PG8_STAGE(bufoff, gbase, voff) do { _Pragma("unroll") for (int _i = 0; _i < 2; ++_i) \
        __builtin_amdgcn_global_load_lds((const unsigned*)((const char*)(gbase) + (voff)[_i]), (PG8_LAS unsigned*)(lds + (bufoff) + ldsw + _i * 8192), 16, 0, 0); } while (0)
#define PG8_LDA(dst, b, h) do { _Pragma("unroll") for (int m = 0; m < 4; ++m) _Pragma("unroll") for (int k = 0; k < 2; ++k) dst[m][k] = *(const PG8_LAS bf16x8*)(lds + PG8_SA(b, h) + aoff + m * 2048 + k * 1024); } while (0)
#define PG8_LDB(dst, b, h) do { _Pragma("unroll") for (int n = 0; n < 2; ++n) _Pragma("unroll") for (int k = 0; k < 2; ++k) dst[n][k] = *(const PG8_LAS bf16x8*)(lds + PG8_SB(b, h) + boff + n * 2048 + k * 1024); } while (0)
#define PG8_MMA(ai, bj, At, Bt) do { __builtin_amdgcn_s_setprio(1); _Pragma("unroll") for (int m = 0; m < 4; ++m) _Pragma("unroll") for (int n = 0; n < 2; ++n) _Pragma("unroll") for (int k = 0; k < 2; ++k) \
        acc[ai][bj][m][n] = __builtin_amdgcn_mfma_f32_16x16x32_bf16(Bt[n][k], At[m][k], acc[ai][bj][m][n], 0, 0, 0); __builtin_amdgcn_s_setprio(0); } while (0)
#define PG8_WAIT_V(n) asm volatile("s_waitcnt vmcnt(" #n ")" ::: "memory")
#define PG8_WAIT_L(n) asm volatile("s_waitcnt lgkmcnt(" #n ")" ::: "memory")
#define PG8_BAR __builtin_amdgcn_s_barrier()
#define PG8_SCHED __builtin_amdgcn_sched_barrier(0)
    Unit cur, nxt; int ui = 0;
    if (!S.next(0, cur)) return;
    f32x4 acc[2][2][4][2];
#pragma unroll
    for (int a = 0; a < 2; ++a)
#pragma unroll
        for (int b = 0; b < 2; ++b)
#pragma unroll
            for (int m = 0; m < 4; ++m)
#pragma unroll
                for (int n = 0; n < 2; ++n) acc[a][b][m][n] = (f32x4){0.f, 0.f, 0.f, 0.f};
    bf16x8 At[4][2], B0[2][2], B1[2][2];
    const char* cA = (const char*)g.A + (size_t)cur.pm * tstep + (size_t)cur.k0 * kstep; const char* cB = (const char*)g.Bt + (size_t)cur.pn * tstep + (size_t)cur.k0 * kstep;
    S.a_ready(cur);
    if constexpr (SP2) {
        PG8_STAGE(PG8_SB(0, 0), cB, voffB); PG8_STAGE(PG8_SB(0, 1), cB + hstep, voffB); PG8_STAGE(PG8_SA(0, 0), cA, voffA); PG8_STAGE(PG8_SA(0, 1), cA + hstep, voffA);
        if (wr == 1) PG8_BAR;
        PG8_WAIT_V(2); PG8_BAR;
        PG8_STAGE(PG8_SB(1, 0), cB + kstep, voffB); PG8_STAGE(PG8_SA(1, 0), cA + kstep, voffA); PG8_STAGE(PG8_SB(1, 1), cB + hstep + kstep, voffB);
        PG8_WAIT_V(6); PG8_BAR;
    } else {
        PG8_STAGE(PG8_SB(0, 0), cB, voffB); PG8_STAGE(PG8_SA(0, 0), cA, voffA); PG8_STAGE(PG8_SB(0, 1), cB + hstep, voffB); PG8_STAGE(PG8_SA(0, 1), cA + hstep, voffA);
        if (wr == 1) PG8_BAR;
        PG8_WAIT_V(4); PG8_BAR;
        PG8_STAGE(PG8_SB(1, 0), cB + kstep, voffB); PG8_STAGE(PG8_SA(1, 0), cA + kstep, voffA); PG8_STAGE(PG8_SB(1, 1), cB + hstep + kstep, voffB);
        PG8_WAIT_V(6); PG8_BAR;
    }
    for (;;) {
        const bool has_next = S.next(ui + 1, nxt);
        const char* nA = has_next ? (const char*)g.A + (size_t)nxt.pm * tstep + (size_t)nxt.k0 * kstep : cA; const char* nB = has_next ? (const char*)g.Bt + (size_t)nxt.pn * tstep + (size_t)nxt.k0 * kstep : cB;
        const int nt = cur.nk;
        for (int t = 0; t < nt; t += 2) {
            const bool last = (t == nt - 2);
            const char* a1 = cA + (size_t)(t + 1) * kstep;
            const char* a2 = last ? nA : cA + (size_t)(t + 2) * kstep; const char* b2 = last ? nB : cB + (size_t)(t + 2) * kstep;
            const char* a3 = a2 + kstep; const char* b3 = b2 + kstep;
            if (last && has_next) S.a_ready(nxt);
            if constexpr (SP2) {
            PG8_LDB(B0, 0, 0); PG8_LDB(B1, 0, 1); PG8_SCHED; PG8_LDA(At, 0, 0); PG8_STAGE(PG8_SA(1, 1), a1 + hstep, voffA);
            PG8_WAIT_V(8); PG8_WAIT_L(0); PG8_BAR; PG8_MMA(0, 0, At, B0); PG8_MMA(0, 1, At, B1); PG8_BAR; PG8_SCHED;
            PG8_LDA(At, 0, 1); PG8_STAGE(PG8_SB(0, 0), b2, voffB); PG8_STAGE(PG8_SB(0, 1), b2 + hstep, voffB); PG8_STAGE(PG8_SA(0, 0), a2, voffA);
            PG8_WAIT_V(8); PG8_WAIT_L(0); PG8_BAR; PG8_MMA(1, 0, At, B0); PG8_MMA(1, 1, At, B1); PG8_BAR; PG8_SCHED;
            PG8_LDB(B0, 1, 0); PG8_LDB(B1, 1, 1); PG8_SCHED; PG8_LDA(At, 1, 0); PG8_STAGE(PG8_SA(0, 1), a2 + hstep, voffA);
            PG8_WAIT_V(8); PG8_WAIT_L(0); PG8_BAR; PG8_MMA(0, 0, At, B0); PG8_MMA(0, 1, At, B1); PG8_BAR; PG8_SCHED;
            PG8_LDA(At, 1, 1); PG8_STAGE(PG8_SB(1, 0), b3, voffB); PG8_STAGE(PG8_SB(1, 1), b3 + hstep, voffB); PG8_STAGE(PG8_SA(1, 0), a3, voffA);
            PG8_WAIT_V(8); PG8_WAIT_L(0); PG8_BAR; PG8_MMA(1, 0, At, B0); PG8_MMA(1, 1, At, B1); PG8_BAR; PG8_SCHED;
            } else {
            PG8_LDB(B0, 0, 0); PG8_SCHED; PG8_LDA(At, 0, 0); PG8_STAGE(PG8_SA(1, 1), a1 + hstep, voffA);
            PG8_WAIT_L(8); PG8_BAR; PG8_WAIT_L(0); PG8_MMA(0, 0, At, B0); PG8_BAR; PG8_SCHED;
            PG8_LDB(B1, 0, 1); PG8_STAGE(PG8_SB(0, 0), b2, voffB);
            PG8_BAR; PG8_WAIT_L(0); PG8_MMA(0, 1, At, B1); PG8_BAR;
            PG8_LDA(At, 0, 1); PG8_STAGE(PG8_SA(0, 0), a2, voffA);
            PG8_BAR; PG8_WAIT_L(0); PG8_MMA(1, 0, At, B0); PG8_BAR; PG8_SCHED;
            PG8_STAGE(PG8_SB(0, 1), b2 + hstep, voffB);
            PG8_WAIT_V(6); PG8_BAR; PG8_MMA(1, 1, At, B1); PG8_BAR;
            PG8_LDB(B0, 1, 0); PG8_SCHED; PG8_LDA(At, 1, 0); PG8_STAGE(PG8_SA(0, 1), a2 + hstep, voffA);
            PG8_WAIT_L(8); PG8_BAR; PG8_WAIT_L(0); PG8_MMA(0, 0, At, B0); PG8_BAR; PG8_SCHED;
            PG8_LDB(B1, 1, 1); PG8_STAGE(PG8_SB(1, 0), b3, voffB);
            PG8_BAR; PG8_WAIT_L(0); PG8_MMA(0, 1, At, B1); PG8_BAR;
            PG8_LDA(At, 1, 1); PG8_STAGE(PG8_SA(1, 0), a3, voffA);
            PG8_BAR; PG8_WAIT_L(0); PG8_MMA(1, 0, At, B0); PG8_BAR; PG8_SCHED;
            PG8_STAGE(PG8_SB(1, 1), b3 + hstep, voffB);
            PG8_WAIT_V(6); PG8_BAR; PG8_MMA(1, 1, At, B1); PG8_BAR;
            }
        }
        if constexpr (ALIGN_EPI) { if (wr == 0) PG8_BAR; }
        if constexpr (!Epi::AFTER_DRAIN) { E(acc, cur, wr, wc, fr, fq); S.done(cur); }
        if (!has_next) break;
#pragma unroll
        for (int a = 0; a < 2; ++a)
#pragma unroll
            for (int b = 0; b < 2; ++b)
#pragma unroll
                for (int m = 0; m < 4; ++m)
#pragma unroll
                    for (int n = 0; n < 2; ++n) acc[a][b][m][n] = (f32x4){0.f, 0.f, 0.f, 0.f};
        cur = nxt; cA = nA; cB = nB; ++ui;
        if constexpr (ALIGN_EPI) { if (wr == 1) PG8_BAR; }
    }
    PG8_WAIT_V(0);
    if constexpr (!ALIGN_EPI) { if (wr == 0) PG8_BAR; }
    PG8_BAR;
    if constexpr (Epi::AFTER_DRAIN) { E.fused(acc, cur, wr, wc, fr, fq, lds, wid, lane); S.done(cur); }
#undef PG8_SA
#undef PG8_SB
#undef PG8_STAGE
#undef PG8_LDA
#undef PG8_LDB
#undef PG8_MMA
#undef PG8_WAIT_V
#undef PG8_WAIT_L
#undef PG8_BAR
#undef PG8_SCHED
}
}

constexpr size_t MiB = 1u << 20;
constexpr size_t WS_CTL = 0, CTL_ZERO_BYTES = 262144;
constexpr size_t WS_MOD = 1 * MiB;
constexpr size_t WS_CS = 1 * MiB + 192 * 1024;
constexpr size_t WS_DLOG = 1 * MiB + 256 * 1024;
constexpr size_t WS_WTOUT = 2 * MiB;
constexpr size_t WS_WTIN = 18 * MiB;
constexpr size_t WS_H = 44 * MiB;
constexpr size_t WS_Z = 92 * MiB;
constexpr size_t WS_U = 248 * MiB;
constexpr size_t WS_OL = 264 * MiB;
constexpr size_t WS_CKV = 312 * MiB;
constexpr size_t WS_END = 313 * MiB;
constexpr int LDS_BYTES = 163840;
constexpr int LDS_CTLW = 163840 - 256;
constexpr int NWAVES = 8, NTHREADS = 512;

#define LAS __attribute__((address_space(3)))
typedef unsigned short bf16;
typedef float f32x4 __attribute__((ext_vector_type(4)));
typedef float f32x16 __attribute__((ext_vector_type(16)));
typedef unsigned u32x4 __attribute__((ext_vector_type(4)));
typedef unsigned u32x2 __attribute__((ext_vector_type(2)));
typedef short bf16x8 __attribute__((ext_vector_type(8)));

__device__ __forceinline__ float bf2f(unsigned short u) { return __builtin_bit_cast(float, (unsigned)u << 16); }
__device__ __forceinline__ float bflo(unsigned u) { return __builtin_bit_cast(float, u << 16); }
__device__ __forceinline__ float bfhi(unsigned u) { return __builtin_bit_cast(float, u & 0xffff0000u); }
typedef float f32x2_t_ __attribute__((ext_vector_type(2))); typedef __bf16 bf16x2_t_ __attribute__((ext_vector_type(2)));
__device__ __forceinline__ unsigned pk2(float lo, float hi) { const f32x2_t_ v = {lo, hi}; return __builtin_bit_cast(unsigned, __builtin_convertvector(v, bf16x2_t_)); }
__device__ __forceinline__ unsigned f2bf(float f) { return pk2(f, f) & 0xffffu; }
__device__ __forceinline__ float sigmoidf_(float x) { return __builtin_amdgcn_rcpf(1.0f + __builtin_amdgcn_exp2f(-1.4426950408889634f * x)); }
__device__ __forceinline__ float siluf_(float x) { return x * __builtin_amdgcn_rcpf(1.0f + __builtin_amdgcn_exp2f(-1.4426950408889634f * x)); }
__device__ __forceinline__ float dpp_add_(float v, const int ctrl_sel) {
    const int x = __builtin_bit_cast(int, v); int y;
    if (ctrl_sel == 0) y = __builtin_amdgcn_update_dpp(0, x, 0xB1, 0xf, 0xf, true);
    else if (ctrl_sel == 1) y = __builtin_amdgcn_update_dpp(0, x, 0x4E, 0xf, 0xf, true);
    else if (ctrl_sel == 2) y = __builtin_amdgcn_update_dpp(0, x, 0x141, 0xf, 0xf, true);
    else y = __builtin_amdgcn_update_dpp(0, x, 0x140, 0xf, 0xf, true);
    return v + __builtin_bit_cast(float, y);
}
__device__ __forceinline__ float wave_sum(float v) {
    v = dpp_add_(v, 0); v = dpp_add_(v, 1); v = dpp_add_(v, 2); v = dpp_add_(v, 3);
    const float r0 = __builtin_bit_cast(float, __builtin_amdgcn_readlane(__builtin_bit_cast(int, v), 0)), r1 = __builtin_bit_cast(float, __builtin_amdgcn_readlane(__builtin_bit_cast(int, v), 16));
    const float r2 = __builtin_bit_cast(float, __builtin_amdgcn_readlane(__builtin_bit_cast(int, v), 32)), r3 = __builtin_bit_cast(float, __builtin_amdgcn_readlane(__builtin_bit_cast(int, v), 48));
    return (r0 + r1) + (r2 + r3);
}

struct Params {
    const float* in[20];
    float* out; unsigned char* ws;
};
typedef const __attribute__((address_space(4))) Params* PP;

__device__ __forceinline__ int next_unit(unsigned* ctr, volatile LAS unsigned* slot, int tid) {
    __syncthreads();
    if (tid == 0) *slot = __hip_atomic_fetch_add(ctr, 1u, __ATOMIC_RELAXED, __HIP_MEMORY_SCOPE_AGENT);
    __syncthreads();
    return (int)*slot;
}
__device__ __forceinline__ int q_pop(unsigned* ctr, volatile LAS unsigned* slot, int tid, int& pend, int pf_from) {
    __syncthreads();
    if (tid == 0) { const int cur = (pend >= 0) ? pend : (int)__hip_atomic_fetch_add(ctr, 1u, __ATOMIC_RELAXED, __HIP_MEMORY_SCOPE_AGENT);
        *slot = (unsigned)cur; pend = (cur >= pf_from) ? (int)__hip_atomic_fetch_add(ctr, 1u, __ATOMIC_RELAXED, __HIP_MEMORY_SCOPE_AGENT) : -1; }
    __syncthreads();
    return (int)*slot;
}
__device__ __forceinline__ void transpose_item(const float* W, int K, int N, bf16* WT, LAS float* scr, int item, int lane) {
    const int nblk = N / 32, kb = item / nblk, nb = item % nblk, k0 = 64 * kb, n0 = 32 * nb;
    float wv[32];
    const float* wp = W + (size_t)(k0 + (lane >> 5)) * N + n0 + (lane & 31);
#pragma unroll
    for (int i = 0; i < 32; ++i) wv[i] = wp[(size_t)(2 * i) * N];
    __builtin_amdgcn_sched_barrier(0);
#pragma unroll
    for (int i = 0; i < 32; ++i) { const int kk = 2 * i + (lane >> 5); scr[kk * 33 + (lane & 31)] = wv[i]; }
    asm volatile("s_waitcnt lgkmcnt(0)" ::: "memory");
    const int c = lane & 7;
#pragma unroll
    for (int j = 0; j < 4; ++j) { const int n = (lane >> 3) + 8 * j; const LAS float* s = scr + (8 * c) * 33 + n;
        u32x4 o; o.x = pk2(s[0 * 33], s[1 * 33]); o.y = pk2(s[2 * 33], s[3 * 33]); o.z = pk2(s[4 * 33], s[5 * 33]); o.w = pk2(s[6 * 33], s[7 * 33]);
        *(u32x4*)(WT + (size_t)(n0 + n) * K + k0 + 8 * c) = o; }
    asm volatile("s_waitcnt lgkmcnt(0)" ::: "memory");
}

__device__ __forceinline__ void mod_unit(PP P, LAS float* lds, int l, int nc, int tid) {
    const float* c = P->in[5]; const float* cctx = P->in[6]; const float* aw = P->in[7] + (size_t)l * 2048 * 6144; const float* ab = P->in[8] + l * 6144;
    LAS float* sc = lds;
    LAS float* red = lds + 3 * 2048;
    for (int i = tid; i < 3 * 2048; i += NTHREADS) { const int j = i >> 11, k = i & 2047; const float v = (j == 0) ? cctx[k] : c[(j - 1) * 2048 + k]; sc[i] = siluf_(v); }
    __syncthreads();
    const int tn = tid & 7, tk = tid >> 3, n0 = nc * 32 + 4 * tn;
    float a[3][4] = {};
    for (int k8 = 0; k8 < 32; k8 += 16) {
        f32x4 w[16];
#pragma unroll
        for (int kk = 0; kk < 16; ++kk) w[kk] = *(const f32x4*)(aw + (size_t)(tk * 32 + k8 + kk) * 6144 + n0);
        __builtin_amdgcn_sched_barrier(0);
#pragma unroll
        for (int kk = 0; kk < 16; ++kk) { const int k = tk * 32 + k8 + kk;
#pragma unroll
            for (int j = 0; j < 3; ++j) { const float s = sc[j * 2048 + k]; a[j][0] += s * w[kk][0]; a[j][1] += s * w[kk][1]; a[j][2] += s * w[kk][2]; a[j][3] += s * w[kk][3]; } }
    }
#pragma unroll
    for (int j = 0; j < 3; ++j)
#pragma unroll
        for (int e = 0; e < 4; ++e) red[(tk * 8 + tn) * 12 + j * 4 + e] = a[j][e];
    __syncthreads();
    if (tid < 96) { const int tn2 = tid / 12, je = tid % 12; float s = 0.f; for (int t = 0; t < 64; ++t) s += red[(t * 8 + tn2) * 12 + je];
        const int j = je >> 2, e = je & 3, n = nc * 32 + 4 * tn2 + e;
        ((float*)(P->ws + WS_MOD))[(l * 3 + j) * 6144 + n] = s + ab[n]; }
    __syncthreads();
}

__device__ __forceinline__ void hprep_row(const float* xrow, const float* mod  , bf16* hrow, int lane) {
#pragma unroll
    for (int j = 0; j < 8; ++j) { const int c = 4 * lane + 256 * j; const f32x4 x = *(const f32x4*)(xrow + c), sh = *(const f32x4*)(mod + c), sc = *(const f32x4*)(mod + 2048 + c);
        const f32x4 h = x * (sc + 1.0f) + sh; u32x2 o; o.x = pk2(h[0], h[1]); o.y = pk2(h[2], h[3]); *(u32x2*)(hrow + c) = o; }
}
template <bool WITH_H>
__device__ __forceinline__ void ln_row_t(const bf16* vsrc, float* yrow, const float* w, const float* b, const float* modn, bf16* hrow, int lane_in) {
    int lane = lane_in; asm volatile("" : "+v"(lane));
    f32x4 v[8], pw[8], pb[8]; float s = 0.f;
#pragma unroll
    for (int j = 0; j < 8; ++j) { const u32x2 r = *(const u32x2*)(vsrc + 4 * lane + 256 * j); v[j] = (f32x4){bflo(r.x), bfhi(r.x), bflo(r.y), bfhi(r.y)}; }
#pragma unroll
    for (int j = 0; j < 8; ++j) { pw[j] = *(const f32x4*)(w + 4 * lane + 256 * j); pb[j] = *(const f32x4*)(b + 4 * lane + 256 * j); }
#pragma unroll
    for (int j = 0; j < 8; ++j) s += (v[j][0] + v[j][1]) + (v[j][2] + v[j][3]);
    const float mean = wave_sum(s) * (1.0f / 2048.0f); float q = 0.f;
#pragma unroll
    for (int j = 0; j < 8; ++j) { v[j] = v[j] - mean; q += (v[j][0] * v[j][0] + v[j][1] * v[j][1]) + (v[j][2] * v[j][2] + v[j][3] * v[j][3]); }
    const float rstd = __builtin_amdgcn_rsqf(wave_sum(q) * (1.0f / 2048.0f) + 1e-5f);
#pragma unroll
    for (int j = 0; j < 8; ++j) { v[j] = v[j] * rstd * pw[j] + pb[j]; *(f32x4*)(yrow + 4 * lane + 256 * j) = v[j]; }
    if (WITH_H) {
#pragma unroll
        for (int j = 0; j < 8; ++j) { pw[j] = *(const f32x4*)(modn + 4 * lane + 256 * j); pb[j] = *(const f32x4*)(modn + 2048 + 4 * lane + 256 * j); }
#pragma unroll
        for (int j = 0; j < 8; ++j) { const f32x4 h = v[j] * (pb[j] + 1.0f) + pw[j]; u32x2 o; o.x = pk2(h[0], h[1]); o.y = pk2(h[2], h[3]); *(u32x2*)(hrow + 4 * lane + 256 * j) = o; }
    }
}
__device__ __forceinline__ void ln_row(const bf16* vsrc, float* yrow, const float* w, const float* b, const float* modn, bf16* hrow, int lane) {
    if (hrow) ln_row_t<true>(vsrc, yrow, w, b, modn, hrow, lane); else ln_row_t<false>(vsrc, yrow, w, b, modn, hrow, lane);
}

typedef float f32x2 __attribute__((ext_vector_type(2)));
__device__ __forceinline__ void conv_unit(PP P, LAS float* lds, int l, int unit, int tid) {
    const int lane = tid & 63, wave = tid >> 6;
    const bf16* Z = (const bf16*)(P->ws + WS_Z); bf16* MIX = (bf16*)(P->ws + WS_H);
    const int t0 = unit * 32;
    int s0, s1; if (t0 < NCTX) { s0 = t0 & ~255; s1 = s0 + 256; } else { s0 = NCTX + ((t0 - NCTX) & ~2047); s1 = s0 + 2048; }
    const int tgs = __builtin_amdgcn_readfirstlane(tid >> 8);
    const int c2 = 2 * (tid & 255), tb = t0 + 16 * tgs;
    u32x4 gq[4];
#pragma unroll
    for (int k = 0; k < 4; ++k) gq[k] = *(const u32x4*)(Z + (size_t)(t0 + 4 * wave + k) * DIN + C_CG + 8 * lane);
    const float* lw = P->in[16] + l * 512 + 8 * lane; const float* lb = P->in[17] + l * 512 + 8 * lane;
    const f32x4 w0 = *(const f32x4*)lw, w1 = *(const f32x4*)(lw + 4), b0 = *(const f32x4*)lb, b1 = *(const f32x4*)(lb + 4);
    f32x2 u[46];
#pragma unroll
    for (int hb = 0; hb < 2; ++hb) {
        unsigned ra[23], rb[23];
#pragma unroll
        for (int r = 0; r < 23; ++r) { const int row = tb - 15 + 23 * hb + r; const int rc = row < s0 ? s0 : (row >= s1 ? s1 - 1 : row);
            const unsigned off = (unsigned)rc * (unsigned)(DIN * 2) + (unsigned)((C_CA + c2) * 2);
            ra[r] = *(const unsigned*)((const char*)Z + off); rb[r] = *(const unsigned*)((const char*)Z + off + (C_CB - C_CA) * 2); }
        __builtin_amdgcn_sched_barrier(0);
#pragma unroll
        for (int r = 0; r < 23; ++r) { const int row = tb - 15 + 23 * hb + r; const bool ok = (row >= s0 && row < s1);
            const f32x2 a = {bflo(ra[r]), bfhi(ra[r])}; const f32x2 g = {bflo(rb[r]), bfhi(rb[r])};
            const f32x2 v = a * g; u[23 * hb + r] = ok ? v : (f32x2){0.f, 0.f}; }
    }
    f32x2 acc[16]; const f32x2 bias = *(const f32x2*)(P->in[15] + l * 512 + c2);
#pragma unroll
    for (int i = 0; i < 16; ++i) acc[i] = bias;
    const float* cw = P->in[14] + (size_t)l * 31 * 512 + c2;
#pragma unroll
    for (int j = 0; j < 31; ++j) { const f32x2 w = *(const f32x2*)(cw + j * 512);
#pragma unroll
        for (int i = 0; i < 16; ++i) acc[i] += u[i + j] * w; }
    LAS float* yb = lds;
#pragma unroll
    for (int i = 0; i < 16; ++i) *(LAS f32x2*)(yb + (16 * tgs + i) * 512 + c2) = acc[i];
    __syncthreads();
#pragma unroll
    for (int k = 0; k < 4; ++k) { const int ti = wave * 4 + k, row = t0 + ti;
        f32x4 a = *(const LAS f32x4*)(yb + ti * 512 + 8 * lane), b = *(const LAS f32x4*)(yb + ti * 512 + 8 * lane + 4);
        float s = (a[0] + a[1]) + (a[2] + a[3]) + (b[0] + b[1]) + (b[2] + b[3]);
        const float mean = wave_sum(s) * (1.0f / 512.0f); a = a - mean; b = b - mean;
        float q = (a[0] * a[0] + a[1] * a[1]) + (a[2] * a[2] + a[3] * a[3]) + (b[0] * b[0] + b[1] * b[1]) + (b[2] * b[2] + b[3] * b[3]);
        const float rstd = __builtin_amdgcn_rsqf(wave_sum(q) * (1.0f / 512.0f) + 1e-5f);
        a = a * rstd * w0 + b0; b = b * rstd * w1 + b1;
        const u32x4 g = gq[k];
        float o[8];
        o[0] = siluf_(a[0]) * siluf_(bflo(g.x)); o[1] = siluf_(a[1]) * siluf_(bfhi(g.x)); o[2] = siluf_(a[2]) * siluf_(bflo(g.y)); o[3] = siluf_(a[3]) * siluf_(bfhi(g.y));
        o[4] = siluf_(b[0]) * siluf_(bflo(g.z)); o[5] = siluf_(b[1]) * siluf_(bfhi(g.z)); o[6] = siluf_(b[2]) * siluf_(bflo(g.w)); o[7] = siluf_(b[3]) * siluf_(bfhi(g.w));
        u32x4 w; w.x = pk2(o[0], o[1]); w.y = pk2(o[2], o[3]); w.z = pk2(o[4], o[5]); w.w = pk2(o[6], o[7]);
        *(u32x4*)(MIX + (size_t)row * D_MODEL + 1536 + 8 * lane) = w; }
}

typedef short v4i16_t __attribute__((ext_vector_type(4)));
#define SBAR __builtin_amdgcn_sched_barrier(0);
#define R0(i) (((i) & 3) + 8 * ((i) >> 2))
constexpr float ATT_C2 = 0.08838834764831845f * 1.4426950408889634f;
constexpr float LOG2E = 1.4426950408889634f;
constexpr int KROW = 272, VROW = 320, ATT_V_OFF = 64 * KROW;

__device__ __forceinline__ bf16x8 trpair(const LAS unsigned char* p, int second_off) {
    const v4i16_t lo = __builtin_amdgcn_ds_read_tr16_b64_v4i16((LAS v4i16_t*)p), hi = __builtin_amdgcn_ds_read_tr16_b64_v4i16((LAS v4i16_t*)(p + second_off));
    return (bf16x8){lo[0], lo[1], lo[2], lo[3], hi[0], hi[1], hi[2], hi[3]};
}
__device__ __forceinline__ bf16x8 pack8(float a, float b, float c, float d, float e, float f, float g, float h) {
    const u32x4 w = {pk2(a, b), pk2(c, d), pk2(e, f), pk2(g, h)}; return __builtin_bit_cast(bf16x8, w);
}
__device__ __forceinline__ void rope8(bf16x8& a, bf16x8& b, const float* cs) {
    float ra[8], rb[8];
#pragma unroll
    for (int j = 0; j < 8; ++j) { const float x1 = bf2f((unsigned short)a[j]), x2 = bf2f((unsigned short)b[j]), c = cs[2 * j], s = cs[2 * j + 1]; ra[j] = x1 * c - x2 * s; rb[j] = x2 * c + x1 * s; }
    a = pack8(ra[0], ra[1], ra[2], ra[3], ra[4], ra[5], ra[6], ra[7]); b = pack8(rb[0], rb[1], rb[2], rb[3], rb[4], rb[5], rb[6], rb[7]);
}
__device__ __forceinline__ void rope8l(bf16x8& a, bf16x8& b, const LAS float* cs) {
    const f32x4 c0 = *(const LAS f32x4*)cs, c1 = *(const LAS f32x4*)(cs + 4), c2 = *(const LAS f32x4*)(cs + 8), c3 = *(const LAS f32x4*)(cs + 12);
    const float cc[8] = {c0[0], c0[2], c1[0], c1[2], c2[0], c2[2], c3[0], c3[2]}, sn[8] = {c0[1], c0[3], c1[1], c1[3], c2[1], c2[3], c3[1], c3[3]};
    float ra[8], rb[8];
#pragma unroll
    for (int j = 0; j < 8; ++j) { const float x1 = bf2f((unsigned short)a[j]), x2 = bf2f((unsigned short)b[j]); ra[j] = x1 * cc[j] - x2 * sn[j]; rb[j] = x2 * cc[j] + x1 * sn[j]; }
    a = pack8(ra[0], ra[1], ra[2], ra[3], ra[4], ra[5], ra[6], ra[7]); b = pack8(rb[0], rb[1], rb[2], rb[3], rb[4], rb[5], rb[6], rb[7]);
}
__device__ __forceinline__ bf16x8 cvt8(const float* p) {
    const f32x4 a = *(const f32x4*)p, b = *(const f32x4*)(p + 4);
    return pack8(a[0], a[1], a[2], a[3], b[0], b[1], b[2], b[3]);
}

typedef _Float16 f16x8_t_ __attribute__((ext_vector_type(8)));
__device__ __forceinline__ void rope8h(u32x4& a, u32x4& b, const LAS unsigned char* cs) {
    const f16x8_t_ t0 = *(const LAS f16x8_t_*)cs, t1 = *(const LAS f16x8_t_*)(cs + 16);
    float ra[8], rb[8];
#pragma unroll
    for (int j = 0; j < 8; ++j) { const unsigned wa = a[j >> 1], wb = b[j >> 1]; const float x1 = (j & 1) ? bfhi(wa) : bflo(wa), x2 = (j & 1) ? bfhi(wb) : bflo(wb);
        const float c = (float)((j < 4) ? t0[2 * j] : t1[2 * (j - 4)]), sn = (float)((j < 4) ? t0[2 * j + 1] : t1[2 * (j - 4) + 1]);
        ra[j] = x1 * c - x2 * sn; rb[j] = x2 * c + x1 * sn; }
    a = (u32x4){pk2(ra[0], ra[1]), pk2(ra[2], ra[3]), pk2(ra[4], ra[5]), pk2(ra[6], ra[7])}; b = (u32x4){pk2(rb[0], rb[1]), pk2(rb[2], rb[3]), pk2(rb[4], rb[5]), pk2(rb[6], rb[7])};
}
constexpr int AT_BUF = 75776, AT_V = 34816, AT_ROPE = 151552;
__device__ __forceinline__ void attn_tile(const LAS unsigned char* kt, const LAS unsigned char* vt, const bf16x8 (&qf)[8], f32x16 (&O)[4], float& m, float& lsum,
                                          bool local, int tk0, int qpos, int lane) {
    const int r32 = lane & 31, hh = lane >> 5, i16 = lane & 15;
    f32x16 p0, p1;
#pragma unroll
    for (int i = 0; i < 16; ++i) { p0[i] = 0.f; p1[i] = 0.f; }
    const LAS unsigned char* kb = kt + r32 * KROW + 16 * hh;
#pragma unroll
    for (int s = 0; s < 8; ++s) { const bf16x8 kf0 = *(const LAS bf16x8*)(kb + 32 * s), kf1 = *(const LAS bf16x8*)(kb + 32 * KROW + 32 * s);
        p0 = __builtin_amdgcn_mfma_f32_32x32x16_bf16(kf0, qf[s], p0, 0, 0, 0); p1 = __builtin_amdgcn_mfma_f32_32x32x16_bf16(kf1, qf[s], p1, 0, 0, 0); }
    const LAS unsigned char* vb = vt + (4 * hh + (i16 >> 2)) * VROW + (16 * ((lane >> 4) & 1) + 4 * (i16 & 3)) * 2;
    bf16x8 vfa[4], vfb[4];
#pragma unroll
    for (int ks = 0; ks < 4; ++ks) vfa[ks] = trpair(vb + (16 * ks) * VROW, 8 * VROW);
    float mx = -3e38f;
    if (local) { const unsigned mb = (unsigned)(qpos - tk0 - 4 * hh + 128);
#pragma unroll
        for (int i = 0; i < 16; ++i) { const unsigned d0 = mb - (unsigned)R0(i), d1 = d0 - 32u;
            p0[i] = (d0 <= 256u) ? p0[i] : -1e30f; p1[i] = (d1 <= 256u) ? p1[i] : -1e30f; } }
#pragma unroll
    for (int i = 0; i < 16; ++i) mx = fmaxf(mx, fmaxf(p0[i], p1[i]));
    mx = fmaxf(mx, __shfl_xor(mx, 32)) * ATT_C2;
    const float mn = fmaxf(m, mx), alpha = __builtin_amdgcn_exp2f(m - mn); m = mn;
    float ps = 0.f;
#pragma unroll
    for (int i = 0; i < 16; ++i) { p0[i] = __builtin_amdgcn_exp2f(__builtin_fmaf(p0[i], ATT_C2, -mn)); p1[i] = __builtin_amdgcn_exp2f(__builtin_fmaf(p1[i], ATT_C2, -mn)); ps += p0[i] + p1[i]; }
    lsum = lsum * alpha + ps;
    if (__builtin_amdgcn_ballot_w64(alpha != 1.0f) != 0ull) {
#pragma unroll
        for (int d = 0; d < 4; ++d)
#pragma unroll
            for (int i = 0; i < 16; ++i) O[d][i] *= alpha;
    }
    bf16x8 pb[4];
#pragma unroll
    for (int s = 0; s < 2; ++s) { pb[s] = pack8(p0[8 * s], p0[8 * s + 1], p0[8 * s + 2], p0[8 * s + 3], p0[8 * s + 4], p0[8 * s + 5], p0[8 * s + 6], p0[8 * s + 7]);
        pb[2 + s] = pack8(p1[8 * s], p1[8 * s + 1], p1[8 * s + 2], p1[8 * s + 3], p1[8 * s + 4], p1[8 * s + 5], p1[8 * s + 6], p1[8 * s + 7]); }
#pragma unroll
    for (int dt = 0; dt < 4; ++dt) {
        if (dt + 1 < 4) {
#pragma unroll
            for (int ks = 0; ks < 4; ++ks) { const bf16x8 t_ = trpair(vb + (16 * ks) * VROW + 64 * (dt + 1), 8 * VROW); if (dt & 1) vfa[ks] = t_; else vfb[ks] = t_; }
        }
#pragma unroll
        for (int ks = 0; ks < 4; ++ks) O[dt] = __builtin_amdgcn_mfma_f32_32x32x16_bf16((dt & 1) ? vfb[ks] : vfa[ks], pb[ks], O[dt], 0, 0, 0);
    }
}
__device__ __forceinline__ void attn_unit(PP P, LAS unsigned char* lds, int l, int kind, int idx, int tid) {
    const int lane = tid & 63, wave = __builtin_amdgcn_readfirstlane(tid >> 6), r32 = lane & 31, hh = lane >> 5;
    const bf16* Z = (const bf16*)(P->ws + WS_Z); bf16* MIX = (bf16*)(P->ws + WS_H); const float* CS = (const float*)(P->ws + WS_CS); const bf16* CKV = (const bf16*)(P->ws + WS_CKV);
    int b, h, qpos0, grow0, kpos0, klrow0, nls, ncs;
    if (kind == 0) { b = idx >> 3; h = idx & 7; qpos0 = 0; grow0 = b * 256; kpos0 = 0; klrow0 = b * 256; nls = 2; ncs = 0; }
    else { const int qb = idx & 7; h = (idx >> 3) & 7; b = idx >> 6; qpos0 = qb * 256; grow0 = NCTX + b * 2048 + qpos0;
        kpos0 = qpos0 - 128 < 0 ? 0 : qpos0 - 128; const int kend = qpos0 + 384 > 2048 ? 2048 : qpos0 + 384; nls = (kend - kpos0) >> 7; klrow0 = NCTX + b * 2048 + kpos0; ncs = 2; }
    const bool lat = (kind == 1);
    const int kv = h >> 2;
    if (lat) {
#pragma unroll
        for (int k = 0; k < 4; ++k) { const int e = tid + 512 * k; const float c = CS[2 * e], sn = CS[2 * e + 1];
            typedef _Float16 h2_ __attribute__((ext_vector_type(2))); const h2_ hv = {(_Float16)c, (_Float16)sn}; *(LAS unsigned*)(lds + AT_ROPE + 4 * e) = __builtin_bit_cast(unsigned, hv); }
    }
    const int qrow = grow0 + 32 * wave + r32, qpos = qpos0 + 32 * wave + r32, qw0 = qpos0 + 32 * wave;
    bf16x8 qf[8];
    { const bf16* qp = Z + (size_t)qrow * DIN + C_AQ + h * 128 + 8 * hh;
#pragma unroll
      for (int s = 0; s < 8; ++s) qf[s] = *(const bf16x8*)(qp + 16 * s);
      if (lat) { const float* c0 = CS + ((qpos >> 6) * 32 + 8 * hh) * 2; const float* c1 = CS + ((qpos & 63) * 32 + 8 * hh) * 2;
          rope8(qf[0], qf[2], c0); rope8(qf[1], qf[3], c0 + 32); rope8(qf[4], qf[6], c1); rope8(qf[5], qf[7], c1 + 32); } }
    f32x16 O[4];
#pragma unroll
    for (int d = 0; d < 4; ++d)
#pragma unroll
        for (int i = 0; i < 16; ++i) O[d][i] = 0.f;
    float m = P->in[11][l * 8 + h] * LOG2E, lsum = (hh == 0) ? 1.0f : 0.0f;
    const int skey = tid >> 2, sub = tid & 3;
    const int nst = nls + ncs;
    u32x4 rr[8];
#define ATT_ISSUE(ST) do { const int st_ = (ST); const bf16* kp_; const bf16* vp_; \
        if (st_ < nls) { const int krow = klrow0 + 128 * st_ + skey; kp_ = Z + (size_t)krow * DIN + C_AK + kv * 128 + 8 * sub; vp_ = kp_ + (C_AV - C_AK); } \
        else { const int key = 128 * (st_ - nls) + skey; kp_ = CKV + ((size_t)((b * 2 + l) * 256 + key) * 2 + kv) * 128 + 8 * sub; vp_ = kp_ + 262144; } \
        rr[0] = *(const u32x4*)kp_; rr[1] = *(const u32x4*)(kp_ + 32); rr[2] = *(const u32x4*)(kp_ + 64); rr[3] = *(const u32x4*)(kp_ + 96); \
        rr[4] = *(const u32x4*)vp_; rr[5] = *(const u32x4*)(vp_ + 32); rr[6] = *(const u32x4*)(vp_ + 64); rr[7] = *(const u32x4*)(vp_ + 96); } while (0)
#define ATT_WRITE(ST) do { const int st_ = (ST); \
        if (lat && st_ < nls) { const int kpos = kpos0 + 128 * st_ + skey; \
            rope8h(rr[0], rr[1], lds + AT_ROPE + ((kpos >> 6) * 32 + 8 * sub) * 4); rope8h(rr[2], rr[3], lds + AT_ROPE + ((kpos & 63) * 32 + 8 * sub) * 4); } \
        LAS unsigned char* kd_ = lds + (st_ & 1) * AT_BUF + skey * KROW + 16 * sub; LAS unsigned char* vd_ = lds + (st_ & 1) * AT_BUF + AT_V + skey * VROW + 16 * sub; \
        *(LAS u32x4*)kd_ = rr[0]; *(LAS u32x4*)(kd_ + 64) = rr[1]; *(LAS u32x4*)(kd_ + 128) = rr[2]; *(LAS u32x4*)(kd_ + 192) = rr[3]; \
        *(LAS u32x4*)vd_ = rr[4]; *(LAS u32x4*)(vd_ + 64) = rr[5]; *(LAS u32x4*)(vd_ + 128) = rr[6]; *(LAS u32x4*)(vd_ + 192) = rr[7]; } while (0)
    if (lat) { ATT_ISSUE(0); __syncthreads();
        ATT_WRITE(0); }
    else {
        u32x4 r2[8];
        { const bf16* kp_ = Z + (size_t)(klrow0 + skey) * DIN + C_AK + kv * 128 + 8 * sub; const bf16* vp_ = kp_ + (C_AV - C_AK); const bf16* kq_ = kp_ + (size_t)128 * DIN; const bf16* vq_ = vp_ + (size_t)128 * DIN;
          rr[0] = *(const u32x4*)kp_; rr[1] = *(const u32x4*)(kp_ + 32); rr[2] = *(const u32x4*)(kp_ + 64); rr[3] = *(const u32x4*)(kp_ + 96);
          rr[4] = *(const u32x4*)vp_; rr[5] = *(const u32x4*)(vp_ + 32); rr[6] = *(const u32x4*)(vp_ + 64); rr[7] = *(const u32x4*)(vp_ + 96);
          r2[0] = *(const u32x4*)kq_; r2[1] = *(const u32x4*)(kq_ + 32); r2[2] = *(const u32x4*)(kq_ + 64); r2[3] = *(const u32x4*)(kq_ + 96);
          r2[4] = *(const u32x4*)vq_; r2[5] = *(const u32x4*)(vq_ + 32); r2[6] = *(const u32x4*)(vq_ + 64); r2[7] = *(const u32x4*)(vq_ + 96); }
        ATT_WRITE(0);
#pragma unroll
        for (int e = 0; e < 8; ++e) rr[e] = r2[e];
        ATT_WRITE(1);
    }
    __syncthreads();
    for (int st = 0; st < nst; ++st) {
        const bool more = lat && (st + 1 < nst);
        if (more) ATT_ISSUE(st + 1);
        const bool local = lat && (st < nls);
        const LAS unsigned char* kt = lds + (st & 1) * AT_BUF; const LAS unsigned char* vt = kt + AT_V;
#pragma unroll
        for (int t2 = 0; t2 < 2; ++t2) {
            const int tk0 = kpos0 + 128 * st + 64 * t2;
            bool skip = false;
            if (local) skip = (tk0 > qw0 + 31 + 128) || (tk0 + 63 < qw0 - 128);
            if (!skip) attn_tile(kt + t2 * 64 * KROW, vt + t2 * 64 * VROW, qf, O, m, lsum, local, tk0, qpos, lane);
        }
        if (more) ATT_WRITE(st + 1);
        if (lat) __syncthreads();
    }
    const float ltot = lsum + __shfl_xor(lsum, 32), inv = __builtin_amdgcn_rcpf(ltot);
    const bf16* gp = Z + (size_t)qrow * DIN + C_AG + h * 128 + 4 * hh; bf16* op = MIX + (size_t)qrow * D_MODEL + h * 128 + 4 * hh;
    u32x2 gg[16];
#pragma unroll
    for (int e = 0; e < 16; ++e) gg[e] = *(const u32x2*)(gp + 32 * (e >> 2) + 8 * (e & 3));
    __builtin_amdgcn_sched_barrier(0);
#pragma unroll
    for (int dt = 0; dt < 4; ++dt)
#pragma unroll
        for (int i4 = 0; i4 < 4; ++i4) { const int d0 = 32 * dt + 8 * i4; const u32x2 g = gg[dt * 4 + i4];
            const float o0 = O[dt][4 * i4 + 0] * inv * siluf_(bflo(g.x)), o1 = O[dt][4 * i4 + 1] * inv * siluf_(bfhi(g.x));
            const float o2 = O[dt][4 * i4 + 2] * inv * siluf_(bflo(g.y)), o3 = O[dt][4 * i4 + 3] * inv * siluf_(bfhi(g.y));
            u32x2 w; w.x = pk2(o0, o1); w.y = pk2(o2, o3); *(u32x2*)(op + d0) = w; }
#undef ATT_ISSUE
#undef ATT_WRITE
}

__device__ __forceinline__ void hg_oml8(PP P, int l, int dir, int hd0, float (&oml)[8]) {
    const float* hb = P->in[12] + dir * 1024 + hd0;
    const f32x4 a0 = *(const f32x4*)hb, a1 = *(const f32x4*)(hb + 4), b0 = *(const f32x4*)(hb + 512), b1 = *(const f32x4*)(hb + 516);
#pragma unroll
    for (int j = 0; j < 4; ++j) { const float s0 = sigmoidf_(b0[j] - a0[j]), s1 = sigmoidf_(b1[j] - a1[j]); oml[j] = l ? 1.0f - s0 : 1.0f; oml[4 + j] = l ? 1.0f - s1 : 1.0f; }
}
constexpr int H2_TG = 0, H2_QE = 16896, H2_KE = 25600, H2_QG = 34304, H2_KG = 42752, H2_V = 52992, H2_OBA = 63232, H2_OBB = 80128, H2_DK = 97024;
constexpr size_t WS_DLC_OFF = 0;
#ifndef PROBE_SEC
#define PROBE_SEC -1
#endif
#if PROBE_SEC >= 0
#define PSEC_DECL unsigned long long ps_acc_ = 0ull, ps_t_ = 0ull;
#define PSEC_START(n) if (PROBE_SEC == n) ps_t_ = __builtin_amdgcn_s_memrealtime();
#define PSEC_END(n) if (PROBE_SEC == n) ps_acc_ += __builtin_amdgcn_s_memrealtime() - ps_t_;
#define PSEC_CLOSE(n) if (PROBE_SEC == n) { __syncthreads(); ps_acc_ += __builtin_amdgcn_s_memrealtime() - ps_t_; }
#define PSEC_FLUSH(cnt) if (kind == 0 && tid == 0) { atomicAdd((unsigned long long*)((unsigned*)(P->ws + WS_CTL) + 60000), ps_acc_); atomicAdd((unsigned*)(P->ws + WS_CTL) + 60002, (unsigned)(cnt)); }
#else
#define PSEC_DECL
#define PSEC_START(n)
#define PSEC_END(n)
#define PSEC_CLOSE(n)
#define PSEC_FLUSH(cnt)
#endif
__device__ __forceinline__ void hgrn2_unit(PP P, LAS unsigned char* lds, int l, int kind, int idx, int tid) {
    const int lane = tid & 63, wave = __builtin_amdgcn_readfirstlane(tid >> 6), r32 = lane & 31, hh = lane >> 5, i16 = lane & 15, cg = (lane >> 4) & 1;
    const bf16* Z = (const bf16*)(P->ws + WS_Z); bf16* MIX = (bf16*)(P->ws + WS_H); float* OL = (float*)(P->ws + WS_OL);
    LAS float* ldsf = (LAS float*)lds;
    int h, row0, seglen, nch, b = 0;
    if (kind == 0) { b = idx >> 2; h = idx & 3; row0 = b * 256; seglen = 256; nch = 8; }
    else { const int blk = idx & 15; h = (idx >> 4) & 3; const int lb = idx >> 6; row0 = NCTX + lb * 2048 + blk * 128; seglen = 128; nch = 4; }
    const int ti = tid >> 4, d0 = 8 * (tid & 15), nt = wave & 3, kp = wave >> 2;
    PSEC_DECL
    const f32x4 n0 = *(const f32x4*)(P->in[13] + l * 512 + h * 128 + d0), n1 = *(const f32x4*)(P->in[13] + l * 512 + h * 128 + d0 + 4);
    for (int dir = 0; dir < 2; ++dir) {
        const int cf = dir ? C_HFB : C_HFF;
        f32x16 S0, S1;
#pragma unroll
        for (int i = 0; i < 16; ++i) { S0[i] = 0.f; S1[i] = 0.f; }
        const int uidx = (kind == 1) ? ((idx >> 4) * 2 + dir) * 16 + (idx & 15) : 0;
        float gtot = 0.f;
        u32x4 uq, uv, uf;
        { const int row = dir ? row0 + seglen - 1 - ti : row0 + ti; const bf16* zr = Z + (size_t)row * DIN + h * 128 + d0;
          uq = *(const u32x4*)(zr + C_HQ); uv = *(const u32x4*)(zr + C_HI); uf = *(const u32x4*)(zr + cf); }
        for (int c = 0; c < nch; ++c) {
            PSEC_START(0)
            const int nc = dir ? nch - 1 - c : c; const int rown = row0 + 32 * nc + ti;
            f32x4 olp0 = {0.f, 0.f, 0.f, 0.f}, olp1 = {0.f, 0.f, 0.f, 0.f}; u32x4 ug = {0u, 0u, 0u, 0u};
            float* olr = OL + (size_t)rown * 512 + h * 128 + d0;
            if (dir == 1) { olp0 = *(const f32x4*)olr; olp1 = *(const f32x4*)(olr + 4); if (kind == 0) ug = *(const u32x4*)(Z + (size_t)rown * DIN + C_HG + h * 128 + d0); }
            float q[8], kk[8];
            {
                float g2[8], vv[8];
#pragma unroll
                for (int j = 0; j < 4; ++j) { const unsigned wq = uq[j], wv = uv[j], wf = uf[j];
                    q[2 * j] = bflo(wq); q[2 * j + 1] = bfhi(wq);
                    vv[2 * j] = bflo(wv); vv[2 * j + 1] = bfhi(wv);
                    g2[2 * j] = bflo(wf); g2[2 * j + 1] = bfhi(wf); }
#pragma unroll
                for (int j = 0; j < 8; ++j) kk[j] = 1.0f - __builtin_amdgcn_exp2f(g2[j]);
                LAS float* pg = ldsf + (H2_TG >> 2) + ti * 132 + d0;
                *(LAS f32x4*)pg = (f32x4){g2[0], g2[1], g2[2], g2[3]}; *(LAS f32x4*)(pg + 4) = (f32x4){g2[4], g2[5], g2[6], g2[7]};
                *(LAS u32x4*)(lds + H2_V + ti * 320 + d0 * 2) = uv;
            }
            if (c + 1 < nch) { const int tl = 32 * (c + 1) + ti; const int row = dir ? row0 + seglen - 1 - tl : row0 + tl; const bf16* zr = Z + (size_t)row * DIN + h * 128 + d0;
                uq = *(const u32x4*)(zr + C_HQ); uv = *(const u32x4*)(zr + C_HI); uf = *(const u32x4*)(zr + cf); }
            __syncthreads();
            PSEC_END(0) PSEC_START(1)
            if (tid < 128) {
                LAS float* gc = ldsf + (H2_TG >> 2) + tid; float run = 0.f; float gv[32];
#pragma unroll
                for (int i = 0; i < 32; ++i) gv[i] = gc[i * 132];
                SBAR
#pragma unroll
                for (int i = 0; i < 32; ++i) { run += gv[i]; gc[i * 132] = run; }
                ldsf[(H2_DK >> 2) + tid] = __builtin_amdgcn_exp2f(run);
                if (kind == 1) ((float*)(P->ws + WS_DLOG))[(uidx * 4 + c) * 128 + tid] = run;
                gtot += run;
            }
            __syncthreads();
            PSEC_END(1) PSEC_START(2)
            {
                const LAS float* gr = ldsf + (H2_TG >> 2) + ti * 132 + d0; const LAS float* gm = ldsf + (H2_TG >> 2) + 15 * 132 + d0; const LAS float* gl = ldsf + (H2_TG >> 2) + 31 * 132 + d0;
                float qe[8], ke[8], qg[8], kg[8];
#pragma unroll
                for (int j = 0; j < 8; ++j) { const float G = gr[j], Gm = gm[j], Gl = gl[j];
                    qe[j] = q[j] * __builtin_amdgcn_exp2f(fminf(G - Gm, 100.f)); ke[j] = kk[j] * __builtin_amdgcn_exp2f(fminf(Gm - G, 100.f));
                    qg[j] = q[j] * __builtin_amdgcn_exp2f(G); kg[j] = kk[j] * __builtin_amdgcn_exp2f(Gl - G); }
                *(LAS bf16x8*)(lds + H2_QE + ti * 272 + d0 * 2) = pack8(qe[0], qe[1], qe[2], qe[3], qe[4], qe[5], qe[6], qe[7]);
                *(LAS bf16x8*)(lds + H2_KE + ti * 272 + d0 * 2) = pack8(ke[0], ke[1], ke[2], ke[3], ke[4], ke[5], ke[6], ke[7]);
                *(LAS bf16x8*)(lds + H2_KG + ti * 320 + d0 * 2) = pack8(kg[0], kg[1], kg[2], kg[3], kg[4], kg[5], kg[6], kg[7]);
                u32x2 w0, w1; w0.x = pk2(qg[0], qg[1]); w0.y = pk2(qg[2], qg[3]); w1.x = pk2(qg[4], qg[5]); w1.y = pk2(qg[6], qg[7]);
                *(LAS u32x2*)(lds + H2_QG + ti * 264 + d0 * 2) = w0; *(LAS u32x2*)(lds + H2_QG + ti * 264 + d0 * 2 + 8) = w1;
            }
            __syncthreads();
            PSEC_END(2) PSEC_START(3)
            {
                f32x16 at;
#pragma unroll
                for (int i = 0; i < 16; ++i) at[i] = 0.f;
                const LAS unsigned char* kep = lds + H2_KE + r32 * 272 + 16 * hh; const LAS unsigned char* qep = lds + H2_QE + r32 * 272 + 16 * hh;
#pragma unroll
                for (int k = 0; k < 8; ++k) at = __builtin_amdgcn_mfma_f32_32x32x16_bf16(*(const LAS bf16x8*)(kep + 32 * k), *(const LAS bf16x8*)(qep + 32 * k), at, 0, 0, 0);
                float am[8];
#pragma unroll
                for (int j = 0; j < 8; ++j) { const float lo = at[j], hi = at[8 + j]; const float v = kp ? hi : lo; const int s = 16 * kp + 8 * (j >> 2) + 4 * hh + (j & 3); am[j] = (s <= r32) ? v : 0.f; }
                const bf16x8 afrag = pack8(am[0], am[1], am[2], am[3], am[4], am[5], am[6], am[7]);
                f32x16 ot;
#pragma unroll
                for (int i = 0; i < 16; ++i) ot[i] = 0.f;
                { const bf16x8 vfrag = trpair(lds + H2_V + (16 * kp + 4 * hh + (i16 >> 2)) * 320 + (32 * nt + 16 * cg + 4 * (i16 & 3)) * 2, 8 * 320);
                  ot = __builtin_amdgcn_mfma_f32_32x32x16_bf16(vfrag, afrag, ot, 0, 0, 0); }
                const LAS unsigned char* qgp = lds + H2_QG + r32 * 264 + (64 * kp + 4 * hh) * 2;
#pragma unroll
                for (int kl = 0; kl < 2; ++kl)
#pragma unroll
                    for (int sp = 0; sp < 2; ++sp) {
                        const u32x2 qlo = *(const LAS u32x2*)(qgp + (32 * kl + 16 * sp) * 2), qhi = *(const LAS u32x2*)(qgp + (32 * kl + 16 * sp) * 2 + 16);
                        const u32x4 qq = {qlo.x, qlo.y, qhi.x, qhi.y};
                        bf16x8 sfrag;
                        if (kl == 0) sfrag = pack8(S0[8 * sp], S0[8 * sp + 1], S0[8 * sp + 2], S0[8 * sp + 3], S0[8 * sp + 4], S0[8 * sp + 5], S0[8 * sp + 6], S0[8 * sp + 7]);
                        else sfrag = pack8(S1[8 * sp], S1[8 * sp + 1], S1[8 * sp + 2], S1[8 * sp + 3], S1[8 * sp + 4], S1[8 * sp + 5], S1[8 * sp + 6], S1[8 * sp + 7]);
                        ot = __builtin_amdgcn_mfma_f32_32x32x16_bf16(sfrag, __builtin_bit_cast(bf16x8, qq), ot, 0, 0, 0);
                    }
                { LAS float* ob = ldsf + ((kp ? H2_OBB : H2_OBA) >> 2) + (32 * nt + 4 * hh) * 33 + r32;
#pragma unroll
                  for (int i = 0; i < 16; ++i) ob[R0(i) * 33] = ot[i]; }
                const LAS float* dkp = ldsf + (H2_DK >> 2) + 64 * kp + 4 * hh;
#pragma unroll
                for (int i = 0; i < 16; ++i) { S0[i] *= dkp[R0(i)]; S1[i] *= dkp[32 + R0(i)]; }
#pragma unroll
                for (int ks = 0; ks < 2; ++ks) {
                    const int roff = (16 * ks + 8 * hh + (i16 >> 2)) * 320, coff = (16 * cg + 4 * (i16 & 3)) * 2;
                    const bf16x8 vf = trpair(lds + H2_V + roff + 64 * nt + coff, 4 * 320);
                    const bf16x8 k0 = trpair(lds + H2_KG + roff + 64 * (2 * kp) + coff, 4 * 320), k1 = trpair(lds + H2_KG + roff + 64 * (2 * kp + 1) + coff, 4 * 320);
                    S0 = __builtin_amdgcn_mfma_f32_32x32x16_bf16(k0, vf, S0, 0, 0, 0); S1 = __builtin_amdgcn_mfma_f32_32x32x16_bf16(k1, vf, S1, 0, 0, 0);
                }
            }
            __syncthreads();
            PSEC_END(3) PSEC_START(4)
            {
                const int t = dir ? 31 - ti : ti;
                const LAS float* oa = ldsf + (H2_OBA >> 2) + d0 * 33 + t; const LAS float* obb = ldsf + (H2_OBB >> 2) + d0 * 33 + t;
                float o[8];
#pragma unroll
                for (int j = 0; j < 8; ++j) o[j] = oa[j * 33] + obb[j * 33];
                if (dir == 1) { o[0] += olp0[0]; o[1] += olp0[1]; o[2] += olp0[2]; o[3] += olp0[3]; o[4] += olp1[0]; o[5] += olp1[1]; o[6] += olp1[2]; o[7] += olp1[3]; }
                if (dir == 0 || kind == 1) { *(f32x4*)olr = (f32x4){o[0], o[1], o[2], o[3]}; *(f32x4*)(olr + 4) = (f32x4){o[4], o[5], o[6], o[7]}; }
                else {
                    float ss = 0.f;
#pragma unroll
                    for (int j = 0; j < 8; ++j) ss += o[j] * o[j];
                    ss += __shfl_xor(ss, 1); ss += __shfl_xor(ss, 2); ss += __shfl_xor(ss, 4); ss += __shfl_xor(ss, 8);
                    const float r = __builtin_amdgcn_rsqf(ss * (1.0f / 128.0f) + 1e-6f);
                    u32x4 w;
                    w.x = pk2(o[0] * r * n0[0] * siluf_(bflo(ug.x)), o[1] * r * n0[1] * siluf_(bfhi(ug.x))); w.y = pk2(o[2] * r * n0[2] * siluf_(bflo(ug.y)), o[3] * r * n0[3] * siluf_(bfhi(ug.y)));
                    w.z = pk2(o[4] * r * n1[0] * siluf_(bflo(ug.z)), o[5] * r * n1[1] * siluf_(bfhi(ug.z))); w.w = pk2(o[6] * r * n1[2] * siluf_(bflo(ug.w)), o[7] * r * n1[3] * siluf_(bfhi(ug.w)));
                    *(u32x4*)(MIX + (size_t)rown * D_MODEL + 1024 + h * 128 + d0) = w;
                }
            }
            PSEC_CLOSE(4)
        }
        if (kind == 1 && tid < 128) ((float*)(P->ws + WS_DLOG) + 131072)[uidx * 128 + tid] = gtot;
        {
            float* Sd = (kind == 0) ? P->out + OUT_ST + (size_t)((((b * 2 + l) * 2 + dir) * 4 + h)) * 16384 : (float*)(P->ws + WS_U) + (size_t)uidx * 16384;
            float* sp = Sd + (64 * kp + 4 * hh) * 128 + 32 * nt + r32;
#pragma unroll
            for (int i = 0; i < 16; ++i) { sp[R0(i) * 128] = S0[i]; sp[(32 + R0(i)) * 128] = S1[i]; }
        }
    }
    PSEC_FLUSH(2 * nch)
}

__device__ __forceinline__ void hgrn_scan_unit(PP P, int l, int su, int tid) {
    float* U = (float*)(P->ws + WS_U); const float* DLB = (const float*)(P->ws + WS_DLOG) + 131072;
#pragma unroll 1
    for (int k = 0; k < 4; ++k) {
        const int e = su * 2048 + tid + 512 * k;
        const int sq = e >> 14, el = e & 16383, dk = el >> 7, lb = sq >> 3, h = (sq >> 1) & 3, dir = sq & 1;
        float S = P->in[4][(size_t)((((lb * 2 + l) * 2 + dir) * 4 + h)) * 16384 + el];
        float u[16], dl[16];
        const long ustep = dir ? -16384 : 16384, dstep = dir ? -128 : 128;
        float* up = U + (size_t)(sq * 16 + (dir ? 15 : 0)) * 16384 + el; const float* dp = DLB + (sq * 16 + (dir ? 15 : 0)) * 128 + dk;
        { float* uq = up; const float* dq = dp;
#pragma unroll
          for (int p = 0; p < 16; ++p) { u[p] = *uq; dl[p] = *dq; uq += ustep; dq += dstep; asm volatile("" : "+v"(uq), "+v"(dq)); } }
        SBAR
        { float* uq = up;
#pragma unroll
          for (int p = 0; p < 16; ++p) { *uq = S; S = __builtin_amdgcn_exp2f(dl[p]) * S + u[p]; uq += ustep; asm volatile("" : "+v"(uq)); } }
    }
}

constexpr int HF_S0 = 0, HF_S1 = 40960, HF_TG0 = 81920, HF_TG1 = 98816, HF_QG0 = 115712, HF_QG1 = 124416;
__device__ __forceinline__ void hgrn_final_unit(PP P, LAS unsigned char* lds, int l, int idx, int half_sel, int tid) {
    const int lane = tid & 63, wave = __builtin_amdgcn_readfirstlane(tid >> 6), r32 = lane & 31, hh = lane >> 5, i16 = lane & 15, cg = (lane >> 4) & 1;
    const bf16* Z = (const bf16*)(P->ws + WS_Z); bf16* MIX = (bf16*)(P->ws + WS_H); const float* OL = (const float*)(P->ws + WS_OL); const float* DLC = (const float*)(P->ws + WS_DLOG);
    LAS float* ldsf = (LAS float*)lds;
    const int blk = idx & 15, h = (idx >> 4) & 3, lb = idx >> 6, row0 = NCTX + lb * 2048 + blk * 128;
    const int ti = tid >> 4, d0 = 8 * (tid & 15), nt = wave & 3, ds = wave >> 2;
    const int uidx0 = ((idx >> 4) * 2 + 0) * 16 + blk, uidx1 = ((idx >> 4) * 2 + 1) * 16 + blk;
    {
        const float* Ug = (const float*)(P->ws + WS_U); const float* DLB = (const float*)(P->ws + WS_DLOG) + 131072;
        const int eoff = (tid >> 5) * 128 + (tid & 31) * 4, dk0 = tid >> 5;
        for (int dsel = 0; dsel < 2; ++dsel) {
            const int pcnt = dsel ? 15 - blk : blk, ub = ((idx >> 4) * 2 + dsel) * 16;
            f32x4 S[8];
            { const float* s0p = P->in[4] + (size_t)((((lb * 2 + l) * 2 + dsel) * 4 + h)) * 16384 + eoff;
#pragma unroll
              for (int k = 0; k < 8; ++k) S[k] = *(const f32x4*)(s0p + 16 * k * 128); }
            for (int j = 0; j < pcnt; j += 3) {
                f32x4 uv[3][8]; float dl[3][8];
#pragma unroll
                for (int jj = 0; jj < 3; ++jj) { const int jc = (j + jj < pcnt) ? j + jj : pcnt - 1; const int b2 = dsel ? 15 - jc : jc;
                    const float* up = Ug + (size_t)(ub + b2) * 16384 + eoff; const float* dp = DLB + (ub + b2) * 128 + dk0;
#pragma unroll
                    for (int k = 0; k < 8; ++k) { uv[jj][k] = *(const f32x4*)(up + 16 * k * 128); dl[jj][k] = dp[16 * k]; } }
                SBAR
#pragma unroll
                for (int jj = 0; jj < 3; ++jj) { const bool ok = (j + jj < pcnt);
#pragma unroll
                    for (int k = 0; k < 8; ++k) { const float dcy = ok ? __builtin_amdgcn_exp2f(dl[jj][k]) : 1.0f; const f32x4 add = ok ? uv[jj][k] : (f32x4){0.f, 0.f, 0.f, 0.f}; S[k] = S[k] * dcy + add; } }
            }
#pragma unroll
            for (int k = 0; k < 8; ++k) { u32x2 w; w.x = pk2(S[k][0], S[k][1]); w.y = pk2(S[k][2], S[k][3]); *(LAS u32x2*)(lds + (dsel ? HF_S1 : HF_S0) + (dk0 + 16 * k) * 320 + (tid & 31) * 8) = w; }
        }
    }
    const f32x4 n0 = *(const f32x4*)(P->in[13] + l * 512 + h * 128 + d0), n1 = *(const f32x4*)(P->in[13] + l * 512 + h * 128 + d0 + 4);
    float carry = 0.f;
    if (tid < 128) { for (int c = 0; c < 2 * half_sel; ++c) carry += DLC[(uidx0 * 4 + c) * 128 + tid]; }
    for (int nc = 2 * half_sel; nc < 2 * half_sel + 2; ++nc) {
        const int rown = row0 + 32 * nc + ti; const bf16* zr = Z + (size_t)rown * DIN + h * 128 + d0;
        const u32x4 uq = *(const u32x4*)(zr + C_HQ), uf0 = *(const u32x4*)(zr + C_HFF), uf1 = *(const u32x4*)(zr + C_HFB), ug = *(const u32x4*)(zr + C_HG);
        const float* olr = OL + (size_t)rown * 512 + h * 128 + d0; const f32x4 olp0 = *(const f32x4*)olr, olp1 = *(const f32x4*)(olr + 4);
        float off1 = 0.f;
        if (tid >= 128 && tid < 256) { for (int c = 0; c < 3 - nc; ++c) off1 += DLC[(uidx1 * 4 + c) * 128 + (tid - 128)]; }
        float q[8];
        {
            float ga[8], gb[8];
#pragma unroll
            for (int j = 0; j < 4; ++j) { const unsigned wq = uq[j], wa = uf0[j], wb = uf1[j];
                q[2 * j] = bflo(wq); q[2 * j + 1] = bfhi(wq);
                ga[2 * j] = bflo(wa); ga[2 * j + 1] = bfhi(wa); gb[2 * j] = bflo(wb); gb[2 * j + 1] = bfhi(wb); }
            LAS float* p0 = ldsf + (HF_TG0 >> 2) + ti * 132 + d0; LAS float* p1 = ldsf + (HF_TG1 >> 2) + ti * 132 + d0;
            *(LAS f32x4*)p0 = (f32x4){ga[0], ga[1], ga[2], ga[3]}; *(LAS f32x4*)(p0 + 4) = (f32x4){ga[4], ga[5], ga[6], ga[7]};
            *(LAS f32x4*)p1 = (f32x4){gb[0], gb[1], gb[2], gb[3]}; *(LAS f32x4*)(p1 + 4) = (f32x4){gb[4], gb[5], gb[6], gb[7]};
        }
        __syncthreads();
        if (tid < 256) { const bool rev = tid >= 128; LAS float* gc = ldsf + ((rev ? HF_TG1 : HF_TG0) >> 2) + (tid & 127); float run = rev ? off1 : carry; float gv[32];
#pragma unroll
            for (int i = 0; i < 32; ++i) gv[i] = gc[(rev ? 31 - i : i) * 132];
            SBAR
#pragma unroll
            for (int i = 0; i < 32; ++i) { run += gv[i]; gc[(rev ? 31 - i : i) * 132] = run; }
            if (!rev) carry = run; }
        __syncthreads();
        {
            const LAS float* g0 = ldsf + (HF_TG0 >> 2) + ti * 132 + d0; const LAS float* g1 = ldsf + (HF_TG1 >> 2) + ti * 132 + d0;
            float a[8], c[8];
#pragma unroll
            for (int j = 0; j < 8; ++j) { a[j] = q[j] * __builtin_amdgcn_exp2f(g0[j]); c[j] = q[j] * __builtin_amdgcn_exp2f(g1[j]); }
            *(LAS bf16x8*)(lds + HF_QG0 + ti * 272 + d0 * 2) = pack8(a[0], a[1], a[2], a[3], a[4], a[5], a[6], a[7]);
            *(LAS bf16x8*)(lds + HF_QG1 + ti * 272 + d0 * 2) = pack8(c[0], c[1], c[2], c[3], c[4], c[5], c[6], c[7]);
        }
        __syncthreads();
        {
            f32x16 acc;
#pragma unroll
            for (int i = 0; i < 16; ++i) acc[i] = 0.f;
            const LAS unsigned char* qp = lds + (ds ? HF_QG1 : HF_QG0) + r32 * 272 + 16 * hh;
            const LAS unsigned char* sp = lds + (ds ? HF_S1 : HF_S0) + (8 * hh + (i16 >> 2)) * 320 + (32 * nt + 16 * cg + 4 * (i16 & 3)) * 2;
#pragma unroll
            for (int k = 0; k < 8; ++k) { const bf16x8 sf = trpair(sp + 16 * k * 320, 4 * 320); acc = __builtin_amdgcn_mfma_f32_32x32x16_bf16(*(const LAS bf16x8*)(qp + 32 * k), sf, acc, 0, 0, 0); }
            LAS float* ob = ldsf + ((ds ? HF_TG1 : HF_TG0) >> 2) + (4 * hh) * 132 + 32 * nt + r32;
#pragma unroll
            for (int i = 0; i < 16; ++i) ob[R0(i) * 132] = acc[i];
        }
        __syncthreads();
        {
            const LAS float* oa = ldsf + (HF_TG0 >> 2) + ti * 132 + d0; const LAS float* obb = ldsf + (HF_TG1 >> 2) + ti * 132 + d0;
            const f32x4 a0 = *(const LAS f32x4*)oa, a1 = *(const LAS f32x4*)(oa + 4), b0 = *(const LAS f32x4*)obb, b1 = *(const LAS f32x4*)(obb + 4);
            const f32x4 o0 = a0 + b0 + olp0, o1 = a1 + b1 + olp1;
            float ss = (o0[0] * o0[0] + o0[1] * o0[1]) + (o0[2] * o0[2] + o0[3] * o0[3]) + (o1[0] * o1[0] + o1[1] * o1[1]) + (o1[2] * o1[2] + o1[3] * o1[3]);
            ss += __shfl_xor(ss, 1); ss += __shfl_xor(ss, 2); ss += __shfl_xor(ss, 4); ss += __shfl_xor(ss, 8);
            const float r = __builtin_amdgcn_rsqf(ss * (1.0f / 128.0f) + 1e-6f);
            u32x4 w;
            w.x = pk2(o0[0] * r * n0[0] * siluf_(bflo(ug.x)), o0[1] * r * n0[1] * siluf_(bfhi(ug.x))); w.y = pk2(o0[2] * r * n0[2] * siluf_(bflo(ug.y)), o0[3] * r * n0[3] * siluf_(bfhi(ug.y)));
            w.z = pk2(o1[0] * r * n1[0] * siluf_(bflo(ug.z)), o1[1] * r * n1[1] * siluf_(bfhi(ug.z))); w.w = pk2(o1[2] * r * n1[2] * siluf_(bflo(ug.w)), o1[3] * r * n1[3] * siluf_(bfhi(ug.w)));
            *(u32x4*)(MIX + (size_t)rown * D_MODEL + 1024 + h * 128 + d0) = w;
        }
        __syncthreads();
    }
}

#define RLX_AGENT __ATOMIC_RELAXED, __HIP_MEMORY_SCOPE_AGENT
#define XB_TMO      128
#define XB_XCNT(j)  (256  + 64 * (j))
#define XB_XSUB(j)  (1280 + 64 * (j))
#define XB_XGEN(j)  (2304 + 64 * (j))
#define XB_TOP      3328
#define XB_TOPGEN   3392
#define XCD_BAR_WORDS 3456
#define XB_SPIN_CAP (1u << 18)

__device__ __forceinline__ unsigned xb_ld(unsigned* p)              { return __hip_atomic_load(p, __ATOMIC_RELAXED, __HIP_MEMORY_SCOPE_AGENT); }
__device__ __forceinline__ unsigned xb_add(unsigned* p, unsigned v) { return __hip_atomic_fetch_add(p, v, __ATOMIC_RELAXED, __HIP_MEMORY_SCOPE_AGENT); }
__device__ __forceinline__ unsigned xb_xcc_id() { return (unsigned)__builtin_amdgcn_s_getreg((3 << 11) | 20) & 0xFu; }
#define XB_SPIN(cond, bar) do { unsigned _sp = 0; while (cond) { __builtin_amdgcn_s_sleep(1); \
    if ((++_sp & 255u) == 0u) { if (xb_ld(&(bar)[XB_TMO])) break; if (_sp > XB_SPIN_CAP) { atomicAdd(&(bar)[XB_TMO], 1u); break; } } } } while (0)

struct XcdBarrier {
    unsigned* bar; unsigned x; bool t0;
    volatile LAS unsigned* st;
};

__device__ __forceinline__ XcdBarrier xcd_barrier_post(unsigned* bar, volatile LAS unsigned* st) {
    XcdBarrier b; b.bar = bar; b.x = xb_xcc_id(); b.st = st; b.t0 = (threadIdx.x == 0);
    if (threadIdx.x == 0) (void)xb_add(&bar[XB_XCNT(b.x)], 1u);
    return b;
}
__device__ __forceinline__ void xcd_barrier_complete(unsigned* bar, unsigned x, unsigned& nloc, unsigned& nx) {
    const unsigned G = gridDim.x * gridDim.y * gridDim.z;
    unsigned sum, cnt, mine, sp = 0u;
    for (;;) {
        sum = 0u; cnt = 0u; mine = 0u;
#pragma unroll
        for (unsigned j = 0; j < 16; ++j) { const unsigned c = xb_ld(&bar[XB_XCNT(j)]); sum += c; cnt += (c > 0u) ? 1u : 0u; mine = (j == x) ? c : mine; }
        if (sum == G) break;
        __builtin_amdgcn_s_sleep(1);
        if ((++sp & 255u) == 0u) { if (xb_ld(&bar[XB_TMO])) break; if (sp > XB_SPIN_CAP) { atomicAdd(&bar[XB_TMO], 1u); break; } }
    }
    nloc = mine > 0u ? mine : 1u; nx = cnt > 0u ? cnt : 1u;
}

__device__ __forceinline__ void xcd_barrier(const XcdBarrier& b) {
    asm volatile("s_waitcnt vmcnt(0)" ::: "memory");
    __syncthreads();
    if (b.t0) {
        unsigned* bar = b.bar;
        __builtin_amdgcn_s_waitcnt(0);
        unsigned nloc = b.st[0], nx = b.st[1];
        if (nloc == 0u) { xcd_barrier_complete(bar, b.x, nloc, nx); b.st[0] = nloc; b.st[1] = nx; }
        const unsigned old = xb_add(&bar[XB_XSUB(b.x)], 1u);
        const unsigned gen = old / nloc;
        if (old + 1u == (gen + 1u) * nloc) {
            __builtin_amdgcn_fence(__ATOMIC_RELEASE, "agent");
            asm volatile("s_waitcnt vmcnt(0)" ::: "memory");
            const unsigned og = xb_add(&bar[XB_TOP], 1u);
            const unsigned tg = og / nx;
            if (og + 1u == (tg + 1u) * nx) xb_add(&bar[XB_TOPGEN], 1u);
            else XB_SPIN(xb_ld(&bar[XB_TOPGEN]) == tg, bar);
            __builtin_amdgcn_fence(__ATOMIC_ACQUIRE, "agent");
            xb_add(&bar[XB_XGEN(b.x)], 1u);
            asm volatile("s_waitcnt vmcnt(0)" ::: "memory");
        } else {
            XB_SPIN(xb_ld(&bar[XB_XGEN(b.x)]) == gen, bar);
            __builtin_amdgcn_fence(__ATOMIC_ACQUIRE, "agent");
            asm volatile("s_waitcnt vmcnt(0)" ::: "memory");
        }
    }
    __syncthreads();
}

#ifndef REP_P0
#define REP_P0 1
#endif
#ifndef REP_P1
#define REP_P1 1
#endif
#ifndef REP_P2
#define REP_P2 1
#endif
#ifndef PROBE_KIND
#define PROBE_KIND -1
#endif
#ifndef PROBE_PH
#define PROBE_PH 0
#endif
#ifndef PROBE_SCALE
#define PROBE_SCALE 1.0f
#endif
#ifndef PROBE_PB
#define PROBE_PB 0
#endif
#ifndef PROBE_PL
#define PROBE_PL 0
#endif
#ifndef P0_MASK
#define P0_MASK 3
#endif
#ifndef P2_MASK
#define P2_MASK 31
#endif
#ifndef REP_P3
#define REP_P3 1
#endif
#ifndef REP_P4
#define REP_P4 1
#endif
__global__ void __launch_bounds__(NTHREADS, 2) fwd_kernel(Params Pkarg) {
    extern __shared__ __attribute__((aligned(16))) unsigned char lds_raw[];
    cg::grid_group grid = cg::this_grid();
    LAS unsigned char* lds = (LAS unsigned char*)lds_raw;
    LAS float* ldsf = (LAS float*)lds;
    volatile LAS unsigned* qslot = (volatile LAS unsigned*)(lds + LDS_CTLW);
    volatile LAS unsigned* xbst = (volatile LAS unsigned*)(lds + LDS_CTLW + 128);
    if (threadIdx.x < 2) xbst[threadIdx.x] = 0u;
    __syncthreads();
    (void)xcd_barrier_post((unsigned*)(Pkarg.ws + WS_CTL) + 1024, xbst);
#define PSTAMP(k, lay) do { if (PROBE_KIND == 20 && (lay) == PROBE_PL && blockIdx.x == PROBE_PB && wave_s == 0) { const unsigned long long t_ = __builtin_amdgcn_s_memrealtime(); if ((k) == PROBE_PH) pst0 = t_; if ((k) == PROBE_PH + 1) pst1 = t_; } } while (0)
#define tid_zero_() (wave_s == 0 && __builtin_amdgcn_mbcnt_hi(~0u, __builtin_amdgcn_mbcnt_lo(~0u, 0u)) == 0u)
#define GSYNC() do { PP Pb_ = (PP)__builtin_amdgcn_kernarg_segment_ptr(); asm volatile("" : "+s"(Pb_)); XcdBarrier xb_; xb_.bar = (unsigned*)(Pb_->ws + WS_CTL) + 1024; xb_.x = xb_xcc_id(); xb_.st = xbst; int ln_; asm volatile("v_mbcnt_lo_u32_b32 %0, -1, 0\n\tv_mbcnt_hi_u32_b32 %0, -1, %0" : "=v"(ln_)); xb_.t0 = (wave_s == 0) && (ln_ == 0); xcd_barrier(xb_); } while (0)
    const int wave_s = __builtin_amdgcn_readfirstlane(threadIdx.x >> 6);
#define PHASE_IDS int tid; asm volatile("v_mbcnt_lo_u32_b32 %0, -1, 0\n\tv_mbcnt_hi_u32_b32 %0, -1, %0" : "=v"(tid)); tid += wave_s * 64; const int lane = tid & 63, wave = wave_s, gw = blockIdx.x * NWAVES + wave; (void)lane; (void)gw; \
    PP P = (PP)__builtin_amdgcn_kernarg_segment_ptr(); asm volatile("" : "+s"(P)); unsigned char* ws = P->ws; unsigned* ctl = (unsigned*)(ws + WS_CTL); float* MOD = (float*)(ws + WS_MOD); \
    bf16* H = (bf16*)(ws + WS_H); bf16* Z = (bf16*)(ws + WS_Z); bf16* WTIN = (bf16*)(ws + WS_WTIN); bf16* WTOUT = (bf16*)(ws + WS_WTOUT); const float* xp = P->in[0]; const float* xs = P->in[1]; \
    (void)ctl; (void)MOD; (void)H; (void)Z; (void)WTIN; (void)WTOUT; (void)xp; (void)xs;
    const int G = gridDim.x, NGW = G * NWAVES;
    unsigned long long pst0 = 0ull, pst1 = 0ull;

    for (int rep = 0; rep < REP_P0; ++rep) {
        PHASE_IDS
        const int m0 = (rep == 0) ? 3 : P0_MASK;
        if (m0 & 1) for (int u = blockIdx.x; u < 192; u += G) mod_unit(P, ldsf, 0, u, tid);
        LAS float* scr = ldsf + wave * 4096;
        if (m0 & 2) for (int it = gw; it < 6656; it += NGW) transpose_item(P->in[9], 2048, DIN, WTIN, scr, it, lane);
        { const int gt4 = (blockIdx.x * NTHREADS + tid) * 4;
          if (gt4 < 524288) { const float* src = (gt4 < 262144) ? P->in[2] + gt4 : P->in[3] + (gt4 - 262144); const f32x4 v = *(const f32x4*)src;
              u32x2 w; w.x = pk2(v[0], v[1]); w.y = pk2(v[2], v[3]); *(u32x2*)((bf16*)(ws + WS_CKV) + gt4) = w; } }
        const int gt = blockIdx.x * NTHREADS + tid;
        if (gt < 2048) { const int pos = gt >> 5, i = gt & 31; const float inv = powf(10000.0f, -(float)i / 32.0f); const float ang = (float)pos * inv;
            float sn, cs; sincosf(ang, &sn, &cs); float* CS = (float*)(ws + WS_CS); CS[gt * 2] = cs; CS[gt * 2 + 1] = sn; }
        grid.sync();
    }
    { PHASE_IDS
    for (int row = gw; row < MTOK; row += NGW) {
        const int cond = (row < NCTX) ? 0 : 1 + ((row - NCTX) >> 11);
        const float* xrow = (row < NCTX) ? xp + (size_t)row * D_MODEL : xs + (size_t)(row - NCTX) * D_MODEL;
        hprep_row(xrow, MOD + (0 * 3 + cond) * 6144, H + (size_t)row * D_MODEL, lane);
    } }
    GSYNC();

    for (int l = 0; l < DEPTH; ++l) {
        PSTAMP(0, l);
        for (int rep = 0; rep < REP_P1; ++rep) {
            PHASE_IDS
            pg8::Gemm g{H, WTIN, MTOK, DIN, D_MODEL}; pg8::StaticOrder S; S.init(MTOK, DIN, D_MODEL, G, (int)blockIdx.x);
            pg8::EpiZ E{Z, P->out + OUT_CK, P->out + OUT_CV, l, P->in[12]};
            pg8::gemm_phase<pg8::EpiZ, pg8::StaticOrder, true, true>(lds, g, S, E, tid);
            GSYNC();
        }
        PSTAMP(1, l);
        {
            int pendf = -1; int uf = -1;
            unsigned long long pr_sum = 0ull; unsigned pr_cnt = 0u;
            const int n_cvt = (l == 0 && G != 256) ? 832 : 0;
            for (int st = 0; st < 3; st += 2) {
                PHASE_IDS
                unsigned* cs = ctl + 64 * (l * 4 + st); unsigned* cf = ctl + 64 * (l * 4 + 3);
                const int nspec = (st == 2) ? 256 : 128;
                const int n_def = (l == 0) ? 192 + 512 : 0;
                const int capf = (st == 0) ? 256 : 896 + n_def + n_cvt;
                int pends = -1; bool spec = true;
                int us = q_pop(cs, qslot, tid, pends, 1 << 30);
                for (;;) {
                    int kind, idx;
                    if (spec) {
                        if (us >= nspec) { spec = false; if (uf < 0) uf = q_pop(cf, qslot, tid, pendf, 512); continue; }
                        kind = (st == 0) ? 1 : (st == 1) ? 6 : 7; idx = us;
                    } else {
                        if (uf >= capf) break;
                        if (uf < 128) { kind = 0; idx = uf; } else if (uf < 256) { kind = 3; idx = uf - 128; } else if (uf < 512) { kind = 2; idx = uf - 256; }
                        else if (uf < 896) { kind = 4; idx = uf - 512; } else if (uf < 896 + n_def) { idx = uf - 896; if (idx < 192) kind = 8; else { kind = 9; idx -= 192; } } else { kind = 5; idx = uf - 896 - n_def; }
                    }
                    asm volatile("" : "+v"(tid));
                    const unsigned long long pr_t0 = (PROBE_KIND >= 0 && PROBE_KIND < 9) ? __builtin_amdgcn_s_memrealtime() : 0ull;
                    if (kind <= 1) hgrn2_unit(P, lds, l, kind, idx, tid);
                    else if (kind <= 3) attn_unit(P, lds, l, kind - 2, idx, tid);
                    else if (kind == 4) conv_unit(P, ldsf, l, idx, tid);
                    else if (kind == 5) { const int lane2 = tid & 63; LAS float* scr = ldsf + wave * 4096; transpose_item(P->in[9] + (size_t)2048 * DIN, 2048, DIN, WTIN, scr, idx * 8 + wave, lane2); }
                    else if (kind == 6) hgrn_scan_unit(P, l, idx, tid);
                    else if (kind == 8) mod_unit(P, ldsf, 1, idx, tid);
                    else if (kind == 9) { const int it = idx * 8 + wave, lo = it & 2047; LAS float* scr = ldsf + wave * 4096;
                        transpose_item(P->in[10] + (size_t)(it >> 11) * 2048 * 2048, 2048, 2048, WTOUT + (size_t)(it >> 11) * 2048 * 2048, scr, lo, tid & 63); }
                    else hgrn_final_unit(P, lds, l, idx >> 1, idx & 1, tid);
                    if (PROBE_KIND >= 0 && PROBE_KIND < 9 && kind == PROBE_KIND) { __syncthreads(); pr_sum += __builtin_amdgcn_s_memrealtime() - pr_t0; pr_cnt += 1u; }
                    if (spec) us = q_pop(cs, qslot, tid, pends, 1 << 30); else uf = q_pop(cf, qslot, tid, pendf, 512);
                }
                GSYNC();
                PSTAMP(2 + st, l); if (st == 0) PSTAMP(3, l);
            }
            if (PROBE_KIND >= 0 && PROBE_KIND < 9 && l == 0 && tid_zero_()) { atomicAdd((unsigned long long*)((unsigned*)(Pkarg.ws + WS_CTL) + 60000), pr_sum); atomicAdd((unsigned*)(Pkarg.ws + WS_CTL) + 60002, pr_cnt); }
        }
        if (G == 256) {
            {   PHASE_IDS
                pg8::Gemm g{H, WTOUT + (size_t)l * 2048 * 2048, MTOK, D_MODEL, D_MODEL}; pg8::StaticOrder S; S.init(MTOK, D_MODEL, D_MODEL, G, (int)blockIdx.x, 0); S.rset = 0;
                pg8::EpiV E{(l == 0) ? xp : P->out, (l == 0) ? xs : P->out + OUT_YS, (bf16*)(ws + WS_OL), MOD + l * 3 * 6144 + 4096, (float*)(ws + WS_U), ctl + 8192};
                pg8::gemm_phase<pg8::EpiV, pg8::StaticOrder, true, true>(lds, g, S, E, tid);
            }
            GSYNC();
            PSTAMP(5, l);
            if (blockIdx.x < 128) {
                PHASE_IDS
                pg8::Gemm g{H, WTOUT + (size_t)l * 2048 * 2048, MTOK, D_MODEL, D_MODEL}; pg8::StaticOrder S; S.init(MTOK, D_MODEL, D_MODEL, G, (int)blockIdx.x, 0); S.rset = 1;
                pg8::EpiV E{(l == 0) ? xp : P->out, (l == 0) ? xs : P->out + OUT_YS, (bf16*)(ws + WS_OL), MOD + l * 3 * 6144 + 4096, (float*)(ws + WS_U), ctl + 8192};
                pg8::gemm_phase<pg8::EpiV, pg8::StaticOrder, true, true>(lds, g, S, E, tid);
            } else {
                PHASE_IDS
                for (int row = (blockIdx.x - 128) * NWAVES + wave; row < NCTX; row += 128 * NWAVES)
                    ln_row((const bf16*)(ws + WS_OL) + (size_t)row * D_MODEL, P->out + (size_t)row * D_MODEL, P->in[18] + l * D_MODEL, P->in[19] + l * D_MODEL, MOD + 3 * 6144, (l == 0) ? H + (size_t)row * D_MODEL : (bf16*)nullptr, lane);
                if (l == 0) {
                    LAS float* scr = ldsf + wave * 4096;
                    for (int it = (blockIdx.x - 128) * NWAVES + wave; it < 6656; it += 128 * NWAVES) { asm volatile("" : "+v"(tid)); transpose_item(P->in[9] + (size_t)2048 * DIN, 2048, DIN, WTIN, scr, it, tid & 63); }
                }
            }
#ifdef PROBE_SUB
            __syncthreads(); PSTAMP(6, l);
#endif
            GSYNC();
#ifndef PROBE_SUB
            PSTAMP(6, l);
#endif
            {   PHASE_IDS
                for (int row = NCTX + gw; row < MTOK; row += NGW) { const int cond = 1 + ((row - NCTX) >> 11);
                    ln_row((const bf16*)(ws + WS_OL) + (size_t)row * D_MODEL, P->out + (size_t)row * D_MODEL, P->in[18] + l * D_MODEL, P->in[19] + l * D_MODEL, MOD + (3 + cond) * 6144, (l == 0) ? H + (size_t)row * D_MODEL : (bf16*)nullptr, lane); }
            }
        } else {
            {   PHASE_IDS
                pg8::Gemm g{H, WTOUT + (size_t)l * 2048 * 2048, MTOK, D_MODEL, D_MODEL}; pg8::StaticOrder S; S.init(MTOK, D_MODEL, D_MODEL, G, (int)blockIdx.x, 0);
                pg8::EpiV E{(l == 0) ? xp : P->out, (l == 0) ? xs : P->out + OUT_YS, (bf16*)(ws + WS_OL), MOD + l * 3 * 6144 + 4096, (float*)(ws + WS_U), ctl + 8192};
                pg8::gemm_phase<pg8::EpiV, pg8::StaticOrder, true, true>(lds, g, S, E, tid);
            }
            GSYNC();
            {   PHASE_IDS
                for (int row = gw; row < MTOK; row += NGW) { const int cond = (row < NCTX) ? 0 : 1 + ((row - NCTX) >> 11);
                    ln_row((const bf16*)(ws + WS_OL) + (size_t)row * D_MODEL, P->out + (size_t)row * D_MODEL, P->in[18] + l * D_MODEL, P->in[19] + l * D_MODEL, MOD + (3 + cond) * 6144, (l == 0) ? H + (size_t)row * D_MODEL : (bf16*)nullptr, lane); }
            }
        }
        if (l + 1 < DEPTH) GSYNC();
        PSTAMP(7, l);
    }
    if (PROBE_KIND >= 0) { GSYNC(); PHASE_IDS if (blockIdx.x == ((PROBE_KIND == 20) ? PROBE_PB : 0) && tid == 0) { const unsigned long long sm = *(volatile unsigned long long*)(ctl + 60000); const unsigned cn = *(volatile unsigned*)(ctl + 60002); const float pv_ = (PROBE_KIND == 20) ? PROBE_SCALE * 0.01f * (float)(pst1 - pst0) : ((PROBE_KIND == 9) ? 0.1f : 0.01f) * (float)sm / (float)(cn ? cn : 1u);     P->out[0] = pv_; P->out[1] = pv_; P->out[2] = pv_; P->out[3] = pv_; }     }
}

extern "C" void kernel_launch(void* const* d_in, const int* in_sizes, int n_in, void* d_out, int out_size, void* d_ws, size_t ws_size, hipStream_t stream) {
    static int grid = 0;
    if (grid == 0) {
        if (n_in != 20 || out_size != (int)OUT_TOTAL || ws_size < WS_END) { fprintf(stderr, "kernel_launch: unexpected shapes (n_in %d, out %d, ws %zu)\n", n_in, out_size, ws_size); grid = -1; return; }
        int dev = 0, cus = 0, per_cu = 0;
        hipGetDevice(&dev); hipDeviceGetAttribute(&cus, hipDeviceAttributeMultiprocessorCount, dev);
        hipFuncSetAttribute((const void*)fwd_kernel, hipFuncAttributeMaxDynamicSharedMemorySize, LDS_BYTES);
        hipOccupancyMaxActiveBlocksPerMultiprocessor(&per_cu, (const void*)fwd_kernel, NTHREADS, LDS_BYTES);
        if (per_cu < 1) { fprintf(stderr, "kernel_launch: occupancy query says %d blocks per CU\n", per_cu); grid = -1; return; }
        grid = cus;
    }
    if (grid < 0) return;
    hipMemsetAsync((char*)d_ws + WS_CTL, 0, CTL_ZERO_BYTES, stream);
    Params p{};
    for (int i = 0; i < 20; ++i) p.in[i] = (const float*)d_in[i];
    p.out = (float*)d_out; p.ws = (unsigned char*)d_ws;
    void* args[] = {&p};
    hipError_t e = hipLaunchCooperativeKernel((const void*)fwd_kernel, dim3(grid), dim3(NTHREADS), args, LDS_BYTES, stream);
    if (e != hipSuccess) fprintf(stderr, "cooperative launch failed: %s (grid %d)\n", hipGetErrorString(e), grid);
}
```
